# Optimizing an MI355X kernel written in HIP

```python
import jax, jax.numpy as jnp
from jax import lax
import numpy as np

D_MODEL = 2048
BATCH = 1
SEQ = 8192
DEPTH = 1

POOL_WIDTH = D_MODEL // 2
POOL_WINDOWS = (2, 4, 8, 16)
N_POOL_GROUPS = len(POOL_WINDOWS)
POOL_GROUP = POOL_WIDTH // N_POOL_GROUPS
N_Q_HEADS = 16
N_KV_HEADS = 4
GROUP = N_Q_HEADS // N_KV_HEADS
HEAD_DIM = D_MODEL // N_Q_HEADS
NSA_WIDTH = N_Q_HEADS * HEAD_DIM
KV_WIDTH = N_KV_HEADS * HEAD_DIM
CMP_BLOCK = 32
CMP_STRIDE = 16
CMP_HIDDEN = 2 * HEAD_DIM
SEL_BLOCK = 64
N_SEL = 16
WINDOW = 512
Q_BLOCK = 128
ROPE_THETA = 10000.0
EPS = 1e-6
NEG = -1e30
FORCE = 1e6
N_BRANCHES = 2
IN_SPLITS = (POOL_WIDTH, POOL_WIDTH, NSA_WIDTH, KV_WIDTH, KV_WIDTH, KV_WIDTH, KV_WIDTH,
             KV_WIDTH, KV_WIDTH, NSA_WIDTH, 3 * N_Q_HEADS)
D_IN = sum(IN_SPLITS)

kernel_name = "hybrid_pool_nsa_gated_block"


def rmsnorm(x, w):
    xf = x.astype(jnp.float32)
    y = xf * lax.rsqrt(jnp.mean(xf * xf, axis=-1, keepdims=True) + EPS)
    return (y * w.astype(jnp.float32)).astype(x.dtype)


def rope(x, pos):
    half = HEAD_DIM // 2
    inv = ROPE_THETA ** (-jnp.arange(half, dtype=jnp.float32) / half)
    ang = pos.astype(jnp.float32)[:, None] * inv[None, :]
    cos = jnp.cos(ang)[None, :, None, :]
    sin = jnp.sin(ang)[None, :, None, :]
    xf = x.astype(jnp.float32)
    x1, x2 = xf[..., :half], xf[..., half:]
    return jnp.concatenate([x1 * cos - x2 * sin, x2 * cos + x1 * sin], axis=-1).astype(x.dtype)


def pool_mixer(u, mix, scale):
    b, s, _ = u.shape
    ug = u.reshape(b, s, N_POOL_GROUPS, POOL_GROUP)
    uf = ug.astype(jnp.float32)
    c = jnp.pad(jnp.cumsum(uf, axis=1), ((0, 0), (1, 0), (0, 0), (0, 0)))
    t = np.arange(s)
    win = np.array(POOL_WINDOWS)
    lo = np.maximum(t[:, None] + 1 - win[None, :], 0)
    cnt = jnp.asarray(np.minimum(t[:, None] + 1, win[None, :]).astype(np.float32))
    c_lo = c[:, lo, np.arange(N_POOL_GROUPS)[None, :]]
    mean = (c[:, 1:] - c_lo) / cnt[None, :, :, None]
    pooled = (mean - uf).astype(u.dtype)
    z = jnp.einsum("bsgc,gcd->bsgd", pooled, mix).reshape(b, s, POOL_WIDTH)
    return z * scale


def compress(kraw, pe, w1, w2):
    s = kraw.shape[1]
    n_cmp = (s - CMP_BLOCK) // CMP_STRIDE + 1
    idx = np.arange(n_cmp)[:, None] * CMP_STRIDE + np.arange(CMP_BLOCK)[None, :]
    kb = kraw[:, idx] + pe[None, None, :, None, :]
    hdn = jax.nn.silu(jnp.einsum("bnlhd,ldf->bnhf", kb, w1))
    return jnp.einsum("bnhf,fe->bnhe", hdn, w2)


def nsa_attention(q, kc, vc, ks, vs, kw, vw, gates):
    b, s = q.shape[0], q.shape[1]
    n_cmp = kc.shape[1]
    n_blk = s // SEL_BLOCK
    n_sel = min(N_SEL, n_blk)
    scale = HEAD_DIM ** -0.5
    cmp_end = jnp.arange(n_cmp) * CMP_STRIDE + CMP_BLOCK - 1
    ratio = SEL_BLOCK // CMP_STRIDE
    sub = CMP_BLOCK // CMP_STRIDE
    sel_idx = (np.arange(n_blk)[:, None, None] * ratio + np.arange(ratio)[None, :, None]
               - np.arange(sub)[None, None, :]).reshape(n_blk, ratio * sub)
    sel_valid = jnp.asarray((sel_idx >= 0) & (sel_idx < n_cmp))
    sel_idx = np.clip(sel_idx, 0, n_cmp - 1)
    ks_blk = ks.reshape(b, n_blk, SEL_BLOCK, N_KV_HEADS, HEAD_DIM).transpose(0, 3, 1, 2, 4)
    vs_blk = vs.reshape(b, n_blk, SEL_BLOCK, N_KV_HEADS, HEAD_DIM).transpose(0, 3, 1, 2, 4)
    kw_pad = jnp.pad(kw, ((0, 0), (WINDOW, 0), (0, 0), (0, 0)))
    vw_pad = jnp.pad(vw, ((0, 0), (WINDOW, 0), (0, 0), (0, 0)))
    gather = jax.vmap(jax.vmap(lambda kt, ix: kt[ix]))
    jblk = jnp.arange(n_blk)

    def block(i):
        s0 = i * Q_BLOCK
        qb = lax.dynamic_slice_in_dim(q, s0, Q_BLOCK, axis=1)
        gb = lax.dynamic_slice_in_dim(gates, s0, Q_BLOCK, axis=1)
        tpos = s0 + jnp.arange(Q_BLOCK)
        sc = jnp.einsum("bqhgd,bnhd->bhgqn", qb, kc, preferred_element_type=jnp.float32) * scale
        cvalid = cmp_end[None, :] <= tpos[:, None]
        p_c = jnp.where(cvalid, jax.nn.softmax(jnp.where(cvalid, sc, NEG), axis=-1), 0.0)
        o_c = jnp.einsum("bhgqn,bnhe->bqhge", p_c.astype(vc.dtype), vc)
        imp_c = p_c.sum(axis=2)
        imp = jnp.where(sel_valid, imp_c[..., sel_idx], 0.0).sum(-1)
        jt = (tpos // SEL_BLOCK)[:, None]
        forced = (jblk[None, :] == 0) | (jblk[None, :] == jt) | (jblk[None, :] == jt - 1)
        imp = jnp.where(forced, FORCE, imp)
        imp = jnp.where(jblk[None, :] > jt, NEG, imp)
        _, top = lax.top_k(imp, n_sel)
        kg = gather(ks_blk, top)
        vg = gather(vs_blk, top)
        kpos = top[..., None] * SEL_BLOCK + jnp.arange(SEL_BLOCK)
        svalid = kpos <= tpos[None, None, :, None, None]
        ss = jnp.einsum("bqhgd,bhqnld->bhgqnl", qb, kg, preferred_element_type=jnp.float32) * scale
        ss = jnp.where(svalid[:, :, None], ss, NEG)
        p_s = jax.nn.softmax(ss.reshape(ss.shape[:4] + (-1,)), axis=-1).reshape(ss.shape)
        o_s = jnp.einsum("bhgqnl,bhqnle->bqhge", p_s.astype(vg.dtype), vg)
        kwb = lax.dynamic_slice_in_dim(kw_pad, s0, WINDOW + Q_BLOCK, axis=1)
        vwb = lax.dynamic_slice_in_dim(vw_pad, s0, WINDOW + Q_BLOCK, axis=1)
        wpos = s0 - WINDOW + jnp.arange(WINDOW + Q_BLOCK)
        diff = tpos[:, None] - wpos[None, :]
        wvalid = (diff >= 0) & (diff < WINDOW) & (wpos[None, :] >= 0)
        sw = jnp.einsum("bqhgd,bkhd->bhgqk", qb, kwb, preferred_element_type=jnp.float32) * scale
        p_w = jax.nn.softmax(jnp.where(wvalid, sw, NEG), axis=-1)
        o_w = jnp.einsum("bhgqk,bkhe->bqhge", p_w.astype(vwb.dtype), vwb)
        return gb[..., 0:1] * o_c + gb[..., 1:2] * o_s + gb[..., 2:3] * o_w

    out = lax.map(block, jnp.arange(s // Q_BLOCK))
    return out.transpose(1, 0, 2, 3, 4, 5).reshape(b, s, NSA_WIDTH)


def setup_inputs(seed: int = 0) -> dict:
    key = jax.random.key(seed)
    ks = jax.random.split(key, 20)
    f32 = jnp.float32
    nrm = lambda k, shape, fan: jax.random.normal(k, shape, f32) * (fan ** -0.5)
    L = DEPTH
    return {
        "x": jax.random.normal(ks[0], (BATCH, SEQ, D_MODEL), f32),
        "norm_w": 1.0 + 0.05 * jax.random.normal(ks[1], (L, D_MODEL), f32),
        "w_in": nrm(ks[2], (L, D_MODEL, D_IN), D_MODEL),
        "pool_mix": nrm(ks[3], (L, N_POOL_GROUPS, POOL_GROUP, POOL_GROUP), POOL_GROUP),
        "pool_scale": 1.0 + 0.1 * jax.random.normal(ks[4], (L, POOL_WIDTH), f32),
        "cmp_pe_k": 0.1 * jax.random.normal(ks[5], (L, CMP_BLOCK, HEAD_DIM), f32),
        "cmp_w1_k": nrm(ks[6], (L, CMP_BLOCK, HEAD_DIM, CMP_HIDDEN), CMP_BLOCK * HEAD_DIM),
        "cmp_w2_k": nrm(ks[7], (L, CMP_HIDDEN, HEAD_DIM), CMP_HIDDEN),
        "cmp_pe_v": 0.1 * jax.random.normal(ks[8], (L, CMP_BLOCK, HEAD_DIM), f32),
        "cmp_w1_v": nrm(ks[9], (L, CMP_BLOCK, HEAD_DIM, CMP_HIDDEN), CMP_BLOCK * HEAD_DIM),
        "cmp_w2_v": nrm(ks[10], (L, CMP_HIDDEN, HEAD_DIM), CMP_HIDDEN),
        "w_pool_out": nrm(ks[11], (L, POOL_WIDTH, D_MODEL), POOL_WIDTH),
        "w_nsa_out": nrm(ks[12], (L, NSA_WIDTH, D_MODEL), NSA_WIDTH),
        "w_merge": nrm(ks[13], (L, D_MODEL, N_BRANCHES * D_MODEL), D_MODEL),
        "b_merge": 0.01 * jax.random.normal(ks[14], (L, N_BRANCHES * D_MODEL), f32),
        "w_out": nrm(ks[15], (L, D_MODEL, D_MODEL), D_MODEL),
        "final_norm_w": 1.0 + 0.05 * jax.random.normal(ks[16], (D_MODEL,), f32),
    }


def reference(x, norm_w, w_in, pool_mix, pool_scale, cmp_pe_k, cmp_w1_k, cmp_w2_k,
              cmp_pe_v, cmp_w1_v, cmp_w2_v, w_pool_out, w_nsa_out, w_merge, b_merge,
              w_out, final_norm_w):
    b, s, _ = x.shape
    pos = jnp.arange(s)
    n_cmp = (s - CMP_BLOCK) // CMP_STRIDE + 1
    cmp_pos = jnp.arange(n_cmp) * CMP_STRIDE + CMP_BLOCK - 1
    split_at = np.cumsum(IN_SPLITS)[:-1].tolist()
    for layer in range(DEPTH):
        h = rmsnorm(x, norm_w[layer])
        proj = h @ w_in[layer]
        (u_pool, g_pool, q, kc_raw, vc_raw, k_sel, v_sel, k_win, v_win,
         g_nsa, g_br) = jnp.split(proj, split_at, axis=-1)
        y_pool = pool_mixer(u_pool, pool_mix[layer], pool_scale[layer]) * jax.nn.silu(g_pool)
        y_a = y_pool @ w_pool_out[layer]
        heads = lambda t, n: t.reshape(b, s, n, HEAD_DIM)
        qh = rope(heads(q, N_Q_HEADS), pos).reshape(b, s, N_KV_HEADS, GROUP, HEAD_DIM)
        kc = rope(compress(heads(kc_raw, N_KV_HEADS), cmp_pe_k[layer], cmp_w1_k[layer],
                           cmp_w2_k[layer]), cmp_pos)
        vc = compress(heads(vc_raw, N_KV_HEADS), cmp_pe_v[layer], cmp_w1_v[layer], cmp_w2_v[layer])
        ksh = rope(heads(k_sel, N_KV_HEADS), pos)
        kwh = rope(heads(k_win, N_KV_HEADS), pos)
        gates = jax.nn.sigmoid(g_br).reshape(b, s, N_KV_HEADS, GROUP, 3)
        o_nsa = nsa_attention(qh, kc, vc, ksh, heads(v_sel, N_KV_HEADS), kwh,
                              heads(v_win, N_KV_HEADS), gates)
        y_b = (o_nsa * jax.nn.silu(g_nsa)) @ w_nsa_out[layer]
        gm = jax.nn.sigmoid(h @ w_merge[layer] + b_merge[layer]).reshape(b, s, N_BRANCHES, D_MODEL)
        merged = gm[:, :, 0] * y_a + gm[:, :, 1] * y_b
        x = x + merged @ w_out[layer]
    return rmsnorm(x, final_norm_w)
```

```cpp
#include <hip/hip_runtime.h>
#include <cstdio>
#include <cstdint>

#define LAS __attribute__((address_space(3)))
#define GAS __attribute__((address_space(1)))
typedef unsigned short bf16_t;
typedef short bf16x8 __attribute__((ext_vector_type(8)));
typedef short s16x4 __attribute__((ext_vector_type(4)));
typedef float f32x4 __attribute__((ext_vector_type(4)));
typedef float f32x16 __attribute__((ext_vector_type(16)));
typedef unsigned u32x4 __attribute__((ext_vector_type(4)));
typedef unsigned u32x2 __attribute__((ext_vector_type(2)));
typedef float f32x2_t __attribute__((ext_vector_type(2)));
typedef __bf16 bf16x2_t __attribute__((ext_vector_type(2)));

#ifndef N_LAUNCHES_PER_PHASE
#define N_LAUNCHES_PER_PHASE 0
#endif

constexpr int S = 8192, DM = 2048, NCAT = 13568;
constexpr int HD = 128, NKV = 4, NCMP = 511;
constexpr float EPS = 1e-6f;

constexpr size_t MiB = 1u << 20;
constexpr size_t WS_CTL = 0, CTL_BYTES = 1 * MiB;
constexpr size_t WS_WCAT = 1 * MiB;
constexpr size_t WS_SLAB = WS_WCAT;
constexpr size_t WS_YAG  = WS_WCAT;
constexpr size_t WS_MIXT = 54 * MiB;
constexpr size_t WS_WPOT = 55 * MiB;
constexpr size_t WS_WNOT = 59 * MiB;
constexpr size_t WS_WOT  = 67 * MiB;
constexpr size_t WS_W1KT = 75 * MiB, WS_W1VT = 77 * MiB;
constexpr size_t WS_W2KT = 79 * MiB, WS_W2VT = 79 * MiB + 65536;
constexpr size_t WS_B1P  = 79 * MiB + 131072;
constexpr size_t WS_B1   = 79 * MiB + 131072 + 32768;
constexpr size_t WS_KC   = 79 * MiB + 262144, WS_VC = 79 * MiB + 786432;
constexpr size_t WS_ROPE = 81 * MiB;
constexpr size_t WS_SSQ  = 85 * MiB;
constexpr size_t WS_H    = 86 * MiB;
constexpr size_t WS_U    = 118 * MiB, WS_GP = 134 * MiB;
constexpr size_t WS_Q    = 150 * MiB;
constexpr size_t WS_KCR  = 182 * MiB, WS_VCR = 190 * MiB, WS_KS = 198 * MiB, WS_VS = 206 * MiB, WS_KW = 214 * MiB, WS_VW = 222 * MiB;
constexpr size_t WS_GN   = 230 * MiB;
constexpr size_t WS_GBR  = 262 * MiB;
constexpr size_t WS_END  = 266 * MiB;
constexpr int CW_BAR = 4096;

constexpr int RING_BYTES = 131072;
constexpr int LDSCTL_OFF = RING_BYTES, MISC_OFF = LDSCTL_OFF + 320;
constexpr int LDS_BYTES = 147456;
constexpr int NWAVES = 8;

#define LDS_WAIT() asm volatile("s_waitcnt lgkmcnt(0)" ::: "memory")
#define VM_WAIT() asm volatile("s_waitcnt vmcnt(0)" ::: "memory")

__device__ __forceinline__ unsigned cvtpk(float lo, float hi) { f32x2_t v = {lo, hi}; bf16x2_t b = __builtin_convertvector(v, bf16x2_t); return __builtin_bit_cast(unsigned, b); }
__device__ __forceinline__ float bf2f(unsigned short h) { return __builtin_bit_cast(float, (unsigned)h << 16); }
__device__ __forceinline__ float bflo(unsigned w) { return __builtin_bit_cast(float, w << 16); }
__device__ __forceinline__ float bfhi(unsigned w) { return __builtin_bit_cast(float, w & 0xffff0000u); }
__device__ __forceinline__ float sigmoidf_(float x) { return 1.0f / (1.0f + __expf(-x)); }
__device__ __forceinline__ float siluf_(float x) { return x / (1.0f + __expf(-x)); }
__device__ __forceinline__ int otid() { int t = threadIdx.x; asm volatile("" : "+v"(t)); return t; }
__device__ __forceinline__ float wave_sum(float v) {
#pragma unroll
    for (int o = 1; o < 64; o <<= 1) v += __shfl_xor(v, o);
    return v;
}

#define XB_TMO      128
#define XB_XCNT(j)  (256  + 64 * (j))
#define XB_XSUB(j)  (1280 + 64 * (j))
#define XB_XGEN(j)  (2304 + 64 * (j))
#define XB_TOP      3328
#define XB_TOPGEN   3392
#define XCD_BAR_WORDS 3456
#define XB_SPIN_CAP (1u << 18)
__device__ __forceinline__ unsigned xb_ld(unsigned* p)              { return __hip_atomic_load(p, __ATOMIC_RELAXED, __HIP_MEMORY_SCOPE_AGENT); }
__device__ __forceinline__ unsigned xb_add(unsigned* p, unsigned v) { return __hip_atomic_fetch_add(p, v, __ATOMIC_RELAXED, __HIP_MEMORY_SCOPE_AGENT); }
__device__ __forceinline__ unsigned xb_xcc_id() { return (unsigned)__builtin_amdgcn_s_getreg((3 << 11) | 20) & 0xFu; }
#define XB_SPIN(cond, bar) do { unsigned _sp = 0; while (cond) { __builtin_amdgcn_s_sleep(1); \
    if ((++_sp & 255u) == 0u) { if (xb_ld(&(bar)[XB_TMO])) break; if (_sp > XB_SPIN_CAP) { atomicAdd(&(bar)[XB_TMO], 1u); break; } } } } while (0)
struct XcdBarrier { unsigned* bar; unsigned x; volatile LAS unsigned* st; };
__device__ __forceinline__ XcdBarrier xcd_barrier_post(unsigned* bar, volatile LAS unsigned* st) {
    XcdBarrier b; b.bar = bar; b.x = xb_xcc_id(); b.st = st;
    if (threadIdx.x == 0) (void)xb_add(&bar[XB_XCNT(b.x)], 1u);
    return b;
}
__device__ __forceinline__ void xcd_barrier_complete(unsigned* bar, unsigned x, unsigned& nloc, unsigned& nx) {
    const unsigned G = gridDim.x * gridDim.y * gridDim.z;
    unsigned sum, cnt, mine, sp = 0u;
    for (;;) {
        sum = 0u; cnt = 0u; mine = 0u;
#pragma unroll
        for (unsigned j = 0; j < 16; ++j) { const unsigned c = xb_ld(&bar[XB_XCNT(j)]); sum += c; cnt += (c > 0u) ? 1u : 0u; mine = (j == x) ? c : mine; }
        if (sum == G) break;
        __builtin_amdgcn_s_sleep(1);
        if ((++sp & 255u) == 0u) { if (xb_ld(&bar[XB_TMO])) break; if (sp > XB_SPIN_CAP) { atomicAdd(&bar[XB_TMO], 1u); break; } }
    }
    nloc = mine > 0u ? mine : 1u; nx = cnt > 0u ? cnt : 1u;
}
__device__ __forceinline__ void xcd_barrier(const XcdBarrier& b) {
    asm volatile("s_waitcnt vmcnt(0)" ::: "memory");
    __syncthreads();
    if (threadIdx.x == 0) {
        unsigned* bar = b.bar;
        __builtin_amdgcn_s_waitcnt(0);
        unsigned nloc = b.st[0], nx = b.st[1];
        if (nloc == 0u) { xcd_barrier_complete(bar, b.x, nloc, nx); b.st[0] = nloc; b.st[1] = nx; }
        const unsigned old = xb_add(&bar[XB_XSUB(b.x)], 1u);
        const unsigned gen = old / nloc;
        if (old + 1u == (gen + 1u) * nloc) {
            __builtin_amdgcn_fence(__ATOMIC_RELEASE, "agent");
            asm volatile("s_waitcnt vmcnt(0)" ::: "memory");
            const unsigned og = xb_add(&bar[XB_TOP], 1u);
            const unsigned tg = og / nx;
            if (og + 1u == (tg + 1u) * nx) xb_add(&bar[XB_TOPGEN], 1u);
            else XB_SPIN(xb_ld(&bar[XB_TOPGEN]) == tg, bar);
            __builtin_amdgcn_fence(__ATOMIC_ACQUIRE, "agent");
            xb_add(&bar[XB_XGEN(b.x)], 1u);
            asm volatile("s_waitcnt vmcnt(0)" ::: "memory");
        } else {
            XB_SPIN(xb_ld(&bar[XB_XGEN(b.x)]) == gen, bar);
            __builtin_amdgcn_fence(__ATOMIC_ACQUIRE, "agent");
            asm volatile("s_waitcnt vmcnt(0)" ::: "memory");
        }
    }
    __syncthreads();
}

namespace pg8 {
constexpr int BM = 256, BK = 64, HALF = 128, HTB = HALF * BK * 2, STAGE_BYTES = 8 * HTB, NXCD = 8, WGM = 8;
__host__ __device__ __forceinline__ int lds_byte(int r, int c) { const int st = (r >> 4) * 2 + (c >> 5), rr = r & 15, cc = c & 31, ob = rr * 64 + cc * 2; return st * 1024 + (ob ^ (((ob >> 9) & 1) << 5)); }
__host__ __device__ __forceinline__ void stage_rc(int b, int& R, int& C) { const int st = b / 1024, sb = b % 1024, swz = sb ^ (((sb >> 9) & 1) << 5); R = (st >> 1) * 16 + swz / 64; C = (st & 1) * 32 + (swz % 64) / 2; }
__host__ __device__ __forceinline__ int perm32(int rho) { const int n = rho >> 4, i = rho & 15; return 8 * (i >> 2) + 4 * n + (i & 3); }
struct Unit { int pm, pn; };
struct Gemm { const bf16_t* A; const bf16_t* Bt; int lda, ldb, K; int a_pn_off; };
struct StaticOrder {
    int nM, nN, nwg, G, c;
    __host__ __device__ void init(int M, int N, int G_, int c_) { nM = M / BM; nN = N / BM; nwg = nM * nN; G = G_; c = c_; }
    __host__ __device__ bool next(int i, Unit& u) const {
        const long L = (long)i * G + c; if (L >= nwg) return false;
        int wgid = (int)L; { const int q = nwg / NXCD, r = nwg % NXCD, xcd = wgid % NXCD, off = wgid / NXCD; wgid = (xcd < r ? xcd * (q + 1) : r * (q + 1) + (xcd - r) * q) + off; }
        const int nig = WGM * nN, gid = wgid / nig, fm = gid * WGM, gsz = (nM - fm) < WGM ? (nM - fm) : WGM;
        u.pm = fm + ((wgid % nig) % gsz); u.pn = (wgid % nig) / gsz; return true;
    }
};
template <class Epi, bool ALIGN_EPI>
__device__ __forceinline__ void gemm_phase(LAS unsigned char* lds, const Gemm g, const StaticOrder& S, const Epi& E) {
    const int tid = otid(), wid = __builtin_amdgcn_readfirstlane(tid >> 6), lane = tid & 63, wr = wid >> 2, wc = wid & 3, fr = lane & 15, fq = lane >> 4;
    const int K = g.K, nt = K / BK;
    unsigned voffA[2], voffB[2];
#pragma unroll
    for (int i = 0; i < 2; ++i) { int R, C; stage_rc(tid * 16 + i * 8192, R, C); const int Rb = (R & ~31) + perm32(R & 31);
        voffA[i] = (unsigned)(R * g.lda + C) * 2u; voffB[i] = (unsigned)(Rb * g.ldb + C) * 2u; }
    const size_t kstep = (size_t)(BK * 2);
    const size_t hA = (size_t)HALF * g.lda * 2, hB = (size_t)HALF * g.ldb * 2;
    const size_t tA = 2 * hA, tB = 2 * hB;
    const unsigned ldsw = (unsigned)wid * 1024u;
    const int aoff = lds_byte(wr * 64 + fr, fq * 8), boff = lds_byte(wc * 32 + fr, fq * 8);
#define PG8_SA(b, h) (((b) * 2 + (h)) * HTB)
#define PG8_SB(b, h) ((4 + (b) * 2 + (h)) * HTB)
#define PG8_STAGE(bufoff, gbase, voff) do { _Pragma("unroll") for (int _i = 0; _i < 2; ++_i) \
        __builtin_amdgcn_global_load_lds((const unsigned*)((const char*)(gbase) + (voff)[_i]), (LAS unsigned*)(lds + (bufoff) + ldsw + _i * 8192), 16, 0, 0); } while (0)
#define PG8_LDA(dst, b, h) do { _Pragma("unroll") for (int m = 0; m < 4; ++m) _Pragma("unroll") for (int k = 0; k < 2; ++k) dst[m][k] = *(const LAS bf16x8*)(lds + PG8_SA(b, h) + aoff + m * 2048 + k * 1024); } while (0)
#define PG8_LDB(dst, b, h) do { _Pragma("unroll") for (int n = 0; n < 2; ++n) _Pragma("unroll") for (int k = 0; k < 2; ++k) dst[n][k] = *(const LAS bf16x8*)(lds + PG8_SB(b, h) + boff + n * 2048 + k * 1024); } while (0)
#define PG8_MMA(ai, bj, At, Bt) do { __builtin_amdgcn_s_setprio(1); _Pragma("unroll") for (int m = 0; m < 4; ++m) _Pragma("unroll") for (int n = 0; n < 2; ++n) _Pragma("unroll") for (int k = 0; k < 2; ++k) \
        acc[ai][bj][m][n] = __builtin_amdgcn_mfma_f32_16x16x32_bf16(Bt[n][k], At[m][k], acc[ai][bj][m][n], 0, 0, 0); __builtin_amdgcn_s_setprio(0); } while (0)
#define PG8_WAIT_V(n) asm volatile("s_waitcnt vmcnt(" #n ")" ::: "memory")
#define PG8_WAIT_L(n) asm volatile("s_waitcnt lgkmcnt(" #n ")" ::: "memory")
#define PG8_BAR __builtin_amdgcn_s_barrier()
#define PG8_SCHED __builtin_amdgcn_sched_barrier(0)
    Unit cur, nxt; int ui = 0;
    if (!S.next(0, cur)) return;
    f32x4 acc[2][2][4][2];
#pragma unroll
    for (int a = 0; a < 2; ++a)
#pragma unroll
        for (int b = 0; b < 2; ++b)
#pragma unroll
            for (int m = 0; m < 4; ++m)
#pragma unroll
                for (int n = 0; n < 2; ++n) acc[a][b][m][n] = (f32x4){0.f, 0.f, 0.f, 0.f};
    bf16x8 At[4][2], B0[2][2], B1[2][2];
    const char* cA = (const char*)g.A + (size_t)cur.pm * tA + (size_t)cur.pn * g.a_pn_off; const char* cB = (const char*)g.Bt + (size_t)cur.pn * tB;
    PG8_STAGE(PG8_SB(0, 0), cB, voffB); PG8_STAGE(PG8_SB(0, 1), cB + hB, voffB); PG8_STAGE(PG8_SA(0, 0), cA, voffA); PG8_STAGE(PG8_SA(0, 1), cA + hA, voffA);
    if (wr == 1) PG8_BAR;
    PG8_WAIT_V(2); PG8_BAR;
    PG8_STAGE(PG8_SB(1, 0), cB + kstep, voffB); PG8_STAGE(PG8_SA(1, 0), cA + kstep, voffA); PG8_STAGE(PG8_SB(1, 1), cB + hB + kstep, voffB);
    PG8_WAIT_V(6); PG8_BAR;
    for (;;) {
        const bool has_next = S.next(ui + 1, nxt);
        const char* nA = has_next ? (const char*)g.A + (size_t)nxt.pm * tA + (size_t)nxt.pn * g.a_pn_off : cA; const char* nB = has_next ? (const char*)g.Bt + (size_t)nxt.pn * tB : cB;
        for (int t = 0; t < nt; t += 2) {
            const bool last = (t == nt - 2);
            const char* a1 = cA + (size_t)(t + 1) * kstep;
            const char* a2 = last ? nA : cA + (size_t)(t + 2) * kstep; const char* b2 = last ? nB : cB + (size_t)(t + 2) * kstep;
            const char* a3 = a2 + kstep; const char* b3 = b2 + kstep;
            PG8_LDB(B0, 0, 0); PG8_LDB(B1, 0, 1); PG8_SCHED; PG8_LDA(At, 0, 0); PG8_STAGE(PG8_SA(1, 1), a1 + hA, voffA);
            PG8_WAIT_V(8); PG8_WAIT_L(0); PG8_BAR; PG8_MMA(0, 0, At, B0); PG8_MMA(0, 1, At, B1); PG8_BAR; PG8_SCHED;
            PG8_LDA(At, 0, 1); PG8_STAGE(PG8_SB(0, 0), b2, voffB); PG8_STAGE(PG8_SB(0, 1), b2 + hB, voffB); PG8_STAGE(PG8_SA(0, 0), a2, voffA);
            PG8_WAIT_V(8); PG8_WAIT_L(0); PG8_BAR; PG8_MMA(1, 0, At, B0); PG8_MMA(1, 1, At, B1); PG8_BAR; PG8_SCHED;
            PG8_LDB(B0, 1, 0); PG8_LDB(B1, 1, 1); PG8_SCHED; PG8_LDA(At, 1, 0); PG8_STAGE(PG8_SA(0, 1), a2 + hA, voffA);
            PG8_WAIT_V(8); PG8_WAIT_L(0); PG8_BAR; PG8_MMA(0, 0, At, B0); PG8_MMA(0, 1, At, B1); PG8_BAR; PG8_SCHED;
            PG8_LDA(At, 1, 1); PG8_STAGE(PG8_SB(1, 0), b3, voffB); PG8_STAGE(PG8_SB(1, 1), b3 + hB, voffB); PG8_STAGE(PG8_SA(1, 0), a3, voffA);
            PG8_WAIT_V(8); PG8_WAIT_L(0); PG8_BAR; PG8_MMA(1, 0, At, B0); PG8_MMA(1, 1, At, B1); PG8_BAR; PG8_SCHED;
        }
        if constexpr (ALIGN_EPI) { if (wr == 0) PG8_BAR; }
        E(acc, cur, wr, wc, fr, fq);
        if (!has_next) break;
#pragma unroll
        for (int a = 0; a < 2; ++a)
#pragma unroll
            for (int b = 0; b < 2; ++b)
#pragma unroll
                for (int m = 0; m < 4; ++m)
#pragma unroll
                    for (int n = 0; n < 2; ++n) acc[a][b][m][n] = (f32x4){0.f, 0.f, 0.f, 0.f};
        cur = nxt; cA = nA; cB = nB; ++ui;
        if constexpr (ALIGN_EPI) { if (wr == 1) PG8_BAR; }
    }
    PG8_WAIT_V(0);
    if constexpr (!ALIGN_EPI) { if (wr == 0) PG8_BAR; }
    PG8_BAR;
#undef PG8_SA
#undef PG8_SB
#undef PG8_STAGE
#undef PG8_LDA
#undef PG8_LDB
#undef PG8_MMA
#undef PG8_WAIT_V
#undef PG8_WAIT_L
#undef PG8_BAR
#undef PG8_SCHED
}
}

typedef f32x4 Acc[2][2][4][2];
__device__ __forceinline__ u32x4 pack8(f32x4 a, f32x4 b) { u32x4 w; w.x = cvtpk(a[0], a[1]); w.y = cvtpk(a[2], a[3]); w.z = cvtpk(b[0], b[1]); w.w = cvtpk(b[2], b[3]); return w; }
__device__ __forceinline__ void unpack8(u32x4 w, f32x4& a, f32x4& b) { a = (f32x4){bflo(w.x), bfhi(w.x), bflo(w.y), bfhi(w.y)}; b = (f32x4){bflo(w.z), bfhi(w.z), bflo(w.w), bfhi(w.w)}; }

struct EpiInProj {
    unsigned char* ws; bf16_t* gm; const float* bmerge;
    __device__ __forceinline__ void operator()(const Acc& acc, const pg8::Unit& u, int wr, int wc, int fr, int fq) const {
        const int pn = u.pn;
        bf16_t* dst; int ldc, cb, mode;
        if (pn < 4)       { dst = (bf16_t*)(ws + WS_U);   ldc = 1024; cb = pn * 256;        mode = 0; }
        else if (pn < 8)  { dst = (bf16_t*)(ws + WS_GP);  ldc = 1024; cb = (pn - 4) * 256;  mode = 1; }
        else if (pn < 16) { dst = (bf16_t*)(ws + WS_Q);   ldc = 2048; cb = (pn - 8) * 256;  mode = 3; }
        else if (pn < 28) { const int k = (pn - 16) >> 1; dst = (bf16_t*)(ws + WS_KCR + (size_t)k * (8 * MiB)); ldc = 512; cb = ((pn - 16) & 1) * 256; mode = (k == 2 || k == 4) ? 3 : 0; }
        else if (pn < 36) { dst = (bf16_t*)(ws + WS_GN);  ldc = 2048; cb = (pn - 28) * 256; mode = 1; }
        else if (pn < 52) { dst = gm;                     ldc = 4096; cb = (pn - 36) * 256; mode = 2; }
        else              { dst = (bf16_t*)(ws + WS_GBR); ldc = 256;  cb = 0;               mode = 4; }
        const int row0 = u.pm * 256 + wr * 64 + fr, cl = wc * 32 + 8 * fq, col0 = cb + cl;
        const float* rcos = (const float*)(ws + WS_ROPE); const float* rsin = rcos + (size_t)S * 64;
        f32x4 bv[2][2];
#pragma unroll
        for (int bj = 0; bj < 2; ++bj)
#pragma unroll
            for (int n = 0; n < 2; ++n) bv[bj][n] = (mode == 2) ? *(const f32x4*)(bmerge + col0 + bj * 128 + 4 * n) : (f32x4){0.f, 0.f, 0.f, 0.f};
#pragma unroll
        for (int ai = 0; ai < 2; ++ai)
#pragma unroll
            for (int m = 0; m < 4; ++m) {
                const int row = row0 + ai * 128 + m * 16;
                bf16_t* rowp = dst + (size_t)row * ldc + col0;
                f32x4 cs0, cs1, sn0, sn1;
                if (mode == 3) { const int i0 = (cl & 127) >> 1; cs0 = *(const f32x4*)(rcos + (size_t)row * 64 + i0); sn0 = *(const f32x4*)(rsin + (size_t)row * 64 + i0); }
#pragma unroll
                for (int bj = 0; bj < 2; ++bj) {
                    f32x4 v0 = acc[ai][bj][m][0], v1 = acc[ai][bj][m][1];
                    if (mode == 1) { for (int e = 0; e < 4; ++e) { v0[e] = siluf_(v0[e]); v1[e] = siluf_(v1[e]); } }
                    else if (mode == 2 || mode == 4) { v0 = v0 + bv[bj][0]; v1 = v1 + bv[bj][1]; for (int e = 0; e < 4; ++e) { v0[e] = sigmoidf_(v0[e]); v1[e] = sigmoidf_(v1[e]); } }
                    else if (mode == 3) {
                        f32x4 o0, o1;
                        o0[0] = v0[0] * cs0[0] - v0[1] * sn0[0]; o0[1] = v0[1] * cs0[0] + v0[0] * sn0[0];
                        o0[2] = v0[2] * cs0[1] - v0[3] * sn0[1]; o0[3] = v0[3] * cs0[1] + v0[2] * sn0[1];
                        o1[0] = v1[0] * cs0[2] - v1[1] * sn0[2]; o1[1] = v1[1] * cs0[2] + v1[0] * sn0[2];
                        o1[2] = v1[2] * cs0[3] - v1[3] * sn0[3]; o1[3] = v1[3] * cs0[3] + v1[2] * sn0[3];
                        v0 = o0; v1 = o1;
                    }
                    *(u32x4*)(rowp + bj * 128) = pack8(v0, v1);
                }
            }
    }
};
struct EpiMix {
    bf16_t* ypool; const bf16_t* gp; const float* scale;
    __device__ __forceinline__ void operator()(const Acc& acc, const pg8::Unit& u, int wr, int wc, int fr, int fq) const {
        const int row0 = u.pm * 256 + wr * 64 + fr, col0 = u.pn * 256 + wc * 32 + 8 * fq;
#pragma unroll
        for (int ai = 0; ai < 2; ++ai)
#pragma unroll
            for (int m = 0; m < 4; ++m) { const size_t ro = (size_t)(row0 + ai * 128 + m * 16) * 1024 + col0;
#pragma unroll
                for (int bj = 0; bj < 2; ++bj) { f32x4 g0, g1; unpack8(*(const u32x4*)(gp + ro + bj * 128), g0, g1);
                    const f32x4 s0 = *(const f32x4*)(scale + col0 + bj * 128), s1 = *(const f32x4*)(scale + col0 + bj * 128 + 4);
                    *(u32x4*)(ypool + ro + bj * 128) = pack8(acc[ai][bj][m][0] * s0 * g0, acc[ai][bj][m][1] * s1 * g1); } }
    }
};
struct EpiYa {
    bf16_t* yag; const bf16_t* gm;
    __device__ __forceinline__ void operator()(const Acc& acc, const pg8::Unit& u, int wr, int wc, int fr, int fq) const {
        const int row0 = u.pm * 256 + wr * 64 + fr, col0 = u.pn * 256 + wc * 32 + 8 * fq;
#pragma unroll
        for (int ai = 0; ai < 2; ++ai)
#pragma unroll
            for (int m = 0; m < 4; ++m) { const size_t r = (size_t)(row0 + ai * 128 + m * 16);
#pragma unroll
                for (int bj = 0; bj < 2; ++bj) { f32x4 g0, g1; unpack8(*(const u32x4*)(gm + r * 4096 + col0 + bj * 128), g0, g1);
                    *(u32x4*)(yag + r * 2048 + col0 + bj * 128) = pack8(acc[ai][bj][m][0] * g0, acc[ai][bj][m][1] * g1); } }
    }
};
struct EpiYb {
    bf16_t* merged; const bf16_t* yag; const bf16_t* gm;
    __device__ __forceinline__ void operator()(const Acc& acc, const pg8::Unit& u, int wr, int wc, int fr, int fq) const {
        const int row0 = u.pm * 256 + wr * 64 + fr, col0 = u.pn * 256 + wc * 32 + 8 * fq;
#pragma unroll
        for (int ai = 0; ai < 2; ++ai)
#pragma unroll
            for (int m = 0; m < 4; ++m) { const size_t r = (size_t)(row0 + ai * 128 + m * 16);
#pragma unroll
                for (int bj = 0; bj < 2; ++bj) { f32x4 g0, g1, y0, y1; unpack8(*(const u32x4*)(gm + r * 4096 + 2048 + col0 + bj * 128), g0, g1);
                    unpack8(*(const u32x4*)(yag + r * 2048 + col0 + bj * 128), y0, y1);
                    *(u32x4*)(merged + r * 2048 + col0 + bj * 128) = pack8(y0 + acc[ai][bj][m][0] * g0, y1 + acc[ai][bj][m][1] * g1); } }
    }
};
struct EpiOut {
    float* out; const float* x; float* ssq;
    __device__ __forceinline__ void operator()(const Acc& acc, const pg8::Unit& u, int wr, int wc, int fr, int fq) const {
        const int row0 = u.pm * 256 + wr * 64 + fr, col0 = u.pn * 256 + wc * 32 + 8 * fq;
#pragma unroll
        for (int ai = 0; ai < 2; ++ai)
#pragma unroll
            for (int m = 0; m < 4; ++m) { const size_t r = (size_t)(row0 + ai * 128 + m * 16); float q = 0.f;
#pragma unroll
                for (int bj = 0; bj < 2; ++bj)
#pragma unroll
                    for (int n = 0; n < 2; ++n) { const size_t o = r * 2048 + col0 + bj * 128 + 4 * n; const f32x4 v = *(const f32x4*)(x + o) + acc[ai][bj][m][n];
                        *(f32x4*)(out + o) = v; q += (v[0] * v[0] + v[1] * v[1]) + (v[2] * v[2] + v[3] * v[3]); }
                q += __shfl_xor(q, 16); q += __shfl_xor(q, 32);
                if (fq == 0) ssq[(size_t)(u.pn * 4 + wc) * S + r] = q; }
    }
};

struct Args { const float* in[17]; float* out; unsigned char* ws; int ph_lo, ph_hi; };
struct Frame { LAS unsigned char* lds; int tid, lane, wave, vcu, G; };

__device__ __forceinline__ int ropeperm(int d) { return d < 64 ? 2 * d : 2 * (d - 64) + 1; }
__device__ __forceinline__ void transpose_item(const float* W, int ldw, int Nvalid, bf16_t* WT, int ldt, int row_off, bool perm, LAS float* scr, int kb, int nb, int lane) {
    const int k0 = 64 * kb, n0 = 32 * nb, nn = n0 + (lane & 31); const bool ok = nn < Nvalid;
#pragma unroll 8
    for (int i = 0; i < 32; ++i) { const int kk = 2 * i + (lane >> 5); scr[kk * 33 + (lane & 31)] = ok ? W[(size_t)(k0 + kk) * ldw + nn] : 0.f; }
    LDS_WAIT(); asm volatile("" ::: "memory");
    const int c = lane & 7;
#pragma unroll
    for (int j = 0; j < 4; ++j) { const int n = (lane >> 3) + 8 * j; const LAS float* s = scr + (8 * c) * 33 + n;
        u32x4 o; o.x = cvtpk(s[0 * 33], s[1 * 33]); o.y = cvtpk(s[2 * 33], s[3 * 33]); o.z = cvtpk(s[4 * 33], s[5 * 33]); o.w = cvtpk(s[6 * 33], s[7 * 33]);
        const int ng = n0 + n;
        if (ng < Nvalid) { const int dr = perm ? ((ng & ~127) | ropeperm(ng & 127)) : ng; *(GAS u32x4*)(WT + (size_t)(row_off + dr) * ldt + k0 + 8 * c) = o; } }
    LDS_WAIT(); asm volatile("" ::: "memory");
}

__device__ __forceinline__ void p0_prologue(const Frame& F, const Args& a) {
    unsigned char* ws = a.ws;
    LAS float* scr = (LAS float*)(F.lds + F.wave * 16384);
    const int gw = F.vcu * NWAVES + F.wave, NGW = F.G * NWAVES, lane = F.lane;
    constexpr int I_WIN = 32 * 290, I_WM = 32 * 128, I_NO = 32 * 64, I_O = 32 * 64, I_PO = 16 * 64, I_MIX = 4 * 32, I_W1 = 64 * 8, I_W2 = 4 * 4;
    constexpr int NITEMS = I_WIN + I_WM + I_NO + I_O + I_PO + I_MIX + 2 * I_W1 + 2 * I_W2;
    for (int it = gw; it < NITEMS; it += NGW) {
        int r = it;
        if (r < I_WIN) { const int kb = r / 290, nb = r % 290, n0 = nb * 32;
            const bool perm = (n0 >= 2048 && n0 < 4096) || (n0 >= 5120 && n0 < 5632) || (n0 >= 6144 && n0 < 6656);
            transpose_item(a.in[2], 9264, 9264, (bf16_t*)(ws + WS_WCAT), 2048, nb >= 288 ? 4096 : 0, perm, scr, kb, nb, lane); continue; } r -= I_WIN;
        if (r < I_WM) { transpose_item(a.in[13], 4096, 4096, (bf16_t*)(ws + WS_WCAT), 2048, 9216, false, scr, r / 128, r % 128, lane); continue; } r -= I_WM;
        if (r < I_NO) { transpose_item(a.in[12], 2048, 2048, (bf16_t*)(ws + WS_WNOT), 2048, 0, false, scr, r / 64, r % 64, lane); continue; } r -= I_NO;
        if (r < I_O)  { transpose_item(a.in[15], 2048, 2048, (bf16_t*)(ws + WS_WOT), 2048, 0, false, scr, r / 64, r % 64, lane); continue; } r -= I_O;
        if (r < I_PO) { transpose_item(a.in[11], 2048, 2048, (bf16_t*)(ws + WS_WPOT), 1024, 0, false, scr, r / 64, r % 64, lane); continue; } r -= I_PO;
        if (r < I_MIX) { const int g = r / 32, q = r % 32; transpose_item(a.in[3] + (size_t)g * 65536, 256, 256, (bf16_t*)(ws + WS_MIXT) + (size_t)g * 65536, 256, 0, false, scr, q / 8, q % 8, lane); continue; } r -= I_MIX;
        if (r < I_W1) { transpose_item(a.in[6], 256, 256, (bf16_t*)(ws + WS_W1KT), 4096, 0, false, scr, r / 8, r % 8, lane); continue; } r -= I_W1;
        if (r < I_W1) { transpose_item(a.in[9], 256, 256, (bf16_t*)(ws + WS_W1VT), 4096, 0, false, scr, r / 8, r % 8, lane); continue; } r -= I_W1;
        if (r < I_W2) { transpose_item(a.in[7], 128, 128, (bf16_t*)(ws + WS_W2KT), 256, 0, true, scr, r / 4, r % 4, lane); continue; } r -= I_W2;
        transpose_item(a.in[10], 128, 128, (bf16_t*)(ws + WS_W2VT), 256, 0, false, scr, r / 4, r % 4, lane);
    }
    for (int i = gw * 64 + lane; i < 53248; i += NGW * 64) *(GAS u32x4*)(ws + WS_WCAT + (size_t)13360 * 4096 + (size_t)i * 16) = (u32x4){0u, 0u, 0u, 0u};
    {
        const float* x = a.in[0]; const float* nw = a.in[1]; bf16_t* H = (bf16_t*)(ws + WS_H);
        f32x4 wv[8];
#pragma unroll
        for (int j = 0; j < 8; ++j) wv[j] = *((const f32x4*)nw + lane + 64 * j);
        for (int m = gw; m < S; m += NGW) {
            const f32x4* xr = (const f32x4*)(x + (size_t)m * DM) + lane; f32x4 v[8]; float s = 0.f;
#pragma unroll
            for (int j = 0; j < 8; ++j) { v[j] = xr[64 * j]; s += (v[j][0] * v[j][0] + v[j][1] * v[j][1]) + (v[j][2] * v[j][2] + v[j][3] * v[j][3]); }
            const float rstd = 1.0f / sqrtf(wave_sum(s) * (1.f / DM) + EPS);
            u32x2* o = (u32x2*)(H + (size_t)m * DM) + lane;
#pragma unroll
            for (int j = 0; j < 8; ++j) { const f32x4 y = v[j] * rstd * wv[j]; u32x2 w; w.x = cvtpk(y[0], y[1]); w.y = cvtpk(y[2], y[3]); o[64 * j] = w; }
        }
    }
    {
        float* rcos = (float*)(ws + WS_ROPE); float* rsin = rcos + (size_t)S * 64;
        for (int e = gw * 64 + lane; e < S * 64; e += NGW * 64) {
            const int pos = e >> 6, i = e & 63;
            double inv = 1.0, b = 0.86596432336006535;
            for (int k = i; k; k >>= 1) { if (k & 1) inv *= b; b *= b; }
            const double t = (double)pos * inv * 0.15915494309189535;
            const float fr = (float)(t - floor(t));
            rcos[e] = __builtin_amdgcn_cosf(fr); rsin[e] = __builtin_amdgcn_sinf(fr);
        }
    }
    for (int it = gw; it < 128; it += NGW) {
        const int which = it >> 6, fb = (it >> 4) & 3, ch = it & 15, f = fb * 64 + lane;
        const float* pe = a.in[which ? 8 : 5]; const float* w1 = a.in[which ? 9 : 6]; float s = 0.f;
        for (int k = ch * 256; k < ch * 256 + 256; ++k) s += pe[k] * w1[(size_t)k * 256 + f];
        ((float*)(ws + WS_B1P))[(which * 16 + ch) * 256 + f] = s;
    }
}

__device__ __forceinline__ void p2_pooled(const Frame& F, unsigned char* ws) {
    const bf16_t* U = (const bf16_t*)(ws + WS_U); bf16_t* P = (bf16_t*)(ws + WS_H);
    const int gt = F.vcu * 512 + F.tid, NGT = F.G * 512;
    for (int it = gt; it < S * 128; it += NGT) {
        const int t = it >> 7, c8 = it & 127, c = c8 * 8, w = 2 << (c >> 8), cnt = (t + 1 < w) ? t + 1 : w;
        float s[8] = {0.f, 0.f, 0.f, 0.f, 0.f, 0.f, 0.f, 0.f}; f32x4 a0, a1;
        for (int i = 0; i < cnt; ++i) { unpack8(*(const u32x4*)(U + (size_t)(t - i) * 1024 + c), a0, a1);
            s[0] += a0[0]; s[1] += a0[1]; s[2] += a0[2]; s[3] += a0[3]; s[4] += a1[0]; s[5] += a1[1]; s[6] += a1[2]; s[7] += a1[3]; }
        unpack8(*(const u32x4*)(U + (size_t)t * 1024 + c), a0, a1);
        const float ic = 1.0f / (float)cnt;
        const f32x4 o0 = {s[0] * ic - a0[0], s[1] * ic - a0[1], s[2] * ic - a0[2], s[3] * ic - a0[3]}, o1 = {s[4] * ic - a1[0], s[5] * ic - a1[1], s[6] * ic - a1[2], s[7] * ic - a1[3]};
        *(u32x4*)(P + (size_t)t * 1024 + c) = pack8(o0, o1);
    }
}
__device__ __forceinline__ void p8_norm(const Frame& F, const Args& a) {
    const float* ssq = (const float*)(a.ws + WS_SSQ); const float* fw = a.in[16]; float* out = a.out;
    const int gw = F.vcu * NWAVES + F.wave, NGW = F.G * NWAVES, lane = F.lane;
    f32x4 wv[8];
#pragma unroll
    for (int j = 0; j < 8; ++j) wv[j] = *((const f32x4*)fw + lane + 64 * j);
    for (int m = gw; m < S; m += NGW) {
        float q = (lane < 32) ? ssq[(size_t)lane * S + m] : 0.f;
        q = wave_sum(q);
        const float rstd = 1.0f / sqrtf(q * (1.f / DM) + EPS);
        f32x4* o = (f32x4*)(out + (size_t)m * DM) + lane;
#pragma unroll
        for (int j = 0; j < 8; ++j) o[64 * j] = o[64 * j] * rstd * wv[j];
    }
}


__device__ __forceinline__ int crow(int r, int hi) { return (r & 3) + 8 * (r >> 2) + 4 * hi; }
__device__ __forceinline__ void p2_compress1(const Frame& F, unsigned char* ws) {
    const int gw = F.vcu * NWAVES + F.wave, NGW = F.G * NWAVES, lane = F.lane, r = lane & 31, hh = lane >> 5;
    for (int it = gw; it < 2048; it += NGW) {
        const int which = it >> 10, rem = it & 1023, ks = rem & 7, ft = (rem >> 3) & 3, nt = (rem >> 5) & 7, h = rem >> 8;
        const bf16_t* X = (const bf16_t*)(ws + (which ? WS_VCR : WS_KCR)); const bf16_t* W1 = (const bf16_t*)(ws + (which ? WS_W1VT : WS_W1KT));
        const int n0 = nt * 64, f0 = ft * 64;
        f32x16 acc[2][2];
#pragma unroll
        for (int a = 0; a < 2; ++a)
#pragma unroll
            for (int b = 0; b < 2; ++b) acc[a][b] = f32x16{};
        for (int l = ks * 4; l < ks * 4 + 4; ++l) {
            int t0 = 16 * (n0 + r) + l, t1 = t0 + 512; t0 = t0 > S - 1 ? S - 1 : t0; t1 = t1 > S - 1 ? S - 1 : t1;
            const bf16_t* xa0 = X + (size_t)t0 * 512 + h * 128 + hh * 8; const bf16_t* xa1 = X + (size_t)t1 * 512 + h * 128 + hh * 8;
            const bf16_t* wb0 = W1 + (size_t)(f0 + r) * 4096 + l * 128 + hh * 8; const bf16_t* wb1 = wb0 + (size_t)32 * 4096;
#pragma unroll
            for (int d0 = 0; d0 < 8; ++d0) {
                const bf16x8 a0 = *(const bf16x8*)(xa0 + d0 * 16), a1 = *(const bf16x8*)(xa1 + d0 * 16), b0 = *(const bf16x8*)(wb0 + d0 * 16), b1 = *(const bf16x8*)(wb1 + d0 * 16);
                acc[0][0] = __builtin_amdgcn_mfma_f32_32x32x16_bf16(a0, b0, acc[0][0], 0, 0, 0); acc[0][1] = __builtin_amdgcn_mfma_f32_32x32x16_bf16(a0, b1, acc[0][1], 0, 0, 0);
                acc[1][0] = __builtin_amdgcn_mfma_f32_32x32x16_bf16(a1, b0, acc[1][0], 0, 0, 0); acc[1][1] = __builtin_amdgcn_mfma_f32_32x32x16_bf16(a1, b1, acc[1][1], 0, 0, 0);
            }
        }
        float* slab = (float*)(ws + WS_SLAB) + ((size_t)(which * 8 + ks) * 2048 + h * 512 + n0) * 256 + f0;
#pragma unroll
        for (int mi = 0; mi < 2; ++mi)
#pragma unroll
            for (int ni = 0; ni < 2; ++ni)
#pragma unroll
                for (int e = 0; e < 16; ++e) slab[(size_t)(mi * 32 + crow(e, hh)) * 256 + ni * 32 + r] = acc[mi][ni][e];
    }
}
__device__ __forceinline__ void p3_compress2(const Frame& F, unsigned char* ws, int cw, int NCW) {
    const int lane = F.lane, r = lane & 31, hh = lane >> 5;
    const float* rcos = (const float*)(ws + WS_ROPE); const float* rsin = rcos + (size_t)S * 64;
    for (int it = cw; it < 512; it += NCW) {
        const int which = it >> 8, rt = (it >> 2) & 63, ct = it & 3, row = rt * 32 + r;
        const bf16_t* W2 = (const bf16_t*)(ws + (which ? WS_W2VT : WS_W2KT)) + (size_t)(ct * 32 + r) * 256 + hh * 8;
        const float* sl = (const float*)(ws + WS_SLAB) + ((size_t)(which * 8) * 2048 + row) * 256 + hh * 8; const float* b1 = (const float*)(ws + WS_B1) + which * 256 + hh * 8;
        f32x16 acc = f32x16{};
        for (int k = 0; k < 16; ++k) {
            f32x4 s0 = *(const f32x4*)(b1 + k * 16), s1 = *(const f32x4*)(b1 + k * 16 + 4);
#pragma unroll
            for (int ks = 0; ks < 8; ++ks) { s0 = s0 + *(const f32x4*)(sl + (size_t)ks * 2048 * 256 + k * 16); s1 = s1 + *(const f32x4*)(sl + (size_t)ks * 2048 * 256 + k * 16 + 4); }
#pragma unroll
            for (int e = 0; e < 4; ++e) { s0[e] = siluf_(s0[e]); s1[e] = siluf_(s1[e]); }
            const u32x4 hb = pack8(s0, s1);
            acc = __builtin_amdgcn_mfma_f32_32x32x16_bf16(*(const bf16x8*)(W2 + k * 16), __builtin_bit_cast(bf16x8, hb), acc, 0, 0, 0);
        }
        const int n = row & 511; bf16_t* dst = (bf16_t*)(ws + (which ? WS_VC : WS_KC)) + (size_t)row * 128 + ct * 32 + 4 * hh;
        const int pos = (16 * n + 31) > S - 1 ? S - 1 : 16 * n + 31;
#pragma unroll
        for (int gq = 0; gq < 4; ++gq) {
            float v0 = acc[4 * gq], v1 = acc[4 * gq + 1], v2 = acc[4 * gq + 2], v3 = acc[4 * gq + 3];
            if (which == 0) { const int i = (ct * 32 + 8 * gq + 4 * hh) >> 1; const float c0 = rcos[(size_t)pos * 64 + i], s0 = rsin[(size_t)pos * 64 + i], c1 = rcos[(size_t)pos * 64 + i + 1], s1 = rsin[(size_t)pos * 64 + i + 1];
                const float o0 = v0 * c0 - v1 * s0, o1 = v1 * c0 + v0 * s0, o2 = v2 * c1 - v3 * s1, o3 = v3 * c1 + v2 * s1; v0 = o0; v1 = o1; v2 = o2; v3 = o3; }
            u32x2 w; w.x = cvtpk(v0, v1); w.y = cvtpk(v2, v3); if (n == 511) { w.x = 0u; w.y = 0u; }
            *(u32x2*)(dst + 8 * gq) = w;
        }
    }
}

namespace nsa {
constexpr int SHM_V = 16384, SHM_K = 16384;
constexpr int L_V = 0, L_K = 2 * SHM_V, L_WS = L_K + 2 * SHM_K, L_IMP = L_WS + NWAVES * 64 * 4, IMP_LD = 129, L_SELM = L_IMP + 64 * IMP_LD * 4, L_END = L_SELM + 64 * 8 * 2;
static_assert(L_END <= RING_BYTES, "attention LDS");
constexpr float SCALE = 0.08838834764831845f, C2 = 1.4426950408889634f * SCALE, THR = 8.f;
#define KSWZ(row, colB) ((row) * 256 + ((colB) ^ (((row) & 7) << 4)))
#define SBAR() __builtin_amdgcn_sched_barrier(0)
#define LADD(p, v) (void)__hip_atomic_fetch_add((p), (v), __ATOMIC_RELAXED, __HIP_MEMORY_SCOPE_WORKGROUP)
__device__ __forceinline__ int v_st(int k, int c) { const int kk = (k & ~0xC) | ((k & 4) << 1) | ((k & 8) >> 1); return ((kk >> 3) * 4 + (c >> 5)) * 512 + ((kk & 7) * 32 + (c & 31)) * 2; }
__device__ __forceinline__ int v_rd_base(int lane) { return ((lane & 3) << 3) | (((lane >> 2) & 3) << 6) | (((lane >> 4) & 1) << 5) | (((lane >> 5) & 1) << 8); }
constexpr int v_rd_off(int d0, int ks, int half) { return d0 * 512 + ks * 4096 + half * 2048; }
__device__ __forceinline__ unsigned cvtpk_a(float lo, float hi) { unsigned r; asm volatile("v_cvt_pk_bf16_f32 %0, %1, %2" : "=v"(r) : "v"(lo), "v"(hi)); return r; }

__device__ __forceinline__ void mask_range(f32x16& p0, f32x16& p1, int dq, unsigned Wn) {
    const float NEG = -__builtin_inff();
#pragma unroll
    for (int r = 0; r < 16; ++r) { const int c = (r & 3) + 8 * (r >> 2);
        if ((unsigned)(dq + c) >= Wn) p0[r] = NEG;
        if ((unsigned)(dq + c + 32) >= Wn) p1[r] = NEG; }
}
__device__ __forceinline__ void mask_row(f32x16& p0, f32x16& p1, bool keep) {
    const float NEG = -__builtin_inff();
#pragma unroll
    for (int r = 0; r < 16; ++r) { p0[r] = keep ? p0[r] : NEG; p1[r] = keep ? p1[r] : NEG; }
}
__device__ __forceinline__ float rowmax32(const f32x16& p0, const f32x16& p1) {
    float pmax = p0[0];
#pragma unroll
    for (int r = 1; r < 16; ++r) pmax = fmaxf(pmax, p0[r]);
#pragma unroll
    for (int r = 0; r < 16; ++r) pmax = fmaxf(pmax, p1[r]);
    auto rr = __builtin_amdgcn_permlane32_swap(__float_as_uint(pmax), __float_as_uint(pmax), false, false);
    return fmaxf(__uint_as_float(rr[0]), __uint_as_float(rr[1]));
}
__device__ __forceinline__ float rowsum32(const f32x16& p0, const f32x16& p1) {
    float ps = 0.f;
#pragma unroll
    for (int r = 0; r < 16; ++r) ps += p0[r];
#pragma unroll
    for (int r = 0; r < 16; ++r) ps += p1[r];
    auto rr = __builtin_amdgcn_permlane32_swap(__float_as_uint(ps), __float_as_uint(ps), false, false);
    return __uint_as_float(rr[0]) + __uint_as_float(rr[1]);
}
__device__ __forceinline__ void pack_p(const f32x16& p0, const f32x16& p1, bf16x8& pa0, bf16x8& pa1, bf16x8& pa2, bf16x8& pa3) {
#define PK4(P, B_, OUT) do { unsigned a0 = cvtpk_a(P[B_+0], P[B_+1]), a1 = cvtpk_a(P[B_+2], P[B_+3]);                          \
        unsigned b0 = cvtpk_a(P[B_+4], P[B_+5]), b1 = cvtpk_a(P[B_+6], P[B_+7]);                                             \
        auto r0 = __builtin_amdgcn_permlane32_swap(a0, b0, false, false); auto r1 = __builtin_amdgcn_permlane32_swap(a1, b1, false, false); \
        u32x4 w = {r0[0], r1[0], r0[1], r1[1]}; OUT = __builtin_bit_cast(bf16x8, w); } while (0)
    PK4(p0, 0, pa0); PK4(p0, 8, pa1); PK4(p1, 0, pa2); PK4(p1, 8, pa3);
#undef PK4
}
template <int KB>
__device__ __forceinline__ void qkt(f32x16& p0, f32x16& p1, const LAS unsigned char* K_lds, int r32, int hi, const bf16x8* qr) {
    p0 = f32x16{}; p1 = f32x16{};
    const LAS unsigned char* kb[4];
#pragma unroll
    for (int dd = 0; dd < 4; ++dd) kb[dd] = K_lds + KB * SHM_K + KSWZ(r32, (dd * 16 + hi * 8) * 2);
#pragma unroll
    for (int d0 = 0; d0 < 8; ++d0) { const LAS unsigned char* a = kb[d0 & 3] + (d0 >> 2) * 128;
        const bf16x8 b0 = *(const LAS bf16x8*)(a);
        const bf16x8 b1 = *(const LAS bf16x8*)(a + 32 * 256);
        p0 = __builtin_amdgcn_mfma_f32_32x32x16_bf16(b0, qr[d0], p0, 0, 0, 0);
        p1 = __builtin_amdgcn_mfma_f32_32x32x16_bf16(b1, qr[d0], p1, 0, 0, 0); }
}
template <int VB>
__device__ __forceinline__ void pv_tile(f32x16* o, int vb0, bf16x8 pa0, bf16x8 pa1, bf16x8 pa2, bf16x8 pa3) {
#define TRRD(dst, off) asm volatile("ds_read_b64_tr_b16 %0, %1 offset:%2" : "=&v"(dst) : "v"(vb0), "i"(off) : "memory")
#define PV_D0(d0) do { s16x4 l0, l1, l2, l3, h0, h1, h2, h3; constexpr int b_ = VB * SHM_V + v_rd_off(d0, 0, 0); \
        TRRD(l0, b_); TRRD(h0, b_ + 2048); TRRD(l1, b_ + 4096); TRRD(h1, b_ + 6144); TRRD(l2, b_ + 8192); TRRD(h2, b_ + 10240); TRRD(l3, b_ + 12288); TRRD(h3, b_ + 14336); \
        asm volatile("s_waitcnt lgkmcnt(0)" ::: "memory"); SBAR();   \
        o[d0] = __builtin_amdgcn_mfma_f32_32x32x16_bf16(pa0, (bf16x8){l0[0], l0[1], l0[2], l0[3], h0[0], h0[1], h0[2], h0[3]}, o[d0], 0, 0, 0);   \
        o[d0] = __builtin_amdgcn_mfma_f32_32x32x16_bf16(pa1, (bf16x8){l1[0], l1[1], l1[2], l1[3], h1[0], h1[1], h1[2], h1[3]}, o[d0], 0, 0, 0);   \
        o[d0] = __builtin_amdgcn_mfma_f32_32x32x16_bf16(pa2, (bf16x8){l2[0], l2[1], l2[2], l2[3], h2[0], h2[1], h2[2], h2[3]}, o[d0], 0, 0, 0);   \
        o[d0] = __builtin_amdgcn_mfma_f32_32x32x16_bf16(pa3, (bf16x8){l3[0], l3[1], l3[2], l3[3], h3[0], h3[1], h3[2], h3[3]}, o[d0], 0, 0, 0); } while (0)
    PV_D0(0); PV_D0(1); PV_D0(2); PV_D0(3);
#undef PV_D0
#undef TRRD
}

enum { M_C1 = 0, M_C2 = 1, M_S = 2, M_W = 3 };
struct RowState { float m, l; };
template <int MODE>
__device__ __forceinline__ void attn_pass(LAS unsigned char* lds, const bf16_t* Kp, const bf16_t* Vp, int ld, int j_lo, int j_hi, const bf16x8* qr, int t, int Tq, const u32x4 sel,
                                          RowState& st, float invl, f32x16* o, bool do_imp) {
    constexpr bool HASV = MODE != M_C1;
    const int tid = otid(), wid = __builtin_amdgcn_readfirstlane(tid >> 6), lane = tid & 63, r32 = lane & 31, hi = lane >> 5;
    LAS unsigned char* V_lds = lds + L_V; LAS unsigned char* K_lds = lds + L_K;
    LAS float* wsf = (LAS float*)(lds + L_WS) + wid * 64; LAS float* al_l = wsf + 32;
    const int sr = tid >> 4, sc = (tid & 15) * 8, vst0 = v_st(sr, sc), vst1 = v_st(32 + sr, sc), kws = KSWZ(sr, sc * 2);
    const int vb0 = (int)(uintptr_t)V_lds + v_rd_base(lane);
    const int NT = j_hi - j_lo;
    bf16x8 st_k0, st_k1, st_v0, st_v1;
    float m_reg = st.m, l_reg = st.l;
#define SLOAD(j) do { const size_t k0_ = (size_t)(j) * 64; st_k0 = *(const bf16x8*)(Kp + (k0_ + sr) * ld + sc); st_k1 = *(const bf16x8*)(Kp + (k0_ + 32 + sr) * ld + sc); \
        if (HASV) { st_v0 = *(const bf16x8*)(Vp + (k0_ + sr) * ld + sc); st_v1 = *(const bf16x8*)(Vp + (k0_ + 32 + sr) * ld + sc); } } while (0)
#define SWRITE(bf) do { *(LAS bf16x8*)(K_lds + (bf) * SHM_K + kws) = st_k0; *(LAS bf16x8*)(K_lds + (bf) * SHM_K + kws + 32 * 256) = st_k1; \
        if (HASV) { *(LAS bf16x8*)(V_lds + (bf) * SHM_V + vst0) = st_v0; *(LAS bf16x8*)(V_lds + (bf) * SHM_V + vst1) = st_v1; } } while (0)
    SLOAD(j_lo); SWRITE(0);
    __syncthreads();
#define STEP(idx, BUF) do { const int j = j_lo + (idx); const int kb = j * 64;                                                          \
        if ((idx) + 1 < NT) SLOAD(j + 1);                                                                                              \
        f32x16 p0, p1; qkt<BUF>(p0, p1, K_lds, r32, hi, qr);                                                                           \
        if (MODE == M_C1 || MODE == M_C2) { const int nmax1 = ((t - 31) >> 4) + 1; mask_range(p0, p1, kb + 4 * hi, (unsigned)(nmax1 > 0 ? nmax1 : 0)); } \
        else if (MODE == M_S) { if (j == Tq) mask_range(p0, p1, kb + 4 * hi, (unsigned)(t + 1));                                        \
                                else { const unsigned w_ = (j >> 5) == 0 ? sel.x : (j >> 5) == 1 ? sel.y : (j >> 5) == 2 ? sel.z : sel.w; mask_row(p0, p1, ((w_ >> (j & 31)) & 1u) != 0u); } } \
        else { if (j == Tq || j + 8 <= Tq) mask_range(p0, p1, kb + 4 * hi - (t - 511), 512u); }                                          \
        if (MODE == M_C1) { const float pmax = rowmax32(p0, p1); const float mn = fmaxf(m_reg, pmax); const float alpha = __builtin_amdgcn_exp2f((m_reg - mn) * C2); m_reg = mn; \
            const float mnL = -mn * C2;                                                                                                \
            _Pragma("unroll") for (int r = 0; r < 16; ++r) { p0[r] = __builtin_amdgcn_exp2f(fmaf(p0[r], C2, mnL)); p1[r] = __builtin_amdgcn_exp2f(fmaf(p1[r], C2, mnL)); } \
            l_reg = l_reg * alpha + rowsum32(p0, p1); }                                                                                \
        else if (MODE == M_C2) { const float mnL = -m_reg * C2;                                                                        \
            _Pragma("unroll") for (int r = 0; r < 16; ++r) { p0[r] = __builtin_amdgcn_exp2f(fmaf(p0[r], C2, mnL)) * invl; p1[r] = __builtin_amdgcn_exp2f(fmaf(p1[r], C2, mnL)) * invl; } \
            if (do_imp) { LAS unsigned* imp = (LAS unsigned*)(lds + L_IMP) + ((wid & 1) * 32 + r32) * IMP_LD + 16 * j + hi;            \
                _Pragma("unroll") for (int k = 0; k < 4; ++k) {                                                                        \
                    { const float e_ = p0[4 * k + 3], a_ = 2.f * (p0[4 * k] + p0[4 * k + 1] + p0[4 * k + 2]) + e_;                     \
                      LADD(imp + 2 * k, (unsigned)(a_ * 67108864.f + 0.5f)); LADD(imp + 2 * k + 1, (unsigned)(e_ * 67108864.f + 0.5f)); } \
                    { const float e_ = p1[4 * k + 3], a_ = 2.f * (p1[4 * k] + p1[4 * k + 1] + p1[4 * k + 2]) + e_;                     \
                      LADD(imp + 8 + 2 * k, (unsigned)(a_ * 67108864.f + 0.5f)); LADD(imp + 8 + 2 * k + 1, (unsigned)(e_ * 67108864.f + 0.5f)); } } } \
            bf16x8 pa0, pa1, pa2, pa3; pack_p(p0, p1, pa0, pa1, pa2, pa3); SBAR(); pv_tile<BUF>(o, vb0, pa0, pa1, pa2, pa3); }          \
        else { const float pmax = rowmax32(p0, p1); float mn, alpha;                                                                   \
            if (__builtin_expect(__all((pmax - m_reg) * SCALE <= THR), 1)) { mn = m_reg; alpha = 1.f; }                                \
            else { mn = fmaxf(m_reg, pmax); alpha = __builtin_amdgcn_exp2f((m_reg - mn) * C2); m_reg = mn; }                           \
            const float mnL = -mn * C2;                                                                                                \
            _Pragma("unroll") for (int r = 0; r < 16; ++r) { p0[r] = __builtin_amdgcn_exp2f(fmaf(p0[r], C2, mnL)); p1[r] = __builtin_amdgcn_exp2f(fmaf(p1[r], C2, mnL)); } \
            l_reg = l_reg * alpha + rowsum32(p0, p1);                                                                                  \
            bf16x8 pa0, pa1, pa2, pa3; pack_p(p0, p1, pa0, pa1, pa2, pa3);                                                             \
            if (__any(alpha < 1.f)) { if (hi == 0) al_l[r32] = alpha; asm volatile("s_waitcnt lgkmcnt(0)" ::: "memory");               \
                _Pragma("unroll") for (int d_ = 0; d_ < 4; ++d_) _Pragma("unroll") for (int r = 0; r < 16; ++r) o[d_][r] *= al_l[crow(r, hi)]; } \
            SBAR(); pv_tile<BUF>(o, vb0, pa0, pa1, pa2, pa3); }                                                                        \
        if ((idx) + 1 < NT) { SWRITE((BUF) ^ 1); }                                                                                     \
        __syncthreads(); } while (0)
    int idx = 0;
    for (; idx + 1 < NT; idx += 2) { STEP(idx, 0); STEP(idx + 1, 1); }
    if (idx < NT) STEP(idx, 0);
    st.m = m_reg; st.l = l_reg;
#undef STEP
#undef SLOAD
#undef SWRITE
}

template <int MODE>
__device__ __forceinline__ void branch_out(LAS unsigned char* lds, const f32x16* o, float rowscale, bf16_t* onsa_w, const bf16_t* gn_w) {
    const int tid = otid(), wid = __builtin_amdgcn_readfirstlane(tid >> 6), lane = tid & 63, r32 = lane & 31, hi = lane >> 5;
    LAS float* li_l = (LAS float*)(lds + L_WS) + wid * 64;
    if (hi == 0) li_l[r32] = rowscale; asm volatile("s_waitcnt lgkmcnt(0)" ::: "memory");
    float rli[16];
#pragma unroll
    for (int r = 0; r < 16; ++r) rli[r] = li_l[crow(r, hi)];
#pragma unroll
    for (int r = 0; r < 16; ++r) { int rr_ = r; asm volatile("" : "+v"(rr_)); const int orow = crow(rr_, hi);
#pragma unroll
        for (int d0 = 0; d0 < 4; ++d0) { const float v = o[d0][r] * rli[r]; const float vn = __shfl_xor(v, 1);
            if ((r32 & 1) == 0) { unsigned* p = (unsigned*)(onsa_w + (size_t)orow * 2048 + d0 * 32 + r32); float a = v, b = vn;
                if (MODE >= 1) { const unsigned w = *p; a += bflo(w); b += bfhi(w); }
                if (MODE == 2) { const unsigned gw_ = *(const unsigned*)(gn_w + (size_t)orow * 2048 + d0 * 32 + r32); a *= bflo(gw_); b *= bfhi(gw_); }
                *p = cvtpk(a, b); } } }
}

__device__ __forceinline__ void attn_unit(LAS unsigned char* lds, unsigned char* ws, int h, int Tq) {
    const int tid = otid(), wid = __builtin_amdgcn_readfirstlane(tid >> 6), lane = tid & 63, r32 = lane & 31, hi = lane >> 5;
    const int g = wid >> 1, tl = (wid & 1) * 32 + r32, t = Tq * 64 + tl, hq = 4 * h + g;
    const bf16_t* Q = (const bf16_t*)(ws + WS_Q); const bf16_t* GBR = (const bf16_t*)(ws + WS_GBR);
    bf16_t* onsa_w = (bf16_t*)(ws + WS_U) + (size_t)(Tq * 64 + (wid & 1) * 32) * 2048 + hq * 128; const bf16_t* gn_w = (const bf16_t*)(ws + WS_GN) + (size_t)(Tq * 64 + (wid & 1) * 32) * 2048 + hq * 128;
    bf16x8 qr[8];
#pragma unroll
    for (int d0 = 0; d0 < 8; ++d0) qr[d0] = *(const bf16x8*)(Q + (size_t)t * 2048 + hq * 128 + d0 * 16 + hi * 8);
    const float g_c = bf2f(GBR[(size_t)t * 256 + hq * 3 + 0]), g_s = bf2f(GBR[(size_t)t * 256 + hq * 3 + 1]), g_w = bf2f(GBR[(size_t)t * 256 + hq * 3 + 2]);
    const bool big = Tq >= 16;
    LAS unsigned* IMP = (LAS unsigned*)(lds + L_IMP);
    if (big) { for (int i = tid; i < 64 * IMP_LD; i += 512) IMP[i] = 0u; }
    const u32x4 nosel = {0u, 0u, 0u, 0u};
    f32x16 o[4];
    {
        const bf16_t* Kc = (const bf16_t*)(ws + WS_KC) + (size_t)h * 512 * 128; const bf16_t* Vc = (const bf16_t*)(ws + WS_VC) + (size_t)h * 512 * 128;
        const int ntc = ((4 * Tq + 2) >> 6) + 1;
        RowState stc{-1e30f, 0.f};
        attn_pass<M_C1>(lds, Kc, Vc, 128, 0, ntc, qr, t, Tq, nosel, stc, 0.f, o, false);
        const float invl = stc.l > 0.f ? 1.0f / stc.l : 0.f;
#pragma unroll
        for (int d = 0; d < 4; ++d) o[d] = f32x16{};
        attn_pass<M_C2>(lds, Kc, Vc, 128, 0, ntc, qr, t, Tq, nosel, stc, invl, o, big);
        branch_out<0>(lds, o, g_c, onsa_w, gn_w);
    }
    {
        LAS unsigned short* SELM = (LAS unsigned short*)(lds + L_SELM);
        int tok = tid >> 3, sub = tid & 7; asm volatile("" : "+v"(tok), "+v"(sub));
        unsigned bits = 0u;
        if (big) {
            unsigned kv[16];
#pragma unroll
            for (int e = 0; e < 16; ++e) { const int j = sub * 16 + e; const unsigned v = IMP[tok * IMP_LD + j]; kv[e] = (j >= 1 && j <= Tq - 2) ? v + 1u : 0u; }
            for (int round = 0; round < 13; ++round) {
                unsigned bv = kv[0]; int bj = 0;
#pragma unroll
                for (int e = 1; e < 16; ++e) { const bool gt = kv[e] > bv; bv = gt ? kv[e] : bv; bj = gt ? e : bj; }
                bj += sub * 16;
#pragma unroll
                for (int sh = 1; sh < 8; sh <<= 1) { const unsigned ov = __shfl_xor(bv, sh); const int oj = __shfl_xor(bj, sh);
                    const bool take = (ov > bv) || (ov == bv && oj < bj); bv = take ? ov : bv; bj = take ? oj : bj; }
                const int we = (bv != 0u && (bj >> 4) == sub) ? (bj & 15) : -1;
#pragma unroll
                for (int e = 0; e < 16; ++e) { const bool hit = (we == e); bits |= hit ? (1u << e) : 0u; kv[e] = hit ? 0u : kv[e]; }
            }
#pragma unroll
            for (int e = 0; e < 16; ++e) { const int j = sub * 16 + e; if (j == 0 || j == Tq - 1 || j == Tq) bits |= 1u << e; }
        } else {
#pragma unroll
            for (int e = 0; e < 16; ++e) { const int j = sub * 16 + e; if (j <= Tq) bits |= 1u << e; }
        }
        SELM[tok * 8 + sub] = (unsigned short)bits;
        __syncthreads();
    }
    const u32x4 sel = *(const LAS u32x4*)(lds + L_SELM + tl * 16);
    {
        RowState sts{-1e30f, 0.f};
#pragma unroll
        for (int d = 0; d < 4; ++d) o[d] = f32x16{};
        attn_pass<M_S>(lds, (const bf16_t*)(ws + WS_KS) + h * 128, (const bf16_t*)(ws + WS_VS) + h * 128, 512, 0, Tq + 1, qr, t, Tq, sel, sts, 0.f, o, false);
        branch_out<1>(lds, o, sts.l > 0.f ? g_s / sts.l : 0.f, onsa_w, gn_w);
    }
    {
        RowState stw{-1e30f, 0.f};
#pragma unroll
        for (int d = 0; d < 4; ++d) o[d] = f32x16{};
        attn_pass<M_W>(lds, (const bf16_t*)(ws + WS_KW) + h * 128, (const bf16_t*)(ws + WS_VW) + h * 128, 512, Tq >= 8 ? Tq - 8 : 0, Tq + 1, qr, t, Tq, sel, stw, 0.f, o, false);
        branch_out<2>(lds, o, stw.l > 0.f ? g_w / stw.l : 0.f, onsa_w, gn_w);
    }
    __syncthreads();
}
#undef KSWZ
#undef SBAR
}

constexpr int NPHASE = 9;
__global__ void __launch_bounds__(NWAVES * 64, 2) mega_fwd(Args args) {
    extern __shared__ __attribute__((aligned(16))) unsigned char lds[];
    Frame F;
    F.lds = (LAS unsigned char*)lds;
    F.tid = threadIdx.x; F.lane = F.tid & 63; F.wave = __builtin_amdgcn_readfirstlane(F.tid >> 6);
    F.G = gridDim.x; { const int bx = blockIdx.x; F.vcu = (F.G % 8 == 0) ? (bx % 8) * (F.G / 8) + bx / 8 : bx; }
    volatile LAS unsigned* MISC = (volatile LAS unsigned*)(F.lds + MISC_OFF);
    unsigned char* ws = args.ws;
    for (int u = F.tid; u < (LDS_BYTES - LDSCTL_OFF) / 4; u += NWAVES * 64) ((LAS unsigned*)(F.lds + LDSCTL_OFF))[u] = 0u;
    __syncthreads();
    XcdBarrier bar; bar.bar = (unsigned*)(ws + WS_CTL) + CW_BAR; bar.x = 0; bar.st = nullptr;
#if !N_LAUNCHES_PER_PHASE
    bar = xcd_barrier_post((unsigned*)(ws + WS_CTL) + CW_BAR, MISC + 8);
#endif
    const int lo = args.ph_lo, hi = args.ph_hi;
#define IN(k) (lo <= (k) && (k) < hi && (F.tid = otid(), F.lane = F.tid & 63, true))
#define SEAM(k) do { if (IN(k) && IN((k) + 1)) xcd_barrier(bar); } while (0)
    bf16_t* const GM = (bf16_t*)args.out;

    if (IN(0)) { p0_prologue(F, args); } SEAM(0);
    if (IN(1)) {
        pg8::Gemm g{(const bf16_t*)(ws + WS_H), (const bf16_t*)(ws + WS_WCAT), 2048, 2048, 2048, 0};
        pg8::StaticOrder So; So.init(S, NCAT, F.G, (int)blockIdx.x);
        EpiInProj E{ws, GM, args.in[14]};
        pg8::gemm_phase<EpiInProj, true>(F.lds, g, So, E);
    } SEAM(1);
    if (IN(2)) {
        p2_compress1(F, ws);
        p2_pooled(F, ws);
        if (blockIdx.x == 0) { const float* b1p = (const float*)(ws + WS_B1P); float* b1 = (float*)(ws + WS_B1); const int t = F.tid; float s = 0.f;
            for (int c = 0; c < 16; ++c) s += b1p[((t >> 8) * 16 + c) * 256 + (t & 255)];
            b1[t] = s; }
    } SEAM(2);
    if (IN(3)) {
        pg8::Gemm g{(const bf16_t*)(ws + WS_H), (const bf16_t*)(ws + WS_MIXT), 1024, 256, 256, 512};
        pg8::StaticOrder So; So.init(S, 1024, F.G, (int)blockIdx.x);
        EpiMix E{(bf16_t*)(ws + WS_H + 16 * MiB), (const bf16_t*)(ws + WS_GP), args.in[4]};
        pg8::gemm_phase<EpiMix, false>(F.lds, g, So, E);
        { const int base = F.G > 128 ? 128 : 0; if ((int)blockIdx.x >= base) p3_compress2(F, ws, ((int)blockIdx.x - base) * NWAVES + F.wave, (F.G - base) * NWAVES); }
    } SEAM(3);
    if (IN(4)) {
        pg8::Gemm g{(const bf16_t*)(ws + WS_H + 16 * MiB), (const bf16_t*)(ws + WS_WPOT), 1024, 1024, 1024, 0};
        pg8::StaticOrder So; So.init(S, 2048, F.G, (int)blockIdx.x);
        EpiYa E{(bf16_t*)(ws + WS_YAG), GM};
        pg8::gemm_phase<EpiYa, false>(F.lds, g, So, E);
    } SEAM(4);
    if (IN(5)) {
        for (int p = F.vcu; p < 256; p += F.G) {
#pragma unroll 1
            for (int i = 0; i < 2; ++i) { const int h = p >> 6, x = p & 63; nsa::attn_unit(F.lds, ws, h, i ? x : 127 - x); } }
    } SEAM(5);
    if (IN(6)) {
        pg8::Gemm g{(const bf16_t*)(ws + WS_U), (const bf16_t*)(ws + WS_WNOT), 2048, 2048, 2048, 0};
        pg8::StaticOrder So; So.init(S, 2048, F.G, (int)blockIdx.x);
        EpiYb E{(bf16_t*)(ws + WS_H), (const bf16_t*)(ws + WS_YAG), GM};
        pg8::gemm_phase<EpiYb, false>(F.lds, g, So, E);
    } SEAM(6);
    if (IN(7)) {
        pg8::Gemm g{(const bf16_t*)(ws + WS_H), (const bf16_t*)(ws + WS_WOT), 2048, 2048, 2048, 0};
        pg8::StaticOrder So; So.init(S, 2048, F.G, (int)blockIdx.x);
        EpiOut E{args.out, args.in[0], (float*)(ws + WS_SSQ)};
        pg8::gemm_phase<EpiOut, false>(F.lds, g, So, E);
    } SEAM(7);
    if (IN(8)) { p8_norm(F, args); }
#undef IN
#undef SEAM
}

extern "C" void kernel_launch(void* const* d_in, const int* in_sizes, int n_in, void* d_out, int out_size, void* d_ws, size_t ws_size, hipStream_t stream) {
    static int grid = 0;
    if (grid == 0) {
        if (n_in != 17 || in_sizes[0] != S * DM || out_size != S * DM || ws_size < WS_END) { fprintf(stderr, "kernel_launch: unexpected shapes (n_in %d, in0 %d, out %d, ws %zu); nothing launched\n", n_in, n_in > 0 ? in_sizes[0] : -1, out_size, ws_size); grid = -1; return; }
        int dev = 0, cus = 0;
        if (hipGetDevice(&dev) != hipSuccess || hipDeviceGetAttribute(&cus, hipDeviceAttributeMultiprocessorCount, dev) != hipSuccess) { fprintf(stderr, "kernel_launch: device query failed\n"); grid = -1; return; }
        if (hipFuncSetAttribute((const void*)mega_fwd, hipFuncAttributeMaxDynamicSharedMemorySize, LDS_BYTES) != hipSuccess) { fprintf(stderr, "kernel_launch: hipFuncSetAttribute failed\n"); grid = -1; return; }
        (void)hipGetLastError();
        grid = cus;
    }
    if (grid < 0) return;
    (void)hipMemsetAsync((char*)d_ws + WS_CTL, 0, CTL_BYTES, stream);
    Args a{};
    for (int i = 0; i < 17; ++i) a.in[i] = (const float*)d_in[i];
    a.out = (float*)d_out; a.ws = (unsigned char*)d_ws;
#if N_LAUNCHES_PER_PHASE
    for (int p = 0; p < NPHASE; ++p) { a.ph_lo = p; a.ph_hi = p + 1; hipLaunchKernelGGL(mega_fwd, dim3(grid), dim3(NWAVES * 64), LDS_BYTES, stream, a); }
#else
    a.ph_lo = 0; a.ph_hi = NPHASE;
    hipLaunchKernelGGL(mega_fwd, dim3(grid), dim3(NWAVES * 64), LDS_BYTES, stream, a);
#endif
}
```

```cpp
#include <hip/hip_runtime.h>
#include <cstdio>
#include <cstdint>

#define LAS __attribute__((address_space(3)))
#define GAS __attribute__((address_space(1)))
typedef unsigned short bf16_t;
typedef short bf16x8 __attribute__((ext_vector_type(8)));
typedef short s16x4 __attribute__((ext_vector_type(4)));
typedef float f32x4 __attribute__((ext_vector_type(4)));
typedef float f32x16 __attribute__((ext_vector_type(16)));
typedef unsigned u32x4 __attribute__((ext_vector_type(4)));
typedef unsigned u32x2 __attribute__((ext_vector_type(2)));
typedef float f32x2_t __attribute__((ext_vector_type(2)));
typedef __bf16 bf16x2_t __attribute__((ext_vector_type(2)));

#ifndef DUP_PHASE
#define DUP_PHASE -1
#endif
#ifndef N_LAUNCHES_PER_PHASE
#define N_LAUNCHES_PER_PHASE 0
#endif

constexpr int S = 8192, DM = 2048, NCAT = 13568;
constexpr int HD = 128, NKV = 4, NCMP = 511;
constexpr float EPS = 1e-6f;

constexpr size_t MiB = 1u << 20;
constexpr size_t WS_CTL = 0, CTL_BYTES = 1 * MiB;
constexpr size_t WS_WCAT = 1 * MiB;
constexpr size_t WS_SLAB = WS_WCAT;
constexpr size_t WS_YAG  = WS_WCAT;
constexpr size_t WS_MIXT = 54 * MiB;
constexpr size_t WS_WPOT = 55 * MiB;
constexpr size_t WS_WNOT = 59 * MiB;
constexpr size_t WS_WOT  = 67 * MiB;
constexpr size_t WS_W1KT = 75 * MiB, WS_W1VT = 77 * MiB;
constexpr size_t WS_W2KT = 79 * MiB, WS_W2VT = 79 * MiB + 65536;
constexpr size_t WS_B1P  = 80 * MiB + 262144;
constexpr size_t WS_B1   = 79 * MiB + 131072 + 32768;
constexpr size_t WS_KC   = 79 * MiB + 262144, WS_VC = 79 * MiB + 786432;
constexpr size_t WS_ROPE = 81 * MiB;
constexpr size_t WS_SSQ  = 85 * MiB;
constexpr size_t WS_H    = 86 * MiB;
constexpr size_t WS_U    = 118 * MiB, WS_GP = 134 * MiB;
constexpr size_t WS_Q    = 150 * MiB;
constexpr size_t WS_KCR  = 182 * MiB, WS_VCR = 190 * MiB, WS_KS = 198 * MiB, WS_VS = 206 * MiB, WS_KW = 214 * MiB, WS_VW = 222 * MiB;
constexpr size_t WS_GN   = 230 * MiB;
constexpr size_t WS_GBR  = 262 * MiB;
constexpr size_t WS_END  = 266 * MiB;
constexpr int CW_BAR = 4096;

constexpr int RING_BYTES = 131072;
constexpr int LDSCTL_OFF = RING_BYTES, MISC_OFF = LDSCTL_OFF + 320;
constexpr int LDS_BYTES = 147456;
constexpr int NWAVES = 8;

#define LDS_WAIT() asm volatile("s_waitcnt lgkmcnt(0)" ::: "memory")
#define VM_WAIT() asm volatile("s_waitcnt vmcnt(0)" ::: "memory")

__device__ __forceinline__ unsigned cvtpk(float lo, float hi) { f32x2_t v = {lo, hi}; bf16x2_t b = __builtin_convertvector(v, bf16x2_t); return __builtin_bit_cast(unsigned, b); }
__device__ __forceinline__ float bf2f(unsigned short h) { return __builtin_bit_cast(float, (unsigned)h << 16); }
__device__ __forceinline__ float bflo(unsigned w) { return __builtin_bit_cast(float, w << 16); }
__device__ __forceinline__ float bfhi(unsigned w) { return __builtin_bit_cast(float, w & 0xffff0000u); }
__device__ __forceinline__ float sigmoidf_(float x) { return 1.0f / (1.0f + __expf(-x)); }
__device__ __forceinline__ float siluf_(float x) { return x / (1.0f + __expf(-x)); }
__device__ __forceinline__ int otid() { int t = threadIdx.x; asm volatile("" : "+v"(t)); return t; }
__device__ __forceinline__ float wave_sum(float v) {
#pragma unroll
    for (int o = 1; o < 64; o <<= 1) v += __shfl_xor(v, o);
    return v;
}

#define XB_TMO      128
#define XB_XCNT(j)  (256  + 64 * (j))
#define XB_XSUB(j)  (1280 + 64 * (j))
#define XB_XGEN(j)  (2304 + 64 * (j))
#define XB_TOP      3328
#define XB_TOPGEN   3392
#define XCD_BAR_WORDS 3456
#define XB_SPIN_CAP (1u << 18)
__device__ __forceinline__ unsigned xb_ld(unsigned* p)              { return __hip_atomic_load(p, __ATOMIC_RELAXED, __HIP_MEMORY_SCOPE_AGENT); }
__device__ __forceinline__ unsigned xb_add(unsigned* p, unsigned v) { return __hip_atomic_fetch_add(p, v, __ATOMIC_RELAXED, __HIP_MEMORY_SCOPE_AGENT); }
__device__ __forceinline__ unsigned xb_xcc_id() { return (unsigned)__builtin_amdgcn_s_getreg((3 << 11) | 20) & 0xFu; }
#define XB_SPIN(cond, bar) do { unsigned _sp = 0; while (cond) { __builtin_amdgcn_s_sleep(1); \
    if ((++_sp & 255u) == 0u) { if (xb_ld(&(bar)[XB_TMO])) break; if (_sp > XB_SPIN_CAP) { atomicAdd(&(bar)[XB_TMO], 1u); break; } } } } while (0)
struct XcdBarrier { unsigned* bar; unsigned x; volatile LAS unsigned* st; };
__device__ __forceinline__ XcdBarrier xcd_barrier_post(unsigned* bar, volatile LAS unsigned* st) {
    XcdBarrier b; b.bar = bar; b.x = xb_xcc_id(); b.st = st;
    if (threadIdx.x == 0) (void)xb_add(&bar[XB_XCNT(b.x)], 1u);
    return b;
}
__device__ __forceinline__ void xcd_barrier_complete(unsigned* bar, unsigned x, unsigned& nloc, unsigned& nx) {
    const unsigned G = gridDim.x * gridDim.y * gridDim.z;
    unsigned sum, cnt, mine, sp = 0u;
    for (;;) {
        sum = 0u; cnt = 0u; mine = 0u;
#pragma unroll
        for (unsigned j = 0; j < 16; ++j) { const unsigned c = xb_ld(&bar[XB_XCNT(j)]); sum += c; cnt += (c > 0u) ? 1u : 0u; mine = (j == x) ? c : mine; }
        if (sum == G) break;
        __builtin_amdgcn_s_sleep(1);
        if ((++sp & 255u) == 0u) { if (xb_ld(&bar[XB_TMO])) break; if (sp > XB_SPIN_CAP) { atomicAdd(&bar[XB_TMO], 1u); break; } }
    }
    nloc = mine > 0u ? mine : 1u; nx = cnt > 0u ? cnt : 1u;
}
__device__ __forceinline__ void xcd_barrier(const XcdBarrier& b) {
    asm volatile("s_waitcnt vmcnt(0)" ::: "memory");
    __syncthreads();
    if (threadIdx.x == 0) {
        unsigned* bar = b.bar;
        __builtin_amdgcn_s_waitcnt(0);
        unsigned nloc = b.st[0], nx = b.st[1];
        if (nloc == 0u) { xcd_barrier_complete(bar, b.x, nloc, nx); b.st[0] = nloc; b.st[1] = nx; }
        const unsigned old = xb_add(&bar[XB_XSUB(b.x)], 1u);
        const unsigned gen = old / nloc;
        if (old + 1u == (gen + 1u) * nloc) {
            __builtin_amdgcn_fence(__ATOMIC_RELEASE, "agent");
            asm volatile("s_waitcnt vmcnt(0)" ::: "memory");
            const unsigned og = xb_add(&bar[XB_TOP], 1u);
            const unsigned tg = og / nx;
            if (og + 1u == (tg + 1u) * nx) xb_add(&bar[XB_TOPGEN], 1u);
            else XB_SPIN(xb_ld(&bar[XB_TOPGEN]) == tg, bar);
            __builtin_amdgcn_fence(__ATOMIC_ACQUIRE, "agent");
            xb_add(&bar[XB_XGEN(b.x)], 1u);
            asm volatile("s_waitcnt vmcnt(0)" ::: "memory");
        } else {
            XB_SPIN(xb_ld(&bar[XB_XGEN(b.x)]) == gen, bar);
            __builtin_amdgcn_fence(__ATOMIC_ACQUIRE, "agent");
            asm volatile("s_waitcnt vmcnt(0)" ::: "memory");
        }
    }
    __syncthreads();
}

namespace pg8 {
constexpr int BM = 256, BK = 64, HALF = 128, HTB = HALF * BK * 2, STAGE_BYTES = 8 * HTB, NXCD = 8, WGM = 8;
__host__ __device__ __forceinline__ int lds_byte(int r, int c) { const int st = (r >> 4) * 2 + (c >> 5), rr = r & 15, cc = c & 31, ob = rr * 64 + cc * 2; return st * 1024 + (ob ^ (((ob >> 9) & 1) << 5)); }
__host__ __device__ __forceinline__ void stage_rc(int b, int& R, int& C) { const int st = b / 1024, sb = b % 1024, swz = sb ^ (((sb >> 9) & 1) << 5); R = (st >> 1) * 16 + swz / 64; C = (st & 1) * 32 + (swz % 64) / 2; }
__host__ __device__ __forceinline__ int perm32(int rho) { const int n = rho >> 4, i = rho & 15; return 8 * (i >> 2) + 4 * n + (i & 3); }
struct Unit { int pm, pn; };
struct Gemm { const bf16_t* A; const bf16_t* Bt; int lda, ldb, K; int a_pn_off; };
struct StaticOrder {
    int nM, nN, nwg, G, c;
    __host__ __device__ void init(int M, int N, int G_, int c_) { nM = M / BM; nN = N / BM; nwg = nM * nN; G = G_; c = c_; }
    __host__ __device__ bool next(int i, Unit& u) const {
        const long L = (long)i * G + c; if (L >= nwg) return false;
        int wgid = (int)L; { const int q = nwg / NXCD, r = nwg % NXCD, xcd = wgid % NXCD, off = wgid / NXCD; wgid = (xcd < r ? xcd * (q + 1) : r * (q + 1) + (xcd - r) * q) + off; }
        const int nig = WGM * nN, gid = wgid / nig, fm = gid * WGM, gsz = (nM - fm) < WGM ? (nM - fm) : WGM;
        u.pm = fm + ((wgid % nig) % gsz); u.pn = (wgid % nig) / gsz; return true;
    }
};
template <class Epi, bool ALIGN_EPI>
__device__ __forceinline__ void gemm_phase(LAS unsigned char* lds, const Gemm g, const StaticOrder& S, const Epi& E) {
    const int tid = otid(), wid = __builtin_amdgcn_readfirstlane(tid >> 6), lane = tid & 63, wr = wid >> 2, wc = wid & 3, fr = lane & 15, fq = lane >> 4;
    const int K = g.K, nt = K / BK;
    unsigned voffA[2], voffB[2];
#pragma unroll
    for (int i = 0; i < 2; ++i) { int R, C; stage_rc(tid * 16 + i * 8192, R, C); const int Rb = (R & ~31) + perm32(R & 31);
        voffA[i] = (unsigned)(R * g.lda + C) * 2u; voffB[i] = (unsigned)(Rb * g.ldb + C) * 2u; }
    const size_t kstep = (size_t)(BK * 2);
    const size_t hA = (size_t)HALF * g.lda * 2, hB = (size_t)HALF * g.ldb * 2;
    const size_t tA = 2 * hA, tB = 2 * hB;
    const unsigned ldsw = (unsigned)wid * 1024u;
    const int aoff = lds_byte(wr * 64 + fr, fq * 8), boff = lds_byte(wc * 32 + fr, fq * 8);
#define PG8_SA(b, h) (((b) * 2 + (h)) * HTB)
#define PG8_SB(b, h) ((4 + (b) * 2 + (h)) * HTB)
#define PG8_STAGE(bufoff, gbase, voff) do { _Pragma("unroll") for (int _i = 0; _i < 2; ++_i) \
        __builtin_amdgcn_global_load_lds((const unsigned*)((const char*)(gbase) + (voff)[_i]), (LAS unsigned*)(lds + (bufoff) + ldsw + _i * 8192), 16, 0, 0); } while (0)
#define PG8_LDA(dst, b, h) do { _Pragma("unroll") for (int m = 0; m < 4; ++m) _Pragma("unroll") for (int k = 0; k < 2; ++k) dst[m][k] = *(const LAS bf16x8*)(lds + PG8_SA(b, h) + aoff + m * 2048 + k * 1024); } while (0)
#define PG8_LDB(dst, b, h) do { _Pragma("unroll") for (int n = 0; n < 2; ++n) _Pragma("unroll") for (int k = 0; k < 2; ++k) dst[n][k] = *(const LAS bf16x8*)(lds + PG8_SB(b, h) + boff + n * 2048 + k * 1024); } while (0)
#define PG8_MMA(ai, bj, At, Bt) do { __builtin_amdgcn_s_setprio(1); _Pragma("unroll") for (int m = 0; m < 4; ++m) _Pragma("unroll") for (int n = 0; n < 2; ++n) _Pragma("unroll") for (int k = 0; k < 2; ++k) \
        acc[ai][bj][m][n] = __builtin_amdgcn_mfma_f32_16x16x32_bf16(Bt[n][k], At[m][k], acc[ai][bj][m][n], 0, 0, 0); __builtin_amdgcn_s_setprio(0); } while (0)
#define PG8_WAIT_V(n) asm volatile("s_waitcnt vmcnt(" #n ")" ::: "memory")
#define PG8_WAIT_L(n) asm volatile("s_waitcnt lgkmcnt(" #n ")" ::: "memory")
#define PG8_BAR __builtin_amdgcn_s_barrier()
#define PG8_SCHED __builtin_amdgcn_sched_barrier(0)
    Unit cur, nxt; int ui = 0;
    if (!S.next(0, cur)) return;
    f32x4 acc[2][2][4][2];
#pragma unroll
    for (int a = 0; a < 2; ++a)
#pragma unroll
        for (int b = 0; b < 2; ++b)
#pragma unroll
            for (int m = 0; m < 4; ++m)
#pragma unroll
                for (int n = 0; n < 2; ++n) acc[a][b][m][n] = (f32x4){0.f, 0.f, 0.f, 0.f};
    bf16x8 At[4][2], B0[2][2], B1[2][2];
    const char* cA = (const char*)g.A + (size_t)cur.pm * tA + (size_t)cur.pn * g.a_pn_off; const char* cB = (const char*)g.Bt + (size_t)cur.pn * tB;
    PG8_STAGE(PG8_SB(0, 0), cB, voffB); PG8_STAGE(PG8_SB(0, 1), cB + hB, voffB); PG8_STAGE(PG8_SA(0, 0), cA, voffA); PG8_STAGE(PG8_SA(0, 1), cA + hA, voffA);
    if (wr == 1) PG8_BAR;
    PG8_WAIT_V(2); PG8_BAR;
    PG8_STAGE(PG8_SB(1, 0), cB + kstep, voffB); PG8_STAGE(PG8_SA(1, 0), cA + kstep, voffA); PG8_STAGE(PG8_SB(1, 1), cB + hB + kstep, voffB);
    PG8_WAIT_V(6); PG8_BAR;
    for (;;) {
        const bool has_next = S.next(ui + 1, nxt);
        const char* nA = has_next ? (const char*)g.A + (size_t)nxt.pm * tA + (size_t)nxt.pn * g.a_pn_off : cA; const char* nB = has_next ? (const char*)g.Bt + (size_t)nxt.pn * tB : cB;
        for (int t = 0; t < nt; t += 2) {
            const bool last = (t == nt - 2);
            const char* a1 = cA + (size_t)(t + 1) * kstep;
            const char* a2 = last ? nA : cA + (size_t)(t + 2) * kstep; const char* b2 = last ? nB : cB + (size_t)(t + 2) * kstep;
            const char* a3 = a2 + kstep; const char* b3 = b2 + kstep;
            PG8_LDB(B0, 0, 0); PG8_LDB(B1, 0, 1); PG8_SCHED; PG8_LDA(At, 0, 0); PG8_STAGE(PG8_SA(1, 1), a1 + hA, voffA);
            PG8_WAIT_V(8); PG8_WAIT_L(0); PG8_BAR; PG8_MMA(0, 0, At, B0); PG8_MMA(0, 1, At, B1); PG8_BAR; PG8_SCHED;
            PG8_LDA(At, 0, 1); PG8_STAGE(PG8_SB(0, 0), b2, voffB); PG8_STAGE(PG8_SB(0, 1), b2 + hB, voffB); PG8_STAGE(PG8_SA(0, 0), a2, voffA);
            PG8_WAIT_V(8); PG8_WAIT_L(0); PG8_BAR; PG8_MMA(1, 0, At, B0); PG8_MMA(1, 1, At, B1); PG8_BAR; PG8_SCHED;
            PG8_LDB(B0, 1, 0); PG8_LDB(B1, 1, 1); PG8_SCHED; PG8_LDA(At, 1, 0); PG8_STAGE(PG8_SA(0, 1), a2 + hA, voffA);
            PG8_WAIT_V(8); PG8_WAIT_L(0); PG8_BAR; PG8_MMA(0, 0, At, B0); PG8_MMA(0, 1, At, B1); PG8_BAR; PG8_SCHED;
            PG8_LDA(At, 1, 1); PG8_STAGE(PG8_SB(1, 0), b3, voffB); PG8_STAGE(PG8_SB(1, 1), b3 + hB, voffB); PG8_STAGE(PG8_SA(1, 0), a3, voffA);
            PG8_WAIT_V(8); PG8_WAIT_L(0); PG8_BAR; PG8_MMA(1, 0, At, B0); PG8_MMA(1, 1, At, B1); PG8_BAR; PG8_SCHED;
        }
        if constexpr (ALIGN_EPI) { if (wr == 0) PG8_BAR; }
        E(acc, cur, wr, wc, fr, fq);
        if (!has_next) break;
#pragma unroll
        for (int a = 0; a < 2; ++a)
#pragma unroll
            for (int b = 0; b < 2; ++b)
#pragma unroll
                for (int m = 0; m < 4; ++m)
#pragma unroll
                    for (int n = 0; n < 2; ++n) acc[a][b][m][n] = (f32x4){0.f, 0.f, 0.f, 0.f};
        cur = nxt; cA = nA; cB = nB; ++ui;
        if constexpr (ALIGN_EPI) { if (wr == 1) PG8_BAR; }
    }
    PG8_WAIT_V(0);
    if constexpr (!ALIGN_EPI) { if (wr == 0) PG8_BAR; }
    PG8_BAR;
#undef PG8_SA
#undef PG8_SB
#undef PG8_STAGE
#undef PG8_LDA
#undef PG8_LDB
#undef PG8_MMA
#undef PG8_WAIT_V
#undef PG8_WAIT_L
#undef PG8_BAR
#undef PG8_SCHED
}
}

typedef f32x4 Acc[2][2][4][2];
__device__ __forceinline__ u32x4 pack8(f32x4 a, f32x4 b) { u32x4 w; w.x = cvtpk(a[0], a[1]); w.y = cvtpk(a[2], a[3]); w.z = cvtpk(b[0], b[1]); w.w = cvtpk(b[2], b[3]); return w; }
__device__ __forceinline__ void unpack8(u32x4 w, f32x4& a, f32x4& b) { a = (f32x4){bflo(w.x), bfhi(w.x), bflo(w.y), bfhi(w.y)}; b = (f32x4){bflo(w.z), bfhi(w.z), bflo(w.w), bfhi(w.w)}; }

struct EpiInProj {
    unsigned char* ws; bf16_t* gm; const float* bmerge;
    __device__ __forceinline__ void operator()(const Acc& acc, const pg8::Unit& u, int wr, int wc, int fr, int fq) const {
        const int pn = u.pn;
        bf16_t* dst; int ldc, cb, mode;
        if (pn < 4)       { dst = (bf16_t*)(ws + WS_U);   ldc = 1024; cb = pn * 256;        mode = 0; }
        else if (pn < 8)  { dst = (bf16_t*)(ws + WS_GP);  ldc = 1024; cb = (pn - 4) * 256;  mode = 1; }
        else if (pn < 16) { dst = (bf16_t*)(ws + WS_Q);   ldc = 2048; cb = (pn - 8) * 256;  mode = 3; }
        else if (pn < 28) { const int k = (pn - 16) >> 1; dst = (bf16_t*)(ws + WS_KCR + (size_t)k * (8 * MiB)); ldc = 512; cb = ((pn - 16) & 1) * 256; mode = (k == 2 || k == 4) ? 3 : 0; }
        else if (pn < 36) { dst = (bf16_t*)(ws + WS_GN);  ldc = 2048; cb = (pn - 28) * 256; mode = 1; }
        else if (pn < 52) { dst = gm;                     ldc = 4096; cb = (pn - 36) * 256; mode = 2; }
        else              { dst = (bf16_t*)(ws + WS_GBR); ldc = 256;  cb = 0;               mode = 4; }
        const int row0 = u.pm * 256 + wr * 64 + fr, cl = wc * 32 + 8 * fq, col0 = cb + cl;
        const float* rcos = (const float*)(ws + WS_ROPE); const float* rsin = rcos + (size_t)S * 64;
#pragma unroll
        for (int ai = 0; ai < 2; ++ai)
#pragma unroll
            for (int m = 0; m < 4; ++m) {
                const int row = row0 + ai * 128 + m * 16;
                bf16_t* rowp = dst + (size_t)row * ldc + col0;
                f32x4 cs0, cs1, sn0, sn1;
                if (mode == 3) { const int i0 = (cl & 127) >> 1; cs0 = *(const f32x4*)(rcos + (size_t)row * 64 + i0); sn0 = *(const f32x4*)(rsin + (size_t)row * 64 + i0); }
#pragma unroll
                for (int bj = 0; bj < 2; ++bj) {
                    f32x4 v0 = acc[ai][bj][m][0], v1 = acc[ai][bj][m][1];
                    if (mode == 1) { for (int e = 0; e < 4; ++e) { v0[e] = siluf_(v0[e]); v1[e] = siluf_(v1[e]); } }
                    else if (mode == 2 || mode == 4) { if (mode == 2) { v0 = v0 + *(const f32x4*)(bmerge + col0 + bj * 128); v1 = v1 + *(const f32x4*)(bmerge + col0 + bj * 128 + 4); } for (int e = 0; e < 4; ++e) { v0[e] = sigmoidf_(v0[e]); v1[e] = sigmoidf_(v1[e]); } }
                    else if (mode == 3) {
                        f32x4 o0, o1;
                        o0[0] = v0[0] * cs0[0] - v0[1] * sn0[0]; o0[1] = v0[1] * cs0[0] + v0[0] * sn0[0];
                        o0[2] = v0[2] * cs0[1] - v0[3] * sn0[1]; o0[3] = v0[3] * cs0[1] + v0[2] * sn0[1];
                        o1[0] = v1[0] * cs0[2] - v1[1] * sn0[2]; o1[1] = v1[1] * cs0[2] + v1[0] * sn0[2];
                        o1[2] = v1[2] * cs0[3] - v1[3] * sn0[3]; o1[3] = v1[3] * cs0[3] + v1[2] * sn0[3];
                        v0 = o0; v1 = o1;
                    }
                    *(u32x4*)(rowp + bj * 128) = pack8(v0, v1);
                }
            }
    }
};
struct EpiMix {
    bf16_t* ypool; const bf16_t* gp; const float* scale;
    __device__ __forceinline__ void operator()(const Acc& acc, const pg8::Unit& u, int wr, int wc, int fr, int fq) const {
        const int row0 = u.pm * 256 + wr * 64 + fr, col0 = u.pn * 256 + wc * 32 + 8 * fq;
#pragma unroll
        for (int ai = 0; ai < 2; ++ai)
#pragma unroll
            for (int m = 0; m < 4; ++m) { const size_t ro = (size_t)(row0 + ai * 128 + m * 16) * 1024 + col0;
#pragma unroll
                for (int bj = 0; bj < 2; ++bj) { f32x4 g0, g1; unpack8(*(const u32x4*)(gp + ro + bj * 128), g0, g1);
                    const f32x4 s0 = *(const f32x4*)(scale + col0 + bj * 128), s1 = *(const f32x4*)(scale + col0 + bj * 128 + 4);
                    *(u32x4*)(ypool + ro + bj * 128) = pack8(acc[ai][bj][m][0] * s0 * g0, acc[ai][bj][m][1] * s1 * g1); } }
    }
};
struct EpiYa {
    bf16_t* yag; const bf16_t* gm;
    __device__ __forceinline__ void operator()(const Acc& acc, const pg8::Unit& u, int wr, int wc, int fr, int fq) const {
        const int row0 = u.pm * 256 + wr * 64 + fr, col0 = u.pn * 256 + wc * 32 + 8 * fq;
#pragma unroll
        for (int ai = 0; ai < 2; ++ai)
#pragma unroll
            for (int m = 0; m < 4; ++m) { const size_t r = (size_t)(row0 + ai * 128 + m * 16);
#pragma unroll
                for (int bj = 0; bj < 2; ++bj) { f32x4 g0, g1; unpack8(*(const u32x4*)(gm + r * 4096 + col0 + bj * 128), g0, g1);
                    *(u32x4*)(yag + r * 2048 + col0 + bj * 128) = pack8(acc[ai][bj][m][0] * g0, acc[ai][bj][m][1] * g1); } }
    }
};
struct EpiYb {
    bf16_t* merged; const bf16_t* yag; const bf16_t* gm;
    __device__ __forceinline__ void operator()(const Acc& acc, const pg8::Unit& u, int wr, int wc, int fr, int fq) const {
        const int row0 = u.pm * 256 + wr * 64 + fr, col0 = u.pn * 256 + wc * 32 + 8 * fq;
#pragma unroll
        for (int ai = 0; ai < 2; ++ai)
#pragma unroll
            for (int m = 0; m < 4; ++m) { const size_t r = (size_t)(row0 + ai * 128 + m * 16);
#pragma unroll
                for (int bj = 0; bj < 2; ++bj) { f32x4 g0, g1, y0, y1; unpack8(*(const u32x4*)(gm + r * 4096 + 2048 + col0 + bj * 128), g0, g1);
                    unpack8(*(const u32x4*)(yag + r * 2048 + col0 + bj * 128), y0, y1);
                    *(u32x4*)(merged + r * 2048 + col0 + bj * 128) = pack8(y0 + acc[ai][bj][m][0] * g0, y1 + acc[ai][bj][m][1] * g1); } }
    }
};
struct EpiOut {
    float* out; const float* x; float* ssq;
    __device__ __forceinline__ void operator()(const Acc& acc, const pg8::Unit& u, int wr, int wc, int fr, int fq) const {
        const int row0 = u.pm * 256 + wr * 64 + fr, col0 = u.pn * 256 + wc * 32 + 8 * fq;
#pragma unroll
        for (int ai = 0; ai < 2; ++ai)
#pragma unroll
            for (int m = 0; m < 4; ++m) { const size_t r = (size_t)(row0 + ai * 128 + m * 16); float q = 0.f;
#pragma unroll
                for (int bj = 0; bj < 2; ++bj)
#pragma unroll
                    for (int n = 0; n < 2; ++n) { const size_t o = r * 2048 + col0 + bj * 128 + 4 * n; const f32x4 v = *(const f32x4*)(x + o) + acc[ai][bj][m][n];
                        *(f32x4*)(out + o) = v; q += (v[0] * v[0] + v[1] * v[1]) + (v[2] * v[2] + v[3] * v[3]); }
                q += __shfl_xor(q, 16); q += __shfl_xor(q, 32);
                if (fq == 0) ssq[(size_t)(u.pn * 4 + wc) * S + r] = q; }
    }
};

struct Args { const float* in[17]; float* out; unsigned char* ws; int ph_lo, ph_hi; };
struct Frame { LAS unsigned char* lds; int tid, lane, wave, vcu, G; };

__device__ __forceinline__ int ropeperm(int d) { return d < 64 ? 2 * d : 2 * (d - 64) + 1; }
__device__ __forceinline__ void transpose_item(const float* W, int ldw, int Nvalid, bf16_t* WT, int ldt, int row_off, bool perm, LAS float* scr, int kb, int nb, int lane) {
    const int k0 = 64 * kb, n0 = 32 * nb, cq = lane & 7, rb = lane >> 3; const bool ok = n0 + cq * 4 < Nvalid;
    f32x4 v[8];
#pragma unroll
    for (int i = 0; i < 8; ++i) v[i] = ok ? *(const f32x4*)(W + (size_t)(k0 + i * 8 + rb) * ldw + n0 + cq * 4) : (f32x4){0.f, 0.f, 0.f, 0.f};
#pragma unroll
    for (int i = 0; i < 8; ++i) *(LAS f32x4*)(scr + (i * 8 + rb) * 32 + ((cq ^ i) << 2)) = v[i];
    LDS_WAIT(); asm volatile("" ::: "memory");
#pragma unroll
    for (int j = 0; j < 4; ++j) { const int idx = lane + 64 * j, n = idx >> 3, c = idx & 7; const LAS float* s = scr + (8 * c) * 32 + ((((n >> 2) ^ c) << 2) | (n & 3));
        u32x4 o; o.x = cvtpk(s[0 * 32], s[1 * 32]); o.y = cvtpk(s[2 * 32], s[3 * 32]); o.z = cvtpk(s[4 * 32], s[5 * 32]); o.w = cvtpk(s[6 * 32], s[7 * 32]);
        const int ng = n0 + n;
        if (ng < Nvalid) { const int dr = perm ? ((ng & ~127) | ropeperm(ng & 127)) : ng; *(GAS u32x4*)(WT + (size_t)(row_off + dr) * ldt + k0 + 8 * c) = o; } }
    LDS_WAIT(); asm volatile("" ::: "memory");
}

__device__ __forceinline__ void p0_prologue(const Frame& F, const Args& a) {
    unsigned char* ws = a.ws;
    LAS float* scr = (LAS float*)(F.lds + F.wave * 8192);
    const int gw = F.vcu * NWAVES + F.wave, NGW = F.G * NWAVES, lane = F.lane;
    constexpr int I_WIN = 32 * 290, I_WM = 32 * 128;
    for (int it = gw; it < I_WIN + I_WM; it += NGW) {
        int r = it;
        if (r < I_WIN) { const int kb = r / 290, nb = r % 290, n0 = nb * 32;
            const bool perm = (n0 >= 2048 && n0 < 4096) || (n0 >= 5120 && n0 < 5632) || (n0 >= 6144 && n0 < 6656);
            transpose_item(a.in[2], 9264, 9264, (bf16_t*)(ws + WS_WCAT), 2048, nb >= 288 ? 4096 : 0, perm, scr, kb, nb, lane); continue; } r -= I_WIN;
        transpose_item(a.in[13], 4096, 4096, (bf16_t*)(ws + WS_WCAT), 2048, 9216, false, scr, r / 128, r % 128, lane);
    }
    for (int i = gw * 64 + lane; i < 53248; i += NGW * 64) *(GAS u32x4*)(ws + WS_WCAT + (size_t)13360 * 4096 + (size_t)i * 16) = (u32x4){0u, 0u, 0u, 0u};
    {
        const float* x = a.in[0]; const float* nw = a.in[1]; bf16_t* H = (bf16_t*)(ws + WS_H);
        f32x4 wv[8];
#pragma unroll
        for (int j = 0; j < 8; ++j) wv[j] = *((const f32x4*)nw + lane + 64 * j);
        for (int m = gw; m < S; m += NGW) {
            const f32x4* xr = (const f32x4*)(x + (size_t)m * DM) + lane; f32x4 v[8]; float s = 0.f;
#pragma unroll
            for (int j = 0; j < 8; ++j) { v[j] = xr[64 * j]; s += (v[j][0] * v[j][0] + v[j][1] * v[j][1]) + (v[j][2] * v[j][2] + v[j][3] * v[j][3]); }
            const float rstd = 1.0f / sqrtf(wave_sum(s) * (1.f / DM) + EPS);
            u32x2* o = (u32x2*)(H + (size_t)m * DM) + lane;
#pragma unroll
            for (int j = 0; j < 8; ++j) { const f32x4 y = v[j] * rstd * wv[j]; u32x2 w; w.x = cvtpk(y[0], y[1]); w.y = cvtpk(y[2], y[3]); o[64 * j] = w; }
        }
    }
    {
        float* rcos = (float*)(ws + WS_ROPE); float* rsin = rcos + (size_t)S * 64;
        for (int e = gw * 64 + lane; e < S * 64; e += NGW * 64) {
            const int pos = e >> 6, i = e & 63;
            double inv = 1.0, b = 0.86596432336006535;
            for (int k = i; k; k >>= 1) { if (k & 1) inv *= b; b *= b; }
            const double t = (double)pos * inv * 0.15915494309189535;
            const float fr = (float)(t - floor(t));
            rcos[e] = __builtin_amdgcn_cosf(fr); rsin[e] = __builtin_amdgcn_sinf(fr);
        }
    }
}
__device__ __forceinline__ void p1_late_weights(const Frame& F, const Args& a, int cw, int NCW) {
    unsigned char* ws = a.ws;
    LAS float* scr = (LAS float*)(F.lds + F.wave * 8192);
    const int lane = F.lane;
    constexpr int I_NO = 32 * 64, I_O = 32 * 64, I_PO = 16 * 64, I_MIX = 4 * 32, I_W1 = 64 * 8, I_W2 = 4 * 4, I_B1 = 512;
    constexpr int NITEMS = I_NO + I_O + I_PO + I_MIX + 2 * I_W1 + 2 * I_W2 + I_B1;
    for (int it = cw; it < NITEMS; it += NCW) {
        int r = it;
        if (r < I_W1) { transpose_item(a.in[6], 256, 256, (bf16_t*)(ws + WS_W1KT), 4096, 0, false, scr, r / 8, r % 8, lane); continue; } r -= I_W1;
        if (r < I_W1) { transpose_item(a.in[9], 256, 256, (bf16_t*)(ws + WS_W1VT), 4096, 0, false, scr, r / 8, r % 8, lane); continue; } r -= I_W1;
        if (r < I_B1) {
            const int which = r >> 8, fb = (r >> 6) & 3, ch = r & 63, f = fb * 64 + lane;
            const float* pe = a.in[which ? 8 : 5]; const float* w1 = a.in[which ? 9 : 6]; float s = 0.f;
#pragma unroll 16
            for (int k = ch * 64; k < ch * 64 + 64; ++k) s += pe[k] * w1[(size_t)k * 256 + f];
            ((float*)(ws + WS_B1P))[(which * 64 + ch) * 256 + f] = s; continue; } r -= I_B1;
        if (r < I_MIX) { const int g = r / 32, q = r % 32; transpose_item(a.in[3] + (size_t)g * 65536, 256, 256, (bf16_t*)(ws + WS_MIXT) + (size_t)g * 65536, 256, 0, false, scr, q / 8, q % 8, lane); continue; } r -= I_MIX;
        if (r < I_W2) { transpose_item(a.in[7], 128, 128, (bf16_t*)(ws + WS_W2KT), 256, 0, true, scr, r / 4, r % 4, lane); continue; } r -= I_W2;
        if (r < I_W2) { transpose_item(a.in[10], 128, 128, (bf16_t*)(ws + WS_W2VT), 256, 0, false, scr, r / 4, r % 4, lane); continue; } r -= I_W2;
        if (r < I_PO) { transpose_item(a.in[11], 2048, 2048, (bf16_t*)(ws + WS_WPOT), 1024, 0, false, scr, r / 64, r % 64, lane); continue; } r -= I_PO;
        if (r < I_NO) { transpose_item(a.in[12], 2048, 2048, (bf16_t*)(ws + WS_WNOT), 2048, 0, false, scr, r / 64, r % 64, lane); continue; } r -= I_NO;
        transpose_item(a.in[15], 2048, 2048, (bf16_t*)(ws + WS_WOT), 2048, 0, false, scr, r / 64, r % 64, lane);
    }
}

__device__ __forceinline__ void p2_pooled(const Frame& F, unsigned char* ws) {
    const bf16_t* U = (const bf16_t*)(ws + WS_U); bf16_t* P = (bf16_t*)(ws + WS_H);
    const int gt = F.vcu * 512 + F.tid, NGT = F.G * 512;
    for (int it = gt; it < S * 128; it += NGT) {
        const int t = it >> 7, c8 = it & 127, c = c8 * 8, w = 2 << (c >> 8), cnt = (t + 1 < w) ? t + 1 : w;
        float s[8] = {0.f, 0.f, 0.f, 0.f, 0.f, 0.f, 0.f, 0.f}; f32x4 a0, a1;
        for (int i = 0; i < cnt; ++i) { unpack8(*(const u32x4*)(U + (size_t)(t - i) * 1024 + c), a0, a1);
            s[0] += a0[0]; s[1] += a0[1]; s[2] += a0[2]; s[3] += a0[3]; s[4] += a1[0]; s[5] += a1[1]; s[6] += a1[2]; s[7] += a1[3]; }
        unpack8(*(const u32x4*)(U + (size_t)t * 1024 + c), a0, a1);
        const float ic = 1.0f / (float)cnt;
        const f32x4 o0 = {s[0] * ic - a0[0], s[1] * ic - a0[1], s[2] * ic - a0[2], s[3] * ic - a0[3]}, o1 = {s[4] * ic - a1[0], s[5] * ic - a1[1], s[6] * ic - a1[2], s[7] * ic - a1[3]};
        *(u32x4*)(P + (size_t)t * 1024 + c) = pack8(o0, o1);
    }
}
__device__ __forceinline__ void p8_norm(const Frame& F, const Args& a) {
    const float* ssq = (const float*)(a.ws + WS_SSQ); const float* fw = a.in[16]; float* out = a.out;
    const int gw = F.vcu * NWAVES + F.wave, NGW = F.G * NWAVES, lane = F.lane;
    f32x4 wv[8];
#pragma unroll
    for (int j = 0; j < 8; ++j) wv[j] = *((const f32x4*)fw + lane + 64 * j);
    for (int m = gw; m < S; m += NGW) {
        float q = (lane < 32) ? ssq[(size_t)lane * S + m] : 0.f;
        q = wave_sum(q);
        const float rstd = 1.0f / sqrtf(q * (1.f / DM) + EPS);
        f32x4* o = (f32x4*)(out + (size_t)m * DM) + lane;
#pragma unroll
        for (int j = 0; j < 8; ++j) o[64 * j] = o[64 * j] * rstd * wv[j];
    }
}


__device__ __forceinline__ int crow(int r, int hi) { return (r & 3) + 8 * (r >> 2) + 4 * hi; }
__device__ __forceinline__ void p2_compress1(const Frame& F, unsigned char* ws) {
    const int gw = F.vcu * NWAVES + F.wave, NGW = F.G * NWAVES, lane = F.lane, r = lane & 31, hh = lane >> 5;
    for (int it = gw; it < 2048; it += NGW) {
        const int which = it >> 10, rem = it & 1023, ks = rem & 7, ft = (rem >> 3) & 3, nt = (rem >> 5) & 7, h = rem >> 8;
        const bf16_t* X = (const bf16_t*)(ws + (which ? WS_VCR : WS_KCR)); const bf16_t* W1 = (const bf16_t*)(ws + (which ? WS_W1VT : WS_W1KT));
        const int n0 = nt * 64, f0 = ft * 64;
        f32x16 acc[2][2];
#pragma unroll
        for (int a = 0; a < 2; ++a)
#pragma unroll
            for (int b = 0; b < 2; ++b) acc[a][b] = f32x16{};
        for (int l = ks * 4; l < ks * 4 + 4; ++l) {
            int t0 = 16 * (n0 + r) + l, t1 = t0 + 512; t0 = t0 > S - 1 ? S - 1 : t0; t1 = t1 > S - 1 ? S - 1 : t1;
            const bf16_t* xa0 = X + (size_t)t0 * 512 + h * 128 + hh * 8; const bf16_t* xa1 = X + (size_t)t1 * 512 + h * 128 + hh * 8;
            const bf16_t* wb0 = W1 + (size_t)(f0 + r) * 4096 + l * 128 + hh * 8; const bf16_t* wb1 = wb0 + (size_t)32 * 4096;
#pragma unroll
            for (int d0 = 0; d0 < 8; ++d0) {
                const bf16x8 a0 = *(const bf16x8*)(xa0 + d0 * 16), a1 = *(const bf16x8*)(xa1 + d0 * 16), b0 = *(const bf16x8*)(wb0 + d0 * 16), b1 = *(const bf16x8*)(wb1 + d0 * 16);
                acc[0][0] = __builtin_amdgcn_mfma_f32_32x32x16_bf16(a0, b0, acc[0][0], 0, 0, 0); acc[0][1] = __builtin_amdgcn_mfma_f32_32x32x16_bf16(a0, b1, acc[0][1], 0, 0, 0);
                acc[1][0] = __builtin_amdgcn_mfma_f32_32x32x16_bf16(a1, b0, acc[1][0], 0, 0, 0); acc[1][1] = __builtin_amdgcn_mfma_f32_32x32x16_bf16(a1, b1, acc[1][1], 0, 0, 0);
            }
        }
        float* slab = (float*)(ws + WS_SLAB) + ((size_t)(which * 8 + ks) * 2048 + h * 512 + n0) * 256 + f0;
#pragma unroll
        for (int mi = 0; mi < 2; ++mi)
#pragma unroll
            for (int ni = 0; ni < 2; ++ni)
#pragma unroll
                for (int e = 0; e < 16; ++e) { int ee = e; asm volatile("" : "+v"(ee)); slab[(size_t)(mi * 32 + crow(ee, hh)) * 256 + ni * 32 + r] = acc[mi][ni][e]; }
    }
}
__device__ __forceinline__ void p3_compress2(const Frame& F, unsigned char* ws, int cw, int NCW) {
    const int lane = F.lane, r = lane & 31, hh = lane >> 5;
    const float* rcos = (const float*)(ws + WS_ROPE); const float* rsin = rcos + (size_t)S * 64;
    for (int it = cw; it < 512; it += NCW) {
        const int which = it >> 8, rt = (it >> 2) & 63, ct = it & 3, row = rt * 32 + r;
        const bf16_t* W2 = (const bf16_t*)(ws + (which ? WS_W2VT : WS_W2KT)) + (size_t)(ct * 32 + r) * 256 + hh * 8;
        const float* sl = (const float*)(ws + WS_SLAB) + ((size_t)(which * 8) * 2048 + row) * 256 + hh * 8; const float* b1 = (const float*)(ws + WS_B1) + which * 256 + hh * 8;
        f32x16 acc = f32x16{};
        for (int k = 0; k < 16; ++k) {
            f32x4 s0 = *(const f32x4*)(b1 + k * 16), s1 = *(const f32x4*)(b1 + k * 16 + 4);
#pragma unroll
            for (int ks = 0; ks < 8; ++ks) { s0 = s0 + *(const f32x4*)(sl + (size_t)ks * 2048 * 256 + k * 16); s1 = s1 + *(const f32x4*)(sl + (size_t)ks * 2048 * 256 + k * 16 + 4); }
#pragma unroll
            for (int e = 0; e < 4; ++e) { s0[e] = siluf_(s0[e]); s1[e] = siluf_(s1[e]); }
            const u32x4 hb = pack8(s0, s1);
            acc = __builtin_amdgcn_mfma_f32_32x32x16_bf16(*(const bf16x8*)(W2 + k * 16), __builtin_bit_cast(bf16x8, hb), acc, 0, 0, 0);
        }
        const int n = row & 511; bf16_t* dst = (bf16_t*)(ws + (which ? WS_VC : WS_KC)) + (size_t)row * 128 + ct * 32 + 4 * hh;
        const int pos = (16 * n + 31) > S - 1 ? S - 1 : 16 * n + 31;
#pragma unroll
        for (int gq = 0; gq < 4; ++gq) {
            float v0 = acc[4 * gq], v1 = acc[4 * gq + 1], v2 = acc[4 * gq + 2], v3 = acc[4 * gq + 3];
            if (which == 0) { const int i = (ct * 32 + 8 * gq + 4 * hh) >> 1; const float c0 = rcos[(size_t)pos * 64 + i], s0 = rsin[(size_t)pos * 64 + i], c1 = rcos[(size_t)pos * 64 + i + 1], s1 = rsin[(size_t)pos * 64 + i + 1];
                const float o0 = v0 * c0 - v1 * s0, o1 = v1 * c0 + v0 * s0, o2 = v2 * c1 - v3 * s1, o3 = v3 * c1 + v2 * s1; v0 = o0; v1 = o1; v2 = o2; v3 = o3; }
            u32x2 w; w.x = cvtpk(v0, v1); w.y = cvtpk(v2, v3); if (n == 511) { w.x = 0u; w.y = 0u; }
            *(u32x2*)(dst + 8 * gq) = w;
        }
    }
}

namespace nsa {
constexpr int SHM_V = 16384, SHM_K = 16384;
constexpr int L_V = 0, L_K = 2 * SHM_V, L_WS = L_K + 2 * SHM_K, L_IMP = L_WS + NWAVES * 64 * 4, IMP_LD = 129, L_SELM = L_IMP + 64 * IMP_LD * 4, L_END = L_SELM + 64 * 8 * 2;
static_assert(L_END <= RING_BYTES, "attention LDS");
constexpr float SCALE = 0.08838834764831845f, C2 = 1.4426950408889634f * SCALE, THR = 8.f;
#define KSWZ(row, colB) ((row) * 256 + ((colB) ^ (((row) & 7) << 4)))
#define SBAR() __builtin_amdgcn_sched_barrier(0)
#define LADD(p, v) (void)__hip_atomic_fetch_add((p), (v), __ATOMIC_RELAXED, __HIP_MEMORY_SCOPE_WORKGROUP)
__device__ __forceinline__ int v_st(int k, int c) { const int kk = (k & ~0xC) | ((k & 4) << 1) | ((k & 8) >> 1); return ((kk >> 3) * 4 + (c >> 5)) * 512 + ((kk & 7) * 32 + (c & 31)) * 2; }
__device__ __forceinline__ int v_rd_base(int lane) { return ((lane & 3) << 3) | (((lane >> 2) & 3) << 6) | (((lane >> 4) & 1) << 5) | (((lane >> 5) & 1) << 8); }
constexpr int v_rd_off(int d0, int ks, int half) { return d0 * 512 + ks * 4096 + half * 2048; }
__device__ __forceinline__ unsigned cvtpk_a(float lo, float hi) { unsigned r; asm volatile("v_cvt_pk_bf16_f32 %0, %1, %2" : "=v"(r) : "v"(lo), "v"(hi)); return r; }

__device__ __forceinline__ void mask_range(f32x16& p0, f32x16& p1, int dq, unsigned Wn) {
    const float NEG = -__builtin_inff();
#pragma unroll
    for (int r = 0; r < 16; ++r) { const int c = (r & 3) + 8 * (r >> 2);
        if ((unsigned)(dq + c) >= Wn) p0[r] = NEG;
        if ((unsigned)(dq + c + 32) >= Wn) p1[r] = NEG; }
}
__device__ __forceinline__ void mask_row(f32x16& p0, f32x16& p1, bool keep) {
    const float NEG = -__builtin_inff();
#pragma unroll
    for (int r = 0; r < 16; ++r) { p0[r] = keep ? p0[r] : NEG; p1[r] = keep ? p1[r] : NEG; }
}
__device__ __forceinline__ float rowmax32(const f32x16& p0, const f32x16& p1) {
    float pmax = p0[0];
#pragma unroll
    for (int r = 1; r < 16; ++r) pmax = fmaxf(pmax, p0[r]);
#pragma unroll
    for (int r = 0; r < 16; ++r) pmax = fmaxf(pmax, p1[r]);
    auto rr = __builtin_amdgcn_permlane32_swap(__float_as_uint(pmax), __float_as_uint(pmax), false, false);
    return fmaxf(__uint_as_float(rr[0]), __uint_as_float(rr[1]));
}
__device__ __forceinline__ float rowsum32(const f32x16& p0, const f32x16& p1) {
    float ps = 0.f;
#pragma unroll
    for (int r = 0; r < 16; ++r) ps += p0[r];
#pragma unroll
    for (int r = 0; r < 16; ++r) ps += p1[r];
    auto rr = __builtin_amdgcn_permlane32_swap(__float_as_uint(ps), __float_as_uint(ps), false, false);
    return __uint_as_float(rr[0]) + __uint_as_float(rr[1]);
}
__device__ __forceinline__ void pack_p(const f32x16& p0, const f32x16& p1, bf16x8& pa0, bf16x8& pa1, bf16x8& pa2, bf16x8& pa3) {
#define PK4(P, B_, OUT) do { unsigned a0 = cvtpk_a(P[B_+0], P[B_+1]), a1 = cvtpk_a(P[B_+2], P[B_+3]);                          \
        unsigned b0 = cvtpk_a(P[B_+4], P[B_+5]), b1 = cvtpk_a(P[B_+6], P[B_+7]);                                             \
        auto r0 = __builtin_amdgcn_permlane32_swap(a0, b0, false, false); auto r1 = __builtin_amdgcn_permlane32_swap(a1, b1, false, false); \
        u32x4 w = {r0[0], r1[0], r0[1], r1[1]}; OUT = __builtin_bit_cast(bf16x8, w); } while (0)
    PK4(p0, 0, pa0); PK4(p0, 8, pa1); PK4(p1, 0, pa2); PK4(p1, 8, pa3);
#undef PK4
}
template <int KB>
__device__ __forceinline__ void qkt(f32x16& p0, f32x16& p1, const LAS unsigned char* K_lds, int r32, int hi, const bf16x8* qr) {
    p0 = f32x16{}; p1 = f32x16{};
    const LAS unsigned char* kb[4];
#pragma unroll
    for (int dd = 0; dd < 4; ++dd) kb[dd] = K_lds + KB * SHM_K + KSWZ(r32, (dd * 16 + hi * 8) * 2);
#pragma unroll
    for (int d0 = 0; d0 < 8; ++d0) { const LAS unsigned char* a = kb[d0 & 3] + (d0 >> 2) * 128;
        const bf16x8 b0 = *(const LAS bf16x8*)(a);
        const bf16x8 b1 = *(const LAS bf16x8*)(a + 32 * 256);
        p0 = __builtin_amdgcn_mfma_f32_32x32x16_bf16(b0, qr[d0], p0, 0, 0, 0);
        p1 = __builtin_amdgcn_mfma_f32_32x32x16_bf16(b1, qr[d0], p1, 0, 0, 0);
        if (d0 == 3) SBAR(); }
}
template <int VB>
__device__ __forceinline__ void pv_tile(f32x16* o, int vb0, bf16x8 pa0, bf16x8 pa1, bf16x8 pa2, bf16x8 pa3) {
#define TRRD(dst, off) asm volatile("ds_read_b64_tr_b16 %0, %1 offset:%2" : "=&v"(dst) : "v"(vb0), "i"(off) : "memory")
#define PV_D0(d0) do { s16x4 l0, l1, l2, l3, h0, h1, h2, h3; constexpr int b_ = VB * SHM_V + v_rd_off(d0, 0, 0); \
        TRRD(l0, b_); TRRD(h0, b_ + 2048); TRRD(l1, b_ + 4096); TRRD(h1, b_ + 6144); TRRD(l2, b_ + 8192); TRRD(h2, b_ + 10240); TRRD(l3, b_ + 12288); TRRD(h3, b_ + 14336); \
        asm volatile("s_waitcnt lgkmcnt(0)" ::: "memory"); SBAR();   \
        o[d0] = __builtin_amdgcn_mfma_f32_32x32x16_bf16(pa0, (bf16x8){l0[0], l0[1], l0[2], l0[3], h0[0], h0[1], h0[2], h0[3]}, o[d0], 0, 0, 0);   \
        o[d0] = __builtin_amdgcn_mfma_f32_32x32x16_bf16(pa1, (bf16x8){l1[0], l1[1], l1[2], l1[3], h1[0], h1[1], h1[2], h1[3]}, o[d0], 0, 0, 0);   \
        o[d0] = __builtin_amdgcn_mfma_f32_32x32x16_bf16(pa2, (bf16x8){l2[0], l2[1], l2[2], l2[3], h2[0], h2[1], h2[2], h2[3]}, o[d0], 0, 0, 0);   \
        o[d0] = __builtin_amdgcn_mfma_f32_32x32x16_bf16(pa3, (bf16x8){l3[0], l3[1], l3[2], l3[3], h3[0], h3[1], h3[2], h3[3]}, o[d0], 0, 0, 0); } while (0)
    PV_D0(0); PV_D0(1); PV_D0(2); PV_D0(3);
#undef PV_D0
#undef TRRD
}

enum { M_C1 = 0, M_C2 = 1, M_S = 2, M_W = 3 };
struct RowState { float m, l; };
template <int MODE>
__device__ __forceinline__ void attn_pass(LAS unsigned char* lds, const bf16_t* Kp, const bf16_t* Vp, int ld, int j_lo, int j_hi, const bf16x8* qr, int t, int Tq, const u32x4 sel,
                                          RowState& st, float invl, f32x16* o, bool do_imp) {
    constexpr bool HASV = MODE != M_C1;
    const int tid = otid(), wid = __builtin_amdgcn_readfirstlane(tid >> 6), lane = tid & 63, r32 = lane & 31, hi = lane >> 5;
    LAS unsigned char* V_lds = lds + L_V; LAS unsigned char* K_lds = lds + L_K;
    LAS float* wsf = (LAS float*)(lds + L_WS) + wid * 64; LAS float* al_l = wsf + 32;
    const int sr = tid >> 4, sc = (tid & 15) * 8, vst0 = v_st(sr, sc), vst1 = v_st(32 + sr, sc), kws = KSWZ(sr, sc * 2);
    const int vb0 = (int)(uintptr_t)V_lds + v_rd_base(lane);
    const int NT = j_hi - j_lo;
    bf16x8 st_k0, st_k1, st_v0, st_v1;
    float m_reg = st.m, l_reg = st.l;
#define SLOAD(j) do { const size_t k0_ = (size_t)(j) * 64; st_k0 = *(const bf16x8*)(Kp + (k0_ + sr) * ld + sc); st_k1 = *(const bf16x8*)(Kp + (k0_ + 32 + sr) * ld + sc); \
        if (HASV) { st_v0 = *(const bf16x8*)(Vp + (k0_ + sr) * ld + sc); st_v1 = *(const bf16x8*)(Vp + (k0_ + 32 + sr) * ld + sc); } } while (0)
#define SWRITE(bf) do { *(LAS bf16x8*)(K_lds + (bf) * SHM_K + kws) = st_k0; *(LAS bf16x8*)(K_lds + (bf) * SHM_K + kws + 32 * 256) = st_k1; \
        if (HASV) { *(LAS bf16x8*)(V_lds + (bf) * SHM_V + vst0) = st_v0; *(LAS bf16x8*)(V_lds + (bf) * SHM_V + vst1) = st_v1; } } while (0)
    SLOAD(j_lo); SWRITE(0);
    __syncthreads();
#define STEP(idx, BUF) do { const int j = j_lo + (idx); const int kb = j * 64;                                                          \
        if ((idx) + 1 < NT) SLOAD(j + 1);                                                                                              \
        f32x16 p0, p1; qkt<BUF>(p0, p1, K_lds, r32, hi, qr);                                                                           \
        if (MODE == M_C1 || MODE == M_C2) { const int nmax1 = ((t - 31) >> 4) + 1; mask_range(p0, p1, kb + 4 * hi, (unsigned)(nmax1 > 0 ? nmax1 : 0)); } \
        else if (MODE == M_S) { if (j == Tq) mask_range(p0, p1, kb + 4 * hi, (unsigned)(t + 1));                                        \
                                else { const unsigned w_ = (j >> 5) == 0 ? sel.x : (j >> 5) == 1 ? sel.y : (j >> 5) == 2 ? sel.z : sel.w; mask_row(p0, p1, ((w_ >> (j & 31)) & 1u) != 0u); } } \
        else { if (j == Tq || j + 8 <= Tq) mask_range(p0, p1, kb + 4 * hi - (t - 511), 512u); }                                          \
        if (MODE == M_C1) { const float pmax = rowmax32(p0, p1); const float mn = fmaxf(m_reg, pmax); const float alpha = __builtin_amdgcn_exp2f((m_reg - mn) * C2); m_reg = mn; \
            const float mnL = -mn * C2;                                                                                                \
            _Pragma("unroll") for (int r = 0; r < 16; ++r) { p0[r] = __builtin_amdgcn_exp2f(fmaf(p0[r], C2, mnL)); p1[r] = __builtin_amdgcn_exp2f(fmaf(p1[r], C2, mnL)); } \
            l_reg = l_reg * alpha + rowsum32(p0, p1); }                                                                                \
        else if (MODE == M_C2) { const float mnL = -m_reg * C2;                                                                        \
            _Pragma("unroll") for (int r = 0; r < 16; ++r) { p0[r] = __builtin_amdgcn_exp2f(fmaf(p0[r], C2, mnL)) * invl; p1[r] = __builtin_amdgcn_exp2f(fmaf(p1[r], C2, mnL)) * invl; } \
            if (do_imp) { LAS unsigned* imp = (LAS unsigned*)(lds + L_IMP) + ((wid & 1) * 32 + r32) * IMP_LD + 16 * j + hi;            \
                _Pragma("unroll") for (int k = 0; k < 4; ++k) {                                                                        \
                    { const float e_ = p0[4 * k + 3], a_ = 2.f * (p0[4 * k] + p0[4 * k + 1] + p0[4 * k + 2]) + e_;                     \
                      LADD(imp + 2 * k, (unsigned)(a_ * 67108864.f + 0.5f)); LADD(imp + 2 * k + 1, (unsigned)(e_ * 67108864.f + 0.5f)); } \
                    { const float e_ = p1[4 * k + 3], a_ = 2.f * (p1[4 * k] + p1[4 * k + 1] + p1[4 * k + 2]) + e_;                     \
                      LADD(imp + 8 + 2 * k, (unsigned)(a_ * 67108864.f + 0.5f)); LADD(imp + 8 + 2 * k + 1, (unsigned)(e_ * 67108864.f + 0.5f)); } } } \
            bf16x8 pa0, pa1, pa2, pa3; pack_p(p0, p1, pa0, pa1, pa2, pa3); SBAR(); pv_tile<BUF>(o, vb0, pa0, pa1, pa2, pa3); }          \
        else { const float pmax = rowmax32(p0, p1); float mn, alpha;                                                                   \
            if (__builtin_expect(__all((pmax - m_reg) * SCALE <= THR), 1)) { mn = m_reg; alpha = 1.f; }                                \
            else { mn = fmaxf(m_reg, pmax); alpha = __builtin_amdgcn_exp2f((m_reg - mn) * C2); m_reg = mn; }                           \
            const float mnL = -mn * C2;                                                                                                \
            _Pragma("unroll") for (int r = 0; r < 16; ++r) { p0[r] = __builtin_amdgcn_exp2f(fmaf(p0[r], C2, mnL)); p1[r] = __builtin_amdgcn_exp2f(fmaf(p1[r], C2, mnL)); } \
            l_reg = l_reg * alpha + rowsum32(p0, p1);                                                                                  \
            bf16x8 pa0, pa1, pa2, pa3; pack_p(p0, p1, pa0, pa1, pa2, pa3);                                                             \
            if (__any(alpha < 1.f)) { if (hi == 0) al_l[r32] = alpha; asm volatile("s_waitcnt lgkmcnt(0)" ::: "memory");               \
                _Pragma("unroll") for (int d_ = 0; d_ < 4; ++d_) _Pragma("unroll") for (int r = 0; r < 16; ++r) o[d_][r] *= al_l[crow(r, hi)]; } \
            SBAR(); pv_tile<BUF>(o, vb0, pa0, pa1, pa2, pa3); }                                                                        \
        if ((idx) + 1 < NT) { SWRITE((BUF) ^ 1); }                                                                                     \
        __syncthreads(); } while (0)
    int idx = 0;
    for (; idx + 1 < NT; idx += 2) { STEP(idx, 0); STEP(idx + 1, 1); }
    if (idx < NT) STEP(idx, 0);
    st.m = m_reg; st.l = l_reg;
#undef STEP
#undef SLOAD
#undef SWRITE
}

template <int MODE>
__device__ __forceinline__ void branch_out(LAS unsigned char* lds, const f32x16* o, float rowscale, bf16_t* onsa_w, const bf16_t* gn_w) {
    const int tid = otid(), wid = __builtin_amdgcn_readfirstlane(tid >> 6), lane = tid & 63, r32 = lane & 31, hi = lane >> 5;
    LAS float* li_l = (LAS float*)(lds + L_WS) + wid * 64;
    if (hi == 0) li_l[r32] = rowscale; asm volatile("s_waitcnt lgkmcnt(0)" ::: "memory");
    float rli[16];
#pragma unroll
    for (int r = 0; r < 16; ++r) rli[r] = li_l[crow(r, hi)];
#pragma unroll
    for (int r = 0; r < 16; ++r) { int rr_ = r; asm volatile("" : "+v"(rr_)); const int orow = crow(rr_, hi);
#pragma unroll
        for (int d0 = 0; d0 < 4; ++d0) { const float v = o[d0][r] * rli[r]; const float vn = __shfl_xor(v, 1);
            if ((r32 & 1) == 0) { unsigned* p = (unsigned*)(onsa_w + (size_t)orow * 2048 + d0 * 32 + r32); float a = v, b = vn;
                if (MODE >= 1) { const unsigned w = *p; a += bflo(w); b += bfhi(w); }
                if (MODE == 2) { const unsigned gw_ = *(const unsigned*)(gn_w + (size_t)orow * 2048 + d0 * 32 + r32); a *= bflo(gw_); b *= bfhi(gw_); }
                *p = cvtpk(a, b); } } }
}

__device__ __forceinline__ void attn_unit(LAS unsigned char* lds, unsigned char* ws, int h, int Tq) {
    const int tid = otid(), wid = __builtin_amdgcn_readfirstlane(tid >> 6), lane = tid & 63, r32 = lane & 31, hi = lane >> 5;
    const int g = wid >> 1, tl = (wid & 1) * 32 + r32, t = Tq * 64 + tl, hq = 4 * h + g;
    const bf16_t* Q = (const bf16_t*)(ws + WS_Q); const bf16_t* GBR = (const bf16_t*)(ws + WS_GBR);
    bf16_t* onsa_w = (bf16_t*)(ws + WS_U) + (size_t)(Tq * 64 + (wid & 1) * 32) * 2048 + hq * 128; const bf16_t* gn_w = (const bf16_t*)(ws + WS_GN) + (size_t)(Tq * 64 + (wid & 1) * 32) * 2048 + hq * 128;
    bf16x8 qr[8];
#pragma unroll
    for (int d0 = 0; d0 < 8; ++d0) qr[d0] = *(const bf16x8*)(Q + (size_t)t * 2048 + hq * 128 + d0 * 16 + hi * 8);
    const float g_c = bf2f(GBR[(size_t)t * 256 + hq * 3 + 0]), g_s = bf2f(GBR[(size_t)t * 256 + hq * 3 + 1]), g_w = bf2f(GBR[(size_t)t * 256 + hq * 3 + 2]);
    const bool big = Tq >= 16;
    LAS unsigned* IMP = (LAS unsigned*)(lds + L_IMP);
    if (big) { for (int i = tid; i < 64 * IMP_LD; i += 512) IMP[i] = 0u; }
    const u32x4 nosel = {0u, 0u, 0u, 0u};
    f32x16 o[4];
    {
        const bf16_t* Kc = (const bf16_t*)(ws + WS_KC) + (size_t)h * 512 * 128; const bf16_t* Vc = (const bf16_t*)(ws + WS_VC) + (size_t)h * 512 * 128;
        const int ntc = ((4 * Tq + 2) >> 6) + 1;
        RowState stc{-1e30f, 0.f};
        attn_pass<M_C1>(lds, Kc, Vc, 128, 0, ntc, qr, t, Tq, nosel, stc, 0.f, o, false);
        const float invl = stc.l > 0.f ? 1.0f / stc.l : 0.f;
#pragma unroll
        for (int d = 0; d < 4; ++d) o[d] = f32x16{};
        attn_pass<M_C2>(lds, Kc, Vc, 128, 0, ntc, qr, t, Tq, nosel, stc, invl, o, big);
        branch_out<0>(lds, o, g_c, onsa_w, gn_w);
    }
    {
        LAS unsigned short* SELM = (LAS unsigned short*)(lds + L_SELM);
        int tok = tid >> 3, sub = tid & 7; asm volatile("" : "+v"(tok), "+v"(sub));
        unsigned bits = 0u;
        if (big) {
            unsigned kv[16];
#pragma unroll
            for (int e = 0; e < 16; ++e) { const int j = sub * 16 + e; const unsigned v = IMP[tok * IMP_LD + j]; kv[e] = (j >= 1 && j <= Tq - 2) ? v + 1u : 0u; }
            for (int round = 0; round < 13; ++round) {
                unsigned bv = kv[0]; int bj = 0;
#pragma unroll
                for (int e = 1; e < 16; ++e) { const bool gt = kv[e] > bv; bv = gt ? kv[e] : bv; bj = gt ? e : bj; }
                bj += sub * 16;
#pragma unroll
                for (int sh = 1; sh < 8; sh <<= 1) { const unsigned ov = __shfl_xor(bv, sh); const int oj = __shfl_xor(bj, sh);
                    const bool take = (ov > bv) || (ov == bv && oj < bj); bv = take ? ov : bv; bj = take ? oj : bj; }
                const int we = (bv != 0u && (bj >> 4) == sub) ? (bj & 15) : -1;
#pragma unroll
                for (int e = 0; e < 16; ++e) { const bool hit = (we == e); bits |= hit ? (1u << e) : 0u; kv[e] = hit ? 0u : kv[e]; }
            }
#pragma unroll
            for (int e = 0; e < 16; ++e) { const int j = sub * 16 + e; if (j == 0 || j == Tq - 1 || j == Tq) bits |= 1u << e; }
        } else {
#pragma unroll
            for (int e = 0; e < 16; ++e) { const int j = sub * 16 + e; if (j <= Tq) bits |= 1u << e; }
        }
        SELM[tok * 8 + sub] = (unsigned short)bits;
        __syncthreads();
    }
    const u32x4 sel = *(const LAS u32x4*)(lds + L_SELM + tl * 16);
    {
        RowState sts{-1e30f, 0.f};
#pragma unroll
        for (int d = 0; d < 4; ++d) o[d] = f32x16{};
        attn_pass<M_S>(lds, (const bf16_t*)(ws + WS_KS) + h * 128, (const bf16_t*)(ws + WS_VS) + h * 128, 512, 0, Tq + 1, qr, t, Tq, sel, sts, 0.f, o, false);
        branch_out<1>(lds, o, sts.l > 0.f ? g_s / sts.l : 0.f, onsa_w, gn_w);
    }
    {
        RowState stw{-1e30f, 0.f};
#pragma unroll
        for (int d = 0; d < 4; ++d) o[d] = f32x16{};
        attn_pass<M_W>(lds, (const bf16_t*)(ws + WS_KW) + h * 128, (const bf16_t*)(ws + WS_VW) + h * 128, 512, Tq >= 8 ? Tq - 8 : 0, Tq + 1, qr, t, Tq, sel, stw, 0.f, o, false);
        branch_out<2>(lds, o, stw.l > 0.f ? g_w / stw.l : 0.f, onsa_w, gn_w);
    }
    __syncthreads();
}
#undef KSWZ
#undef SBAR
}

constexpr int NPHASE = 9;
__global__ void __launch_bounds__(NWAVES * 64, 2) mega_fwd(Args args) {
    extern __shared__ __attribute__((aligned(16))) unsigned char lds[];
    Frame F;
    F.lds = (LAS unsigned char*)lds;
    F.tid = threadIdx.x; F.lane = F.tid & 63; F.wave = __builtin_amdgcn_readfirstlane(F.tid >> 6);
    F.G = gridDim.x; { const int bx = blockIdx.x; F.vcu = (F.G % 8 == 0) ? (bx % 8) * (F.G / 8) + bx / 8 : bx; }
    volatile LAS unsigned* MISC = (volatile LAS unsigned*)(F.lds + MISC_OFF);
    unsigned char* ws = args.ws;
    for (int u = F.tid; u < (LDS_BYTES - LDSCTL_OFF) / 4; u += NWAVES * 64) ((LAS unsigned*)(F.lds + LDSCTL_OFF))[u] = 0u;
    __syncthreads();
    XcdBarrier bar; bar.bar = (unsigned*)(ws + WS_CTL) + CW_BAR; bar.x = 0; bar.st = nullptr;
#if !N_LAUNCHES_PER_PHASE
    bar = xcd_barrier_post((unsigned*)(ws + WS_CTL) + CW_BAR, MISC + 8);
#endif
    const int lo = args.ph_lo, hi = args.ph_hi;
#define IN(k) (lo <= (k) && (k) < hi && (F.tid = otid(), F.lane = F.tid & 63, true))
#define SEAM(k) do { if (IN(k) && IN((k) + 1)) xcd_barrier(bar); } while (0)
    bf16_t* const GM = (bf16_t*)args.out;

    for (int rep_ = 0; rep_ < (DUP_PHASE == 0 ? 2 : 1); ++rep_) if (IN(0)) { if (rep_) xcd_barrier(bar); p0_prologue(F, args); } SEAM(0);
    for (int rep_ = 0; rep_ < (DUP_PHASE == 1 ? 2 : 1); ++rep_) if (IN(1)) { if (rep_) xcd_barrier(bar);
        pg8::Gemm g{(const bf16_t*)(ws + WS_H), (const bf16_t*)(ws + WS_WCAT), 2048, 2048, 2048, 0};
        pg8::StaticOrder So; So.init(S, NCAT, F.G, (int)blockIdx.x);
        EpiInProj E{ws, GM, args.in[14]};
        pg8::gemm_phase<EpiInProj, true>(F.lds, g, So, E);
        { const int nun = (So.nwg + F.G - 1) / F.G, full = So.nwg - (nun - 1) * F.G;
          const int base = full < F.G ? full : 0; if ((int)blockIdx.x >= base) p1_late_weights(F, args, ((int)blockIdx.x - base) * NWAVES + F.wave, (F.G - base) * NWAVES); }
    } SEAM(1);
    for (int rep_ = 0; rep_ < (DUP_PHASE == 2 ? 2 : 1); ++rep_) if (IN(2)) { if (rep_) xcd_barrier(bar);
        p2_compress1(F, ws);
        p2_pooled(F, ws);
        if (blockIdx.x == 0) { const float* b1p = (const float*)(ws + WS_B1P); float* b1 = (float*)(ws + WS_B1); const int t = F.tid; float s = 0.f;
            for (int c = 0; c < 64; ++c) s += b1p[((t >> 8) * 64 + c) * 256 + (t & 255)];
            b1[t] = s; }
    } SEAM(2);
    for (int rep_ = 0; rep_ < (DUP_PHASE == 3 ? 2 : 1); ++rep_) if (IN(3)) { if (rep_) xcd_barrier(bar);
        pg8::Gemm g{(const bf16_t*)(ws + WS_H), (const bf16_t*)(ws + WS_MIXT), 1024, 256, 256, 512};
        pg8::StaticOrder So; So.init(S, 1024, F.G, (int)blockIdx.x);
        EpiMix E{(bf16_t*)(ws + WS_H + 16 * MiB), (const bf16_t*)(ws + WS_GP), args.in[4]};
        pg8::gemm_phase<EpiMix, false>(F.lds, g, So, E);
        { const int base = F.G > 128 ? 128 : 0; if ((int)blockIdx.x >= base) p3_compress2(F, ws, ((int)blockIdx.x - base) * NWAVES + F.wave, (F.G - base) * NWAVES); }
    } SEAM(3);
    for (int rep_ = 0; rep_ < (DUP_PHASE == 4 ? 2 : 1); ++rep_) if (IN(4)) { if (rep_) xcd_barrier(bar);
        pg8::Gemm g{(const bf16_t*)(ws + WS_H + 16 * MiB), (const bf16_t*)(ws + WS_WPOT), 1024, 1024, 1024, 0};
        pg8::StaticOrder So; So.init(S, 2048, F.G, (int)blockIdx.x);
        EpiYa E{(bf16_t*)(ws + WS_YAG), GM};
        pg8::gemm_phase<EpiYa, false>(F.lds, g, So, E);
    } SEAM(4);
    for (int rep_ = 0; rep_ < (DUP_PHASE == 5 ? 2 : 1); ++rep_) if (IN(5)) { if (rep_) xcd_barrier(bar);
        for (int p = F.vcu; p < 256; p += F.G) {
#pragma unroll 1
            for (int i = 0; i < 2; ++i) { const int h = p >> 6, x = p & 63; nsa::attn_unit(F.lds, ws, h, i ? x : 127 - x); } }
    } SEAM(5);
    for (int rep_ = 0; rep_ < (DUP_PHASE == 6 ? 2 : 1); ++rep_) if (IN(6)) { if (rep_) xcd_barrier(bar);
        pg8::Gemm g{(const bf16_t*)(ws + WS_U), (const bf16_t*)(ws + WS_WNOT), 2048, 2048, 2048, 0};
        pg8::StaticOrder So; So.init(S, 2048, F.G, (int)blockIdx.x);
        EpiYb E{(bf16_t*)(ws + WS_H), (const bf16_t*)(ws + WS_YAG), GM};
        pg8::gemm_phase<EpiYb, false>(F.lds, g, So, E);
    } SEAM(6);
    for (int rep_ = 0; rep_ < (DUP_PHASE == 7 ? 2 : 1); ++rep_) if (IN(7)) { if (rep_) xcd_barrier(bar);
        pg8::Gemm g{(const bf16_t*)(ws + WS_H), (const bf16_t*)(ws + WS_WOT), 2048, 2048, 2048, 0};
        pg8::StaticOrder So; So.init(S, 2048, F.G, (int)blockIdx.x);
        EpiOut E{args.out, args.in[0], (float*)(ws + WS_SSQ)};
        pg8::gemm_phase<EpiOut, false>(F.lds, g, So, E);
    } SEAM(7);
    if (IN(8)) { p8_norm(F, args); }
#undef IN
#undef SEAM
}

extern "C" void kernel_launch(void* const* d_in, const int* in_sizes, int n_in, void* d_out, int out_size, void* d_ws, size_t ws_size, hipStream_t stream) {
    static int grid = 0;
    if (grid == 0) {
        if (n_in != 17 || in_sizes[0] != S * DM || out_size != S * DM || ws_size < WS_END) { fprintf(stderr, "kernel_launch: unexpected shapes (n_in %d, in0 %d, out %d, ws %zu); nothing launched\n", n_in, n_in > 0 ? in_sizes[0] : -1, out_size, ws_size); grid = -1; return; }
        int dev = 0, cus = 0;
        if (hipGetDevice(&dev) != hipSuccess || hipDeviceGetAttribute(&cus, hipDeviceAttributeMultiprocessorCount, dev) != hipSuccess) { fprintf(stderr, "kernel_launch: device query failed\n"); grid = -1; return; }
        if (hipFuncSetAttribute((const void*)mega_fwd, hipFuncAttributeMaxDynamicSharedMemorySize, LDS_BYTES) != hipSuccess) { fprintf(stderr, "kernel_launch: hipFuncSetAttribute failed\n"); grid = -1; return; }
        (void)hipGetLastError();
        grid = cus;
    }
    if (grid < 0) return;
    (void)hipMemsetAsync((char*)d_ws + WS_CTL, 0, CTL_BYTES, stream);
    Args a{};
    for (int i = 0; i < 17; ++i) a.in[i] = (const float*)d_in[i];
    a.out = (float*)d_out; a.ws = (unsigned char*)d_ws;
#if N_LAUNCHES_PER_PHASE
    for (int p = 0; p < NPHASE; ++p) { a.ph_lo = p; a.ph_hi = p + 1; hipLaunchKernelGGL(mega_fwd, dim3(grid), dim3(NWAVES * 64), LDS_BYTES, stream, a); }
#else
    a.ph_lo = 0; a.ph_hi = NPHASE;
    hipLaunchKernelGGL(mega_fwd, dim3(grid), dim3(NWAVES * 64), LDS_BYTES, stream, a);
#endif
}
```

```cpp
#include <hip/hip_runtime.h>
#include <cstdio>
#include <cstdint>

#define LAS __attribute__((address_space(3)))
#define GAS __attribute__((address_space(1)))
typedef unsigned short bf16_t;
typedef short bf16x8 __attribute__((ext_vector_type(8)));
typedef short s16x4 __attribute__((ext_vector_type(4)));
typedef float f32x4 __attribute__((ext_vector_type(4)));
typedef float f32x16 __attribute__((ext_vector_type(16)));
typedef unsigned u32x4 __attribute__((ext_vector_type(4)));
typedef unsigned u32x2 __attribute__((ext_vector_type(2)));
typedef float f32x2_t __attribute__((ext_vector_type(2)));
typedef __bf16 bf16x2_t __attribute__((ext_vector_type(2)));

#ifndef DUP_PHASE
#define DUP_PHASE -1
#endif
#ifndef N_LAUNCHES_PER_PHASE
#define N_LAUNCHES_PER_PHASE 0
#endif

constexpr int S = 8192, DM = 2048, NCAT = 13568;
constexpr int HD = 128, NKV = 4, NCMP = 511;
constexpr float EPS = 1e-6f;

constexpr size_t MiB = 1u << 20;
constexpr size_t WS_CTL = 0, CTL_BYTES = 1 * MiB;
constexpr size_t WS_WCAT = 1 * MiB;
constexpr size_t WS_SLAB = WS_WCAT;
constexpr size_t WS_YAG  = WS_WCAT;
constexpr size_t WS_MIXT = 54 * MiB;
constexpr size_t WS_WPOT = 55 * MiB;
constexpr size_t WS_WNOT = 59 * MiB;
constexpr size_t WS_WOT  = 67 * MiB;
constexpr size_t WS_W1KT = 75 * MiB, WS_W1VT = 77 * MiB;
constexpr size_t WS_W2KT = 79 * MiB, WS_W2VT = 79 * MiB + 65536;
constexpr size_t WS_B1P  = 80 * MiB + 262144;
constexpr size_t WS_B1   = 79 * MiB + 131072 + 32768;
constexpr size_t WS_KC   = 79 * MiB + 262144, WS_VC = 79 * MiB + 786432;
constexpr size_t WS_ROPE = 81 * MiB;
constexpr size_t WS_SSQ  = 85 * MiB;
constexpr size_t WS_H    = 86 * MiB;
constexpr size_t WS_U    = 118 * MiB, WS_GP = 134 * MiB;
constexpr size_t WS_Q    = 150 * MiB;
constexpr size_t WS_KCR  = 182 * MiB, WS_VCR = 190 * MiB, WS_KS = 198 * MiB, WS_VS = 206 * MiB, WS_KW = 214 * MiB, WS_VW = 222 * MiB;
constexpr size_t WS_GN   = 230 * MiB;
constexpr size_t WS_GBR  = 262 * MiB;
constexpr size_t WS_END  = 266 * MiB;
constexpr int CW_BAR = 4096;

constexpr int RING_BYTES = 131072;
constexpr int LDSCTL_OFF = RING_BYTES, MISC_OFF = LDSCTL_OFF + 320;
constexpr int LDS_BYTES = 147456;
constexpr int NWAVES = 8;

#define LDS_WAIT() asm volatile("s_waitcnt lgkmcnt(0)" ::: "memory")
#define VM_WAIT() asm volatile("s_waitcnt vmcnt(0)" ::: "memory")

__device__ __forceinline__ unsigned cvtpk(float lo, float hi) { f32x2_t v = {lo, hi}; bf16x2_t b = __builtin_convertvector(v, bf16x2_t); return __builtin_bit_cast(unsigned, b); }
__device__ __forceinline__ float bf2f(unsigned short h) { return __builtin_bit_cast(float, (unsigned)h << 16); }
__device__ __forceinline__ float bflo(unsigned w) { return __builtin_bit_cast(float, w << 16); }
__device__ __forceinline__ float bfhi(unsigned w) { return __builtin_bit_cast(float, w & 0xffff0000u); }
__device__ __forceinline__ float sigmoidf_(float x) { return 1.0f / (1.0f + __expf(-x)); }
__device__ __forceinline__ float siluf_(float x) { return x / (1.0f + __expf(-x)); }
__device__ __forceinline__ int otid() { int t = threadIdx.x; asm volatile("" : "+v"(t)); return t; }
__device__ __forceinline__ int crow(int r, int hi) { return (r & 3) + 8 * (r >> 2) + 4 * hi; }
__device__ __forceinline__ float wave_sum(float v) {
#pragma unroll
    for (int o = 1; o < 64; o <<= 1) v += __shfl_xor(v, o);
    return v;
}

#define XB_TMO      128
#define XB_XCNT(j)  (256  + 64 * (j))
#define XB_XSUB(j)  (1280 + 64 * (j))
#define XB_XGEN(j)  (2304 + 64 * (j))
#define XB_TOP      3328
#define XB_TOPGEN   3392
#define XCD_BAR_WORDS 3456
#define XB_SPIN_CAP (1u << 18)
__device__ __forceinline__ unsigned xb_ld(unsigned* p)              { return __hip_atomic_load(p, __ATOMIC_RELAXED, __HIP_MEMORY_SCOPE_AGENT); }
__device__ __forceinline__ unsigned xb_add(unsigned* p, unsigned v) { return __hip_atomic_fetch_add(p, v, __ATOMIC_RELAXED, __HIP_MEMORY_SCOPE_AGENT); }
__device__ __forceinline__ unsigned xb_xcc_id() { return (unsigned)__builtin_amdgcn_s_getreg((3 << 11) | 20) & 0xFu; }
#define XB_SPIN(cond, bar) do { unsigned _sp = 0; while (cond) { __builtin_amdgcn_s_sleep(1); \
    if ((++_sp & 255u) == 0u) { if (xb_ld(&(bar)[XB_TMO])) break; if (_sp > XB_SPIN_CAP) { atomicAdd(&(bar)[XB_TMO], 1u); break; } } } } while (0)
struct XcdBarrier { unsigned* bar; unsigned x; volatile LAS unsigned* st; };
__device__ __forceinline__ XcdBarrier xcd_barrier_post(unsigned* bar, volatile LAS unsigned* st) {
    XcdBarrier b; b.bar = bar; b.x = xb_xcc_id(); b.st = st;
    if (threadIdx.x == 0) (void)xb_add(&bar[XB_XCNT(b.x)], 1u);
    return b;
}
__device__ __forceinline__ void xcd_barrier_complete(unsigned* bar, unsigned x, unsigned& nloc, unsigned& nx) {
    const unsigned G = gridDim.x * gridDim.y * gridDim.z;
    unsigned sum, cnt, mine, sp = 0u;
    for (;;) {
        sum = 0u; cnt = 0u; mine = 0u;
#pragma unroll
        for (unsigned j = 0; j < 16; ++j) { const unsigned c = xb_ld(&bar[XB_XCNT(j)]); sum += c; cnt += (c > 0u) ? 1u : 0u; mine = (j == x) ? c : mine; }
        if (sum == G) break;
        __builtin_amdgcn_s_sleep(1);
        if ((++sp & 255u) == 0u) { if (xb_ld(&bar[XB_TMO])) break; if (sp > XB_SPIN_CAP) { atomicAdd(&bar[XB_TMO], 1u); break; } }
    }
    nloc = mine > 0u ? mine : 1u; nx = cnt > 0u ? cnt : 1u;
}
__device__ __forceinline__ void xcd_barrier(const XcdBarrier& b) {
    asm volatile("s_waitcnt vmcnt(0)" ::: "memory");
    __syncthreads();
    if (threadIdx.x == 0) {
        unsigned* bar = b.bar;
        __builtin_amdgcn_s_waitcnt(0);
        unsigned nloc = b.st[0], nx = b.st[1];
        if (nloc == 0u) { xcd_barrier_complete(bar, b.x, nloc, nx); b.st[0] = nloc; b.st[1] = nx; }
        const unsigned old = xb_add(&bar[XB_XSUB(b.x)], 1u);
        const unsigned gen = old / nloc;
        if (old + 1u == (gen + 1u) * nloc) {
            __builtin_amdgcn_fence(__ATOMIC_RELEASE, "agent");
            asm volatile("s_waitcnt vmcnt(0)" ::: "memory");
            const unsigned og = xb_add(&bar[XB_TOP], 1u);
            const unsigned tg = og / nx;
            if (og + 1u == (tg + 1u) * nx) xb_add(&bar[XB_TOPGEN], 1u);
            else XB_SPIN(xb_ld(&bar[XB_TOPGEN]) == tg, bar);
            __builtin_amdgcn_fence(__ATOMIC_ACQUIRE, "agent");
            xb_add(&bar[XB_XGEN(b.x)], 1u);
            asm volatile("s_waitcnt vmcnt(0)" ::: "memory");
        } else {
            XB_SPIN(xb_ld(&bar[XB_XGEN(b.x)]) == gen, bar);
            __builtin_amdgcn_fence(__ATOMIC_ACQUIRE, "agent");
            asm volatile("s_waitcnt vmcnt(0)" ::: "memory");
        }
    }
    __syncthreads();
}

namespace pg8 {
constexpr int BM = 256, BK = 64, HALF = 128, HTB = HALF * BK * 2, STAGE_BYTES = 8 * HTB, NXCD = 8, WGM = 8;
__host__ __device__ __forceinline__ int lds_byte(int r, int c) { const int st = (r >> 4) * 2 + (c >> 5), rr = r & 15, cc = c & 31, ob = rr * 64 + cc * 2; return st * 1024 + (ob ^ (((ob >> 9) & 1) << 5)); }
__host__ __device__ __forceinline__ void stage_rc(int b, int& R, int& C) { const int st = b / 1024, sb = b % 1024, swz = sb ^ (((sb >> 9) & 1) << 5); R = (st >> 1) * 16 + swz / 64; C = (st & 1) * 32 + (swz % 64) / 2; }
__host__ __device__ __forceinline__ int perm32(int rho) { const int n = rho >> 4, i = rho & 15; return 8 * (i >> 2) + 4 * n + (i & 3); }
struct Unit { int pm, pn; };
struct Gemm { const bf16_t* A; const bf16_t* Bt; int lda, ldb, K; };
struct AddrAffine { size_t tA, tB;
    __device__ __forceinline__ const char* A(const char* b, const Unit& u) const { return b + (size_t)u.pm * tA; }
    __device__ __forceinline__ const char* B(const char* b, const Unit& u) const { return b + (size_t)u.pn * tB; }
    __device__ __forceinline__ size_t ka(int t) const { return (size_t)t * (BK * 2); } };
struct AddrCmp { int ntile;
    __device__ __forceinline__ const char* A(const char* b, const Unit& u) const { return b + (size_t)(u.pm >> 3) * (8 * MiB) + (size_t)((u.pm >> 1) & 3) * 256 + (size_t)(u.pm & 1) * (256 * 16384) + ka(u.pn * ntile); }
    __device__ __forceinline__ const char* B(const char* b, const Unit& u) const { return b + (size_t)(u.pm >> 3) * (2 * MiB) + (size_t)u.pn * ntile * (BK * 2); }
    __device__ __forceinline__ size_t ka(int t) const { return (size_t)(t >> 1) * 1024 + (size_t)(t & 1) * 128; } };
struct StaticOrder {
    int nM, nN, nwg, G, c;
    __host__ __device__ void init(int M, int N, int G_, int c_) { nM = M / BM; nN = N / BM; nwg = nM * nN; G = G_; c = c_; }
    __host__ __device__ bool next(int i, Unit& u) const {
        const long L = (long)i * G + c; if (L >= nwg) return false;
        int wgid = (int)L; { const int q = nwg / NXCD, r = nwg % NXCD, xcd = wgid % NXCD, off = wgid / NXCD; wgid = (xcd < r ? xcd * (q + 1) : r * (q + 1) + (xcd - r) * q) + off; }
        const int nig = WGM * nN, gid = wgid / nig, fm = gid * WGM, gsz = (nM - fm) < WGM ? (nM - fm) : WGM;
        u.pm = fm + ((wgid % nig) % gsz); u.pn = (wgid % nig) / gsz; return true;
    }
};
template <class Epi, bool ALIGN_EPI, class Addr>
__device__ __forceinline__ void gemm_phase(LAS unsigned char* lds, const Gemm g, const StaticOrder& S, const Epi& E, const Addr& AD) {
    const int tid = otid(), wid = __builtin_amdgcn_readfirstlane(tid >> 6), lane = tid & 63, wr = wid >> 2, wc = wid & 3, fr = lane & 15, fq = lane >> 4;
    const int K = g.K, nt = K / BK;
    unsigned voffA[2], voffB[2];
#pragma unroll
    for (int i = 0; i < 2; ++i) { int R, C; stage_rc(tid * 16 + i * 8192, R, C); const int Rb = (R & ~31) + perm32(R & 31);
        voffA[i] = (unsigned)(R * g.lda + C) * 2u; voffB[i] = (unsigned)(Rb * g.ldb + C) * 2u; }
    const size_t kstep = (size_t)(BK * 2);
    const size_t hA = (size_t)HALF * g.lda * 2, hB = (size_t)HALF * g.ldb * 2;
    const unsigned ldsw = (unsigned)wid * 1024u;
    const int aoff = lds_byte(wr * 64 + fr, fq * 8), boff = lds_byte(wc * 32 + fr, fq * 8);
#define PG8_SA(b, h) (((b) * 2 + (h)) * HTB)
#define PG8_SB(b, h) ((4 + (b) * 2 + (h)) * HTB)
#define PG8_STAGE(bufoff, gbase, voff) do { _Pragma("unroll") for (int _i = 0; _i < 2; ++_i) \
        __builtin_amdgcn_global_load_lds((const unsigned*)((const char*)(gbase) + (voff)[_i]), (LAS unsigned*)(lds + (bufoff) + ldsw + _i * 8192), 16, 0, 0); } while (0)
#define PG8_LDA(dst, b, h) do { _Pragma("unroll") for (int m = 0; m < 4; ++m) _Pragma("unroll") for (int k = 0; k < 2; ++k) dst[m][k] = *(const LAS bf16x8*)(lds + PG8_SA(b, h) + aoff + m * 2048 + k * 1024); } while (0)
#define PG8_LDB(dst, b, h) do { _Pragma("unroll") for (int n = 0; n < 2; ++n) _Pragma("unroll") for (int k = 0; k < 2; ++k) dst[n][k] = *(const LAS bf16x8*)(lds + PG8_SB(b, h) + boff + n * 2048 + k * 1024); } while (0)
#define PG8_MMA(ai, bj, At, Bt) do { __builtin_amdgcn_s_setprio(1); _Pragma("unroll") for (int m = 0; m < 4; ++m) _Pragma("unroll") for (int n = 0; n < 2; ++n) _Pragma("unroll") for (int k = 0; k < 2; ++k) \
        acc[ai][bj][m][n] = __builtin_amdgcn_mfma_f32_16x16x32_bf16(Bt[n][k], At[m][k], acc[ai][bj][m][n], 0, 0, 0); __builtin_amdgcn_s_setprio(0); } while (0)
#define PG8_WAIT_V(n) asm volatile("s_waitcnt vmcnt(" #n ")" ::: "memory")
#define PG8_WAIT_L(n) asm volatile("s_waitcnt lgkmcnt(" #n ")" ::: "memory")
#define PG8_BAR __builtin_amdgcn_s_barrier()
#define PG8_SCHED __builtin_amdgcn_sched_barrier(0)
    Unit cur, nxt; int ui = 0;
    if (!S.next(0, cur)) return;
    f32x4 acc[2][2][4][2];
#pragma unroll
    for (int a = 0; a < 2; ++a)
#pragma unroll
        for (int b = 0; b < 2; ++b)
#pragma unroll
            for (int m = 0; m < 4; ++m)
#pragma unroll
                for (int n = 0; n < 2; ++n) acc[a][b][m][n] = (f32x4){0.f, 0.f, 0.f, 0.f};
    bf16x8 At[4][2], B0[2][2], B1[2][2];
    const char* cA = AD.A((const char*)g.A, cur); const char* cB = AD.B((const char*)g.Bt, cur);
    PG8_STAGE(PG8_SB(0, 0), cB, voffB); PG8_STAGE(PG8_SB(0, 1), cB + hB, voffB); PG8_STAGE(PG8_SA(0, 0), cA, voffA); PG8_STAGE(PG8_SA(0, 1), cA + hA, voffA);
    if (wr == 1) PG8_BAR;
    PG8_WAIT_V(2); PG8_BAR;
    PG8_STAGE(PG8_SB(1, 0), cB + kstep, voffB); PG8_STAGE(PG8_SA(1, 0), cA + kstep, voffA); PG8_STAGE(PG8_SB(1, 1), cB + hB + kstep, voffB);
    PG8_WAIT_V(6); PG8_BAR;
    for (;;) {
        const bool has_next = S.next(ui + 1, nxt);
        const char* nA = has_next ? AD.A((const char*)g.A, nxt) : cA; const char* nB = has_next ? AD.B((const char*)g.Bt, nxt) : cB;
        for (int t = 0; t < nt; t += 2) {
            const bool last = (t == nt - 2);
            const char* a1 = cA + AD.ka(t) + kstep;
            const char* a2 = last ? nA : cA + AD.ka(t + 2); const char* b2 = last ? nB : cB + (size_t)(t + 2) * kstep;
            const char* a3 = a2 + kstep; const char* b3 = b2 + kstep;
            PG8_LDB(B0, 0, 0); PG8_LDB(B1, 0, 1); PG8_SCHED; PG8_LDA(At, 0, 0); PG8_STAGE(PG8_SA(1, 1), a1 + hA, voffA);
            PG8_WAIT_V(8); PG8_WAIT_L(0); PG8_BAR; PG8_MMA(0, 0, At, B0); PG8_MMA(0, 1, At, B1); PG8_BAR; PG8_SCHED;
            PG8_LDA(At, 0, 1); PG8_STAGE(PG8_SB(0, 0), b2, voffB); PG8_STAGE(PG8_SB(0, 1), b2 + hB, voffB); PG8_STAGE(PG8_SA(0, 0), a2, voffA);
            PG8_WAIT_V(8); PG8_WAIT_L(0); PG8_BAR; PG8_MMA(1, 0, At, B0); PG8_MMA(1, 1, At, B1); PG8_BAR; PG8_SCHED;
            PG8_LDB(B0, 1, 0); PG8_LDB(B1, 1, 1); PG8_SCHED; PG8_LDA(At, 1, 0); PG8_STAGE(PG8_SA(0, 1), a2 + hA, voffA);
            PG8_WAIT_V(8); PG8_WAIT_L(0); PG8_BAR; PG8_MMA(0, 0, At, B0); PG8_MMA(0, 1, At, B1); PG8_BAR; PG8_SCHED;
            PG8_LDA(At, 1, 1); PG8_STAGE(PG8_SB(1, 0), b3, voffB); PG8_STAGE(PG8_SB(1, 1), b3 + hB, voffB); PG8_STAGE(PG8_SA(1, 0), a3, voffA);
            PG8_WAIT_V(8); PG8_WAIT_L(0); PG8_BAR; PG8_MMA(1, 0, At, B0); PG8_MMA(1, 1, At, B1); PG8_BAR; PG8_SCHED;
        }
        if constexpr (ALIGN_EPI) { if (wr == 0) PG8_BAR; }
        E(acc, cur, wr, wc, fr, fq);
        if (!has_next) break;
#pragma unroll
        for (int a = 0; a < 2; ++a)
#pragma unroll
            for (int b = 0; b < 2; ++b)
#pragma unroll
                for (int m = 0; m < 4; ++m)
#pragma unroll
                    for (int n = 0; n < 2; ++n) acc[a][b][m][n] = (f32x4){0.f, 0.f, 0.f, 0.f};
        cur = nxt; cA = nA; cB = nB; ++ui;
        if constexpr (ALIGN_EPI) { if (wr == 1) PG8_BAR; }
    }
    PG8_WAIT_V(0);
    if constexpr (!ALIGN_EPI) { if (wr == 0) PG8_BAR; }
    PG8_BAR;
#undef PG8_SA
#undef PG8_SB
#undef PG8_STAGE
#undef PG8_LDA
#undef PG8_LDB
#undef PG8_MMA
#undef PG8_WAIT_V
#undef PG8_WAIT_L
#undef PG8_BAR
#undef PG8_SCHED
}
}

typedef f32x4 Acc[2][2][4][2];
__device__ __forceinline__ u32x4 pack8(f32x4 a, f32x4 b) { u32x4 w; w.x = cvtpk(a[0], a[1]); w.y = cvtpk(a[2], a[3]); w.z = cvtpk(b[0], b[1]); w.w = cvtpk(b[2], b[3]); return w; }
__device__ __forceinline__ void unpack8(u32x4 w, f32x4& a, f32x4& b) { a = (f32x4){bflo(w.x), bfhi(w.x), bflo(w.y), bfhi(w.y)}; b = (f32x4){bflo(w.z), bfhi(w.z), bflo(w.w), bfhi(w.w)}; }

struct EpiInProj {
    unsigned char* ws; bf16_t* gm; const float* bmerge;
    __device__ __forceinline__ void operator()(const Acc& acc, const pg8::Unit& u, int wr, int wc, int fr, int fq) const {
        const int pn = u.pn;
        bf16_t* dst; int ldc, cb, mode;
        if (pn < 4)       { dst = (bf16_t*)(ws + WS_U);   ldc = 1024; cb = pn * 256;        mode = 0; }
        else if (pn < 8)  { dst = (bf16_t*)(ws + WS_GP);  ldc = 1024; cb = (pn - 4) * 256;  mode = 1; }
        else if (pn < 16) { dst = (bf16_t*)(ws + WS_Q);   ldc = 2048; cb = (pn - 8) * 256;  mode = 3; }
        else if (pn < 28) { const int k = (pn - 16) >> 1; dst = (bf16_t*)(ws + WS_KCR + (size_t)k * (8 * MiB)); ldc = 512; cb = ((pn - 16) & 1) * 256; mode = (k == 2 || k == 4) ? 3 : 0; }
        else if (pn < 36) { dst = (bf16_t*)(ws + WS_GN);  ldc = 2048; cb = (pn - 28) * 256; mode = 1; }
        else if (pn < 52) { dst = gm;                     ldc = 4096; cb = (pn - 36) * 256; mode = 2; }
        else              { dst = (bf16_t*)(ws + WS_GBR); ldc = 256;  cb = 0;               mode = 4; }
        const int row0 = u.pm * 256 + wr * 64 + fr, cl = wc * 32 + 8 * fq, col0 = cb + cl;
        const float* rcos = (const float*)(ws + WS_ROPE); const float* rsin = rcos + (size_t)S * 64;
#pragma unroll
        for (int ai = 0; ai < 2; ++ai)
#pragma unroll
            for (int m = 0; m < 4; ++m) {
                const int row = row0 + ai * 128 + m * 16;
                bf16_t* rowp = dst + (size_t)row * ldc + col0;
                f32x4 cs0, cs1, sn0, sn1;
                if (mode == 3) { const int i0 = (cl & 127) >> 1; cs0 = *(const f32x4*)(rcos + (size_t)row * 64 + i0); sn0 = *(const f32x4*)(rsin + (size_t)row * 64 + i0); }
#pragma unroll
                for (int bj = 0; bj < 2; ++bj) {
                    f32x4 v0 = acc[ai][bj][m][0], v1 = acc[ai][bj][m][1];
                    if (mode == 1) { for (int e = 0; e < 4; ++e) { v0[e] = siluf_(v0[e]); v1[e] = siluf_(v1[e]); } }
                    else if (mode == 2 || mode == 4) { if (mode == 2) { v0 = v0 + *(const f32x4*)(bmerge + col0 + bj * 128); v1 = v1 + *(const f32x4*)(bmerge + col0 + bj * 128 + 4); } for (int e = 0; e < 4; ++e) { v0[e] = sigmoidf_(v0[e]); v1[e] = sigmoidf_(v1[e]); } }
                    else if (mode == 3) {
                        f32x4 o0, o1;
                        o0[0] = v0[0] * cs0[0] - v0[1] * sn0[0]; o0[1] = v0[1] * cs0[0] + v0[0] * sn0[0];
                        o0[2] = v0[2] * cs0[1] - v0[3] * sn0[1]; o0[3] = v0[3] * cs0[1] + v0[2] * sn0[1];
                        o1[0] = v1[0] * cs0[2] - v1[1] * sn0[2]; o1[1] = v1[1] * cs0[2] + v1[0] * sn0[2];
                        o1[2] = v1[2] * cs0[3] - v1[3] * sn0[3]; o1[3] = v1[3] * cs0[3] + v1[2] * sn0[3];
                        v0 = o0; v1 = o1;
                    }
                    *(u32x4*)(rowp + bj * 128) = pack8(v0, v1);
                }
            }
    }
};
struct EpiYa {
    bf16_t* yag; const bf16_t* gm;
    __device__ __forceinline__ void operator()(const Acc& acc, const pg8::Unit& u, int wr, int wc, int fr, int fq) const {
        const int row0 = u.pm * 256 + wr * 64 + fr, col0 = u.pn * 256 + wc * 32 + 8 * fq;
#pragma unroll
        for (int ai = 0; ai < 2; ++ai)
#pragma unroll
            for (int m = 0; m < 4; ++m) { const size_t r = (size_t)(row0 + ai * 128 + m * 16);
#pragma unroll
                for (int bj = 0; bj < 2; ++bj) { f32x4 g0, g1; unpack8(*(const u32x4*)(gm + r * 4096 + col0 + bj * 128), g0, g1);
                    *(u32x4*)(yag + r * 2048 + col0 + bj * 128) = pack8(acc[ai][bj][m][0] * g0, acc[ai][bj][m][1] * g1); } }
    }
};
struct EpiYb {
    bf16_t* merged; const bf16_t* yag; const bf16_t* gm;
    __device__ __forceinline__ void operator()(const Acc& acc, const pg8::Unit& u, int wr, int wc, int fr, int fq) const {
        const int row0 = u.pm * 256 + wr * 64 + fr, col0 = u.pn * 256 + wc * 32 + 8 * fq;
#pragma unroll
        for (int ai = 0; ai < 2; ++ai)
#pragma unroll
            for (int m = 0; m < 4; ++m) { const size_t r = (size_t)(row0 + ai * 128 + m * 16);
#pragma unroll
                for (int bj = 0; bj < 2; ++bj) { f32x4 g0, g1, y0, y1; unpack8(*(const u32x4*)(gm + r * 4096 + 2048 + col0 + bj * 128), g0, g1);
                    unpack8(*(const u32x4*)(yag + r * 2048 + col0 + bj * 128), y0, y1);
                    *(u32x4*)(merged + r * 2048 + col0 + bj * 128) = pack8(y0 + acc[ai][bj][m][0] * g0, y1 + acc[ai][bj][m][1] * g1); } }
    }
};
constexpr int NSPLIT = 8;
struct EpiSlab {
    float* slab;
    __device__ __forceinline__ void operator()(const Acc& acc, const pg8::Unit& u, int wr, int wc, int fr, int fq) const {
        float* base = slab + ((size_t)((u.pm >> 3) * NSPLIT + u.pn) * 2048 + (size_t)(u.pm & 7) * 256 + wr * 64 + fr) * 256 + wc * 32 + 8 * fq;
#pragma unroll
        for (int ai = 0; ai < 2; ++ai)
#pragma unroll
            for (int m = 0; m < 4; ++m)
#pragma unroll
                for (int bj = 0; bj < 2; ++bj) { float* p = base + (size_t)(ai * 128 + m * 16) * 256 + bj * 128; *(f32x4*)p = acc[ai][bj][m][0]; *(f32x4*)(p + 4) = acc[ai][bj][m][1]; }
    }
};
struct EpiOut {
    float* out; const float* x; float* ssq;
    __device__ __forceinline__ void operator()(const Acc& acc, const pg8::Unit& u, int wr, int wc, int fr, int fq) const {
        const int row0 = u.pm * 256 + wr * 64 + fr, col0 = u.pn * 256 + wc * 32 + 8 * fq;
#pragma unroll
        for (int ai = 0; ai < 2; ++ai)
#pragma unroll
            for (int m = 0; m < 4; ++m) { const size_t r = (size_t)(row0 + ai * 128 + m * 16); float q = 0.f;
#pragma unroll
                for (int bj = 0; bj < 2; ++bj)
#pragma unroll
                    for (int n = 0; n < 2; ++n) { const size_t o = r * 2048 + col0 + bj * 128 + 4 * n; const f32x4 v = *(const f32x4*)(x + o) + acc[ai][bj][m][n];
                        *(f32x4*)(out + o) = v; q += (v[0] * v[0] + v[1] * v[1]) + (v[2] * v[2] + v[3] * v[3]); }
                q += __shfl_xor(q, 16); q += __shfl_xor(q, 32);
                if (fq == 0) ssq[(size_t)(u.pn * 4 + wc) * S + r] = q; }
    }
};

struct Args { const float* in[17]; float* out; unsigned char* ws; int ph_lo, ph_hi; };
struct Frame { LAS unsigned char* lds; int tid, lane, wave, vcu, G; };

__device__ __forceinline__ int ropeperm(int d) { return d < 64 ? 2 * d : 2 * (d - 64) + 1; }
__device__ __forceinline__ void transpose_item(const float* W, int ldw, int Nvalid, bf16_t* WT, int ldt, int row_off, bool perm, LAS float* scr, int kb, int nb, int lane) {
    const int k0 = 64 * kb, n0 = 32 * nb, cq = lane & 7, rb = lane >> 3; const bool ok = n0 + cq * 4 < Nvalid;
    f32x4 v[8];
#pragma unroll
    for (int i = 0; i < 8; ++i) v[i] = ok ? *(const f32x4*)(W + (size_t)(k0 + i * 8 + rb) * ldw + n0 + cq * 4) : (f32x4){0.f, 0.f, 0.f, 0.f};
#pragma unroll
    for (int i = 0; i < 8; ++i) *(LAS f32x4*)(scr + (i * 8 + rb) * 32 + ((cq ^ i) << 2)) = v[i];
    LDS_WAIT(); asm volatile("" ::: "memory");
#pragma unroll
    for (int j = 0; j < 4; ++j) { const int idx = lane + 64 * j, n = idx >> 3, c = idx & 7; const LAS float* s = scr + (8 * c) * 32 + ((((n >> 2) ^ c) << 2) | (n & 3));
        u32x4 o; o.x = cvtpk(s[0 * 32], s[1 * 32]); o.y = cvtpk(s[2 * 32], s[3 * 32]); o.z = cvtpk(s[4 * 32], s[5 * 32]); o.w = cvtpk(s[6 * 32], s[7 * 32]);
        const int ng = n0 + n;
        if (ng < Nvalid) { const int dr = perm ? ((ng & ~127) | ropeperm(ng & 127)) : ng; *(GAS u32x4*)(WT + (size_t)(row_off + dr) * ldt + k0 + 8 * c) = o; } }
    LDS_WAIT(); asm volatile("" ::: "memory");
}

__device__ __forceinline__ void p0_prologue(const Frame& F, const Args& a) {
    unsigned char* ws = a.ws;
    LAS float* scr = (LAS float*)(F.lds + F.wave * 8192);
    const int gw = F.vcu * NWAVES + F.wave, NGW = F.G * NWAVES, lane = F.lane;
    constexpr int I_WIN = 32 * 258, I_WM = 32 * 128;
    for (int it = gw; it < I_WIN + I_WM; it += NGW) {
        int r = it;
        if (r < I_WIN) { const int kb = r / 258, nb = 32 + r % 258, n0 = nb * 32;
            const bool perm = (n0 >= 2048 && n0 < 4096) || (n0 >= 5120 && n0 < 5632) || (n0 >= 6144 && n0 < 6656);
            transpose_item(a.in[2], 9264, 9264, (bf16_t*)(ws + WS_WCAT), 2048, nb >= 288 ? 4096 : 0, perm, scr, kb, nb, lane); continue; } r -= I_WIN;
        transpose_item(a.in[13], 4096, 4096, (bf16_t*)(ws + WS_WCAT), 2048, 9216, false, scr, r / 128, r % 128, lane);
    }
    {
        const float* win = a.in[2]; const float* mix = a.in[3]; bf16_t* WC = (bf16_t*)(ws + WS_WCAT); const int r = lane & 31, hh = lane >> 5;
        for (int it = gw; it < 1024; it += NGW) {
            const int g = it >> 8, d0 = ((it >> 5) & 7) * 32, kin0 = (it & 31) * 64;
            f32x16 acc0 = f32x16{}, acc1 = f32x16{};
            const float* ap = mix + (size_t)g * 65536 + (size_t)(8 * hh) * 256 + d0 + r;
            const float* bp0 = win + (size_t)(kin0 + r) * 9264 + g * 256 + 8 * hh; const float* bp1 = bp0 + (size_t)32 * 9264;
#pragma unroll 4
            for (int k = 0; k < 16; ++k) {
                f32x4 a0, a1;
#pragma unroll
                for (int j = 0; j < 4; ++j) { a0[j] = ap[(size_t)(k * 16 + j) * 256]; a1[j] = ap[(size_t)(k * 16 + 4 + j) * 256]; }
                const u32x4 af = pack8(a0, a1), b0 = pack8(*(const f32x4*)(bp0 + k * 16), *(const f32x4*)(bp0 + k * 16 + 4)), b1 = pack8(*(const f32x4*)(bp1 + k * 16), *(const f32x4*)(bp1 + k * 16 + 4));
                acc0 = __builtin_amdgcn_mfma_f32_32x32x16_bf16(__builtin_bit_cast(bf16x8, af), __builtin_bit_cast(bf16x8, b0), acc0, 0, 0, 0);
                acc1 = __builtin_amdgcn_mfma_f32_32x32x16_bf16(__builtin_bit_cast(bf16x8, af), __builtin_bit_cast(bf16x8, b1), acc1, 0, 0, 0);
            }
#pragma unroll
            for (int e = 0; e < 16; ++e) { int ee = e; asm volatile("" : "+v"(ee)); bf16_t* rowp = WC + (size_t)(g * 256 + d0 + crow(ee, hh)) * 2048 + kin0 + r;
                const float v0 = acc0[e], v1 = acc1[e], n0_ = __shfl_xor(v0, 1), n1_ = __shfl_xor(v1, 1);
                if ((r & 1) == 0) { *(unsigned*)rowp = cvtpk(v0, n0_); *(unsigned*)(rowp + 32) = cvtpk(v1, n1_); } }
        }
    }
    for (int i = gw * 64 + lane; i < 53248; i += NGW * 64) *(GAS u32x4*)(ws + WS_WCAT + (size_t)13360 * 4096 + (size_t)i * 16) = (u32x4){0u, 0u, 0u, 0u};
    {
        const float* x = a.in[0]; const float* nw = a.in[1]; bf16_t* H = (bf16_t*)(ws + WS_H);
        f32x4 wv[8];
#pragma unroll
        for (int j = 0; j < 8; ++j) wv[j] = *((const f32x4*)nw + lane + 64 * j);
        for (int m = gw; m < S; m += NGW) {
            const f32x4* xr = (const f32x4*)(x + (size_t)m * DM) + lane; f32x4 v[8]; float s = 0.f;
#pragma unroll
            for (int j = 0; j < 8; ++j) { v[j] = xr[64 * j]; s += (v[j][0] * v[j][0] + v[j][1] * v[j][1]) + (v[j][2] * v[j][2] + v[j][3] * v[j][3]); }
            const float rstd = 1.0f / sqrtf(wave_sum(s) * (1.f / DM) + EPS);
            u32x2* o = (u32x2*)(H + (size_t)m * DM) + lane;
#pragma unroll
            for (int j = 0; j < 8; ++j) { const f32x4 y = v[j] * rstd * wv[j]; u32x2 w; w.x = cvtpk(y[0], y[1]); w.y = cvtpk(y[2], y[3]); o[64 * j] = w; }
        }
    }
    {
        float* rcos = (float*)(ws + WS_ROPE); float* rsin = rcos + (size_t)S * 64;
        for (int e = gw * 64 + lane; e < S * 64; e += NGW * 64) {
            const int pos = e >> 6, i = e & 63;
            double inv = 1.0, b = 0.86596432336006535;
            for (int k = i; k; k >>= 1) { if (k & 1) inv *= b; b *= b; }
            const double t = (double)pos * inv * 0.15915494309189535;
            const float fr = (float)(t - floor(t));
            rcos[e] = __builtin_amdgcn_cosf(fr); rsin[e] = __builtin_amdgcn_sinf(fr);
        }
    }
}
__device__ __forceinline__ void p1_late_weights(const Frame& F, const Args& a, int cw, int NCW) {
    unsigned char* ws = a.ws;
    LAS float* scr = (LAS float*)(F.lds + F.wave * 8192);
    const int lane = F.lane;
    constexpr int I_NO = 32 * 64, I_O = 32 * 64, I_PO = 16 * 64, I_W1 = 64 * 8, I_W2 = 4 * 4, I_B1 = 512;
    constexpr int NITEMS = I_NO + I_O + I_PO + 2 * I_W1 + 2 * I_W2 + I_B1;
    for (int it = cw; it < NITEMS; it += NCW) {
        int r = it;
        if (r < I_W1) { transpose_item(a.in[6], 256, 256, (bf16_t*)(ws + WS_W1KT), 4096, 0, false, scr, r / 8, r % 8, lane); continue; } r -= I_W1;
        if (r < I_W1) { transpose_item(a.in[9], 256, 256, (bf16_t*)(ws + WS_W1VT), 4096, 0, false, scr, r / 8, r % 8, lane); continue; } r -= I_W1;
        if (r < I_B1) {
            const int which = r >> 8, fb = (r >> 6) & 3, ch = r & 63, f = fb * 64 + lane;
            const float* pe = a.in[which ? 8 : 5]; const float* w1 = a.in[which ? 9 : 6]; float s = 0.f;
#pragma unroll 16
            for (int k = ch * 64; k < ch * 64 + 64; ++k) s += pe[k] * w1[(size_t)k * 256 + f];
            ((float*)(ws + WS_B1P))[(which * 64 + ch) * 256 + f] = s; continue; } r -= I_B1;
        if (r < I_W2) { transpose_item(a.in[7], 128, 128, (bf16_t*)(ws + WS_W2KT), 256, 0, true, scr, r / 4, r % 4, lane); continue; } r -= I_W2;
        if (r < I_W2) { transpose_item(a.in[10], 128, 128, (bf16_t*)(ws + WS_W2VT), 256, 0, false, scr, r / 4, r % 4, lane); continue; } r -= I_W2;
        if (r < I_PO) { transpose_item(a.in[11], 2048, 2048, (bf16_t*)(ws + WS_WPOT), 1024, 0, false, scr, r / 64, r % 64, lane); continue; } r -= I_PO;
        if (r < I_NO) { transpose_item(a.in[12], 2048, 2048, (bf16_t*)(ws + WS_WNOT), 2048, 0, false, scr, r / 64, r % 64, lane); continue; } r -= I_NO;
        transpose_item(a.in[15], 2048, 2048, (bf16_t*)(ws + WS_WOT), 2048, 0, false, scr, r / 64, r % 64, lane);
    }
}

__device__ __forceinline__ void p2_ypool(const Frame& F, unsigned char* ws, const float* scale, int ct, int NCT) {
    const bf16_t* U = (const bf16_t*)(ws + WS_U); const bf16_t* GP = (const bf16_t*)(ws + WS_GP); bf16_t* Y = (bf16_t*)(ws + WS_H + 16 * MiB);
    for (int it = ct; it < (S / 16) * 128; it += NCT) {
        const int c = (it & 127) * 8, t0 = (it >> 7) * 16, w = 2 << (c >> 8);
        const f32x4 sc0 = *(const f32x4*)(scale + c), sc1 = *(const f32x4*)(scale + c + 4);
        f32x4 s0 = {0.f, 0.f, 0.f, 0.f}, s1 = s0, a0, a1;
        for (int i = 1; i < w; ++i) if (t0 - i >= 0) { unpack8(*(const u32x4*)(U + (size_t)(t0 - i) * 1024 + c), a0, a1); s0 = s0 + a0; s1 = s1 + a1; }
#pragma unroll 4
        for (int t = t0; t < t0 + 16; ++t) {
            unpack8(*(const u32x4*)(U + (size_t)t * 1024 + c), a0, a1); s0 = s0 + a0; s1 = s1 + a1;
            const int cnt = (t + 1 < w) ? t + 1 : w; const float ic = 1.0f / (float)cnt;
            f32x4 g0, g1; unpack8(*(const u32x4*)(GP + (size_t)t * 1024 + c), g0, g1);
            *(u32x4*)(Y + (size_t)t * 1024 + c) = pack8((s0 * ic - a0) * sc0 * g0, (s1 * ic - a1) * sc1 * g1);
            if (t - w + 1 >= 0) { f32x4 b0, b1; unpack8(*(const u32x4*)(U + (size_t)(t - w + 1) * 1024 + c), b0, b1); s0 = s0 - b0; s1 = s1 - b1; }
        }
    }
}
__device__ __forceinline__ void p8_norm(const Frame& F, const Args& a) {
    const float* ssq = (const float*)(a.ws + WS_SSQ); const float* fw = a.in[16]; float* out = a.out;
    const int gw = F.vcu * NWAVES + F.wave, NGW = F.G * NWAVES, lane = F.lane;
    f32x4 wv[8];
#pragma unroll
    for (int j = 0; j < 8; ++j) wv[j] = *((const f32x4*)fw + lane + 64 * j);
    for (int m = gw; m < S; m += NGW) {
        float q = (lane < 32) ? ssq[(size_t)lane * S + m] : 0.f;
        q = wave_sum(q);
        const float rstd = 1.0f / sqrtf(q * (1.f / DM) + EPS);
        f32x4* o = (f32x4*)(out + (size_t)m * DM) + lane;
#pragma unroll
        for (int j = 0; j < 8; ++j) o[64 * j] = o[64 * j] * rstd * wv[j];
    }
}


__device__ __forceinline__ void p3_compress2(const Frame& F, unsigned char* ws, int cwg, int NCWG) {
    const int tid = F.tid, lane = F.lane, r = lane & 31, hh = lane >> 5, wave = F.wave;
    const float* rcos = (const float*)(ws + WS_ROPE); const float* rsin = rcos + (size_t)S * 64;
    LAS bf16_t* hl = (LAS bf16_t*)F.lds;
    for (int it = cwg; it < 128; it += NCWG) {
        const int which = it >> 6, rt = it & 63;
        { const int row = tid >> 4, f0 = (tid & 15) * 16;
          const float* sl = (const float*)(ws + WS_SLAB) + ((size_t)(which * NSPLIT) * 2048 + rt * 32 + row) * 256 + f0; const float* b1 = (const float*)(ws + WS_B1) + which * 256 + f0;
          f32x4 s[4];
#pragma unroll
          for (int q = 0; q < 4; ++q) s[q] = *(const f32x4*)(b1 + 4 * q);
#pragma unroll
          for (int ks = 0; ks < NSPLIT; ++ks)
#pragma unroll
              for (int q = 0; q < 4; ++q) s[q] = s[q] + *(const f32x4*)(sl + (size_t)ks * 2048 * 256 + 4 * q);
#pragma unroll
          for (int q = 0; q < 4; ++q)
#pragma unroll
              for (int e = 0; e < 4; ++e) s[q][e] = siluf_(s[q][e]);
          *(LAS u32x4*)(hl + row * 264 + f0) = pack8(s[0], s[1]); *(LAS u32x4*)(hl + row * 264 + f0 + 8) = pack8(s[2], s[3]); }
        __syncthreads();
        if (wave < 4) {
            const int ct = wave, row = rt * 32 + r;
            const bf16_t* W2 = (const bf16_t*)(ws + (which ? WS_W2VT : WS_W2KT)) + (size_t)(ct * 32 + r) * 256 + hh * 8;
            f32x16 acc = f32x16{};
#pragma unroll 4
            for (int k = 0; k < 16; ++k) acc = __builtin_amdgcn_mfma_f32_32x32x16_bf16(*(const bf16x8*)(W2 + k * 16), *(const LAS bf16x8*)(hl + r * 264 + k * 16 + hh * 8), acc, 0, 0, 0);
            const int n = row & 511; bf16_t* dst = (bf16_t*)(ws + (which ? WS_VC : WS_KC)) + (size_t)row * 128 + ct * 32 + 4 * hh;
            const int pos = (16 * n + 31) > S - 1 ? S - 1 : 16 * n + 31;
#pragma unroll
            for (int gq = 0; gq < 4; ++gq) {
                float v0 = acc[4 * gq], v1 = acc[4 * gq + 1], v2 = acc[4 * gq + 2], v3 = acc[4 * gq + 3];
                if (which == 0) { const int i = (ct * 32 + 8 * gq + 4 * hh) >> 1; const float c0 = rcos[(size_t)pos * 64 + i], s0 = rsin[(size_t)pos * 64 + i], c1 = rcos[(size_t)pos * 64 + i + 1], s1 = rsin[(size_t)pos * 64 + i + 1];
                    const float o0 = v0 * c0 - v1 * s0, o1 = v1 * c0 + v0 * s0, o2 = v2 * c1 - v3 * s1, o3 = v3 * c1 + v2 * s1; v0 = o0; v1 = o1; v2 = o2; v3 = o3; }
                u32x2 w; w.x = cvtpk(v0, v1); w.y = cvtpk(v2, v3); if (n == 511) { w.x = 0u; w.y = 0u; }
                *(u32x2*)(dst + 8 * gq) = w;
            }
        }
        __syncthreads();
    }
}

namespace nsa {
constexpr int SHM_V = 16384, SHM_K = 16384;
constexpr int L_V = 0, L_K = 2 * SHM_V, L_WS = L_K + 2 * SHM_K, L_IMP = L_WS + NWAVES * 64 * 4, IMP_LD = 129, L_SELM = L_IMP + 64 * IMP_LD * 4, L_END = L_SELM + 64 * 8 * 2;
static_assert(L_END <= RING_BYTES, "attention LDS");
constexpr float SCALE = 0.08838834764831845f, C2 = 1.4426950408889634f * SCALE, THR = 8.f;
#define KSWZ(row, colB) ((row) * 256 + ((colB) ^ (((row) & 7) << 4)))
#define SBAR() __builtin_amdgcn_sched_barrier(0)
#define LADD(p, v) (void)__hip_atomic_fetch_add((p), (v), __ATOMIC_RELAXED, __HIP_MEMORY_SCOPE_WORKGROUP)
__device__ __forceinline__ int v_st(int k, int c) { const int kk = (k & ~0xC) | ((k & 4) << 1) | ((k & 8) >> 1); return ((kk >> 3) * 4 + (c >> 5)) * 512 + ((kk & 7) * 32 + (c & 31)) * 2; }
__device__ __forceinline__ int v_rd_base(int lane) { return ((lane & 3) << 3) | (((lane >> 2) & 3) << 6) | (((lane >> 4) & 1) << 5) | (((lane >> 5) & 1) << 8); }
constexpr int v_rd_off(int d0, int ks, int half) { return d0 * 512 + ks * 4096 + half * 2048; }
__device__ __forceinline__ unsigned cvtpk_a(float lo, float hi) { unsigned r; asm volatile("v_cvt_pk_bf16_f32 %0, %1, %2" : "=v"(r) : "v"(lo), "v"(hi)); return r; }

__device__ __forceinline__ void mask_range(f32x16& p0, f32x16& p1, int dq, unsigned Wn) {
    const float NEG = -__builtin_inff();
#pragma unroll
    for (int r = 0; r < 16; ++r) { const int c = (r & 3) + 8 * (r >> 2);
        if ((unsigned)(dq + c) >= Wn) p0[r] = NEG;
        if ((unsigned)(dq + c + 32) >= Wn) p1[r] = NEG; }
}
__device__ __forceinline__ void mask_row(f32x16& p0, f32x16& p1, bool keep) {
    const float NEG = -__builtin_inff();
#pragma unroll
    for (int r = 0; r < 16; ++r) { p0[r] = keep ? p0[r] : NEG; p1[r] = keep ? p1[r] : NEG; }
}
__device__ __forceinline__ float rowmax32(const f32x16& p0, const f32x16& p1) {
    float pmax = p0[0];
#pragma unroll
    for (int r = 1; r < 16; ++r) pmax = fmaxf(pmax, p0[r]);
#pragma unroll
    for (int r = 0; r < 16; ++r) pmax = fmaxf(pmax, p1[r]);
    auto rr = __builtin_amdgcn_permlane32_swap(__float_as_uint(pmax), __float_as_uint(pmax), false, false);
    return fmaxf(__uint_as_float(rr[0]), __uint_as_float(rr[1]));
}
__device__ __forceinline__ float rowsum32(const f32x16& p0, const f32x16& p1) {
    float ps = 0.f;
#pragma unroll
    for (int r = 0; r < 16; ++r) ps += p0[r];
#pragma unroll
    for (int r = 0; r < 16; ++r) ps += p1[r];
    auto rr = __builtin_amdgcn_permlane32_swap(__float_as_uint(ps), __float_as_uint(ps), false, false);
    return __uint_as_float(rr[0]) + __uint_as_float(rr[1]);
}
__device__ __forceinline__ void pack_p(const f32x16& p0, const f32x16& p1, bf16x8& pa0, bf16x8& pa1, bf16x8& pa2, bf16x8& pa3) {
#define PK4(P, B_, OUT) do { unsigned a0 = cvtpk_a(P[B_+0], P[B_+1]), a1 = cvtpk_a(P[B_+2], P[B_+3]);                          \
        unsigned b0 = cvtpk_a(P[B_+4], P[B_+5]), b1 = cvtpk_a(P[B_+6], P[B_+7]);                                             \
        auto r0 = __builtin_amdgcn_permlane32_swap(a0, b0, false, false); auto r1 = __builtin_amdgcn_permlane32_swap(a1, b1, false, false); \
        u32x4 w = {r0[0], r1[0], r0[1], r1[1]}; OUT = __builtin_bit_cast(bf16x8, w); } while (0)
    PK4(p0, 0, pa0); PK4(p0, 8, pa1); PK4(p1, 0, pa2); PK4(p1, 8, pa3);
#undef PK4
}
template <int KB>
__device__ __forceinline__ void qkt(f32x16& p0, f32x16& p1, const LAS unsigned char* K_lds, int r32, int hi, const bf16x8* qr) {
    p0 = f32x16{}; p1 = f32x16{};
    const LAS unsigned char* kb[4];
#pragma unroll
    for (int dd = 0; dd < 4; ++dd) kb[dd] = K_lds + KB * SHM_K + KSWZ(r32, (dd * 16 + hi * 8) * 2);
#pragma unroll
    for (int d0 = 0; d0 < 8; ++d0) { const LAS unsigned char* a = kb[d0 & 3] + (d0 >> 2) * 128;
        const bf16x8 b0 = *(const LAS bf16x8*)(a);
        const bf16x8 b1 = *(const LAS bf16x8*)(a + 32 * 256);
        p0 = __builtin_amdgcn_mfma_f32_32x32x16_bf16(b0, qr[d0], p0, 0, 0, 0);
        p1 = __builtin_amdgcn_mfma_f32_32x32x16_bf16(b1, qr[d0], p1, 0, 0, 0);
        if (d0 == 3) SBAR(); }
}
template <int VB>
__device__ __forceinline__ void pv_tile(f32x16* o, int vb0, bf16x8 pa0, bf16x8 pa1, bf16x8 pa2, bf16x8 pa3) {
#define TRRD(dst, off) asm volatile("ds_read_b64_tr_b16 %0, %1 offset:%2" : "=&v"(dst) : "v"(vb0), "i"(off) : "memory")
#define PV_D0(d0) do { s16x4 l0, l1, l2, l3, h0, h1, h2, h3; constexpr int b_ = VB * SHM_V + v_rd_off(d0, 0, 0); \
        TRRD(l0, b_); TRRD(h0, b_ + 2048); TRRD(l1, b_ + 4096); TRRD(h1, b_ + 6144); TRRD(l2, b_ + 8192); TRRD(h2, b_ + 10240); TRRD(l3, b_ + 12288); TRRD(h3, b_ + 14336); \
        asm volatile("s_waitcnt lgkmcnt(0)" ::: "memory"); SBAR();   \
        o[d0] = __builtin_amdgcn_mfma_f32_32x32x16_bf16(pa0, (bf16x8){l0[0], l0[1], l0[2], l0[3], h0[0], h0[1], h0[2], h0[3]}, o[d0], 0, 0, 0);   \
        o[d0] = __builtin_amdgcn_mfma_f32_32x32x16_bf16(pa1, (bf16x8){l1[0], l1[1], l1[2], l1[3], h1[0], h1[1], h1[2], h1[3]}, o[d0], 0, 0, 0);   \
        o[d0] = __builtin_amdgcn_mfma_f32_32x32x16_bf16(pa2, (bf16x8){l2[0], l2[1], l2[2], l2[3], h2[0], h2[1], h2[2], h2[3]}, o[d0], 0, 0, 0);   \
        o[d0] = __builtin_amdgcn_mfma_f32_32x32x16_bf16(pa3, (bf16x8){l3[0], l3[1], l3[2], l3[3], h3[0], h3[1], h3[2], h3[3]}, o[d0], 0, 0, 0); } while (0)
    PV_D0(0); PV_D0(1); PV_D0(2); PV_D0(3);
#undef PV_D0
#undef TRRD
}

enum { M_C1 = 0, M_C2 = 1, M_S = 2, M_W = 3 };
struct RowState { float m, l; };
template <int MODE>
__device__ __forceinline__ void attn_pass(LAS unsigned char* lds, const bf16_t* Kp, const bf16_t* Vp, int ld, int j_lo, int j_hi, const bf16x8* qr, int t, int Tq, const u32x4 sel,
                                          RowState& st, float invl, f32x16* o, bool do_imp) {
    constexpr bool HASV = MODE != M_C1;
    const int tid = otid(), wid = __builtin_amdgcn_readfirstlane(tid >> 6), lane = tid & 63, r32 = lane & 31, hi = lane >> 5;
    LAS unsigned char* V_lds = lds + L_V; LAS unsigned char* K_lds = lds + L_K;
    LAS float* wsf = (LAS float*)(lds + L_WS) + wid * 64; LAS float* al_l = wsf + 32;
    const int sr = tid >> 4, sc = (tid & 15) * 8, vst0 = v_st(sr, sc), vst1 = v_st(32 + sr, sc), kws = KSWZ(sr, sc * 2);
    const int vb0 = (int)(uintptr_t)V_lds + v_rd_base(lane);
    const int NT = j_hi - j_lo;
    bf16x8 st_k0, st_k1, st_v0, st_v1;
    float m_reg = st.m, l_reg = st.l;
#define SLOAD(j) do { const size_t k0_ = (size_t)(j) * 64; st_k0 = *(const bf16x8*)(Kp + (k0_ + sr) * ld + sc); st_k1 = *(const bf16x8*)(Kp + (k0_ + 32 + sr) * ld + sc); \
        if (HASV) { st_v0 = *(const bf16x8*)(Vp + (k0_ + sr) * ld + sc); st_v1 = *(const bf16x8*)(Vp + (k0_ + 32 + sr) * ld + sc); } } while (0)
#define SWRITE(bf) do { *(LAS bf16x8*)(K_lds + (bf) * SHM_K + kws) = st_k0; *(LAS bf16x8*)(K_lds + (bf) * SHM_K + kws + 32 * 256) = st_k1; \
        if (HASV) { *(LAS bf16x8*)(V_lds + (bf) * SHM_V + vst0) = st_v0; *(LAS bf16x8*)(V_lds + (bf) * SHM_V + vst1) = st_v1; } } while (0)
    SLOAD(j_lo); SWRITE(0);
    __syncthreads();
#define STEP(idx, BUF) do { const int j = j_lo + (idx); const int kb = j * 64;                                                          \
        if ((idx) + 1 < NT) SLOAD(j + 1);                                                                                              \
        f32x16 p0, p1; qkt<BUF>(p0, p1, K_lds, r32, hi, qr);                                                                           \
        if (MODE == M_C1 || MODE == M_C2) { const int nmax1 = ((t - 31) >> 4) + 1; mask_range(p0, p1, kb + 4 * hi, (unsigned)(nmax1 > 0 ? nmax1 : 0)); } \
        else if (MODE == M_S) { if (j == Tq) mask_range(p0, p1, kb + 4 * hi, (unsigned)(t + 1));                                        \
                                else { const unsigned w_ = (j >> 5) == 0 ? sel.x : (j >> 5) == 1 ? sel.y : (j >> 5) == 2 ? sel.z : sel.w; mask_row(p0, p1, ((w_ >> (j & 31)) & 1u) != 0u); } } \
        else { if (j == Tq || j + 8 <= Tq) mask_range(p0, p1, kb + 4 * hi - (t - 511), 512u); }                                          \
        if (MODE == M_C1) { const float pmax = rowmax32(p0, p1); const float mn = fmaxf(m_reg, pmax); const float alpha = __builtin_amdgcn_exp2f((m_reg - mn) * C2); m_reg = mn; \
            const float mnL = -mn * C2;                                                                                                \
            _Pragma("unroll") for (int r = 0; r < 16; ++r) { p0[r] = __builtin_amdgcn_exp2f(fmaf(p0[r], C2, mnL)); p1[r] = __builtin_amdgcn_exp2f(fmaf(p1[r], C2, mnL)); } \
            l_reg = l_reg * alpha + rowsum32(p0, p1); }                                                                                \
        else if (MODE == M_C2) { const float mnL = -m_reg * C2;                                                                        \
            _Pragma("unroll") for (int r = 0; r < 16; ++r) { p0[r] = __builtin_amdgcn_exp2f(fmaf(p0[r], C2, mnL)) * invl; p1[r] = __builtin_amdgcn_exp2f(fmaf(p1[r], C2, mnL)) * invl; } \
            if (do_imp) { LAS unsigned* imp = (LAS unsigned*)(lds + L_IMP) + ((wid & 1) * 32 + r32) * IMP_LD + 16 * j + hi;            \
                _Pragma("unroll") for (int k = 0; k < 4; ++k) {                                                                        \
                    { const float e_ = p0[4 * k + 3], a_ = 2.f * (p0[4 * k] + p0[4 * k + 1] + p0[4 * k + 2]) + e_;                     \
                      LADD(imp + 2 * k, (unsigned)(a_ * 67108864.f + 0.5f)); LADD(imp + 2 * k + 1, (unsigned)(e_ * 67108864.f + 0.5f)); } \
                    { const float e_ = p1[4 * k + 3], a_ = 2.f * (p1[4 * k] + p1[4 * k + 1] + p1[4 * k + 2]) + e_;                     \
                      LADD(imp + 8 + 2 * k, (unsigned)(a_ * 67108864.f + 0.5f)); LADD(imp + 8 + 2 * k + 1, (unsigned)(e_ * 67108864.f + 0.5f)); } } } \
            bf16x8 pa0, pa1, pa2, pa3; pack_p(p0, p1, pa0, pa1, pa2, pa3); SBAR(); pv_tile<BUF>(o, vb0, pa0, pa1, pa2, pa3); }          \
        else { const float pmax = rowmax32(p0, p1); float mn, alpha;                                                                   \
            if (__builtin_expect(__all((pmax - m_reg) * SCALE <= THR), 1)) { mn = m_reg; alpha = 1.f; }                                \
            else { mn = fmaxf(m_reg, pmax); alpha = __builtin_amdgcn_exp2f((m_reg - mn) * C2); m_reg = mn; }                           \
            const float mnL = -mn * C2;                                                                                                \
            _Pragma("unroll") for (int r = 0; r < 16; ++r) { p0[r] = __builtin_amdgcn_exp2f(fmaf(p0[r], C2, mnL)); p1[r] = __builtin_amdgcn_exp2f(fmaf(p1[r], C2, mnL)); } \
            l_reg = l_reg * alpha + rowsum32(p0, p1);                                                                                  \
            bf16x8 pa0, pa1, pa2, pa3; pack_p(p0, p1, pa0, pa1, pa2, pa3);                                                             \
            if (__any(alpha < 1.f)) { if (hi == 0) al_l[r32] = alpha; asm volatile("s_waitcnt lgkmcnt(0)" ::: "memory");               \
                _Pragma("unroll") for (int d_ = 0; d_ < 4; ++d_) _Pragma("unroll") for (int r = 0; r < 16; ++r) o[d_][r] *= al_l[crow(r, hi)]; } \
            SBAR(); pv_tile<BUF>(o, vb0, pa0, pa1, pa2, pa3); }                                                                        \
        if ((idx) + 1 < NT) { SWRITE((BUF) ^ 1); }                                                                                     \
        __syncthreads(); } while (0)
    int idx = 0;
    for (; idx + 1 < NT; idx += 2) { STEP(idx, 0); STEP(idx + 1, 1); }
    if (idx < NT) STEP(idx, 0);
    st.m = m_reg; st.l = l_reg;
#undef STEP
#undef SLOAD
#undef SWRITE
}

template <int MODE>
__device__ __forceinline__ void branch_out(LAS unsigned char* lds, const f32x16* o, float rowscale, bf16_t* onsa_w, const bf16_t* gn_w) {
    const int tid = otid(), wid = __builtin_amdgcn_readfirstlane(tid >> 6), lane = tid & 63, r32 = lane & 31, hi = lane >> 5;
    LAS float* li_l = (LAS float*)(lds + L_WS) + wid * 64;
    if (hi == 0) li_l[r32] = rowscale; asm volatile("s_waitcnt lgkmcnt(0)" ::: "memory");
    float rli[16];
#pragma unroll
    for (int r = 0; r < 16; ++r) rli[r] = li_l[crow(r, hi)];
#pragma unroll
    for (int r = 0; r < 16; ++r) { int rr_ = r; asm volatile("" : "+v"(rr_)); const int orow = crow(rr_, hi);
#pragma unroll
        for (int d0 = 0; d0 < 4; ++d0) { const float v = o[d0][r] * rli[r]; const float vn = __shfl_xor(v, 1);
            if ((r32 & 1) == 0) { unsigned* p = (unsigned*)(onsa_w + (size_t)orow * 2048 + d0 * 32 + r32); float a = v, b = vn;
                if (MODE >= 1) { const unsigned w = *p; a += bflo(w); b += bfhi(w); }
                if (MODE == 2) { const unsigned gw_ = *(const unsigned*)(gn_w + (size_t)orow * 2048 + d0 * 32 + r32); a *= bflo(gw_); b *= bfhi(gw_); }
                *p = cvtpk(a, b); } } }
}

__device__ __forceinline__ void attn_unit(LAS unsigned char* lds, unsigned char* ws, int h, int Tq) {
    const int tid = otid(), wid = __builtin_amdgcn_readfirstlane(tid >> 6), lane = tid & 63, r32 = lane & 31, hi = lane >> 5;
    const int g = wid >> 1, tl = (wid & 1) * 32 + r32, t = Tq * 64 + tl, hq = 4 * h + g;
    const bf16_t* Q = (const bf16_t*)(ws + WS_Q); const bf16_t* GBR = (const bf16_t*)(ws + WS_GBR);
    bf16_t* onsa_w = (bf16_t*)(ws + WS_U) + (size_t)(Tq * 64 + (wid & 1) * 32) * 2048 + hq * 128; const bf16_t* gn_w = (const bf16_t*)(ws + WS_GN) + (size_t)(Tq * 64 + (wid & 1) * 32) * 2048 + hq * 128;
    bf16x8 qr[8];
#pragma unroll
    for (int d0 = 0; d0 < 8; ++d0) qr[d0] = *(const bf16x8*)(Q + (size_t)t * 2048 + hq * 128 + d0 * 16 + hi * 8);
    const float g_c = bf2f(GBR[(size_t)t * 256 + hq * 3 + 0]), g_s = bf2f(GBR[(size_t)t * 256 + hq * 3 + 1]), g_w = bf2f(GBR[(size_t)t * 256 + hq * 3 + 2]);
    const bool big = Tq >= 16;
    LAS unsigned* IMP = (LAS unsigned*)(lds + L_IMP);
    if (big) { for (int i = tid; i < 64 * IMP_LD; i += 512) IMP[i] = 0u; }
    const u32x4 nosel = {0u, 0u, 0u, 0u};
    f32x16 o[4];
    {
        const bf16_t* Kc = (const bf16_t*)(ws + WS_KC) + (size_t)h * 512 * 128; const bf16_t* Vc = (const bf16_t*)(ws + WS_VC) + (size_t)h * 512 * 128;
        const int ntc = ((4 * Tq + 2) >> 6) + 1;
        RowState stc{-1e30f, 0.f};
        attn_pass<M_C1>(lds, Kc, Vc, 128, 0, ntc, qr, t, Tq, nosel, stc, 0.f, o, false);
        const float invl = stc.l > 0.f ? 1.0f / stc.l : 0.f;
#pragma unroll
        for (int d = 0; d < 4; ++d) o[d] = f32x16{};
        attn_pass<M_C2>(lds, Kc, Vc, 128, 0, ntc, qr, t, Tq, nosel, stc, invl, o, big);
        branch_out<0>(lds, o, g_c, onsa_w, gn_w);
    }
    {
        LAS unsigned short* SELM = (LAS unsigned short*)(lds + L_SELM);
        int tok = tid >> 3, sub = tid & 7; asm volatile("" : "+v"(tok), "+v"(sub));
        unsigned bits = 0u;
        if (big) {
            unsigned kv[16];
#pragma unroll
            for (int e = 0; e < 16; ++e) { const int j = sub * 16 + e; const unsigned v = IMP[tok * IMP_LD + j]; kv[e] = (j >= 1 && j <= Tq - 2) ? v + 1u : 0u; }
            for (int round = 0; round < 13; ++round) {
                unsigned bv = kv[0]; int bj = 0;
#pragma unroll
                for (int e = 1; e < 16; ++e) { const bool gt = kv[e] > bv; bv = gt ? kv[e] : bv; bj = gt ? e : bj; }
                bj += sub * 16;
#pragma unroll
                for (int sh = 1; sh < 8; sh <<= 1) { const unsigned ov = __shfl_xor(bv, sh); const int oj = __shfl_xor(bj, sh);
                    const bool take = (ov > bv) || (ov == bv && oj < bj); bv = take ? ov : bv; bj = take ? oj : bj; }
                const int we = (bv != 0u && (bj >> 4) == sub) ? (bj & 15) : -1;
#pragma unroll
                for (int e = 0; e < 16; ++e) { const bool hit = (we == e); bits |= hit ? (1u << e) : 0u; kv[e] = hit ? 0u : kv[e]; }
            }
#pragma unroll
            for (int e = 0; e < 16; ++e) { const int j = sub * 16 + e; if (j == 0 || j == Tq - 1 || j == Tq) bits |= 1u << e; }
        } else {
#pragma unroll
            for (int e = 0; e < 16; ++e) { const int j = sub * 16 + e; if (j <= Tq) bits |= 1u << e; }
        }
        SELM[tok * 8 + sub] = (unsigned short)bits;
        __syncthreads();
    }
    const u32x4 sel = *(const LAS u32x4*)(lds + L_SELM + tl * 16);
    {
        RowState sts{-1e30f, 0.f};
#pragma unroll
        for (int d = 0; d < 4; ++d) o[d] = f32x16{};
        attn_pass<M_S>(lds, (const bf16_t*)(ws + WS_KS) + h * 128, (const bf16_t*)(ws + WS_VS) + h * 128, 512, 0, Tq + 1, qr, t, Tq, sel, sts, 0.f, o, false);
        branch_out<1>(lds, o, sts.l > 0.f ? g_s / sts.l : 0.f, onsa_w, gn_w);
    }
    {
        RowState stw{-1e30f, 0.f};
#pragma unroll
        for (int d = 0; d < 4; ++d) o[d] = f32x16{};
        attn_pass<M_W>(lds, (const bf16_t*)(ws + WS_KW) + h * 128, (const bf16_t*)(ws + WS_VW) + h * 128, 512, Tq >= 8 ? Tq - 8 : 0, Tq + 1, qr, t, Tq, sel, stw, 0.f, o, false);
        branch_out<2>(lds, o, stw.l > 0.f ? g_w / stw.l : 0.f, onsa_w, gn_w);
    }
    __syncthreads();
}
#undef KSWZ
#undef SBAR
}

constexpr int NPHASE = 9;
__global__ void __launch_bounds__(NWAVES * 64, 2) mega_fwd(Args args) {
    extern __shared__ __attribute__((aligned(16))) unsigned char lds[];
    Frame F;
    F.lds = (LAS unsigned char*)lds;
    F.tid = threadIdx.x; F.lane = F.tid & 63; F.wave = __builtin_amdgcn_readfirstlane(F.tid >> 6);
    F.G = gridDim.x; { const int bx = blockIdx.x; F.vcu = (F.G % 8 == 0) ? (bx % 8) * (F.G / 8) + bx / 8 : bx; }
    volatile LAS unsigned* MISC = (volatile LAS unsigned*)(F.lds + MISC_OFF);
    unsigned char* ws = args.ws;
    for (int u = F.tid; u < (LDS_BYTES - LDSCTL_OFF) / 4; u += NWAVES * 64) ((LAS unsigned*)(F.lds + LDSCTL_OFF))[u] = 0u;
    __syncthreads();
    XcdBarrier bar; bar.bar = (unsigned*)(ws + WS_CTL) + CW_BAR; bar.x = 0; bar.st = nullptr;
#if !N_LAUNCHES_PER_PHASE
    bar = xcd_barrier_post((unsigned*)(ws + WS_CTL) + CW_BAR, MISC + 8);
#endif
    const int lo = args.ph_lo, hi = args.ph_hi;
#define IN(k) (lo <= (k) && (k) < hi && (F.tid = otid(), F.lane = F.tid & 63, true))
#define SEAM(k) do { if (IN(k) && IN((k) + 1)) xcd_barrier(bar); } while (0)
    bf16_t* const GM = (bf16_t*)args.out;

    for (int rep_ = 0; rep_ < (DUP_PHASE == 0 ? 2 : 1); ++rep_) if (IN(0)) { if (rep_) xcd_barrier(bar); p0_prologue(F, args); } SEAM(0);
    for (int rep_ = 0; rep_ < (DUP_PHASE == 1 ? 2 : 1); ++rep_) if (IN(1)) { if (rep_) xcd_barrier(bar);
        pg8::Gemm g{(const bf16_t*)(ws + WS_H), (const bf16_t*)(ws + WS_WCAT), 2048, 2048, 2048};
        pg8::StaticOrder So; So.init(S, NCAT, F.G, (int)blockIdx.x);
        EpiInProj E{ws, GM, args.in[14]};
        pg8::AddrAffine AD{(size_t)256 * 2048 * 2, (size_t)256 * 2048 * 2};
        pg8::gemm_phase<EpiInProj, true>(F.lds, g, So, E, AD);
        { const int nun = (So.nwg + F.G - 1) / F.G, full = So.nwg - (nun - 1) * F.G;
          const int base = full < F.G ? full : 0; if ((int)blockIdx.x >= base) p1_late_weights(F, args, ((int)blockIdx.x - base) * NWAVES + F.wave, (F.G - base) * NWAVES); }
    } SEAM(1);
    for (int rep_ = 0; rep_ < (DUP_PHASE == 2 ? 2 : 1); ++rep_) if (IN(2)) { if (rep_) xcd_barrier(bar);
        pg8::Gemm g{(const bf16_t*)(ws + WS_KCR), (const bf16_t*)(ws + WS_W1KT), 8192, 4096, 4096 / NSPLIT};
        pg8::StaticOrder So; So.init(16 * 256, NSPLIT * 256, F.G, (int)blockIdx.x);
        EpiSlab E{(float*)(ws + WS_SLAB)};
        pg8::AddrCmp AD{(4096 / NSPLIT) / 64};
        pg8::gemm_phase<EpiSlab, false>(F.lds, g, So, E, AD);
        { const int base = F.G > So.nwg ? So.nwg : 0; if ((int)blockIdx.x >= base) p2_ypool(F, ws, args.in[4], ((int)blockIdx.x - base) * 512 + F.tid, (F.G - base) * 512); }
        if (blockIdx.x == F.G - 1) { const float* b1p = (const float*)(ws + WS_B1P); float* b1 = (float*)(ws + WS_B1); const int t = F.tid; float s = 0.f;
            for (int c = 0; c < 64; ++c) s += b1p[((t >> 8) * 64 + c) * 256 + (t & 255)];
            b1[t] = s; }
    } SEAM(2);
    for (int rep_ = 0; rep_ < (DUP_PHASE == 3 ? 2 : 1); ++rep_) if (IN(3)) { if (rep_) xcd_barrier(bar);
        p3_compress2(F, ws, (int)blockIdx.x, F.G);
        pg8::Gemm g{(const bf16_t*)(ws + WS_H + 16 * MiB), (const bf16_t*)(ws + WS_WPOT), 1024, 1024, 1024};
        pg8::StaticOrder So; So.init(S, 2048, F.G, (int)blockIdx.x);
        EpiYa E{(bf16_t*)(ws + WS_YAG), GM};
        pg8::AddrAffine AD{(size_t)256 * 1024 * 2, (size_t)256 * 1024 * 2};
        pg8::gemm_phase<EpiYa, false>(F.lds, g, So, E, AD);
    } SEAM(3);
    for (int rep_ = 0; rep_ < (DUP_PHASE == 5 ? 2 : 1); ++rep_) if (IN(5)) { if (rep_) xcd_barrier(bar);
        for (int p = F.vcu; p < 256; p += F.G) {
#pragma unroll 1
            for (int i = 0; i < 2; ++i) { const int h = p >> 6, x = p & 63; nsa::attn_unit(F.lds, ws, h, i ? x : 127 - x); } }
    } SEAM(5);
    for (int rep_ = 0; rep_ < (DUP_PHASE == 6 ? 2 : 1); ++rep_) if (IN(6)) { if (rep_) xcd_barrier(bar);
        pg8::Gemm g{(const bf16_t*)(ws + WS_U), (const bf16_t*)(ws + WS_WNOT), 2048, 2048, 2048}; pg8::AddrAffine AD{(size_t)256 * 2048 * 2, (size_t)256 * 2048 * 2};
        pg8::StaticOrder So; So.init(S, 2048, F.G, (int)blockIdx.x);
        EpiYb E{(bf16_t*)(ws + WS_H), (const bf16_t*)(ws + WS_YAG), GM};
        pg8::gemm_phase<EpiYb, false>(F.lds, g, So, E, AD);
    } SEAM(6);
    for (int rep_ = 0; rep_ < (DUP_PHASE == 7 ? 2 : 1); ++rep_) if (IN(7)) { if (rep_) xcd_barrier(bar);
        pg8::Gemm g{(const bf16_t*)(ws + WS_H), (const bf16_t*)(ws + WS_WOT), 2048, 2048, 2048}; pg8::AddrAffine AD{(size_t)256 * 2048 * 2, (size_t)256 * 2048 * 2};
        pg8::StaticOrder So; So.init(S, 2048, F.G, (int)blockIdx.x);
        EpiOut E{args.out, args.in[0], (float*)(ws + WS_SSQ)};
        pg8::gemm_phase<EpiOut, false>(F.lds, g, So, E, AD);
    } SEAM(7);
    if (IN(8)) { p8_norm(F, args); }
#undef IN
#undef SEAM
}

extern "C" void kernel_launch(void* const* d_in, const int* in_sizes, int n_in, void* d_out, int out_size, void* d_ws, size_t ws_size, hipStream_t stream) {
    static int grid = 0;
    if (grid == 0) {
        if (n_in != 17 || in_sizes[0] != S * DM || out_size != S * DM || ws_size < WS_END) { fprintf(stderr, "kernel_launch: unexpected shapes (n_in %d, in0 %d, out %d, ws %zu); nothing launched\n", n_in, n_in > 0 ? in_sizes[0] : -1, out_size, ws_size); grid = -1; return; }
        int dev = 0, cus = 0;
        if (hipGetDevice(&dev) != hipSuccess || hipDeviceGetAttribute(&cus, hipDeviceAttributeMultiprocessorCount, dev) != hipSuccess) { fprintf(stderr, "kernel_launch: device query failed\n"); grid = -1; return; }
        if (hipFuncSetAttribute((const void*)mega_fwd, hipFuncAttributeMaxDynamicSharedMemorySize, LDS_BYTES) != hipSuccess) { fprintf(stderr, "kernel_launch: hipFuncSetAttribute failed\n"); grid = -1; return; }
        (void)hipGetLastError();
        grid = cus;
    }
    if (grid < 0) return;
    (void)hipMemsetAsync((char*)d_ws + WS_CTL, 0, CTL_BYTES, stream);
    Args a{};
    for (int i = 0; i < 17; ++i) a.in[i] = (const float*)d_in[i];
    a.out = (float*)d_out; a.ws = (unsigned char*)d_ws;
#if N_LAUNCHES_PER_PHASE
    for (int p = 0; p < NPHASE; ++p) { a.ph_lo = p; a.ph_hi = p + 1; hipLaunchKernelGGL(mega_fwd, dim3(grid), dim3(NWAVES * 64), LDS_BYTES, stream, a); }
#else
    a.ph_lo = 0; a.ph_hi = NPHASE;
    hipLaunchKernelGGL(mega_fwd, dim3(grid), dim3(NWAVES * 64), LDS_BYTES, stream, a);
#endif
}
```

```cpp
#include <hip/hip_runtime.h>
#include <cstdio>
#include <cstdint>

#define LAS __attribute__((address_space(3)))
#define GAS __attribute__((address_space(1)))
typedef unsigned short bf16_t;
typedef short bf16x8 __attribute__((ext_vector_type(8)));
typedef short s16x4 __attribute__((ext_vector_type(4)));
typedef float f32x4 __attribute__((ext_vector_type(4)));
typedef float f32x16 __attribute__((ext_vector_type(16)));
typedef unsigned u32x4 __attribute__((ext_vector_type(4)));
typedef unsigned u32x2 __attribute__((ext_vector_type(2)));
typedef float f32x2_t __attribute__((ext_vector_type(2)));
typedef __bf16 bf16x2_t __attribute__((ext_vector_type(2)));

#ifndef EXP_QKT2
#define EXP_QKT2 0
#endif
#ifndef DUP_PHASE
#define DUP_PHASE -1
#endif
#ifndef N_LAUNCHES_PER_PHASE
#define N_LAUNCHES_PER_PHASE 0
#endif

constexpr int S = 8192, DM = 2048, NCAT = 13568;
constexpr int HD = 128, NKV = 4, NCMP = 511;
constexpr float EPS = 1e-6f;

constexpr size_t MiB = 1u << 20;
constexpr size_t WS_CTL = 0, CTL_BYTES = 1 * MiB;
constexpr size_t WS_WCAT = 1 * MiB;
constexpr size_t WS_SLAB = WS_WCAT;
constexpr size_t WS_YAG  = WS_WCAT;
constexpr size_t WS_MIXT = 54 * MiB;
constexpr size_t WS_WPOT = 55 * MiB;
constexpr size_t WS_WNOT = 59 * MiB;
constexpr size_t WS_WOT  = 67 * MiB;
constexpr size_t WS_W1KT = 75 * MiB, WS_W1VT = 77 * MiB;
constexpr size_t WS_W2KT = 79 * MiB, WS_W2VT = 79 * MiB + 65536;
constexpr size_t WS_B1P  = 80 * MiB + 262144;
constexpr size_t WS_B1   = 79 * MiB + 131072 + 32768;
constexpr size_t WS_KC   = 79 * MiB + 262144, WS_VC = 79 * MiB + 786432;
constexpr size_t WS_ROPE = 81 * MiB;
constexpr size_t WS_SSQ  = 85 * MiB;
constexpr size_t WS_H    = 86 * MiB;
constexpr size_t WS_U    = 118 * MiB, WS_GP = 134 * MiB;
constexpr size_t WS_Q    = 150 * MiB;
constexpr size_t WS_KCR  = 182 * MiB, WS_VCR = 190 * MiB, WS_KS = 198 * MiB, WS_VS = 206 * MiB, WS_KW = 214 * MiB, WS_VW = 222 * MiB;
constexpr size_t WS_GN   = 230 * MiB;
constexpr size_t WS_GBR  = 262 * MiB;
constexpr size_t WS_END  = 266 * MiB;
constexpr int CW_BAR = 4096;

constexpr int RING_BYTES = 131072;
constexpr int LDSCTL_OFF = RING_BYTES, MISC_OFF = LDSCTL_OFF + 320;
constexpr int LDS_BYTES = 147456;
constexpr int NWAVES = 8;

#define LDS_WAIT() asm volatile("s_waitcnt lgkmcnt(0)" ::: "memory")
#define VM_WAIT() asm volatile("s_waitcnt vmcnt(0)" ::: "memory")

__device__ __forceinline__ unsigned cvtpk(float lo, float hi) { f32x2_t v = {lo, hi}; bf16x2_t b = __builtin_convertvector(v, bf16x2_t); return __builtin_bit_cast(unsigned, b); }
__device__ __forceinline__ float bf2f(unsigned short h) { return __builtin_bit_cast(float, (unsigned)h << 16); }
__device__ __forceinline__ float bflo(unsigned w) { return __builtin_bit_cast(float, w << 16); }
__device__ __forceinline__ float bfhi(unsigned w) { return __builtin_bit_cast(float, w & 0xffff0000u); }
__device__ __forceinline__ float sigmoidf_(float x) { return __builtin_amdgcn_rcpf(1.0f + __expf(-x)); }
__device__ __forceinline__ float siluf_(float x) { return x * __builtin_amdgcn_rcpf(1.0f + __expf(-x)); }
__device__ __forceinline__ int otid() { int t = threadIdx.x; asm volatile("" : "+v"(t)); return t; }
__device__ __forceinline__ int crow(int r, int hi) { return (r & 3) + 8 * (r >> 2) + 4 * hi; }
__device__ __forceinline__ float wave_sum(float v) {
#pragma unroll
    for (int o = 1; o < 64; o <<= 1) v += __shfl_xor(v, o);
    return v;
}

#define XB_TMO      128
#define XB_XCNT(j)  (256  + 64 * (j))
#define XB_XSUB(j)  (1280 + 64 * (j))
#define XB_XGEN(j)  (2304 + 64 * (j))
#define XB_TOP      3328
#define XB_TOPGEN   3392
#define XCD_BAR_WORDS 3456
#define XB_SPIN_CAP (1u << 18)
__device__ __forceinline__ unsigned xb_ld(unsigned* p)              { return __hip_atomic_load(p, __ATOMIC_RELAXED, __HIP_MEMORY_SCOPE_AGENT); }
__device__ __forceinline__ unsigned xb_add(unsigned* p, unsigned v) { return __hip_atomic_fetch_add(p, v, __ATOMIC_RELAXED, __HIP_MEMORY_SCOPE_AGENT); }
__device__ __forceinline__ unsigned xb_xcc_id() { return (unsigned)__builtin_amdgcn_s_getreg((3 << 11) | 20) & 0xFu; }
#define XB_SPIN(cond, bar) do { unsigned _sp = 0; while (cond) { __builtin_amdgcn_s_sleep(1); \
    if ((++_sp & 255u) == 0u) { if (xb_ld(&(bar)[XB_TMO])) break; if (_sp > XB_SPIN_CAP) { atomicAdd(&(bar)[XB_TMO], 1u); break; } } } } while (0)
struct XcdBarrier { unsigned* bar; unsigned x; volatile LAS unsigned* st; };
__device__ __forceinline__ XcdBarrier xcd_barrier_post(unsigned* bar, volatile LAS unsigned* st) {
    XcdBarrier b; b.bar = bar; b.x = xb_xcc_id(); b.st = st;
    if (threadIdx.x == 0) (void)xb_add(&bar[XB_XCNT(b.x)], 1u);
    return b;
}
__device__ __forceinline__ void xcd_barrier_complete(unsigned* bar, unsigned x, unsigned& nloc, unsigned& nx) {
    const unsigned G = gridDim.x * gridDim.y * gridDim.z;
    unsigned sum, cnt, mine, sp = 0u;
    for (;;) {
        sum = 0u; cnt = 0u; mine = 0u;
#pragma unroll
        for (unsigned j = 0; j < 16; ++j) { const unsigned c = xb_ld(&bar[XB_XCNT(j)]); sum += c; cnt += (c > 0u) ? 1u : 0u; mine = (j == x) ? c : mine; }
        if (sum == G) break;
        __builtin_amdgcn_s_sleep(1);
        if ((++sp & 255u) == 0u) { if (xb_ld(&bar[XB_TMO])) break; if (sp > XB_SPIN_CAP) { atomicAdd(&bar[XB_TMO], 1u); break; } }
    }
    nloc = mine > 0u ? mine : 1u; nx = cnt > 0u ? cnt : 1u;
}
__device__ __forceinline__ void xcd_barrier(const XcdBarrier& b) {
    asm volatile("s_waitcnt vmcnt(0)" ::: "memory");
    __syncthreads();
    if (threadIdx.x == 0) {
        unsigned* bar = b.bar;
        __builtin_amdgcn_s_waitcnt(0);
        unsigned nloc = b.st[0], nx = b.st[1];
        if (nloc == 0u) { xcd_barrier_complete(bar, b.x, nloc, nx); b.st[0] = nloc; b.st[1] = nx; }
        const unsigned old = xb_add(&bar[XB_XSUB(b.x)], 1u);
        const unsigned gen = old / nloc;
        if (old + 1u == (gen + 1u) * nloc) {
            __builtin_amdgcn_fence(__ATOMIC_RELEASE, "agent");
            asm volatile("s_waitcnt vmcnt(0)" ::: "memory");
            const unsigned og = xb_add(&bar[XB_TOP], 1u);
            const unsigned tg = og / nx;
            if (og + 1u == (tg + 1u) * nx) xb_add(&bar[XB_TOPGEN], 1u);
            else XB_SPIN(xb_ld(&bar[XB_TOPGEN]) == tg, bar);
            __builtin_amdgcn_fence(__ATOMIC_ACQUIRE, "agent");
            xb_add(&bar[XB_XGEN(b.x)], 1u);
            asm volatile("s_waitcnt vmcnt(0)" ::: "memory");
        } else {
            XB_SPIN(xb_ld(&bar[XB_XGEN(b.x)]) == gen, bar);
            __builtin_amdgcn_fence(__ATOMIC_ACQUIRE, "agent");
            asm volatile("s_waitcnt vmcnt(0)" ::: "memory");
        }
    }
    __syncthreads();
}

namespace pg8 {
constexpr int BM = 256, BK = 64, HALF = 128, HTB = HALF * BK * 2, STAGE_BYTES = 8 * HTB, NXCD = 8, WGM = 8;
__host__ __device__ __forceinline__ int lds_byte(int r, int c) { const int st = (r >> 4) * 2 + (c >> 5), rr = r & 15, cc = c & 31, ob = rr * 64 + cc * 2; return st * 1024 + (ob ^ (((ob >> 9) & 1) << 5)); }
__host__ __device__ __forceinline__ void stage_rc(int b, int& R, int& C) { const int st = b / 1024, sb = b % 1024, swz = sb ^ (((sb >> 9) & 1) << 5); R = (st >> 1) * 16 + swz / 64; C = (st & 1) * 32 + (swz % 64) / 2; }
__host__ __device__ __forceinline__ int perm32(int rho) { const int n = rho >> 4, i = rho & 15; return 8 * (i >> 2) + 4 * n + (i & 3); }
struct Unit { int pm, pn; };
struct Gemm { const bf16_t* A; const bf16_t* Bt; int lda, ldb, K; };
struct AddrAffine { size_t tA, tB;
    __device__ __forceinline__ const char* A(const char* b, const Unit& u) const { return b + (size_t)u.pm * tA; }
    __device__ __forceinline__ const char* B(const char* b, const Unit& u) const { return b + (size_t)u.pn * tB; }
    __device__ __forceinline__ size_t ka(int t) const { return (size_t)t * (BK * 2); } };
struct AddrCmp { int ntile;
    __device__ __forceinline__ const char* A(const char* b, const Unit& u) const { return b + (size_t)(u.pm >> 3) * (8 * MiB) + (size_t)((u.pm >> 1) & 3) * (2 * MiB) + (size_t)(u.pm & 1) * (256 * 4096) + ka(u.pn * ntile); }
    __device__ __forceinline__ const char* B(const char* b, const Unit& u) const { return b + (size_t)(u.pm >> 3) * (2 * MiB) + (size_t)u.pn * ntile * (BK * 2); }
    __device__ __forceinline__ size_t ka(int t) const { return (size_t)t * (BK * 2); } };
struct StaticOrder {
    int nM, nN, nwg, G, c;
    __host__ __device__ void init(int M, int N, int G_, int c_) { nM = M / BM; nN = N / BM; nwg = nM * nN; G = G_; c = c_; }
    __host__ __device__ bool next(int i, Unit& u) const {
        const long L = (long)i * G + c; if (L >= nwg) return false;
        int wgid = (int)L; { const int q = nwg / NXCD, r = nwg % NXCD, xcd = wgid % NXCD, off = wgid / NXCD; wgid = (xcd < r ? xcd * (q + 1) : r * (q + 1) + (xcd - r) * q) + off; }
        const int nig = WGM * nN, gid = wgid / nig, fm = gid * WGM, gsz = (nM - fm) < WGM ? (nM - fm) : WGM;
        u.pm = fm + ((wgid % nig) % gsz); u.pn = (wgid % nig) / gsz; return true;
    }
};
template <class Epi, bool ALIGN_EPI, class Addr>
__device__ __forceinline__ void gemm_phase(LAS unsigned char* lds, const Gemm g, const StaticOrder& S, const Epi& E, const Addr& AD) {
    const int tid = otid(), wid = __builtin_amdgcn_readfirstlane(tid >> 6), lane = tid & 63, wr = wid >> 2, wc = wid & 3, fr = lane & 15, fq = lane >> 4;
    const int K = g.K, nt = K / BK;
    unsigned voffA[2], voffB[2];
#pragma unroll
    for (int i = 0; i < 2; ++i) { int R, C; stage_rc(tid * 16 + i * 8192, R, C); const int Rb = (R & ~31) + perm32(R & 31);
        voffA[i] = (unsigned)(R * g.lda + C) * 2u; voffB[i] = (unsigned)(Rb * g.ldb + C) * 2u; }
    const size_t kstep = (size_t)(BK * 2);
    const size_t hA = (size_t)HALF * g.lda * 2, hB = (size_t)HALF * g.ldb * 2;
    const unsigned ldsw = (unsigned)wid * 1024u;
    const int aoff = lds_byte(wr * 64 + fr, fq * 8), boff = lds_byte(wc * 32 + fr, fq * 8);
#define PG8_SA(b, h) (((b) * 2 + (h)) * HTB)
#define PG8_SB(b, h) ((4 + (b) * 2 + (h)) * HTB)
#define PG8_STAGE(bufoff, gbase, voff) do { _Pragma("unroll") for (int _i = 0; _i < 2; ++_i) \
        __builtin_amdgcn_global_load_lds((const unsigned*)((const char*)(gbase) + (voff)[_i]), (LAS unsigned*)(lds + (bufoff) + ldsw + _i * 8192), 16, 0, 0); } while (0)
#define PG8_LDA(dst, b, h) do { _Pragma("unroll") for (int m = 0; m < 4; ++m) _Pragma("unroll") for (int k = 0; k < 2; ++k) dst[m][k] = *(const LAS bf16x8*)(lds + PG8_SA(b, h) + aoff + m * 2048 + k * 1024); } while (0)
#define PG8_LDB(dst, b, h) do { _Pragma("unroll") for (int n = 0; n < 2; ++n) _Pragma("unroll") for (int k = 0; k < 2; ++k) dst[n][k] = *(const LAS bf16x8*)(lds + PG8_SB(b, h) + boff + n * 2048 + k * 1024); } while (0)
#define PG8_MMA(ai, bj, At, Bt) do { __builtin_amdgcn_s_setprio(1); _Pragma("unroll") for (int m = 0; m < 4; ++m) _Pragma("unroll") for (int n = 0; n < 2; ++n) _Pragma("unroll") for (int k = 0; k < 2; ++k) \
        acc[ai][bj][m][n] = __builtin_amdgcn_mfma_f32_16x16x32_bf16(Bt[n][k], At[m][k], acc[ai][bj][m][n], 0, 0, 0); __builtin_amdgcn_s_setprio(0); } while (0)
#define PG8_WAIT_V(n) asm volatile("s_waitcnt vmcnt(" #n ")" ::: "memory")
#define PG8_WAIT_L(n) asm volatile("s_waitcnt lgkmcnt(" #n ")" ::: "memory")
#define PG8_BAR __builtin_amdgcn_s_barrier()
#define PG8_SCHED __builtin_amdgcn_sched_barrier(0)
    Unit cur, nxt; int ui = 0;
    if (!S.next(0, cur)) return;
    f32x4 acc[2][2][4][2];
#pragma unroll
    for (int a = 0; a < 2; ++a)
#pragma unroll
        for (int b = 0; b < 2; ++b)
#pragma unroll
            for (int m = 0; m < 4; ++m)
#pragma unroll
                for (int n = 0; n < 2; ++n) acc[a][b][m][n] = (f32x4){0.f, 0.f, 0.f, 0.f};
    bf16x8 At[4][2], B0[2][2], B1[2][2];
    const char* cA = AD.A((const char*)g.A, cur); const char* cB = AD.B((const char*)g.Bt, cur);
    PG8_STAGE(PG8_SB(0, 0), cB, voffB); PG8_STAGE(PG8_SB(0, 1), cB + hB, voffB); PG8_STAGE(PG8_SA(0, 0), cA, voffA); PG8_STAGE(PG8_SA(0, 1), cA + hA, voffA);
    if (wr == 1) PG8_BAR;
    PG8_WAIT_V(2); PG8_BAR;
    PG8_STAGE(PG8_SB(1, 0), cB + kstep, voffB); PG8_STAGE(PG8_SA(1, 0), cA + kstep, voffA); PG8_STAGE(PG8_SB(1, 1), cB + hB + kstep, voffB);
    PG8_WAIT_V(6); PG8_BAR;
    for (;;) {
        const bool has_next = S.next(ui + 1, nxt);
        const char* nA = has_next ? AD.A((const char*)g.A, nxt) : cA; const char* nB = has_next ? AD.B((const char*)g.Bt, nxt) : cB;
        for (int t = 0; t < nt; t += 2) {
            const bool last = (t == nt - 2);
            const char* a1 = cA + AD.ka(t) + kstep;
            const char* a2 = last ? nA : cA + AD.ka(t + 2); const char* b2 = last ? nB : cB + (size_t)(t + 2) * kstep;
            const char* a3 = a2 + kstep; const char* b3 = b2 + kstep;
            PG8_LDB(B0, 0, 0); PG8_LDB(B1, 0, 1); PG8_SCHED; PG8_LDA(At, 0, 0); PG8_STAGE(PG8_SA(1, 1), a1 + hA, voffA);
            PG8_WAIT_V(8); PG8_WAIT_L(0); PG8_BAR; PG8_MMA(0, 0, At, B0); PG8_MMA(0, 1, At, B1); PG8_BAR; PG8_SCHED;
            PG8_LDA(At, 0, 1); PG8_STAGE(PG8_SB(0, 0), b2, voffB); PG8_STAGE(PG8_SB(0, 1), b2 + hB, voffB); PG8_STAGE(PG8_SA(0, 0), a2, voffA);
            PG8_WAIT_V(8); PG8_WAIT_L(0); PG8_BAR; PG8_MMA(1, 0, At, B0); PG8_MMA(1, 1, At, B1); PG8_BAR; PG8_SCHED;
            PG8_LDB(B0, 1, 0); PG8_LDB(B1, 1, 1); PG8_SCHED; PG8_LDA(At, 1, 0); PG8_STAGE(PG8_SA(0, 1), a2 + hA, voffA);
            PG8_WAIT_V(8); PG8_WAIT_L(0); PG8_BAR; PG8_MMA(0, 0, At, B0); PG8_MMA(0, 1, At, B1); PG8_BAR; PG8_SCHED;
            PG8_LDA(At, 1, 1); PG8_STAGE(PG8_SB(1, 0), b3, voffB); PG8_STAGE(PG8_SB(1, 1), b3 + hB, voffB); PG8_STAGE(PG8_SA(1, 0), a3, voffA);
            PG8_WAIT_V(8); PG8_WAIT_L(0); PG8_BAR; PG8_MMA(1, 0, At, B0); PG8_MMA(1, 1, At, B1); PG8_BAR; PG8_SCHED;
        }
        if constexpr (ALIGN_EPI) { if (wr == 0) PG8_BAR; }
        E(acc, cur, wr, wc, fr, fq);
        if (!has_next) break;
#pragma unroll
        for (int a = 0; a < 2; ++a)
#pragma unroll
            for (int b = 0; b < 2; ++b)
#pragma unroll
                for (int m = 0; m < 4; ++m)
#pragma unroll
                    for (int n = 0; n < 2; ++n) acc[a][b][m][n] = (f32x4){0.f, 0.f, 0.f, 0.f};
        cur = nxt; cA = nA; cB = nB; ++ui;
        if constexpr (ALIGN_EPI) { if (wr == 1) PG8_BAR; }
    }
    PG8_WAIT_V(0);
    if constexpr (!ALIGN_EPI) { if (wr == 0) PG8_BAR; }
    PG8_BAR;
#undef PG8_SA
#undef PG8_SB
#undef PG8_STAGE
#undef PG8_LDA
#undef PG8_LDB
#undef PG8_MMA
#undef PG8_WAIT_V
#undef PG8_WAIT_L
#undef PG8_BAR
#undef PG8_SCHED
}
}

typedef f32x4 Acc[2][2][4][2];
__device__ __forceinline__ u32x4 pack8(f32x4 a, f32x4 b) { u32x4 w; w.x = cvtpk(a[0], a[1]); w.y = cvtpk(a[2], a[3]); w.z = cvtpk(b[0], b[1]); w.w = cvtpk(b[2], b[3]); return w; }
__device__ __forceinline__ void unpack8(u32x4 w, f32x4& a, f32x4& b) { a = (f32x4){bflo(w.x), bfhi(w.x), bflo(w.y), bfhi(w.y)}; b = (f32x4){bflo(w.z), bfhi(w.z), bflo(w.w), bfhi(w.w)}; }

struct EpiInProj {
    unsigned char* ws; bf16_t* gm; const float* bmerge;
    __device__ __forceinline__ void operator()(const Acc& acc, const pg8::Unit& u, int wr, int wc, int fr, int fq) const {
        const int pn = u.pn;
        bf16_t* dst; int ldc, cb, mode; size_t bjs = 128;
        if (pn < 4)       { dst = (bf16_t*)(ws + WS_U);   ldc = 1024; cb = pn * 256;        mode = 0; }
        else if (pn < 8)  { dst = (bf16_t*)(ws + WS_GP);  ldc = 1024; cb = (pn - 4) * 256;  mode = 1; }
        else if (pn < 16) { dst = (bf16_t*)(ws + WS_Q);   ldc = 2048; cb = (pn - 8) * 256;  mode = 3; }
        else if (pn < 28) { const int k = (pn - 16) >> 1; dst = (bf16_t*)(ws + WS_KCR + (size_t)k * (8 * MiB)); ldc = 512; cb = ((pn - 16) & 1) * 256; mode = (k == 2 || k == 4) ? 3 : 0;
                            if (k < 2) { ldc = 128; cb = 0; bjs = (size_t)S * 128; dst += (size_t)((pn - 16) & 1) * 2 * S * 128; } }
        else if (pn < 36) { dst = (bf16_t*)(ws + WS_GN);  ldc = 2048; cb = (pn - 28) * 256; mode = 1; }
        else if (pn < 52) { dst = gm;                     ldc = 4096; cb = (pn - 36) * 256; mode = 2; }
        else              { dst = (bf16_t*)(ws + WS_GBR); ldc = 256;  cb = 0;               mode = 4; }
        const int row0 = u.pm * 256 + wr * 64 + fr, cl = wc * 32 + 8 * fq, col0 = cb + cl;
        const float* rcos = (const float*)(ws + WS_ROPE); const float* rsin = rcos + (size_t)S * 64;
#pragma unroll
        for (int ai = 0; ai < 2; ++ai)
#pragma unroll
            for (int m = 0; m < 4; ++m) {
                const int row = row0 + ai * 128 + m * 16;
                bf16_t* rowp = dst + (size_t)row * ldc + col0;
                f32x4 cs0, cs1, sn0, sn1;
                if (mode == 3) { const int i0 = (cl & 127) >> 1; cs0 = *(const f32x4*)(rcos + (size_t)row * 64 + i0); sn0 = *(const f32x4*)(rsin + (size_t)row * 64 + i0); }
#pragma unroll
                for (int bj = 0; bj < 2; ++bj) {
                    f32x4 v0 = acc[ai][bj][m][0], v1 = acc[ai][bj][m][1];
                    if (mode == 1) { for (int e = 0; e < 4; ++e) { v0[e] = siluf_(v0[e]); v1[e] = siluf_(v1[e]); } }
                    else if (mode == 2 || mode == 4) { if (mode == 2) { v0 = v0 + *(const f32x4*)(bmerge + col0 + bj * 128); v1 = v1 + *(const f32x4*)(bmerge + col0 + bj * 128 + 4); } for (int e = 0; e < 4; ++e) { v0[e] = sigmoidf_(v0[e]); v1[e] = sigmoidf_(v1[e]); } }
                    else if (mode == 3) {
                        f32x4 o0, o1;
                        o0[0] = v0[0] * cs0[0] - v0[1] * sn0[0]; o0[1] = v0[1] * cs0[0] + v0[0] * sn0[0];
                        o0[2] = v0[2] * cs0[1] - v0[3] * sn0[1]; o0[3] = v0[3] * cs0[1] + v0[2] * sn0[1];
                        o1[0] = v1[0] * cs0[2] - v1[1] * sn0[2]; o1[1] = v1[1] * cs0[2] + v1[0] * sn0[2];
                        o1[2] = v1[2] * cs0[3] - v1[3] * sn0[3]; o1[3] = v1[3] * cs0[3] + v1[2] * sn0[3];
                        v0 = o0; v1 = o1;
                    }
                    *(u32x4*)(rowp + bj * bjs) = pack8(v0, v1);
                }
            }
    }
};
struct EpiYa {
    bf16_t* yag; const bf16_t* gm;
    __device__ __forceinline__ void operator()(const Acc& acc, const pg8::Unit& u, int wr, int wc, int fr, int fq) const {
        const int row0 = u.pm * 256 + wr * 64 + fr, col0 = u.pn * 256 + wc * 32 + 8 * fq;
#pragma unroll
        for (int ai = 0; ai < 2; ++ai)
#pragma unroll
            for (int m = 0; m < 4; ++m) { const size_t r = (size_t)(row0 + ai * 128 + m * 16);
#pragma unroll
                for (int bj = 0; bj < 2; ++bj) { f32x4 g0, g1; unpack8(*(const u32x4*)(gm + r * 4096 + col0 + bj * 128), g0, g1);
                    *(u32x4*)(yag + r * 2048 + col0 + bj * 128) = pack8(acc[ai][bj][m][0] * g0, acc[ai][bj][m][1] * g1); } }
    }
};
struct EpiYb {
    bf16_t* merged; const bf16_t* yag; const bf16_t* gm;
    __device__ __forceinline__ void operator()(const Acc& acc, const pg8::Unit& u, int wr, int wc, int fr, int fq) const {
        const int row0 = u.pm * 256 + wr * 64 + fr, col0 = u.pn * 256 + wc * 32 + 8 * fq;
#pragma unroll
        for (int ai = 0; ai < 2; ++ai)
#pragma unroll
            for (int m = 0; m < 4; ++m) { const size_t r = (size_t)(row0 + ai * 128 + m * 16);
#pragma unroll
                for (int bj = 0; bj < 2; ++bj) { f32x4 g0, g1, y0, y1; unpack8(*(const u32x4*)(gm + r * 4096 + 2048 + col0 + bj * 128), g0, g1);
                    unpack8(*(const u32x4*)(yag + r * 2048 + col0 + bj * 128), y0, y1);
                    *(u32x4*)(merged + r * 2048 + col0 + bj * 128) = pack8(y0 + acc[ai][bj][m][0] * g0, y1 + acc[ai][bj][m][1] * g1); } }
    }
};
constexpr int NSPLIT = 8;
struct EpiSlab {
    float* slab;
    __device__ __forceinline__ void operator()(const Acc& acc, const pg8::Unit& u, int wr, int wc, int fr, int fq) const {
        float* base = slab + ((size_t)((u.pm >> 3) * NSPLIT + u.pn) * 2048 + (size_t)(u.pm & 7) * 256 + wr * 64 + fr) * 256 + wc * 32 + 8 * fq;
#pragma unroll
        for (int ai = 0; ai < 2; ++ai)
#pragma unroll
            for (int m = 0; m < 4; ++m)
#pragma unroll
                for (int bj = 0; bj < 2; ++bj) { float* p = base + (size_t)(ai * 128 + m * 16) * 256 + bj * 128; *(f32x4*)p = acc[ai][bj][m][0]; *(f32x4*)(p + 4) = acc[ai][bj][m][1]; }
    }
};
constexpr int CW_PANEL = 16384;
constexpr int EPI_LDS_OFF = RING_BYTES + 1024;
struct EpiOut {
    float* out; const float* x; float* ssq; const float* fw; unsigned* ctl; LAS unsigned char* lds;
    __device__ __forceinline__ void operator()(const Acc& acc_, const pg8::Unit& u, int wr, int wc, int fr, int fq) const {
        Acc& acc = const_cast<Acc&>(acc_);
        const int tid = otid();
        const int row0 = u.pm * 256 + wr * 64 + fr, col0 = u.pn * 256 + wc * 32 + 8 * fq;
        LAS float* rs = (LAS float*)(lds + EPI_LDS_OFF);
#pragma unroll
        for (int ai = 0; ai < 2; ++ai)
#pragma unroll
            for (int m = 0; m < 4; ++m) { const size_t r = (size_t)(row0 + ai * 128 + m * 16); float q = 0.f;
#pragma unroll
                for (int bj = 0; bj < 2; ++bj)
#pragma unroll
                    for (int n = 0; n < 2; ++n) { const size_t o = r * 2048 + col0 + bj * 128 + 4 * n; const f32x4 v = *(const f32x4*)(x + o) + acc[ai][bj][m][n];
                        acc[ai][bj][m][n] = v; q += (v[0] * v[0] + v[1] * v[1]) + (v[2] * v[2] + v[3] * v[3]); }
                q += __shfl_xor(q, 16); q += __shfl_xor(q, 32);
                if (fq == 0) __hip_atomic_store((unsigned*)(ssq + (size_t)(u.pn * 4 + wc) * S + r), __float_as_uint(q), __ATOMIC_RELAXED, __HIP_MEMORY_SCOPE_AGENT); }
        asm volatile("s_waitcnt vmcnt(0)" ::: "memory");
        __syncthreads();
        if (tid == 0) { unsigned* c = ctl + CW_PANEL + 64 * u.pm;
            __hip_atomic_fetch_add(c, 1u, __ATOMIC_RELAXED, __HIP_MEMORY_SCOPE_AGENT);
            unsigned sp = 0; while (__hip_atomic_load(c, __ATOMIC_RELAXED, __HIP_MEMORY_SCOPE_AGENT) < 8u) { __builtin_amdgcn_s_sleep(2); if (++sp > (1u << 22)) break; }
            __builtin_amdgcn_fence(__ATOMIC_ACQUIRE, "agent"); asm volatile("s_waitcnt vmcnt(0)" ::: "memory"); }
        __syncthreads();
        if (tid < 256) { const size_t r = (size_t)u.pm * 256 + tid; float s = 0.f;
#pragma unroll 8
            for (int p = 0; p < 32; ++p) s += __uint_as_float(__hip_atomic_load((unsigned*)(ssq + (size_t)p * S + r), __ATOMIC_RELAXED, __HIP_MEMORY_SCOPE_AGENT));
            rs[tid] = 1.0f / sqrtf(s * (1.f / DM) + EPS); }
        __syncthreads();
#pragma unroll
        for (int ai = 0; ai < 2; ++ai)
#pragma unroll
            for (int m = 0; m < 4; ++m) { const int rl = wr * 64 + fr + ai * 128 + m * 16; const float sc = rs[rl]; const size_t r = (size_t)u.pm * 256 + rl;
#pragma unroll
                for (int bj = 0; bj < 2; ++bj)
#pragma unroll
                    for (int n = 0; n < 2; ++n) { const size_t o = r * 2048 + col0 + bj * 128 + 4 * n; *(f32x4*)(out + o) = acc[ai][bj][m][n] * sc * *(const f32x4*)(fw + col0 + bj * 128 + 4 * n); } }
    }
};

struct Args { const float* in[17]; float* out; unsigned char* ws; int ph_lo, ph_hi; };
struct Frame { LAS unsigned char* lds; int tid, lane, wave, vcu, G; };

__device__ __forceinline__ int ropeperm(int d) { return d < 64 ? 2 * d : 2 * (d - 64) + 1; }
__device__ __forceinline__ void transpose_item(const float* W, int ldw, int Nvalid, bf16_t* WT, int ldt, int row_off, bool perm, LAS float* scr, int kb, int nb, int lane) {
    const int k0 = 64 * kb, n0 = 32 * nb, cq = lane & 7, rb = lane >> 3; const bool ok = n0 + cq * 4 < Nvalid;
    f32x4 v[8];
#pragma unroll
    for (int i = 0; i < 8; ++i) v[i] = ok ? *(const f32x4*)(W + (size_t)(k0 + i * 8 + rb) * ldw + n0 + cq * 4) : (f32x4){0.f, 0.f, 0.f, 0.f};
#pragma unroll
    for (int i = 0; i < 8; ++i) *(LAS f32x4*)(scr + (i * 8 + rb) * 32 + ((cq ^ i) << 2)) = v[i];
    LDS_WAIT(); asm volatile("" ::: "memory");
#pragma unroll
    for (int j = 0; j < 4; ++j) { const int idx = lane + 64 * j, n = idx >> 3, c = idx & 7; const LAS float* s = scr + (8 * c) * 32 + ((((n >> 2) ^ c) << 2) | (n & 3));
        u32x4 o; o.x = cvtpk(s[0 * 32], s[1 * 32]); o.y = cvtpk(s[2 * 32], s[3 * 32]); o.z = cvtpk(s[4 * 32], s[5 * 32]); o.w = cvtpk(s[6 * 32], s[7 * 32]);
        const int ng = n0 + n;
        if (ng < Nvalid) { const int dr = perm ? ((ng & ~127) | ropeperm(ng & 127)) : ng; *(GAS u32x4*)(WT + (size_t)(row_off + dr) * ldt + k0 + 8 * c) = o; } }
    LDS_WAIT(); asm volatile("" ::: "memory");
}

__device__ __forceinline__ void p0_prologue(const Frame& F, const Args& a) {
    unsigned char* ws = a.ws;
    LAS float* scr = (LAS float*)(F.lds + F.wave * 8192);
    const int gw = F.vcu * NWAVES + F.wave, NGW = F.G * NWAVES, lane = F.lane;
    constexpr int I_WIN = 32 * 258, I_WM = 32 * 128;
    for (int it = gw; it < I_WIN + I_WM; it += NGW) {
        int r = it;
        if (r < I_WIN) { const int kb = r / 258, nb = 32 + r % 258, n0 = nb * 32;
            const bool perm = (n0 >= 2048 && n0 < 4096) || (n0 >= 5120 && n0 < 5632) || (n0 >= 6144 && n0 < 6656);
            transpose_item(a.in[2], 9264, 9264, (bf16_t*)(ws + WS_WCAT), 2048, nb >= 288 ? 4096 : 0, perm, scr, kb, nb, lane); continue; } r -= I_WIN;
        transpose_item(a.in[13], 4096, 4096, (bf16_t*)(ws + WS_WCAT), 2048, 9216, false, scr, r / 128, r % 128, lane);
    }
    {
        const float* win = a.in[2]; const float* mix = a.in[3]; bf16_t* WC = (bf16_t*)(ws + WS_WCAT); const int r = lane & 31, hh = lane >> 5;
        for (int it = gw; it < 1024; it += NGW) {
            const int g = it >> 8, d0 = ((it >> 5) & 7) * 32, kin0 = (it & 31) * 64;
            f32x16 acc0 = f32x16{}, acc1 = f32x16{};
            const float* ap = mix + (size_t)g * 65536 + (size_t)(8 * hh) * 256 + d0 + r;
            const float* bp0 = win + (size_t)(kin0 + r) * 9264 + g * 256 + 8 * hh; const float* bp1 = bp0 + (size_t)32 * 9264;
#pragma unroll 4
            for (int k = 0; k < 16; ++k) {
                f32x4 a0, a1;
#pragma unroll
                for (int j = 0; j < 4; ++j) { a0[j] = ap[(size_t)(k * 16 + j) * 256]; a1[j] = ap[(size_t)(k * 16 + 4 + j) * 256]; }
                const u32x4 af = pack8(a0, a1), b0 = pack8(*(const f32x4*)(bp0 + k * 16), *(const f32x4*)(bp0 + k * 16 + 4)), b1 = pack8(*(const f32x4*)(bp1 + k * 16), *(const f32x4*)(bp1 + k * 16 + 4));
                acc0 = __builtin_amdgcn_mfma_f32_32x32x16_bf16(__builtin_bit_cast(bf16x8, af), __builtin_bit_cast(bf16x8, b0), acc0, 0, 0, 0);
                acc1 = __builtin_amdgcn_mfma_f32_32x32x16_bf16(__builtin_bit_cast(bf16x8, af), __builtin_bit_cast(bf16x8, b1), acc1, 0, 0, 0);
            }
#pragma unroll
            for (int e = 0; e < 16; ++e) { int ee = e; asm volatile("" : "+v"(ee)); bf16_t* rowp = WC + (size_t)(g * 256 + d0 + crow(ee, hh)) * 2048 + kin0 + r;
                const float v0 = acc0[e], v1 = acc1[e], n0_ = __shfl_xor(v0, 1), n1_ = __shfl_xor(v1, 1);
                if ((r & 1) == 0) { *(unsigned*)rowp = cvtpk(v0, n0_); *(unsigned*)(rowp + 32) = cvtpk(v1, n1_); } }
        }
    }
    for (int i = gw * 64 + lane; i < 53248; i += NGW * 64) *(GAS u32x4*)(ws + WS_WCAT + (size_t)13360 * 4096 + (size_t)i * 16) = (u32x4){0u, 0u, 0u, 0u};
    {
        const float* x = a.in[0]; const float* nw = a.in[1]; bf16_t* H = (bf16_t*)(ws + WS_H);
        f32x4 wv[8];
#pragma unroll
        for (int j = 0; j < 8; ++j) wv[j] = *((const f32x4*)nw + lane + 64 * j);
        for (int m = gw; m < S; m += NGW) {
            const f32x4* xr = (const f32x4*)(x + (size_t)m * DM) + lane; f32x4 v[8]; float s = 0.f;
#pragma unroll
            for (int j = 0; j < 8; ++j) { v[j] = xr[64 * j]; s += (v[j][0] * v[j][0] + v[j][1] * v[j][1]) + (v[j][2] * v[j][2] + v[j][3] * v[j][3]); }
            const float rstd = 1.0f / sqrtf(wave_sum(s) * (1.f / DM) + EPS);
            u32x2* o = (u32x2*)(H + (size_t)m * DM) + lane;
#pragma unroll
            for (int j = 0; j < 8; ++j) { const f32x4 y = v[j] * rstd * wv[j]; u32x2 w; w.x = cvtpk(y[0], y[1]); w.y = cvtpk(y[2], y[3]); o[64 * j] = w; }
        }
    }
    {
        float* rcos = (float*)(ws + WS_ROPE); float* rsin = rcos + (size_t)S * 64;
        for (int e = gw * 64 + lane; e < S * 64; e += NGW * 64) {
            const int pos = e >> 6, i = e & 63;
            double inv = 1.0, b = 0.86596432336006535;
            for (int k = i; k; k >>= 1) { if (k & 1) inv *= b; b *= b; }
            const double t = (double)pos * inv * 0.15915494309189535;
            const float fr = (float)(t - floor(t));
            rcos[e] = __builtin_amdgcn_cosf(fr); rsin[e] = __builtin_amdgcn_sinf(fr);
        }
    }
}
__device__ __forceinline__ void p1_late_weights(const Frame& F, const Args& a, int cw, int NCW) {
    unsigned char* ws = a.ws;
    LAS float* scr = (LAS float*)(F.lds + F.wave * 8192);
    const int lane = F.lane;
    constexpr int I_NO = 32 * 64, I_O = 32 * 64, I_PO = 16 * 64, I_W1 = 64 * 8, I_W2 = 4 * 4, I_B1 = 512;
    constexpr int NITEMS = I_NO + I_O + I_PO + 2 * I_W1 + 2 * I_W2 + I_B1;
    for (int it = cw; it < NITEMS; it += NCW) {
        int r = it;
        if (r < I_W1) { transpose_item(a.in[6], 256, 256, (bf16_t*)(ws + WS_W1KT), 4096, 0, false, scr, r / 8, r % 8, lane); continue; } r -= I_W1;
        if (r < I_W1) { transpose_item(a.in[9], 256, 256, (bf16_t*)(ws + WS_W1VT), 4096, 0, false, scr, r / 8, r % 8, lane); continue; } r -= I_W1;
        if (r < I_B1) {
            const int which = r >> 8, fb = (r >> 6) & 3, ch = r & 63, f = fb * 64 + lane;
            const float* pe = a.in[which ? 8 : 5]; const float* w1 = a.in[which ? 9 : 6]; float s = 0.f;
#pragma unroll 16
            for (int k = ch * 64; k < ch * 64 + 64; ++k) s += pe[k] * w1[(size_t)k * 256 + f];
            ((float*)(ws + WS_B1P))[(which * 64 + ch) * 256 + f] = s; continue; } r -= I_B1;
        if (r < I_W2) { transpose_item(a.in[7], 128, 128, (bf16_t*)(ws + WS_W2KT), 256, 0, true, scr, r / 4, r % 4, lane); continue; } r -= I_W2;
        if (r < I_W2) { transpose_item(a.in[10], 128, 128, (bf16_t*)(ws + WS_W2VT), 256, 0, false, scr, r / 4, r % 4, lane); continue; } r -= I_W2;
        if (r < I_PO) { transpose_item(a.in[11], 2048, 2048, (bf16_t*)(ws + WS_WPOT), 1024, 0, false, scr, r / 64, r % 64, lane); continue; } r -= I_PO;
        if (r < I_NO) { transpose_item(a.in[12], 2048, 2048, (bf16_t*)(ws + WS_WNOT), 2048, 0, false, scr, r / 64, r % 64, lane); continue; } r -= I_NO;
        transpose_item(a.in[15], 2048, 2048, (bf16_t*)(ws + WS_WOT), 2048, 0, false, scr, r / 64, r % 64, lane);
    }
}

template <int W>
__device__ __forceinline__ void ypool_item(const bf16_t* __restrict__ U, const bf16_t* __restrict__ GP, bf16_t* __restrict__ Y, const float* __restrict__ scale, int c, int t0) {
    u32x4 x[W + 7], gq[8];
#pragma unroll
    for (int k = 0; k < W + 7; ++k) { const int r = t0 - (W - 1) + k; x[k] = r >= 0 ? *(const u32x4*)(U + (size_t)r * 1024 + c) : (u32x4){0u, 0u, 0u, 0u}; }
#pragma unroll
    for (int k = 0; k < 8; ++k) gq[k] = *(const u32x4*)(GP + (size_t)(t0 + k) * 1024 + c);
    const f32x4 sc0 = *(const f32x4*)(scale + c), sc1 = *(const f32x4*)(scale + c + 4);
    f32x4 s0 = {0.f, 0.f, 0.f, 0.f}, s1 = s0, a0, a1;
#pragma unroll
    for (int k = 0; k < W - 1; ++k) { unpack8(x[k], a0, a1); s0 = s0 + a0; s1 = s1 + a1; }
#pragma unroll
    for (int k = 0; k < 8; ++k) { const int t = t0 + k;
        unpack8(x[W - 1 + k], a0, a1); s0 = s0 + a0; s1 = s1 + a1;
        const int cnt = (t + 1 < W) ? t + 1 : W; const float ic = 1.0f / (float)cnt;
        f32x4 g0, g1; unpack8(gq[k], g0, g1);
        *(u32x4*)(Y + (size_t)t * 1024 + c) = pack8((s0 * ic - a0) * sc0 * g0, (s1 * ic - a1) * sc1 * g1);
        f32x4 b0, b1; unpack8(x[k], b0, b1); s0 = s0 - b0; s1 = s1 - b1; }
}
__device__ __forceinline__ void p2_ypool(const Frame& F, unsigned char* ws, const float* __restrict__ scale, int cw, int NCW) {
    const bf16_t* __restrict__ U = (const bf16_t*)(ws + WS_U); const bf16_t* __restrict__ GP = (const bf16_t*)(ws + WS_GP); bf16_t* __restrict__ Y = (bf16_t*)(ws + WS_H + 16 * MiB);
    for (int wi = cw; wi < 4 * 512; wi += NCW) {
        const int g = wi & 3, t0 = ((wi >> 2) * 2 + (F.lane >> 5)) * 8, c = (g * 32 + (F.lane & 31)) * 8;
        if (g == 0) ypool_item<2>(U, GP, Y, scale, c, t0); else if (g == 1) ypool_item<4>(U, GP, Y, scale, c, t0);
        else if (g == 2) ypool_item<8>(U, GP, Y, scale, c, t0); else ypool_item<16>(U, GP, Y, scale, c, t0);
    }
}
__device__ __forceinline__ void p3_compress2(const Frame& F, unsigned char* ws, int cwg, int NCWG) {
    const int tid = F.tid, lane = F.lane, r = lane & 31, hh = lane >> 5, wave = F.wave;
    const float* rcos = (const float*)(ws + WS_ROPE); const float* rsin = rcos + (size_t)S * 64;
    LAS bf16_t* hl = (LAS bf16_t*)F.lds;
    for (int it = cwg; it < 128; it += NCWG) {
        const int which = it >> 6, rt = it & 63;
        { const int row = tid >> 4, f0 = (tid & 15) * 16;
          const float* sl = (const float*)(ws + WS_SLAB) + ((size_t)(which * NSPLIT) * 2048 + rt * 32 + row) * 256 + f0; const float* b1 = (const float*)(ws + WS_B1) + which * 256 + f0;
          f32x4 s[4];
#pragma unroll
          for (int q = 0; q < 4; ++q) s[q] = *(const f32x4*)(b1 + 4 * q);
#pragma unroll
          for (int ks = 0; ks < NSPLIT; ++ks)
#pragma unroll
              for (int q = 0; q < 4; ++q) s[q] = s[q] + *(const f32x4*)(sl + (size_t)ks * 2048 * 256 + 4 * q);
#pragma unroll
          for (int q = 0; q < 4; ++q)
#pragma unroll
              for (int e = 0; e < 4; ++e) s[q][e] = siluf_(s[q][e]);
          *(LAS u32x4*)(hl + row * 264 + f0) = pack8(s[0], s[1]); *(LAS u32x4*)(hl + row * 264 + f0 + 8) = pack8(s[2], s[3]); }
        __syncthreads();
        if (wave < 4) {
            const int ct = wave, row = rt * 32 + r;
            const bf16_t* W2 = (const bf16_t*)(ws + (which ? WS_W2VT : WS_W2KT)) + (size_t)(ct * 32 + r) * 256 + hh * 8;
            f32x16 acc = f32x16{};
#pragma unroll 4
            for (int k = 0; k < 16; ++k) acc = __builtin_amdgcn_mfma_f32_32x32x16_bf16(*(const bf16x8*)(W2 + k * 16), *(const LAS bf16x8*)(hl + r * 264 + k * 16 + hh * 8), acc, 0, 0, 0);
            const int n = row & 511; bf16_t* dst = (bf16_t*)(ws + (which ? WS_VC : WS_KC)) + (size_t)row * 128 + ct * 32 + 4 * hh;
            const int pos = (16 * n + 31) > S - 1 ? S - 1 : 16 * n + 31;
#pragma unroll
            for (int gq = 0; gq < 4; ++gq) {
                float v0 = acc[4 * gq], v1 = acc[4 * gq + 1], v2 = acc[4 * gq + 2], v3 = acc[4 * gq + 3];
                if (which == 0) { const int i = (ct * 32 + 8 * gq + 4 * hh) >> 1; const float c0 = rcos[(size_t)pos * 64 + i], s0 = rsin[(size_t)pos * 64 + i], c1 = rcos[(size_t)pos * 64 + i + 1], s1 = rsin[(size_t)pos * 64 + i + 1];
                    const float o0 = v0 * c0 - v1 * s0, o1 = v1 * c0 + v0 * s0, o2 = v2 * c1 - v3 * s1, o3 = v3 * c1 + v2 * s1; v0 = o0; v1 = o1; v2 = o2; v3 = o3; }
                u32x2 w; w.x = cvtpk(v0, v1); w.y = cvtpk(v2, v3); if (n == 511) { w.x = 0u; w.y = 0u; }
                *(u32x2*)(dst + 8 * gq) = w;
            }
        }
        __syncthreads();
    }
}

namespace nsa {
constexpr int SHM_V = 16384, SHM_K = 16384;
constexpr int L_V = 0, L_K = 3 * SHM_V, L_WS = L_K + 2 * SHM_K, L_IMP = L_WS + NWAVES * 64 * 4, IMP_LD = 129, L_SELM = L_IMP + 64 * IMP_LD * 4, L_END = L_SELM + 64 * 8 * 2;
static_assert(L_END <= RING_BYTES, "attention LDS");
constexpr float SCALE = 0.08838834764831845f, C2 = 1.4426950408889634f * SCALE, THR = 8.f;
#define KSWZ(row, colB) ((row) * 256 + ((colB) ^ (((row) & 7) << 4)))
#define SBAR() __builtin_amdgcn_sched_barrier(0)
#define LADD(p, v) (void)__hip_atomic_fetch_add((p), (v), __ATOMIC_RELAXED, __HIP_MEMORY_SCOPE_WORKGROUP)
__device__ __forceinline__ int v_st(int k, int c) { const int kk = (k & ~0xC) | ((k & 4) << 1) | ((k & 8) >> 1); return ((kk >> 3) * 4 + (c >> 5)) * 512 + ((kk & 7) * 32 + (c & 31)) * 2; }
__device__ __forceinline__ int v_rd_base(int lane) { return ((lane & 3) << 3) | (((lane >> 2) & 3) << 6) | (((lane >> 4) & 1) << 5) | (((lane >> 5) & 1) << 8); }
constexpr int v_rd_off(int d0, int ks, int half) { return d0 * 512 + ks * 4096 + half * 2048; }
__device__ __forceinline__ unsigned cvtpk_a(float lo, float hi) { unsigned r; asm volatile("v_cvt_pk_bf16_f32 %0, %1, %2" : "=v"(r) : "v"(lo), "v"(hi)); return r; }

__device__ __forceinline__ void mask_range(f32x16& p0, f32x16& p1, int dq, unsigned Wn) {
    const float NEG = -__builtin_inff();
#pragma unroll
    for (int r = 0; r < 16; ++r) { const int c = (r & 3) + 8 * (r >> 2);
        if ((unsigned)(dq + c) >= Wn) p0[r] = NEG;
        if ((unsigned)(dq + c + 32) >= Wn) p1[r] = NEG; }
}
__device__ __forceinline__ void mask_row(f32x16& p0, f32x16& p1, bool keep) {
    const float NEG = -__builtin_inff();
#pragma unroll
    for (int r = 0; r < 16; ++r) { p0[r] = keep ? p0[r] : NEG; p1[r] = keep ? p1[r] : NEG; }
}
__device__ __forceinline__ float rowmax32(const f32x16& p0, const f32x16& p1) {
    float pmax = p0[0];
#pragma unroll
    for (int r = 1; r < 16; ++r) pmax = fmaxf(pmax, p0[r]);
#pragma unroll
    for (int r = 0; r < 16; ++r) pmax = fmaxf(pmax, p1[r]);
    auto rr = __builtin_amdgcn_permlane32_swap(__float_as_uint(pmax), __float_as_uint(pmax), false, false);
    return fmaxf(__uint_as_float(rr[0]), __uint_as_float(rr[1]));
}
__device__ __forceinline__ float rowsum32(const f32x16& p0, const f32x16& p1) {
    float ps = 0.f;
#pragma unroll
    for (int r = 0; r < 16; ++r) ps += p0[r];
#pragma unroll
    for (int r = 0; r < 16; ++r) ps += p1[r];
    auto rr = __builtin_amdgcn_permlane32_swap(__float_as_uint(ps), __float_as_uint(ps), false, false);
    return __uint_as_float(rr[0]) + __uint_as_float(rr[1]);
}
__device__ __forceinline__ void pack_p(const f32x16& p0, const f32x16& p1, bf16x8& pa0, bf16x8& pa1, bf16x8& pa2, bf16x8& pa3) {
#define PK4(P, B_, OUT) do { unsigned a0 = cvtpk_a(P[B_+0], P[B_+1]), a1 = cvtpk_a(P[B_+2], P[B_+3]);                          \
        unsigned b0 = cvtpk_a(P[B_+4], P[B_+5]), b1 = cvtpk_a(P[B_+6], P[B_+7]);                                             \
        auto r0 = __builtin_amdgcn_permlane32_swap(a0, b0, false, false); auto r1 = __builtin_amdgcn_permlane32_swap(a1, b1, false, false); \
        u32x4 w = {r0[0], r1[0], r0[1], r1[1]}; OUT = __builtin_bit_cast(bf16x8, w); } while (0)
    PK4(p0, 0, pa0); PK4(p0, 8, pa1); PK4(p1, 0, pa2); PK4(p1, 8, pa3);
#undef PK4
}
__device__ __forceinline__ void qkt(f32x16& p0, f32x16& p1, const LAS unsigned char* K_buf, int r32, int hi, const bf16x8* qr) {
    p0 = f32x16{}; p1 = f32x16{};
    const LAS unsigned char* kb[4];
#pragma unroll
    for (int dd = 0; dd < 4; ++dd) kb[dd] = K_buf + KSWZ(r32, (dd * 16 + hi * 8) * 2);
#pragma unroll
    for (int d0 = 0; d0 < 8; ++d0) { const LAS unsigned char* a = kb[d0 & 3] + (d0 >> 2) * 128;
        const bf16x8 b0 = *(const LAS bf16x8*)(a);
        const bf16x8 b1 = *(const LAS bf16x8*)(a + 32 * 256);
        p0 = __builtin_amdgcn_mfma_f32_32x32x16_bf16(b0, qr[d0], p0, 0, 0, 0);
        p1 = __builtin_amdgcn_mfma_f32_32x32x16_bf16(b1, qr[d0], p1, 0, 0, 0);
        if (d0 == 3) SBAR(); }
}
__device__ __forceinline__ void pv_tile(f32x16* o, int vb0, bf16x8 pa0, bf16x8 pa1, bf16x8 pa2, bf16x8 pa3) {
#define TRRD(dst, off) asm volatile("ds_read_b64_tr_b16 %0, %1 offset:%2" : "=&v"(dst) : "v"(vb0), "i"(off) : "memory")
#define PV_D0(d0) do { s16x4 l0, l1, l2, l3, h0, h1, h2, h3; constexpr int b_ = v_rd_off(d0, 0, 0); \
        TRRD(l0, b_); TRRD(h0, b_ + 2048); TRRD(l1, b_ + 4096); TRRD(h1, b_ + 6144); TRRD(l2, b_ + 8192); TRRD(h2, b_ + 10240); TRRD(l3, b_ + 12288); TRRD(h3, b_ + 14336); \
        asm volatile("s_waitcnt lgkmcnt(0)" ::: "memory"); SBAR();   \
        o[d0] = __builtin_amdgcn_mfma_f32_32x32x16_bf16(pa0, (bf16x8){l0[0], l0[1], l0[2], l0[3], h0[0], h0[1], h0[2], h0[3]}, o[d0], 0, 0, 0);   \
        o[d0] = __builtin_amdgcn_mfma_f32_32x32x16_bf16(pa1, (bf16x8){l1[0], l1[1], l1[2], l1[3], h1[0], h1[1], h1[2], h1[3]}, o[d0], 0, 0, 0);   \
        o[d0] = __builtin_amdgcn_mfma_f32_32x32x16_bf16(pa2, (bf16x8){l2[0], l2[1], l2[2], l2[3], h2[0], h2[1], h2[2], h2[3]}, o[d0], 0, 0, 0);   \
        o[d0] = __builtin_amdgcn_mfma_f32_32x32x16_bf16(pa3, (bf16x8){l3[0], l3[1], l3[2], l3[3], h3[0], h3[1], h3[2], h3[3]}, o[d0], 0, 0, 0); } while (0)
    PV_D0(0); PV_D0(1); PV_D0(2); PV_D0(3);
#undef PV_D0
#undef TRRD
}

enum { M_C1 = 0, M_C2 = 1, M_S = 2, M_W = 3 };
struct RowState { float m, l; };
template <int MODE>
__device__ __forceinline__ void attn_pass(LAS unsigned char* lds, const bf16_t* Kp, const bf16_t* Vp, int ld, int j_lo, int j_hi, const bf16x8* qr, int t, int Tq, const u32x4 sel,
                                          RowState& st, float invl, f32x16* o, bool do_imp) {
    constexpr bool HASV = MODE != M_C1;
    const int tid = otid(), wid = __builtin_amdgcn_readfirstlane(tid >> 6), lane = tid & 63, r32 = lane & 31, hi = lane >> 5;
    LAS unsigned char* V_lds = lds + L_V; LAS unsigned char* K_lds = lds + L_K;
    LAS float* wsf = (LAS float*)(lds + L_WS) + wid * 64; LAS float* al_l = wsf + 32;
    const int sr = tid >> 4, sc = (tid & 15) * 8, vst0 = v_st(sr, sc), vst1 = v_st(32 + sr, sc), kws = KSWZ(sr, sc * 2);
    const int vb0 = (int)(uintptr_t)V_lds + v_rd_base(lane);
    const int NT = j_hi - j_lo;
    bf16x8 st_k0, st_k1, st_v0, st_v1;
    float m_reg = st.m, l_reg = st.l;
#define SLOAD(j) do { const size_t k0_ = (size_t)(j) * 64; st_k0 = *(const bf16x8*)(Kp + (k0_ + sr) * ld + sc); st_k1 = *(const bf16x8*)(Kp + (k0_ + 32 + sr) * ld + sc); \
        if (HASV) { st_v0 = *(const bf16x8*)(Vp + (k0_ + sr) * ld + sc); st_v1 = *(const bf16x8*)(Vp + (k0_ + 32 + sr) * ld + sc); } } while (0)
#define SWRITE(kof, vof) do { *(LAS bf16x8*)(K_lds + (kof) + kws) = st_k0; *(LAS bf16x8*)(K_lds + (kof) + kws + 32 * 256) = st_k1; \
        if (HASV) { *(LAS bf16x8*)(V_lds + (vof) + vst0) = st_v0; *(LAS bf16x8*)(V_lds + (vof) + vst1) = st_v1; } } while (0)
    const bool late = HASV && wid >= 4;
    bf16x8 pa0, pa1, pa2, pa3;
    SLOAD(j_lo); SWRITE(0, 0);
    __syncthreads();
    int kof = 0, vof = 0, vprev = 0;
    for (int idx = 0; idx < NT; ++idx) {
        const int j = j_lo + idx, kb = j * 64;
        if (idx + 1 < NT) SLOAD(j + 1);
        if (HASV && late && idx > 0) { SBAR(); pv_tile(o, vb0 + vprev, pa0, pa1, pa2, pa3); SBAR(); }
        f32x16 p0, p1; qkt(p0, p1, K_lds + kof, r32, hi, qr);
#if EXP_QKT2
        asm volatile("" : "+v"(p0), "+v"(p1)); SBAR(); qkt(p0, p1, K_lds + kof, r32, hi, qr);
#endif
        if (MODE == M_C1 || MODE == M_C2) { const int nmax1 = ((t - 31) >> 4) + 1; mask_range(p0, p1, kb + 4 * hi, (unsigned)(nmax1 > 0 ? nmax1 : 0)); }
        else if (MODE == M_S) { if (j == Tq) mask_range(p0, p1, kb + 4 * hi, (unsigned)(t + 1));
                                else { const unsigned w_ = (j >> 5) == 0 ? sel.x : (j >> 5) == 1 ? sel.y : (j >> 5) == 2 ? sel.z : sel.w; mask_row(p0, p1, ((w_ >> (j & 31)) & 1u) != 0u); } }
        else { if (j == Tq || j + 8 <= Tq) mask_range(p0, p1, kb + 4 * hi - (t - 511), 512u); }
        if (MODE == M_C1) { const float pmax = rowmax32(p0, p1); const float mn = fmaxf(m_reg, pmax); const float alpha = __builtin_amdgcn_exp2f((m_reg - mn) * C2); m_reg = mn;
            const float mnL = -mn * C2;
#pragma unroll
            for (int r = 0; r < 16; ++r) { p0[r] = __builtin_amdgcn_exp2f(fmaf(p0[r], C2, mnL)); p1[r] = __builtin_amdgcn_exp2f(fmaf(p1[r], C2, mnL)); }
            l_reg = l_reg * alpha + rowsum32(p0, p1); }
        else if (MODE == M_C2) { const float mnL = -m_reg * C2;
#pragma unroll
            for (int r = 0; r < 16; ++r) { p0[r] = __builtin_amdgcn_exp2f(fmaf(p0[r], C2, mnL)) * invl; p1[r] = __builtin_amdgcn_exp2f(fmaf(p1[r], C2, mnL)) * invl; }
            if (do_imp) { LAS unsigned* imp = (LAS unsigned*)(lds + L_IMP) + ((wid & 1) * 32 + r32) * IMP_LD + 16 * j + hi;
#pragma unroll
                for (int k = 0; k < 4; ++k) {
                    { const float e_ = p0[4 * k + 3], a_ = 2.f * (p0[4 * k] + p0[4 * k + 1] + p0[4 * k + 2]) + e_;
                      LADD(imp + 2 * k, (unsigned)(a_ * 67108864.f + 0.5f)); LADD(imp + 2 * k + 1, (unsigned)(e_ * 67108864.f + 0.5f)); }
                    { const float e_ = p1[4 * k + 3], a_ = 2.f * (p1[4 * k] + p1[4 * k + 1] + p1[4 * k + 2]) + e_;
                      LADD(imp + 8 + 2 * k, (unsigned)(a_ * 67108864.f + 0.5f)); LADD(imp + 8 + 2 * k + 1, (unsigned)(e_ * 67108864.f + 0.5f)); } } }
            pack_p(p0, p1, pa0, pa1, pa2, pa3); }
        else { const float pmax = rowmax32(p0, p1); float mn, alpha;
            if (__builtin_expect(__all((pmax - m_reg) * SCALE <= THR), 1)) { mn = m_reg; alpha = 1.f; }
            else { mn = fmaxf(m_reg, pmax); alpha = __builtin_amdgcn_exp2f((m_reg - mn) * C2); m_reg = mn; }
            const float mnL = -mn * C2;
#pragma unroll
            for (int r = 0; r < 16; ++r) { p0[r] = __builtin_amdgcn_exp2f(fmaf(p0[r], C2, mnL)); p1[r] = __builtin_amdgcn_exp2f(fmaf(p1[r], C2, mnL)); }
            l_reg = l_reg * alpha + rowsum32(p0, p1);
            pack_p(p0, p1, pa0, pa1, pa2, pa3);
            if (__any(alpha < 1.f)) { if (hi == 0) al_l[r32] = alpha; asm volatile("s_waitcnt lgkmcnt(0)" ::: "memory");
#pragma unroll
                for (int d_ = 0; d_ < 4; ++d_)
#pragma unroll
                    for (int r = 0; r < 16; ++r) o[d_][r] *= al_l[crow(r, hi)]; } }
        if (HASV && !late) { SBAR(); pv_tile(o, vb0 + vof, pa0, pa1, pa2, pa3); }
        const int kn = kof ^ SHM_K, vn = (vof == 2 * SHM_V) ? 0 : vof + SHM_V;
        if (idx + 1 < NT) { SWRITE(kn, vn); }
        __syncthreads();
        vprev = vof; kof = kn; vof = vn;
    }
    if (HASV) { if (late) { SBAR(); pv_tile(o, vb0 + vprev, pa0, pa1, pa2, pa3); } __syncthreads(); }
    st.m = m_reg; st.l = l_reg;
#undef SLOAD
#undef SWRITE
}

template <int MODE>
__device__ __forceinline__ void branch_out(LAS unsigned char* lds, const f32x16* o, float rowscale, bf16_t* onsa_w, const bf16_t* gn_w) {
    const int tid = otid(), wid = __builtin_amdgcn_readfirstlane(tid >> 6), lane = tid & 63, r32 = lane & 31, hi = lane >> 5;
    LAS float* li_l = (LAS float*)(lds + L_WS) + wid * 64;
    if (hi == 0) li_l[r32] = rowscale; asm volatile("s_waitcnt lgkmcnt(0)" ::: "memory");
    float rli[16];
#pragma unroll
    for (int r = 0; r < 16; ++r) rli[r] = li_l[crow(r, hi)];
#pragma unroll
    for (int r = 0; r < 16; ++r) { int rr_ = r; asm volatile("" : "+v"(rr_)); const int orow = crow(rr_, hi);
#pragma unroll
        for (int d0 = 0; d0 < 4; ++d0) { const float v = o[d0][r] * rli[r]; const float vn = __shfl_xor(v, 1);
            if ((r32 & 1) == 0) { unsigned* p = (unsigned*)(onsa_w + (size_t)orow * 2048 + d0 * 32 + r32); float a = v, b = vn;
                if (MODE >= 1) { const unsigned w = *p; a += bflo(w); b += bfhi(w); }
                if (MODE == 2) { const unsigned gw_ = *(const unsigned*)(gn_w + (size_t)orow * 2048 + d0 * 32 + r32); a *= bflo(gw_); b *= bfhi(gw_); }
                *p = cvtpk(a, b); } } }
}

__device__ __forceinline__ void attn_unit(LAS unsigned char* lds, unsigned char* ws, int h, int Tq) {
    const int tid = otid(), wid = __builtin_amdgcn_readfirstlane(tid >> 6), lane = tid & 63, r32 = lane & 31, hi = lane >> 5;
    const int g = wid >> 1, tl = (wid & 1) * 32 + r32, t = Tq * 64 + tl, hq = 4 * h + g;
    const bf16_t* Q = (const bf16_t*)(ws + WS_Q); const bf16_t* GBR = (const bf16_t*)(ws + WS_GBR);
    bf16_t* onsa_w = (bf16_t*)(ws + WS_U) + (size_t)(Tq * 64 + (wid & 1) * 32) * 2048 + hq * 128; const bf16_t* gn_w = (const bf16_t*)(ws + WS_GN) + (size_t)(Tq * 64 + (wid & 1) * 32) * 2048 + hq * 128;
    bf16x8 qr[8];
#pragma unroll
    for (int d0 = 0; d0 < 8; ++d0) qr[d0] = *(const bf16x8*)(Q + (size_t)t * 2048 + hq * 128 + d0 * 16 + hi * 8);
    const float g_c = bf2f(GBR[(size_t)t * 256 + hq * 3 + 0]), g_s = bf2f(GBR[(size_t)t * 256 + hq * 3 + 1]), g_w = bf2f(GBR[(size_t)t * 256 + hq * 3 + 2]);
    const bool big = Tq >= 16;
    LAS unsigned* IMP = (LAS unsigned*)(lds + L_IMP);
    if (big) { for (int i = tid; i < 64 * IMP_LD; i += 512) IMP[i] = 0u; }
    const u32x4 nosel = {0u, 0u, 0u, 0u};
    f32x16 o[4];
    {
        const bf16_t* Kc = (const bf16_t*)(ws + WS_KC) + (size_t)h * 512 * 128; const bf16_t* Vc = (const bf16_t*)(ws + WS_VC) + (size_t)h * 512 * 128;
        const int ntc = ((4 * Tq + 2) >> 6) + 1;
        RowState stc{-1e30f, 0.f};
        attn_pass<M_C1>(lds, Kc, Vc, 128, 0, ntc, qr, t, Tq, nosel, stc, 0.f, o, false);
        const float invl = stc.l > 0.f ? 1.0f / stc.l : 0.f;
#pragma unroll
        for (int d = 0; d < 4; ++d) o[d] = f32x16{};
        attn_pass<M_C2>(lds, Kc, Vc, 128, 0, ntc, qr, t, Tq, nosel, stc, invl, o, big);
        branch_out<0>(lds, o, g_c, onsa_w, gn_w);
    }
    {
        LAS unsigned short* SELM = (LAS unsigned short*)(lds + L_SELM);
        int tok = tid >> 3, sub = tid & 7; asm volatile("" : "+v"(tok), "+v"(sub));
        unsigned bits = 0u;
        if (big) {
            unsigned kv[16];
#pragma unroll
            for (int e = 0; e < 16; ++e) { const int j = sub * 16 + e; const unsigned v = IMP[tok * IMP_LD + j]; kv[e] = (j >= 1 && j <= Tq - 2) ? v + 1u : 0u; }
            for (int round = 0; round < 13; ++round) {
                unsigned bv = kv[0]; int bj = 0;
#pragma unroll
                for (int e = 1; e < 16; ++e) { const bool gt = kv[e] > bv; bv = gt ? kv[e] : bv; bj = gt ? e : bj; }
                bj += sub * 16;
#pragma unroll
                for (int sh = 1; sh < 8; sh <<= 1) { const unsigned ov = __shfl_xor(bv, sh); const int oj = __shfl_xor(bj, sh);
                    const bool take = (ov > bv) || (ov == bv && oj < bj); bv = take ? ov : bv; bj = take ? oj : bj; }
                const int we = (bv != 0u && (bj >> 4) == sub) ? (bj & 15) : -1;
#pragma unroll
                for (int e = 0; e < 16; ++e) { const bool hit = (we == e); bits |= hit ? (1u << e) : 0u; kv[e] = hit ? 0u : kv[e]; }
            }
#pragma unroll
            for (int e = 0; e < 16; ++e) { const int j = sub * 16 + e; if (j == 0 || j == Tq - 1 || j == Tq) bits |= 1u << e; }
        } else {
#pragma unroll
            for (int e = 0; e < 16; ++e) { const int j = sub * 16 + e; if (j <= Tq) bits |= 1u << e; }
        }
        SELM[tok * 8 + sub] = (unsigned short)bits;
        __syncthreads();
    }
    const u32x4 sel = *(const LAS u32x4*)(lds + L_SELM + tl * 16);
    {
        RowState sts{-1e30f, 0.f};
#pragma unroll
        for (int d = 0; d < 4; ++d) o[d] = f32x16{};
        attn_pass<M_S>(lds, (const bf16_t*)(ws + WS_KS) + h * 128, (const bf16_t*)(ws + WS_VS) + h * 128, 512, 0, Tq + 1, qr, t, Tq, sel, sts, 0.f, o, false);
        branch_out<1>(lds, o, sts.l > 0.f ? g_s / sts.l : 0.f, onsa_w, gn_w);
    }
    {
        RowState stw{-1e30f, 0.f};
#pragma unroll
        for (int d = 0; d < 4; ++d) o[d] = f32x16{};
        attn_pass<M_W>(lds, (const bf16_t*)(ws + WS_KW) + h * 128, (const bf16_t*)(ws + WS_VW) + h * 128, 512, Tq >= 8 ? Tq - 8 : 0, Tq + 1, qr, t, Tq, sel, stw, 0.f, o, false);
        branch_out<2>(lds, o, stw.l > 0.f ? g_w / stw.l : 0.f, onsa_w, gn_w);
    }
    __syncthreads();
}
#undef KSWZ
#undef SBAR
}

constexpr int NPHASE = 8;
__global__ void __launch_bounds__(NWAVES * 64, 2) mega_fwd(Args args) {
    extern __shared__ __attribute__((aligned(16))) unsigned char lds[];
    Frame F;
    F.lds = (LAS unsigned char*)lds;
    F.tid = threadIdx.x; F.lane = F.tid & 63; F.wave = __builtin_amdgcn_readfirstlane(F.tid >> 6);
    F.G = gridDim.x; { const int bx = blockIdx.x; F.vcu = (F.G % 8 == 0) ? (bx % 8) * (F.G / 8) + bx / 8 : bx; }
    volatile LAS unsigned* MISC = (volatile LAS unsigned*)(F.lds + MISC_OFF);
    unsigned char* ws = args.ws;
    for (int u = F.tid; u < (LDS_BYTES - LDSCTL_OFF) / 4; u += NWAVES * 64) ((LAS unsigned*)(F.lds + LDSCTL_OFF))[u] = 0u;
    __syncthreads();
    XcdBarrier bar; bar.bar = (unsigned*)(ws + WS_CTL) + CW_BAR; bar.x = 0; bar.st = nullptr;
#if !N_LAUNCHES_PER_PHASE
    bar = xcd_barrier_post((unsigned*)(ws + WS_CTL) + CW_BAR, MISC + 8);
#endif
    const int lo = args.ph_lo, hi = args.ph_hi;
#define IN(k) (lo <= (k) && (k) < hi && (F.tid = otid(), F.lane = F.tid & 63, true))
#define SEAM(k) do { if (IN(k) && IN((k) + 1)) xcd_barrier(bar); } while (0)
    bf16_t* const GM = (bf16_t*)args.out;

    for (int rep_ = 0; rep_ < (DUP_PHASE == 0 ? 2 : 1); ++rep_) if (IN(0)) { if (rep_) xcd_barrier(bar); p0_prologue(F, args); } SEAM(0);
    for (int rep_ = 0; rep_ < (DUP_PHASE == 1 ? 2 : 1); ++rep_) if (IN(1)) { if (rep_) xcd_barrier(bar);
        pg8::Gemm g{(const bf16_t*)(ws + WS_H), (const bf16_t*)(ws + WS_WCAT), 2048, 2048, 2048};
        pg8::StaticOrder So; So.init(S, NCAT, F.G, (int)blockIdx.x);
        EpiInProj E{ws, GM, args.in[14]};
        pg8::AddrAffine AD{(size_t)256 * 2048 * 2, (size_t)256 * 2048 * 2};
        pg8::gemm_phase<EpiInProj, true>(F.lds, g, So, E, AD);
        { const int nun = (So.nwg + F.G - 1) / F.G, full = So.nwg - (nun - 1) * F.G;
          const int base = full < F.G ? full : 0; if ((int)blockIdx.x >= base) p1_late_weights(F, args, ((int)blockIdx.x - base) * NWAVES + F.wave, (F.G - base) * NWAVES); }
    } SEAM(1);
    for (int rep_ = 0; rep_ < (DUP_PHASE == 2 ? 2 : 1); ++rep_) if (IN(2)) { if (rep_) xcd_barrier(bar);
        pg8::Gemm g{(const bf16_t*)(ws + WS_KCR), (const bf16_t*)(ws + WS_W1KT), 2048, 4096, 4096 / NSPLIT};
        pg8::StaticOrder So; So.init(16 * 256, NSPLIT * 256, F.G, (int)blockIdx.x);
        EpiSlab E{(float*)(ws + WS_SLAB)};
        pg8::AddrCmp AD{(4096 / NSPLIT) / 64};
        pg8::gemm_phase<EpiSlab, false>(F.lds, g, So, E, AD);
        { const int base = F.G > So.nwg ? So.nwg : 0; if ((int)blockIdx.x >= base) p2_ypool(F, ws, args.in[4], ((int)blockIdx.x - base) * NWAVES + F.wave, (F.G - base) * NWAVES); }
        if (blockIdx.x == F.G - 1) { const float* b1p = (const float*)(ws + WS_B1P); float* b1 = (float*)(ws + WS_B1); const int t = F.tid; float s = 0.f;
            for (int c = 0; c < 64; ++c) s += b1p[((t >> 8) * 64 + c) * 256 + (t & 255)];
            b1[t] = s; }
    } SEAM(2);
    for (int rep_ = 0; rep_ < (DUP_PHASE == 3 ? 2 : 1); ++rep_) if (IN(3)) { if (rep_) xcd_barrier(bar);
        p3_compress2(F, ws, (int)blockIdx.x, F.G);
        pg8::Gemm g{(const bf16_t*)(ws + WS_H + 16 * MiB), (const bf16_t*)(ws + WS_WPOT), 1024, 1024, 1024};
        pg8::StaticOrder So; So.init(S, 2048, F.G, (int)blockIdx.x);
        EpiYa E{(bf16_t*)(ws + WS_YAG), GM};
        pg8::AddrAffine AD{(size_t)256 * 1024 * 2, (size_t)256 * 1024 * 2};
        pg8::gemm_phase<EpiYa, false>(F.lds, g, So, E, AD);
    } SEAM(3);
    for (int rep_ = 0; rep_ < (DUP_PHASE == 5 ? 2 : 1); ++rep_) if (IN(5)) { if (rep_) xcd_barrier(bar);
        for (int p = F.vcu; p < 256; p += F.G) {
#pragma unroll 1
            for (int i = 0; i < 2; ++i) { const int h = p >> 6, x = p & 63; nsa::attn_unit(F.lds, ws, h, i ? x : 127 - x); } }
    } SEAM(5);
    for (int rep_ = 0; rep_ < (DUP_PHASE == 6 ? 2 : 1); ++rep_) if (IN(6)) { if (rep_) xcd_barrier(bar);
        pg8::Gemm g{(const bf16_t*)(ws + WS_U), (const bf16_t*)(ws + WS_WNOT), 2048, 2048, 2048}; pg8::AddrAffine AD{(size_t)256 * 2048 * 2, (size_t)256 * 2048 * 2};
        pg8::StaticOrder So; So.init(S, 2048, F.G, (int)blockIdx.x);
        EpiYb E{(bf16_t*)(ws + WS_H), (const bf16_t*)(ws + WS_YAG), GM};
        pg8::gemm_phase<EpiYb, false>(F.lds, g, So, E, AD);
    } SEAM(6);
    for (int rep_ = 0; rep_ < (DUP_PHASE == 7 ? 2 : 1); ++rep_) if (IN(7)) { if (rep_) xcd_barrier(bar);
        pg8::Gemm g{(const bf16_t*)(ws + WS_H), (const bf16_t*)(ws + WS_WOT), 2048, 2048, 2048}; pg8::AddrAffine AD{(size_t)256 * 2048 * 2, (size_t)256 * 2048 * 2};
        pg8::StaticOrder So; So.init(S, 2048, F.G, (int)blockIdx.x);
        EpiOut E{args.out, args.in[0], (float*)(ws + WS_SSQ), args.in[16], (unsigned*)(ws + WS_CTL), F.lds};
        pg8::gemm_phase<EpiOut, true>(F.lds, g, So, E, AD);
    }
#undef IN
#undef SEAM
}

extern "C" void kernel_launch(void* const* d_in, const int* in_sizes, int n_in, void* d_out, int out_size, void* d_ws, size_t ws_size, hipStream_t stream) {
    static int grid = 0;
    if (grid == 0) {
        if (n_in != 17 || in_sizes[0] != S * DM || out_size != S * DM || ws_size < WS_END) { fprintf(stderr, "kernel_launch: unexpected shapes (n_in %d, in0 %d, out %d, ws %zu); nothing launched\n", n_in, n_in > 0 ? in_sizes[0] : -1, out_size, ws_size); grid = -1; return; }
        int dev = 0, cus = 0;
        if (hipGetDevice(&dev) != hipSuccess || hipDeviceGetAttribute(&cus, hipDeviceAttributeMultiprocessorCount, dev) != hipSuccess) { fprintf(stderr, "kernel_launch: device query failed\n"); grid = -1; return; }
        if (hipFuncSetAttribute((const void*)mega_fwd, hipFuncAttributeMaxDynamicSharedMemorySize, LDS_BYTES) != hipSuccess) { fprintf(stderr, "kernel_launch: hipFuncSetAttribute failed\n"); grid = -1; return; }
        (void)hipGetLastError();
        grid = cus;
    }
    if (grid < 0) return;
    (void)hipMemsetAsync((char*)d_ws + WS_CTL, 0, CTL_BYTES, stream);
    Args a{};
    for (int i = 0; i < 17; ++i) a.in[i] = (const float*)d_in[i];
    a.out = (float*)d_out; a.ws = (unsigned char*)d_ws;
#if N_LAUNCHES_PER_PHASE
    for (int p = 0; p < NPHASE; ++p) { a.ph_lo = p; a.ph_hi = p + 1; hipLaunchKernelGGL(mega_fwd, dim3(grid), dim3(NWAVES * 64), LDS_BYTES, stream, a); }
#else
    a.ph_lo = 0; a.ph_hi = NPHASE;
    hipLaunchKernelGGL(mega_fwd, dim3(grid), dim3(NWAVES * 64), LDS_BYTES, stream, a);
#endif
}
```

```cpp
#include <hip/hip_runtime.h>
#include <cstdio>
#include <cstdint>

#define LAS __attribute__((address_space(3)))
#define GAS __attribute__((address_space(1)))
typedef unsigned short bf16_t;
typedef short bf16x8 __attribute__((ext_vector_type(8)));
typedef short s16x4 __attribute__((ext_vector_type(4)));
typedef float f32x4 __attribute__((ext_vector_type(4)));
typedef float f32x16 __attribute__((ext_vector_type(16)));
typedef unsigned u32x4 __attribute__((ext_vector_type(4)));
typedef unsigned u32x2 __attribute__((ext_vector_type(2)));
typedef float f32x2_t __attribute__((ext_vector_type(2)));
typedef __bf16 bf16x2_t __attribute__((ext_vector_type(2)));

#ifndef EXP_QKT2
#define EXP_QKT2 0
#endif
#ifndef DUP_PHASE
#define DUP_PHASE -1
#endif
#ifndef N_LAUNCHES_PER_PHASE
#define N_LAUNCHES_PER_PHASE 0
#endif

constexpr int S = 8192, DM = 2048, NCAT = 13568;
constexpr int HD = 128, NKV = 4, NCMP = 511;
constexpr float EPS = 1e-6f;

constexpr size_t MiB = 1u << 20;
constexpr size_t WS_CTL = 0, CTL_BYTES = 1 * MiB;
constexpr size_t WS_WCAT = 1 * MiB;
constexpr size_t WS_SLAB = WS_WCAT;
constexpr size_t WS_ONSA = WS_WCAT;
constexpr size_t WS_MIXT = 54 * MiB;
constexpr size_t WS_WPOT = 55 * MiB;
constexpr size_t WS_WNOT = 59 * MiB;
constexpr size_t WS_WOT  = 67 * MiB;
constexpr size_t WS_W1KT = 75 * MiB, WS_W1VT = 77 * MiB;
constexpr size_t WS_W2KT = 79 * MiB, WS_W2VT = 79 * MiB + 65536;
constexpr size_t WS_B1P  = 80 * MiB + 262144;
constexpr size_t WS_B1   = 79 * MiB + 131072 + 32768;
constexpr size_t WS_KC   = 79 * MiB + 262144, WS_VC = 79 * MiB + 786432;
constexpr size_t WS_ROPE = 81 * MiB;
constexpr size_t WS_SSQ  = 85 * MiB;
constexpr size_t WS_H    = 86 * MiB;
constexpr size_t WS_U    = 118 * MiB, WS_GP = 134 * MiB;
constexpr size_t WS_YAG  = WS_U;
constexpr size_t WS_Q    = 150 * MiB;
constexpr size_t WS_KCR  = 182 * MiB, WS_VCR = 190 * MiB, WS_KS = 198 * MiB, WS_VS = 206 * MiB, WS_KW = 214 * MiB, WS_VW = 222 * MiB;
constexpr size_t WS_GN   = 230 * MiB;
constexpr size_t WS_GBR  = 262 * MiB;
constexpr size_t WS_END  = 266 * MiB;
constexpr int CW_BAR = 4096;

constexpr int RING_BYTES = 131072;
constexpr int LDSCTL_OFF = RING_BYTES, MISC_OFF = LDSCTL_OFF + 320;
constexpr int LDS_BYTES = 147456;
constexpr int NWAVES = 8;

#define LDS_WAIT() asm volatile("s_waitcnt lgkmcnt(0)" ::: "memory")
#define VM_WAIT() asm volatile("s_waitcnt vmcnt(0)" ::: "memory")

__device__ __forceinline__ unsigned cvtpk(float lo, float hi) { f32x2_t v = {lo, hi}; bf16x2_t b = __builtin_convertvector(v, bf16x2_t); return __builtin_bit_cast(unsigned, b); }
__device__ __forceinline__ float bf2f(unsigned short h) { return __builtin_bit_cast(float, (unsigned)h << 16); }
__device__ __forceinline__ float bflo(unsigned w) { return __builtin_bit_cast(float, w << 16); }
__device__ __forceinline__ float bfhi(unsigned w) { return __builtin_bit_cast(float, w & 0xffff0000u); }
__device__ __forceinline__ float sigmoidf_(float x) { return __builtin_amdgcn_rcpf(1.0f + __expf(-x)); }
__device__ __forceinline__ float siluf_(float x) { return x * __builtin_amdgcn_rcpf(1.0f + __expf(-x)); }
__device__ __forceinline__ int otid() { int t = threadIdx.x; asm volatile("" : "+v"(t)); return t; }
__device__ __forceinline__ int crow(int r, int hi) { return (r & 3) + 8 * (r >> 2) + 4 * hi; }
__device__ __forceinline__ float wave_sum(float v) {
#pragma unroll
    for (int o = 1; o < 64; o <<= 1) v += __shfl_xor(v, o);
    return v;
}

#define XB_TMO      128
#define XB_XCNT(j)  (256  + 64 * (j))
#define XB_XSUB(j)  (1280 + 64 * (j))
#define XB_XGEN(j)  (2304 + 64 * (j))
#define XB_TOP      3328
#define XB_TOPGEN   3392
#define XCD_BAR_WORDS 3456
#define XB_SPIN_CAP (1u << 18)
__device__ __forceinline__ unsigned xb_ld(unsigned* p)              { return __hip_atomic_load(p, __ATOMIC_RELAXED, __HIP_MEMORY_SCOPE_AGENT); }
__device__ __forceinline__ unsigned xb_add(unsigned* p, unsigned v) { return __hip_atomic_fetch_add(p, v, __ATOMIC_RELAXED, __HIP_MEMORY_SCOPE_AGENT); }
__device__ __forceinline__ unsigned xb_xcc_id() { return (unsigned)__builtin_amdgcn_s_getreg((3 << 11) | 20) & 0xFu; }
#define XB_SPIN(cond, bar) do { unsigned _sp = 0; while (cond) { __builtin_amdgcn_s_sleep(1); \
    if ((++_sp & 255u) == 0u) { if (xb_ld(&(bar)[XB_TMO])) break; if (_sp > XB_SPIN_CAP) { atomicAdd(&(bar)[XB_TMO], 1u); break; } } } } while (0)
struct XcdBarrier { unsigned* bar; unsigned x; volatile LAS unsigned* st; };
__device__ __forceinline__ XcdBarrier xcd_barrier_post(unsigned* bar, volatile LAS unsigned* st) {
    XcdBarrier b; b.bar = bar; b.x = xb_xcc_id(); b.st = st;
    if (threadIdx.x == 0) (void)xb_add(&bar[XB_XCNT(b.x)], 1u);
    return b;
}
__device__ __forceinline__ void xcd_barrier_complete(unsigned* bar, unsigned x, unsigned& nloc, unsigned& nx) {
    const unsigned G = gridDim.x * gridDim.y * gridDim.z;
    unsigned sum, cnt, mine, sp = 0u;
    for (;;) {
        sum = 0u; cnt = 0u; mine = 0u;
#pragma unroll
        for (unsigned j = 0; j < 16; ++j) { const unsigned c = xb_ld(&bar[XB_XCNT(j)]); sum += c; cnt += (c > 0u) ? 1u : 0u; mine = (j == x) ? c : mine; }
        if (sum == G) break;
        __builtin_amdgcn_s_sleep(1);
        if ((++sp & 255u) == 0u) { if (xb_ld(&bar[XB_TMO])) break; if (sp > XB_SPIN_CAP) { atomicAdd(&bar[XB_TMO], 1u); break; } }
    }
    nloc = mine > 0u ? mine : 1u; nx = cnt > 0u ? cnt : 1u;
}
__device__ __forceinline__ void xcd_barrier(const XcdBarrier& b) {
    asm volatile("s_waitcnt vmcnt(0)" ::: "memory");
    __syncthreads();
    if (threadIdx.x == 0) {
        unsigned* bar = b.bar;
        __builtin_amdgcn_s_waitcnt(0);
        unsigned nloc = b.st[0], nx = b.st[1];
        if (nloc == 0u) { xcd_barrier_complete(bar, b.x, nloc, nx); b.st[0] = nloc; b.st[1] = nx; }
        const unsigned old = xb_add(&bar[XB_XSUB(b.x)], 1u);
        const unsigned gen = old / nloc;
        if (old + 1u == (gen + 1u) * nloc) {
            __builtin_amdgcn_fence(__ATOMIC_RELEASE, "agent");
            asm volatile("s_waitcnt vmcnt(0)" ::: "memory");
            const unsigned og = xb_add(&bar[XB_TOP], 1u);
            const unsigned tg = og / nx;
            if (og + 1u == (tg + 1u) * nx) xb_add(&bar[XB_TOPGEN], 1u);
            else XB_SPIN(xb_ld(&bar[XB_TOPGEN]) == tg, bar);
            __builtin_amdgcn_fence(__ATOMIC_ACQUIRE, "agent");
            xb_add(&bar[XB_XGEN(b.x)], 1u);
            asm volatile("s_waitcnt vmcnt(0)" ::: "memory");
        } else {
            XB_SPIN(xb_ld(&bar[XB_XGEN(b.x)]) == gen, bar);
            __builtin_amdgcn_fence(__ATOMIC_ACQUIRE, "agent");
            asm volatile("s_waitcnt vmcnt(0)" ::: "memory");
        }
    }
    __syncthreads();
}

namespace pg8 {
constexpr int BM = 256, BK = 64, HALF = 128, HTB = HALF * BK * 2, STAGE_BYTES = 8 * HTB, NXCD = 8, WGM = 8;
__host__ __device__ __forceinline__ int lds_byte(int r, int c) { const int st = (r >> 4) * 2 + (c >> 5), rr = r & 15, cc = c & 31, ob = rr * 64 + cc * 2; return st * 1024 + (ob ^ (((ob >> 9) & 1) << 5)); }
__host__ __device__ __forceinline__ void stage_rc(int b, int& R, int& C) { const int st = b / 1024, sb = b % 1024, swz = sb ^ (((sb >> 9) & 1) << 5); R = (st >> 1) * 16 + swz / 64; C = (st & 1) * 32 + (swz % 64) / 2; }
__host__ __device__ __forceinline__ int perm32(int rho) { const int n = rho >> 4, i = rho & 15; return 8 * (i >> 2) + 4 * n + (i & 3); }
struct Unit { int pm, pn; };
struct Gemm { const bf16_t* A; const bf16_t* Bt; int lda, ldb, K; };
struct AddrAffine { size_t tA, tB;
    __device__ __forceinline__ const char* A(const char* b, const Unit& u) const { return b + (size_t)u.pm * tA; }
    __device__ __forceinline__ const char* B(const char* b, const Unit& u) const { return b + (size_t)u.pn * tB; }
    __device__ __forceinline__ size_t ka(int t) const { return (size_t)t * (BK * 2); } };
struct AddrCmp { int ntile;
    __device__ __forceinline__ const char* A(const char* b, const Unit& u) const { return b + (size_t)(u.pm >> 3) * (8 * MiB) + (size_t)((u.pm >> 1) & 3) * (2 * MiB) + (size_t)(u.pm & 1) * (256 * 4096) + ka(u.pn * ntile); }
    __device__ __forceinline__ const char* B(const char* b, const Unit& u) const { return b + (size_t)(u.pm >> 3) * (2 * MiB) + (size_t)u.pn * ntile * (BK * 2); }
    __device__ __forceinline__ size_t ka(int t) const { return (size_t)t * (BK * 2); } };
struct StaticOrder {
    int nM, nN, nwg, G, c;
    __host__ __device__ void init(int M, int N, int G_, int c_) { nM = M / BM; nN = N / BM; nwg = nM * nN; G = G_; c = c_; }
    __host__ __device__ bool next(int i, Unit& u) const {
        const long L = (long)i * G + c; if (L >= nwg) return false;
        int wgid = (int)L; { const int q = nwg / NXCD, r = nwg % NXCD, xcd = wgid % NXCD, off = wgid / NXCD; wgid = (xcd < r ? xcd * (q + 1) : r * (q + 1) + (xcd - r) * q) + off; }
        const int nig = WGM * nN, gid = wgid / nig, fm = gid * WGM, gsz = (nM - fm) < WGM ? (nM - fm) : WGM;
        u.pm = fm + ((wgid % nig) % gsz); u.pn = (wgid % nig) / gsz; return true;
    }
};
template <class Epi, bool ALIGN_EPI, class Addr>
__device__ __forceinline__ void gemm_phase(LAS unsigned char* lds, const Gemm g, const StaticOrder& S, const Epi& E, const Addr& AD) {
    const int tid = otid(), wid = __builtin_amdgcn_readfirstlane(tid >> 6), lane = tid & 63, wr = wid >> 2, wc = wid & 3, fr = lane & 15, fq = lane >> 4;
    const int K = g.K, nt = K / BK;
    unsigned voffA[2], voffB[2];
#pragma unroll
    for (int i = 0; i < 2; ++i) { int R, C; stage_rc(tid * 16 + i * 8192, R, C); const int Rb = (R & ~31) + perm32(R & 31);
        voffA[i] = (unsigned)(R * g.lda + C) * 2u; voffB[i] = (unsigned)(Rb * g.ldb + C) * 2u; }
    const size_t kstep = (size_t)(BK * 2);
    const size_t hA = (size_t)HALF * g.lda * 2, hB = (size_t)HALF * g.ldb * 2;
    const unsigned ldsw = (unsigned)wid * 1024u;
    const int aoff = lds_byte(wr * 64 + fr, fq * 8), boff = lds_byte(wc * 32 + fr, fq * 8);
#define PG8_SA(b, h) (((b) * 2 + (h)) * HTB)
#define PG8_SB(b, h) ((4 + (b) * 2 + (h)) * HTB)
#define PG8_STAGE(bufoff, gbase, voff) do { _Pragma("unroll") for (int _i = 0; _i < 2; ++_i) \
        __builtin_amdgcn_global_load_lds((const unsigned*)((const char*)(gbase) + (voff)[_i]), (LAS unsigned*)(lds + (bufoff) + ldsw + _i * 8192), 16, 0, 0); } while (0)
#define PG8_LDA(dst, b, h) do { _Pragma("unroll") for (int m = 0; m < 4; ++m) _Pragma("unroll") for (int k = 0; k < 2; ++k) dst[m][k] = *(const LAS bf16x8*)(lds + PG8_SA(b, h) + aoff + m * 2048 + k * 1024); } while (0)
#define PG8_LDB(dst, b, h) do { _Pragma("unroll") for (int n = 0; n < 2; ++n) _Pragma("unroll") for (int k = 0; k < 2; ++k) dst[n][k] = *(const LAS bf16x8*)(lds + PG8_SB(b, h) + boff + n * 2048 + k * 1024); } while (0)
#define PG8_MMA(ai, bj, At, Bt) do { __builtin_amdgcn_s_setprio(1); _Pragma("unroll") for (int m = 0; m < 4; ++m) _Pragma("unroll") for (int n = 0; n < 2; ++n) _Pragma("unroll") for (int k = 0; k < 2; ++k) \
        acc[ai][bj][m][n] = __builtin_amdgcn_mfma_f32_16x16x32_bf16(Bt[n][k], At[m][k], acc[ai][bj][m][n], 0, 0, 0); __builtin_amdgcn_s_setprio(0); } while (0)
#define PG8_WAIT_V(n) asm volatile("s_waitcnt vmcnt(" #n ")" ::: "memory")
#define PG8_WAIT_L(n) asm volatile("s_waitcnt lgkmcnt(" #n ")" ::: "memory")
#define PG8_BAR __builtin_amdgcn_s_barrier()
#define PG8_SCHED __builtin_amdgcn_sched_barrier(0)
    Unit cur, nxt; int ui = 0;
    if (!S.next(0, cur)) return;
    f32x4 acc[2][2][4][2];
#pragma unroll
    for (int a = 0; a < 2; ++a)
#pragma unroll
        for (int b = 0; b < 2; ++b)
#pragma unroll
            for (int m = 0; m < 4; ++m)
#pragma unroll
                for (int n = 0; n < 2; ++n) acc[a][b][m][n] = (f32x4){0.f, 0.f, 0.f, 0.f};
    bf16x8 At[4][2], B0[2][2], B1[2][2];
    const char* cA = AD.A((const char*)g.A, cur); const char* cB = AD.B((const char*)g.Bt, cur);
    PG8_STAGE(PG8_SB(0, 0), cB, voffB); PG8_STAGE(PG8_SB(0, 1), cB + hB, voffB); PG8_STAGE(PG8_SA(0, 0), cA, voffA); PG8_STAGE(PG8_SA(0, 1), cA + hA, voffA);
    if (wr == 1) PG8_BAR;
    PG8_WAIT_V(2); PG8_BAR;
    PG8_STAGE(PG8_SB(1, 0), cB + kstep, voffB); PG8_STAGE(PG8_SA(1, 0), cA + kstep, voffA); PG8_STAGE(PG8_SB(1, 1), cB + hB + kstep, voffB);
    PG8_WAIT_V(6); PG8_BAR;
    for (;;) {
        const bool has_next = S.next(ui + 1, nxt);
        const char* nA = has_next ? AD.A((const char*)g.A, nxt) : cA; const char* nB = has_next ? AD.B((const char*)g.Bt, nxt) : cB;
        for (int t = 0; t < nt; t += 2) {
            const bool last = (t == nt - 2);
            const char* a1 = cA + AD.ka(t) + kstep;
            const char* a2 = last ? nA : cA + AD.ka(t + 2); const char* b2 = last ? nB : cB + (size_t)(t + 2) * kstep;
            const char* a3 = a2 + kstep; const char* b3 = b2 + kstep;
            PG8_LDB(B0, 0, 0); PG8_LDB(B1, 0, 1); PG8_SCHED; PG8_LDA(At, 0, 0); PG8_STAGE(PG8_SA(1, 1), a1 + hA, voffA);
            PG8_WAIT_V(8); PG8_WAIT_L(0); PG8_BAR; PG8_MMA(0, 0, At, B0); PG8_MMA(0, 1, At, B1); PG8_BAR; PG8_SCHED;
            PG8_LDA(At, 0, 1); PG8_STAGE(PG8_SB(0, 0), b2, voffB); PG8_STAGE(PG8_SB(0, 1), b2 + hB, voffB); PG8_STAGE(PG8_SA(0, 0), a2, voffA);
            PG8_WAIT_V(8); PG8_WAIT_L(0); PG8_BAR; PG8_MMA(1, 0, At, B0); PG8_MMA(1, 1, At, B1); PG8_BAR; PG8_SCHED;
            PG8_LDB(B0, 1, 0); PG8_LDB(B1, 1, 1); PG8_SCHED; PG8_LDA(At, 1, 0); PG8_STAGE(PG8_SA(0, 1), a2 + hA, voffA);
            PG8_WAIT_V(8); PG8_WAIT_L(0); PG8_BAR; PG8_MMA(0, 0, At, B0); PG8_MMA(0, 1, At, B1); PG8_BAR; PG8_SCHED;
            PG8_LDA(At, 1, 1); PG8_STAGE(PG8_SB(1, 0), b3, voffB); PG8_STAGE(PG8_SB(1, 1), b3 + hB, voffB); PG8_STAGE(PG8_SA(1, 0), a3, voffA);
            PG8_WAIT_V(8); PG8_WAIT_L(0); PG8_BAR; PG8_MMA(1, 0, At, B0); PG8_MMA(1, 1, At, B1); PG8_BAR; PG8_SCHED;
        }
        if constexpr (ALIGN_EPI) { if (wr == 0) PG8_BAR; }
        E(acc, cur, wr, wc, fr, fq);
        if (!has_next) break;
#pragma unroll
        for (int a = 0; a < 2; ++a)
#pragma unroll
            for (int b = 0; b < 2; ++b)
#pragma unroll
                for (int m = 0; m < 4; ++m)
#pragma unroll
                    for (int n = 0; n < 2; ++n) acc[a][b][m][n] = (f32x4){0.f, 0.f, 0.f, 0.f};
        cur = nxt; cA = nA; cB = nB; ++ui;
        if constexpr (ALIGN_EPI) { if (wr == 1) PG8_BAR; }
    }
    PG8_WAIT_V(0);
    if constexpr (!ALIGN_EPI) { if (wr == 0) PG8_BAR; }
    PG8_BAR;
#undef PG8_SA
#undef PG8_SB
#undef PG8_STAGE
#undef PG8_LDA
#undef PG8_LDB
#undef PG8_MMA
#undef PG8_WAIT_V
#undef PG8_WAIT_L
#undef PG8_BAR
#undef PG8_SCHED
}
}

typedef f32x4 Acc[2][2][4][2];
__device__ __forceinline__ u32x4 pack8(f32x4 a, f32x4 b) { u32x4 w; w.x = cvtpk(a[0], a[1]); w.y = cvtpk(a[2], a[3]); w.z = cvtpk(b[0], b[1]); w.w = cvtpk(b[2], b[3]); return w; }
__device__ __forceinline__ void unpack8(u32x4 w, f32x4& a, f32x4& b) { a = (f32x4){bflo(w.x), bfhi(w.x), bflo(w.y), bfhi(w.y)}; b = (f32x4){bflo(w.z), bfhi(w.z), bflo(w.w), bfhi(w.w)}; }

struct EpiInProj {
    unsigned char* ws; bf16_t* gm; const float* bmerge;
    __device__ __forceinline__ void operator()(const Acc& acc, const pg8::Unit& u, int wr, int wc, int fr, int fq) const {
        const int pn = u.pn;
        bf16_t* dst; int ldc, cb, mode; size_t bjs = 128;
        if (pn < 4)       { dst = (bf16_t*)(ws + WS_U);   ldc = 1024; cb = pn * 256;        mode = 0; }
        else if (pn < 8)  { dst = (bf16_t*)(ws + WS_GP);  ldc = 1024; cb = (pn - 4) * 256;  mode = 1; }
        else if (pn < 16) { dst = (bf16_t*)(ws + WS_Q);   ldc = 2048; cb = (pn - 8) * 256;  mode = 3; }
        else if (pn < 28) { const int k = (pn - 16) >> 1; dst = (bf16_t*)(ws + WS_KCR + (size_t)k * (8 * MiB)); ldc = 512; cb = ((pn - 16) & 1) * 256; mode = (k == 2 || k == 4) ? 3 : 0;
                            if (k < 2) { ldc = 128; cb = 0; bjs = (size_t)S * 128; dst += (size_t)((pn - 16) & 1) * 2 * S * 128; } }
        else if (pn < 36) { dst = (bf16_t*)(ws + WS_GN);  ldc = 2048; cb = (pn - 28) * 256; mode = 1; }
        else if (pn < 52) { dst = gm;                     ldc = 4096; cb = (pn - 36) * 256; mode = 2; }
        else              { dst = (bf16_t*)(ws + WS_GBR); ldc = 256;  cb = 0;               mode = 4; }
        const int row0 = u.pm * 256 + wr * 64 + fr, cl = wc * 32 + 8 * fq, col0 = cb + cl;
        const float* rcos = (const float*)(ws + WS_ROPE); const float* rsin = rcos + (size_t)S * 64;
#pragma unroll
        for (int ai = 0; ai < 2; ++ai)
#pragma unroll
            for (int m = 0; m < 4; ++m) {
                const int row = row0 + ai * 128 + m * 16;
                bf16_t* rowp = dst + (size_t)row * ldc + col0;
                f32x4 cs0, cs1, sn0, sn1;
                if (mode == 3) { const int i0 = (cl & 127) >> 1; cs0 = *(const f32x4*)(rcos + (size_t)row * 64 + i0); sn0 = *(const f32x4*)(rsin + (size_t)row * 64 + i0); }
#pragma unroll
                for (int bj = 0; bj < 2; ++bj) {
                    f32x4 v0 = acc[ai][bj][m][0], v1 = acc[ai][bj][m][1];
                    if (mode == 1) { for (int e = 0; e < 4; ++e) { v0[e] = siluf_(v0[e]); v1[e] = siluf_(v1[e]); } }
                    else if (mode == 2 || mode == 4) { if (mode == 2) { v0 = v0 + *(const f32x4*)(bmerge + col0 + bj * 128); v1 = v1 + *(const f32x4*)(bmerge + col0 + bj * 128 + 4); } for (int e = 0; e < 4; ++e) { v0[e] = sigmoidf_(v0[e]); v1[e] = sigmoidf_(v1[e]); } }
                    else if (mode == 3) {
                        f32x4 o0, o1;
                        o0[0] = v0[0] * cs0[0] - v0[1] * sn0[0]; o0[1] = v0[1] * cs0[0] + v0[0] * sn0[0];
                        o0[2] = v0[2] * cs0[1] - v0[3] * sn0[1]; o0[3] = v0[3] * cs0[1] + v0[2] * sn0[1];
                        o1[0] = v1[0] * cs0[2] - v1[1] * sn0[2]; o1[1] = v1[1] * cs0[2] + v1[0] * sn0[2];
                        o1[2] = v1[2] * cs0[3] - v1[3] * sn0[3]; o1[3] = v1[3] * cs0[3] + v1[2] * sn0[3];
                        v0 = o0; v1 = o1;
                    }
                    *(u32x4*)(rowp + bj * bjs) = pack8(v0, v1);
                }
            }
    }
};
struct EpiYa {
    bf16_t* yag; const bf16_t* gm;
    __device__ __forceinline__ void operator()(const Acc& acc, const pg8::Unit& u, int wr, int wc, int fr, int fq) const {
        const int row0 = u.pm * 256 + wr * 64 + fr, col0 = u.pn * 256 + wc * 32 + 8 * fq;
#pragma unroll
        for (int ai = 0; ai < 2; ++ai)
#pragma unroll
            for (int m = 0; m < 4; ++m) { const size_t r = (size_t)(row0 + ai * 128 + m * 16);
#pragma unroll
                for (int bj = 0; bj < 2; ++bj) { f32x4 g0, g1; unpack8(*(const u32x4*)(gm + r * 4096 + col0 + bj * 128), g0, g1);
                    *(u32x4*)(yag + r * 2048 + col0 + bj * 128) = pack8(acc[ai][bj][m][0] * g0, acc[ai][bj][m][1] * g1); } }
    }
};
struct EpiYb {
    bf16_t* merged; const bf16_t* yag; const bf16_t* gm;
    __device__ __forceinline__ void operator()(const Acc& acc, const pg8::Unit& u, int wr, int wc, int fr, int fq) const {
        const int row0 = u.pm * 256 + wr * 64 + fr, col0 = u.pn * 256 + wc * 32 + 8 * fq;
#pragma unroll
        for (int ai = 0; ai < 2; ++ai)
#pragma unroll
            for (int m = 0; m < 4; ++m) { const size_t r = (size_t)(row0 + ai * 128 + m * 16);
#pragma unroll
                for (int bj = 0; bj < 2; ++bj) { f32x4 g0, g1, y0, y1; unpack8(*(const u32x4*)(gm + r * 4096 + 2048 + col0 + bj * 128), g0, g1);
                    unpack8(*(const u32x4*)(yag + r * 2048 + col0 + bj * 128), y0, y1);
                    *(u32x4*)(merged + r * 2048 + col0 + bj * 128) = pack8(y0 + acc[ai][bj][m][0] * g0, y1 + acc[ai][bj][m][1] * g1); } }
    }
};
constexpr int NSPLIT = 8;
struct EpiSlab {
    float* slab;
    __device__ __forceinline__ void operator()(const Acc& acc, const pg8::Unit& u, int wr, int wc, int fr, int fq) const {
        float* base = slab + ((size_t)((u.pm >> 3) * NSPLIT + u.pn) * 2048 + (size_t)(u.pm & 7) * 256 + wr * 64 + fr) * 256 + wc * 32 + 8 * fq;
#pragma unroll
        for (int ai = 0; ai < 2; ++ai)
#pragma unroll
            for (int m = 0; m < 4; ++m)
#pragma unroll
                for (int bj = 0; bj < 2; ++bj) { float* p = base + (size_t)(ai * 128 + m * 16) * 256 + bj * 128; *(f32x4*)p = acc[ai][bj][m][0]; *(f32x4*)(p + 4) = acc[ai][bj][m][1]; }
    }
};
constexpr int CW_PANEL = 16384;
constexpr int EPI_LDS_OFF = RING_BYTES + 1024;
struct EpiOut {
    float* out; const float* x; float* ssq; const float* fw; unsigned* ctl; LAS unsigned char* lds;
    __device__ __forceinline__ void operator()(const Acc& acc_, const pg8::Unit& u, int wr, int wc, int fr, int fq) const {
        Acc& acc = const_cast<Acc&>(acc_);
        const int tid = otid();
        const int row0 = u.pm * 256 + wr * 64 + fr, col0 = u.pn * 256 + wc * 32 + 8 * fq;
        LAS float* rs = (LAS float*)(lds + EPI_LDS_OFF);
#pragma unroll
        for (int ai = 0; ai < 2; ++ai)
#pragma unroll
            for (int m = 0; m < 4; ++m) { const size_t r = (size_t)(row0 + ai * 128 + m * 16); float q = 0.f;
#pragma unroll
                for (int bj = 0; bj < 2; ++bj)
#pragma unroll
                    for (int n = 0; n < 2; ++n) { const size_t o = r * 2048 + col0 + bj * 128 + 4 * n; const f32x4 v = *(const f32x4*)(x + o) + acc[ai][bj][m][n];
                        acc[ai][bj][m][n] = v; q += (v[0] * v[0] + v[1] * v[1]) + (v[2] * v[2] + v[3] * v[3]); }
                q += __shfl_xor(q, 16); q += __shfl_xor(q, 32);
                if (fq == 0) __hip_atomic_store((unsigned*)(ssq + (size_t)(u.pn * 4 + wc) * S + r), __float_as_uint(q), __ATOMIC_RELAXED, __HIP_MEMORY_SCOPE_AGENT); }
        asm volatile("s_waitcnt vmcnt(0)" ::: "memory");
        __syncthreads();
        if (tid == 0) { unsigned* c = ctl + CW_PANEL + 64 * u.pm;
            __hip_atomic_fetch_add(c, 1u, __ATOMIC_RELAXED, __HIP_MEMORY_SCOPE_AGENT);
            unsigned sp = 0; while (__hip_atomic_load(c, __ATOMIC_RELAXED, __HIP_MEMORY_SCOPE_AGENT) < 8u) { __builtin_amdgcn_s_sleep(2); if (++sp > (1u << 22)) break; }
            __builtin_amdgcn_fence(__ATOMIC_ACQUIRE, "agent"); asm volatile("s_waitcnt vmcnt(0)" ::: "memory"); }
        __syncthreads();
        if (tid < 256) { const size_t r = (size_t)u.pm * 256 + tid; float s = 0.f;
#pragma unroll 8
            for (int p = 0; p < 32; ++p) s += __uint_as_float(__hip_atomic_load((unsigned*)(ssq + (size_t)p * S + r), __ATOMIC_RELAXED, __HIP_MEMORY_SCOPE_AGENT));
            rs[tid] = 1.0f / sqrtf(s * (1.f / DM) + EPS); }
        __syncthreads();
#pragma unroll
        for (int ai = 0; ai < 2; ++ai)
#pragma unroll
            for (int m = 0; m < 4; ++m) { const int rl = wr * 64 + fr + ai * 128 + m * 16; const float sc = rs[rl]; const size_t r = (size_t)u.pm * 256 + rl;
#pragma unroll
                for (int bj = 0; bj < 2; ++bj)
#pragma unroll
                    for (int n = 0; n < 2; ++n) { const size_t o = r * 2048 + col0 + bj * 128 + 4 * n; *(f32x4*)(out + o) = acc[ai][bj][m][n] * sc * *(const f32x4*)(fw + col0 + bj * 128 + 4 * n); } }
    }
};

struct Args { const float* in[17]; float* out; unsigned char* ws; int ph_lo, ph_hi; };
struct Frame { LAS unsigned char* lds; int tid, lane, wave, vcu, G; };

__device__ __forceinline__ int ropeperm(int d) { return d < 64 ? 2 * d : 2 * (d - 64) + 1; }
__device__ __forceinline__ void transpose_item(const float* W, int ldw, int Nvalid, bf16_t* WT, int ldt, int row_off, bool perm, LAS float* scr, int kb, int nb, int lane) {
    const int k0 = 64 * kb, n0 = 32 * nb, cq = lane & 7, rb = lane >> 3; const bool ok = n0 + cq * 4 < Nvalid;
    f32x4 v[8];
#pragma unroll
    for (int i = 0; i < 8; ++i) v[i] = ok ? *(const f32x4*)(W + (size_t)(k0 + i * 8 + rb) * ldw + n0 + cq * 4) : (f32x4){0.f, 0.f, 0.f, 0.f};
#pragma unroll
    for (int i = 0; i < 8; ++i) *(LAS f32x4*)(scr + (i * 8 + rb) * 32 + ((cq ^ i) << 2)) = v[i];
    LDS_WAIT(); asm volatile("" ::: "memory");
#pragma unroll
    for (int j = 0; j < 4; ++j) { const int idx = lane + 64 * j, n = idx >> 3, c = idx & 7; const LAS float* s = scr + (8 * c) * 32 + ((((n >> 2) ^ c) << 2) | (n & 3));
        u32x4 o; o.x = cvtpk(s[0 * 32], s[1 * 32]); o.y = cvtpk(s[2 * 32], s[3 * 32]); o.z = cvtpk(s[4 * 32], s[5 * 32]); o.w = cvtpk(s[6 * 32], s[7 * 32]);
        const int ng = n0 + n;
        if (ng < Nvalid) { const int dr = perm ? ((ng & ~127) | ropeperm(ng & 127)) : ng; *(GAS u32x4*)(WT + (size_t)(row_off + dr) * ldt + k0 + 8 * c) = o; } }
    LDS_WAIT(); asm volatile("" ::: "memory");
}

__device__ __forceinline__ void p0_prologue(const Frame& F, const Args& a) {
    unsigned char* ws = a.ws;
    LAS float* scr = (LAS float*)(F.lds + F.wave * 8192);
    const int gw = F.vcu * NWAVES + F.wave, NGW = F.G * NWAVES, lane = F.lane;
    constexpr int I_WIN = 32 * 258, I_WM = 32 * 128;
    for (int it = gw; it < I_WIN + I_WM; it += NGW) {
        int r = it;
        if (r < I_WIN) { const int kb = r / 258, nb = 32 + r % 258, n0 = nb * 32;
            const bool perm = (n0 >= 2048 && n0 < 4096) || (n0 >= 5120 && n0 < 5632) || (n0 >= 6144 && n0 < 6656);
            transpose_item(a.in[2], 9264, 9264, (bf16_t*)(ws + WS_WCAT), 2048, nb >= 288 ? 4096 : 0, perm, scr, kb, nb, lane); continue; } r -= I_WIN;
        transpose_item(a.in[13], 4096, 4096, (bf16_t*)(ws + WS_WCAT), 2048, 9216, false, scr, r / 128, r % 128, lane);
    }
    {
        const float* win = a.in[2]; const float* mix = a.in[3]; bf16_t* WC = (bf16_t*)(ws + WS_WCAT); const int r = lane & 31, hh = lane >> 5;
        for (int it = gw; it < 1024; it += NGW) {
            const int g = it >> 8, d0 = ((it >> 5) & 7) * 32, kin0 = (it & 31) * 64;
            f32x16 acc0 = f32x16{}, acc1 = f32x16{};
            const float* ap = mix + (size_t)g * 65536 + (size_t)(8 * hh) * 256 + d0 + r;
            const float* bp0 = win + (size_t)(kin0 + r) * 9264 + g * 256 + 8 * hh; const float* bp1 = bp0 + (size_t)32 * 9264;
#pragma unroll 4
            for (int k = 0; k < 16; ++k) {
                f32x4 a0, a1;
#pragma unroll
                for (int j = 0; j < 4; ++j) { a0[j] = ap[(size_t)(k * 16 + j) * 256]; a1[j] = ap[(size_t)(k * 16 + 4 + j) * 256]; }
                const u32x4 af = pack8(a0, a1), b0 = pack8(*(const f32x4*)(bp0 + k * 16), *(const f32x4*)(bp0 + k * 16 + 4)), b1 = pack8(*(const f32x4*)(bp1 + k * 16), *(const f32x4*)(bp1 + k * 16 + 4));
                acc0 = __builtin_amdgcn_mfma_f32_32x32x16_bf16(__builtin_bit_cast(bf16x8, af), __builtin_bit_cast(bf16x8, b0), acc0, 0, 0, 0);
                acc1 = __builtin_amdgcn_mfma_f32_32x32x16_bf16(__builtin_bit_cast(bf16x8, af), __builtin_bit_cast(bf16x8, b1), acc1, 0, 0, 0);
            }
#pragma unroll
            for (int e = 0; e < 16; ++e) { int ee = e; asm volatile("" : "+v"(ee)); bf16_t* rowp = WC + (size_t)(g * 256 + d0 + crow(ee, hh)) * 2048 + kin0 + r;
                const float v0 = acc0[e], v1 = acc1[e], n0_ = __shfl_xor(v0, 1), n1_ = __shfl_xor(v1, 1);
                if ((r & 1) == 0) { *(unsigned*)rowp = cvtpk(v0, n0_); *(unsigned*)(rowp + 32) = cvtpk(v1, n1_); } }
        }
    }
    for (int i = gw * 64 + lane; i < 53248; i += NGW * 64) *(GAS u32x4*)(ws + WS_WCAT + (size_t)13360 * 4096 + (size_t)i * 16) = (u32x4){0u, 0u, 0u, 0u};
    {
        const float* x = a.in[0]; const float* nw = a.in[1]; bf16_t* H = (bf16_t*)(ws + WS_H);
        f32x4 wv[8];
#pragma unroll
        for (int j = 0; j < 8; ++j) wv[j] = *((const f32x4*)nw + lane + 64 * j);
        for (int m = gw; m < S; m += NGW) {
            const f32x4* xr = (const f32x4*)(x + (size_t)m * DM) + lane; f32x4 v[8]; float s = 0.f;
#pragma unroll
            for (int j = 0; j < 8; ++j) { v[j] = xr[64 * j]; s += (v[j][0] * v[j][0] + v[j][1] * v[j][1]) + (v[j][2] * v[j][2] + v[j][3] * v[j][3]); }
            const float rstd = 1.0f / sqrtf(wave_sum(s) * (1.f / DM) + EPS);
            u32x2* o = (u32x2*)(H + (size_t)m * DM) + lane;
#pragma unroll
            for (int j = 0; j < 8; ++j) { const f32x4 y = v[j] * rstd * wv[j]; u32x2 w; w.x = cvtpk(y[0], y[1]); w.y = cvtpk(y[2], y[3]); o[64 * j] = w; }
        }
    }
    {
        float* rcos = (float*)(ws + WS_ROPE); float* rsin = rcos + (size_t)S * 64;
        for (int e = gw * 64 + lane; e < S * 64; e += NGW * 64) {
            const int pos = e >> 6, i = e & 63;
            double inv = 1.0, b = 0.86596432336006535;
            for (int k = i; k; k >>= 1) { if (k & 1) inv *= b; b *= b; }
            const double t = (double)pos * inv * 0.15915494309189535;
            const float fr = (float)(t - floor(t));
            rcos[e] = __builtin_amdgcn_cosf(fr); rsin[e] = __builtin_amdgcn_sinf(fr);
        }
    }
}
__device__ __forceinline__ void p1_late_weights(const Frame& F, const Args& a, int cw, int NCW) {
    unsigned char* ws = a.ws;
    LAS float* scr = (LAS float*)(F.lds + F.wave * 8192);
    const int lane = F.lane;
    constexpr int I_NO = 32 * 64, I_O = 32 * 64, I_PO = 16 * 64, I_W1 = 64 * 8, I_W2 = 4 * 4, I_B1 = 512;
    constexpr int NITEMS = I_NO + I_O + I_PO + 2 * I_W1 + 2 * I_W2 + I_B1;
    for (int it = cw; it < NITEMS; it += NCW) {
        int r = it;
        if (r < I_W1) { transpose_item(a.in[6], 256, 256, (bf16_t*)(ws + WS_W1KT), 4096, 0, false, scr, r / 8, r % 8, lane); continue; } r -= I_W1;
        if (r < I_W1) { transpose_item(a.in[9], 256, 256, (bf16_t*)(ws + WS_W1VT), 4096, 0, false, scr, r / 8, r % 8, lane); continue; } r -= I_W1;
        if (r < I_B1) {
            const int which = r >> 8, fb = (r >> 6) & 3, ch = r & 63, f = fb * 64 + lane;
            const float* pe = a.in[which ? 8 : 5]; const float* w1 = a.in[which ? 9 : 6]; float s = 0.f;
#pragma unroll 16
            for (int k = ch * 64; k < ch * 64 + 64; ++k) s += pe[k] * w1[(size_t)k * 256 + f];
            ((float*)(ws + WS_B1P))[(which * 64 + ch) * 256 + f] = s; continue; } r -= I_B1;
        if (r < I_W2) { transpose_item(a.in[7], 128, 128, (bf16_t*)(ws + WS_W2KT), 256, 0, true, scr, r / 4, r % 4, lane); continue; } r -= I_W2;
        if (r < I_W2) { transpose_item(a.in[10], 128, 128, (bf16_t*)(ws + WS_W2VT), 256, 0, false, scr, r / 4, r % 4, lane); continue; } r -= I_W2;
        if (r < I_PO) { transpose_item(a.in[11], 2048, 2048, (bf16_t*)(ws + WS_WPOT), 1024, 0, false, scr, r / 64, r % 64, lane); continue; } r -= I_PO;
        if (r < I_NO) { transpose_item(a.in[12], 2048, 2048, (bf16_t*)(ws + WS_WNOT), 2048, 0, false, scr, r / 64, r % 64, lane); continue; } r -= I_NO;
        transpose_item(a.in[15], 2048, 2048, (bf16_t*)(ws + WS_WOT), 2048, 0, false, scr, r / 64, r % 64, lane);
    }
}

template <int W>
__device__ __forceinline__ void ypool_item(const bf16_t* __restrict__ U, const bf16_t* __restrict__ GP, bf16_t* __restrict__ Y, const float* __restrict__ scale, int c, int t0) {
    u32x4 x[W + 7], gq[8];
#pragma unroll
    for (int k = 0; k < W + 7; ++k) { const int r = t0 - (W - 1) + k; x[k] = r >= 0 ? *(const u32x4*)(U + (size_t)r * 1024 + c) : (u32x4){0u, 0u, 0u, 0u}; }
#pragma unroll
    for (int k = 0; k < 8; ++k) gq[k] = *(const u32x4*)(GP + (size_t)(t0 + k) * 1024 + c);
    const f32x4 sc0 = *(const f32x4*)(scale + c), sc1 = *(const f32x4*)(scale + c + 4);
    f32x4 s0 = {0.f, 0.f, 0.f, 0.f}, s1 = s0, a0, a1;
#pragma unroll
    for (int k = 0; k < W - 1; ++k) { unpack8(x[k], a0, a1); s0 = s0 + a0; s1 = s1 + a1; }
#pragma unroll
    for (int k = 0; k < 8; ++k) { const int t = t0 + k;
        unpack8(x[W - 1 + k], a0, a1); s0 = s0 + a0; s1 = s1 + a1;
        const int cnt = (t + 1 < W) ? t + 1 : W; const float ic = 1.0f / (float)cnt;
        f32x4 g0, g1; unpack8(gq[k], g0, g1);
        *(u32x4*)(Y + (size_t)t * 1024 + c) = pack8((s0 * ic - a0) * sc0 * g0, (s1 * ic - a1) * sc1 * g1);
        f32x4 b0, b1; unpack8(x[k], b0, b1); s0 = s0 - b0; s1 = s1 - b1; }
}
__device__ __forceinline__ void p2_ypool(const Frame& F, unsigned char* ws, const float* __restrict__ scale, int cw, int NCW) {
    const bf16_t* __restrict__ U = (const bf16_t*)(ws + WS_U); const bf16_t* __restrict__ GP = (const bf16_t*)(ws + WS_GP); bf16_t* __restrict__ Y = (bf16_t*)(ws + WS_H + 16 * MiB);
    for (int wi = cw; wi < 4 * 512; wi += NCW) {
        const int g = wi & 3, t0 = ((wi >> 2) * 2 + (F.lane >> 5)) * 8, c = (g * 32 + (F.lane & 31)) * 8;
        if (g == 0) ypool_item<2>(U, GP, Y, scale, c, t0); else if (g == 1) ypool_item<4>(U, GP, Y, scale, c, t0);
        else if (g == 2) ypool_item<8>(U, GP, Y, scale, c, t0); else ypool_item<16>(U, GP, Y, scale, c, t0);
    }
}
__device__ __forceinline__ void p3_compress2(const Frame& F, unsigned char* ws, int cwg, int NCWG) {
    const int tid = F.tid, lane = F.lane, r = lane & 31, hh = lane >> 5, wave = F.wave;
    const float* rcos = (const float*)(ws + WS_ROPE); const float* rsin = rcos + (size_t)S * 64;
    LAS bf16_t* hl = (LAS bf16_t*)F.lds;
    for (int it = cwg; it < 128; it += NCWG) {
        const int which = it >> 6, rt = it & 63;
        { const int row = tid >> 4, f0 = (tid & 15) * 16;
          const float* sl = (const float*)(ws + WS_SLAB) + ((size_t)(which * NSPLIT) * 2048 + rt * 32 + row) * 256 + f0; const float* b1 = (const float*)(ws + WS_B1) + which * 256 + f0;
          f32x4 s[4];
#pragma unroll
          for (int q = 0; q < 4; ++q) s[q] = *(const f32x4*)(b1 + 4 * q);
#pragma unroll
          for (int ks = 0; ks < NSPLIT; ++ks)
#pragma unroll
              for (int q = 0; q < 4; ++q) s[q] = s[q] + *(const f32x4*)(sl + (size_t)ks * 2048 * 256 + 4 * q);
#pragma unroll
          for (int q = 0; q < 4; ++q)
#pragma unroll
              for (int e = 0; e < 4; ++e) s[q][e] = siluf_(s[q][e]);
          *(LAS u32x4*)(hl + row * 264 + f0) = pack8(s[0], s[1]); *(LAS u32x4*)(hl + row * 264 + f0 + 8) = pack8(s[2], s[3]); }
        __syncthreads();
        if (wave < 4) {
            const int ct = wave, row = rt * 32 + r;
            const bf16_t* W2 = (const bf16_t*)(ws + (which ? WS_W2VT : WS_W2KT)) + (size_t)(ct * 32 + r) * 256 + hh * 8;
            f32x16 acc = f32x16{};
#pragma unroll 4
            for (int k = 0; k < 16; ++k) acc = __builtin_amdgcn_mfma_f32_32x32x16_bf16(*(const bf16x8*)(W2 + k * 16), *(const LAS bf16x8*)(hl + r * 264 + k * 16 + hh * 8), acc, 0, 0, 0);
            const int n = row & 511; bf16_t* dst = (bf16_t*)(ws + (which ? WS_VC : WS_KC)) + (size_t)row * 128 + ct * 32 + 4 * hh;
            const int pos = (16 * n + 31) > S - 1 ? S - 1 : 16 * n + 31;
#pragma unroll
            for (int gq = 0; gq < 4; ++gq) {
                float v0 = acc[4 * gq], v1 = acc[4 * gq + 1], v2 = acc[4 * gq + 2], v3 = acc[4 * gq + 3];
                if (which == 0) { const int i = (ct * 32 + 8 * gq + 4 * hh) >> 1; const float c0 = rcos[(size_t)pos * 64 + i], s0 = rsin[(size_t)pos * 64 + i], c1 = rcos[(size_t)pos * 64 + i + 1], s1 = rsin[(size_t)pos * 64 + i + 1];
                    const float o0 = v0 * c0 - v1 * s0, o1 = v1 * c0 + v0 * s0, o2 = v2 * c1 - v3 * s1, o3 = v3 * c1 + v2 * s1; v0 = o0; v1 = o1; v2 = o2; v3 = o3; }
                u32x2 w; w.x = cvtpk(v0, v1); w.y = cvtpk(v2, v3); if (n == 511) { w.x = 0u; w.y = 0u; }
                *(u32x2*)(dst + 8 * gq) = w;
            }
        }
        __syncthreads();
    }
}

namespace nsa {
constexpr int SHM_V = 16384, SHM_K = 16384;
constexpr int L_V = 0, L_K = 3 * SHM_V, L_WS = L_K + 2 * SHM_K, L_IMP = L_WS + NWAVES * 64 * 4, IMP_LD = 129, L_SELM = L_IMP + 64 * IMP_LD * 4, L_END = L_SELM + 64 * 8 * 2;
static_assert(L_END <= RING_BYTES, "attention LDS");
constexpr float SCALE = 0.08838834764831845f, C2 = 1.4426950408889634f * SCALE, THR = 8.f;
#define KSWZ(row, colB) ((row) * 256 + ((colB) ^ (((row) & 7) << 4)))
#define SBAR() __builtin_amdgcn_sched_barrier(0)
#define LADD(p, v) (void)__hip_atomic_fetch_add((p), (v), __ATOMIC_RELAXED, __HIP_MEMORY_SCOPE_WORKGROUP)
__device__ __forceinline__ int v_st(int k, int c) { const int kk = (k & ~0xC) | ((k & 4) << 1) | ((k & 8) >> 1); return ((kk >> 3) * 4 + (c >> 5)) * 512 + ((kk & 7) * 32 + (c & 31)) * 2; }
__device__ __forceinline__ int v_rd_base(int lane) { return ((lane & 3) << 3) | (((lane >> 2) & 3) << 6) | (((lane >> 4) & 1) << 5) | (((lane >> 5) & 1) << 8); }
constexpr int v_rd_off(int d0, int ks, int half) { return d0 * 512 + ks * 4096 + half * 2048; }
__device__ __forceinline__ unsigned cvtpk_a(float lo, float hi) { unsigned r; asm volatile("v_cvt_pk_bf16_f32 %0, %1, %2" : "=v"(r) : "v"(lo), "v"(hi)); return r; }

__device__ __forceinline__ void mask_range(f32x16& p0, f32x16& p1, int dq, unsigned Wn) {
    const float NEG = -__builtin_inff();
#pragma unroll
    for (int r = 0; r < 16; ++r) { const int c = (r & 3) + 8 * (r >> 2);
        if ((unsigned)(dq + c) >= Wn) p0[r] = NEG;
        if ((unsigned)(dq + c + 32) >= Wn) p1[r] = NEG; }
}
__device__ __forceinline__ void mask_row(f32x16& p0, f32x16& p1, bool keep) {
    const float NEG = -__builtin_inff();
#pragma unroll
    for (int r = 0; r < 16; ++r) { p0[r] = keep ? p0[r] : NEG; p1[r] = keep ? p1[r] : NEG; }
}
__device__ __forceinline__ float rowmax32(const f32x16& p0, const f32x16& p1) {
    float pmax = p0[0];
#pragma unroll
    for (int r = 1; r < 16; ++r) pmax = fmaxf(pmax, p0[r]);
#pragma unroll
    for (int r = 0; r < 16; ++r) pmax = fmaxf(pmax, p1[r]);
    auto rr = __builtin_amdgcn_permlane32_swap(__float_as_uint(pmax), __float_as_uint(pmax), false, false);
    return fmaxf(__uint_as_float(rr[0]), __uint_as_float(rr[1]));
}
__device__ __forceinline__ float rowsum32(const f32x16& p0, const f32x16& p1) {
    float ps = 0.f;
#pragma unroll
    for (int r = 0; r < 16; ++r) ps += p0[r];
#pragma unroll
    for (int r = 0; r < 16; ++r) ps += p1[r];
    auto rr = __builtin_amdgcn_permlane32_swap(__float_as_uint(ps), __float_as_uint(ps), false, false);
    return __uint_as_float(rr[0]) + __uint_as_float(rr[1]);
}
__device__ __forceinline__ void pack_p(const f32x16& p0, const f32x16& p1, bf16x8& pa0, bf16x8& pa1, bf16x8& pa2, bf16x8& pa3) {
#define PK4(P, B_, OUT) do { unsigned a0 = cvtpk_a(P[B_+0], P[B_+1]), a1 = cvtpk_a(P[B_+2], P[B_+3]);                          \
        unsigned b0 = cvtpk_a(P[B_+4], P[B_+5]), b1 = cvtpk_a(P[B_+6], P[B_+7]);                                             \
        auto r0 = __builtin_amdgcn_permlane32_swap(a0, b0, false, false); auto r1 = __builtin_amdgcn_permlane32_swap(a1, b1, false, false); \
        u32x4 w = {r0[0], r1[0], r0[1], r1[1]}; OUT = __builtin_bit_cast(bf16x8, w); } while (0)
    PK4(p0, 0, pa0); PK4(p0, 8, pa1); PK4(p1, 0, pa2); PK4(p1, 8, pa3);
#undef PK4
}
__device__ __forceinline__ void qkt(f32x16& p0, f32x16& p1, const LAS unsigned char* K_buf, int r32, int hi, const bf16x8* qr) {
    p0 = f32x16{}; p1 = f32x16{};
    const LAS unsigned char* kb[4];
#pragma unroll
    for (int dd = 0; dd < 4; ++dd) kb[dd] = K_buf + KSWZ(r32, (dd * 16 + hi * 8) * 2);
#pragma unroll
    for (int d0 = 0; d0 < 8; ++d0) { const LAS unsigned char* a = kb[d0 & 3] + (d0 >> 2) * 128;
        const bf16x8 b0 = *(const LAS bf16x8*)(a);
        const bf16x8 b1 = *(const LAS bf16x8*)(a + 32 * 256);
        p0 = __builtin_amdgcn_mfma_f32_32x32x16_bf16(b0, qr[d0], p0, 0, 0, 0);
        p1 = __builtin_amdgcn_mfma_f32_32x32x16_bf16(b1, qr[d0], p1, 0, 0, 0);
        if (d0 == 3) SBAR(); }
}
__device__ __forceinline__ void pv_tile(f32x16* o, int vb0, bf16x8 pa0, bf16x8 pa1, bf16x8 pa2, bf16x8 pa3) {
#define TRRD(dst, off) asm volatile("ds_read_b64_tr_b16 %0, %1 offset:%2" : "=&v"(dst) : "v"(vb0), "i"(off) : "memory")
#define PV_D0(d0) do { s16x4 l0, l1, l2, l3, h0, h1, h2, h3; constexpr int b_ = v_rd_off(d0, 0, 0); \
        TRRD(l0, b_); TRRD(h0, b_ + 2048); TRRD(l1, b_ + 4096); TRRD(h1, b_ + 6144); TRRD(l2, b_ + 8192); TRRD(h2, b_ + 10240); TRRD(l3, b_ + 12288); TRRD(h3, b_ + 14336); \
        asm volatile("s_waitcnt lgkmcnt(0)" ::: "memory"); SBAR();   \
        o[d0] = __builtin_amdgcn_mfma_f32_32x32x16_bf16(pa0, (bf16x8){l0[0], l0[1], l0[2], l0[3], h0[0], h0[1], h0[2], h0[3]}, o[d0], 0, 0, 0);   \
        o[d0] = __builtin_amdgcn_mfma_f32_32x32x16_bf16(pa1, (bf16x8){l1[0], l1[1], l1[2], l1[3], h1[0], h1[1], h1[2], h1[3]}, o[d0], 0, 0, 0);   \
        o[d0] = __builtin_amdgcn_mfma_f32_32x32x16_bf16(pa2, (bf16x8){l2[0], l2[1], l2[2], l2[3], h2[0], h2[1], h2[2], h2[3]}, o[d0], 0, 0, 0);   \
        o[d0] = __builtin_amdgcn_mfma_f32_32x32x16_bf16(pa3, (bf16x8){l3[0], l3[1], l3[2], l3[3], h3[0], h3[1], h3[2], h3[3]}, o[d0], 0, 0, 0); } while (0)
    PV_D0(0); PV_D0(1); PV_D0(2); PV_D0(3);
#undef PV_D0
#undef TRRD
}

enum { M_C1 = 0, M_C2 = 1, M_S = 2, M_W = 3 };
struct RowState { float m, l; };
template <int MODE>
__device__ __forceinline__ void attn_pass(LAS unsigned char* lds, const bf16_t* Kp, const bf16_t* Vp, int ld, int j_lo, int j_hi, const bf16x8* qr, int t, int Tq, const u32x4 sel,
                                          RowState& st, float invl, f32x16* o, bool do_imp) {
    constexpr bool HASV = MODE != M_C1;
    const int tid = otid(), wid = __builtin_amdgcn_readfirstlane(tid >> 6), lane = tid & 63, r32 = lane & 31, hi = lane >> 5;
    LAS unsigned char* V_lds = lds + L_V; LAS unsigned char* K_lds = lds + L_K;
    LAS float* wsf = (LAS float*)(lds + L_WS) + wid * 64; LAS float* al_l = wsf + 32;
    const int sr = tid >> 4, sc = (tid & 15) * 8, vst0 = v_st(sr, sc), vst1 = v_st(32 + sr, sc), kws = KSWZ(sr, sc * 2);
    const int vb0 = (int)(uintptr_t)V_lds + v_rd_base(lane);
    const int NT = j_hi - j_lo;
    bf16x8 st_k0, st_k1, st_v0, st_v1;
    float m_reg = st.m, l_reg = st.l;
#define SLOAD(j) do { const size_t k0_ = (size_t)(j) * 64; st_k0 = *(const bf16x8*)(Kp + (k0_ + sr) * ld + sc); st_k1 = *(const bf16x8*)(Kp + (k0_ + 32 + sr) * ld + sc); \
        if (HASV) { st_v0 = *(const bf16x8*)(Vp + (k0_ + sr) * ld + sc); st_v1 = *(const bf16x8*)(Vp + (k0_ + 32 + sr) * ld + sc); } } while (0)
#define SWRITE(kof, vof) do { *(LAS bf16x8*)(K_lds + (kof) + kws) = st_k0; *(LAS bf16x8*)(K_lds + (kof) + kws + 32 * 256) = st_k1; \
        if (HASV) { *(LAS bf16x8*)(V_lds + (vof) + vst0) = st_v0; *(LAS bf16x8*)(V_lds + (vof) + vst1) = st_v1; } } while (0)
    const bool late = HASV && wid >= 4;
    bf16x8 pa0, pa1, pa2, pa3;
    SLOAD(j_lo); SWRITE(0, 0);
    __syncthreads();
    int kof = 0, vof = 0, vprev = 0;
    for (int idx = 0; idx < NT; ++idx) {
        const int j = j_lo + idx, kb = j * 64;
        if (idx + 1 < NT) SLOAD(j + 1);
        if (HASV && late && idx > 0) { SBAR(); pv_tile(o, vb0 + vprev, pa0, pa1, pa2, pa3); SBAR(); }
        f32x16 p0, p1; qkt(p0, p1, K_lds + kof, r32, hi, qr);
#if EXP_QKT2
        asm volatile("" : "+v"(p0), "+v"(p1)); SBAR(); qkt(p0, p1, K_lds + kof, r32, hi, qr);
#endif
        if (MODE == M_C1 || MODE == M_C2) { const int nmax1 = ((t - 31) >> 4) + 1; mask_range(p0, p1, kb + 4 * hi, (unsigned)(nmax1 > 0 ? nmax1 : 0)); }
        else if (MODE == M_S) { if (j == Tq) mask_range(p0, p1, kb + 4 * hi, (unsigned)(t + 1));
                                else { const unsigned w_ = (j >> 5) == 0 ? sel.x : (j >> 5) == 1 ? sel.y : (j >> 5) == 2 ? sel.z : sel.w; mask_row(p0, p1, ((w_ >> (j & 31)) & 1u) != 0u); } }
        else { if (j == Tq || j + 8 <= Tq) mask_range(p0, p1, kb + 4 * hi - (t - 511), 512u); }
        if (MODE == M_C1) { const float pmax = rowmax32(p0, p1); const float mn = fmaxf(m_reg, pmax); const float alpha = __builtin_amdgcn_exp2f((m_reg - mn) * C2); m_reg = mn;
            const float mnL = -mn * C2;
#pragma unroll
            for (int r = 0; r < 16; ++r) { p0[r] = __builtin_amdgcn_exp2f(fmaf(p0[r], C2, mnL)); p1[r] = __builtin_amdgcn_exp2f(fmaf(p1[r], C2, mnL)); }
            l_reg = l_reg * alpha + rowsum32(p0, p1); }
        else if (MODE == M_C2) { const float mnL = -m_reg * C2;
#pragma unroll
            for (int r = 0; r < 16; ++r) { p0[r] = __builtin_amdgcn_exp2f(fmaf(p0[r], C2, mnL)) * invl; p1[r] = __builtin_amdgcn_exp2f(fmaf(p1[r], C2, mnL)) * invl; }
            if (do_imp) { LAS unsigned* imp = (LAS unsigned*)(lds + L_IMP) + ((wid & 1) * 32 + r32) * IMP_LD + 16 * j + hi;
#pragma unroll
                for (int k = 0; k < 4; ++k) {
                    { const float e_ = p0[4 * k + 3], a_ = 2.f * (p0[4 * k] + p0[4 * k + 1] + p0[4 * k + 2]) + e_;
                      LADD(imp + 2 * k, (unsigned)(a_ * 67108864.f + 0.5f)); LADD(imp + 2 * k + 1, (unsigned)(e_ * 67108864.f + 0.5f)); }
                    { const float e_ = p1[4 * k + 3], a_ = 2.f * (p1[4 * k] + p1[4 * k + 1] + p1[4 * k + 2]) + e_;
                      LADD(imp + 8 + 2 * k, (unsigned)(a_ * 67108864.f + 0.5f)); LADD(imp + 8 + 2 * k + 1, (unsigned)(e_ * 67108864.f + 0.5f)); } } }
            pack_p(p0, p1, pa0, pa1, pa2, pa3); }
        else { const float pmax = rowmax32(p0, p1); float mn, alpha;
            if (__builtin_expect(__all((pmax - m_reg) * SCALE <= THR), 1)) { mn = m_reg; alpha = 1.f; }
            else { mn = fmaxf(m_reg, pmax); alpha = __builtin_amdgcn_exp2f((m_reg - mn) * C2); m_reg = mn; }
            const float mnL = -mn * C2;
#pragma unroll
            for (int r = 0; r < 16; ++r) { p0[r] = __builtin_amdgcn_exp2f(fmaf(p0[r], C2, mnL)); p1[r] = __builtin_amdgcn_exp2f(fmaf(p1[r], C2, mnL)); }
            l_reg = l_reg * alpha + rowsum32(p0, p1);
            pack_p(p0, p1, pa0, pa1, pa2, pa3);
            if (__any(alpha < 1.f)) { if (hi == 0) al_l[r32] = alpha; asm volatile("s_waitcnt lgkmcnt(0)" ::: "memory");
#pragma unroll
                for (int d_ = 0; d_ < 4; ++d_)
#pragma unroll
                    for (int r = 0; r < 16; ++r) o[d_][r] *= al_l[crow(r, hi)]; } }
        if (HASV && !late) { SBAR(); pv_tile(o, vb0 + vof, pa0, pa1, pa2, pa3); }
        const int kn = kof ^ SHM_K, vn = (vof == 2 * SHM_V) ? 0 : vof + SHM_V;
        if (idx + 1 < NT) { SWRITE(kn, vn); }
        __syncthreads();
        vprev = vof; kof = kn; vof = vn;
    }
    if (HASV) { if (late) { SBAR(); pv_tile(o, vb0 + vprev, pa0, pa1, pa2, pa3); } __syncthreads(); }
    st.m = m_reg; st.l = l_reg;
#undef SLOAD
#undef SWRITE
}

template <int MODE>
__device__ __forceinline__ void branch_out(LAS unsigned char* lds, const f32x16* o, float rowscale, bf16_t* onsa_w, const bf16_t* gn_w) {
    const int tid = otid(), wid = __builtin_amdgcn_readfirstlane(tid >> 6), lane = tid & 63, r32 = lane & 31, hi = lane >> 5;
    LAS float* li_l = (LAS float*)(lds + L_WS) + wid * 64;
    if (hi == 0) li_l[r32] = rowscale; asm volatile("s_waitcnt lgkmcnt(0)" ::: "memory");
    LAS unsigned* stg = (LAS unsigned*)(lds + wid * 8192);
#pragma unroll
    for (int r = 0; r < 16; ++r) { const int orow = crow(r, hi); const float sc = li_l[orow];
#pragma unroll
        for (int d0 = 0; d0 < 4; ++d0) { const float v = o[d0][r] * sc; const float vn = __shfl_xor(v, 1);
            if ((r32 & 1) == 0) stg[orow * 64 + d0 * 16 + (r32 >> 1)] = cvtpk(v, vn); } }
    asm volatile("s_waitcnt lgkmcnt(0)" ::: "memory");
    u32x4 val[8], prev[8], gq[8];
#pragma unroll
    for (int i = 0; i < 8; ++i) val[i] = *(const LAS u32x4*)(stg + (i * 4 + (lane >> 4)) * 64 + (lane & 15) * 4);
    int rb = lane >> 4; asm volatile("" : "+v"(rb));
    bf16_t* gp_ = onsa_w + (size_t)rb * 2048 + (lane & 15) * 8; const bf16_t* gg_ = gn_w + (size_t)rb * 2048 + (lane & 15) * 8;
    if (MODE >= 1) {
#pragma unroll
        for (int i = 0; i < 8; ++i) prev[i] = *(const u32x4*)(gp_ + (size_t)i * 4 * 2048); }
    if (MODE == 2) {
#pragma unroll
        for (int i = 0; i < 8; ++i) gq[i] = *(const u32x4*)(gg_ + (size_t)i * 4 * 2048); }
#pragma unroll
    for (int i = 0; i < 8; ++i) { u32x4 w = val[i];
        if (MODE >= 1) { f32x4 a0, a1, b0, b1; unpack8(val[i], a0, a1); unpack8(prev[i], b0, b1); a0 = a0 + b0; a1 = a1 + b1;
            if (MODE == 2) { f32x4 g0, g1; unpack8(gq[i], g0, g1); a0 = a0 * g0; a1 = a1 * g1; }
            w = pack8(a0, a1); }
        *(u32x4*)(gp_ + (size_t)i * 4 * 2048) = w; }
    __syncthreads();
}

__device__ __forceinline__ void attn_unit(LAS unsigned char* lds, unsigned char* ws, int h, int Tq) {
    const int tid = otid(), wid = __builtin_amdgcn_readfirstlane(tid >> 6), lane = tid & 63, r32 = lane & 31, hi = lane >> 5;
    const int g = wid >> 1, tl = (wid & 1) * 32 + r32, t = Tq * 64 + tl, hq = 4 * h + g;
    const bf16_t* Q = (const bf16_t*)(ws + WS_Q); const bf16_t* GBR = (const bf16_t*)(ws + WS_GBR);
    bf16_t* onsa_w = (bf16_t*)(ws + WS_ONSA) + (size_t)(Tq * 64 + (wid & 1) * 32) * 2048 + hq * 128; const bf16_t* gn_w = (const bf16_t*)(ws + WS_GN) + (size_t)(Tq * 64 + (wid & 1) * 32) * 2048 + hq * 128;
    bf16x8 qr[8];
#pragma unroll
    for (int d0 = 0; d0 < 8; ++d0) qr[d0] = *(const bf16x8*)(Q + (size_t)t * 2048 + hq * 128 + d0 * 16 + hi * 8);
    const float g_c = bf2f(GBR[(size_t)t * 256 + hq * 3 + 0]), g_s = bf2f(GBR[(size_t)t * 256 + hq * 3 + 1]), g_w = bf2f(GBR[(size_t)t * 256 + hq * 3 + 2]);
    const bool big = Tq >= 16;
    LAS unsigned* IMP = (LAS unsigned*)(lds + L_IMP);
    if (big) { for (int i = tid; i < 64 * IMP_LD; i += 512) IMP[i] = 0u; }
    const u32x4 nosel = {0u, 0u, 0u, 0u};
    f32x16 o[4];
    {
        const bf16_t* Kc = (const bf16_t*)(ws + WS_KC) + (size_t)h * 512 * 128; const bf16_t* Vc = (const bf16_t*)(ws + WS_VC) + (size_t)h * 512 * 128;
        const int ntc = ((4 * Tq + 2) >> 6) + 1;
        RowState stc{-1e30f, 0.f};
        attn_pass<M_C1>(lds, Kc, Vc, 128, 0, ntc, qr, t, Tq, nosel, stc, 0.f, o, false);
        const float invl = stc.l > 0.f ? 1.0f / stc.l : 0.f;
#pragma unroll
        for (int d = 0; d < 4; ++d) o[d] = f32x16{};
        attn_pass<M_C2>(lds, Kc, Vc, 128, 0, ntc, qr, t, Tq, nosel, stc, invl, o, big);
        branch_out<0>(lds, o, g_c, onsa_w, gn_w);
    }
    {
        LAS unsigned short* SELM = (LAS unsigned short*)(lds + L_SELM);
        int tok = tid >> 3, sub = tid & 7; asm volatile("" : "+v"(tok), "+v"(sub));
        unsigned bits = 0u;
        if (big) {
            unsigned kv[16];
#pragma unroll
            for (int e = 0; e < 16; ++e) { const int j = sub * 16 + e; const unsigned v = IMP[tok * IMP_LD + j]; kv[e] = (j >= 1 && j <= Tq - 2) ? v + 1u : 0u; }
            for (int round = 0; round < 13; ++round) {
                unsigned bv = kv[0]; int bj = 0;
#pragma unroll
                for (int e = 1; e < 16; ++e) { const bool gt = kv[e] > bv; bv = gt ? kv[e] : bv; bj = gt ? e : bj; }
                bj += sub * 16;
#pragma unroll
                for (int sh = 1; sh < 8; sh <<= 1) { const unsigned ov = __shfl_xor(bv, sh); const int oj = __shfl_xor(bj, sh);
                    const bool take = (ov > bv) || (ov == bv && oj < bj); bv = take ? ov : bv; bj = take ? oj : bj; }
                const int we = (bv != 0u && (bj >> 4) == sub) ? (bj & 15) : -1;
#pragma unroll
                for (int e = 0; e < 16; ++e) { const bool hit = (we == e); bits |= hit ? (1u << e) : 0u; kv[e] = hit ? 0u : kv[e]; }
            }
#pragma unroll
            for (int e = 0; e < 16; ++e) { const int j = sub * 16 + e; if (j == 0 || j == Tq - 1 || j == Tq) bits |= 1u << e; }
        } else {
#pragma unroll
            for (int e = 0; e < 16; ++e) { const int j = sub * 16 + e; if (j <= Tq) bits |= 1u << e; }
        }
        SELM[tok * 8 + sub] = (unsigned short)bits;
        __syncthreads();
    }
    const u32x4 sel = *(const LAS u32x4*)(lds + L_SELM + tl * 16);
    {
        RowState sts{-1e30f, 0.f};
#pragma unroll
        for (int d = 0; d < 4; ++d) o[d] = f32x16{};
        attn_pass<M_S>(lds, (const bf16_t*)(ws + WS_KS) + h * 128, (const bf16_t*)(ws + WS_VS) + h * 128, 512, 0, Tq + 1, qr, t, Tq, sel, sts, 0.f, o, false);
        branch_out<1>(lds, o, sts.l > 0.f ? g_s / sts.l : 0.f, onsa_w, gn_w);
    }
    {
        RowState stw{-1e30f, 0.f};
#pragma unroll
        for (int d = 0; d < 4; ++d) o[d] = f32x16{};
        attn_pass<M_W>(lds, (const bf16_t*)(ws + WS_KW) + h * 128, (const bf16_t*)(ws + WS_VW) + h * 128, 512, Tq >= 8 ? Tq - 8 : 0, Tq + 1, qr, t, Tq, sel, stw, 0.f, o, false);
        branch_out<2>(lds, o, stw.l > 0.f ? g_w / stw.l : 0.f, onsa_w, gn_w);
    }
    __syncthreads();
}
#undef KSWZ
#undef SBAR
}

constexpr int NPHASE = 8;
__global__ void __launch_bounds__(NWAVES * 64, 2) mega_fwd(Args args) {
    extern __shared__ __attribute__((aligned(16))) unsigned char lds[];
    Frame F;
    F.lds = (LAS unsigned char*)lds;
    F.tid = threadIdx.x; F.lane = F.tid & 63; F.wave = __builtin_amdgcn_readfirstlane(F.tid >> 6);
    F.G = gridDim.x; { const int bx = blockIdx.x; F.vcu = (F.G % 8 == 0) ? (bx % 8) * (F.G / 8) + bx / 8 : bx; }
    volatile LAS unsigned* MISC = (volatile LAS unsigned*)(F.lds + MISC_OFF);
    unsigned char* ws = args.ws;
    for (int u = F.tid; u < (LDS_BYTES - LDSCTL_OFF) / 4; u += NWAVES * 64) ((LAS unsigned*)(F.lds + LDSCTL_OFF))[u] = 0u;
    __syncthreads();
    XcdBarrier bar; bar.bar = (unsigned*)(ws + WS_CTL) + CW_BAR; bar.x = 0; bar.st = nullptr;
#if !N_LAUNCHES_PER_PHASE
    bar = xcd_barrier_post((unsigned*)(ws + WS_CTL) + CW_BAR, MISC + 8);
#endif
    const int lo = args.ph_lo, hi = args.ph_hi;
#define IN(k) (lo <= (k) && (k) < hi && (F.tid = otid(), F.lane = F.tid & 63, true))
#define SEAM(k) do { if (IN(k) && IN((k) + 1)) xcd_barrier(bar); } while (0)
    bf16_t* const GM = (bf16_t*)args.out;

    for (int rep_ = 0; rep_ < (DUP_PHASE == 0 ? 2 : 1); ++rep_) if (IN(0)) { if (rep_) xcd_barrier(bar); p0_prologue(F, args); } SEAM(0);
    for (int rep_ = 0; rep_ < (DUP_PHASE == 1 ? 2 : 1); ++rep_) if (IN(1)) { if (rep_) xcd_barrier(bar);
        pg8::Gemm g{(const bf16_t*)(ws + WS_H), (const bf16_t*)(ws + WS_WCAT), 2048, 2048, 2048};
        pg8::StaticOrder So; So.init(S, NCAT, F.G, (int)blockIdx.x);
        EpiInProj E{ws, GM, args.in[14]};
        pg8::AddrAffine AD{(size_t)256 * 2048 * 2, (size_t)256 * 2048 * 2};
        pg8::gemm_phase<EpiInProj, true>(F.lds, g, So, E, AD);
        { const int nun = (So.nwg + F.G - 1) / F.G, full = So.nwg - (nun - 1) * F.G;
          const int base = full < F.G ? full : 0; if ((int)blockIdx.x >= base) p1_late_weights(F, args, ((int)blockIdx.x - base) * NWAVES + F.wave, (F.G - base) * NWAVES); }
    } SEAM(1);
    for (int rep_ = 0; rep_ < (DUP_PHASE == 2 ? 2 : 1); ++rep_) if (IN(2)) { if (rep_) xcd_barrier(bar);
        pg8::Gemm g{(const bf16_t*)(ws + WS_KCR), (const bf16_t*)(ws + WS_W1KT), 2048, 4096, 4096 / NSPLIT};
        pg8::StaticOrder So; So.init(16 * 256, NSPLIT * 256, F.G, (int)blockIdx.x);
        EpiSlab E{(float*)(ws + WS_SLAB)};
        pg8::AddrCmp AD{(4096 / NSPLIT) / 64};
        pg8::gemm_phase<EpiSlab, false>(F.lds, g, So, E, AD);
        { const int base = F.G > So.nwg ? So.nwg : 0; if ((int)blockIdx.x >= base) p2_ypool(F, ws, args.in[4], ((int)blockIdx.x - base) * NWAVES + F.wave, (F.G - base) * NWAVES); }
        if (blockIdx.x == F.G - 1) { const float* b1p = (const float*)(ws + WS_B1P); float* b1 = (float*)(ws + WS_B1); const int t = F.tid; float s = 0.f;
            for (int c = 0; c < 64; ++c) s += b1p[((t >> 8) * 64 + c) * 256 + (t & 255)];
            b1[t] = s; }
    } SEAM(2);
    for (int rep_ = 0; rep_ < (DUP_PHASE == 3 ? 2 : 1); ++rep_) if (IN(3)) { if (rep_) xcd_barrier(bar);
        p3_compress2(F, ws, (int)blockIdx.x, F.G);
        pg8::Gemm g{(const bf16_t*)(ws + WS_H + 16 * MiB), (const bf16_t*)(ws + WS_WPOT), 1024, 1024, 1024};
        pg8::StaticOrder So; So.init(S, 2048, F.G, (int)blockIdx.x);
        EpiYa E{(bf16_t*)(ws + WS_YAG), GM};
        pg8::AddrAffine AD{(size_t)256 * 1024 * 2, (size_t)256 * 1024 * 2};
        pg8::gemm_phase<EpiYa, false>(F.lds, g, So, E, AD);
    } SEAM(3);
    for (int rep_ = 0; rep_ < (DUP_PHASE == 5 ? 2 : 1); ++rep_) if (IN(5)) { if (rep_) xcd_barrier(bar);
        for (int p = F.vcu; p < 256; p += F.G) {
#pragma unroll 1
            for (int i = 0; i < 2; ++i) { const int h = p >> 6, x = p & 63; nsa::attn_unit(F.lds, ws, h, i ? x : 127 - x); } }
    } SEAM(5);
    for (int rep_ = 0; rep_ < (DUP_PHASE == 6 ? 2 : 1); ++rep_) if (IN(6)) { if (rep_) xcd_barrier(bar);
        pg8::Gemm g{(const bf16_t*)(ws + WS_ONSA), (const bf16_t*)(ws + WS_WNOT), 2048, 2048, 2048}; pg8::AddrAffine AD{(size_t)256 * 2048 * 2, (size_t)256 * 2048 * 2};
        pg8::StaticOrder So; So.init(S, 2048, F.G, (int)blockIdx.x);
        EpiYb E{(bf16_t*)(ws + WS_H), (const bf16_t*)(ws + WS_YAG), GM};
        pg8::gemm_phase<EpiYb, false>(F.lds, g, So, E, AD);
    } SEAM(6);
    for (int rep_ = 0; rep_ < (DUP_PHASE == 7 ? 2 : 1); ++rep_) if (IN(7)) { if (rep_) xcd_barrier(bar);
        pg8::Gemm g{(const bf16_t*)(ws + WS_H), (const bf16_t*)(ws + WS_WOT), 2048, 2048, 2048}; pg8::AddrAffine AD{(size_t)256 * 2048 * 2, (size_t)256 * 2048 * 2};
        pg8::StaticOrder So; So.init(S, 2048, F.G, (int)blockIdx.x);
        EpiOut E{args.out, args.in[0], (float*)(ws + WS_SSQ), args.in[16], (unsigned*)(ws + WS_CTL), F.lds};
        pg8::gemm_phase<EpiOut, true>(F.lds, g, So, E, AD);
    }
#undef IN
#undef SEAM
}

extern "C" void kernel_launch(void* const* d_in, const int* in_sizes, int n_in, void* d_out, int out_size, void* d_ws, size_t ws_size, hipStream_t stream) {
    static int grid = 0;
    if (grid == 0) {
        if (n_in != 17 || in_sizes[0] != S * DM || out_size != S * DM || ws_size < WS_END) { fprintf(stderr, "kernel_launch: unexpected shapes (n_in %d, in0 %d, out %d, ws %zu); nothing launched\n", n_in, n_in > 0 ? in_sizes[0] : -1, out_size, ws_size); grid = -1; return; }
        int dev = 0, cus = 0;
        if (hipGetDevice(&dev) != hipSuccess || hipDeviceGetAttribute(&cus, hipDeviceAttributeMultiprocessorCount, dev) != hipSuccess) { fprintf(stderr, "kernel_launch: device query failed\n"); grid = -1; return; }
        if (hipFuncSetAttribute((const void*)mega_fwd, hipFuncAttributeMaxDynamicSharedMemorySize, LDS_BYTES) != hipSuccess) { fprintf(stderr, "kernel_launch: hipFuncSetAttribute failed\n"); grid = -1; return; }
        (void)hipGetLastError();
        grid = cus;
    }
    if (grid < 0) return;
    (void)hipMemsetAsync((char*)d_ws + WS_CTL, 0, CTL_BYTES, stream);
    Args a{};
    for (int i = 0; i < 17; ++i) a.in[i] = (const float*)d_in[i];
    a.out = (float*)d_out; a.ws = (unsigned char*)d_ws;
#if N_LAUNCHES_PER_PHASE
    for (int p = 0; p < NPHASE; ++p) { a.ph_lo = p; a.ph_hi = p + 1; hipLaunchKernelGGL(mega_fwd, dim3(grid), dim3(NWAVES * 64), LDS_BYTES, stream, a); }
#else
    a.ph_lo = 0; a.ph_hi = NPHASE;
    hipLaunchKernelGGL(mega_fwd, dim3(grid), dim3(NWAVES * 64), LDS_BYTES, stream, a);
#endif
}
```

```cpp
#include <hip/hip_runtime.h>
#include <cstdio>
#include <cstdint>

#define LAS __attribute__((address_space(3)))
#define GAS __attribute__((address_space(1)))
typedef unsigned short bf16_t;
typedef short bf16x8 __attribute__((ext_vector_type(8)));
typedef short s16x4 __attribute__((ext_vector_type(4)));
typedef float f32x4 __attribute__((ext_vector_type(4)));
typedef float f32x16 __attribute__((ext_vector_type(16)));
typedef unsigned u32x4 __attribute__((ext_vector_type(4)));
typedef unsigned u32x2 __attribute__((ext_vector_type(2)));
typedef float f32x2_t __attribute__((ext_vector_type(2)));
typedef __bf16 bf16x2_t __attribute__((ext_vector_type(2)));

#ifndef EXP_QKT2
#define EXP_QKT2 0
#endif
#ifndef DUP_PHASE
#define DUP_PHASE -1
#endif
#ifndef N_LAUNCHES_PER_PHASE
#define N_LAUNCHES_PER_PHASE 0
#endif

constexpr int S = 8192, DM = 2048, NCAT = 13568;
constexpr int HD = 128, NKV = 4, NCMP = 511;
constexpr float EPS = 1e-6f;

constexpr size_t MiB = 1u << 20;
constexpr size_t WS_CTL = 0, CTL_BYTES = 1 * MiB;
constexpr size_t WS_WCAT = 1 * MiB;
constexpr size_t WS_SLAB = WS_WCAT;
constexpr size_t WS_ONSA = WS_WCAT;
constexpr size_t WS_MIXT = 54 * MiB;
constexpr size_t WS_WPOT = 55 * MiB;
constexpr size_t WS_WNOT = 59 * MiB;
constexpr size_t WS_WOT  = 67 * MiB;
constexpr size_t WS_W1KT = 75 * MiB, WS_W1VT = 77 * MiB;
constexpr size_t WS_W2KT = 79 * MiB, WS_W2VT = 79 * MiB + 65536;
constexpr size_t WS_B1P  = 80 * MiB + 262144;
constexpr size_t WS_B1   = 79 * MiB + 131072 + 32768;
constexpr size_t WS_KC   = 79 * MiB + 262144, WS_VC = 79 * MiB + 786432;
constexpr size_t WS_ROPE = 81 * MiB;
constexpr size_t WS_SSQ  = 85 * MiB;
constexpr size_t WS_H    = 86 * MiB;
constexpr size_t WS_U    = 118 * MiB, WS_GP = 134 * MiB;
constexpr size_t WS_YAG  = WS_U;
constexpr size_t WS_Q    = 150 * MiB;
constexpr size_t WS_KCR  = 182 * MiB, WS_VCR = 190 * MiB, WS_KS = 198 * MiB, WS_VS = 206 * MiB, WS_KW = 214 * MiB, WS_VW = 222 * MiB;
constexpr size_t WS_GN   = 230 * MiB;
constexpr size_t WS_GBR  = 262 * MiB;
constexpr size_t WS_END  = 266 * MiB;
constexpr int CW_BAR = 4096;

constexpr int RING_BYTES = 131072;
constexpr int LDSCTL_OFF = RING_BYTES, MISC_OFF = LDSCTL_OFF + 320;
constexpr int LDS_BYTES = 147456;
constexpr int NWAVES = 8;

#define LDS_WAIT() asm volatile("s_waitcnt lgkmcnt(0)" ::: "memory")
#define VM_WAIT() asm volatile("s_waitcnt vmcnt(0)" ::: "memory")

__device__ __forceinline__ unsigned cvtpk(float lo, float hi) { f32x2_t v = {lo, hi}; bf16x2_t b = __builtin_convertvector(v, bf16x2_t); return __builtin_bit_cast(unsigned, b); }
__device__ __forceinline__ float bf2f(unsigned short h) { return __builtin_bit_cast(float, (unsigned)h << 16); }
__device__ __forceinline__ float bflo(unsigned w) { return __builtin_bit_cast(float, w << 16); }
__device__ __forceinline__ float bfhi(unsigned w) { return __builtin_bit_cast(float, w & 0xffff0000u); }
__device__ __forceinline__ float sigmoidf_(float x) { return __builtin_amdgcn_rcpf(1.0f + __expf(-x)); }
__device__ __forceinline__ float siluf_(float x) { return x * __builtin_amdgcn_rcpf(1.0f + __expf(-x)); }
__device__ __forceinline__ int otid() { int t = threadIdx.x; asm volatile("" : "+v"(t)); return t; }
__device__ __forceinline__ unsigned dpp_x1(unsigned v) { return __builtin_amdgcn_update_dpp(0u, v, 0xB1, 0xF, 0xF, false); }
__device__ __forceinline__ unsigned dpp_x2(unsigned v) { return __builtin_amdgcn_update_dpp(0u, v, 0x4E, 0xF, 0xF, false); }
__device__ __forceinline__ unsigned dpp_m8(unsigned v) { return __builtin_amdgcn_update_dpp(0u, v, 0x141, 0xF, 0xF, false); }
__device__ __forceinline__ float dpp_x1f(float v) { return __uint_as_float(dpp_x1(__float_as_uint(v))); }
__device__ __forceinline__ int crow(int r, int hi) { return (r & 3) + 8 * (r >> 2) + 4 * hi; }
__device__ __forceinline__ float wave_sum(float v) {
#pragma unroll
    for (int o = 1; o < 64; o <<= 1) v += __shfl_xor(v, o);
    return v;
}

#define XB_TMO      128
#define XB_XCNT(j)  (256  + 64 * (j))
#define XB_XSUB(j)  (1280 + 64 * (j))
#define XB_XGEN(j)  (2304 + 64 * (j))
#define XB_TOP      3328
#define XB_TOPGEN   3392
#define XCD_BAR_WORDS 3456
#define XB_SPIN_CAP (1u << 18)
__device__ __forceinline__ unsigned xb_ld(unsigned* p)              { return __hip_atomic_load(p, __ATOMIC_RELAXED, __HIP_MEMORY_SCOPE_AGENT); }
__device__ __forceinline__ unsigned xb_add(unsigned* p, unsigned v) { return __hip_atomic_fetch_add(p, v, __ATOMIC_RELAXED, __HIP_MEMORY_SCOPE_AGENT); }
__device__ __forceinline__ unsigned xb_xcc_id() { return (unsigned)__builtin_amdgcn_s_getreg((3 << 11) | 20) & 0xFu; }
#define XB_SPIN(cond, bar) do { unsigned _sp = 0; while (cond) { __builtin_amdgcn_s_sleep(1); \
    if ((++_sp & 255u) == 0u) { if (xb_ld(&(bar)[XB_TMO])) break; if (_sp > XB_SPIN_CAP) { atomicAdd(&(bar)[XB_TMO], 1u); break; } } } } while (0)
struct XcdBarrier { unsigned* bar; unsigned x; volatile LAS unsigned* st; };
__device__ __forceinline__ XcdBarrier xcd_barrier_post(unsigned* bar, volatile LAS unsigned* st) {
    XcdBarrier b; b.bar = bar; b.x = xb_xcc_id(); b.st = st;
    if (threadIdx.x == 0) (void)xb_add(&bar[XB_XCNT(b.x)], 1u);
    return b;
}
__device__ __forceinline__ void xcd_barrier_complete(unsigned* bar, unsigned x, unsigned& nloc, unsigned& nx) {
    const unsigned G = gridDim.x * gridDim.y * gridDim.z;
    unsigned sum, cnt, mine, sp = 0u;
    for (;;) {
        sum = 0u; cnt = 0u; mine = 0u;
#pragma unroll
        for (unsigned j = 0; j < 16; ++j) { const unsigned c = xb_ld(&bar[XB_XCNT(j)]); sum += c; cnt += (c > 0u) ? 1u : 0u; mine = (j == x) ? c : mine; }
        if (sum == G) break;
        __builtin_amdgcn_s_sleep(1);
        if ((++sp & 255u) == 0u) { if (xb_ld(&bar[XB_TMO])) break; if (sp > XB_SPIN_CAP) { atomicAdd(&bar[XB_TMO], 1u); break; } }
    }
    nloc = mine > 0u ? mine : 1u; nx = cnt > 0u ? cnt : 1u;
}
__device__ __forceinline__ void xcd_barrier(const XcdBarrier& b) {
    asm volatile("s_waitcnt vmcnt(0)" ::: "memory");
    __syncthreads();
    if (threadIdx.x == 0) {
        unsigned* bar = b.bar;
        __builtin_amdgcn_s_waitcnt(0);
        unsigned nloc = b.st[0], nx = b.st[1];
        if (nloc == 0u) { xcd_barrier_complete(bar, b.x, nloc, nx); b.st[0] = nloc; b.st[1] = nx; }
        const unsigned old = xb_add(&bar[XB_XSUB(b.x)], 1u);
        const unsigned gen = old / nloc;
        if (old + 1u == (gen + 1u) * nloc) {
            __builtin_amdgcn_fence(__ATOMIC_RELEASE, "agent");
            asm volatile("s_waitcnt vmcnt(0)" ::: "memory");
            const unsigned og = xb_add(&bar[XB_TOP], 1u);
            const unsigned tg = og / nx;
            if (og + 1u == (tg + 1u) * nx) xb_add(&bar[XB_TOPGEN], 1u);
            else XB_SPIN(xb_ld(&bar[XB_TOPGEN]) == tg, bar);
            __builtin_amdgcn_fence(__ATOMIC_ACQUIRE, "agent");
            xb_add(&bar[XB_XGEN(b.x)], 1u);
            asm volatile("s_waitcnt vmcnt(0)" ::: "memory");
        } else {
            XB_SPIN(xb_ld(&bar[XB_XGEN(b.x)]) == gen, bar);
            __builtin_amdgcn_fence(__ATOMIC_ACQUIRE, "agent");
            asm volatile("s_waitcnt vmcnt(0)" ::: "memory");
        }
    }
    __syncthreads();
}

namespace pg8 {
constexpr int BM = 256, BK = 64, HALF = 128, HTB = HALF * BK * 2, STAGE_BYTES = 8 * HTB, NXCD = 8, WGM = 8;
__host__ __device__ __forceinline__ int lds_byte(int r, int c) { const int st = (r >> 4) * 2 + (c >> 5), rr = r & 15, cc = c & 31, ob = rr * 64 + cc * 2; return st * 1024 + (ob ^ (((ob >> 9) & 1) << 5)); }
__host__ __device__ __forceinline__ void stage_rc(int b, int& R, int& C) { const int st = b / 1024, sb = b % 1024, swz = sb ^ (((sb >> 9) & 1) << 5); R = (st >> 1) * 16 + swz / 64; C = (st & 1) * 32 + (swz % 64) / 2; }
__host__ __device__ __forceinline__ int perm32(int rho) { const int n = rho >> 4, i = rho & 15; return 8 * (i >> 2) + 4 * n + (i & 3); }
struct Unit { int pm, pn; };
struct Gemm { const bf16_t* A; const bf16_t* Bt; int lda, ldb, K; };
struct AddrAffine { size_t tA, tB;
    __device__ __forceinline__ const char* A(const char* b, const Unit& u) const { return b + (size_t)u.pm * tA; }
    __device__ __forceinline__ const char* B(const char* b, const Unit& u) const { return b + (size_t)u.pn * tB; }
    __device__ __forceinline__ size_t ka(int t) const { return (size_t)t * (BK * 2); } };
struct AddrCmp { int ntile;
    __device__ __forceinline__ const char* A(const char* b, const Unit& u) const { return b + (size_t)(u.pm >> 3) * (8 * MiB) + (size_t)((u.pm >> 1) & 3) * (2 * MiB) + (size_t)(u.pm & 1) * (256 * 4096) + ka(u.pn * ntile); }
    __device__ __forceinline__ const char* B(const char* b, const Unit& u) const { return b + (size_t)(u.pm >> 3) * (2 * MiB) + (size_t)u.pn * ntile * (BK * 2); }
    __device__ __forceinline__ size_t ka(int t) const { return (size_t)t * (BK * 2); } };
struct StaticOrder {
    int nM, nN, nwg, G, c;
    __host__ __device__ void init(int M, int N, int G_, int c_) { nM = M / BM; nN = N / BM; nwg = nM * nN; G = G_; c = c_; }
    __host__ __device__ bool next(int i, Unit& u) const {
        const long L = (long)i * G + c; if (L >= nwg) return false;
        int wgid = (int)L; { const int q = nwg / NXCD, r = nwg % NXCD, xcd = wgid % NXCD, off = wgid / NXCD; wgid = (xcd < r ? xcd * (q + 1) : r * (q + 1) + (xcd - r) * q) + off; }
        const int nig = WGM * nN, gid = wgid / nig, fm = gid * WGM, gsz = (nM - fm) < WGM ? (nM - fm) : WGM;
        u.pm = fm + ((wgid % nig) % gsz); u.pn = (wgid % nig) / gsz; return true;
    }
};
template <class Epi, bool ALIGN_EPI, class Addr>
__device__ __forceinline__ void gemm_phase(LAS unsigned char* lds, const Gemm g, const StaticOrder& S, const Epi& E, const Addr& AD) {
    const int tid = otid(), wid = __builtin_amdgcn_readfirstlane(tid >> 6), lane = tid & 63, wr = wid >> 2, wc = wid & 3, fr = lane & 15, fq = lane >> 4;
    const int K = g.K, nt = K / BK;
    unsigned voffA[2], voffB[2];
#pragma unroll
    for (int i = 0; i < 2; ++i) { int R, C; stage_rc(tid * 16 + i * 8192, R, C); const int Rb = (R & ~31) + perm32(R & 31);
        voffA[i] = (unsigned)(R * g.lda + C) * 2u; voffB[i] = (unsigned)(Rb * g.ldb + C) * 2u; }
    const size_t kstep = (size_t)(BK * 2);
    const size_t hA = (size_t)HALF * g.lda * 2, hB = (size_t)HALF * g.ldb * 2;
    const unsigned ldsw = (unsigned)wid * 1024u;
    const int aoff = lds_byte(wr * 64 + fr, fq * 8), boff = lds_byte(wc * 32 + fr, fq * 8);
#define PG8_SA(b, h) (((b) * 2 + (h)) * HTB)
#define PG8_SB(b, h) ((4 + (b) * 2 + (h)) * HTB)
#define PG8_STAGE(bufoff, gbase, voff) do { _Pragma("unroll") for (int _i = 0; _i < 2; ++_i) \
        __builtin_amdgcn_global_load_lds((const unsigned*)((const char*)(gbase) + (voff)[_i]), (LAS unsigned*)(lds + (bufoff) + ldsw + _i * 8192), 16, 0, 0); } while (0)
#define PG8_LDA(dst, b, h) do { _Pragma("unroll") for (int m = 0; m < 4; ++m) _Pragma("unroll") for (int k = 0; k < 2; ++k) dst[m][k] = *(const LAS bf16x8*)(lds + PG8_SA(b, h) + aoff + m * 2048 + k * 1024); } while (0)
#define PG8_LDB(dst, b, h) do { _Pragma("unroll") for (int n = 0; n < 2; ++n) _Pragma("unroll") for (int k = 0; k < 2; ++k) dst[n][k] = *(const LAS bf16x8*)(lds + PG8_SB(b, h) + boff + n * 2048 + k * 1024); } while (0)
#define PG8_MMA(ai, bj, At, Bt) do { __builtin_amdgcn_s_setprio(1); _Pragma("unroll") for (int m = 0; m < 4; ++m) _Pragma("unroll") for (int n = 0; n < 2; ++n) _Pragma("unroll") for (int k = 0; k < 2; ++k) \
        acc[ai][bj][m][n] = __builtin_amdgcn_mfma_f32_16x16x32_bf16(Bt[n][k], At[m][k], acc[ai][bj][m][n], 0, 0, 0); __builtin_amdgcn_s_setprio(0); } while (0)
#define PG8_WAIT_V(n) asm volatile("s_waitcnt vmcnt(" #n ")" ::: "memory")
#define PG8_WAIT_L(n) asm volatile("s_waitcnt lgkmcnt(" #n ")" ::: "memory")
#define PG8_BAR __builtin_amdgcn_s_barrier()
#define PG8_SCHED __builtin_amdgcn_sched_barrier(0)
    Unit cur, nxt; int ui = 0;
    if (!S.next(0, cur)) return;
    f32x4 acc[2][2][4][2];
#pragma unroll
    for (int a = 0; a < 2; ++a)
#pragma unroll
        for (int b = 0; b < 2; ++b)
#pragma unroll
            for (int m = 0; m < 4; ++m)
#pragma unroll
                for (int n = 0; n < 2; ++n) acc[a][b][m][n] = (f32x4){0.f, 0.f, 0.f, 0.f};
    bf16x8 At[4][2], B0[2][2], B1[2][2];
    const char* cA = AD.A((const char*)g.A, cur); const char* cB = AD.B((const char*)g.Bt, cur);
    PG8_STAGE(PG8_SB(0, 0), cB, voffB); PG8_STAGE(PG8_SB(0, 1), cB + hB, voffB); PG8_STAGE(PG8_SA(0, 0), cA, voffA); PG8_STAGE(PG8_SA(0, 1), cA + hA, voffA);
    if (wr == 1) PG8_BAR;
    PG8_WAIT_V(2); PG8_BAR;
    PG8_STAGE(PG8_SB(1, 0), cB + kstep, voffB); PG8_STAGE(PG8_SA(1, 0), cA + kstep, voffA); PG8_STAGE(PG8_SB(1, 1), cB + hB + kstep, voffB);
    PG8_WAIT_V(6); PG8_BAR;
    for (;;) {
        const bool has_next = S.next(ui + 1, nxt);
        const char* nA = has_next ? AD.A((const char*)g.A, nxt) : cA; const char* nB = has_next ? AD.B((const char*)g.Bt, nxt) : cB;
        for (int t = 0; t < nt; t += 2) {
            const bool last = (t == nt - 2);
            const char* a1 = cA + AD.ka(t) + kstep;
            const char* a2 = last ? nA : cA + AD.ka(t + 2); const char* b2 = last ? nB : cB + (size_t)(t + 2) * kstep;
            const char* a3 = a2 + kstep; const char* b3 = b2 + kstep;
            PG8_LDB(B0, 0, 0); PG8_LDB(B1, 0, 1); PG8_SCHED; PG8_LDA(At, 0, 0); PG8_STAGE(PG8_SA(1, 1), a1 + hA, voffA);
            PG8_WAIT_V(8); PG8_WAIT_L(0); PG8_BAR; PG8_MMA(0, 0, At, B0); PG8_MMA(0, 1, At, B1); PG8_BAR; PG8_SCHED;
            PG8_LDA(At, 0, 1); PG8_STAGE(PG8_SB(0, 0), b2, voffB); PG8_STAGE(PG8_SB(0, 1), b2 + hB, voffB); PG8_STAGE(PG8_SA(0, 0), a2, voffA);
            PG8_WAIT_V(8); PG8_WAIT_L(0); PG8_BAR; PG8_MMA(1, 0, At, B0); PG8_MMA(1, 1, At, B1); PG8_BAR; PG8_SCHED;
            PG8_LDB(B0, 1, 0); PG8_LDB(B1, 1, 1); PG8_SCHED; PG8_LDA(At, 1, 0); PG8_STAGE(PG8_SA(0, 1), a2 + hA, voffA);
            PG8_WAIT_V(8); PG8_WAIT_L(0); PG8_BAR; PG8_MMA(0, 0, At, B0); PG8_MMA(0, 1, At, B1); PG8_BAR; PG8_SCHED;
            PG8_LDA(At, 1, 1); PG8_STAGE(PG8_SB(1, 0), b3, voffB); PG8_STAGE(PG8_SB(1, 1), b3 + hB, voffB); PG8_STAGE(PG8_SA(1, 0), a3, voffA);
            PG8_WAIT_V(8); PG8_WAIT_L(0); PG8_BAR; PG8_MMA(1, 0, At, B0); PG8_MMA(1, 1, At, B1); PG8_BAR; PG8_SCHED;
        }
        if constexpr (ALIGN_EPI) { if (wr == 0) PG8_BAR; }
        E(acc, cur, wr, wc, fr, fq);
        if (!has_next) break;
#pragma unroll
        for (int a = 0; a < 2; ++a)
#pragma unroll
            for (int b = 0; b < 2; ++b)
#pragma unroll
                for (int m = 0; m < 4; ++m)
#pragma unroll
                    for (int n = 0; n < 2; ++n) acc[a][b][m][n] = (f32x4){0.f, 0.f, 0.f, 0.f};
        cur = nxt; cA = nA; cB = nB; ++ui;
        if constexpr (ALIGN_EPI) { if (wr == 1) PG8_BAR; }
    }
    PG8_WAIT_V(0);
    if constexpr (!ALIGN_EPI) { if (wr == 0) PG8_BAR; }
    PG8_BAR;
#undef PG8_SA
#undef PG8_SB
#undef PG8_STAGE
#undef PG8_LDA
#undef PG8_LDB
#undef PG8_MMA
#undef PG8_WAIT_V
#undef PG8_WAIT_L
#undef PG8_BAR
#undef PG8_SCHED
}
template <class Epi>
__device__ __forceinline__ void gemm_phase2(LAS unsigned char* lds, const Gemm g0, const Gemm g1, const StaticOrder& S, const Epi& E) {
    const int tid = otid(), wid = __builtin_amdgcn_readfirstlane(tid >> 6), lane = tid & 63, wr = wid >> 2, wc = wid & 3, fr = lane & 15, fq = lane >> 4;
#define PG8_MKOFF(vA, vB, G) do { _Pragma("unroll") for (int i_ = 0; i_ < 2; ++i_) { int R_, C_; stage_rc(tid * 16 + i_ * 8192, R_, C_); const int Rb_ = (R_ & ~31) + perm32(R_ & 31); \
        (vA)[i_] = (unsigned)(R_ * (G).lda + C_) * 2u; (vB)[i_] = (unsigned)(Rb_ * (G).ldb + C_) * 2u; } } while (0)
    const size_t kstep = (size_t)(BK * 2);
    const size_t hA0 = (size_t)HALF * g0.lda * 2, hB0 = (size_t)HALF * g0.ldb * 2, hA1 = (size_t)HALF * g1.lda * 2, hB1 = (size_t)HALF * g1.ldb * 2;
    const unsigned ldsw = (unsigned)wid * 1024u;
    const int aoff = lds_byte(wr * 64 + fr, fq * 8), boff = lds_byte(wc * 32 + fr, fq * 8);
#define PG8_SA(b, h) (((b) * 2 + (h)) * HTB)
#define PG8_SB(b, h) ((4 + (b) * 2 + (h)) * HTB)
#define PG8_STAGE(bufoff, gbase, voff) do { _Pragma("unroll") for (int _i = 0; _i < 2; ++_i) \
        __builtin_amdgcn_global_load_lds((const unsigned*)((const char*)(gbase) + (voff)[_i]), (LAS unsigned*)(lds + (bufoff) + ldsw + _i * 8192), 16, 0, 0); } while (0)
#define PG8_LDA(dst, b, h) do { _Pragma("unroll") for (int m = 0; m < 4; ++m) _Pragma("unroll") for (int k = 0; k < 2; ++k) dst[m][k] = *(const LAS bf16x8*)(lds + PG8_SA(b, h) + aoff + m * 2048 + k * 1024); } while (0)
#define PG8_LDB(dst, b, h) do { _Pragma("unroll") for (int n = 0; n < 2; ++n) _Pragma("unroll") for (int k = 0; k < 2; ++k) dst[n][k] = *(const LAS bf16x8*)(lds + PG8_SB(b, h) + boff + n * 2048 + k * 1024); } while (0)
#define PG8_MMA(ai, bj, At, Bt) do { __builtin_amdgcn_s_setprio(1); _Pragma("unroll") for (int m = 0; m < 4; ++m) _Pragma("unroll") for (int n = 0; n < 2; ++n) _Pragma("unroll") for (int k = 0; k < 2; ++k) \
        acc[ai][bj][m][n] = __builtin_amdgcn_mfma_f32_16x16x32_bf16(Bt[n][k], At[m][k], acc[ai][bj][m][n], 0, 0, 0); __builtin_amdgcn_s_setprio(0); } while (0)
#define PG8_WAIT_V(n) asm volatile("s_waitcnt vmcnt(" #n ")" ::: "memory")
#define PG8_WAIT_L(n) asm volatile("s_waitcnt lgkmcnt(" #n ")" ::: "memory")
#define PG8_BAR __builtin_amdgcn_s_barrier()
#define PG8_SCHED __builtin_amdgcn_sched_barrier(0)
    Unit cur; int kind = 0;
    if (!S.next(0, cur)) return;
    f32x4 acc[2][2][4][2];
#pragma unroll
    for (int a = 0; a < 2; ++a)
#pragma unroll
        for (int b = 0; b < 2; ++b)
#pragma unroll
            for (int m = 0; m < 4; ++m)
#pragma unroll
                for (int n = 0; n < 2; ++n) acc[a][b][m][n] = (f32x4){0.f, 0.f, 0.f, 0.f};
    bf16x8 At[4][2], B0[2][2], B1[2][2];
    const char* cA = (const char*)g0.A + (size_t)cur.pm * (2 * hA0); const char* cB = (const char*)g0.Bt + (size_t)cur.pn * (2 * hB0);
    unsigned voffA[2], voffB[2]; PG8_MKOFF(voffA, voffB, g0); size_t hA = hA0, hB = hB0;
    PG8_STAGE(PG8_SB(0, 0), cB, voffB); PG8_STAGE(PG8_SB(0, 1), cB + hB, voffB); PG8_STAGE(PG8_SA(0, 0), cA, voffA); PG8_STAGE(PG8_SA(0, 1), cA + hA, voffA);
    if (wr == 1) PG8_BAR;
    PG8_WAIT_V(2); PG8_BAR;
    PG8_STAGE(PG8_SB(1, 0), cB + kstep, voffB); PG8_STAGE(PG8_SA(1, 0), cA + kstep, voffA); PG8_STAGE(PG8_SB(1, 1), cB + hB + kstep, voffB);
    PG8_WAIT_V(6); PG8_BAR;
    for (;;) {
        const bool has_next = kind == 0;
        const int nt = (kind == 0 ? g0.K : g1.K) / BK;
        const char* nA = has_next ? (const char*)g1.A + (size_t)cur.pm * (2 * hA1) : cA; const char* nB = has_next ? (const char*)g1.Bt + (size_t)cur.pn * (2 * hB1) : cB;
        for (int t = 0; t < nt; t += 2) {
            const bool last = (t == nt - 2);
            const char* a1 = cA + (size_t)(t + 1) * kstep;
            const char* a2 = last ? nA : cA + (size_t)(t + 2) * kstep; const char* b2 = last ? nB : cB + (size_t)(t + 2) * kstep;
            const char* a3 = a2 + kstep; const char* b3 = b2 + kstep;
            const bool sw = last && has_next;
            unsigned voffAn[2] = {voffA[0], voffA[1]}, voffBn[2] = {voffB[0], voffB[1]}; if (sw) PG8_MKOFF(voffAn, voffBn, g1);
            const size_t hAn = sw ? hA1 : hA, hBn = sw ? hB1 : hB;
            PG8_LDB(B0, 0, 0); PG8_LDB(B1, 0, 1); PG8_SCHED; PG8_LDA(At, 0, 0); PG8_STAGE(PG8_SA(1, 1), a1 + hA, voffA);
            PG8_WAIT_V(8); PG8_WAIT_L(0); PG8_BAR; PG8_MMA(0, 0, At, B0); PG8_MMA(0, 1, At, B1); PG8_BAR; PG8_SCHED;
            PG8_LDA(At, 0, 1); PG8_STAGE(PG8_SB(0, 0), b2, voffBn); PG8_STAGE(PG8_SB(0, 1), b2 + hBn, voffBn); PG8_STAGE(PG8_SA(0, 0), a2, voffAn);
            PG8_WAIT_V(8); PG8_WAIT_L(0); PG8_BAR; PG8_MMA(1, 0, At, B0); PG8_MMA(1, 1, At, B1); PG8_BAR; PG8_SCHED;
            PG8_LDB(B0, 1, 0); PG8_LDB(B1, 1, 1); PG8_SCHED; PG8_LDA(At, 1, 0); PG8_STAGE(PG8_SA(0, 1), a2 + hAn, voffAn);
            PG8_WAIT_V(8); PG8_WAIT_L(0); PG8_BAR; PG8_MMA(0, 0, At, B0); PG8_MMA(0, 1, At, B1); PG8_BAR; PG8_SCHED;
            PG8_LDA(At, 1, 1); PG8_STAGE(PG8_SB(1, 0), b3, voffBn); PG8_STAGE(PG8_SB(1, 1), b3 + hBn, voffBn); PG8_STAGE(PG8_SA(1, 0), a3, voffAn);
            PG8_WAIT_V(8); PG8_WAIT_L(0); PG8_BAR; PG8_MMA(1, 0, At, B0); PG8_MMA(1, 1, At, B1); PG8_BAR; PG8_SCHED;
        }
        if (wr == 0) PG8_BAR;
        E(acc, cur, kind, wr, wc, fr, fq);
        if (!has_next) break;
#pragma unroll
        for (int a = 0; a < 2; ++a)
#pragma unroll
            for (int b = 0; b < 2; ++b)
#pragma unroll
                for (int m = 0; m < 4; ++m)
#pragma unroll
                    for (int n = 0; n < 2; ++n) acc[a][b][m][n] = (f32x4){0.f, 0.f, 0.f, 0.f};
        cA = nA; cB = nB; kind = 1; PG8_MKOFF(voffA, voffB, g1); hA = hA1; hB = hB1;
        if (wr == 1) PG8_BAR;
    }
    PG8_WAIT_V(0);
    PG8_BAR;
#undef PG8_SA
#undef PG8_SB
#undef PG8_STAGE
#undef PG8_LDA
#undef PG8_LDB
#undef PG8_MMA
#undef PG8_WAIT_V
#undef PG8_WAIT_L
#undef PG8_BAR
#undef PG8_SCHED
#undef PG8_MKOFF
}
}

typedef f32x4 Acc[2][2][4][2];
__device__ __forceinline__ u32x4 pack8(f32x4 a, f32x4 b) { u32x4 w; w.x = cvtpk(a[0], a[1]); w.y = cvtpk(a[2], a[3]); w.z = cvtpk(b[0], b[1]); w.w = cvtpk(b[2], b[3]); return w; }
__device__ __forceinline__ void unpack8(u32x4 w, f32x4& a, f32x4& b) { a = (f32x4){bflo(w.x), bfhi(w.x), bflo(w.y), bfhi(w.y)}; b = (f32x4){bflo(w.z), bfhi(w.z), bflo(w.w), bfhi(w.w)}; }

struct EpiInProj {
    unsigned char* ws; bf16_t* gm; const float* bmerge;
    __device__ __forceinline__ void operator()(const Acc& acc, const pg8::Unit& u, int wr, int wc, int fr, int fq) const {
        const int pn = u.pn;
        bf16_t* dst; int ldc, cb, mode; size_t bjs = 128;
        if (pn < 4)       { dst = (bf16_t*)(ws + WS_U);   ldc = 1024; cb = pn * 256;        mode = 0; }
        else if (pn < 8)  { dst = (bf16_t*)(ws + WS_GP);  ldc = 1024; cb = (pn - 4) * 256;  mode = 1; }
        else if (pn < 16) { dst = (bf16_t*)(ws + WS_Q);   ldc = 2048; cb = (pn - 8) * 256;  mode = 3; }
        else if (pn < 28) { const int k = (pn - 16) >> 1; dst = (bf16_t*)(ws + WS_KCR + (size_t)k * (8 * MiB)); ldc = 512; cb = ((pn - 16) & 1) * 256; mode = (k == 2 || k == 4) ? 3 : 0;
                            if (k < 2) { ldc = 128; cb = 0; bjs = (size_t)S * 128; dst += (size_t)((pn - 16) & 1) * 2 * S * 128; } }
        else if (pn < 36) { dst = (bf16_t*)(ws + WS_GN);  ldc = 2048; cb = (pn - 28) * 256; mode = 1; }
        else if (pn < 52) { dst = gm;                     ldc = 4096; cb = (pn - 36) * 256; mode = 2; }
        else              { dst = (bf16_t*)(ws + WS_GBR); ldc = 256;  cb = 0;               mode = 4; }
        const int row0 = u.pm * 256 + wr * 64 + fr, cl = wc * 32 + 8 * fq, col0 = cb + cl;
        const float* rcos = (const float*)(ws + WS_ROPE); const float* rsin = rcos + (size_t)S * 64;
#pragma unroll
        for (int ai = 0; ai < 2; ++ai)
#pragma unroll
            for (int m = 0; m < 4; ++m) {
                const int row = row0 + ai * 128 + m * 16;
                bf16_t* rowp = dst + (size_t)row * ldc + col0;
                f32x4 cs0, cs1, sn0, sn1;
                if (mode == 3) { const int i0 = (cl & 127) >> 1; cs0 = *(const f32x4*)(rcos + (size_t)row * 64 + i0); sn0 = *(const f32x4*)(rsin + (size_t)row * 64 + i0); }
#pragma unroll
                for (int bj = 0; bj < 2; ++bj) {
                    f32x4 v0 = acc[ai][bj][m][0], v1 = acc[ai][bj][m][1];
                    if (mode == 1) { for (int e = 0; e < 4; ++e) { v0[e] = siluf_(v0[e]); v1[e] = siluf_(v1[e]); } }
                    else if (mode == 2 || mode == 4) { if (mode == 2) { v0 = v0 + *(const f32x4*)(bmerge + col0 + bj * 128); v1 = v1 + *(const f32x4*)(bmerge + col0 + bj * 128 + 4); } for (int e = 0; e < 4; ++e) { v0[e] = sigmoidf_(v0[e]); v1[e] = sigmoidf_(v1[e]); } }
                    else if (mode == 3) {
                        f32x4 o0, o1;
                        o0[0] = v0[0] * cs0[0] - v0[1] * sn0[0]; o0[1] = v0[1] * cs0[0] + v0[0] * sn0[0];
                        o0[2] = v0[2] * cs0[1] - v0[3] * sn0[1]; o0[3] = v0[3] * cs0[1] + v0[2] * sn0[1];
                        o1[0] = v1[0] * cs0[2] - v1[1] * sn0[2]; o1[1] = v1[1] * cs0[2] + v1[0] * sn0[2];
                        o1[2] = v1[2] * cs0[3] - v1[3] * sn0[3]; o1[3] = v1[3] * cs0[3] + v1[2] * sn0[3];
                        v0 = o0; v1 = o1;
                    }
                    *(u32x4*)(rowp + bj * bjs) = pack8(v0, v1);
                }
            }
    }
};
struct EpiYa {
    bf16_t* yag; const bf16_t* gm;
    __device__ __forceinline__ void operator()(const Acc& acc, const pg8::Unit& u, int wr, int wc, int fr, int fq) const {
        const int row0 = u.pm * 256 + wr * 64 + fr, col0 = u.pn * 256 + wc * 32 + 8 * fq;
#pragma unroll
        for (int ai = 0; ai < 2; ++ai)
#pragma unroll
            for (int m = 0; m < 4; ++m) { int ro_ = ai * 128 + m * 16; asm volatile("" : "+v"(ro_)); const size_t r = (size_t)(row0 + ro_);
#pragma unroll
                for (int bj = 0; bj < 2; ++bj) { f32x4 g0, g1; unpack8(*(const u32x4*)(gm + r * 4096 + col0 + bj * 128), g0, g1);
                    *(u32x4*)(yag + r * 2048 + col0 + bj * 128) = pack8(acc[ai][bj][m][0] * g0, acc[ai][bj][m][1] * g1); } }
    }
};
struct EpiYb {
    bf16_t* merged; const bf16_t* yag; const bf16_t* gm;
    __device__ __forceinline__ void operator()(const Acc& acc, const pg8::Unit& u, int wr, int wc, int fr, int fq) const {
        const int row0 = u.pm * 256 + wr * 64 + fr, col0 = u.pn * 256 + wc * 32 + 8 * fq;
#pragma unroll
        for (int ai = 0; ai < 2; ++ai)
#pragma unroll
            for (int m = 0; m < 4; ++m) { int ro_ = ai * 128 + m * 16; asm volatile("" : "+v"(ro_)); const size_t r = (size_t)(row0 + ro_);
#pragma unroll
                for (int bj = 0; bj < 2; ++bj) { f32x4 g0, g1, y0, y1; unpack8(*(const u32x4*)(gm + r * 4096 + 2048 + col0 + bj * 128), g0, g1);
                    unpack8(*(const u32x4*)(yag + r * 2048 + col0 + bj * 128), y0, y1);
                    *(u32x4*)(merged + r * 2048 + col0 + bj * 128) = pack8(y0 + acc[ai][bj][m][0] * g0, y1 + acc[ai][bj][m][1] * g1); } }
    }
};
struct EpiYaYb {
    EpiYa ya; EpiYb yb;
    __device__ __forceinline__ void operator()(const Acc& acc, const pg8::Unit& u, int kind, int wr, int wc, int fr, int fq) const {
        if (kind == 0) { ya(acc, u, wr, wc, fr, fq); asm volatile("s_waitcnt vmcnt(0)" ::: "memory"); } else yb(acc, u, wr, wc, fr, fq);
    }
};
constexpr int NSPLIT = 8;
struct EpiSlab {
    float* slab;
    __device__ __forceinline__ void operator()(const Acc& acc, const pg8::Unit& u, int wr, int wc, int fr, int fq) const {
        float* base = slab + ((size_t)((u.pm >> 3) * NSPLIT + u.pn) * 2048 + (size_t)(u.pm & 7) * 256 + wr * 64 + fr) * 256 + wc * 32 + 8 * fq;
#pragma unroll
        for (int ai = 0; ai < 2; ++ai)
#pragma unroll
            for (int m = 0; m < 4; ++m)
#pragma unroll
                for (int bj = 0; bj < 2; ++bj) { float* p = base + (size_t)(ai * 128 + m * 16) * 256 + bj * 128; *(f32x4*)p = acc[ai][bj][m][0]; *(f32x4*)(p + 4) = acc[ai][bj][m][1]; }
    }
};
constexpr int CW_PANEL = 16384;
constexpr int EPI_LDS_OFF = RING_BYTES + 1024;
struct EpiOut {
    float* out; const float* x; float* ssq; const float* fw; unsigned* ctl; LAS unsigned char* lds;
    __device__ __forceinline__ void operator()(const Acc& acc_, const pg8::Unit& u, int wr, int wc, int fr, int fq) const {
        Acc& acc = const_cast<Acc&>(acc_);
        const int tid = otid();
        const int row0 = u.pm * 256 + wr * 64 + fr, col0 = u.pn * 256 + wc * 32 + 8 * fq;
        LAS float* rs = (LAS float*)(lds + EPI_LDS_OFF);
#pragma unroll
        for (int ai = 0; ai < 2; ++ai)
#pragma unroll
            for (int m = 0; m < 4; ++m) { const size_t r = (size_t)(row0 + ai * 128 + m * 16); float q = 0.f;
#pragma unroll
                for (int bj = 0; bj < 2; ++bj)
#pragma unroll
                    for (int n = 0; n < 2; ++n) { const size_t o = r * 2048 + col0 + bj * 128 + 4 * n; const f32x4 v = *(const f32x4*)(x + o) + acc[ai][bj][m][n];
                        acc[ai][bj][m][n] = v; q += (v[0] * v[0] + v[1] * v[1]) + (v[2] * v[2] + v[3] * v[3]); }
                q += __shfl_xor(q, 16); q += __shfl_xor(q, 32);
                if (fq == 0) __hip_atomic_store((unsigned*)(ssq + (size_t)(u.pn * 4 + wc) * S + r), __float_as_uint(q), __ATOMIC_RELAXED, __HIP_MEMORY_SCOPE_AGENT); }
        asm volatile("s_waitcnt vmcnt(0)" ::: "memory");
        __syncthreads();
        if (tid == 0) { unsigned* c = ctl + CW_PANEL + 64 * u.pm;
            __hip_atomic_fetch_add(c, 1u, __ATOMIC_RELAXED, __HIP_MEMORY_SCOPE_AGENT);
            unsigned sp = 0; while (__hip_atomic_load(c, __ATOMIC_RELAXED, __HIP_MEMORY_SCOPE_AGENT) < 8u) { __builtin_amdgcn_s_sleep(2); if (++sp > (1u << 22)) break; }
            __builtin_amdgcn_fence(__ATOMIC_ACQUIRE, "agent"); asm volatile("s_waitcnt vmcnt(0)" ::: "memory"); }
        __syncthreads();
        if (tid < 256) { const size_t r = (size_t)u.pm * 256 + tid; float s = 0.f;
#pragma unroll 8
            for (int p = 0; p < 32; ++p) s += __uint_as_float(__hip_atomic_load((unsigned*)(ssq + (size_t)p * S + r), __ATOMIC_RELAXED, __HIP_MEMORY_SCOPE_AGENT));
            rs[tid] = 1.0f / sqrtf(s * (1.f / DM) + EPS); }
        __syncthreads();
#pragma unroll
        for (int ai = 0; ai < 2; ++ai)
#pragma unroll
            for (int m = 0; m < 4; ++m) { const int rl = wr * 64 + fr + ai * 128 + m * 16; const float sc = rs[rl]; const size_t r = (size_t)u.pm * 256 + rl;
#pragma unroll
                for (int bj = 0; bj < 2; ++bj)
#pragma unroll
                    for (int n = 0; n < 2; ++n) { const size_t o = r * 2048 + col0 + bj * 128 + 4 * n; *(f32x4*)(out + o) = acc[ai][bj][m][n] * sc * *(const f32x4*)(fw + col0 + bj * 128 + 4 * n); } }
    }
};

struct Args { const float* in[17]; float* out; unsigned char* ws; int ph_lo, ph_hi; };
struct Frame { LAS unsigned char* lds; int tid, lane, wave, vcu, G; };

__device__ __forceinline__ int ropeperm(int d) { return d < 64 ? 2 * d : 2 * (d - 64) + 1; }
__device__ __forceinline__ void transpose_item(const float* W, int ldw, int Nvalid, bf16_t* WT, int ldt, int row_off, bool perm, LAS float* scr, int kb, int nb, int lane) {
    const int k0 = 64 * kb, n0 = 32 * nb, cq = lane & 7, rb = lane >> 3; const bool ok = n0 + cq * 4 < Nvalid;
    f32x4 v[8];
#pragma unroll
    for (int i = 0; i < 8; ++i) v[i] = ok ? *(const f32x4*)(W + (size_t)(k0 + i * 8 + rb) * ldw + n0 + cq * 4) : (f32x4){0.f, 0.f, 0.f, 0.f};
#pragma unroll
    for (int i = 0; i < 8; ++i) *(LAS f32x4*)(scr + (i * 8 + rb) * 32 + ((cq ^ i) << 2)) = v[i];
    LDS_WAIT(); asm volatile("" ::: "memory");
#pragma unroll
    for (int j = 0; j < 4; ++j) { const int idx = lane + 64 * j, n = idx >> 3, c = idx & 7; const LAS float* s = scr + (8 * c) * 32 + ((((n >> 2) ^ c) << 2) | (n & 3));
        u32x4 o; o.x = cvtpk(s[0 * 32], s[1 * 32]); o.y = cvtpk(s[2 * 32], s[3 * 32]); o.z = cvtpk(s[4 * 32], s[5 * 32]); o.w = cvtpk(s[6 * 32], s[7 * 32]);
        const int ng = n0 + n;
        if (ng < Nvalid) { const int dr = perm ? ((ng & ~127) | ropeperm(ng & 127)) : ng; *(GAS u32x4*)(WT + (size_t)(row_off + dr) * ldt + k0 + 8 * c) = o; } }
    LDS_WAIT(); asm volatile("" ::: "memory");
}

__device__ __forceinline__ void p0_prologue(const Frame& F, const Args& a) {
    unsigned char* ws = a.ws;
    LAS float* scr = (LAS float*)(F.lds + F.wave * 8192);
    const int gw = F.vcu * NWAVES + F.wave, NGW = F.G * NWAVES, lane = F.lane;
    constexpr int I_WIN = 32 * 258, I_WM = 32 * 128;
    for (int it = gw; it < I_WIN + I_WM; it += NGW) {
        int r = it;
        if (r < I_WIN) { const int kb = r / 258, nb = 32 + r % 258, n0 = nb * 32;
            const bool perm = (n0 >= 2048 && n0 < 4096) || (n0 >= 5120 && n0 < 5632) || (n0 >= 6144 && n0 < 6656);
            transpose_item(a.in[2], 9264, 9264, (bf16_t*)(ws + WS_WCAT), 2048, nb >= 288 ? 4096 : 0, perm, scr, kb, nb, lane); continue; } r -= I_WIN;
        transpose_item(a.in[13], 4096, 4096, (bf16_t*)(ws + WS_WCAT), 2048, 9216, false, scr, r / 128, r % 128, lane);
    }
    {
        const float* win = a.in[2]; const float* mix = a.in[3]; bf16_t* WC = (bf16_t*)(ws + WS_WCAT); const int r = lane & 31, hh = lane >> 5;
        for (int it = gw; it < 1024; it += NGW) {
            const int g = it >> 8, d0 = ((it >> 5) & 7) * 32, kin0 = (it & 31) * 64;
            f32x16 acc0 = f32x16{}, acc1 = f32x16{};
            const float* ap = mix + (size_t)g * 65536 + (size_t)(8 * hh) * 256 + d0 + r;
            const float* bp0 = win + (size_t)(kin0 + r) * 9264 + g * 256 + 8 * hh; const float* bp1 = bp0 + (size_t)32 * 9264;
#pragma unroll 4
            for (int k = 0; k < 16; ++k) {
                f32x4 a0, a1;
#pragma unroll
                for (int j = 0; j < 4; ++j) { a0[j] = ap[(size_t)(k * 16 + j) * 256]; a1[j] = ap[(size_t)(k * 16 + 4 + j) * 256]; }
                const u32x4 af = pack8(a0, a1), b0 = pack8(*(const f32x4*)(bp0 + k * 16), *(const f32x4*)(bp0 + k * 16 + 4)), b1 = pack8(*(const f32x4*)(bp1 + k * 16), *(const f32x4*)(bp1 + k * 16 + 4));
                acc0 = __builtin_amdgcn_mfma_f32_32x32x16_bf16(__builtin_bit_cast(bf16x8, af), __builtin_bit_cast(bf16x8, b0), acc0, 0, 0, 0);
                acc1 = __builtin_amdgcn_mfma_f32_32x32x16_bf16(__builtin_bit_cast(bf16x8, af), __builtin_bit_cast(bf16x8, b1), acc1, 0, 0, 0);
            }
#pragma unroll
            for (int e = 0; e < 16; ++e) { int ee = e; asm volatile("" : "+v"(ee)); bf16_t* rowp = WC + (size_t)(g * 256 + d0 + crow(ee, hh)) * 2048 + kin0 + r;
                const float v0 = acc0[e], v1 = acc1[e], n0_ = dpp_x1f(v0), n1_ = dpp_x1f(v1);
                if ((r & 1) == 0) { *(unsigned*)rowp = cvtpk(v0, n0_); *(unsigned*)(rowp + 32) = cvtpk(v1, n1_); } }
        }
    }
    for (int i = gw * 64 + lane; i < 53248; i += NGW * 64) *(GAS u32x4*)(ws + WS_WCAT + (size_t)13360 * 4096 + (size_t)i * 16) = (u32x4){0u, 0u, 0u, 0u};
    {
        const float* x = a.in[0]; const float* nw = a.in[1]; bf16_t* H = (bf16_t*)(ws + WS_H);
        f32x4 wv[8];
#pragma unroll
        for (int j = 0; j < 8; ++j) wv[j] = *((const f32x4*)nw + lane + 64 * j);
        for (int m = gw; m < S; m += NGW) {
            const f32x4* xr = (const f32x4*)(x + (size_t)m * DM) + lane; f32x4 v[8]; float s = 0.f;
#pragma unroll
            for (int j = 0; j < 8; ++j) { v[j] = xr[64 * j]; s += (v[j][0] * v[j][0] + v[j][1] * v[j][1]) + (v[j][2] * v[j][2] + v[j][3] * v[j][3]); }
            const float rstd = 1.0f / sqrtf(wave_sum(s) * (1.f / DM) + EPS);
            u32x2* o = (u32x2*)(H + (size_t)m * DM) + lane;
#pragma unroll
            for (int j = 0; j < 8; ++j) { const f32x4 y = v[j] * rstd * wv[j]; u32x2 w; w.x = cvtpk(y[0], y[1]); w.y = cvtpk(y[2], y[3]); o[64 * j] = w; }
        }
    }
    {
        float* rcos = (float*)(ws + WS_ROPE); float* rsin = rcos + (size_t)S * 64;
        for (int e = gw * 64 + lane; e < S * 64; e += NGW * 64) {
            const int pos = e >> 6, i = e & 63;
            double inv = 1.0, b = 0.86596432336006535;
            for (int k = i; k; k >>= 1) { if (k & 1) inv *= b; b *= b; }
            const double t = (double)pos * inv * 0.15915494309189535;
            const float fr = (float)(t - floor(t));
            rcos[e] = __builtin_amdgcn_cosf(fr); rsin[e] = __builtin_amdgcn_sinf(fr);
        }
    }
}
__device__ __forceinline__ void p1_late_weights(const Frame& F, const Args& a, int cw, int NCW) {
    unsigned char* ws = a.ws;
    LAS float* scr = (LAS float*)(F.lds + F.wave * 8192);
    const int lane = F.lane;
    constexpr int I_NO = 32 * 64, I_O = 32 * 64, I_PO = 16 * 64, I_W1 = 64 * 8, I_W2 = 4 * 4, I_B1 = 512;
    constexpr int NITEMS = I_NO + I_O + I_PO + 2 * I_W1 + 2 * I_W2 + I_B1;
    for (int it = cw; it < NITEMS; it += NCW) {
        int r = it;
        if (r < I_W1) { transpose_item(a.in[6], 256, 256, (bf16_t*)(ws + WS_W1KT), 4096, 0, false, scr, r / 8, r % 8, lane); continue; } r -= I_W1;
        if (r < I_W1) { transpose_item(a.in[9], 256, 256, (bf16_t*)(ws + WS_W1VT), 4096, 0, false, scr, r / 8, r % 8, lane); continue; } r -= I_W1;
        if (r < I_B1) {
            const int which = r >> 8, fb = (r >> 6) & 3, ch = r & 63, f = fb * 64 + lane;
            const float* pe = a.in[which ? 8 : 5]; const float* w1 = a.in[which ? 9 : 6]; float s = 0.f;
#pragma unroll 16
            for (int k = ch * 64; k < ch * 64 + 64; ++k) s += pe[k] * w1[(size_t)k * 256 + f];
            ((float*)(ws + WS_B1P))[(which * 64 + ch) * 256 + f] = s; continue; } r -= I_B1;
        if (r < I_W2) { transpose_item(a.in[7], 128, 128, (bf16_t*)(ws + WS_W2KT), 256, 0, true, scr, r / 4, r % 4, lane); continue; } r -= I_W2;
        if (r < I_W2) { transpose_item(a.in[10], 128, 128, (bf16_t*)(ws + WS_W2VT), 256, 0, false, scr, r / 4, r % 4, lane); continue; } r -= I_W2;
        if (r < I_PO) { transpose_item(a.in[11], 2048, 2048, (bf16_t*)(ws + WS_WPOT), 1024, 0, false, scr, r / 64, r % 64, lane); continue; } r -= I_PO;
        if (r < I_NO) { transpose_item(a.in[12], 2048, 2048, (bf16_t*)(ws + WS_WNOT), 2048, 0, false, scr, r / 64, r % 64, lane); continue; } r -= I_NO;
        transpose_item(a.in[15], 2048, 2048, (bf16_t*)(ws + WS_WOT), 2048, 0, false, scr, r / 64, r % 64, lane);
    }
}

template <int W>
__device__ __forceinline__ void ypool_item(const bf16_t* __restrict__ U, const bf16_t* __restrict__ GP, bf16_t* __restrict__ Y, const float* __restrict__ scale, int c, int t0) {
    u32x4 x[W + 7], gq[8];
#pragma unroll
    for (int k = 0; k < W + 7; ++k) { const int r = t0 - (W - 1) + k; x[k] = r >= 0 ? *(const u32x4*)(U + (size_t)r * 1024 + c) : (u32x4){0u, 0u, 0u, 0u}; }
#pragma unroll
    for (int k = 0; k < 8; ++k) gq[k] = *(const u32x4*)(GP + (size_t)(t0 + k) * 1024 + c);
    const f32x4 sc0 = *(const f32x4*)(scale + c), sc1 = *(const f32x4*)(scale + c + 4);
    f32x4 s0 = {0.f, 0.f, 0.f, 0.f}, s1 = s0, a0, a1;
#pragma unroll
    for (int k = 0; k < W - 1; ++k) { unpack8(x[k], a0, a1); s0 = s0 + a0; s1 = s1 + a1; }
#pragma unroll
    for (int k = 0; k < 8; ++k) { const int t = t0 + k;
        unpack8(x[W - 1 + k], a0, a1); s0 = s0 + a0; s1 = s1 + a1;
        const int cnt = (t + 1 < W) ? t + 1 : W; const float ic = 1.0f / (float)cnt;
        f32x4 g0, g1; unpack8(gq[k], g0, g1);
        *(u32x4*)(Y + (size_t)t * 1024 + c) = pack8((s0 * ic - a0) * sc0 * g0, (s1 * ic - a1) * sc1 * g1);
        f32x4 b0, b1; unpack8(x[k], b0, b1); s0 = s0 - b0; s1 = s1 - b1; }
}
__device__ __forceinline__ void p2_ypool(const Frame& F, unsigned char* ws, const float* __restrict__ scale, int cw, int NCW) {
    const bf16_t* __restrict__ U = (const bf16_t*)(ws + WS_U); const bf16_t* __restrict__ GP = (const bf16_t*)(ws + WS_GP); bf16_t* __restrict__ Y = (bf16_t*)(ws + WS_H + 16 * MiB);
    for (int wi = cw; wi < 4 * 512; wi += NCW) {
        const int g = wi & 3, t0 = ((wi >> 2) * 2 + (F.lane >> 5)) * 8, c = (g * 32 + (F.lane & 31)) * 8;
        if (g == 0) ypool_item<2>(U, GP, Y, scale, c, t0); else if (g == 1) ypool_item<4>(U, GP, Y, scale, c, t0);
        else if (g == 2) ypool_item<8>(U, GP, Y, scale, c, t0); else ypool_item<16>(U, GP, Y, scale, c, t0);
    }
}
__device__ __forceinline__ void p3_compress2(const Frame& F, unsigned char* ws, int cwg, int NCWG) {
    const int tid = F.tid, lane = F.lane, r = lane & 31, hh = lane >> 5, wave = F.wave;
    const float* rcos = (const float*)(ws + WS_ROPE); const float* rsin = rcos + (size_t)S * 64;
    LAS bf16_t* hl = (LAS bf16_t*)F.lds;
    for (int it = cwg; it < 128; it += NCWG) {
        const int which = it >> 6, rt = it & 63;
        { const int row = tid >> 4, f0 = (tid & 15) * 16;
          const float* sl = (const float*)(ws + WS_SLAB) + ((size_t)(which * NSPLIT) * 2048 + rt * 32 + row) * 256 + f0; const float* b1 = (const float*)(ws + WS_B1) + which * 256 + f0;
          f32x4 s[4];
#pragma unroll
          for (int q = 0; q < 4; ++q) s[q] = *(const f32x4*)(b1 + 4 * q);
#pragma unroll
          for (int ks = 0; ks < NSPLIT; ++ks)
#pragma unroll
              for (int q = 0; q < 4; ++q) s[q] = s[q] + *(const f32x4*)(sl + (size_t)ks * 2048 * 256 + 4 * q);
#pragma unroll
          for (int q = 0; q < 4; ++q)
#pragma unroll
              for (int e = 0; e < 4; ++e) s[q][e] = siluf_(s[q][e]);
          *(LAS u32x4*)(hl + row * 264 + f0) = pack8(s[0], s[1]); *(LAS u32x4*)(hl + row * 264 + f0 + 8) = pack8(s[2], s[3]); }
        __syncthreads();
        if (wave < 4) {
            const int ct = wave, row = rt * 32 + r;
            const bf16_t* W2 = (const bf16_t*)(ws + (which ? WS_W2VT : WS_W2KT)) + (size_t)(ct * 32 + r) * 256 + hh * 8;
            f32x16 acc = f32x16{};
#pragma unroll 4
            for (int k = 0; k < 16; ++k) acc = __builtin_amdgcn_mfma_f32_32x32x16_bf16(*(const bf16x8*)(W2 + k * 16), *(const LAS bf16x8*)(hl + r * 264 + k * 16 + hh * 8), acc, 0, 0, 0);
            const int n = row & 511; bf16_t* dst = (bf16_t*)(ws + (which ? WS_VC : WS_KC)) + (size_t)row * 128 + ct * 32 + 4 * hh;
            const int pos = (16 * n + 31) > S - 1 ? S - 1 : 16 * n + 31;
#pragma unroll
            for (int gq = 0; gq < 4; ++gq) {
                float v0 = acc[4 * gq], v1 = acc[4 * gq + 1], v2 = acc[4 * gq + 2], v3 = acc[4 * gq + 3];
                if (which == 0) { const int i = (ct * 32 + 8 * gq + 4 * hh) >> 1; const float c0 = rcos[(size_t)pos * 64 + i], s0 = rsin[(size_t)pos * 64 + i], c1 = rcos[(size_t)pos * 64 + i + 1], s1 = rsin[(size_t)pos * 64 + i + 1];
                    const float o0 = v0 * c0 - v1 * s0, o1 = v1 * c0 + v0 * s0, o2 = v2 * c1 - v3 * s1, o3 = v3 * c1 + v2 * s1; v0 = o0; v1 = o1; v2 = o2; v3 = o3; }
                u32x2 w; w.x = cvtpk(v0, v1); w.y = cvtpk(v2, v3); if (n == 511) { w.x = 0u; w.y = 0u; }
                *(u32x2*)(dst + 8 * gq) = w;
            }
        }
        __syncthreads();
    }
}

namespace nsa {
constexpr int SHM_V = 16384, SHM_K = 16384;
constexpr int L_V = 0, L_K = 3 * SHM_V, L_WS = L_K + 2 * SHM_K, L_IMP = L_WS + NWAVES * 64 * 4, IMP_LD = 129, L_SELM = L_IMP + 64 * IMP_LD * 4, L_END = L_SELM + 64 * 8 * 2;
static_assert(L_END <= RING_BYTES, "attention LDS");
constexpr float SCALE = 0.08838834764831845f, C2 = 1.4426950408889634f * SCALE, THR = 8.f;
#define KSWZ(row, colB) ((row) * 256 + ((colB) ^ (((row) & 7) << 4)))
#define SBAR() __builtin_amdgcn_sched_barrier(0)
#define LADD(p, v) (void)__hip_atomic_fetch_add((p), (v), __ATOMIC_RELAXED, __HIP_MEMORY_SCOPE_WORKGROUP)
__device__ __forceinline__ int v_st(int k, int c) { const int kk = (k & ~0xC) | ((k & 4) << 1) | ((k & 8) >> 1); return ((kk >> 3) * 4 + (c >> 5)) * 512 + ((kk & 7) * 32 + (c & 31)) * 2; }
__device__ __forceinline__ int v_rd_base(int lane) { return ((lane & 3) << 3) | (((lane >> 2) & 3) << 6) | (((lane >> 4) & 1) << 5) | (((lane >> 5) & 1) << 8); }
constexpr int v_rd_off(int d0, int ks, int half) { return d0 * 512 + ks * 4096 + half * 2048; }
__device__ __forceinline__ unsigned cvtpk_a(float lo, float hi) { unsigned r; asm volatile("v_cvt_pk_bf16_f32 %0, %1, %2" : "=v"(r) : "v"(lo), "v"(hi)); return r; }

__device__ __forceinline__ void mask_range(f32x16& p0, f32x16& p1, int dq, unsigned Wn) {
    const float NEG = -__builtin_inff();
#pragma unroll
    for (int r = 0; r < 16; ++r) { const int c = (r & 3) + 8 * (r >> 2);
        if ((unsigned)(dq + c) >= Wn) p0[r] = NEG;
        if ((unsigned)(dq + c + 32) >= Wn) p1[r] = NEG; }
}
__device__ __forceinline__ void mask_row(f32x16& p0, f32x16& p1, bool keep) {
    const float NEG = -__builtin_inff();
#pragma unroll
    for (int r = 0; r < 16; ++r) { p0[r] = keep ? p0[r] : NEG; p1[r] = keep ? p1[r] : NEG; }
}
__device__ __forceinline__ float rowmax32(const f32x16& p0, const f32x16& p1) {
    float pmax = p0[0];
#pragma unroll
    for (int r = 1; r < 16; ++r) pmax = fmaxf(pmax, p0[r]);
#pragma unroll
    for (int r = 0; r < 16; ++r) pmax = fmaxf(pmax, p1[r]);
    auto rr = __builtin_amdgcn_permlane32_swap(__float_as_uint(pmax), __float_as_uint(pmax), false, false);
    return fmaxf(__uint_as_float(rr[0]), __uint_as_float(rr[1]));
}
__device__ __forceinline__ float rowsum32(const f32x16& p0, const f32x16& p1) {
    float ps = 0.f;
#pragma unroll
    for (int r = 0; r < 16; ++r) ps += p0[r];
#pragma unroll
    for (int r = 0; r < 16; ++r) ps += p1[r];
    auto rr = __builtin_amdgcn_permlane32_swap(__float_as_uint(ps), __float_as_uint(ps), false, false);
    return __uint_as_float(rr[0]) + __uint_as_float(rr[1]);
}
__device__ __forceinline__ void pack_p(const f32x16& p0, const f32x16& p1, bf16x8& pa0, bf16x8& pa1, bf16x8& pa2, bf16x8& pa3) {
#define PK4(P, B_, OUT) do { unsigned a0 = cvtpk_a(P[B_+0], P[B_+1]), a1 = cvtpk_a(P[B_+2], P[B_+3]);                          \
        unsigned b0 = cvtpk_a(P[B_+4], P[B_+5]), b1 = cvtpk_a(P[B_+6], P[B_+7]);                                             \
        auto r0 = __builtin_amdgcn_permlane32_swap(a0, b0, false, false); auto r1 = __builtin_amdgcn_permlane32_swap(a1, b1, false, false); \
        u32x4 w = {r0[0], r1[0], r0[1], r1[1]}; OUT = __builtin_bit_cast(bf16x8, w); } while (0)
    PK4(p0, 0, pa0); PK4(p0, 8, pa1); PK4(p1, 0, pa2); PK4(p1, 8, pa3);
#undef PK4
}
__device__ __forceinline__ void qkt(f32x16& p0, f32x16& p1, const LAS unsigned char* K_buf, int r32, int hi, const bf16x8* qr) {
    p0 = f32x16{}; p1 = f32x16{};
    const LAS unsigned char* kb[4];
#pragma unroll
    for (int dd = 0; dd < 4; ++dd) kb[dd] = K_buf + KSWZ(r32, (dd * 16 + hi * 8) * 2);
#pragma unroll
    for (int d0 = 0; d0 < 8; ++d0) { const LAS unsigned char* a = kb[d0 & 3] + (d0 >> 2) * 128;
        const bf16x8 b0 = *(const LAS bf16x8*)(a);
        const bf16x8 b1 = *(const LAS bf16x8*)(a + 32 * 256);
        p0 = __builtin_amdgcn_mfma_f32_32x32x16_bf16(b0, qr[d0], p0, 0, 0, 0);
        p1 = __builtin_amdgcn_mfma_f32_32x32x16_bf16(b1, qr[d0], p1, 0, 0, 0);
        if (d0 == 3) SBAR(); }
}
__device__ __forceinline__ void pv_tile(f32x16* o, int vb0, bf16x8 pa0, bf16x8 pa1, bf16x8 pa2, bf16x8 pa3) {
#define TRRD(dst, off) asm volatile("ds_read_b64_tr_b16 %0, %1 offset:%2" : "=&v"(dst) : "v"(vb0), "i"(off) : "memory")
#define PV_D0(d0) do { s16x4 l0, l1, l2, l3, h0, h1, h2, h3; constexpr int b_ = v_rd_off(d0, 0, 0); \
        TRRD(l0, b_); TRRD(h0, b_ + 2048); TRRD(l1, b_ + 4096); TRRD(h1, b_ + 6144); TRRD(l2, b_ + 8192); TRRD(h2, b_ + 10240); TRRD(l3, b_ + 12288); TRRD(h3, b_ + 14336); \
        asm volatile("s_waitcnt lgkmcnt(0)" ::: "memory"); SBAR();   \
        o[d0] = __builtin_amdgcn_mfma_f32_32x32x16_bf16(pa0, (bf16x8){l0[0], l0[1], l0[2], l0[3], h0[0], h0[1], h0[2], h0[3]}, o[d0], 0, 0, 0);   \
        o[d0] = __builtin_amdgcn_mfma_f32_32x32x16_bf16(pa1, (bf16x8){l1[0], l1[1], l1[2], l1[3], h1[0], h1[1], h1[2], h1[3]}, o[d0], 0, 0, 0);   \
        o[d0] = __builtin_amdgcn_mfma_f32_32x32x16_bf16(pa2, (bf16x8){l2[0], l2[1], l2[2], l2[3], h2[0], h2[1], h2[2], h2[3]}, o[d0], 0, 0, 0);   \
        o[d0] = __builtin_amdgcn_mfma_f32_32x32x16_bf16(pa3, (bf16x8){l3[0], l3[1], l3[2], l3[3], h3[0], h3[1], h3[2], h3[3]}, o[d0], 0, 0, 0); } while (0)
    PV_D0(0); PV_D0(1); PV_D0(2); PV_D0(3);
#undef PV_D0
#undef TRRD
}

enum { M_C1 = 0, M_C2 = 1, M_S = 2, M_W = 3 };
struct Stage { bf16x8 k0, k1, v0, v1; };
__device__ __forceinline__ void stage_load(Stage& sg, const bf16_t* Kp, const bf16_t* Vp, int ld, int j, bool hasv) {
    const int tid = otid(), sr = tid >> 4, sc = (tid & 15) * 8; const size_t k0_ = (size_t)j * 64;
    sg.k0 = *(const bf16x8*)(Kp + (k0_ + sr) * ld + sc); sg.k1 = *(const bf16x8*)(Kp + (k0_ + 32 + sr) * ld + sc);
    if (hasv) { sg.v0 = *(const bf16x8*)(Vp + (k0_ + sr) * ld + sc); sg.v1 = *(const bf16x8*)(Vp + (k0_ + 32 + sr) * ld + sc); }
}
struct RowState { float m, l; };
template <int MODE>
__device__ __forceinline__ void attn_pass(LAS unsigned char* lds, const bf16_t* Kp, const bf16_t* Vp, int ld, int j_lo, int j_hi, const bf16x8* qr, int t, int Tq, const u32x4 sel,
                                          RowState& st, float invl, f32x16* o, bool do_imp, Stage& sg) {
    constexpr bool HASV = MODE != M_C1;
    const int tid = otid(), wid = __builtin_amdgcn_readfirstlane(tid >> 6), lane = tid & 63, r32 = lane & 31, hi = lane >> 5;
    LAS unsigned char* V_lds = lds + L_V; LAS unsigned char* K_lds = lds + L_K;
    LAS float* wsf = (LAS float*)(lds + L_WS) + wid * 64; LAS float* al_l = wsf + 32;
    const int sr = tid >> 4, sc = (tid & 15) * 8, vst0 = v_st(sr, sc), vst1 = v_st(32 + sr, sc), kws = KSWZ(sr, sc * 2);
    const int vb0 = (int)(uintptr_t)V_lds + v_rd_base(lane);
    const int NT = j_hi - j_lo;
#define st_k0 sg.k0
#define st_k1 sg.k1
#define st_v0 sg.v0
#define st_v1 sg.v1
    float m_reg = st.m, l_reg = st.l;
#define SLOAD(j) do { const size_t k0_ = (size_t)(j) * 64; st_k0 = *(const bf16x8*)(Kp + (k0_ + sr) * ld + sc); st_k1 = *(const bf16x8*)(Kp + (k0_ + 32 + sr) * ld + sc); \
        if (HASV) { st_v0 = *(const bf16x8*)(Vp + (k0_ + sr) * ld + sc); st_v1 = *(const bf16x8*)(Vp + (k0_ + 32 + sr) * ld + sc); } } while (0)
#define SWRITE(kof, vof) do { *(LAS bf16x8*)(K_lds + (kof) + kws) = st_k0; *(LAS bf16x8*)(K_lds + (kof) + kws + 32 * 256) = st_k1; \
        if (HASV) { *(LAS bf16x8*)(V_lds + (vof) + vst0) = st_v0; *(LAS bf16x8*)(V_lds + (vof) + vst1) = st_v1; } } while (0)
    const bool late = HASV && wid >= 4;
    bf16x8 pa0, pa1, pa2, pa3;
    SWRITE(0, 0);
    __syncthreads();
    int kof = 0, vof = 0, vprev = 0;
    for (int idx = 0; idx < NT; ++idx) {
        const int j = j_lo + idx, kb = j * 64;
        if (idx + 1 < NT) SLOAD(j + 1);
        if (HASV && late && idx > 0) { SBAR(); pv_tile(o, vb0 + vprev, pa0, pa1, pa2, pa3); SBAR(); }
        f32x16 p0, p1; qkt(p0, p1, K_lds + kof, r32, hi, qr);
#if EXP_QKT2
        asm volatile("" : "+v"(p0), "+v"(p1)); SBAR(); qkt(p0, p1, K_lds + kof, r32, hi, qr);
#endif
        if (MODE == M_C1 || MODE == M_C2) { const int nmax1 = ((t - 31) >> 4) + 1; mask_range(p0, p1, kb + 4 * hi, (unsigned)(nmax1 > 0 ? nmax1 : 0)); }
        else if (MODE == M_S) { if (j == Tq) mask_range(p0, p1, kb + 4 * hi, (unsigned)(t + 1));
                                else { const unsigned w_ = (j >> 5) == 0 ? sel.x : (j >> 5) == 1 ? sel.y : (j >> 5) == 2 ? sel.z : sel.w; mask_row(p0, p1, ((w_ >> (j & 31)) & 1u) != 0u); } }
        else { if (j == Tq || j + 8 <= Tq) mask_range(p0, p1, kb + 4 * hi - (t - 511), 512u); }
        if (MODE == M_C1) { const float pmax = rowmax32(p0, p1); const float mn = fmaxf(m_reg, pmax); const float alpha = __builtin_amdgcn_exp2f((m_reg - mn) * C2); m_reg = mn;
            const float mnL = -mn * C2;
#pragma unroll
            for (int r = 0; r < 16; ++r) { p0[r] = __builtin_amdgcn_exp2f(fmaf(p0[r], C2, mnL)); p1[r] = __builtin_amdgcn_exp2f(fmaf(p1[r], C2, mnL)); }
            l_reg = l_reg * alpha + rowsum32(p0, p1); }
        else if (MODE == M_C2) { const float mnL = -m_reg * C2;
#pragma unroll
            for (int r = 0; r < 16; ++r) { p0[r] = __builtin_amdgcn_exp2f(fmaf(p0[r], C2, mnL)) * invl; p1[r] = __builtin_amdgcn_exp2f(fmaf(p1[r], C2, mnL)) * invl; }
            if (do_imp) { LAS unsigned* imp = (LAS unsigned*)(lds + L_IMP) + ((wid & 1) * 32 + r32) * IMP_LD + 16 * j + hi;
#pragma unroll
                for (int k = 0; k < 4; ++k) {
                    { const float e_ = p0[4 * k + 3], a_ = 2.f * (p0[4 * k] + p0[4 * k + 1] + p0[4 * k + 2]) + e_;
                      LADD(imp + 2 * k, (unsigned)(a_ * 67108864.f + 0.5f)); LADD(imp + 2 * k + 1, (unsigned)(e_ * 67108864.f + 0.5f)); }
                    { const float e_ = p1[4 * k + 3], a_ = 2.f * (p1[4 * k] + p1[4 * k + 1] + p1[4 * k + 2]) + e_;
                      LADD(imp + 8 + 2 * k, (unsigned)(a_ * 67108864.f + 0.5f)); LADD(imp + 8 + 2 * k + 1, (unsigned)(e_ * 67108864.f + 0.5f)); } } }
            pack_p(p0, p1, pa0, pa1, pa2, pa3); }
        else { const float pmax = rowmax32(p0, p1); float mn, alpha;
            if (__builtin_expect(__all((pmax - m_reg) * SCALE <= THR), 1)) { mn = m_reg; alpha = 1.f; }
            else { mn = fmaxf(m_reg, pmax); alpha = __builtin_amdgcn_exp2f((m_reg - mn) * C2); m_reg = mn; }
            const float mnL = -mn * C2;
#pragma unroll
            for (int r = 0; r < 16; ++r) { p0[r] = __builtin_amdgcn_exp2f(fmaf(p0[r], C2, mnL)); p1[r] = __builtin_amdgcn_exp2f(fmaf(p1[r], C2, mnL)); }
            l_reg = l_reg * alpha + rowsum32(p0, p1);
            pack_p(p0, p1, pa0, pa1, pa2, pa3);
            if (__any(alpha < 1.f)) { if (hi == 0) al_l[r32] = alpha; asm volatile("s_waitcnt lgkmcnt(0)" ::: "memory");
#pragma unroll
                for (int d_ = 0; d_ < 4; ++d_)
#pragma unroll
                    for (int r = 0; r < 16; ++r) o[d_][r] *= al_l[crow(r, hi)]; } }
        if (HASV && !late) { SBAR(); pv_tile(o, vb0 + vof, pa0, pa1, pa2, pa3); }
        const int kn = kof ^ SHM_K, vn = (vof == 2 * SHM_V) ? 0 : vof + SHM_V;
        if (idx + 1 < NT) { SWRITE(kn, vn); }
        __syncthreads();
        vprev = vof; kof = kn; vof = vn;
    }
    if (HASV) { if (late) { SBAR(); pv_tile(o, vb0 + vprev, pa0, pa1, pa2, pa3); } __syncthreads(); }
    st.m = m_reg; st.l = l_reg;
#undef SLOAD
#undef SWRITE
#undef st_k0
#undef st_k1
#undef st_v0
#undef st_v1
}

template <int MODE>
__device__ __forceinline__ void branch_out(LAS unsigned char* lds, const f32x16* o, float rowscale, bf16_t* onsa_w, const bf16_t* gn_w) {
    const int tid = otid(), wid = __builtin_amdgcn_readfirstlane(tid >> 6), lane = tid & 63, r32 = lane & 31, hi = lane >> 5;
    LAS float* li_l = (LAS float*)(lds + L_WS) + wid * 64;
    if (hi == 0) li_l[r32] = rowscale; asm volatile("s_waitcnt lgkmcnt(0)" ::: "memory");
    LAS unsigned* stg = (LAS unsigned*)(lds + wid * 8192);
#pragma unroll
    for (int r = 0; r < 16; ++r) { const int orow = crow(r, hi); const float sc = li_l[orow];
#pragma unroll
        for (int d0 = 0; d0 < 4; ++d0) { const float v = o[d0][r] * sc; const float vn = dpp_x1f(v);
            if ((r32 & 1) == 0) stg[orow * 64 + d0 * 16 + (r32 >> 1)] = cvtpk(v, vn); } }
    asm volatile("s_waitcnt lgkmcnt(0)" ::: "memory");
    u32x4 val[8], prev[8], gq[8];
#pragma unroll
    for (int i = 0; i < 8; ++i) val[i] = *(const LAS u32x4*)(stg + (i * 4 + (lane >> 4)) * 64 + (lane & 15) * 4);
    int rb = lane >> 4; asm volatile("" : "+v"(rb));
    bf16_t* gp_ = onsa_w + (size_t)rb * 2048 + (lane & 15) * 8; const bf16_t* gg_ = gn_w + (size_t)rb * 2048 + (lane & 15) * 8;
    if (MODE >= 1) {
#pragma unroll
        for (int i = 0; i < 8; ++i) prev[i] = *(const u32x4*)(gp_ + (size_t)i * 4 * 2048); }
    if (MODE == 2) {
#pragma unroll
        for (int i = 0; i < 8; ++i) gq[i] = *(const u32x4*)(gg_ + (size_t)i * 4 * 2048); }
#pragma unroll
    for (int i = 0; i < 8; ++i) { u32x4 w = val[i];
        if (MODE >= 1) { f32x4 a0, a1, b0, b1; unpack8(val[i], a0, a1); unpack8(prev[i], b0, b1); a0 = a0 + b0; a1 = a1 + b1;
            if (MODE == 2) { f32x4 g0, g1; unpack8(gq[i], g0, g1); a0 = a0 * g0; a1 = a1 * g1; }
            w = pack8(a0, a1); }
        *(u32x4*)(gp_ + (size_t)i * 4 * 2048) = w; }
    __syncthreads();
}

__device__ __forceinline__ void attn_unit(LAS unsigned char* lds, unsigned char* ws, int h, int Tq) {
    const int tid = otid(), wid = __builtin_amdgcn_readfirstlane(tid >> 6), lane = tid & 63, r32 = lane & 31, hi = lane >> 5;
    const int g = wid >> 1, tl = (wid & 1) * 32 + r32, t = Tq * 64 + tl, hq = 4 * h + g;
    const bf16_t* Q = (const bf16_t*)(ws + WS_Q); const bf16_t* GBR = (const bf16_t*)(ws + WS_GBR);
    bf16_t* onsa_w = (bf16_t*)(ws + WS_ONSA) + (size_t)(Tq * 64 + (wid & 1) * 32) * 2048 + hq * 128; const bf16_t* gn_w = (const bf16_t*)(ws + WS_GN) + (size_t)(Tq * 64 + (wid & 1) * 32) * 2048 + hq * 128;
    bf16x8 qr[8];
#pragma unroll
    for (int d0 = 0; d0 < 8; ++d0) qr[d0] = *(const bf16x8*)(Q + (size_t)t * 2048 + hq * 128 + d0 * 16 + hi * 8);
    const float g_c = bf2f(GBR[(size_t)t * 256 + hq * 3 + 0]), g_s = bf2f(GBR[(size_t)t * 256 + hq * 3 + 1]), g_w = bf2f(GBR[(size_t)t * 256 + hq * 3 + 2]);
    const bool big = Tq >= 16;
    LAS unsigned* IMP = (LAS unsigned*)(lds + L_IMP);
    if (big) { for (int i = tid; i < 64 * IMP_LD; i += 512) IMP[i] = 0u; }
    const u32x4 nosel = {0u, 0u, 0u, 0u};
    f32x16 o[4]; Stage sg;
    {
        const bf16_t* Kc = (const bf16_t*)(ws + WS_KC) + (size_t)h * 512 * 128; const bf16_t* Vc = (const bf16_t*)(ws + WS_VC) + (size_t)h * 512 * 128;
        const int ntc = ((4 * Tq + 2) >> 6) + 1;
        RowState stc{-1e30f, 0.f};
        stage_load(sg, Kc, Vc, 128, 0, false);
        attn_pass<M_C1>(lds, Kc, Vc, 128, 0, ntc, qr, t, Tq, nosel, stc, 0.f, o, false, sg);
        stage_load(sg, Kc, Vc, 128, 0, true);
        const float invl = stc.l > 0.f ? 1.0f / stc.l : 0.f;
#pragma unroll
        for (int d = 0; d < 4; ++d) o[d] = f32x16{};
        attn_pass<M_C2>(lds, Kc, Vc, 128, 0, ntc, qr, t, Tq, nosel, stc, invl, o, big, sg);
        stage_load(sg, (const bf16_t*)(ws + WS_KS) + h * 128, (const bf16_t*)(ws + WS_VS) + h * 128, 512, 0, true);
        branch_out<0>(lds, o, g_c, onsa_w, gn_w);
    }
    {
        LAS unsigned short* SELM = (LAS unsigned short*)(lds + L_SELM);
        int tok = tid >> 3, sub = tid & 7; asm volatile("" : "+v"(tok), "+v"(sub));
        unsigned bits = 0u;
        if (big) {
            unsigned kv[16];
#pragma unroll
            for (int e = 0; e < 16; ++e) { const int j = sub * 16 + e; const unsigned v = IMP[tok * IMP_LD + j]; kv[e] = (j >= 1 && j <= Tq - 2) ? v + 1u : 0u; }
            for (int round = 0; round < 13; ++round) {
                unsigned bv = kv[0]; int bj = 0;
#pragma unroll
                for (int e = 1; e < 16; ++e) { const bool gt = kv[e] > bv; bv = gt ? kv[e] : bv; bj = gt ? e : bj; }
                bj += sub * 16;
#pragma unroll
                for (int st_ = 0; st_ < 3; ++st_) { const unsigned ov = st_ == 0 ? dpp_x1(bv) : st_ == 1 ? dpp_x2(bv) : dpp_m8(bv); const int oj = (int)(st_ == 0 ? dpp_x1((unsigned)bj) : st_ == 1 ? dpp_x2((unsigned)bj) : dpp_m8((unsigned)bj));
                    const bool take = (ov > bv) || (ov == bv && oj < bj); bv = take ? ov : bv; bj = take ? oj : bj; }
                const int we = (bv != 0u && (bj >> 4) == sub) ? (bj & 15) : -1;
#pragma unroll
                for (int e = 0; e < 16; ++e) { const bool hit = (we == e); bits |= hit ? (1u << e) : 0u; kv[e] = hit ? 0u : kv[e]; }
            }
#pragma unroll
            for (int e = 0; e < 16; ++e) { const int j = sub * 16 + e; if (j == 0 || j == Tq - 1 || j == Tq) bits |= 1u << e; }
        } else {
#pragma unroll
            for (int e = 0; e < 16; ++e) { const int j = sub * 16 + e; if (j <= Tq) bits |= 1u << e; }
        }
        SELM[tok * 8 + sub] = (unsigned short)bits;
        __syncthreads();
    }
    const u32x4 sel = *(const LAS u32x4*)(lds + L_SELM + tl * 16);
    {
        RowState sts{-1e30f, 0.f};
#pragma unroll
        for (int d = 0; d < 4; ++d) o[d] = f32x16{};
        attn_pass<M_S>(lds, (const bf16_t*)(ws + WS_KS) + h * 128, (const bf16_t*)(ws + WS_VS) + h * 128, 512, 0, Tq + 1, qr, t, Tq, sel, sts, 0.f, o, false, sg);
        stage_load(sg, (const bf16_t*)(ws + WS_KW) + h * 128, (const bf16_t*)(ws + WS_VW) + h * 128, 512, Tq >= 8 ? Tq - 8 : 0, true);
        branch_out<1>(lds, o, sts.l > 0.f ? g_s / sts.l : 0.f, onsa_w, gn_w);
    }
    {
        RowState stw{-1e30f, 0.f};
#pragma unroll
        for (int d = 0; d < 4; ++d) o[d] = f32x16{};
        attn_pass<M_W>(lds, (const bf16_t*)(ws + WS_KW) + h * 128, (const bf16_t*)(ws + WS_VW) + h * 128, 512, Tq >= 8 ? Tq - 8 : 0, Tq + 1, qr, t, Tq, sel, stw, 0.f, o, false, sg);
        branch_out<2>(lds, o, stw.l > 0.f ? g_w / stw.l : 0.f, onsa_w, gn_w);
    }
}
#undef KSWZ
#undef SBAR
}

constexpr int NPHASE = 8;
__global__ void __launch_bounds__(NWAVES * 64, 2) mega_fwd(Args args) {
    extern __shared__ __attribute__((aligned(16))) unsigned char lds[];
    Frame F;
    F.lds = (LAS unsigned char*)lds;
    F.tid = threadIdx.x; F.lane = F.tid & 63; F.wave = __builtin_amdgcn_readfirstlane(F.tid >> 6);
    F.G = gridDim.x; { const int bx = blockIdx.x; F.vcu = (F.G % 8 == 0) ? (bx % 8) * (F.G / 8) + bx / 8 : bx; }
    volatile LAS unsigned* MISC = (volatile LAS unsigned*)(F.lds + MISC_OFF);
    unsigned char* ws = args.ws;
    for (int u = F.tid; u < (LDS_BYTES - LDSCTL_OFF) / 4; u += NWAVES * 64) ((LAS unsigned*)(F.lds + LDSCTL_OFF))[u] = 0u;
    __syncthreads();
    XcdBarrier bar; bar.bar = (unsigned*)(ws + WS_CTL) + CW_BAR; bar.x = 0; bar.st = nullptr;
#if !N_LAUNCHES_PER_PHASE
    bar = xcd_barrier_post((unsigned*)(ws + WS_CTL) + CW_BAR, MISC + 8);
#endif
    const int lo = args.ph_lo, hi = args.ph_hi;
#define IN(k) (lo <= (k) && (k) < hi && (F.tid = otid(), F.lane = F.tid & 63, true))
#define SEAM(k) do { if (IN(k) && IN((k) + 1)) xcd_barrier(bar); } while (0)
    bf16_t* const GM = (bf16_t*)args.out;

    for (int rep_ = 0; rep_ < (DUP_PHASE == 0 ? 2 : 1); ++rep_) if (IN(0)) { if (rep_) xcd_barrier(bar); p0_prologue(F, args); } SEAM(0);
    for (int rep_ = 0; rep_ < (DUP_PHASE == 1 ? 2 : 1); ++rep_) if (IN(1)) { if (rep_) xcd_barrier(bar);
        pg8::Gemm g{(const bf16_t*)(ws + WS_H), (const bf16_t*)(ws + WS_WCAT), 2048, 2048, 2048};
        pg8::StaticOrder So; So.init(S, NCAT, F.G, (int)blockIdx.x);
        EpiInProj E{ws, GM, args.in[14]};
        pg8::AddrAffine AD{(size_t)256 * 2048 * 2, (size_t)256 * 2048 * 2};
        pg8::gemm_phase<EpiInProj, true>(F.lds, g, So, E, AD);
        { const int nun = (So.nwg + F.G - 1) / F.G, full = So.nwg - (nun - 1) * F.G;
          const int base = full < F.G ? full : 0; if ((int)blockIdx.x >= base) p1_late_weights(F, args, ((int)blockIdx.x - base) * NWAVES + F.wave, (F.G - base) * NWAVES); }
    } SEAM(1);
    for (int rep_ = 0; rep_ < (DUP_PHASE == 2 ? 2 : 1); ++rep_) if (IN(2)) { if (rep_) xcd_barrier(bar);
        pg8::Gemm g{(const bf16_t*)(ws + WS_KCR), (const bf16_t*)(ws + WS_W1KT), 2048, 4096, 4096 / NSPLIT};
        pg8::StaticOrder So; So.init(16 * 256, NSPLIT * 256, F.G, (int)blockIdx.x);
        EpiSlab E{(float*)(ws + WS_SLAB)};
        pg8::AddrCmp AD{(4096 / NSPLIT) / 64};
        pg8::gemm_phase<EpiSlab, false>(F.lds, g, So, E, AD);
        { const int base = F.G > So.nwg ? So.nwg : 0; if ((int)blockIdx.x >= base) p2_ypool(F, ws, args.in[4], ((int)blockIdx.x - base) * NWAVES + F.wave, (F.G - base) * NWAVES); }
        if (blockIdx.x == F.G - 1) { const float* b1p = (const float*)(ws + WS_B1P); float* b1 = (float*)(ws + WS_B1); const int t = F.tid; float s = 0.f;
            for (int c = 0; c < 64; ++c) s += b1p[((t >> 8) * 64 + c) * 256 + (t & 255)];
            b1[t] = s; }
    } SEAM(2);
    for (int rep_ = 0; rep_ < (DUP_PHASE == 3 ? 2 : 1); ++rep_) if (IN(3)) { if (rep_) xcd_barrier(bar);
        p3_compress2(F, ws, (int)blockIdx.x, F.G);
    } SEAM(3);
    for (int rep_ = 0; rep_ < (DUP_PHASE == 5 ? 2 : 1); ++rep_) if (IN(5)) { if (rep_) xcd_barrier(bar);
        for (int p = F.vcu; p < 256; p += F.G) {
#pragma unroll 1
            for (int i = 0; i < 2; ++i) { const int h = p >> 6, x = p & 63; nsa::attn_unit(F.lds, ws, h, i ? x : 127 - x); } }
    } SEAM(5);
    for (int rep_ = 0; rep_ < (DUP_PHASE == 6 ? 2 : 1); ++rep_) if (IN(6)) { if (rep_) xcd_barrier(bar);
        pg8::Gemm ga{(const bf16_t*)(ws + WS_H + 16 * MiB), (const bf16_t*)(ws + WS_WPOT), 1024, 1024, 1024};
        pg8::Gemm gb{(const bf16_t*)(ws + WS_ONSA), (const bf16_t*)(ws + WS_WNOT), 2048, 2048, 2048};
        pg8::StaticOrder So; So.init(S, 2048, F.G, (int)blockIdx.x);
        EpiYaYb E{EpiYa{(bf16_t*)(ws + WS_YAG), GM}, EpiYb{(bf16_t*)(ws + WS_H), (const bf16_t*)(ws + WS_YAG), GM}};
        pg8::gemm_phase2<EpiYaYb>(F.lds, ga, gb, So, E);
    } SEAM(6);
    for (int rep_ = 0; rep_ < (DUP_PHASE == 7 ? 2 : 1); ++rep_) if (IN(7)) { if (rep_) xcd_barrier(bar);
        pg8::Gemm g{(const bf16_t*)(ws + WS_H), (const bf16_t*)(ws + WS_WOT), 2048, 2048, 2048}; pg8::AddrAffine AD{(size_t)256 * 2048 * 2, (size_t)256 * 2048 * 2};
        pg8::StaticOrder So; So.init(S, 2048, F.G, (int)blockIdx.x);
        EpiOut E{args.out, args.in[0], (float*)(ws + WS_SSQ), args.in[16], (unsigned*)(ws + WS_CTL), F.lds};
        pg8::gemm_phase<EpiOut, true>(F.lds, g, So, E, AD);
    }
#undef IN
#undef SEAM
}

extern "C" void kernel_launch(void* const* d_in, const int* in_sizes, int n_in, void* d_out, int out_size, void* d_ws, size_t ws_size, hipStream_t stream) {
    static int grid = 0;
    if (grid == 0) {
        if (n_in != 17 || in_sizes[0] != S * DM || out_size != S * DM || ws_size < WS_END) { fprintf(stderr, "kernel_launch: unexpected shapes (n_in %d, in0 %d, out %d, ws %zu); nothing launched\n", n_in, n_in > 0 ? in_sizes[0] : -1, out_size, ws_size); grid = -1; return; }
        int dev = 0, cus = 0;
        if (hipGetDevice(&dev) != hipSuccess || hipDeviceGetAttribute(&cus, hipDeviceAttributeMultiprocessorCount, dev) != hipSuccess) { fprintf(stderr, "kernel_launch: device query failed\n"); grid = -1; return; }
        if (hipFuncSetAttribute((const void*)mega_fwd, hipFuncAttributeMaxDynamicSharedMemorySize, LDS_BYTES) != hipSuccess) { fprintf(stderr, "kernel_launch: hipFuncSetAttribute failed\n"); grid = -1; return; }
        (void)hipGetLastError();
        grid = cus;
    }
    if (grid < 0) return;
    (void)hipMemsetAsync((char*)d_ws + WS_CTL, 0, CTL_BYTES, stream);
    Args a{};
    for (int i = 0; i < 17; ++i) a.in[i] = (const float*)d_in[i];
    a.out = (float*)d_out; a.ws = (unsigned char*)d_ws;
#if N_LAUNCHES_PER_PHASE
    for (int p = 0; p < NPHASE; ++p) { a.ph_lo = p; a.ph_hi = p + 1; hipLaunchKernelGGL(mega_fwd, dim3(grid), dim3(NWAVES * 64), LDS_BYTES, stream, a); }
#else
    a.ph_lo = 0; a.ph_hi = NPHASE;
    hipLaunchKernelGGL(mega_fwd, dim3(grid), dim3(NWAVES * 64), LDS_BYTES, stream, a);
#endif
}
```

```cpp
#include <hip/hip_runtime.h>
#include <cstdio>
#include <cstdint>

#define LAS __attribute__((address_space(3)))
#define GAS __attribute__((address_space(1)))
typedef unsigned short bf16_t;
typedef short bf16x8 __attribute__((ext_vector_type(8)));
typedef short s16x4 __attribute__((ext_vector_type(4)));
typedef float f32x4 __attribute__((ext_vector_type(4)));
typedef float f32x16 __attribute__((ext_vector_type(16)));
typedef unsigned u32x4 __attribute__((ext_vector_type(4)));
typedef unsigned u32x2 __attribute__((ext_vector_type(2)));
typedef float f32x2_t __attribute__((ext_vector_type(2)));
typedef __bf16 bf16x2_t __attribute__((ext_vector_type(2)));

#ifndef EXP_QKT2
#define EXP_QKT2 0
#endif
#ifndef DUP_PHASE
#define DUP_PHASE -1
#endif
#ifndef N_LAUNCHES_PER_PHASE
#define N_LAUNCHES_PER_PHASE 0
#endif

constexpr int S = 8192, DM = 2048, NCAT = 13568;
constexpr int HD = 128, NKV = 4, NCMP = 511;
constexpr float EPS = 1e-6f;

constexpr size_t MiB = 1u << 20;
constexpr size_t WS_CTL = 0, CTL_BYTES = 1 * MiB;
constexpr size_t WS_WCAT = 1 * MiB;
constexpr size_t WS_SLAB = WS_WCAT;
constexpr size_t WS_ONSA = WS_WCAT;
constexpr size_t WS_MIXT = 54 * MiB;
constexpr size_t WS_WPOT = 55 * MiB;
constexpr size_t WS_WNOT = 59 * MiB;
constexpr size_t WS_WOT  = 67 * MiB;
constexpr size_t WS_W1KT = 75 * MiB, WS_W1VT = 77 * MiB;
constexpr size_t WS_W2KT = 79 * MiB, WS_W2VT = 79 * MiB + 65536;
constexpr size_t WS_B1P  = 80 * MiB + 262144;
constexpr size_t WS_B1   = 79 * MiB + 131072 + 32768;
constexpr size_t WS_KC   = 79 * MiB + 262144, WS_VC = 79 * MiB + 786432;
constexpr size_t WS_ROPE = 81 * MiB;
constexpr size_t WS_SSQ  = 85 * MiB;
constexpr size_t WS_H    = 86 * MiB;
constexpr size_t WS_U    = 118 * MiB, WS_GP = 134 * MiB;
constexpr size_t WS_YAG  = WS_U;
constexpr size_t WS_Q    = 150 * MiB;
constexpr size_t WS_KCR  = 182 * MiB, WS_VCR = 190 * MiB, WS_KS = 198 * MiB, WS_VS = 206 * MiB, WS_KW = 214 * MiB, WS_VW = 222 * MiB;
constexpr size_t WS_GN   = 230 * MiB;
constexpr size_t WS_GBR  = 262 * MiB;
constexpr size_t WS_END  = 266 * MiB;
constexpr int CW_BAR = 4096;

constexpr int RING_BYTES = 131072;
constexpr int LDSCTL_OFF = RING_BYTES, MISC_OFF = LDSCTL_OFF + 320;
constexpr int LDS_BYTES = 147456;
constexpr int NWAVES = 8;

#define LDS_WAIT() asm volatile("s_waitcnt lgkmcnt(0)" ::: "memory")
#define VM_WAIT() asm volatile("s_waitcnt vmcnt(0)" ::: "memory")

__device__ __forceinline__ unsigned cvtpk(float lo, float hi) { f32x2_t v = {lo, hi}; bf16x2_t b = __builtin_convertvector(v, bf16x2_t); return __builtin_bit_cast(unsigned, b); }
__device__ __forceinline__ float bf2f(unsigned short h) { return __builtin_bit_cast(float, (unsigned)h << 16); }
__device__ __forceinline__ float bflo(unsigned w) { return __builtin_bit_cast(float, w << 16); }
__device__ __forceinline__ float bfhi(unsigned w) { return __builtin_bit_cast(float, w & 0xffff0000u); }
__device__ __forceinline__ float sigmoidf_(float x) { return __builtin_amdgcn_rcpf(1.0f + __expf(-x)); }
__device__ __forceinline__ float siluf_(float x) { return x * __builtin_amdgcn_rcpf(1.0f + __expf(-x)); }
__device__ __forceinline__ int otid() { int t = threadIdx.x; asm volatile("" : "+v"(t)); return t; }
__device__ __forceinline__ unsigned dpp_x1(unsigned v) { return __builtin_amdgcn_update_dpp(0u, v, 0xB1, 0xF, 0xF, false); }
__device__ __forceinline__ unsigned dpp_x2(unsigned v) { return __builtin_amdgcn_update_dpp(0u, v, 0x4E, 0xF, 0xF, false); }
__device__ __forceinline__ unsigned dpp_m8(unsigned v) { return __builtin_amdgcn_update_dpp(0u, v, 0x141, 0xF, 0xF, false); }
__device__ __forceinline__ float dpp_x1f(float v) { return __uint_as_float(dpp_x1(__float_as_uint(v))); }
__device__ __forceinline__ int crow(int r, int hi) { return (r & 3) + 8 * (r >> 2) + 4 * hi; }
__device__ __forceinline__ float wave_sum(float v) {
#pragma unroll
    for (int o = 1; o < 64; o <<= 1) v += __shfl_xor(v, o);
    return v;
}

#define XB_TMO      128
#define XB_XCNT(j)  (256  + 64 * (j))
#define XB_XSUB(j)  (1280 + 64 * (j))
#define XB_XGEN(j)  (2304 + 64 * (j))
#define XB_TOP      3328
#define XB_TOPGEN   3392
#define XCD_BAR_WORDS 3456
#define XB_SPIN_CAP (1u << 18)
__device__ __forceinline__ unsigned xb_ld(unsigned* p)              { return __hip_atomic_load(p, __ATOMIC_RELAXED, __HIP_MEMORY_SCOPE_AGENT); }
__device__ __forceinline__ unsigned xb_add(unsigned* p, unsigned v) { return __hip_atomic_fetch_add(p, v, __ATOMIC_RELAXED, __HIP_MEMORY_SCOPE_AGENT); }
__device__ __forceinline__ unsigned xb_xcc_id() { return (unsigned)__builtin_amdgcn_s_getreg((3 << 11) | 20) & 0xFu; }
#define XB_SPIN(cond, bar) do { unsigned _sp = 0; while (cond) { __builtin_amdgcn_s_sleep(1); \
    if ((++_sp & 255u) == 0u) { if (xb_ld(&(bar)[XB_TMO])) break; if (_sp > XB_SPIN_CAP) { atomicAdd(&(bar)[XB_TMO], 1u); break; } } } } while (0)
struct XcdBarrier { unsigned* bar; unsigned x; volatile LAS unsigned* st; };
__device__ __forceinline__ XcdBarrier xcd_barrier_post(unsigned* bar, volatile LAS unsigned* st) {
    XcdBarrier b; b.bar = bar; b.x = xb_xcc_id(); b.st = st;
    if (threadIdx.x == 0) (void)xb_add(&bar[XB_XCNT(b.x)], 1u);
    return b;
}
__device__ __forceinline__ void xcd_barrier_complete(unsigned* bar, unsigned x, unsigned& nloc, unsigned& nx) {
    const unsigned G = gridDim.x * gridDim.y * gridDim.z;
    unsigned sum, cnt, mine, sp = 0u;
    for (;;) {
        sum = 0u; cnt = 0u; mine = 0u;
#pragma unroll
        for (unsigned j = 0; j < 16; ++j) { const unsigned c = xb_ld(&bar[XB_XCNT(j)]); sum += c; cnt += (c > 0u) ? 1u : 0u; mine = (j == x) ? c : mine; }
        if (sum == G) break;
        __builtin_amdgcn_s_sleep(1);
        if ((++sp & 255u) == 0u) { if (xb_ld(&bar[XB_TMO])) break; if (sp > XB_SPIN_CAP) { atomicAdd(&bar[XB_TMO], 1u); break; } }
    }
    nloc = mine > 0u ? mine : 1u; nx = cnt > 0u ? cnt : 1u;
}
__device__ __forceinline__ void xcd_barrier(const XcdBarrier& b) {
    asm volatile("s_waitcnt vmcnt(0)" ::: "memory");
    __syncthreads();
    if (threadIdx.x == 0) {
        unsigned* bar = b.bar;
        __builtin_amdgcn_s_waitcnt(0);
        unsigned nloc = b.st[0], nx = b.st[1];
        if (nloc == 0u) { xcd_barrier_complete(bar, b.x, nloc, nx); b.st[0] = nloc; b.st[1] = nx; }
        const unsigned old = xb_add(&bar[XB_XSUB(b.x)], 1u);
        const unsigned gen = old / nloc;
        if (old + 1u == (gen + 1u) * nloc) {
            __builtin_amdgcn_fence(__ATOMIC_RELEASE, "agent");
            asm volatile("s_waitcnt vmcnt(0)" ::: "memory");
            const unsigned og = xb_add(&bar[XB_TOP], 1u);
            const unsigned tg = og / nx;
            if (og + 1u == (tg + 1u) * nx) xb_add(&bar[XB_TOPGEN], 1u);
            else XB_SPIN(xb_ld(&bar[XB_TOPGEN]) == tg, bar);
            __builtin_amdgcn_fence(__ATOMIC_ACQUIRE, "agent");
            xb_add(&bar[XB_XGEN(b.x)], 1u);
            asm volatile("s_waitcnt vmcnt(0)" ::: "memory");
        } else {
            XB_SPIN(xb_ld(&bar[XB_XGEN(b.x)]) == gen, bar);
            __builtin_amdgcn_fence(__ATOMIC_ACQUIRE, "agent");
            asm volatile("s_waitcnt vmcnt(0)" ::: "memory");
        }
    }
    __syncthreads();
}

namespace pg8 {
constexpr int BM = 256, BK = 64, HALF = 128, HTB = HALF * BK * 2, STAGE_BYTES = 8 * HTB, NXCD = 8, WGM = 8;
__host__ __device__ __forceinline__ int lds_byte(int r, int c) { const int st = (r >> 4) * 2 + (c >> 5), rr = r & 15, cc = c & 31, ob = rr * 64 + cc * 2; return st * 1024 + (ob ^ (((ob >> 9) & 1) << 5)); }
__host__ __device__ __forceinline__ void stage_rc(int b, int& R, int& C) { const int st = b / 1024, sb = b % 1024, swz = sb ^ (((sb >> 9) & 1) << 5); R = (st >> 1) * 16 + swz / 64; C = (st & 1) * 32 + (swz % 64) / 2; }
__host__ __device__ __forceinline__ int perm32(int rho) { const int n = rho >> 4, i = rho & 15; return 8 * (i >> 2) + 4 * n + (i & 3); }
struct Unit { int pm, pn; };
struct Gemm { const bf16_t* A; const bf16_t* Bt; int lda, ldb, K; };
struct AddrAffine { size_t tA, tB;
    __device__ __forceinline__ const char* A(const char* b, const Unit& u) const { return b + (size_t)u.pm * tA; }
    __device__ __forceinline__ const char* B(const char* b, const Unit& u) const { return b + (size_t)u.pn * tB; }
    __device__ __forceinline__ size_t ka(int t) const { return (size_t)t * (BK * 2); } };
struct AddrCmp { int ntile;
    __device__ __forceinline__ const char* A(const char* b, const Unit& u) const { return b + (size_t)(u.pm >> 3) * (8 * MiB) + (size_t)((u.pm >> 1) & 3) * (2 * MiB) + (size_t)(u.pm & 1) * (256 * 4096) + ka(u.pn * ntile); }
    __device__ __forceinline__ const char* B(const char* b, const Unit& u) const { return b + (size_t)(u.pm >> 3) * (2 * MiB) + (size_t)u.pn * ntile * (BK * 2); }
    __device__ __forceinline__ size_t ka(int t) const { return (size_t)t * (BK * 2); } };
struct StaticOrder {
    int nM, nN, nwg, G, c;
    __host__ __device__ void init(int M, int N, int G_, int c_) { nM = M / BM; nN = N / BM; nwg = nM * nN; G = G_; c = c_; }
    __host__ __device__ bool next(int i, Unit& u) const {
        const long L = (long)i * G + c; if (L >= nwg) return false;
        int wgid = (int)L; { const int q = nwg / NXCD, r = nwg % NXCD, xcd = wgid % NXCD, off = wgid / NXCD; wgid = (xcd < r ? xcd * (q + 1) : r * (q + 1) + (xcd - r) * q) + off; }
        const int nig = WGM * nN, gid = wgid / nig, fm = gid * WGM, gsz = (nM - fm) < WGM ? (nM - fm) : WGM;
        u.pm = fm + ((wgid % nig) % gsz); u.pn = (wgid % nig) / gsz; return true;
    }
};
template <class Epi, bool ALIGN_EPI, class Addr>
__device__ __forceinline__ void gemm_phase(LAS unsigned char* lds, const Gemm g, const StaticOrder& S, const Epi& E, const Addr& AD) {
    const int tid = otid(), wid = __builtin_amdgcn_readfirstlane(tid >> 6), lane = tid & 63, wr = wid >> 2, wc = wid & 3, fr = lane & 15, fq = lane >> 4;
    const int K = g.K, nt = K / BK;
    unsigned voffA[2], voffB[2];
#pragma unroll
    for (int i = 0; i < 2; ++i) { int R, C; stage_rc(tid * 16 + i * 8192, R, C); const int Rb = (R & ~31) + perm32(R & 31);
        voffA[i] = (unsigned)(R * g.lda + C) * 2u; voffB[i] = (unsigned)(Rb * g.ldb + C) * 2u; }
    const size_t kstep = (size_t)(BK * 2);
    const size_t hA = (size_t)HALF * g.lda * 2, hB = (size_t)HALF * g.ldb * 2;
    const unsigned ldsw = (unsigned)wid * 1024u;
    const int aoff = lds_byte(wr * 64 + fr, fq * 8), boff = lds_byte(wc * 32 + fr, fq * 8);
#define PG8_SA(b, h) (((b) * 2 + (h)) * HTB)
#define PG8_SB(b, h) ((4 + (b) * 2 + (h)) * HTB)
#define PG8_STAGE(bufoff, gbase, voff) do { _Pragma("unroll") for (int _i = 0; _i < 2; ++_i) \
        __builtin_amdgcn_global_load_lds((const unsigned*)((const char*)(gbase) + (voff)[_i]), (LAS unsigned*)(lds + (bufoff) + ldsw + _i * 8192), 16, 0, 0); } while (0)
#define PG8_LDA(dst, b, h) do { _Pragma("unroll") for (int m = 0; m < 4; ++m) _Pragma("unroll") for (int k = 0; k < 2; ++k) dst[m][k] = *(const LAS bf16x8*)(lds + PG8_SA(b, h) + aoff + m * 2048 + k * 1024); } while (0)
#define PG8_LDB(dst, b, h) do { _Pragma("unroll") for (int n = 0; n < 2; ++n) _Pragma("unroll") for (int k = 0; k < 2; ++k) dst[n][k] = *(const LAS bf16x8*)(lds + PG8_SB(b, h) + boff + n * 2048 + k * 1024); } while (0)
#define PG8_MMA(ai, bj, At, Bt) do { __builtin_amdgcn_s_setprio(1); _Pragma("unroll") for (int m = 0; m < 4; ++m) _Pragma("unroll") for (int n = 0; n < 2; ++n) _Pragma("unroll") for (int k = 0; k < 2; ++k) \
        acc[ai][bj][m][n] = __builtin_amdgcn_mfma_f32_16x16x32_bf16(Bt[n][k], At[m][k], acc[ai][bj][m][n], 0, 0, 0); __builtin_amdgcn_s_setprio(0); } while (0)
#define PG8_WAIT_V(n) asm volatile("s_waitcnt vmcnt(" #n ")" ::: "memory")
#define PG8_WAIT_L(n) asm volatile("s_waitcnt lgkmcnt(" #n ")" ::: "memory")
#define PG8_BAR __builtin_amdgcn_s_barrier()
#define PG8_SCHED __builtin_amdgcn_sched_barrier(0)
    Unit cur, nxt; int ui = 0;
    if (!S.next(0, cur)) return;
    f32x4 acc[2][2][4][2];
#pragma unroll
    for (int a = 0; a < 2; ++a)
#pragma unroll
        for (int b = 0; b < 2; ++b)
#pragma unroll
            for (int m = 0; m < 4; ++m)
#pragma unroll
                for (int n = 0; n < 2; ++n) acc[a][b][m][n] = (f32x4){0.f, 0.f, 0.f, 0.f};
    bf16x8 At[4][2], B0[2][2], B1[2][2];
    const char* cA = AD.A((const char*)g.A, cur); const char* cB = AD.B((const char*)g.Bt, cur);
    PG8_STAGE(PG8_SB(0, 0), cB, voffB); PG8_STAGE(PG8_SB(0, 1), cB + hB, voffB); PG8_STAGE(PG8_SA(0, 0), cA, voffA); PG8_STAGE(PG8_SA(0, 1), cA + hA, voffA);
    if (wr == 1) PG8_BAR;
    PG8_WAIT_V(2); PG8_BAR;
    PG8_STAGE(PG8_SB(1, 0), cB + kstep, voffB); PG8_STAGE(PG8_SA(1, 0), cA + kstep, voffA); PG8_STAGE(PG8_SB(1, 1), cB + hB + kstep, voffB);
    PG8_WAIT_V(6); PG8_BAR;
    for (;;) {
        const bool has_next = S.next(ui + 1, nxt);
        const char* nA = has_next ? AD.A((const char*)g.A, nxt) : cA; const char* nB = has_next ? AD.B((const char*)g.Bt, nxt) : cB;
        for (int t = 0; t < nt; t += 2) {
            const bool last = (t == nt - 2);
            const char* a1 = cA + AD.ka(t) + kstep;
            const char* a2 = last ? nA : cA + AD.ka(t + 2); const char* b2 = last ? nB : cB + (size_t)(t + 2) * kstep;
            const char* a3 = a2 + kstep; const char* b3 = b2 + kstep;
            PG8_LDB(B0, 0, 0); PG8_LDB(B1, 0, 1); PG8_SCHED; PG8_LDA(At, 0, 0); PG8_STAGE(PG8_SA(1, 1), a1 + hA, voffA);
            PG8_WAIT_V(8); PG8_WAIT_L(0); PG8_BAR; PG8_MMA(0, 0, At, B0); PG8_MMA(0, 1, At, B1); PG8_BAR; PG8_SCHED;
            PG8_LDA(At, 0, 1); PG8_STAGE(PG8_SB(0, 0), b2, voffB); PG8_STAGE(PG8_SB(0, 1), b2 + hB, voffB); PG8_STAGE(PG8_SA(0, 0), a2, voffA);
            PG8_WAIT_V(8); PG8_WAIT_L(0); PG8_BAR; PG8_MMA(1, 0, At, B0); PG8_MMA(1, 1, At, B1); PG8_BAR; PG8_SCHED;
            PG8_LDB(B0, 1, 0); PG8_LDB(B1, 1, 1); PG8_SCHED; PG8_LDA(At, 1, 0); PG8_STAGE(PG8_SA(0, 1), a2 + hA, voffA);
            PG8_WAIT_V(8); PG8_WAIT_L(0); PG8_BAR; PG8_MMA(0, 0, At, B0); PG8_MMA(0, 1, At, B1); PG8_BAR; PG8_SCHED;
            PG8_LDA(At, 1, 1); PG8_STAGE(PG8_SB(1, 0), b3, voffB); PG8_STAGE(PG8_SB(1, 1), b3 + hB, voffB); PG8_STAGE(PG8_SA(1, 0), a3, voffA);
            PG8_WAIT_V(8); PG8_WAIT_L(0); PG8_BAR; PG8_MMA(1, 0, At, B0); PG8_MMA(1, 1, At, B1); PG8_BAR; PG8_SCHED;
        }
        if constexpr (ALIGN_EPI) { if (wr == 0) PG8_BAR; }
        E(acc, cur, wr, wc, fr, fq);
        if (!has_next) break;
#pragma unroll
        for (int a = 0; a < 2; ++a)
#pragma unroll
            for (int b = 0; b < 2; ++b)
#pragma unroll
                for (int m = 0; m < 4; ++m)
#pragma unroll
                    for (int n = 0; n < 2; ++n) acc[a][b][m][n] = (f32x4){0.f, 0.f, 0.f, 0.f};
        cur = nxt; cA = nA; cB = nB; ++ui;
        if constexpr (ALIGN_EPI) { if (wr == 1) PG8_BAR; }
    }
    PG8_WAIT_V(0);
    if constexpr (!ALIGN_EPI) { if (wr == 0) PG8_BAR; }
    PG8_BAR;
#undef PG8_SA
#undef PG8_SB
#undef PG8_STAGE
#undef PG8_LDA
#undef PG8_LDB
#undef PG8_MMA
#undef PG8_WAIT_V
#undef PG8_WAIT_L
#undef PG8_BAR
#undef PG8_SCHED
}
template <class Epi>
__device__ __forceinline__ void gemm_phase2(LAS unsigned char* lds, const Gemm g0, const Gemm g1, const StaticOrder& S, const Epi& E) {
    const int tid = otid(), wid = __builtin_amdgcn_readfirstlane(tid >> 6), lane = tid & 63, wr = wid >> 2, wc = wid & 3, fr = lane & 15, fq = lane >> 4;
#define PG8_MKOFF(vA, vB, G) do { _Pragma("unroll") for (int i_ = 0; i_ < 2; ++i_) { int R_, C_; stage_rc(tid * 16 + i_ * 8192, R_, C_); const int Rb_ = (R_ & ~31) + perm32(R_ & 31); \
        (vA)[i_] = (unsigned)(R_ * (G).lda + C_) * 2u; (vB)[i_] = (unsigned)(Rb_ * (G).ldb + C_) * 2u; } } while (0)
    const size_t kstep = (size_t)(BK * 2);
    const size_t hA0 = (size_t)HALF * g0.lda * 2, hB0 = (size_t)HALF * g0.ldb * 2, hA1 = (size_t)HALF * g1.lda * 2, hB1 = (size_t)HALF * g1.ldb * 2;
    const unsigned ldsw = (unsigned)wid * 1024u;
    const int aoff = lds_byte(wr * 64 + fr, fq * 8), boff = lds_byte(wc * 32 + fr, fq * 8);
#define PG8_SA(b, h) (((b) * 2 + (h)) * HTB)
#define PG8_SB(b, h) ((4 + (b) * 2 + (h)) * HTB)
#define PG8_STAGE(bufoff, gbase, voff) do { _Pragma("unroll") for (int _i = 0; _i < 2; ++_i) \
        __builtin_amdgcn_global_load_lds((const unsigned*)((const char*)(gbase) + (voff)[_i]), (LAS unsigned*)(lds + (bufoff) + ldsw + _i * 8192), 16, 0, 0); } while (0)
#define PG8_LDA(dst, b, h) do { _Pragma("unroll") for (int m = 0; m < 4; ++m) _Pragma("unroll") for (int k = 0; k < 2; ++k) dst[m][k] = *(const LAS bf16x8*)(lds + PG8_SA(b, h) + aoff + m * 2048 + k * 1024); } while (0)
#define PG8_LDB(dst, b, h) do { _Pragma("unroll") for (int n = 0; n < 2; ++n) _Pragma("unroll") for (int k = 0; k < 2; ++k) dst[n][k] = *(const LAS bf16x8*)(lds + PG8_SB(b, h) + boff + n * 2048 + k * 1024); } while (0)
#define PG8_MMA(ai, bj, At, Bt) do { __builtin_amdgcn_s_setprio(1); _Pragma("unroll") for (int m = 0; m < 4; ++m) _Pragma("unroll") for (int n = 0; n < 2; ++n) _Pragma("unroll") for (int k = 0; k < 2; ++k) \
        acc[ai][bj][m][n] = __builtin_amdgcn_mfma_f32_16x16x32_bf16(Bt[n][k], At[m][k], acc[ai][bj][m][n], 0, 0, 0); __builtin_amdgcn_s_setprio(0); } while (0)
#define PG8_WAIT_V(n) asm volatile("s_waitcnt vmcnt(" #n ")" ::: "memory")
#define PG8_WAIT_L(n) asm volatile("s_waitcnt lgkmcnt(" #n ")" ::: "memory")
#define PG8_BAR __builtin_amdgcn_s_barrier()
#define PG8_SCHED __builtin_amdgcn_sched_barrier(0)
    Unit cur; int kind = 0;
    if (!S.next(0, cur)) return;
    f32x4 acc[2][2][4][2];
#pragma unroll
    for (int a = 0; a < 2; ++a)
#pragma unroll
        for (int b = 0; b < 2; ++b)
#pragma unroll
            for (int m = 0; m < 4; ++m)
#pragma unroll
                for (int n = 0; n < 2; ++n) acc[a][b][m][n] = (f32x4){0.f, 0.f, 0.f, 0.f};
    bf16x8 At[4][2], B0[2][2], B1[2][2];
    const char* cA = (const char*)g0.A + (size_t)cur.pm * (2 * hA0); const char* cB = (const char*)g0.Bt + (size_t)cur.pn * (2 * hB0);
    unsigned voffA[2], voffB[2]; PG8_MKOFF(voffA, voffB, g0); size_t hA = hA0, hB = hB0;
    PG8_STAGE(PG8_SB(0, 0), cB, voffB); PG8_STAGE(PG8_SB(0, 1), cB + hB, voffB); PG8_STAGE(PG8_SA(0, 0), cA, voffA); PG8_STAGE(PG8_SA(0, 1), cA + hA, voffA);
    if (wr == 1) PG8_BAR;
    PG8_WAIT_V(2); PG8_BAR;
    PG8_STAGE(PG8_SB(1, 0), cB + kstep, voffB); PG8_STAGE(PG8_SA(1, 0), cA + kstep, voffA); PG8_STAGE(PG8_SB(1, 1), cB + hB + kstep, voffB);
    PG8_WAIT_V(6); PG8_BAR;
    for (;;) {
        const bool has_next = kind == 0;
        const int nt = (kind == 0 ? g0.K : g1.K) / BK;
        const char* nA = has_next ? (const char*)g1.A + (size_t)cur.pm * (2 * hA1) : cA; const char* nB = has_next ? (const char*)g1.Bt + (size_t)cur.pn * (2 * hB1) : cB;
        for (int t = 0; t < nt; t += 2) {
            const bool last = (t == nt - 2);
            const char* a1 = cA + (size_t)(t + 1) * kstep;
            const char* a2 = last ? nA : cA + (size_t)(t + 2) * kstep; const char* b2 = last ? nB : cB + (size_t)(t + 2) * kstep;
            const char* a3 = a2 + kstep; const char* b3 = b2 + kstep;
            const bool sw = last && has_next;
            unsigned voffAn[2] = {voffA[0], voffA[1]}, voffBn[2] = {voffB[0], voffB[1]}; if (sw) PG8_MKOFF(voffAn, voffBn, g1);
            const size_t hAn = sw ? hA1 : hA, hBn = sw ? hB1 : hB;
            PG8_LDB(B0, 0, 0); PG8_LDB(B1, 0, 1); PG8_SCHED; PG8_LDA(At, 0, 0); PG8_STAGE(PG8_SA(1, 1), a1 + hA, voffA);
            PG8_WAIT_V(8); PG8_WAIT_L(0); PG8_BAR; PG8_MMA(0, 0, At, B0); PG8_MMA(0, 1, At, B1); PG8_BAR; PG8_SCHED;
            PG8_LDA(At, 0, 1); PG8_STAGE(PG8_SB(0, 0), b2, voffBn); PG8_STAGE(PG8_SB(0, 1), b2 + hBn, voffBn); PG8_STAGE(PG8_SA(0, 0), a2, voffAn);
            PG8_WAIT_V(8); PG8_WAIT_L(0); PG8_BAR; PG8_MMA(1, 0, At, B0); PG8_MMA(1, 1, At, B1); PG8_BAR; PG8_SCHED;
            PG8_LDB(B0, 1, 0); PG8_LDB(B1, 1, 1); PG8_SCHED; PG8_LDA(At, 1, 0); PG8_STAGE(PG8_SA(0, 1), a2 + hAn, voffAn);
            PG8_WAIT_V(8); PG8_WAIT_L(0); PG8_BAR; PG8_MMA(0, 0, At, B0); PG8_MMA(0, 1, At, B1); PG8_BAR; PG8_SCHED;
            PG8_LDA(At, 1, 1); PG8_STAGE(PG8_SB(1, 0), b3, voffBn); PG8_STAGE(PG8_SB(1, 1), b3 + hBn, voffBn); PG8_STAGE(PG8_SA(1, 0), a3, voffAn);
            PG8_WAIT_V(8); PG8_WAIT_L(0); PG8_BAR; PG8_MMA(1, 0, At, B0); PG8_MMA(1, 1, At, B1); PG8_BAR; PG8_SCHED;
        }
        if (wr == 0) PG8_BAR;
        E(acc, cur, kind, wr, wc, fr, fq);
        if (!has_next) break;
#pragma unroll
        for (int a = 0; a < 2; ++a)
#pragma unroll
            for (int b = 0; b < 2; ++b)
#pragma unroll
                for (int m = 0; m < 4; ++m)
#pragma unroll
                    for (int n = 0; n < 2; ++n) acc[a][b][m][n] = (f32x4){0.f, 0.f, 0.f, 0.f};
        cA = nA; cB = nB; kind = 1; PG8_MKOFF(voffA, voffB, g1); hA = hA1; hB = hB1;
        if (wr == 1) PG8_BAR;
    }
    PG8_WAIT_V(0);
    PG8_BAR;
#undef PG8_SA
#undef PG8_SB
#undef PG8_STAGE
#undef PG8_LDA
#undef PG8_LDB
#undef PG8_MMA
#undef PG8_WAIT_V
#undef PG8_WAIT_L
#undef PG8_BAR
#undef PG8_SCHED
#undef PG8_MKOFF
}
}

typedef f32x4 Acc[2][2][4][2];
__device__ __forceinline__ u32x4 pack8(f32x4 a, f32x4 b) { u32x4 w; w.x = cvtpk(a[0], a[1]); w.y = cvtpk(a[2], a[3]); w.z = cvtpk(b[0], b[1]); w.w = cvtpk(b[2], b[3]); return w; }
__device__ __forceinline__ void unpack8(u32x4 w, f32x4& a, f32x4& b) { a = (f32x4){bflo(w.x), bfhi(w.x), bflo(w.y), bfhi(w.y)}; b = (f32x4){bflo(w.z), bfhi(w.z), bflo(w.w), bfhi(w.w)}; }

struct EpiInProj {
    unsigned char* ws; bf16_t* gm; const float* bmerge;
    __device__ __forceinline__ void operator()(const Acc& acc, const pg8::Unit& u, int wr, int wc, int fr, int fq) const {
        const int pn = u.pn;
        bf16_t* dst; int ldc, cb, mode; size_t bjs = 128;
        if (pn < 4)       { dst = (bf16_t*)(ws + WS_U);   ldc = 1024; cb = pn * 256;        mode = 0; }
        else if (pn < 8)  { dst = (bf16_t*)(ws + WS_GP);  ldc = 1024; cb = (pn - 4) * 256;  mode = 1; }
        else if (pn < 16) { dst = (bf16_t*)(ws + WS_Q);   ldc = 2048; cb = (pn - 8) * 256;  mode = 3; }
        else if (pn < 28) { const int k = (pn - 16) >> 1; dst = (bf16_t*)(ws + WS_KCR + (size_t)k * (8 * MiB)); ldc = 512; cb = ((pn - 16) & 1) * 256; mode = (k == 2 || k == 4) ? 3 : 0;
                            if (k < 2) { ldc = 128; cb = 0; bjs = (size_t)S * 128; dst += (size_t)((pn - 16) & 1) * 2 * S * 128; } }
        else if (pn < 36) { dst = (bf16_t*)(ws + WS_GN);  ldc = 2048; cb = (pn - 28) * 256; mode = 1; }
        else if (pn < 52) { dst = gm;                     ldc = 4096; cb = (pn - 36) * 256; mode = 2; }
        else              { dst = (bf16_t*)(ws + WS_GBR); ldc = 256;  cb = 0;               mode = 4; }
        const int row0 = u.pm * 256 + wr * 64 + fr, cl = wc * 32 + 8 * fq, col0 = cb + cl;
        const float* rcos = (const float*)(ws + WS_ROPE); const float* rsin = rcos + (size_t)S * 64;
#pragma unroll
        for (int ai = 0; ai < 2; ++ai)
#pragma unroll
            for (int m = 0; m < 4; ++m) {
                const int row = row0 + ai * 128 + m * 16;
                bf16_t* rowp = dst + (size_t)row * ldc + col0;
                f32x4 cs0, cs1, sn0, sn1;
                if (mode == 3) { const int i0 = (cl & 127) >> 1; cs0 = *(const f32x4*)(rcos + (size_t)row * 64 + i0); sn0 = *(const f32x4*)(rsin + (size_t)row * 64 + i0); }
#pragma unroll
                for (int bj = 0; bj < 2; ++bj) {
                    f32x4 v0 = acc[ai][bj][m][0], v1 = acc[ai][bj][m][1];
                    if (mode == 1) { for (int e = 0; e < 4; ++e) { v0[e] = siluf_(v0[e]); v1[e] = siluf_(v1[e]); } }
                    else if (mode == 2 || mode == 4) { if (mode == 2) { v0 = v0 + *(const f32x4*)(bmerge + col0 + bj * 128); v1 = v1 + *(const f32x4*)(bmerge + col0 + bj * 128 + 4); } for (int e = 0; e < 4; ++e) { v0[e] = sigmoidf_(v0[e]); v1[e] = sigmoidf_(v1[e]); } }
                    else if (mode == 3) {
                        f32x4 o0, o1;
                        o0[0] = v0[0] * cs0[0] - v0[1] * sn0[0]; o0[1] = v0[1] * cs0[0] + v0[0] * sn0[0];
                        o0[2] = v0[2] * cs0[1] - v0[3] * sn0[1]; o0[3] = v0[3] * cs0[1] + v0[2] * sn0[1];
                        o1[0] = v1[0] * cs0[2] - v1[1] * sn0[2]; o1[1] = v1[1] * cs0[2] + v1[0] * sn0[2];
                        o1[2] = v1[2] * cs0[3] - v1[3] * sn0[3]; o1[3] = v1[3] * cs0[3] + v1[2] * sn0[3];
                        v0 = o0; v1 = o1;
                    }
                    *(u32x4*)(rowp + bj * bjs) = pack8(v0, v1);
                }
            }
    }
};
struct EpiYa {
    bf16_t* yag; const bf16_t* gm;
    __device__ __forceinline__ void operator()(const Acc& acc, const pg8::Unit& u, int wr, int wc, int fr, int fq) const {
        const int row0 = u.pm * 256 + wr * 64 + fr, col0 = u.pn * 256 + wc * 32 + 8 * fq;
#pragma unroll
        for (int ai = 0; ai < 2; ++ai)
#pragma unroll
            for (int m = 0; m < 4; ++m) { int ro_ = ai * 128 + m * 16; asm volatile("" : "+v"(ro_)); const size_t r = (size_t)(row0 + ro_);
#pragma unroll
                for (int bj = 0; bj < 2; ++bj) { f32x4 g0, g1; unpack8(*(const u32x4*)(gm + r * 4096 + col0 + bj * 128), g0, g1);
                    *(u32x4*)(yag + r * 2048 + col0 + bj * 128) = pack8(acc[ai][bj][m][0] * g0, acc[ai][bj][m][1] * g1); } }
    }
};
struct EpiYb {
    bf16_t* merged; const bf16_t* yag; const bf16_t* gm;
    __device__ __forceinline__ void operator()(const Acc& acc, const pg8::Unit& u, int wr, int wc, int fr, int fq) const {
        const int row0 = u.pm * 256 + wr * 64 + fr, col0 = u.pn * 256 + wc * 32 + 8 * fq;
#pragma unroll
        for (int ai = 0; ai < 2; ++ai)
#pragma unroll
            for (int m = 0; m < 4; ++m) { int ro_ = ai * 128 + m * 16; asm volatile("" : "+v"(ro_)); const size_t r = (size_t)(row0 + ro_);
#pragma unroll
                for (int bj = 0; bj < 2; ++bj) { f32x4 g0, g1, y0, y1; unpack8(*(const u32x4*)(gm + r * 4096 + 2048 + col0 + bj * 128), g0, g1);
                    unpack8(*(const u32x4*)(yag + r * 2048 + col0 + bj * 128), y0, y1);
                    *(u32x4*)(merged + r * 2048 + col0 + bj * 128) = pack8(y0 + acc[ai][bj][m][0] * g0, y1 + acc[ai][bj][m][1] * g1); } }
    }
};
struct EpiYaYb {
    EpiYa ya; EpiYb yb;
    __device__ __forceinline__ void operator()(const Acc& acc, const pg8::Unit& u, int kind, int wr, int wc, int fr, int fq) const {
        if (kind == 0) { ya(acc, u, wr, wc, fr, fq); asm volatile("s_waitcnt vmcnt(0)" ::: "memory"); } else yb(acc, u, wr, wc, fr, fq);
    }
};
constexpr int NSPLIT = 8;
struct EpiSlab {
    float* slab;
    __device__ __forceinline__ void operator()(const Acc& acc, const pg8::Unit& u, int wr, int wc, int fr, int fq) const {
        float* base = slab + ((size_t)((u.pm >> 3) * NSPLIT + u.pn) * 2048 + (size_t)(u.pm & 7) * 256 + wr * 64 + fr) * 256 + wc * 32 + 8 * fq;
#pragma unroll
        for (int ai = 0; ai < 2; ++ai)
#pragma unroll
            for (int m = 0; m < 4; ++m)
#pragma unroll
                for (int bj = 0; bj < 2; ++bj) { float* p = base + (size_t)(ai * 128 + m * 16) * 256 + bj * 128; *(f32x4*)p = acc[ai][bj][m][0]; *(f32x4*)(p + 4) = acc[ai][bj][m][1]; }
    }
};
constexpr int CW_PANEL = 16384;
constexpr int EPI_LDS_OFF = RING_BYTES + 1024;
struct EpiOut {
    float* out; const float* x; float* ssq; const float* fw; unsigned* ctl; LAS unsigned char* lds;
    __device__ __forceinline__ void operator()(const Acc& acc_, const pg8::Unit& u, int wr, int wc, int fr, int fq) const {
        Acc& acc = const_cast<Acc&>(acc_);
        const int tid = otid();
        const int row0 = u.pm * 256 + wr * 64 + fr, col0 = u.pn * 256 + wc * 32 + 8 * fq;
        LAS float* rs = (LAS float*)(lds + EPI_LDS_OFF);
#pragma unroll
        for (int ai = 0; ai < 2; ++ai)
#pragma unroll
            for (int m = 0; m < 4; ++m) { const size_t r = (size_t)(row0 + ai * 128 + m * 16); float q = 0.f;
#pragma unroll
                for (int bj = 0; bj < 2; ++bj)
#pragma unroll
                    for (int n = 0; n < 2; ++n) { const size_t o = r * 2048 + col0 + bj * 128 + 4 * n; const f32x4 v = *(const f32x4*)(x + o) + acc[ai][bj][m][n];
                        acc[ai][bj][m][n] = v; q += (v[0] * v[0] + v[1] * v[1]) + (v[2] * v[2] + v[3] * v[3]); }
                q += __shfl_xor(q, 16); q += __shfl_xor(q, 32);
                if (fq == 0) __hip_atomic_store((unsigned*)(ssq + (size_t)(u.pn * 4 + wc) * S + r), __float_as_uint(q), __ATOMIC_RELAXED, __HIP_MEMORY_SCOPE_AGENT); }
        asm volatile("s_waitcnt vmcnt(0)" ::: "memory");
        __syncthreads();
        if (tid == 0) { unsigned* c = ctl + CW_PANEL + 64 * u.pm;
            __hip_atomic_fetch_add(c, 1u, __ATOMIC_RELAXED, __HIP_MEMORY_SCOPE_AGENT);
            unsigned sp = 0; while (__hip_atomic_load(c, __ATOMIC_RELAXED, __HIP_MEMORY_SCOPE_AGENT) < 8u) { __builtin_amdgcn_s_sleep(2); if (++sp > (1u << 22)) break; }
            __builtin_amdgcn_fence(__ATOMIC_ACQUIRE, "agent"); asm volatile("s_waitcnt vmcnt(0)" ::: "memory"); }
        __syncthreads();
        if (tid < 256) { const size_t r = (size_t)u.pm * 256 + tid; float s = 0.f;
#pragma unroll 8
            for (int p = 0; p < 32; ++p) s += __uint_as_float(__hip_atomic_load((unsigned*)(ssq + (size_t)p * S + r), __ATOMIC_RELAXED, __HIP_MEMORY_SCOPE_AGENT));
            rs[tid] = 1.0f / sqrtf(s * (1.f / DM) + EPS); }
        __syncthreads();
#pragma unroll
        for (int ai = 0; ai < 2; ++ai)
#pragma unroll
            for (int m = 0; m < 4; ++m) { const int rl = wr * 64 + fr + ai * 128 + m * 16; const float sc = rs[rl]; const size_t r = (size_t)u.pm * 256 + rl;
#pragma unroll
                for (int bj = 0; bj < 2; ++bj)
#pragma unroll
                    for (int n = 0; n < 2; ++n) { const size_t o = r * 2048 + col0 + bj * 128 + 4 * n; *(f32x4*)(out + o) = acc[ai][bj][m][n] * sc * *(const f32x4*)(fw + col0 + bj * 128 + 4 * n); } }
    }
};

struct Args { const float* in[17]; float* out; unsigned char* ws; int ph_lo, ph_hi; };
struct Frame { LAS unsigned char* lds; int tid, lane, wave, vcu, G; };

__device__ __forceinline__ int ropeperm(int d) { return d < 64 ? 2 * d : 2 * (d - 64) + 1; }
__device__ __forceinline__ void transpose_item(const float* W, int ldw, int Nvalid, bf16_t* WT, int ldt, int row_off, bool perm, LAS float* scr, int kb, int nb, int lane) {
    const int k0 = 64 * kb, n0 = 32 * nb, cq = lane & 7, rb = lane >> 3; const bool ok = n0 + cq * 4 < Nvalid;
    f32x4 v[8];
#pragma unroll
    for (int i = 0; i < 8; ++i) v[i] = ok ? *(const f32x4*)(W + (size_t)(k0 + i * 8 + rb) * ldw + n0 + cq * 4) : (f32x4){0.f, 0.f, 0.f, 0.f};
#pragma unroll
    for (int i = 0; i < 8; ++i) *(LAS f32x4*)(scr + (i * 8 + rb) * 32 + ((cq ^ i) << 2)) = v[i];
    LDS_WAIT(); asm volatile("" ::: "memory");
#pragma unroll
    for (int j = 0; j < 4; ++j) { const int idx = lane + 64 * j, n = idx >> 3, c = idx & 7; const LAS float* s = scr + (8 * c) * 32 + ((((n >> 2) ^ c) << 2) | (n & 3));
        u32x4 o; o.x = cvtpk(s[0 * 32], s[1 * 32]); o.y = cvtpk(s[2 * 32], s[3 * 32]); o.z = cvtpk(s[4 * 32], s[5 * 32]); o.w = cvtpk(s[6 * 32], s[7 * 32]);
        const int ng = n0 + n;
        if (ng < Nvalid) { const int dr = perm ? ((ng & ~127) | ropeperm(ng & 127)) : ng; *(GAS u32x4*)(WT + (size_t)(row_off + dr) * ldt + k0 + 8 * c) = o; } }
    LDS_WAIT(); asm volatile("" ::: "memory");
}

__device__ __forceinline__ void p0_prologue(const Frame& F, const Args& a) {
    unsigned char* ws = a.ws;
    LAS float* scr = (LAS float*)(F.lds + F.wave * 8192);
    const int gw = F.vcu * NWAVES + F.wave, NGW = F.G * NWAVES, lane = F.lane;
    constexpr int I_WIN = 32 * 258, I_WM = 32 * 128;
    for (int it = gw; it < I_WIN + I_WM; it += NGW) {
        int r = it;
        if (r < I_WIN) { const int kb = r / 258, nb = 32 + r % 258, n0 = nb * 32;
            const bool perm = (n0 >= 2048 && n0 < 4096) || (n0 >= 5120 && n0 < 5632) || (n0 >= 6144 && n0 < 6656);
            transpose_item(a.in[2], 9264, 9264, (bf16_t*)(ws + WS_WCAT), 2048, nb >= 288 ? 4096 : 0, perm, scr, kb, nb, lane); continue; } r -= I_WIN;
        transpose_item(a.in[13], 4096, 4096, (bf16_t*)(ws + WS_WCAT), 2048, 9216, false, scr, r / 128, r % 128, lane);
    }
    {
        const float* win = a.in[2]; const float* mix = a.in[3]; bf16_t* WC = (bf16_t*)(ws + WS_WCAT); const int r = lane & 31, hh = lane >> 5;
        for (int it = gw; it < 1024; it += NGW) {
            const int g = it >> 8, d0 = ((it >> 5) & 7) * 32, kin0 = (it & 31) * 64;
            f32x16 acc0 = f32x16{}, acc1 = f32x16{};
            const float* ap = mix + (size_t)g * 65536 + (size_t)(8 * hh) * 256 + d0 + r;
            const float* bp0 = win + (size_t)(kin0 + r) * 9264 + g * 256 + 8 * hh; const float* bp1 = bp0 + (size_t)32 * 9264;
#pragma unroll 4
            for (int k = 0; k < 16; ++k) {
                f32x4 a0, a1;
#pragma unroll
                for (int j = 0; j < 4; ++j) { a0[j] = ap[(size_t)(k * 16 + j) * 256]; a1[j] = ap[(size_t)(k * 16 + 4 + j) * 256]; }
                const u32x4 af = pack8(a0, a1), b0 = pack8(*(const f32x4*)(bp0 + k * 16), *(const f32x4*)(bp0 + k * 16 + 4)), b1 = pack8(*(const f32x4*)(bp1 + k * 16), *(const f32x4*)(bp1 + k * 16 + 4));
                acc0 = __builtin_amdgcn_mfma_f32_32x32x16_bf16(__builtin_bit_cast(bf16x8, af), __builtin_bit_cast(bf16x8, b0), acc0, 0, 0, 0);
                acc1 = __builtin_amdgcn_mfma_f32_32x32x16_bf16(__builtin_bit_cast(bf16x8, af), __builtin_bit_cast(bf16x8, b1), acc1, 0, 0, 0);
            }
#pragma unroll
            for (int e = 0; e < 16; ++e) { int ee = e; asm volatile("" : "+v"(ee)); bf16_t* rowp = WC + (size_t)(g * 256 + d0 + crow(ee, hh)) * 2048 + kin0 + r;
                const float v0 = acc0[e], v1 = acc1[e], n0_ = dpp_x1f(v0), n1_ = dpp_x1f(v1);
                if ((r & 1) == 0) { *(unsigned*)rowp = cvtpk(v0, n0_); *(unsigned*)(rowp + 32) = cvtpk(v1, n1_); } }
        }
    }
    for (int i = gw * 64 + lane; i < 53248; i += NGW * 64) *(GAS u32x4*)(ws + WS_WCAT + (size_t)13360 * 4096 + (size_t)i * 16) = (u32x4){0u, 0u, 0u, 0u};
    {
        const float* x = a.in[0]; const float* nw = a.in[1]; bf16_t* H = (bf16_t*)(ws + WS_H);
        f32x4 wv[8];
#pragma unroll
        for (int j = 0; j < 8; ++j) wv[j] = *((const f32x4*)nw + lane + 64 * j);
        for (int m = gw; m < S; m += NGW) {
            const f32x4* xr = (const f32x4*)(x + (size_t)m * DM) + lane; f32x4 v[8]; float s = 0.f;
#pragma unroll
            for (int j = 0; j < 8; ++j) { v[j] = xr[64 * j]; s += (v[j][0] * v[j][0] + v[j][1] * v[j][1]) + (v[j][2] * v[j][2] + v[j][3] * v[j][3]); }
            const float rstd = 1.0f / sqrtf(wave_sum(s) * (1.f / DM) + EPS);
            u32x2* o = (u32x2*)(H + (size_t)m * DM) + lane;
#pragma unroll
            for (int j = 0; j < 8; ++j) { const f32x4 y = v[j] * rstd * wv[j]; u32x2 w; w.x = cvtpk(y[0], y[1]); w.y = cvtpk(y[2], y[3]); o[64 * j] = w; }
        }
    }
    {
        float* rcos = (float*)(ws + WS_ROPE); float* rsin = rcos + (size_t)S * 64;
        for (int e = gw * 64 + lane; e < S * 64; e += NGW * 64) {
            const int pos = e >> 6, i = e & 63;
            double inv = 1.0, b = 0.86596432336006535;
            for (int k = i; k; k >>= 1) { if (k & 1) inv *= b; b *= b; }
            const double t = (double)pos * inv * 0.15915494309189535;
            const float fr = (float)(t - floor(t));
            rcos[e] = __builtin_amdgcn_cosf(fr); rsin[e] = __builtin_amdgcn_sinf(fr);
        }
    }
}
__device__ __forceinline__ void p1_late_weights(const Frame& F, const Args& a, int cw, int NCW) {
    unsigned char* ws = a.ws;
    LAS float* scr = (LAS float*)(F.lds + F.wave * 8192);
    const int lane = F.lane;
    constexpr int I_NO = 32 * 64, I_O = 32 * 64, I_PO = 16 * 64, I_W1 = 64 * 8, I_W2 = 4 * 4, I_B1 = 512;
    constexpr int NITEMS = I_NO + I_O + I_PO + 2 * I_W1 + 2 * I_W2 + I_B1;
    for (int it = cw; it < NITEMS; it += NCW) {
        int r = it;
        if (r < I_W1) { transpose_item(a.in[6], 256, 256, (bf16_t*)(ws + WS_W1KT), 4096, 0, false, scr, r / 8, r % 8, lane); continue; } r -= I_W1;
        if (r < I_W1) { transpose_item(a.in[9], 256, 256, (bf16_t*)(ws + WS_W1VT), 4096, 0, false, scr, r / 8, r % 8, lane); continue; } r -= I_W1;
        if (r < I_B1) {
            const int which = r >> 8, fb = (r >> 6) & 3, ch = r & 63, f = fb * 64 + lane;
            const float* pe = a.in[which ? 8 : 5]; const float* w1 = a.in[which ? 9 : 6]; float s = 0.f;
#pragma unroll 16
            for (int k = ch * 64; k < ch * 64 + 64; ++k) s += pe[k] * w1[(size_t)k * 256 + f];
            ((float*)(ws + WS_B1P))[(which * 64 + ch) * 256 + f] = s; continue; } r -= I_B1;
        if (r < I_W2) { transpose_item(a.in[7], 128, 128, (bf16_t*)(ws + WS_W2KT), 256, 0, true, scr, r / 4, r % 4, lane); continue; } r -= I_W2;
        if (r < I_W2) { transpose_item(a.in[10], 128, 128, (bf16_t*)(ws + WS_W2VT), 256, 0, false, scr, r / 4, r % 4, lane); continue; } r -= I_W2;
        if (r < I_PO) { transpose_item(a.in[11], 2048, 2048, (bf16_t*)(ws + WS_WPOT), 1024, 0, false, scr, r / 64, r % 64, lane); continue; } r -= I_PO;
        if (r < I_NO) { transpose_item(a.in[12], 2048, 2048, (bf16_t*)(ws + WS_WNOT), 2048, 0, false, scr, r / 64, r % 64, lane); continue; } r -= I_NO;
        transpose_item(a.in[15], 2048, 2048, (bf16_t*)(ws + WS_WOT), 2048, 0, false, scr, r / 64, r % 64, lane);
    }
}

template <int W>
__device__ __forceinline__ void ypool_item(const bf16_t* __restrict__ U, const bf16_t* __restrict__ GP, bf16_t* __restrict__ Y, const float* __restrict__ scale, int c, int t0) {
    u32x4 x[W + 7], gq[8];
#pragma unroll
    for (int k = 0; k < W + 7; ++k) { const int r = t0 - (W - 1) + k; x[k] = r >= 0 ? *(const u32x4*)(U + (size_t)r * 1024 + c) : (u32x4){0u, 0u, 0u, 0u}; }
#pragma unroll
    for (int k = 0; k < 8; ++k) gq[k] = *(const u32x4*)(GP + (size_t)(t0 + k) * 1024 + c);
    const f32x4 sc0 = *(const f32x4*)(scale + c), sc1 = *(const f32x4*)(scale + c + 4);
    f32x4 s0 = {0.f, 0.f, 0.f, 0.f}, s1 = s0, a0, a1;
#pragma unroll
    for (int k = 0; k < W - 1; ++k) { unpack8(x[k], a0, a1); s0 = s0 + a0; s1 = s1 + a1; }
#pragma unroll
    for (int k = 0; k < 8; ++k) { const int t = t0 + k;
        unpack8(x[W - 1 + k], a0, a1); s0 = s0 + a0; s1 = s1 + a1;
        const int cnt = (t + 1 < W) ? t + 1 : W; const float ic = 1.0f / (float)cnt;
        f32x4 g0, g1; unpack8(gq[k], g0, g1);
        *(u32x4*)(Y + (size_t)t * 1024 + c) = pack8((s0 * ic - a0) * sc0 * g0, (s1 * ic - a1) * sc1 * g1);
        f32x4 b0, b1; unpack8(x[k], b0, b1); s0 = s0 - b0; s1 = s1 - b1; }
}
__device__ __forceinline__ void p2_ypool(const Frame& F, unsigned char* ws, const float* __restrict__ scale, int cw, int NCW) {
    const bf16_t* __restrict__ U = (const bf16_t*)(ws + WS_U); const bf16_t* __restrict__ GP = (const bf16_t*)(ws + WS_GP); bf16_t* __restrict__ Y = (bf16_t*)(ws + WS_H + 16 * MiB);
    for (int wi = cw; wi < 4 * 512; wi += NCW) {
        const int g = wi & 3, t0 = ((wi >> 2) * 2 + (F.lane >> 5)) * 8, c = (g * 32 + (F.lane & 31)) * 8;
        if (g == 0) ypool_item<2>(U, GP, Y, scale, c, t0); else if (g == 1) ypool_item<4>(U, GP, Y, scale, c, t0);
        else if (g == 2) ypool_item<8>(U, GP, Y, scale, c, t0); else ypool_item<16>(U, GP, Y, scale, c, t0);
    }
}
__device__ __forceinline__ void p3_compress2(const Frame& F, unsigned char* ws, int cwg, int NCWG) {
    const int tid = F.tid, lane = F.lane, r = lane & 31, hh = lane >> 5, wave = F.wave;
    const float* rcos = (const float*)(ws + WS_ROPE); const float* rsin = rcos + (size_t)S * 64;
    LAS bf16_t* hl = (LAS bf16_t*)F.lds;
    for (int it = cwg; it < 128; it += NCWG) {
        const int which = it >> 6, rt = it & 63;
        { const int row = tid >> 4, f0 = (tid & 15) * 16;
          const float* sl = (const float*)(ws + WS_SLAB) + ((size_t)(which * NSPLIT) * 2048 + rt * 32 + row) * 256 + f0; const float* b1 = (const float*)(ws + WS_B1) + which * 256 + f0;
          f32x4 s[4];
#pragma unroll
          for (int q = 0; q < 4; ++q) s[q] = *(const f32x4*)(b1 + 4 * q);
#pragma unroll
          for (int ks = 0; ks < NSPLIT; ++ks)
#pragma unroll
              for (int q = 0; q < 4; ++q) s[q] = s[q] + *(const f32x4*)(sl + (size_t)ks * 2048 * 256 + 4 * q);
#pragma unroll
          for (int q = 0; q < 4; ++q)
#pragma unroll
              for (int e = 0; e < 4; ++e) s[q][e] = siluf_(s[q][e]);
          *(LAS u32x4*)(hl + row * 264 + f0) = pack8(s[0], s[1]); *(LAS u32x4*)(hl + row * 264 + f0 + 8) = pack8(s[2], s[3]); }
        __syncthreads();
        if (wave < 4) {
            const int ct = wave, row = rt * 32 + r;
            const bf16_t* W2 = (const bf16_t*)(ws + (which ? WS_W2VT : WS_W2KT)) + (size_t)(ct * 32 + r) * 256 + hh * 8;
            f32x16 acc = f32x16{};
#pragma unroll 4
            for (int k = 0; k < 16; ++k) acc = __builtin_amdgcn_mfma_f32_32x32x16_bf16(*(const bf16x8*)(W2 + k * 16), *(const LAS bf16x8*)(hl + r * 264 + k * 16 + hh * 8), acc, 0, 0, 0);
            const int n = row & 511; bf16_t* dst = (bf16_t*)(ws + (which ? WS_VC : WS_KC)) + (size_t)row * 128 + ct * 32 + 4 * hh;
            const int pos = (16 * n + 31) > S - 1 ? S - 1 : 16 * n + 31;
#pragma unroll
            for (int gq = 0; gq < 4; ++gq) {
                float v0 = acc[4 * gq], v1 = acc[4 * gq + 1], v2 = acc[4 * gq + 2], v3 = acc[4 * gq + 3];
                if (which == 0) { const int i = (ct * 32 + 8 * gq + 4 * hh) >> 1; const float c0 = rcos[(size_t)pos * 64 + i], s0 = rsin[(size_t)pos * 64 + i], c1 = rcos[(size_t)pos * 64 + i + 1], s1 = rsin[(size_t)pos * 64 + i + 1];
                    const float o0 = v0 * c0 - v1 * s0, o1 = v1 * c0 + v0 * s0, o2 = v2 * c1 - v3 * s1, o3 = v3 * c1 + v2 * s1; v0 = o0; v1 = o1; v2 = o2; v3 = o3; }
                u32x2 w; w.x = cvtpk(v0, v1); w.y = cvtpk(v2, v3); if (n == 511) { w.x = 0u; w.y = 0u; }
                *(u32x2*)(dst + 8 * gq) = w;
            }
        }
        __syncthreads();
    }
}

namespace nsa {
constexpr int SHM_V = 16384, SHM_K = 16384;
constexpr int L_V = 0, L_K = 3 * SHM_V, L_WS = L_K + 2 * SHM_K, L_IMP = L_WS + NWAVES * 64 * 4, IMP_LD = 129, L_SELM = L_IMP + 64 * IMP_LD * 4, L_END = L_SELM + 64 * 8 * 2;
static_assert(L_END <= RING_BYTES, "attention LDS");
constexpr float SCALE = 0.08838834764831845f, C2 = 1.4426950408889634f * SCALE, THR = 8.f;
#define KSWZ(row, colB) ((row) * 256 + ((colB) ^ (((row) & 7) << 4)))
#define SBAR() __builtin_amdgcn_sched_barrier(0)
#define LADD(p, v) (void)__hip_atomic_fetch_add((p), (v), __ATOMIC_RELAXED, __HIP_MEMORY_SCOPE_WORKGROUP)
__device__ __forceinline__ int v_st(int k, int c) { const int kk = (k & ~0xC) | ((k & 4) << 1) | ((k & 8) >> 1); return ((kk >> 3) * 4 + (c >> 5)) * 512 + ((kk & 7) * 32 + (c & 31)) * 2; }
__device__ __forceinline__ int v_rd_base(int lane) { return ((lane & 3) << 3) | (((lane >> 2) & 3) << 6) | (((lane >> 4) & 1) << 5) | (((lane >> 5) & 1) << 8); }
constexpr int v_rd_off(int d0, int ks, int half) { return d0 * 512 + ks * 4096 + half * 2048; }
__device__ __forceinline__ unsigned cvtpk_a(float lo, float hi) { unsigned r; asm volatile("v_cvt_pk_bf16_f32 %0, %1, %2" : "=v"(r) : "v"(lo), "v"(hi)); return r; }

__device__ __forceinline__ void mask_range(f32x16& p0, f32x16& p1, int dq, unsigned Wn) {
    const float NEG = -__builtin_inff();
#pragma unroll
    for (int r = 0; r < 16; ++r) { const int c = (r & 3) + 8 * (r >> 2);
        if ((unsigned)(dq + c) >= Wn) p0[r] = NEG;
        if ((unsigned)(dq + c + 32) >= Wn) p1[r] = NEG; }
}
__device__ __forceinline__ void mask_row(f32x16& p0, f32x16& p1, bool keep) {
    const float NEG = -__builtin_inff();
#pragma unroll
    for (int r = 0; r < 16; ++r) { p0[r] = keep ? p0[r] : NEG; p1[r] = keep ? p1[r] : NEG; }
}
__device__ __forceinline__ float rowmax32(const f32x16& p0, const f32x16& p1) {
    float pmax = p0[0];
#pragma unroll
    for (int r = 1; r < 16; ++r) pmax = fmaxf(pmax, p0[r]);
#pragma unroll
    for (int r = 0; r < 16; ++r) pmax = fmaxf(pmax, p1[r]);
    auto rr = __builtin_amdgcn_permlane32_swap(__float_as_uint(pmax), __float_as_uint(pmax), false, false);
    return fmaxf(__uint_as_float(rr[0]), __uint_as_float(rr[1]));
}
__device__ __forceinline__ float rowsum32(const f32x16& p0, const f32x16& p1) {
    float ps = 0.f;
#pragma unroll
    for (int r = 0; r < 16; ++r) ps += p0[r];
#pragma unroll
    for (int r = 0; r < 16; ++r) ps += p1[r];
    auto rr = __builtin_amdgcn_permlane32_swap(__float_as_uint(ps), __float_as_uint(ps), false, false);
    return __uint_as_float(rr[0]) + __uint_as_float(rr[1]);
}
__device__ __forceinline__ void pack_p(const f32x16& p0, const f32x16& p1, bf16x8& pa0, bf16x8& pa1, bf16x8& pa2, bf16x8& pa3) {
#define PK4(P, B_, OUT) do { unsigned a0 = cvtpk_a(P[B_+0], P[B_+1]), a1 = cvtpk_a(P[B_+2], P[B_+3]);                          \
        unsigned b0 = cvtpk_a(P[B_+4], P[B_+5]), b1 = cvtpk_a(P[B_+6], P[B_+7]);                                             \
        auto r0 = __builtin_amdgcn_permlane32_swap(a0, b0, false, false); auto r1 = __builtin_amdgcn_permlane32_swap(a1, b1, false, false); \
        u32x4 w = {r0[0], r1[0], r0[1], r1[1]}; OUT = __builtin_bit_cast(bf16x8, w); } while (0)
    PK4(p0, 0, pa0); PK4(p0, 8, pa1); PK4(p1, 0, pa2); PK4(p1, 8, pa3);
#undef PK4
}
__device__ __forceinline__ void qkt(f32x16& p0, f32x16& p1, const LAS unsigned char* K_buf, int r32, int hi, const bf16x8* qr) {
    p0 = f32x16{}; p1 = f32x16{};
    const LAS unsigned char* kb[4];
#pragma unroll
    for (int dd = 0; dd < 4; ++dd) kb[dd] = K_buf + KSWZ(r32, (dd * 16 + hi * 8) * 2);
#define KLD(F, d0) do { const LAS unsigned char* a_ = kb[(d0) & 3] + ((d0) >> 2) * 128; F##0 = *(const LAS bf16x8*)(a_); F##1 = *(const LAS bf16x8*)(a_ + 32 * 256); \
        const LAS unsigned char* c_ = kb[((d0) + 1) & 3] + (((d0) + 1) >> 2) * 128; F##2 = *(const LAS bf16x8*)(c_); F##3 = *(const LAS bf16x8*)(c_ + 32 * 256); } while (0)
#define KMM(F, d0) do { p0 = __builtin_amdgcn_mfma_f32_32x32x16_bf16(F##0, qr[d0], p0, 0, 0, 0); p1 = __builtin_amdgcn_mfma_f32_32x32x16_bf16(F##1, qr[d0], p1, 0, 0, 0); \
        p0 = __builtin_amdgcn_mfma_f32_32x32x16_bf16(F##2, qr[(d0) + 1], p0, 0, 0, 0); p1 = __builtin_amdgcn_mfma_f32_32x32x16_bf16(F##3, qr[(d0) + 1], p1, 0, 0, 0); } while (0)
    bf16x8 fa0, fa1, fa2, fa3, fb0, fb1, fb2, fb3;
    KLD(fa, 0); KLD(fb, 2); SBAR();
    KMM(fa, 0); KLD(fa, 4); SBAR();
    KMM(fb, 2); KLD(fb, 6); SBAR();
    KMM(fa, 4); SBAR();
    KMM(fb, 6);
#undef KLD
#undef KMM
}
struct VF8 { s16x4 l0, h0, l1, h1, l2, h2, l3, h3; };
#define TRRD(dst, off) asm volatile("ds_read_b64_tr_b16 %0, %1 offset:%2" : "=&v"(dst) : "v"(vb0), "i"(off) : "memory")
__device__ __forceinline__ void pv_read0(VF8& f, int vb0) {
    constexpr int b_ = v_rd_off(0, 0, 0);
    TRRD(f.l0, b_); TRRD(f.h0, b_ + 2048); TRRD(f.l1, b_ + 4096); TRRD(f.h1, b_ + 6144); TRRD(f.l2, b_ + 8192); TRRD(f.h2, b_ + 10240); TRRD(f.l3, b_ + 12288); TRRD(f.h3, b_ + 14336);
}
__device__ __forceinline__ void pv_tile(f32x16* o, int vb0, bf16x8 pa0, bf16x8 pa1, bf16x8 pa2, bf16x8 pa3, VF8& f) {
#define PV_MM(d0, l0, h0, l1, h1, l2, h2, l3, h3) do { \
        o[d0] = __builtin_amdgcn_mfma_f32_32x32x16_bf16(pa0, (bf16x8){l0[0], l0[1], l0[2], l0[3], h0[0], h0[1], h0[2], h0[3]}, o[d0], 0, 0, 0);   \
        o[d0] = __builtin_amdgcn_mfma_f32_32x32x16_bf16(pa1, (bf16x8){l1[0], l1[1], l1[2], l1[3], h1[0], h1[1], h1[2], h1[3]}, o[d0], 0, 0, 0);   \
        o[d0] = __builtin_amdgcn_mfma_f32_32x32x16_bf16(pa2, (bf16x8){l2[0], l2[1], l2[2], l2[3], h2[0], h2[1], h2[2], h2[3]}, o[d0], 0, 0, 0);   \
        o[d0] = __builtin_amdgcn_mfma_f32_32x32x16_bf16(pa3, (bf16x8){l3[0], l3[1], l3[2], l3[3], h3[0], h3[1], h3[2], h3[3]}, o[d0], 0, 0, 0); } while (0)
#define PV_D0(d0) do { s16x4 l0, l1, l2, l3, h0, h1, h2, h3; constexpr int b_ = v_rd_off(d0, 0, 0); \
        TRRD(l0, b_); TRRD(h0, b_ + 2048); TRRD(l1, b_ + 4096); TRRD(h1, b_ + 6144); TRRD(l2, b_ + 8192); TRRD(h2, b_ + 10240); TRRD(l3, b_ + 12288); TRRD(h3, b_ + 14336); \
        asm volatile("s_waitcnt lgkmcnt(0)" ::: "memory"); SBAR(); PV_MM(d0, l0, h0, l1, h1, l2, h2, l3, h3); } while (0)
    asm volatile("s_waitcnt lgkmcnt(0)" ::: "memory"); SBAR(); PV_MM(0, f.l0, f.h0, f.l1, f.h1, f.l2, f.h2, f.l3, f.h3);
    PV_D0(1); PV_D0(2); PV_D0(3);
#undef PV_D0
#undef PV_MM
}
#undef TRRD

enum { M_C1 = 0, M_C2 = 1, M_S = 2, M_W = 3 };
struct Stage { bf16x8 k0, k1, v0, v1; };
__device__ __forceinline__ void stage_load(Stage& sg, const bf16_t* Kp, const bf16_t* Vp, int ld, int j, bool hasv) {
    const int tid = otid(), sr = tid >> 4, sc = (tid & 15) * 8; const size_t k0_ = (size_t)j * 64;
    sg.k0 = *(const bf16x8*)(Kp + (k0_ + sr) * ld + sc); sg.k1 = *(const bf16x8*)(Kp + (k0_ + 32 + sr) * ld + sc);
    if (hasv) { sg.v0 = *(const bf16x8*)(Vp + (k0_ + sr) * ld + sc); sg.v1 = *(const bf16x8*)(Vp + (k0_ + 32 + sr) * ld + sc); }
}
struct RowState { float m, l; };
template <int MODE>
__device__ __forceinline__ void attn_pass(LAS unsigned char* lds, const bf16_t* Kp, const bf16_t* Vp, int ld, int j_lo, int j_hi, const bf16x8* qr, int t, int Tq, const u32x4 sel,
                                          RowState& st, float invl, f32x16* o, bool do_imp, Stage& sg) {
    constexpr bool HASV = MODE != M_C1;
    const int tid = otid(), wid = __builtin_amdgcn_readfirstlane(tid >> 6), lane = tid & 63, r32 = lane & 31, hi = lane >> 5;
    LAS unsigned char* V_lds = lds + L_V; LAS unsigned char* K_lds = lds + L_K;
    LAS float* wsf = (LAS float*)(lds + L_WS) + wid * 64; LAS float* al_l = wsf + 32;
    const int sr = tid >> 4, sc = (tid & 15) * 8, vst0 = v_st(sr, sc), vst1 = v_st(32 + sr, sc), kws = KSWZ(sr, sc * 2);
    const int vb0 = (int)(uintptr_t)V_lds + v_rd_base(lane);
    const int NT = j_hi - j_lo;
#define st_k0 sg.k0
#define st_k1 sg.k1
#define st_v0 sg.v0
#define st_v1 sg.v1
    float m_reg = st.m, l_reg = st.l;
#define SLOAD(j) do { const size_t k0_ = (size_t)(j) * 64; st_k0 = *(const bf16x8*)(Kp + (k0_ + sr) * ld + sc); st_k1 = *(const bf16x8*)(Kp + (k0_ + 32 + sr) * ld + sc); \
        if (HASV) { st_v0 = *(const bf16x8*)(Vp + (k0_ + sr) * ld + sc); st_v1 = *(const bf16x8*)(Vp + (k0_ + 32 + sr) * ld + sc); } } while (0)
#define SWRITE(kof, vof) do { *(LAS bf16x8*)(K_lds + (kof) + kws) = st_k0; *(LAS bf16x8*)(K_lds + (kof) + kws + 32 * 256) = st_k1; \
        if (HASV) { *(LAS bf16x8*)(V_lds + (vof) + vst0) = st_v0; *(LAS bf16x8*)(V_lds + (vof) + vst1) = st_v1; } } while (0)
    const bool late = HASV && wid >= 4;
    bf16x8 pa0, pa1, pa2, pa3;
    SWRITE(0, 0);
    __syncthreads();
    int kof = 0, vof = 0, vprev = 0;
    for (int idx = 0; idx < NT; ++idx) {
        const int j = j_lo + idx, kb = j * 64;
        if (idx + 1 < NT) SLOAD(j + 1);
        if (HASV && late && idx > 0) { SBAR(); VF8 vf; pv_read0(vf, vb0 + vprev); pv_tile(o, vb0 + vprev, pa0, pa1, pa2, pa3, vf); SBAR(); }
        f32x16 p0, p1; qkt(p0, p1, K_lds + kof, r32, hi, qr);
        VF8 vfe; if (HASV && !late) { SBAR(); pv_read0(vfe, vb0 + vof); SBAR(); }
#if EXP_QKT2
        asm volatile("" : "+v"(p0), "+v"(p1)); SBAR(); qkt(p0, p1, K_lds + kof, r32, hi, qr);
#endif
        if (MODE == M_C1 || MODE == M_C2) { const int nmax1 = ((t - 31) >> 4) + 1; mask_range(p0, p1, kb + 4 * hi, (unsigned)(nmax1 > 0 ? nmax1 : 0)); }
        else if (MODE == M_S) { if (j == Tq) mask_range(p0, p1, kb + 4 * hi, (unsigned)(t + 1));
                                else { const unsigned w_ = (j >> 5) == 0 ? sel.x : (j >> 5) == 1 ? sel.y : (j >> 5) == 2 ? sel.z : sel.w; mask_row(p0, p1, ((w_ >> (j & 31)) & 1u) != 0u); } }
        else { if (j == Tq || j + 8 <= Tq) mask_range(p0, p1, kb + 4 * hi - (t - 511), 512u); }
        if (MODE == M_C1) { const float pmax = rowmax32(p0, p1); const float mn = fmaxf(m_reg, pmax); const float alpha = __builtin_amdgcn_exp2f((m_reg - mn) * C2); m_reg = mn;
            const float mnL = -mn * C2;
#pragma unroll
            for (int r = 0; r < 16; ++r) { p0[r] = __builtin_amdgcn_exp2f(fmaf(p0[r], C2, mnL)); p1[r] = __builtin_amdgcn_exp2f(fmaf(p1[r], C2, mnL)); }
            l_reg = l_reg * alpha + rowsum32(p0, p1); }
        else if (MODE == M_C2) { const float mnL = -m_reg * C2;
#pragma unroll
            for (int r = 0; r < 16; ++r) { p0[r] = __builtin_amdgcn_exp2f(fmaf(p0[r], C2, mnL)) * invl; p1[r] = __builtin_amdgcn_exp2f(fmaf(p1[r], C2, mnL)) * invl; }
            if (do_imp) { LAS unsigned* imp = (LAS unsigned*)(lds + L_IMP) + ((wid & 1) * 32 + r32) * IMP_LD + 16 * j + hi;
#pragma unroll
                for (int k = 0; k < 4; ++k) {
                    { const float e_ = p0[4 * k + 3], a_ = 2.f * (p0[4 * k] + p0[4 * k + 1] + p0[4 * k + 2]) + e_;
                      LADD(imp + 2 * k, (unsigned)(a_ * 67108864.f + 0.5f)); LADD(imp + 2 * k + 1, (unsigned)(e_ * 67108864.f + 0.5f)); }
                    { const float e_ = p1[4 * k + 3], a_ = 2.f * (p1[4 * k] + p1[4 * k + 1] + p1[4 * k + 2]) + e_;
                      LADD(imp + 8 + 2 * k, (unsigned)(a_ * 67108864.f + 0.5f)); LADD(imp + 8 + 2 * k + 1, (unsigned)(e_ * 67108864.f + 0.5f)); } } }
            pack_p(p0, p1, pa0, pa1, pa2, pa3); }
        else { const float pmax = rowmax32(p0, p1); float mn, alpha;
            if (__builtin_expect(__all((pmax - m_reg) * SCALE <= THR), 1)) { mn = m_reg; alpha = 1.f; }
            else { mn = fmaxf(m_reg, pmax); alpha = __builtin_amdgcn_exp2f((m_reg - mn) * C2); m_reg = mn; }
            const float mnL = -mn * C2;
#pragma unroll
            for (int r = 0; r < 16; ++r) { p0[r] = __builtin_amdgcn_exp2f(fmaf(p0[r], C2, mnL)); p1[r] = __builtin_amdgcn_exp2f(fmaf(p1[r], C2, mnL)); }
            l_reg = l_reg * alpha + rowsum32(p0, p1);
            pack_p(p0, p1, pa0, pa1, pa2, pa3);
            if (__any(alpha < 1.f)) { if (hi == 0) al_l[r32] = alpha; asm volatile("s_waitcnt lgkmcnt(0)" ::: "memory");
#pragma unroll
                for (int d_ = 0; d_ < 4; ++d_)
#pragma unroll
                    for (int r = 0; r < 16; ++r) o[d_][r] *= al_l[crow(r, hi)]; } }
        if (HASV && !late) { SBAR(); pv_tile(o, vb0 + vof, pa0, pa1, pa2, pa3, vfe); }
        const int kn = kof ^ SHM_K, vn = (vof == 2 * SHM_V) ? 0 : vof + SHM_V;
        if (idx + 1 < NT) { SWRITE(kn, vn); }
        __syncthreads();
        vprev = vof; kof = kn; vof = vn;
    }
    if (HASV) { if (late) { SBAR(); VF8 vf; pv_read0(vf, vb0 + vprev); pv_tile(o, vb0 + vprev, pa0, pa1, pa2, pa3, vf); } __syncthreads(); }
    st.m = m_reg; st.l = l_reg;
#undef SLOAD
#undef SWRITE
#undef st_k0
#undef st_k1
#undef st_v0
#undef st_v1
}

template <int MODE>
__device__ __forceinline__ void branch_out(LAS unsigned char* lds, const f32x16* o, float rowscale, bf16_t* onsa_w, const bf16_t* gn_w) {
    const int tid = otid(), wid = __builtin_amdgcn_readfirstlane(tid >> 6), lane = tid & 63, r32 = lane & 31, hi = lane >> 5;
    LAS float* li_l = (LAS float*)(lds + L_WS) + wid * 64;
    if (hi == 0) li_l[r32] = rowscale; asm volatile("s_waitcnt lgkmcnt(0)" ::: "memory");
    LAS unsigned* stg = (LAS unsigned*)(lds + wid * 8192);
#pragma unroll
    for (int r = 0; r < 16; ++r) { const int orow = crow(r, hi); const float sc = li_l[orow];
#pragma unroll
        for (int d0 = 0; d0 < 4; ++d0) { const float v = o[d0][r] * sc; const float vn = dpp_x1f(v);
            if ((r32 & 1) == 0) stg[orow * 64 + d0 * 16 + (r32 >> 1)] = cvtpk(v, vn); } }
    asm volatile("s_waitcnt lgkmcnt(0)" ::: "memory");
    u32x4 val[8], prev[8], gq[8];
#pragma unroll
    for (int i = 0; i < 8; ++i) val[i] = *(const LAS u32x4*)(stg + (i * 4 + (lane >> 4)) * 64 + (lane & 15) * 4);
    int rb = lane >> 4; asm volatile("" : "+v"(rb));
    bf16_t* gp_ = onsa_w + (size_t)rb * 2048 + (lane & 15) * 8; const bf16_t* gg_ = gn_w + (size_t)rb * 2048 + (lane & 15) * 8;
    if (MODE >= 1) {
#pragma unroll
        for (int i = 0; i < 8; ++i) prev[i] = *(const u32x4*)(gp_ + (size_t)i * 4 * 2048); }
    if (MODE == 2) {
#pragma unroll
        for (int i = 0; i < 8; ++i) gq[i] = *(const u32x4*)(gg_ + (size_t)i * 4 * 2048); }
#pragma unroll
    for (int i = 0; i < 8; ++i) { u32x4 w = val[i];
        if (MODE >= 1) { f32x4 a0, a1, b0, b1; unpack8(val[i], a0, a1); unpack8(prev[i], b0, b1); a0 = a0 + b0; a1 = a1 + b1;
            if (MODE == 2) { f32x4 g0, g1; unpack8(gq[i], g0, g1); a0 = a0 * g0; a1 = a1 * g1; }
            w = pack8(a0, a1); }
        *(u32x4*)(gp_ + (size_t)i * 4 * 2048) = w; }
    __syncthreads();
}

__device__ __forceinline__ void attn_unit(LAS unsigned char* lds, unsigned char* ws, int h, int Tq) {
    const int tid = otid(), wid = __builtin_amdgcn_readfirstlane(tid >> 6), lane = tid & 63, r32 = lane & 31, hi = lane >> 5;
    const int g = wid >> 1, tl = (wid & 1) * 32 + r32, t = Tq * 64 + tl, hq = 4 * h + g;
    const bf16_t* Q = (const bf16_t*)(ws + WS_Q); const bf16_t* GBR = (const bf16_t*)(ws + WS_GBR);
    bf16_t* onsa_w = (bf16_t*)(ws + WS_ONSA) + (size_t)(Tq * 64 + (wid & 1) * 32) * 2048 + hq * 128; const bf16_t* gn_w = (const bf16_t*)(ws + WS_GN) + (size_t)(Tq * 64 + (wid & 1) * 32) * 2048 + hq * 128;
    bf16x8 qr[8];
#pragma unroll
    for (int d0 = 0; d0 < 8; ++d0) qr[d0] = *(const bf16x8*)(Q + (size_t)t * 2048 + hq * 128 + d0 * 16 + hi * 8);
    const float g_c = bf2f(GBR[(size_t)t * 256 + hq * 3 + 0]), g_s = bf2f(GBR[(size_t)t * 256 + hq * 3 + 1]), g_w = bf2f(GBR[(size_t)t * 256 + hq * 3 + 2]);
    const bool big = Tq >= 16;
    LAS unsigned* IMP = (LAS unsigned*)(lds + L_IMP);
    if (big) { for (int i = tid; i < 64 * IMP_LD; i += 512) IMP[i] = 0u; }
    const u32x4 nosel = {0u, 0u, 0u, 0u};
    f32x16 o[4]; Stage sg;
    {
        const bf16_t* Kc = (const bf16_t*)(ws + WS_KC) + (size_t)h * 512 * 128; const bf16_t* Vc = (const bf16_t*)(ws + WS_VC) + (size_t)h * 512 * 128;
        const int ntc = ((4 * Tq + 2) >> 6) + 1;
        RowState stc{-1e30f, 0.f};
        stage_load(sg, Kc, Vc, 128, 0, false);
        attn_pass<M_C1>(lds, Kc, Vc, 128, 0, ntc, qr, t, Tq, nosel, stc, 0.f, o, false, sg);
        stage_load(sg, Kc, Vc, 128, 0, true);
        const float invl = stc.l > 0.f ? 1.0f / stc.l : 0.f;
#pragma unroll
        for (int d = 0; d < 4; ++d) o[d] = f32x16{};
        attn_pass<M_C2>(lds, Kc, Vc, 128, 0, ntc, qr, t, Tq, nosel, stc, invl, o, big, sg);
        stage_load(sg, (const bf16_t*)(ws + WS_KS) + h * 128, (const bf16_t*)(ws + WS_VS) + h * 128, 512, 0, true);
        branch_out<0>(lds, o, g_c, onsa_w, gn_w);
    }
    {
        LAS unsigned short* SELM = (LAS unsigned short*)(lds + L_SELM);
        int tok = tid >> 3, sub = tid & 7; asm volatile("" : "+v"(tok), "+v"(sub));
        unsigned bits = 0u;
        if (big) {
            unsigned kv[16];
#pragma unroll
            for (int e = 0; e < 16; ++e) { const int j = sub * 16 + e; const unsigned v = IMP[tok * IMP_LD + j]; kv[e] = (j >= 1 && j <= Tq - 2) ? v + 1u : 0u; }
            for (int round = 0; round < 13; ++round) {
                unsigned bv = kv[0]; int bj = 0;
#pragma unroll
                for (int e = 1; e < 16; ++e) { const bool gt = kv[e] > bv; bv = gt ? kv[e] : bv; bj = gt ? e : bj; }
                bj += sub * 16;
#pragma unroll
                for (int st_ = 0; st_ < 3; ++st_) { const unsigned ov = st_ == 0 ? dpp_x1(bv) : st_ == 1 ? dpp_x2(bv) : dpp_m8(bv); const int oj = (int)(st_ == 0 ? dpp_x1((unsigned)bj) : st_ == 1 ? dpp_x2((unsigned)bj) : dpp_m8((unsigned)bj));
                    const bool take = (ov > bv) || (ov == bv && oj < bj); bv = take ? ov : bv; bj = take ? oj : bj; }
                const int we = (bv != 0u && (bj >> 4) == sub) ? (bj & 15) : -1;
#pragma unroll
                for (int e = 0; e < 16; ++e) { const bool hit = (we == e); bits |= hit ? (1u << e) : 0u; kv[e] = hit ? 0u : kv[e]; }
            }
#pragma unroll
            for (int e = 0; e < 16; ++e) { const int j = sub * 16 + e; if (j == 0 || j == Tq - 1 || j == Tq) bits |= 1u << e; }
        } else {
#pragma unroll
            for (int e = 0; e < 16; ++e) { const int j = sub * 16 + e; if (j <= Tq) bits |= 1u << e; }
        }
        SELM[tok * 8 + sub] = (unsigned short)bits;
        __syncthreads();
    }
    const u32x4 sel = *(const LAS u32x4*)(lds + L_SELM + tl * 16);
    {
        RowState sts{-1e30f, 0.f};
#pragma unroll
        for (int d = 0; d < 4; ++d) o[d] = f32x16{};
        attn_pass<M_S>(lds, (const bf16_t*)(ws + WS_KS) + h * 128, (const bf16_t*)(ws + WS_VS) + h * 128, 512, 0, Tq + 1, qr, t, Tq, sel, sts, 0.f, o, false, sg);
        stage_load(sg, (const bf16_t*)(ws + WS_KW) + h * 128, (const bf16_t*)(ws + WS_VW) + h * 128, 512, Tq >= 8 ? Tq - 8 : 0, true);
        branch_out<1>(lds, o, sts.l > 0.f ? g_s / sts.l : 0.f, onsa_w, gn_w);
    }
    {
        RowState stw{-1e30f, 0.f};
#pragma unroll
        for (int d = 0; d < 4; ++d) o[d] = f32x16{};
        attn_pass<M_W>(lds, (const bf16_t*)(ws + WS_KW) + h * 128, (const bf16_t*)(ws + WS_VW) + h * 128, 512, Tq >= 8 ? Tq - 8 : 0, Tq + 1, qr, t, Tq, sel, stw, 0.f, o, false, sg);
        branch_out<2>(lds, o, stw.l > 0.f ? g_w / stw.l : 0.f, onsa_w, gn_w);
    }
}
#undef KSWZ
#undef SBAR
}

constexpr int NPHASE = 8;
__global__ void __launch_bounds__(NWAVES * 64, 2) mega_fwd(Args args) {
    extern __shared__ __attribute__((aligned(16))) unsigned char lds[];
    Frame F;
    F.lds = (LAS unsigned char*)lds;
    F.tid = threadIdx.x; F.lane = F.tid & 63; F.wave = __builtin_amdgcn_readfirstlane(F.tid >> 6);
    F.G = gridDim.x; { const int bx = blockIdx.x; F.vcu = (F.G % 8 == 0) ? (bx % 8) * (F.G / 8) + bx / 8 : bx; }
    volatile LAS unsigned* MISC = (volatile LAS unsigned*)(F.lds + MISC_OFF);
    unsigned char* ws = args.ws;
    for (int u = F.tid; u < (LDS_BYTES - LDSCTL_OFF) / 4; u += NWAVES * 64) ((LAS unsigned*)(F.lds + LDSCTL_OFF))[u] = 0u;
    __syncthreads();
    XcdBarrier bar; bar.bar = (unsigned*)(ws + WS_CTL) + CW_BAR; bar.x = 0; bar.st = nullptr;
#if !N_LAUNCHES_PER_PHASE
    bar = xcd_barrier_post((unsigned*)(ws + WS_CTL) + CW_BAR, MISC + 8);
#endif
    const int lo = args.ph_lo, hi = args.ph_hi;
#define IN(k) (lo <= (k) && (k) < hi && (F.tid = otid(), F.lane = F.tid & 63, true))
#define SEAM(k) do { if (IN(k) && IN((k) + 1)) xcd_barrier(bar); } while (0)
    bf16_t* const GM = (bf16_t*)args.out;

    for (int rep_ = 0; rep_ < (DUP_PHASE == 0 ? 2 : 1); ++rep_) if (IN(0)) { if (rep_) xcd_barrier(bar); p0_prologue(F, args); } SEAM(0);
    for (int rep_ = 0; rep_ < (DUP_PHASE == 1 ? 2 : 1); ++rep_) if (IN(1)) { if (rep_) xcd_barrier(bar);
        pg8::Gemm g{(const bf16_t*)(ws + WS_H), (const bf16_t*)(ws + WS_WCAT), 2048, 2048, 2048};
        pg8::StaticOrder So; So.init(S, NCAT, F.G, (int)blockIdx.x);
        EpiInProj E{ws, GM, args.in[14]};
        pg8::AddrAffine AD{(size_t)256 * 2048 * 2, (size_t)256 * 2048 * 2};
        pg8::gemm_phase<EpiInProj, true>(F.lds, g, So, E, AD);
        { const int nun = (So.nwg + F.G - 1) / F.G, full = So.nwg - (nun - 1) * F.G;
          const int base = full < F.G ? full : 0; if ((int)blockIdx.x >= base) p1_late_weights(F, args, ((int)blockIdx.x - base) * NWAVES + F.wave, (F.G - base) * NWAVES); }
    } SEAM(1);
    for (int rep_ = 0; rep_ < (DUP_PHASE == 2 ? 2 : 1); ++rep_) if (IN(2)) { if (rep_) xcd_barrier(bar);
        pg8::Gemm g{(const bf16_t*)(ws + WS_KCR), (const bf16_t*)(ws + WS_W1KT), 2048, 4096, 4096 / NSPLIT};
        pg8::StaticOrder So; So.init(16 * 256, NSPLIT * 256, F.G, (int)blockIdx.x);
        EpiSlab E{(float*)(ws + WS_SLAB)};
        pg8::AddrCmp AD{(4096 / NSPLIT) / 64};
        pg8::gemm_phase<EpiSlab, false>(F.lds, g, So, E, AD);
        { const int base = F.G > So.nwg ? So.nwg : 0; if ((int)blockIdx.x >= base) p2_ypool(F, ws, args.in[4], ((int)blockIdx.x - base) * NWAVES + F.wave, (F.G - base) * NWAVES); }
        if (blockIdx.x == F.G - 1) { const float* b1p = (const float*)(ws + WS_B1P); float* b1 = (float*)(ws + WS_B1); const int t = F.tid; float s = 0.f;
            for (int c = 0; c < 64; ++c) s += b1p[((t >> 8) * 64 + c) * 256 + (t & 255)];
            b1[t] = s; }
    } SEAM(2);
    for (int rep_ = 0; rep_ < (DUP_PHASE == 3 ? 2 : 1); ++rep_) if (IN(3)) { if (rep_) xcd_barrier(bar);
        p3_compress2(F, ws, (int)blockIdx.x, F.G);
    } SEAM(3);
    for (int rep_ = 0; rep_ < (DUP_PHASE == 5 ? 2 : 1); ++rep_) if (IN(5)) { if (rep_) xcd_barrier(bar);
        for (int p = F.vcu; p < 256; p += F.G) {
#pragma unroll 1
            for (int i = 0; i < 2; ++i) { const int h = p >> 6, x = p & 63; nsa::attn_unit(F.lds, ws, h, i ? x : 127 - x); } }
    } SEAM(5);
    for (int rep_ = 0; rep_ < (DUP_PHASE == 6 ? 2 : 1); ++rep_) if (IN(6)) { if (rep_) xcd_barrier(bar);
        pg8::Gemm ga{(const bf16_t*)(ws + WS_H + 16 * MiB), (const bf16_t*)(ws + WS_WPOT), 1024, 1024, 1024};
        pg8::Gemm gb{(const bf16_t*)(ws + WS_ONSA), (const bf16_t*)(ws + WS_WNOT), 2048, 2048, 2048};
        pg8::StaticOrder So; So.init(S, 2048, F.G, (int)blockIdx.x);
        EpiYaYb E{EpiYa{(bf16_t*)(ws + WS_YAG), GM}, EpiYb{(bf16_t*)(ws + WS_H), (const bf16_t*)(ws + WS_YAG), GM}};
        pg8::gemm_phase2<EpiYaYb>(F.lds, ga, gb, So, E);
    } SEAM(6);
    for (int rep_ = 0; rep_ < (DUP_PHASE == 7 ? 2 : 1); ++rep_) if (IN(7)) { if (rep_) xcd_barrier(bar);
        pg8::Gemm g{(const bf16_t*)(ws + WS_H), (const bf16_t*)(ws + WS_WOT), 2048, 2048, 2048}; pg8::AddrAffine AD{(size_t)256 * 2048 * 2, (size_t)256 * 2048 * 2};
        pg8::StaticOrder So; So.init(S, 2048, F.G, (int)blockIdx.x);
        EpiOut E{args.out, args.in[0], (float*)(ws + WS_SSQ), args.in[16], (unsigned*)(ws + WS_CTL), F.lds};
        pg8::gemm_phase<EpiOut, true>(F.lds, g, So, E, AD);
    }
#undef IN
#undef SEAM
}

extern "C" void kernel_launch(void* const* d_in, const int* in_sizes, int n_in, void* d_out, int out_size, void* d_ws, size_t ws_size, hipStream_t stream) {
    static int grid = 0;
    if (grid == 0) {
        if (n_in != 17 || in_sizes[0] != S * DM || out_size != S * DM || ws_size < WS_END) { fprintf(stderr, "kernel_launch: unexpected shapes (n_in %d, in0 %d, out %d, ws %zu); nothing launched\n", n_in, n_in > 0 ? in_sizes[0] : -1, out_size, ws_size); grid = -1; return; }
        int dev = 0, cus = 0;
        if (hipGetDevice(&dev) != hipSuccess || hipDeviceGetAttribute(&cus, hipDeviceAttributeMultiprocessorCount, dev) != hipSuccess) { fprintf(stderr, "kernel_launch: device query failed\n"); grid = -1; return; }
        if (hipFuncSetAttribute((const void*)mega_fwd, hipFuncAttributeMaxDynamicSharedMemorySize, LDS_BYTES) != hipSuccess) { fprintf(stderr, "kernel_launch: hipFuncSetAttribute failed\n"); grid = -1; return; }
        (void)hipGetLastError();
        grid = cus;
    }
    if (grid < 0) return;
    (void)hipMemsetAsync((char*)d_ws + WS_CTL, 0, CTL_BYTES, stream);
    Args a{};
    for (int i = 0; i < 17; ++i) a.in[i] = (const float*)d_in[i];
    a.out = (float*)d_out; a.ws = (unsigned char*)d_ws;
#if N_LAUNCHES_PER_PHASE
    for (int p = 0; p < NPHASE; ++p) { a.ph_lo = p; a.ph_hi = p + 1; hipLaunchKernelGGL(mega_fwd, dim3(grid), dim3(NWAVES * 64), LDS_BYTES, stream, a); }
#else
    a.ph_lo = 0; a.ph_hi = NPHASE;
    hipLaunchKernelGGL(mega_fwd, dim3(grid), dim3(NWAVES * 64), LDS_BYTES, stream, a);
#endif
}
```

```cpp
#include <hip/hip_runtime.h>
#include <cstdio>
#include <cstdint>

#define LAS __attribute__((address_space(3)))
#define GAS __attribute__((address_space(1)))
typedef unsigned short bf16_t;
typedef short bf16x8 __attribute__((ext_vector_type(8)));
typedef short s16x4 __attribute__((ext_vector_type(4)));
typedef float f32x4 __attribute__((ext_vector_type(4)));
typedef float f32x16 __attribute__((ext_vector_type(16)));
typedef unsigned u32x4 __attribute__((ext_vector_type(4)));
typedef unsigned u32x2 __attribute__((ext_vector_type(2)));
typedef float f32x2_t __attribute__((ext_vector_type(2)));
typedef __bf16 bf16x2_t __attribute__((ext_vector_type(2)));

#ifndef EXP_QKT2
#define EXP_QKT2 0
#endif
#ifndef DUP_PHASE
#define DUP_PHASE -1
#endif
#ifndef N_LAUNCHES_PER_PHASE
#define N_LAUNCHES_PER_PHASE 0
#endif

constexpr int S = 8192, DM = 2048, NCAT = 13568;
constexpr int HD = 128, NKV = 4, NCMP = 511;
constexpr float EPS = 1e-6f;

constexpr size_t MiB = 1u << 20;
constexpr size_t WS_CTL = 0, CTL_BYTES = 1 * MiB;
constexpr size_t WS_WCAT = 1 * MiB;
constexpr size_t WS_SLAB = WS_WCAT;
constexpr size_t WS_ONSA = WS_WCAT;
constexpr size_t WS_MIXT = 54 * MiB;
constexpr size_t WS_WPOT = 55 * MiB;
constexpr size_t WS_WNOT = 59 * MiB;
constexpr size_t WS_WOT  = 67 * MiB;
constexpr size_t WS_W1KT = 75 * MiB, WS_W1VT = 77 * MiB;
constexpr size_t WS_W2KT = 79 * MiB, WS_W2VT = 79 * MiB + 65536;
constexpr size_t WS_B1P  = 80 * MiB + 262144;
constexpr size_t WS_B1   = 79 * MiB + 131072 + 32768;
constexpr size_t WS_KC   = 79 * MiB + 262144, WS_VC = 79 * MiB + 786432;
constexpr size_t WS_ROPE = 81 * MiB;
constexpr size_t WS_SSQ  = 85 * MiB;
constexpr size_t WS_H    = 86 * MiB;
constexpr size_t WS_U    = 118 * MiB, WS_GP = 134 * MiB;
constexpr size_t WS_YAG  = WS_U;
constexpr size_t WS_Q    = 150 * MiB;
constexpr size_t WS_KCR  = 182 * MiB, WS_VCR = 190 * MiB, WS_KS = 198 * MiB, WS_VS = 206 * MiB, WS_KW = 214 * MiB, WS_VW = 222 * MiB;
constexpr size_t WS_GN   = 230 * MiB;
constexpr size_t WS_GBR  = 262 * MiB;
constexpr size_t WS_K8S = 198 * MiB, WS_K8W = 202 * MiB;
constexpr size_t WS_V8S = 206 * MiB, WS_V8W = 210 * MiB;
constexpr size_t WS_V8TS = 214 * MiB, WS_V8TW = 218 * MiB;
constexpr size_t WS_Q8   = 266 * MiB;
constexpr size_t WS_END  = 282 * MiB;
constexpr int CW_BAR = 4096;

constexpr int RING_BYTES = 131072;
constexpr int LDSCTL_OFF = RING_BYTES, MISC_OFF = LDSCTL_OFF + 320;
constexpr int LDS_BYTES = 147456;
constexpr int NWAVES = 8;

#define LDS_WAIT() asm volatile("s_waitcnt lgkmcnt(0)" ::: "memory")
#define VM_WAIT() asm volatile("s_waitcnt vmcnt(0)" ::: "memory")

__device__ __forceinline__ unsigned cvtpk(float lo, float hi) { f32x2_t v = {lo, hi}; bf16x2_t b = __builtin_convertvector(v, bf16x2_t); return __builtin_bit_cast(unsigned, b); }
__device__ __forceinline__ unsigned cvt4_fp8(float a, float b, float c, float d) { int w = __builtin_amdgcn_cvt_pk_fp8_f32(a, b, 0, false); return (unsigned)__builtin_amdgcn_cvt_pk_fp8_f32(c, d, w, true); }
__device__ __forceinline__ float bf2f(unsigned short h) { return __builtin_bit_cast(float, (unsigned)h << 16); }
__device__ __forceinline__ float bflo(unsigned w) { return __builtin_bit_cast(float, w << 16); }
__device__ __forceinline__ float bfhi(unsigned w) { return __builtin_bit_cast(float, w & 0xffff0000u); }
__device__ __forceinline__ float sigmoidf_(float x) { return __builtin_amdgcn_rcpf(1.0f + __expf(-x)); }
__device__ __forceinline__ float siluf_(float x) { return x * __builtin_amdgcn_rcpf(1.0f + __expf(-x)); }
__device__ __forceinline__ int otid() { int t = threadIdx.x; asm volatile("" : "+v"(t)); return t; }
__device__ __forceinline__ unsigned dpp_x1(unsigned v) { return __builtin_amdgcn_update_dpp(0u, v, 0xB1, 0xF, 0xF, false); }
__device__ __forceinline__ unsigned dpp_x2(unsigned v) { return __builtin_amdgcn_update_dpp(0u, v, 0x4E, 0xF, 0xF, false); }
__device__ __forceinline__ unsigned dpp_m8(unsigned v) { return __builtin_amdgcn_update_dpp(0u, v, 0x141, 0xF, 0xF, false); }
__device__ __forceinline__ float dpp_x1f(float v) { return __uint_as_float(dpp_x1(__float_as_uint(v))); }
__device__ __forceinline__ int crow(int r, int hi) { return (r & 3) + 8 * (r >> 2) + 4 * hi; }
__device__ __forceinline__ float wave_sum(float v) {
#pragma unroll
    for (int o = 1; o < 64; o <<= 1) v += __shfl_xor(v, o);
    return v;
}

#define XB_TMO      128
#define XB_XCNT(j)  (256  + 64 * (j))
#define XB_XSUB(j)  (1280 + 64 * (j))
#define XB_XGEN(j)  (2304 + 64 * (j))
#define XB_TOP      3328
#define XB_TOPGEN   3392
#define XCD_BAR_WORDS 3456
#define XB_SPIN_CAP (1u << 18)
__device__ __forceinline__ unsigned xb_ld(unsigned* p)              { return __hip_atomic_load(p, __ATOMIC_RELAXED, __HIP_MEMORY_SCOPE_AGENT); }
__device__ __forceinline__ unsigned xb_add(unsigned* p, unsigned v) { return __hip_atomic_fetch_add(p, v, __ATOMIC_RELAXED, __HIP_MEMORY_SCOPE_AGENT); }
__device__ __forceinline__ unsigned xb_xcc_id() { return (unsigned)__builtin_amdgcn_s_getreg((3 << 11) | 20) & 0xFu; }
#define XB_SPIN(cond, bar) do { unsigned _sp = 0; while (cond) { __builtin_amdgcn_s_sleep(1); \
    if ((++_sp & 255u) == 0u) { if (xb_ld(&(bar)[XB_TMO])) break; if (_sp > XB_SPIN_CAP) { atomicAdd(&(bar)[XB_TMO], 1u); break; } } } } while (0)
struct XcdBarrier { unsigned* bar; unsigned x; volatile LAS unsigned* st; };
__device__ __forceinline__ XcdBarrier xcd_barrier_post(unsigned* bar, volatile LAS unsigned* st) {
    XcdBarrier b; b.bar = bar; b.x = xb_xcc_id(); b.st = st;
    if (threadIdx.x == 0) (void)xb_add(&bar[XB_XCNT(b.x)], 1u);
    return b;
}
__device__ __forceinline__ void xcd_barrier_complete(unsigned* bar, unsigned x, unsigned& nloc, unsigned& nx) {
    const unsigned G = gridDim.x * gridDim.y * gridDim.z;
    unsigned sum, cnt, mine, sp = 0u;
    for (;;) {
        sum = 0u; cnt = 0u; mine = 0u;
#pragma unroll
        for (unsigned j = 0; j < 16; ++j) { const unsigned c = xb_ld(&bar[XB_XCNT(j)]); sum += c; cnt += (c > 0u) ? 1u : 0u; mine = (j == x) ? c : mine; }
        if (sum == G) break;
        __builtin_amdgcn_s_sleep(1);
        if ((++sp & 255u) == 0u) { if (xb_ld(&bar[XB_TMO])) break; if (sp > XB_SPIN_CAP) { atomicAdd(&bar[XB_TMO], 1u); break; } }
    }
    nloc = mine > 0u ? mine : 1u; nx = cnt > 0u ? cnt : 1u;
}
__device__ __forceinline__ void xcd_barrier(const XcdBarrier& b) {
    asm volatile("s_waitcnt vmcnt(0)" ::: "memory");
    __syncthreads();
    if (threadIdx.x == 0) {
        unsigned* bar = b.bar;
        __builtin_amdgcn_s_waitcnt(0);
        unsigned nloc = b.st[0], nx = b.st[1];
        if (nloc == 0u) { xcd_barrier_complete(bar, b.x, nloc, nx); b.st[0] = nloc; b.st[1] = nx; }
        const unsigned old = xb_add(&bar[XB_XSUB(b.x)], 1u);
        const unsigned gen = old / nloc;
        if (old + 1u == (gen + 1u) * nloc) {
            __builtin_amdgcn_fence(__ATOMIC_RELEASE, "agent");
            asm volatile("s_waitcnt vmcnt(0)" ::: "memory");
            const unsigned og = xb_add(&bar[XB_TOP], 1u);
            const unsigned tg = og / nx;
            if (og + 1u == (tg + 1u) * nx) xb_add(&bar[XB_TOPGEN], 1u);
            else XB_SPIN(xb_ld(&bar[XB_TOPGEN]) == tg, bar);
            __builtin_amdgcn_fence(__ATOMIC_ACQUIRE, "agent");
            xb_add(&bar[XB_XGEN(b.x)], 1u);
            asm volatile("s_waitcnt vmcnt(0)" ::: "memory");
        } else {
            XB_SPIN(xb_ld(&bar[XB_XGEN(b.x)]) == gen, bar);
            __builtin_amdgcn_fence(__ATOMIC_ACQUIRE, "agent");
            asm volatile("s_waitcnt vmcnt(0)" ::: "memory");
        }
    }
    __syncthreads();
}

namespace pg8 {
constexpr int BM = 256, BK = 64, HALF = 128, HTB = HALF * BK * 2, STAGE_BYTES = 8 * HTB, NXCD = 8, WGM = 8;
__host__ __device__ __forceinline__ int lds_byte(int r, int c) { const int st = (r >> 4) * 2 + (c >> 5), rr = r & 15, cc = c & 31, ob = rr * 64 + cc * 2; return st * 1024 + (ob ^ (((ob >> 9) & 1) << 5)); }
__host__ __device__ __forceinline__ void stage_rc(int b, int& R, int& C) { const int st = b / 1024, sb = b % 1024, swz = sb ^ (((sb >> 9) & 1) << 5); R = (st >> 1) * 16 + swz / 64; C = (st & 1) * 32 + (swz % 64) / 2; }
__host__ __device__ __forceinline__ int perm32(int rho) { const int n = rho >> 4, i = rho & 15; return 8 * (i >> 2) + 4 * n + (i & 3); }
struct Unit { int pm, pn; };
struct Gemm { const bf16_t* A; const bf16_t* Bt; int lda, ldb, K; };
struct AddrAffine { size_t tA, tB;
    __device__ __forceinline__ const char* A(const char* b, const Unit& u) const { return b + (size_t)u.pm * tA; }
    __device__ __forceinline__ const char* B(const char* b, const Unit& u) const { return b + (size_t)u.pn * tB; }
    __device__ __forceinline__ size_t ka(int t) const { return (size_t)t * (BK * 2); } };
struct AddrCmp { int ntile;
    __device__ __forceinline__ const char* A(const char* b, const Unit& u) const { return b + (size_t)(u.pm >> 3) * (8 * MiB) + (size_t)((u.pm >> 1) & 3) * (2 * MiB) + (size_t)(u.pm & 1) * (256 * 4096) + ka(u.pn * ntile); }
    __device__ __forceinline__ const char* B(const char* b, const Unit& u) const { return b + (size_t)(u.pm >> 3) * (2 * MiB) + (size_t)u.pn * ntile * (BK * 2); }
    __device__ __forceinline__ size_t ka(int t) const { return (size_t)t * (BK * 2); } };
struct StaticOrder {
    int nM, nN, nwg, G, c;
    __host__ __device__ void init(int M, int N, int G_, int c_) { nM = M / BM; nN = N / BM; nwg = nM * nN; G = G_; c = c_; }
    __host__ __device__ bool next(int i, Unit& u) const {
        const long L = (long)i * G + c; if (L >= nwg) return false;
        int wgid = (int)L; { const int q = nwg / NXCD, r = nwg % NXCD, xcd = wgid % NXCD, off = wgid / NXCD; wgid = (xcd < r ? xcd * (q + 1) : r * (q + 1) + (xcd - r) * q) + off; }
        const int nig = WGM * nN, gid = wgid / nig, fm = gid * WGM, gsz = (nM - fm) < WGM ? (nM - fm) : WGM;
        u.pm = fm + ((wgid % nig) % gsz); u.pn = (wgid % nig) / gsz; return true;
    }
};
template <class Epi, bool ALIGN_EPI, class Addr>
__device__ __forceinline__ void gemm_phase(LAS unsigned char* lds, const Gemm g, const StaticOrder& S, const Epi& E, const Addr& AD) {
    const int tid = otid(), wid = __builtin_amdgcn_readfirstlane(tid >> 6), lane = tid & 63, wr = wid >> 2, wc = wid & 3, fr = lane & 15, fq = lane >> 4;
    const int K = g.K, nt = K / BK;
    unsigned voffA[2], voffB[2];
#pragma unroll
    for (int i = 0; i < 2; ++i) { int R, C; stage_rc(tid * 16 + i * 8192, R, C); const int Rb = (R & ~31) + perm32(R & 31);
        voffA[i] = (unsigned)(R * g.lda + C) * 2u; voffB[i] = (unsigned)(Rb * g.ldb + C) * 2u; }
    const size_t kstep = (size_t)(BK * 2);
    const size_t hA = (size_t)HALF * g.lda * 2, hB = (size_t)HALF * g.ldb * 2;
    const unsigned ldsw = (unsigned)wid * 1024u;
    const int aoff = lds_byte(wr * 64 + fr, fq * 8), boff = lds_byte(wc * 32 + fr, fq * 8);
#define PG8_SA(b, h) (((b) * 2 + (h)) * HTB)
#define PG8_SB(b, h) ((4 + (b) * 2 + (h)) * HTB)
#define PG8_STAGE(bufoff, gbase, voff) do { _Pragma("unroll") for (int _i = 0; _i < 2; ++_i) \
        __builtin_amdgcn_global_load_lds((const unsigned*)((const char*)(gbase) + (voff)[_i]), (LAS unsigned*)(lds + (bufoff) + ldsw + _i * 8192), 16, 0, 0); } while (0)
#define PG8_LDA(dst, b, h) do { _Pragma("unroll") for (int m = 0; m < 4; ++m) _Pragma("unroll") for (int k = 0; k < 2; ++k) dst[m][k] = *(const LAS bf16x8*)(lds + PG8_SA(b, h) + aoff + m * 2048 + k * 1024); } while (0)
#define PG8_LDB(dst, b, h) do { _Pragma("unroll") for (int n = 0; n < 2; ++n) _Pragma("unroll") for (int k = 0; k < 2; ++k) dst[n][k] = *(const LAS bf16x8*)(lds + PG8_SB(b, h) + boff + n * 2048 + k * 1024); } while (0)
#define PG8_MMA(ai, bj, At, Bt) do { __builtin_amdgcn_s_setprio(1); _Pragma("unroll") for (int m = 0; m < 4; ++m) _Pragma("unroll") for (int n = 0; n < 2; ++n) _Pragma("unroll") for (int k = 0; k < 2; ++k) \
        acc[ai][bj][m][n] = __builtin_amdgcn_mfma_f32_16x16x32_bf16(Bt[n][k], At[m][k], acc[ai][bj][m][n], 0, 0, 0); __builtin_amdgcn_s_setprio(0); } while (0)
#define PG8_WAIT_V(n) asm volatile("s_waitcnt vmcnt(" #n ")" ::: "memory")
#define PG8_WAIT_L(n) asm volatile("s_waitcnt lgkmcnt(" #n ")" ::: "memory")
#define PG8_BAR __builtin_amdgcn_s_barrier()
#define PG8_SCHED __builtin_amdgcn_sched_barrier(0)
    Unit cur, nxt; int ui = 0;
    if (!S.next(0, cur)) return;
    f32x4 acc[2][2][4][2];
#pragma unroll
    for (int a = 0; a < 2; ++a)
#pragma unroll
        for (int b = 0; b < 2; ++b)
#pragma unroll
            for (int m = 0; m < 4; ++m)
#pragma unroll
                for (int n = 0; n < 2; ++n) acc[a][b][m][n] = (f32x4){0.f, 0.f, 0.f, 0.f};
    bf16x8 At[4][2], B0[2][2], B1[2][2];
    const char* cA = AD.A((const char*)g.A, cur); const char* cB = AD.B((const char*)g.Bt, cur);
    PG8_STAGE(PG8_SB(0, 0), cB, voffB); PG8_STAGE(PG8_SB(0, 1), cB + hB, voffB); PG8_STAGE(PG8_SA(0, 0), cA, voffA); PG8_STAGE(PG8_SA(0, 1), cA + hA, voffA);
    if (wr == 1) PG8_BAR;
    PG8_WAIT_V(2); PG8_BAR;
    PG8_STAGE(PG8_SB(1, 0), cB + kstep, voffB); PG8_STAGE(PG8_SA(1, 0), cA + kstep, voffA); PG8_STAGE(PG8_SB(1, 1), cB + hB + kstep, voffB);
    PG8_WAIT_V(6); PG8_BAR;
    for (;;) {
        const bool has_next = S.next(ui + 1, nxt);
        const char* nA = has_next ? AD.A((const char*)g.A, nxt) : cA; const char* nB = has_next ? AD.B((const char*)g.Bt, nxt) : cB;
        for (int t = 0; t < nt; t += 2) {
            const bool last = (t == nt - 2);
            const char* a1 = cA + AD.ka(t) + kstep;
            const char* a2 = last ? nA : cA + AD.ka(t + 2); const char* b2 = last ? nB : cB + (size_t)(t + 2) * kstep;
            const char* a3 = a2 + kstep; const char* b3 = b2 + kstep;
            PG8_LDB(B0, 0, 0); PG8_LDB(B1, 0, 1); PG8_SCHED; PG8_LDA(At, 0, 0); PG8_STAGE(PG8_SA(1, 1), a1 + hA, voffA);
            PG8_WAIT_V(8); PG8_WAIT_L(0); PG8_BAR; PG8_MMA(0, 0, At, B0); PG8_MMA(0, 1, At, B1); PG8_BAR; PG8_SCHED;
            PG8_LDA(At, 0, 1); PG8_STAGE(PG8_SB(0, 0), b2, voffB); PG8_STAGE(PG8_SB(0, 1), b2 + hB, voffB); PG8_STAGE(PG8_SA(0, 0), a2, voffA);
            PG8_WAIT_V(8); PG8_WAIT_L(0); PG8_BAR; PG8_MMA(1, 0, At, B0); PG8_MMA(1, 1, At, B1); PG8_BAR; PG8_SCHED;
            PG8_LDB(B0, 1, 0); PG8_LDB(B1, 1, 1); PG8_SCHED; PG8_LDA(At, 1, 0); PG8_STAGE(PG8_SA(0, 1), a2 + hA, voffA);
            PG8_WAIT_V(8); PG8_WAIT_L(0); PG8_BAR; PG8_MMA(0, 0, At, B0); PG8_MMA(0, 1, At, B1); PG8_BAR; PG8_SCHED;
            PG8_LDA(At, 1, 1); PG8_STAGE(PG8_SB(1, 0), b3, voffB); PG8_STAGE(PG8_SB(1, 1), b3 + hB, voffB); PG8_STAGE(PG8_SA(1, 0), a3, voffA);
            PG8_WAIT_V(8); PG8_WAIT_L(0); PG8_BAR; PG8_MMA(1, 0, At, B0); PG8_MMA(1, 1, At, B1); PG8_BAR; PG8_SCHED;
        }
        if constexpr (ALIGN_EPI) { if (wr == 0) PG8_BAR; }
        E(acc, cur, wr, wc, fr, fq);
        if (!has_next) break;
#pragma unroll
        for (int a = 0; a < 2; ++a)
#pragma unroll
            for (int b = 0; b < 2; ++b)
#pragma unroll
                for (int m = 0; m < 4; ++m)
#pragma unroll
                    for (int n = 0; n < 2; ++n) acc[a][b][m][n] = (f32x4){0.f, 0.f, 0.f, 0.f};
        cur = nxt; cA = nA; cB = nB; ++ui;
        if constexpr (ALIGN_EPI) { if (wr == 1) PG8_BAR; }
    }
    PG8_WAIT_V(0);
    if constexpr (!ALIGN_EPI) { if (wr == 0) PG8_BAR; }
    PG8_BAR;
#undef PG8_SA
#undef PG8_SB
#undef PG8_STAGE
#undef PG8_LDA
#undef PG8_LDB
#undef PG8_MMA
#undef PG8_WAIT_V
#undef PG8_WAIT_L
#undef PG8_BAR
#undef PG8_SCHED
}
template <class Epi>
__device__ __forceinline__ void gemm_phase2(LAS unsigned char* lds, const Gemm g0, const Gemm g1, const StaticOrder& S, const Epi& E) {
    const int tid = otid(), wid = __builtin_amdgcn_readfirstlane(tid >> 6), lane = tid & 63, wr = wid >> 2, wc = wid & 3, fr = lane & 15, fq = lane >> 4;
#define PG8_MKOFF(vA, vB, G) do { _Pragma("unroll") for (int i_ = 0; i_ < 2; ++i_) { int R_, C_; stage_rc(tid * 16 + i_ * 8192, R_, C_); const int Rb_ = (R_ & ~31) + perm32(R_ & 31); \
        (vA)[i_] = (unsigned)(R_ * (G).lda + C_) * 2u; (vB)[i_] = (unsigned)(Rb_ * (G).ldb + C_) * 2u; } } while (0)
    const size_t kstep = (size_t)(BK * 2);
    const size_t hA0 = (size_t)HALF * g0.lda * 2, hB0 = (size_t)HALF * g0.ldb * 2, hA1 = (size_t)HALF * g1.lda * 2, hB1 = (size_t)HALF * g1.ldb * 2;
    const unsigned ldsw = (unsigned)wid * 1024u;
    const int aoff = lds_byte(wr * 64 + fr, fq * 8), boff = lds_byte(wc * 32 + fr, fq * 8);
#define PG8_SA(b, h) (((b) * 2 + (h)) * HTB)
#define PG8_SB(b, h) ((4 + (b) * 2 + (h)) * HTB)
#define PG8_STAGE(bufoff, gbase, voff) do { _Pragma("unroll") for (int _i = 0; _i < 2; ++_i) \
        __builtin_amdgcn_global_load_lds((const unsigned*)((const char*)(gbase) + (voff)[_i]), (LAS unsigned*)(lds + (bufoff) + ldsw + _i * 8192), 16, 0, 0); } while (0)
#define PG8_LDA(dst, b, h) do { _Pragma("unroll") for (int m = 0; m < 4; ++m) _Pragma("unroll") for (int k = 0; k < 2; ++k) dst[m][k] = *(const LAS bf16x8*)(lds + PG8_SA(b, h) + aoff + m * 2048 + k * 1024); } while (0)
#define PG8_LDB(dst, b, h) do { _Pragma("unroll") for (int n = 0; n < 2; ++n) _Pragma("unroll") for (int k = 0; k < 2; ++k) dst[n][k] = *(const LAS bf16x8*)(lds + PG8_SB(b, h) + boff + n * 2048 + k * 1024); } while (0)
#define PG8_MMA(ai, bj, At, Bt) do { __builtin_amdgcn_s_setprio(1); _Pragma("unroll") for (int m = 0; m < 4; ++m) _Pragma("unroll") for (int n = 0; n < 2; ++n) _Pragma("unroll") for (int k = 0; k < 2; ++k) \
        acc[ai][bj][m][n] = __builtin_amdgcn_mfma_f32_16x16x32_bf16(Bt[n][k], At[m][k], acc[ai][bj][m][n], 0, 0, 0); __builtin_amdgcn_s_setprio(0); } while (0)
#define PG8_WAIT_V(n) asm volatile("s_waitcnt vmcnt(" #n ")" ::: "memory")
#define PG8_WAIT_L(n) asm volatile("s_waitcnt lgkmcnt(" #n ")" ::: "memory")
#define PG8_BAR __builtin_amdgcn_s_barrier()
#define PG8_SCHED __builtin_amdgcn_sched_barrier(0)
    Unit cur; int kind = 0;
    if (!S.next(0, cur)) return;
    f32x4 acc[2][2][4][2];
#pragma unroll
    for (int a = 0; a < 2; ++a)
#pragma unroll
        for (int b = 0; b < 2; ++b)
#pragma unroll
            for (int m = 0; m < 4; ++m)
#pragma unroll
                for (int n = 0; n < 2; ++n) acc[a][b][m][n] = (f32x4){0.f, 0.f, 0.f, 0.f};
    bf16x8 At[4][2], B0[2][2], B1[2][2];
    const char* cA = (const char*)g0.A + (size_t)cur.pm * (2 * hA0); const char* cB = (const char*)g0.Bt + (size_t)cur.pn * (2 * hB0);
    unsigned voffA[2], voffB[2]; PG8_MKOFF(voffA, voffB, g0); size_t hA = hA0, hB = hB0;
    PG8_STAGE(PG8_SB(0, 0), cB, voffB); PG8_STAGE(PG8_SB(0, 1), cB + hB, voffB); PG8_STAGE(PG8_SA(0, 0), cA, voffA); PG8_STAGE(PG8_SA(0, 1), cA + hA, voffA);
    if (wr == 1) PG8_BAR;
    PG8_WAIT_V(2); PG8_BAR;
    PG8_STAGE(PG8_SB(1, 0), cB + kstep, voffB); PG8_STAGE(PG8_SA(1, 0), cA + kstep, voffA); PG8_STAGE(PG8_SB(1, 1), cB + hB + kstep, voffB);
    PG8_WAIT_V(6); PG8_BAR;
    for (;;) {
        const bool has_next = kind == 0;
        const int nt = (kind == 0 ? g0.K : g1.K) / BK;
        const char* nA = has_next ? (const char*)g1.A + (size_t)cur.pm * (2 * hA1) : cA; const char* nB = has_next ? (const char*)g1.Bt + (size_t)cur.pn * (2 * hB1) : cB;
        for (int t = 0; t < nt; t += 2) {
            const bool last = (t == nt - 2);
            const char* a1 = cA + (size_t)(t + 1) * kstep;
            const char* a2 = last ? nA : cA + (size_t)(t + 2) * kstep; const char* b2 = last ? nB : cB + (size_t)(t + 2) * kstep;
            const char* a3 = a2 + kstep; const char* b3 = b2 + kstep;
            const bool sw = last && has_next;
            unsigned voffAn[2] = {voffA[0], voffA[1]}, voffBn[2] = {voffB[0], voffB[1]}; if (sw) PG8_MKOFF(voffAn, voffBn, g1);
            const size_t hAn = sw ? hA1 : hA, hBn = sw ? hB1 : hB;
            PG8_LDB(B0, 0, 0); PG8_LDB(B1, 0, 1); PG8_SCHED; PG8_LDA(At, 0, 0); PG8_STAGE(PG8_SA(1, 1), a1 + hA, voffA);
            PG8_WAIT_V(8); PG8_WAIT_L(0); PG8_BAR; PG8_MMA(0, 0, At, B0); PG8_MMA(0, 1, At, B1); PG8_BAR; PG8_SCHED;
            PG8_LDA(At, 0, 1); PG8_STAGE(PG8_SB(0, 0), b2, voffBn); PG8_STAGE(PG8_SB(0, 1), b2 + hBn, voffBn); PG8_STAGE(PG8_SA(0, 0), a2, voffAn);
            PG8_WAIT_V(8); PG8_WAIT_L(0); PG8_BAR; PG8_MMA(1, 0, At, B0); PG8_MMA(1, 1, At, B1); PG8_BAR; PG8_SCHED;
            PG8_LDB(B0, 1, 0); PG8_LDB(B1, 1, 1); PG8_SCHED; PG8_LDA(At, 1, 0); PG8_STAGE(PG8_SA(0, 1), a2 + hAn, voffAn);
            PG8_WAIT_V(8); PG8_WAIT_L(0); PG8_BAR; PG8_MMA(0, 0, At, B0); PG8_MMA(0, 1, At, B1); PG8_BAR; PG8_SCHED;
            PG8_LDA(At, 1, 1); PG8_STAGE(PG8_SB(1, 0), b3, voffBn); PG8_STAGE(PG8_SB(1, 1), b3 + hBn, voffBn); PG8_STAGE(PG8_SA(1, 0), a3, voffAn);
            PG8_WAIT_V(8); PG8_WAIT_L(0); PG8_BAR; PG8_MMA(1, 0, At, B0); PG8_MMA(1, 1, At, B1); PG8_BAR; PG8_SCHED;
        }
        if (wr == 0) PG8_BAR;
        E(acc, cur, kind, wr, wc, fr, fq);
        if (!has_next) break;
#pragma unroll
        for (int a = 0; a < 2; ++a)
#pragma unroll
            for (int b = 0; b < 2; ++b)
#pragma unroll
                for (int m = 0; m < 4; ++m)
#pragma unroll
                    for (int n = 0; n < 2; ++n) acc[a][b][m][n] = (f32x4){0.f, 0.f, 0.f, 0.f};
        cA = nA; cB = nB; kind = 1; PG8_MKOFF(voffA, voffB, g1); hA = hA1; hB = hB1;
        if (wr == 1) PG8_BAR;
    }
    PG8_WAIT_V(0);
    PG8_BAR;
#undef PG8_SA
#undef PG8_SB
#undef PG8_STAGE
#undef PG8_LDA
#undef PG8_LDB
#undef PG8_MMA
#undef PG8_WAIT_V
#undef PG8_WAIT_L
#undef PG8_BAR
#undef PG8_SCHED
#undef PG8_MKOFF
}
}

typedef f32x4 Acc[2][2][4][2];
__device__ __forceinline__ u32x4 pack8(f32x4 a, f32x4 b) { u32x4 w; w.x = cvtpk(a[0], a[1]); w.y = cvtpk(a[2], a[3]); w.z = cvtpk(b[0], b[1]); w.w = cvtpk(b[2], b[3]); return w; }
__device__ __forceinline__ void unpack8(u32x4 w, f32x4& a, f32x4& b) { a = (f32x4){bflo(w.x), bfhi(w.x), bflo(w.y), bfhi(w.y)}; b = (f32x4){bflo(w.z), bfhi(w.z), bflo(w.w), bfhi(w.w)}; }

struct EpiInProj {
    unsigned char* ws; bf16_t* gm; const float* bmerge;
    __device__ __forceinline__ void operator()(const Acc& acc, const pg8::Unit& u, int wr, int wc, int fr, int fq) const {
        const int pn = u.pn;
        bf16_t* dst; int ldc, cb, mode; size_t bjs = 128; unsigned char* dst8 = nullptr;
        if (pn < 4)       { dst = (bf16_t*)(ws + WS_U);   ldc = 1024; cb = pn * 256;        mode = 0; }
        else if (pn < 8)  { dst = (bf16_t*)(ws + WS_GP);  ldc = 1024; cb = (pn - 4) * 256;  mode = 1; }
        else if (pn < 16) { dst = (bf16_t*)(ws + WS_Q);   ldc = 2048; cb = (pn - 8) * 256;  mode = 3; dst8 = ws + WS_Q8; }
        else if (pn < 28) { const int k = (pn - 16) >> 1; dst = (bf16_t*)(ws + WS_KCR + (size_t)k * (8 * MiB)); ldc = 512; cb = ((pn - 16) & 1) * 256; mode = (k == 2 || k == 4) ? 3 : 0;
                            if (k < 2) { ldc = 128; cb = 0; bjs = (size_t)S * 128; dst += (size_t)((pn - 16) & 1) * 2 * S * 128; }
                            else { dst8 = ws + (k == 2 ? WS_K8S : k == 3 ? WS_V8S : k == 4 ? WS_K8W : WS_V8W); dst = nullptr; } }
        else if (pn < 36) { dst = (bf16_t*)(ws + WS_GN);  ldc = 2048; cb = (pn - 28) * 256; mode = 1; }
        else if (pn < 52) { dst = gm;                     ldc = 4096; cb = (pn - 36) * 256; mode = 2; }
        else              { dst = (bf16_t*)(ws + WS_GBR); ldc = 256;  cb = 0;               mode = 4; }
        const int row0 = u.pm * 256 + wr * 64 + fr, cl = wc * 32 + 8 * fq, col0 = cb + cl;
        const float* rcos = (const float*)(ws + WS_ROPE); const float* rsin = rcos + (size_t)S * 64;
#pragma unroll
        for (int ai = 0; ai < 2; ++ai)
#pragma unroll
            for (int m = 0; m < 4; ++m) {
                const int row = row0 + ai * 128 + m * 16;
                bf16_t* rowp = dst + (size_t)row * ldc + col0;
                f32x4 cs0, cs1, sn0, sn1;
                if (mode == 3) { const int i0 = (cl & 127) >> 1; cs0 = *(const f32x4*)(rcos + (size_t)row * 64 + i0); sn0 = *(const f32x4*)(rsin + (size_t)row * 64 + i0); }
#pragma unroll
                for (int bj = 0; bj < 2; ++bj) {
                    f32x4 v0 = acc[ai][bj][m][0], v1 = acc[ai][bj][m][1];
                    if (mode == 1) { for (int e = 0; e < 4; ++e) { v0[e] = siluf_(v0[e]); v1[e] = siluf_(v1[e]); } }
                    else if (mode == 2 || mode == 4) { if (mode == 2) { v0 = v0 + *(const f32x4*)(bmerge + col0 + bj * 128); v1 = v1 + *(const f32x4*)(bmerge + col0 + bj * 128 + 4); } for (int e = 0; e < 4; ++e) { v0[e] = sigmoidf_(v0[e]); v1[e] = sigmoidf_(v1[e]); } }
                    else if (mode == 3) {
                        f32x4 o0, o1;
                        o0[0] = v0[0] * cs0[0] - v0[1] * sn0[0]; o0[1] = v0[1] * cs0[0] + v0[0] * sn0[0];
                        o0[2] = v0[2] * cs0[1] - v0[3] * sn0[1]; o0[3] = v0[3] * cs0[1] + v0[2] * sn0[1];
                        o1[0] = v1[0] * cs0[2] - v1[1] * sn0[2]; o1[1] = v1[1] * cs0[2] + v1[0] * sn0[2];
                        o1[2] = v1[2] * cs0[3] - v1[3] * sn0[3]; o1[3] = v1[3] * cs0[3] + v1[2] * sn0[3];
                        v0 = o0; v1 = o1;
                    }
                    if (dst) *(u32x4*)(rowp + bj * bjs) = pack8(v0, v1);
                    if (dst8) { u32x2 w8; w8.x = cvt4_fp8(v0[0], v0[1], v0[2], v0[3]); w8.y = cvt4_fp8(v1[0], v1[1], v1[2], v1[3]); *(u32x2*)(dst8 + (size_t)row * ldc + col0 + bj * 128) = w8; }
                }
            }
    }
};
struct EpiYa {
    bf16_t* yag; const bf16_t* gm;
    __device__ __forceinline__ void operator()(const Acc& acc, const pg8::Unit& u, int wr, int wc, int fr, int fq) const {
        const int row0 = u.pm * 256 + wr * 64 + fr, col0 = u.pn * 256 + wc * 32 + 8 * fq;
#pragma unroll
        for (int ai = 0; ai < 2; ++ai)
#pragma unroll
            for (int m = 0; m < 4; ++m) { int ro_ = ai * 128 + m * 16; asm volatile("" : "+v"(ro_)); const size_t r = (size_t)(row0 + ro_);
#pragma unroll
                for (int bj = 0; bj < 2; ++bj) { f32x4 g0, g1; unpack8(*(const u32x4*)(gm + r * 4096 + col0 + bj * 128), g0, g1);
                    *(u32x4*)(yag + r * 2048 + col0 + bj * 128) = pack8(acc[ai][bj][m][0] * g0, acc[ai][bj][m][1] * g1); } }
    }
};
struct EpiYb {
    bf16_t* merged; const bf16_t* yag; const bf16_t* gm;
    __device__ __forceinline__ void operator()(const Acc& acc, const pg8::Unit& u, int wr, int wc, int fr, int fq) const {
        const int row0 = u.pm * 256 + wr * 64 + fr, col0 = u.pn * 256 + wc * 32 + 8 * fq;
#pragma unroll
        for (int ai = 0; ai < 2; ++ai)
#pragma unroll
            for (int m = 0; m < 4; ++m) { int ro_ = ai * 128 + m * 16; asm volatile("" : "+v"(ro_)); const size_t r = (size_t)(row0 + ro_);
#pragma unroll
                for (int bj = 0; bj < 2; ++bj) { f32x4 g0, g1, y0, y1; unpack8(*(const u32x4*)(gm + r * 4096 + 2048 + col0 + bj * 128), g0, g1);
                    unpack8(*(const u32x4*)(yag + r * 2048 + col0 + bj * 128), y0, y1);
                    *(u32x4*)(merged + r * 2048 + col0 + bj * 128) = pack8(y0 + acc[ai][bj][m][0] * g0, y1 + acc[ai][bj][m][1] * g1); } }
    }
};
struct EpiYaYb {
    EpiYa ya; EpiYb yb;
    __device__ __forceinline__ void operator()(const Acc& acc, const pg8::Unit& u, int kind, int wr, int wc, int fr, int fq) const {
        if (kind == 0) { ya(acc, u, wr, wc, fr, fq); asm volatile("s_waitcnt vmcnt(0)" ::: "memory"); } else yb(acc, u, wr, wc, fr, fq);
    }
};
constexpr int NSPLIT = 8;
struct EpiSlab {
    float* slab;
    __device__ __forceinline__ void operator()(const Acc& acc, const pg8::Unit& u, int wr, int wc, int fr, int fq) const {
        float* base = slab + ((size_t)((u.pm >> 3) * NSPLIT + u.pn) * 2048 + (size_t)(u.pm & 7) * 256 + wr * 64 + fr) * 256 + wc * 32 + 8 * fq;
#pragma unroll
        for (int ai = 0; ai < 2; ++ai)
#pragma unroll
            for (int m = 0; m < 4; ++m)
#pragma unroll
                for (int bj = 0; bj < 2; ++bj) { float* p = base + (size_t)(ai * 128 + m * 16) * 256 + bj * 128; *(f32x4*)p = acc[ai][bj][m][0]; *(f32x4*)(p + 4) = acc[ai][bj][m][1]; }
    }
};
constexpr int CW_PANEL = 16384;
constexpr int EPI_LDS_OFF = RING_BYTES + 1024;
struct EpiOut {
    float* out; const float* x; float* ssq; const float* fw; unsigned* ctl; LAS unsigned char* lds;
    __device__ __forceinline__ void operator()(const Acc& acc_, const pg8::Unit& u, int wr, int wc, int fr, int fq) const {
        Acc& acc = const_cast<Acc&>(acc_);
        const int tid = otid();
        const int row0 = u.pm * 256 + wr * 64 + fr, col0 = u.pn * 256 + wc * 32 + 8 * fq;
        LAS float* rs = (LAS float*)(lds + EPI_LDS_OFF);
#pragma unroll
        for (int ai = 0; ai < 2; ++ai)
#pragma unroll
            for (int m = 0; m < 4; ++m) { const size_t r = (size_t)(row0 + ai * 128 + m * 16); float q = 0.f;
#pragma unroll
                for (int bj = 0; bj < 2; ++bj)
#pragma unroll
                    for (int n = 0; n < 2; ++n) { const size_t o = r * 2048 + col0 + bj * 128 + 4 * n; const f32x4 v = *(const f32x4*)(x + o) + acc[ai][bj][m][n];
                        acc[ai][bj][m][n] = v; q += (v[0] * v[0] + v[1] * v[1]) + (v[2] * v[2] + v[3] * v[3]); }
                q += __shfl_xor(q, 16); q += __shfl_xor(q, 32);
                if (fq == 0) __hip_atomic_store((unsigned*)(ssq + (size_t)(u.pn * 4 + wc) * S + r), __float_as_uint(q), __ATOMIC_RELAXED, __HIP_MEMORY_SCOPE_AGENT); }
        asm volatile("s_waitcnt vmcnt(0)" ::: "memory");
        __syncthreads();
        if (tid == 0) { unsigned* c = ctl + CW_PANEL + 64 * u.pm;
            __hip_atomic_fetch_add(c, 1u, __ATOMIC_RELAXED, __HIP_MEMORY_SCOPE_AGENT);
            unsigned sp = 0; while (__hip_atomic_load(c, __ATOMIC_RELAXED, __HIP_MEMORY_SCOPE_AGENT) < 8u) { __builtin_amdgcn_s_sleep(2); if (++sp > (1u << 22)) break; }
            __builtin_amdgcn_fence(__ATOMIC_ACQUIRE, "agent"); asm volatile("s_waitcnt vmcnt(0)" ::: "memory"); }
        __syncthreads();
        if (tid < 256) { const size_t r = (size_t)u.pm * 256 + tid; float s = 0.f;
#pragma unroll 8
            for (int p = 0; p < 32; ++p) s += __uint_as_float(__hip_atomic_load((unsigned*)(ssq + (size_t)p * S + r), __ATOMIC_RELAXED, __HIP_MEMORY_SCOPE_AGENT));
            rs[tid] = 1.0f / sqrtf(s * (1.f / DM) + EPS); }
        __syncthreads();
#pragma unroll
        for (int ai = 0; ai < 2; ++ai)
#pragma unroll
            for (int m = 0; m < 4; ++m) { const int rl = wr * 64 + fr + ai * 128 + m * 16; const float sc = rs[rl]; const size_t r = (size_t)u.pm * 256 + rl;
#pragma unroll
                for (int bj = 0; bj < 2; ++bj)
#pragma unroll
                    for (int n = 0; n < 2; ++n) { const size_t o = r * 2048 + col0 + bj * 128 + 4 * n; *(f32x4*)(out + o) = acc[ai][bj][m][n] * sc * *(const f32x4*)(fw + col0 + bj * 128 + 4 * n); } }
    }
};

struct Args { const float* in[17]; float* out; unsigned char* ws; int ph_lo, ph_hi; };
struct Frame { LAS unsigned char* lds; int tid, lane, wave, vcu, G; };

__device__ __forceinline__ int ropeperm(int d) { return d < 64 ? 2 * d : 2 * (d - 64) + 1; }
__device__ __forceinline__ void transpose_item(const float* W, int ldw, int Nvalid, bf16_t* WT, int ldt, int row_off, bool perm, LAS float* scr, int kb, int nb, int lane) {
    const int k0 = 64 * kb, n0 = 32 * nb, cq = lane & 7, rb = lane >> 3; const bool ok = n0 + cq * 4 < Nvalid;
    f32x4 v[8];
#pragma unroll
    for (int i = 0; i < 8; ++i) v[i] = ok ? *(const f32x4*)(W + (size_t)(k0 + i * 8 + rb) * ldw + n0 + cq * 4) : (f32x4){0.f, 0.f, 0.f, 0.f};
#pragma unroll
    for (int i = 0; i < 8; ++i) *(LAS f32x4*)(scr + (i * 8 + rb) * 32 + ((cq ^ i) << 2)) = v[i];
    LDS_WAIT(); asm volatile("" ::: "memory");
#pragma unroll
    for (int j = 0; j < 4; ++j) { const int idx = lane + 64 * j, n = idx >> 3, c = idx & 7; const LAS float* s = scr + (8 * c) * 32 + ((((n >> 2) ^ c) << 2) | (n & 3));
        u32x4 o; o.x = cvtpk(s[0 * 32], s[1 * 32]); o.y = cvtpk(s[2 * 32], s[3 * 32]); o.z = cvtpk(s[4 * 32], s[5 * 32]); o.w = cvtpk(s[6 * 32], s[7 * 32]);
        const int ng = n0 + n;
        if (ng < Nvalid) { const int dr = perm ? ((ng & ~127) | ropeperm(ng & 127)) : ng; *(GAS u32x4*)(WT + (size_t)(row_off + dr) * ldt + k0 + 8 * c) = o; } }
    LDS_WAIT(); asm volatile("" ::: "memory");
}

__device__ __forceinline__ void p0_prologue(const Frame& F, const Args& a) {
    unsigned char* ws = a.ws;
    LAS float* scr = (LAS float*)(F.lds + F.wave * 8192);
    const int gw = F.vcu * NWAVES + F.wave, NGW = F.G * NWAVES, lane = F.lane;
    constexpr int I_WIN = 32 * 258, I_WM = 32 * 128;
    for (int it = gw; it < I_WIN + I_WM; it += NGW) {
        int r = it;
        if (r < I_WIN) { const int kb = r / 258, nb = 32 + r % 258, n0 = nb * 32;
            const bool perm = (n0 >= 2048 && n0 < 4096) || (n0 >= 5120 && n0 < 5632) || (n0 >= 6144 && n0 < 6656);
            transpose_item(a.in[2], 9264, 9264, (bf16_t*)(ws + WS_WCAT), 2048, nb >= 288 ? 4096 : 0, perm, scr, kb, nb, lane); continue; } r -= I_WIN;
        transpose_item(a.in[13], 4096, 4096, (bf16_t*)(ws + WS_WCAT), 2048, 9216, false, scr, r / 128, r % 128, lane);
    }
    {
        const float* win = a.in[2]; const float* mix = a.in[3]; bf16_t* WC = (bf16_t*)(ws + WS_WCAT); const int r = lane & 31, hh = lane >> 5;
        for (int it = gw; it < 1024; it += NGW) {
            const int g = it >> 8, d0 = ((it >> 5) & 7) * 32, kin0 = (it & 31) * 64;
            f32x16 acc0 = f32x16{}, acc1 = f32x16{};
            const float* ap = mix + (size_t)g * 65536 + (size_t)(8 * hh) * 256 + d0 + r;
            const float* bp0 = win + (size_t)(kin0 + r) * 9264 + g * 256 + 8 * hh; const float* bp1 = bp0 + (size_t)32 * 9264;
#pragma unroll 4
            for (int k = 0; k < 16; ++k) {
                f32x4 a0, a1;
#pragma unroll
                for (int j = 0; j < 4; ++j) { a0[j] = ap[(size_t)(k * 16 + j) * 256]; a1[j] = ap[(size_t)(k * 16 + 4 + j) * 256]; }
                const u32x4 af = pack8(a0, a1), b0 = pack8(*(const f32x4*)(bp0 + k * 16), *(const f32x4*)(bp0 + k * 16 + 4)), b1 = pack8(*(const f32x4*)(bp1 + k * 16), *(const f32x4*)(bp1 + k * 16 + 4));
                acc0 = __builtin_amdgcn_mfma_f32_32x32x16_bf16(__builtin_bit_cast(bf16x8, af), __builtin_bit_cast(bf16x8, b0), acc0, 0, 0, 0);
                acc1 = __builtin_amdgcn_mfma_f32_32x32x16_bf16(__builtin_bit_cast(bf16x8, af), __builtin_bit_cast(bf16x8, b1), acc1, 0, 0, 0);
            }
#pragma unroll
            for (int e = 0; e < 16; ++e) { int ee = e; asm volatile("" : "+v"(ee)); bf16_t* rowp = WC + (size_t)(g * 256 + d0 + crow(ee, hh)) * 2048 + kin0 + r;
                const float v0 = acc0[e], v1 = acc1[e], n0_ = dpp_x1f(v0), n1_ = dpp_x1f(v1);
                if ((r & 1) == 0) { *(unsigned*)rowp = cvtpk(v0, n0_); *(unsigned*)(rowp + 32) = cvtpk(v1, n1_); } }
        }
    }
    for (int i = gw * 64 + lane; i < 53248; i += NGW * 64) *(GAS u32x4*)(ws + WS_WCAT + (size_t)13360 * 4096 + (size_t)i * 16) = (u32x4){0u, 0u, 0u, 0u};
    {
        const float* x = a.in[0]; const float* nw = a.in[1]; bf16_t* H = (bf16_t*)(ws + WS_H);
        f32x4 wv[8];
#pragma unroll
        for (int j = 0; j < 8; ++j) wv[j] = *((const f32x4*)nw + lane + 64 * j);
        for (int m = gw; m < S; m += NGW) {
            const f32x4* xr = (const f32x4*)(x + (size_t)m * DM) + lane; f32x4 v[8]; float s = 0.f;
#pragma unroll
            for (int j = 0; j < 8; ++j) { v[j] = xr[64 * j]; s += (v[j][0] * v[j][0] + v[j][1] * v[j][1]) + (v[j][2] * v[j][2] + v[j][3] * v[j][3]); }
            const float rstd = 1.0f / sqrtf(wave_sum(s) * (1.f / DM) + EPS);
            u32x2* o = (u32x2*)(H + (size_t)m * DM) + lane;
#pragma unroll
            for (int j = 0; j < 8; ++j) { const f32x4 y = v[j] * rstd * wv[j]; u32x2 w; w.x = cvtpk(y[0], y[1]); w.y = cvtpk(y[2], y[3]); o[64 * j] = w; }
        }
    }
    {
        float* rcos = (float*)(ws + WS_ROPE); float* rsin = rcos + (size_t)S * 64;
        for (int e = gw * 64 + lane; e < S * 64; e += NGW * 64) {
            const int pos = e >> 6, i = e & 63;
            double inv = 1.0, b = 0.86596432336006535;
            for (int k = i; k; k >>= 1) { if (k & 1) inv *= b; b *= b; }
            const double t = (double)pos * inv * 0.15915494309189535;
            const float fr = (float)(t - floor(t));
            rcos[e] = __builtin_amdgcn_cosf(fr); rsin[e] = __builtin_amdgcn_sinf(fr);
        }
    }
}
__device__ __forceinline__ void p1_late_weights(const Frame& F, const Args& a, int cw, int NCW) {
    unsigned char* ws = a.ws;
    LAS float* scr = (LAS float*)(F.lds + F.wave * 8192);
    const int lane = F.lane;
    constexpr int I_NO = 32 * 64, I_O = 32 * 64, I_PO = 16 * 64, I_W1 = 64 * 8, I_W2 = 4 * 4, I_B1 = 512;
    constexpr int NITEMS = I_NO + I_O + I_PO + 2 * I_W1 + 2 * I_W2 + I_B1;
    for (int it = cw; it < NITEMS; it += NCW) {
        int r = it;
        if (r < I_W1) { transpose_item(a.in[6], 256, 256, (bf16_t*)(ws + WS_W1KT), 4096, 0, false, scr, r / 8, r % 8, lane); continue; } r -= I_W1;
        if (r < I_W1) { transpose_item(a.in[9], 256, 256, (bf16_t*)(ws + WS_W1VT), 4096, 0, false, scr, r / 8, r % 8, lane); continue; } r -= I_W1;
        if (r < I_B1) {
            const int which = r >> 8, fb = (r >> 6) & 3, ch = r & 63, f = fb * 64 + lane;
            const float* pe = a.in[which ? 8 : 5]; const float* w1 = a.in[which ? 9 : 6]; float s = 0.f;
#pragma unroll 16
            for (int k = ch * 64; k < ch * 64 + 64; ++k) s += pe[k] * w1[(size_t)k * 256 + f];
            ((float*)(ws + WS_B1P))[(which * 64 + ch) * 256 + f] = s; continue; } r -= I_B1;
        if (r < I_W2) { transpose_item(a.in[7], 128, 128, (bf16_t*)(ws + WS_W2KT), 256, 0, true, scr, r / 4, r % 4, lane); continue; } r -= I_W2;
        if (r < I_W2) { transpose_item(a.in[10], 128, 128, (bf16_t*)(ws + WS_W2VT), 256, 0, false, scr, r / 4, r % 4, lane); continue; } r -= I_W2;
        if (r < I_PO) { transpose_item(a.in[11], 2048, 2048, (bf16_t*)(ws + WS_WPOT), 1024, 0, false, scr, r / 64, r % 64, lane); continue; } r -= I_PO;
        if (r < I_NO) { transpose_item(a.in[12], 2048, 2048, (bf16_t*)(ws + WS_WNOT), 2048, 0, false, scr, r / 64, r % 64, lane); continue; } r -= I_NO;
        transpose_item(a.in[15], 2048, 2048, (bf16_t*)(ws + WS_WOT), 2048, 0, false, scr, r / 64, r % 64, lane);
    }
}

template <int W>
__device__ __forceinline__ void ypool_item(const bf16_t* __restrict__ U, const bf16_t* __restrict__ GP, bf16_t* __restrict__ Y, const float* __restrict__ scale, int c, int t0) {
    u32x4 x[W + 7], gq[8];
#pragma unroll
    for (int k = 0; k < W + 7; ++k) { const int r = t0 - (W - 1) + k; x[k] = r >= 0 ? *(const u32x4*)(U + (size_t)r * 1024 + c) : (u32x4){0u, 0u, 0u, 0u}; }
#pragma unroll
    for (int k = 0; k < 8; ++k) gq[k] = *(const u32x4*)(GP + (size_t)(t0 + k) * 1024 + c);
    const f32x4 sc0 = *(const f32x4*)(scale + c), sc1 = *(const f32x4*)(scale + c + 4);
    f32x4 s0 = {0.f, 0.f, 0.f, 0.f}, s1 = s0, a0, a1;
#pragma unroll
    for (int k = 0; k < W - 1; ++k) { unpack8(x[k], a0, a1); s0 = s0 + a0; s1 = s1 + a1; }
#pragma unroll
    for (int k = 0; k < 8; ++k) { const int t = t0 + k;
        unpack8(x[W - 1 + k], a0, a1); s0 = s0 + a0; s1 = s1 + a1;
        const int cnt = (t + 1 < W) ? t + 1 : W; const float ic = 1.0f / (float)cnt;
        f32x4 g0, g1; unpack8(gq[k], g0, g1);
        *(u32x4*)(Y + (size_t)t * 1024 + c) = pack8((s0 * ic - a0) * sc0 * g0, (s1 * ic - a1) * sc1 * g1);
        f32x4 b0, b1; unpack8(x[k], b0, b1); s0 = s0 - b0; s1 = s1 - b1; }
}
__device__ __forceinline__ void p2_ypool(const Frame& F, unsigned char* ws, const float* __restrict__ scale, int cw, int NCW) {
    const bf16_t* __restrict__ U = (const bf16_t*)(ws + WS_U); const bf16_t* __restrict__ GP = (const bf16_t*)(ws + WS_GP); bf16_t* __restrict__ Y = (bf16_t*)(ws + WS_H + 16 * MiB);
    for (int wi = cw; wi < 4 * 512; wi += NCW) {
        const int g = wi & 3, t0 = ((wi >> 2) * 2 + (F.lane >> 5)) * 8, c = (g * 32 + (F.lane & 31)) * 8;
        if (g == 0) ypool_item<2>(U, GP, Y, scale, c, t0); else if (g == 1) ypool_item<4>(U, GP, Y, scale, c, t0);
        else if (g == 2) ypool_item<8>(U, GP, Y, scale, c, t0); else ypool_item<16>(U, GP, Y, scale, c, t0);
    }
}
__device__ __forceinline__ void p2_vt8(const Frame& F, unsigned char* ws, int cw, int NCW) {
    const int lane = F.lane;
    for (int it = cw; it < 1024; it += NCW) {
        const int which = it >> 9, h = (it >> 7) & 3, j = it & 127;
        const unsigned char* V8 = ws + (which ? WS_V8W : WS_V8S) + (size_t)(64 * j) * 512 + h * 128 + 2 * lane;
        unsigned char* T = ws + (which ? WS_V8TW : WS_V8TS) + (size_t)(h * 128 + j) * 8192 + (size_t)(2 * lane) * 64;
#pragma unroll
        for (int hb = 0; hb < 2; ++hb) {
            unsigned short e[32];
#pragma unroll
            for (int jj = 0; jj < 32; ++jj) { const int key = jj < 16 ? crow(jj, hb) : 32 + crow(jj - 16, hb); e[jj] = *(const unsigned short*)(V8 + (size_t)key * 512); }
            u32x4 a0, a1, b0, b1;
#pragma unroll
            for (int q = 0; q < 4; ++q) {
                a0[q] = (unsigned)(e[4*q] & 0xff) | ((unsigned)(e[4*q+1] & 0xff) << 8) | ((unsigned)(e[4*q+2] & 0xff) << 16) | ((unsigned)(e[4*q+3] & 0xff) << 24);
                a1[q] = (unsigned)(e[16+4*q] & 0xff) | ((unsigned)(e[16+4*q+1] & 0xff) << 8) | ((unsigned)(e[16+4*q+2] & 0xff) << 16) | ((unsigned)(e[16+4*q+3] & 0xff) << 24);
                b0[q] = (unsigned)(e[4*q] >> 8) | ((unsigned)(e[4*q+1] >> 8) << 8) | ((unsigned)(e[4*q+2] >> 8) << 16) | ((unsigned)(e[4*q+3] >> 8) << 24);
                b1[q] = (unsigned)(e[16+4*q] >> 8) | ((unsigned)(e[16+4*q+1] >> 8) << 8) | ((unsigned)(e[16+4*q+2] >> 8) << 16) | ((unsigned)(e[16+4*q+3] >> 8) << 24); }
            *(u32x4*)(T + hb * 32) = a0; *(u32x4*)(T + hb * 32 + 16) = a1; *(u32x4*)(T + 64 + hb * 32) = b0; *(u32x4*)(T + 64 + hb * 32 + 16) = b1;
        }
    }
}

__device__ __forceinline__ void p3_compress2(const Frame& F, unsigned char* ws, int cwg, int NCWG) {
    const int tid = F.tid, lane = F.lane, r = lane & 31, hh = lane >> 5, wave = F.wave;
    const float* rcos = (const float*)(ws + WS_ROPE); const float* rsin = rcos + (size_t)S * 64;
    LAS bf16_t* hl = (LAS bf16_t*)F.lds;
    for (int it = cwg; it < 128; it += NCWG) {
        const int which = it >> 6, rt = it & 63;
        { const int row = tid >> 4, f0 = (tid & 15) * 16;
          const float* sl = (const float*)(ws + WS_SLAB) + ((size_t)(which * NSPLIT) * 2048 + rt * 32 + row) * 256 + f0; const float* b1 = (const float*)(ws + WS_B1) + which * 256 + f0;
          f32x4 s[4];
#pragma unroll
          for (int q = 0; q < 4; ++q) s[q] = *(const f32x4*)(b1 + 4 * q);
#pragma unroll
          for (int ks = 0; ks < NSPLIT; ++ks)
#pragma unroll
              for (int q = 0; q < 4; ++q) s[q] = s[q] + *(const f32x4*)(sl + (size_t)ks * 2048 * 256 + 4 * q);
#pragma unroll
          for (int q = 0; q < 4; ++q)
#pragma unroll
              for (int e = 0; e < 4; ++e) s[q][e] = siluf_(s[q][e]);
          *(LAS u32x4*)(hl + row * 264 + f0) = pack8(s[0], s[1]); *(LAS u32x4*)(hl + row * 264 + f0 + 8) = pack8(s[2], s[3]); }
        __syncthreads();
        if (wave < 4) {
            const int ct = wave, row = rt * 32 + r;
            const bf16_t* W2 = (const bf16_t*)(ws + (which ? WS_W2VT : WS_W2KT)) + (size_t)(ct * 32 + r) * 256 + hh * 8;
            f32x16 acc = f32x16{};
#pragma unroll 4
            for (int k = 0; k < 16; ++k) acc = __builtin_amdgcn_mfma_f32_32x32x16_bf16(*(const bf16x8*)(W2 + k * 16), *(const LAS bf16x8*)(hl + r * 264 + k * 16 + hh * 8), acc, 0, 0, 0);
            const int n = row & 511; bf16_t* dst = (bf16_t*)(ws + (which ? WS_VC : WS_KC)) + (size_t)row * 128 + ct * 32 + 4 * hh;
            const int pos = (16 * n + 31) > S - 1 ? S - 1 : 16 * n + 31;
#pragma unroll
            for (int gq = 0; gq < 4; ++gq) {
                float v0 = acc[4 * gq], v1 = acc[4 * gq + 1], v2 = acc[4 * gq + 2], v3 = acc[4 * gq + 3];
                if (which == 0) { const int i = (ct * 32 + 8 * gq + 4 * hh) >> 1; const float c0 = rcos[(size_t)pos * 64 + i], s0 = rsin[(size_t)pos * 64 + i], c1 = rcos[(size_t)pos * 64 + i + 1], s1 = rsin[(size_t)pos * 64 + i + 1];
                    const float o0 = v0 * c0 - v1 * s0, o1 = v1 * c0 + v0 * s0, o2 = v2 * c1 - v3 * s1, o3 = v3 * c1 + v2 * s1; v0 = o0; v1 = o1; v2 = o2; v3 = o3; }
                u32x2 w; w.x = cvtpk(v0, v1); w.y = cvtpk(v2, v3); if (n == 511) { w.x = 0u; w.y = 0u; }
                *(u32x2*)(dst + 8 * gq) = w;
            }
        }
        __syncthreads();
    }
}

namespace nsa {
constexpr int SHM_V = 16384, SHM_K = 16384;
constexpr int L_V = 0, L_K = 3 * SHM_V, L_WS = L_K + 2 * SHM_K, L_IMP = L_WS + NWAVES * 64 * 4, IMP_LD = 129, L_SELM = L_IMP + 64 * IMP_LD * 4, L_END = L_SELM + 64 * 8 * 2;
static_assert(L_END <= RING_BYTES, "attention LDS");
constexpr float SCALE = 0.08838834764831845f, C2 = 1.4426950408889634f * SCALE, THR = 8.f;
#define KSWZ(row, colB) ((row) * 256 + ((colB) ^ (((row) & 7) << 4)))
#define SBAR() __builtin_amdgcn_sched_barrier(0)
#define LADD(p, v) (void)__hip_atomic_fetch_add((p), (v), __ATOMIC_RELAXED, __HIP_MEMORY_SCOPE_WORKGROUP)
__device__ __forceinline__ int v_st(int k, int c) { const int kk = (k & ~0xC) | ((k & 4) << 1) | ((k & 8) >> 1); return ((kk >> 3) * 4 + (c >> 5)) * 512 + ((kk & 7) * 32 + (c & 31)) * 2; }
__device__ __forceinline__ int v_rd_base(int lane) { return ((lane & 3) << 3) | (((lane >> 2) & 3) << 6) | (((lane >> 4) & 1) << 5) | (((lane >> 5) & 1) << 8); }
constexpr int v_rd_off(int d0, int ks, int half) { return d0 * 512 + ks * 4096 + half * 2048; }
__device__ __forceinline__ unsigned cvtpk_a(float lo, float hi) { unsigned r; asm volatile("v_cvt_pk_bf16_f32 %0, %1, %2" : "=v"(r) : "v"(lo), "v"(hi)); return r; }

__device__ __forceinline__ void mask_range(f32x16& p0, f32x16& p1, int dq, unsigned Wn) {
    const float NEG = -__builtin_inff();
#pragma unroll
    for (int r = 0; r < 16; ++r) { const int c = (r & 3) + 8 * (r >> 2);
        if ((unsigned)(dq + c) >= Wn) p0[r] = NEG;
        if ((unsigned)(dq + c + 32) >= Wn) p1[r] = NEG; }
}
__device__ __forceinline__ void mask_row(f32x16& p0, f32x16& p1, bool keep) {
    const float NEG = -__builtin_inff();
#pragma unroll
    for (int r = 0; r < 16; ++r) { p0[r] = keep ? p0[r] : NEG; p1[r] = keep ? p1[r] : NEG; }
}
__device__ __forceinline__ float rowmax32(const f32x16& p0, const f32x16& p1) {
    float pmax = p0[0];
#pragma unroll
    for (int r = 1; r < 16; ++r) pmax = fmaxf(pmax, p0[r]);
#pragma unroll
    for (int r = 0; r < 16; ++r) pmax = fmaxf(pmax, p1[r]);
    auto rr = __builtin_amdgcn_permlane32_swap(__float_as_uint(pmax), __float_as_uint(pmax), false, false);
    return fmaxf(__uint_as_float(rr[0]), __uint_as_float(rr[1]));
}
__device__ __forceinline__ float rowsum32(const f32x16& p0, const f32x16& p1) {
    float ps = 0.f;
#pragma unroll
    for (int r = 0; r < 16; ++r) ps += p0[r];
#pragma unroll
    for (int r = 0; r < 16; ++r) ps += p1[r];
    auto rr = __builtin_amdgcn_permlane32_swap(__float_as_uint(ps), __float_as_uint(ps), false, false);
    return __uint_as_float(rr[0]) + __uint_as_float(rr[1]);
}
__device__ __forceinline__ void pack_p(const f32x16& p0, const f32x16& p1, bf16x8& pa0, bf16x8& pa1, bf16x8& pa2, bf16x8& pa3) {
#define PK4(P, B_, OUT) do { unsigned a0 = cvtpk_a(P[B_+0], P[B_+1]), a1 = cvtpk_a(P[B_+2], P[B_+3]);                          \
        unsigned b0 = cvtpk_a(P[B_+4], P[B_+5]), b1 = cvtpk_a(P[B_+6], P[B_+7]);                                             \
        auto r0 = __builtin_amdgcn_permlane32_swap(a0, b0, false, false); auto r1 = __builtin_amdgcn_permlane32_swap(a1, b1, false, false); \
        u32x4 w = {r0[0], r1[0], r0[1], r1[1]}; OUT = __builtin_bit_cast(bf16x8, w); } while (0)
    PK4(p0, 0, pa0); PK4(p0, 8, pa1); PK4(p1, 0, pa2); PK4(p1, 8, pa3);
#undef PK4
}
__device__ __forceinline__ void qkt(f32x16& p0, f32x16& p1, const LAS unsigned char* K_buf, int r32, int hi, const bf16x8* qr) {
    p0 = f32x16{}; p1 = f32x16{};
    const LAS unsigned char* kb[4];
#pragma unroll
    for (int dd = 0; dd < 4; ++dd) kb[dd] = K_buf + KSWZ(r32, (dd * 16 + hi * 8) * 2);
#define KLD(F, d0) do { const LAS unsigned char* a_ = kb[(d0) & 3] + ((d0) >> 2) * 128; F##0 = *(const LAS bf16x8*)(a_); F##1 = *(const LAS bf16x8*)(a_ + 32 * 256); \
        const LAS unsigned char* c_ = kb[((d0) + 1) & 3] + (((d0) + 1) >> 2) * 128; F##2 = *(const LAS bf16x8*)(c_); F##3 = *(const LAS bf16x8*)(c_ + 32 * 256); } while (0)
#define KMM(F, d0) do { p0 = __builtin_amdgcn_mfma_f32_32x32x16_bf16(F##0, qr[d0], p0, 0, 0, 0); p1 = __builtin_amdgcn_mfma_f32_32x32x16_bf16(F##1, qr[d0], p1, 0, 0, 0); \
        p0 = __builtin_amdgcn_mfma_f32_32x32x16_bf16(F##2, qr[(d0) + 1], p0, 0, 0, 0); p1 = __builtin_amdgcn_mfma_f32_32x32x16_bf16(F##3, qr[(d0) + 1], p1, 0, 0, 0); } while (0)
    bf16x8 fa0, fa1, fa2, fa3, fb0, fb1, fb2, fb3;
    KLD(fa, 0); KLD(fb, 2); SBAR();
    KMM(fa, 0); KLD(fa, 4); SBAR();
    KMM(fb, 2); KLD(fb, 6); SBAR();
    KMM(fa, 4); SBAR();
    KMM(fb, 6);
#undef KLD
#undef KMM
}
struct VF8 { s16x4 l0, h0, l1, h1, l2, h2, l3, h3; };
#define TRRD(dst, off) asm volatile("ds_read_b64_tr_b16 %0, %1 offset:%2" : "=&v"(dst) : "v"(vb0), "i"(off) : "memory")
__device__ __forceinline__ void pv_read0(VF8& f, int vb0) {
    constexpr int b_ = v_rd_off(0, 0, 0);
    TRRD(f.l0, b_); TRRD(f.h0, b_ + 2048); TRRD(f.l1, b_ + 4096); TRRD(f.h1, b_ + 6144); TRRD(f.l2, b_ + 8192); TRRD(f.h2, b_ + 10240); TRRD(f.l3, b_ + 12288); TRRD(f.h3, b_ + 14336);
}
__device__ __forceinline__ void pv_tile(f32x16* o, int vb0, bf16x8 pa0, bf16x8 pa1, bf16x8 pa2, bf16x8 pa3, VF8& f) {
#define PV_MM(d0, l0, h0, l1, h1, l2, h2, l3, h3) do { \
        o[d0] = __builtin_amdgcn_mfma_f32_32x32x16_bf16(pa0, (bf16x8){l0[0], l0[1], l0[2], l0[3], h0[0], h0[1], h0[2], h0[3]}, o[d0], 0, 0, 0);   \
        o[d0] = __builtin_amdgcn_mfma_f32_32x32x16_bf16(pa1, (bf16x8){l1[0], l1[1], l1[2], l1[3], h1[0], h1[1], h1[2], h1[3]}, o[d0], 0, 0, 0);   \
        o[d0] = __builtin_amdgcn_mfma_f32_32x32x16_bf16(pa2, (bf16x8){l2[0], l2[1], l2[2], l2[3], h2[0], h2[1], h2[2], h2[3]}, o[d0], 0, 0, 0);   \
        o[d0] = __builtin_amdgcn_mfma_f32_32x32x16_bf16(pa3, (bf16x8){l3[0], l3[1], l3[2], l3[3], h3[0], h3[1], h3[2], h3[3]}, o[d0], 0, 0, 0); } while (0)
#define PV_D0(d0) do { s16x4 l0, l1, l2, l3, h0, h1, h2, h3; constexpr int b_ = v_rd_off(d0, 0, 0); \
        TRRD(l0, b_); TRRD(h0, b_ + 2048); TRRD(l1, b_ + 4096); TRRD(h1, b_ + 6144); TRRD(l2, b_ + 8192); TRRD(h2, b_ + 10240); TRRD(l3, b_ + 12288); TRRD(h3, b_ + 14336); \
        asm volatile("s_waitcnt lgkmcnt(0)" ::: "memory"); SBAR(); PV_MM(d0, l0, h0, l1, h1, l2, h2, l3, h3); } while (0)
    asm volatile("s_waitcnt lgkmcnt(0)" ::: "memory"); SBAR(); PV_MM(0, f.l0, f.h0, f.l1, f.h1, f.l2, f.h2, f.l3, f.h3);
    PV_D0(1); PV_D0(2); PV_D0(3);
#undef PV_D0
#undef PV_MM
}
#undef TRRD

enum { M_C1 = 0, M_C2 = 1, M_S = 2, M_W = 3 };
struct Stage { bf16x8 k0, k1, v0, v1; };
__device__ __forceinline__ void stage_load(Stage& sg, const bf16_t* Kp, const bf16_t* Vp, int ld, int j, bool hasv) {
    const int tid = otid(), sr = tid >> 4, sc = (tid & 15) * 8; const size_t k0_ = (size_t)j * 64;
    sg.k0 = *(const bf16x8*)(Kp + (k0_ + sr) * ld + sc); sg.k1 = *(const bf16x8*)(Kp + (k0_ + 32 + sr) * ld + sc);
    if (hasv) { sg.v0 = *(const bf16x8*)(Vp + (k0_ + sr) * ld + sc); sg.v1 = *(const bf16x8*)(Vp + (k0_ + 32 + sr) * ld + sc); }
}
struct RowState { float m, l; };
template <int MODE>
__device__ __forceinline__ void attn_pass(LAS unsigned char* lds, const bf16_t* Kp, const bf16_t* Vp, int ld, int j_lo, int j_hi, const bf16x8* qr, int t, int Tq, const u32x4 sel,
                                          RowState& st, float invl, f32x16* o, bool do_imp, Stage& sg) {
    constexpr bool HASV = MODE != M_C1;
    const int tid = otid(), wid = __builtin_amdgcn_readfirstlane(tid >> 6), lane = tid & 63, r32 = lane & 31, hi = lane >> 5;
    LAS unsigned char* V_lds = lds + L_V; LAS unsigned char* K_lds = lds + L_K;
    LAS float* wsf = (LAS float*)(lds + L_WS) + wid * 64; LAS float* al_l = wsf + 32;
    const int sr = tid >> 4, sc = (tid & 15) * 8, vst0 = v_st(sr, sc), vst1 = v_st(32 + sr, sc), kws = KSWZ(sr, sc * 2);
    const int vb0 = (int)(uintptr_t)V_lds + v_rd_base(lane);
    const int NT = j_hi - j_lo;
#define st_k0 sg.k0
#define st_k1 sg.k1
#define st_v0 sg.v0
#define st_v1 sg.v1
    float m_reg = st.m, l_reg = st.l;
#define SLOAD(j) do { const size_t k0_ = (size_t)(j) * 64; st_k0 = *(const bf16x8*)(Kp + (k0_ + sr) * ld + sc); st_k1 = *(const bf16x8*)(Kp + (k0_ + 32 + sr) * ld + sc); \
        if (HASV) { st_v0 = *(const bf16x8*)(Vp + (k0_ + sr) * ld + sc); st_v1 = *(const bf16x8*)(Vp + (k0_ + 32 + sr) * ld + sc); } } while (0)
#define SWRITE(kof, vof) do { *(LAS bf16x8*)(K_lds + (kof) + kws) = st_k0; *(LAS bf16x8*)(K_lds + (kof) + kws + 32 * 256) = st_k1; \
        if (HASV) { *(LAS bf16x8*)(V_lds + (vof) + vst0) = st_v0; *(LAS bf16x8*)(V_lds + (vof) + vst1) = st_v1; } } while (0)
    const bool late = HASV && wid >= 4;
    bf16x8 pa0, pa1, pa2, pa3;
    SWRITE(0, 0);
    __syncthreads();
    int kof = 0, vof = 0, vprev = 0;
    for (int idx = 0; idx < NT; ++idx) {
        const int j = j_lo + idx, kb = j * 64;
        if (idx + 1 < NT) SLOAD(j + 1);
        if (HASV && late && idx > 0) { SBAR(); VF8 vf; pv_read0(vf, vb0 + vprev); pv_tile(o, vb0 + vprev, pa0, pa1, pa2, pa3, vf); SBAR(); }
        f32x16 p0, p1; qkt(p0, p1, K_lds + kof, r32, hi, qr);
        VF8 vfe; if (HASV && !late) { SBAR(); pv_read0(vfe, vb0 + vof); SBAR(); }
#if EXP_QKT2
        asm volatile("" : "+v"(p0), "+v"(p1)); SBAR(); qkt(p0, p1, K_lds + kof, r32, hi, qr);
#endif
        if (MODE == M_C1 || MODE == M_C2) { const int nmax1 = ((t - 31) >> 4) + 1; mask_range(p0, p1, kb + 4 * hi, (unsigned)(nmax1 > 0 ? nmax1 : 0)); }
        else if (MODE == M_S) { if (j == Tq) mask_range(p0, p1, kb + 4 * hi, (unsigned)(t + 1));
                                else { const unsigned w_ = (j >> 5) == 0 ? sel.x : (j >> 5) == 1 ? sel.y : (j >> 5) == 2 ? sel.z : sel.w; mask_row(p0, p1, ((w_ >> (j & 31)) & 1u) != 0u); } }
        else { if (j == Tq || j + 8 <= Tq) mask_range(p0, p1, kb + 4 * hi - (t - 511), 512u); }
        if (MODE == M_C1) { const float pmax = rowmax32(p0, p1); const float mn = fmaxf(m_reg, pmax); const float alpha = __builtin_amdgcn_exp2f((m_reg - mn) * C2); m_reg = mn;
            const float mnL = -mn * C2;
#pragma unroll
            for (int r = 0; r < 16; ++r) { p0[r] = __builtin_amdgcn_exp2f(fmaf(p0[r], C2, mnL)); p1[r] = __builtin_amdgcn_exp2f(fmaf(p1[r], C2, mnL)); }
            l_reg = l_reg * alpha + rowsum32(p0, p1); }
        else if (MODE == M_C2) { const float mnL = -m_reg * C2;
#pragma unroll
            for (int r = 0; r < 16; ++r) { p0[r] = __builtin_amdgcn_exp2f(fmaf(p0[r], C2, mnL)) * invl; p1[r] = __builtin_amdgcn_exp2f(fmaf(p1[r], C2, mnL)) * invl; }
            if (do_imp) { LAS unsigned* imp = (LAS unsigned*)(lds + L_IMP) + ((wid & 1) * 32 + r32) * IMP_LD + 16 * j + hi;
#pragma unroll
                for (int k = 0; k < 4; ++k) {
                    { const float e_ = p0[4 * k + 3], a_ = 2.f * (p0[4 * k] + p0[4 * k + 1] + p0[4 * k + 2]) + e_;
                      LADD(imp + 2 * k, (unsigned)(a_ * 67108864.f + 0.5f)); LADD(imp + 2 * k + 1, (unsigned)(e_ * 67108864.f + 0.5f)); }
                    { const float e_ = p1[4 * k + 3], a_ = 2.f * (p1[4 * k] + p1[4 * k + 1] + p1[4 * k + 2]) + e_;
                      LADD(imp + 8 + 2 * k, (unsigned)(a_ * 67108864.f + 0.5f)); LADD(imp + 8 + 2 * k + 1, (unsigned)(e_ * 67108864.f + 0.5f)); } } }
            pack_p(p0, p1, pa0, pa1, pa2, pa3); }
        else { const float pmax = rowmax32(p0, p1); float mn, alpha;
            if (__builtin_expect(__all((pmax - m_reg) * SCALE <= THR), 1)) { mn = m_reg; alpha = 1.f; }
            else { mn = fmaxf(m_reg, pmax); alpha = __builtin_amdgcn_exp2f((m_reg - mn) * C2); m_reg = mn; }
            const float mnL = -mn * C2;
#pragma unroll
            for (int r = 0; r < 16; ++r) { p0[r] = __builtin_amdgcn_exp2f(fmaf(p0[r], C2, mnL)); p1[r] = __builtin_amdgcn_exp2f(fmaf(p1[r], C2, mnL)); }
            l_reg = l_reg * alpha + rowsum32(p0, p1);
            pack_p(p0, p1, pa0, pa1, pa2, pa3);
            if (__any(alpha < 1.f)) { if (hi == 0) al_l[r32] = alpha; asm volatile("s_waitcnt lgkmcnt(0)" ::: "memory");
#pragma unroll
                for (int d_ = 0; d_ < 4; ++d_)
#pragma unroll
                    for (int r = 0; r < 16; ++r) o[d_][r] *= al_l[crow(r, hi)]; } }
        if (HASV && !late) { SBAR(); pv_tile(o, vb0 + vof, pa0, pa1, pa2, pa3, vfe); }
        const int kn = kof ^ SHM_K, vn = (vof == 2 * SHM_V) ? 0 : vof + SHM_V;
        if (idx + 1 < NT) { SWRITE(kn, vn); }
        __syncthreads();
        vprev = vof; kof = kn; vof = vn;
    }
    if (HASV) { if (late) { SBAR(); VF8 vf; pv_read0(vf, vb0 + vprev); pv_tile(o, vb0 + vprev, pa0, pa1, pa2, pa3, vf); } __syncthreads(); }
    st.m = m_reg; st.l = l_reg;
#undef SLOAD
#undef SWRITE
#undef st_k0
#undef st_k1
#undef st_v0
#undef st_v1
}

typedef int v8i __attribute__((ext_vector_type(8)));
struct Stage8 { u32x4 k, v; };
constexpr int SHM8 = 8192;
constexpr float THR8 = 0.5f;
__device__ __forceinline__ f32x16 mfma8(v8i a, v8i b, f32x16 c) { return __builtin_amdgcn_mfma_scale_f32_32x32x64_f8f6f4(a, b, c, 0, 0, 0, 0x7F7F7F7F, 0, 0x7F7F7F7F); }
__device__ __forceinline__ int k8_off(int key, int c) { return key * 128 + ((c ^ ((key >> 1) & 7)) << 4); }
__device__ __forceinline__ int v8_off(int d, int c) { return d * 64 + ((c ^ ((d >> 2) & 3)) << 4); }
__device__ __forceinline__ void stage_load8(Stage8& sg, const unsigned char* K8h, const unsigned char* V8Th, int j) {
    const int tid = otid();
    sg.k = *(const u32x4*)(K8h + (size_t)(64 * j + (tid >> 3)) * 512 + (tid & 7) * 16); sg.v = *(const u32x4*)(V8Th + (size_t)j * 8192 + tid * 16);
}
__device__ __forceinline__ v8i ld_v8i(const LAS unsigned char* a, const LAS unsigned char* b) { const u32x4 x = *(const LAS u32x4*)a, y = *(const LAS u32x4*)b; return (v8i){(int)x.x, (int)x.y, (int)x.z, (int)x.w, (int)y.x, (int)y.y, (int)y.z, (int)y.w}; }
template <int MODE>
__device__ __forceinline__ void attn_pass8(LAS unsigned char* lds, const unsigned char* K8h, const unsigned char* V8Th, int j_lo, int j_hi, const v8i* qf, int t, int Tq, const u32x4 sel,
                                           RowState& st, f32x16* o, Stage8& sg) {
    const int tid = otid(), wid = __builtin_amdgcn_readfirstlane(tid >> 6), lane = tid & 63, r32 = lane & 31, hi = lane >> 5;
    LAS unsigned char* V_lds = lds + L_V; LAS unsigned char* K_lds = lds + L_K;
    LAS float* wsf = (LAS float*)(lds + L_WS) + wid * 64; LAS float* al_l = wsf + 32;
    const int kws = k8_off(tid >> 3, tid & 7), vws = v8_off(tid >> 2, tid & 3);
    const int NT = j_hi - j_lo;
    float m_reg = st.m, l_reg = st.l;
#define SLOAD8(j) stage_load8(sg, K8h, V8Th, (j))
#define SWRITE8(kof, vof) do { *(LAS u32x4*)(K_lds + (kof) + kws) = sg.k; *(LAS u32x4*)(V_lds + (vof) + vws) = sg.v; } while (0)
    const bool late = wid >= 4;
    v8i pa;
    SWRITE8(0, 0);
    __syncthreads();
    int kof = 0, vof = 0, vprev = 0;
#define PV8(vo) do { const LAS unsigned char* vb_ = V_lds + (vo);                                                                      \
        _Pragma("unroll") for (int d0 = 0; d0 < 4; ++d0) { const int d_ = d0 * 32 + r32;                                               \
            o[d0] = mfma8(pa, ld_v8i(vb_ + v8_off(d_, 2 * hi), vb_ + v8_off(d_, 2 * hi + 1)), o[d0]); } } while (0)
    for (int idx = 0; idx < NT; ++idx) {
        const int j = j_lo + idx, kb = j * 64;
        if (idx + 1 < NT) SLOAD8(j + 1);
        if (late && idx > 0) { SBAR(); PV8(vprev); SBAR(); }
        f32x16 p0 = f32x16{}, p1 = f32x16{};
        { const LAS unsigned char* kb_ = K_lds + kof;
#pragma unroll
          for (int ks = 0; ks < 2; ++ks) {
              p0 = mfma8(ld_v8i(kb_ + k8_off(r32, 4 * ks + 2 * hi), kb_ + k8_off(r32, 4 * ks + 2 * hi + 1)), qf[ks], p0);
              p1 = mfma8(ld_v8i(kb_ + k8_off(32 + r32, 4 * ks + 2 * hi), kb_ + k8_off(32 + r32, 4 * ks + 2 * hi + 1)), qf[ks], p1); } }
        if (MODE == M_S) { if (j == Tq) mask_range(p0, p1, kb + 4 * hi, (unsigned)(t + 1));
                           else { const unsigned w_ = (j >> 5) == 0 ? sel.x : (j >> 5) == 1 ? sel.y : (j >> 5) == 2 ? sel.z : sel.w; mask_row(p0, p1, ((w_ >> (j & 31)) & 1u) != 0u); } }
        else { if (j == Tq || j + 8 <= Tq) mask_range(p0, p1, kb + 4 * hi - (t - 511), 512u); }
        { const float pmax = rowmax32(p0, p1); float mn, alpha;
          if (__builtin_expect(__all((pmax - m_reg) * SCALE <= THR8), 1)) { mn = m_reg; alpha = 1.f; }
          else { mn = fmaxf(m_reg, pmax); alpha = __builtin_amdgcn_exp2f((m_reg - mn) * C2); m_reg = mn; }
          const float mnL = 8.0f - mn * C2;
#pragma unroll
          for (int r = 0; r < 16; ++r) { p0[r] = __builtin_amdgcn_exp2f(fmaf(p0[r], C2, mnL)); p1[r] = __builtin_amdgcn_exp2f(fmaf(p1[r], C2, mnL)); }
          l_reg = l_reg * alpha + rowsum32(p0, p1);
          if (late && idx > 0) { }
#pragma unroll
          for (int q = 0; q < 4; ++q) { pa[q] = (int)cvt4_fp8(p0[4 * q], p0[4 * q + 1], p0[4 * q + 2], p0[4 * q + 3]); pa[4 + q] = (int)cvt4_fp8(p1[4 * q], p1[4 * q + 1], p1[4 * q + 2], p1[4 * q + 3]); }
          if (__any(alpha < 1.f)) { if (hi == 0) al_l[r32] = alpha; asm volatile("s_waitcnt lgkmcnt(0)" ::: "memory");
#pragma unroll
              for (int d_ = 0; d_ < 4; ++d_)
#pragma unroll
                  for (int r = 0; r < 16; ++r) o[d_][r] *= al_l[crow(r, hi)]; } }
        if (!late) { SBAR(); PV8(vof); }
        const int kn = kof ^ SHM8, vn = (vof == 2 * SHM8) ? 0 : vof + SHM8;
        if (idx + 1 < NT) { SWRITE8(kn, vn); }
        __syncthreads();
        vprev = vof; kof = kn; vof = vn;
    }
    if (late) { SBAR(); PV8(vprev); }
    __syncthreads();
    st.m = m_reg; st.l = l_reg;
#undef PV8
#undef SLOAD8
#undef SWRITE8
}

template <int MODE>
__device__ __forceinline__ void branch_out(LAS unsigned char* lds, const f32x16* o, float rowscale, bf16_t* onsa_w, const bf16_t* gn_w) {
    const int tid = otid(), wid = __builtin_amdgcn_readfirstlane(tid >> 6), lane = tid & 63, r32 = lane & 31, hi = lane >> 5;
    LAS float* li_l = (LAS float*)(lds + L_WS) + wid * 64;
    if (hi == 0) li_l[r32] = rowscale; asm volatile("s_waitcnt lgkmcnt(0)" ::: "memory");
    LAS unsigned* stg = (LAS unsigned*)(lds + wid * 8192);
#pragma unroll
    for (int r = 0; r < 16; ++r) { const int orow = crow(r, hi); const float sc = li_l[orow];
#pragma unroll
        for (int d0 = 0; d0 < 4; ++d0) { const float v = o[d0][r] * sc; const float vn = dpp_x1f(v);
            if ((r32 & 1) == 0) stg[orow * 64 + d0 * 16 + (r32 >> 1)] = cvtpk(v, vn); } }
    asm volatile("s_waitcnt lgkmcnt(0)" ::: "memory");
    u32x4 val[8], prev[8], gq[8];
#pragma unroll
    for (int i = 0; i < 8; ++i) val[i] = *(const LAS u32x4*)(stg + (i * 4 + (lane >> 4)) * 64 + (lane & 15) * 4);
    int rb = lane >> 4; asm volatile("" : "+v"(rb));
    bf16_t* gp_ = onsa_w + (size_t)rb * 2048 + (lane & 15) * 8; const bf16_t* gg_ = gn_w + (size_t)rb * 2048 + (lane & 15) * 8;
    if (MODE >= 1) {
#pragma unroll
        for (int i = 0; i < 8; ++i) prev[i] = *(const u32x4*)(gp_ + (size_t)i * 4 * 2048); }
    if (MODE == 2) {
#pragma unroll
        for (int i = 0; i < 8; ++i) gq[i] = *(const u32x4*)(gg_ + (size_t)i * 4 * 2048); }
#pragma unroll
    for (int i = 0; i < 8; ++i) { u32x4 w = val[i];
        if (MODE >= 1) { f32x4 a0, a1, b0, b1; unpack8(val[i], a0, a1); unpack8(prev[i], b0, b1); a0 = a0 + b0; a1 = a1 + b1;
            if (MODE == 2) { f32x4 g0, g1; unpack8(gq[i], g0, g1); a0 = a0 * g0; a1 = a1 * g1; }
            w = pack8(a0, a1); }
        *(u32x4*)(gp_ + (size_t)i * 4 * 2048) = w; }
    __syncthreads();
}

__device__ __forceinline__ void attn_unit(LAS unsigned char* lds, unsigned char* ws, int h, int Tq) {
    const int tid = otid(), wid = __builtin_amdgcn_readfirstlane(tid >> 6), lane = tid & 63, r32 = lane & 31, hi = lane >> 5;
    const int g = wid >> 1, tl = (wid & 1) * 32 + r32, t = Tq * 64 + tl, hq = 4 * h + g;
    const bf16_t* Q = (const bf16_t*)(ws + WS_Q); const bf16_t* GBR = (const bf16_t*)(ws + WS_GBR);
    bf16_t* onsa_w = (bf16_t*)(ws + WS_ONSA) + (size_t)(Tq * 64 + (wid & 1) * 32) * 2048 + hq * 128; const bf16_t* gn_w = (const bf16_t*)(ws + WS_GN) + (size_t)(Tq * 64 + (wid & 1) * 32) * 2048 + hq * 128;
    bf16x8 qr[8];
#pragma unroll
    for (int d0 = 0; d0 < 8; ++d0) qr[d0] = *(const bf16x8*)(Q + (size_t)t * 2048 + hq * 128 + d0 * 16 + hi * 8);
    const float g_c = bf2f(GBR[(size_t)t * 256 + hq * 3 + 0]), g_s = bf2f(GBR[(size_t)t * 256 + hq * 3 + 1]), g_w = bf2f(GBR[(size_t)t * 256 + hq * 3 + 2]);
    const bool big = Tq >= 16;
    LAS unsigned* IMP = (LAS unsigned*)(lds + L_IMP);
    if (big) { for (int i = tid; i < 64 * IMP_LD; i += 512) IMP[i] = 0u; }
    const u32x4 nosel = {0u, 0u, 0u, 0u};
    f32x16 o[4]; Stage sg;
    {
        const bf16_t* Kc = (const bf16_t*)(ws + WS_KC) + (size_t)h * 512 * 128; const bf16_t* Vc = (const bf16_t*)(ws + WS_VC) + (size_t)h * 512 * 128;
        const int ntc = ((4 * Tq + 2) >> 6) + 1;
        RowState stc{-1e30f, 0.f};
        stage_load(sg, Kc, Vc, 128, 0, false);
        attn_pass<M_C1>(lds, Kc, Vc, 128, 0, ntc, qr, t, Tq, nosel, stc, 0.f, o, false, sg);
        stage_load(sg, Kc, Vc, 128, 0, true);
        const float invl = stc.l > 0.f ? 1.0f / stc.l : 0.f;
#pragma unroll
        for (int d = 0; d < 4; ++d) o[d] = f32x16{};
        attn_pass<M_C2>(lds, Kc, Vc, 128, 0, ntc, qr, t, Tq, nosel, stc, invl, o, big, sg);
        branch_out<0>(lds, o, g_c, onsa_w, gn_w);
    }
    {
        LAS unsigned short* SELM = (LAS unsigned short*)(lds + L_SELM);
        int tok = tid >> 3, sub = tid & 7; asm volatile("" : "+v"(tok), "+v"(sub));
        unsigned bits = 0u;
        if (big) {
            unsigned kv[16];
#pragma unroll
            for (int e = 0; e < 16; ++e) { const int j = sub * 16 + e; const unsigned v = IMP[tok * IMP_LD + j]; kv[e] = (j >= 1 && j <= Tq - 2) ? v + 1u : 0u; }
            for (int round = 0; round < 13; ++round) {
                unsigned bv = kv[0]; int bj = 0;
#pragma unroll
                for (int e = 1; e < 16; ++e) { const bool gt = kv[e] > bv; bv = gt ? kv[e] : bv; bj = gt ? e : bj; }
                bj += sub * 16;
#pragma unroll
                for (int st_ = 0; st_ < 3; ++st_) { const unsigned ov = st_ == 0 ? dpp_x1(bv) : st_ == 1 ? dpp_x2(bv) : dpp_m8(bv); const int oj = (int)(st_ == 0 ? dpp_x1((unsigned)bj) : st_ == 1 ? dpp_x2((unsigned)bj) : dpp_m8((unsigned)bj));
                    const bool take = (ov > bv) || (ov == bv && oj < bj); bv = take ? ov : bv; bj = take ? oj : bj; }
                const int we = (bv != 0u && (bj >> 4) == sub) ? (bj & 15) : -1;
#pragma unroll
                for (int e = 0; e < 16; ++e) { const bool hit = (we == e); bits |= hit ? (1u << e) : 0u; kv[e] = hit ? 0u : kv[e]; }
            }
#pragma unroll
            for (int e = 0; e < 16; ++e) { const int j = sub * 16 + e; if (j == 0 || j == Tq - 1 || j == Tq) bits |= 1u << e; }
        } else {
#pragma unroll
            for (int e = 0; e < 16; ++e) { const int j = sub * 16 + e; if (j <= Tq) bits |= 1u << e; }
        }
        SELM[tok * 8 + sub] = (unsigned short)bits;
        __syncthreads();
    }
    const u32x4 sel = *(const LAS u32x4*)(lds + L_SELM + tl * 16);
    v8i qf[2];
    { const unsigned char* q8 = ws + WS_Q8 + (size_t)t * 2048 + hq * 128 + 32 * hi;
#pragma unroll
      for (int ks = 0; ks < 2; ++ks) { const u32x4 x = *(const u32x4*)(q8 + 64 * ks), y = *(const u32x4*)(q8 + 64 * ks + 16); qf[ks] = (v8i){(int)x.x, (int)x.y, (int)x.z, (int)x.w, (int)y.x, (int)y.y, (int)y.z, (int)y.w}; } }
    const unsigned char* K8S = ws + WS_K8S + h * 128; const unsigned char* V8TS = ws + WS_V8TS + (size_t)h * 128 * 8192;
    const unsigned char* K8W = ws + WS_K8W + h * 128; const unsigned char* V8TW = ws + WS_V8TW + (size_t)h * 128 * 8192;
    Stage8 s8;
    {
        RowState sts{-1e30f, 0.f};
#pragma unroll
        for (int d = 0; d < 4; ++d) o[d] = f32x16{};
        stage_load8(s8, K8S, V8TS, 0);
        attn_pass8<M_S>(lds, K8S, V8TS, 0, Tq + 1, qf, t, Tq, sel, sts, o, s8);
        stage_load8(s8, K8W, V8TW, Tq >= 8 ? Tq - 8 : 0);
        branch_out<1>(lds, o, sts.l > 0.f ? g_s / sts.l : 0.f, onsa_w, gn_w);
    }
    {
        RowState stw{-1e30f, 0.f};
#pragma unroll
        for (int d = 0; d < 4; ++d) o[d] = f32x16{};
        attn_pass8<M_W>(lds, K8W, V8TW, Tq >= 8 ? Tq - 8 : 0, Tq + 1, qf, t, Tq, sel, stw, o, s8);
        branch_out<2>(lds, o, stw.l > 0.f ? g_w / stw.l : 0.f, onsa_w, gn_w);
    }
}
#undef KSWZ
#undef SBAR
}

constexpr int NPHASE = 8;
__global__ void __launch_bounds__(NWAVES * 64, 2) mega_fwd(Args args) {
    extern __shared__ __attribute__((aligned(16))) unsigned char lds[];
    Frame F;
    F.lds = (LAS unsigned char*)lds;
    F.tid = threadIdx.x; F.lane = F.tid & 63; F.wave = __builtin_amdgcn_readfirstlane(F.tid >> 6);
    F.G = gridDim.x; { const int bx = blockIdx.x; F.vcu = (F.G % 8 == 0) ? (bx % 8) * (F.G / 8) + bx / 8 : bx; }
    volatile LAS unsigned* MISC = (volatile LAS unsigned*)(F.lds + MISC_OFF);
    unsigned char* ws = args.ws;
    for (int u = F.tid; u < (LDS_BYTES - LDSCTL_OFF) / 4; u += NWAVES * 64) ((LAS unsigned*)(F.lds + LDSCTL_OFF))[u] = 0u;
    __syncthreads();
    XcdBarrier bar; bar.bar = (unsigned*)(ws + WS_CTL) + CW_BAR; bar.x = 0; bar.st = nullptr;
#if !N_LAUNCHES_PER_PHASE
    bar = xcd_barrier_post((unsigned*)(ws + WS_CTL) + CW_BAR, MISC + 8);
#endif
    const int lo = args.ph_lo, hi = args.ph_hi;
#define IN(k) (lo <= (k) && (k) < hi && (F.tid = otid(), F.lane = F.tid & 63, true))
#define SEAM(k) do { if (IN(k) && IN((k) + 1)) xcd_barrier(bar); } while (0)
    bf16_t* const GM = (bf16_t*)args.out;

    for (int rep_ = 0; rep_ < (DUP_PHASE == 0 ? 2 : 1); ++rep_) if (IN(0)) { if (rep_) xcd_barrier(bar); p0_prologue(F, args); } SEAM(0);
    for (int rep_ = 0; rep_ < (DUP_PHASE == 1 ? 2 : 1); ++rep_) if (IN(1)) { if (rep_) xcd_barrier(bar);
        pg8::Gemm g{(const bf16_t*)(ws + WS_H), (const bf16_t*)(ws + WS_WCAT), 2048, 2048, 2048};
        pg8::StaticOrder So; So.init(S, NCAT, F.G, (int)blockIdx.x);
        EpiInProj E{ws, GM, args.in[14]};
        pg8::AddrAffine AD{(size_t)256 * 2048 * 2, (size_t)256 * 2048 * 2};
        pg8::gemm_phase<EpiInProj, true>(F.lds, g, So, E, AD);
        { const int nun = (So.nwg + F.G - 1) / F.G, full = So.nwg - (nun - 1) * F.G;
          const int base = full < F.G ? full : 0; if ((int)blockIdx.x >= base) p1_late_weights(F, args, ((int)blockIdx.x - base) * NWAVES + F.wave, (F.G - base) * NWAVES); }
    } SEAM(1);
    for (int rep_ = 0; rep_ < (DUP_PHASE == 2 ? 2 : 1); ++rep_) if (IN(2)) { if (rep_) xcd_barrier(bar);
        pg8::Gemm g{(const bf16_t*)(ws + WS_KCR), (const bf16_t*)(ws + WS_W1KT), 2048, 4096, 4096 / NSPLIT};
        pg8::StaticOrder So; So.init(16 * 256, NSPLIT * 256, F.G, (int)blockIdx.x);
        EpiSlab E{(float*)(ws + WS_SLAB)};
        pg8::AddrCmp AD{(4096 / NSPLIT) / 64};
        pg8::gemm_phase<EpiSlab, false>(F.lds, g, So, E, AD);
        { const int base = F.G > So.nwg ? So.nwg : 0; if ((int)blockIdx.x >= base) { p2_ypool(F, ws, args.in[4], ((int)blockIdx.x - base) * NWAVES + F.wave, (F.G - base) * NWAVES); p2_vt8(F, ws, ((int)blockIdx.x - base) * NWAVES + F.wave, (F.G - base) * NWAVES); } }
        if (blockIdx.x == F.G - 1) { const float* b1p = (const float*)(ws + WS_B1P); float* b1 = (float*)(ws + WS_B1); const int t = F.tid; float s = 0.f;
            for (int c = 0; c < 64; ++c) s += b1p[((t >> 8) * 64 + c) * 256 + (t & 255)];
            b1[t] = s; }
    } SEAM(2);
    for (int rep_ = 0; rep_ < (DUP_PHASE == 3 ? 2 : 1); ++rep_) if (IN(3)) { if (rep_) xcd_barrier(bar);
        p3_compress2(F, ws, (int)blockIdx.x, F.G);
    } SEAM(3);
    for (int rep_ = 0; rep_ < (DUP_PHASE == 5 ? 2 : 1); ++rep_) if (IN(5)) { if (rep_) xcd_barrier(bar);
        for (int p = F.vcu; p < 256; p += F.G) {
#pragma unroll 1
            for (int i = 0; i < 2; ++i) { const int h = p >> 6, x = p & 63; nsa::attn_unit(F.lds, ws, h, i ? x : 127 - x); } }
    } SEAM(5);
    for (int rep_ = 0; rep_ < (DUP_PHASE == 6 ? 2 : 1); ++rep_) if (IN(6)) { if (rep_) xcd_barrier(bar);
        pg8::Gemm ga{(const bf16_t*)(ws + WS_H + 16 * MiB), (const bf16_t*)(ws + WS_WPOT), 1024, 1024, 1024};
        pg8::Gemm gb{(const bf16_t*)(ws + WS_ONSA), (const bf16_t*)(ws + WS_WNOT), 2048, 2048, 2048};
        pg8::StaticOrder So; So.init(S, 2048, F.G, (int)blockIdx.x);
        EpiYaYb E{EpiYa{(bf16_t*)(ws + WS_YAG), GM}, EpiYb{(bf16_t*)(ws + WS_H), (const bf16_t*)(ws + WS_YAG), GM}};
        pg8::gemm_phase2<EpiYaYb>(F.lds, ga, gb, So, E);
    } SEAM(6);
    for (int rep_ = 0; rep_ < (DUP_PHASE == 7 ? 2 : 1); ++rep_) if (IN(7)) { if (rep_) xcd_barrier(bar);
        pg8::Gemm g{(const bf16_t*)(ws + WS_H), (const bf16_t*)(ws + WS_WOT), 2048, 2048, 2048}; pg8::AddrAffine AD{(size_t)256 * 2048 * 2, (size_t)256 * 2048 * 2};
        pg8::StaticOrder So; So.init(S, 2048, F.G, (int)blockIdx.x);
        EpiOut E{args.out, args.in[0], (float*)(ws + WS_SSQ), args.in[16], (unsigned*)(ws + WS_CTL), F.lds};
        pg8::gemm_phase<EpiOut, true>(F.lds, g, So, E, AD);
    }
#undef IN
#undef SEAM
}

extern "C" void kernel_launch(void* const* d_in, const int* in_sizes, int n_in, void* d_out, int out_size, void* d_ws, size_t ws_size, hipStream_t stream) {
    static int grid = 0;
    if (grid == 0) {
        if (n_in != 17 || in_sizes[0] != S * DM || out_size != S * DM || ws_size < WS_END) { fprintf(stderr, "kernel_launch: unexpected shapes (n_in %d, in0 %d, out %d, ws %zu); nothing launched\n", n_in, n_in > 0 ? in_sizes[0] : -1, out_size, ws_size); grid = -1; return; }
        int dev = 0, cus = 0;
        if (hipGetDevice(&dev) != hipSuccess || hipDeviceGetAttribute(&cus, hipDeviceAttributeMultiprocessorCount, dev) != hipSuccess) { fprintf(stderr, "kernel_launch: device query failed\n"); grid = -1; return; }
        if (hipFuncSetAttribute((const void*)mega_fwd, hipFuncAttributeMaxDynamicSharedMemorySize, LDS_BYTES) != hipSuccess) { fprintf(stderr, "kernel_launch: hipFuncSetAttribute failed\n"); grid = -1; return; }
        (void)hipGetLastError();
        grid = cus;
    }
    if (grid < 0) return;
    (void)hipMemsetAsync((char*)d_ws + WS_CTL, 0, CTL_BYTES, stream);
    Args a{};
    for (int i = 0; i < 17; ++i) a.in[i] = (const float*)d_in[i];
    a.out = (float*)d_out; a.ws = (unsigned char*)d_ws;
#if N_LAUNCHES_PER_PHASE
    for (int p = 0; p < NPHASE; ++p) { a.ph_lo = p; a.ph_hi = p + 1; hipLaunchKernelGGL(mega_fwd, dim3(grid), dim3(NWAVES * 64), LDS_BYTES, stream, a); }
#else
    a.ph_lo = 0; a.ph_hi = NPHASE;
    hipLaunchKernelGGL(mega_fwd, dim3(grid), dim3(NWAVES * 64), LDS_BYTES, stream, a);
#endif
}
```

```cpp
#include <hip/hip_runtime.h>
#include <cstdio>
#include <cstdint>

#define LAS __attribute__((address_space(3)))
#define GAS __attribute__((address_space(1)))
typedef unsigned short bf16_t;
typedef short bf16x8 __attribute__((ext_vector_type(8)));
typedef short s16x4 __attribute__((ext_vector_type(4)));
typedef float f32x4 __attribute__((ext_vector_type(4)));
typedef float f32x16 __attribute__((ext_vector_type(16)));
typedef unsigned u32x4 __attribute__((ext_vector_type(4)));
typedef unsigned u32x2 __attribute__((ext_vector_type(2)));
typedef float f32x2_t __attribute__((ext_vector_type(2)));
typedef __bf16 bf16x2_t __attribute__((ext_vector_type(2)));

#ifndef EXP_QKT2
#define EXP_QKT2 0
#endif
#ifndef DUP_PHASE
#define DUP_PHASE -1
#endif
#ifndef N_LAUNCHES_PER_PHASE
#define N_LAUNCHES_PER_PHASE 0
#endif

constexpr int S = 8192, DM = 2048, NCAT = 13568;
constexpr int HD = 128, NKV = 4, NCMP = 511;
constexpr float EPS = 1e-6f;

constexpr size_t MiB = 1u << 20;
constexpr size_t WS_CTL = 0, CTL_BYTES = 1 * MiB;
constexpr size_t WS_WCAT = 1 * MiB;
constexpr size_t WS_SLAB = WS_WCAT;
constexpr size_t WS_ONSA = WS_WCAT;
constexpr size_t WS_MIXT = 54 * MiB;
constexpr size_t WS_WPOT = 55 * MiB;
constexpr size_t WS_WNOT = 59 * MiB;
constexpr size_t WS_WOT  = 67 * MiB;
constexpr size_t WS_W1KT = 75 * MiB, WS_W1VT = 77 * MiB;
constexpr size_t WS_W2KT = 79 * MiB, WS_W2VT = 79 * MiB + 65536;
constexpr size_t WS_B1P  = 80 * MiB + 262144;
constexpr size_t WS_B1   = 79 * MiB + 131072 + 32768;
constexpr size_t WS_KC   = 79 * MiB + 262144, WS_VC = 79 * MiB + 786432;
constexpr size_t WS_ROPE = 81 * MiB;
constexpr size_t WS_SSQ  = 85 * MiB;
constexpr size_t WS_H    = 86 * MiB;
constexpr size_t WS_U    = 118 * MiB, WS_GP = 134 * MiB;
constexpr size_t WS_YAG  = WS_U;
constexpr size_t WS_Q    = 150 * MiB;
constexpr size_t WS_KCR  = 182 * MiB, WS_VCR = 190 * MiB, WS_KS = 198 * MiB, WS_VS = 206 * MiB, WS_KW = 214 * MiB, WS_VW = 222 * MiB;
constexpr size_t WS_GN   = 230 * MiB;
constexpr size_t WS_GBR  = 262 * MiB;
constexpr size_t WS_K8S = 198 * MiB, WS_K8W = 202 * MiB;
constexpr size_t WS_V8S = 206 * MiB, WS_V8W = 210 * MiB;
constexpr size_t WS_V8TS = 214 * MiB, WS_V8TW = 218 * MiB;
constexpr size_t WS_Q8   = 266 * MiB;
constexpr size_t WS_END  = 282 * MiB;
constexpr int CW_BAR = 4096;

constexpr int RING_BYTES = 131072;
constexpr int LDSCTL_OFF = RING_BYTES, MISC_OFF = LDSCTL_OFF + 320;
constexpr int LDS_BYTES = 147456;
constexpr int NWAVES = 8;

#define LDS_WAIT() asm volatile("s_waitcnt lgkmcnt(0)" ::: "memory")
#define VM_WAIT() asm volatile("s_waitcnt vmcnt(0)" ::: "memory")

__device__ __forceinline__ unsigned cvtpk(float lo, float hi) { f32x2_t v = {lo, hi}; bf16x2_t b = __builtin_convertvector(v, bf16x2_t); return __builtin_bit_cast(unsigned, b); }
__device__ __forceinline__ unsigned cvt4_fp8(float a, float b, float c, float d) { int w = __builtin_amdgcn_cvt_pk_fp8_f32(a, b, 0, false); return (unsigned)__builtin_amdgcn_cvt_pk_fp8_f32(c, d, w, true); }
__device__ __forceinline__ float bf2f(unsigned short h) { return __builtin_bit_cast(float, (unsigned)h << 16); }
__device__ __forceinline__ float bflo(unsigned w) { return __builtin_bit_cast(float, w << 16); }
__device__ __forceinline__ float bfhi(unsigned w) { return __builtin_bit_cast(float, w & 0xffff0000u); }
__device__ __forceinline__ float sigmoidf_(float x) { return __builtin_amdgcn_rcpf(1.0f + __expf(-x)); }
__device__ __forceinline__ float siluf_(float x) { return x * __builtin_amdgcn_rcpf(1.0f + __expf(-x)); }
__device__ __forceinline__ int otid() { int t = threadIdx.x; asm volatile("" : "+v"(t)); return t; }
__device__ __forceinline__ unsigned dpp_x1(unsigned v) { return __builtin_amdgcn_update_dpp(0u, v, 0xB1, 0xF, 0xF, false); }
__device__ __forceinline__ unsigned dpp_x2(unsigned v) { return __builtin_amdgcn_update_dpp(0u, v, 0x4E, 0xF, 0xF, false); }
__device__ __forceinline__ unsigned dpp_m8(unsigned v) { return __builtin_amdgcn_update_dpp(0u, v, 0x141, 0xF, 0xF, false); }
__device__ __forceinline__ float dpp_x1f(float v) { return __uint_as_float(dpp_x1(__float_as_uint(v))); }
__device__ __forceinline__ int crow(int r, int hi) { return (r & 3) + 8 * (r >> 2) + 4 * hi; }
__device__ __forceinline__ float wave_sum(float v) {
#pragma unroll
    for (int o = 1; o < 64; o <<= 1) v += __shfl_xor(v, o);
    return v;
}

#define XB_TMO      128
#define XB_XCNT(j)  (256  + 64 * (j))
#define XB_XSUB(j)  (1280 + 64 * (j))
#define XB_XGEN(j)  (2304 + 64 * (j))
#define XB_TOP      3328
#define XB_TOPGEN   3392
#define XCD_BAR_WORDS 3456
#define XB_SPIN_CAP (1u << 18)
__device__ __forceinline__ unsigned xb_ld(unsigned* p)              { return __hip_atomic_load(p, __ATOMIC_RELAXED, __HIP_MEMORY_SCOPE_AGENT); }
__device__ __forceinline__ unsigned xb_add(unsigned* p, unsigned v) { return __hip_atomic_fetch_add(p, v, __ATOMIC_RELAXED, __HIP_MEMORY_SCOPE_AGENT); }
__device__ __forceinline__ unsigned xb_xcc_id() { return (unsigned)__builtin_amdgcn_s_getreg((3 << 11) | 20) & 0xFu; }
#define XB_SPIN(cond, bar) do { unsigned _sp = 0; while (cond) { __builtin_amdgcn_s_sleep(1); \
    if ((++_sp & 255u) == 0u) { if (xb_ld(&(bar)[XB_TMO])) break; if (_sp > XB_SPIN_CAP) { atomicAdd(&(bar)[XB_TMO], 1u); break; } } } } while (0)
struct XcdBarrier { unsigned* bar; unsigned x; volatile LAS unsigned* st; };
__device__ __forceinline__ XcdBarrier xcd_barrier_post(unsigned* bar, volatile LAS unsigned* st) {
    XcdBarrier b; b.bar = bar; b.x = xb_xcc_id(); b.st = st;
    if (threadIdx.x == 0) (void)xb_add(&bar[XB_XCNT(b.x)], 1u);
    return b;
}
__device__ __forceinline__ void xcd_barrier_complete(unsigned* bar, unsigned x, unsigned& nloc, unsigned& nx) {
    const unsigned G = gridDim.x * gridDim.y * gridDim.z;
    unsigned sum, cnt, mine, sp = 0u;
    for (;;) {
        sum = 0u; cnt = 0u; mine = 0u;
#pragma unroll
        for (unsigned j = 0; j < 16; ++j) { const unsigned c = xb_ld(&bar[XB_XCNT(j)]); sum += c; cnt += (c > 0u) ? 1u : 0u; mine = (j == x) ? c : mine; }
        if (sum == G) break;
        __builtin_amdgcn_s_sleep(1);
        if ((++sp & 255u) == 0u) { if (xb_ld(&bar[XB_TMO])) break; if (sp > XB_SPIN_CAP) { atomicAdd(&bar[XB_TMO], 1u); break; } }
    }
    nloc = mine > 0u ? mine : 1u; nx = cnt > 0u ? cnt : 1u;
}
__device__ __forceinline__ void xcd_barrier(const XcdBarrier& b) {
    asm volatile("s_waitcnt vmcnt(0)" ::: "memory");
    __syncthreads();
    if (threadIdx.x == 0) {
        unsigned* bar = b.bar;
        __builtin_amdgcn_s_waitcnt(0);
        unsigned nloc = b.st[0], nx = b.st[1];
        if (nloc == 0u) { xcd_barrier_complete(bar, b.x, nloc, nx); b.st[0] = nloc; b.st[1] = nx; }
        const unsigned old = xb_add(&bar[XB_XSUB(b.x)], 1u);
        const unsigned gen = old / nloc;
        if (old + 1u == (gen + 1u) * nloc) {
            __builtin_amdgcn_fence(__ATOMIC_RELEASE, "agent");
            asm volatile("s_waitcnt vmcnt(0)" ::: "memory");
            const unsigned og = xb_add(&bar[XB_TOP], 1u);
            const unsigned tg = og / nx;
            if (og + 1u == (tg + 1u) * nx) xb_add(&bar[XB_TOPGEN], 1u);
            else XB_SPIN(xb_ld(&bar[XB_TOPGEN]) == tg, bar);
            __builtin_amdgcn_fence(__ATOMIC_ACQUIRE, "agent");
            xb_add(&bar[XB_XGEN(b.x)], 1u);
            asm volatile("s_waitcnt vmcnt(0)" ::: "memory");
        } else {
            XB_SPIN(xb_ld(&bar[XB_XGEN(b.x)]) == gen, bar);
            __builtin_amdgcn_fence(__ATOMIC_ACQUIRE, "agent");
            asm volatile("s_waitcnt vmcnt(0)" ::: "memory");
        }
    }
    __syncthreads();
}

namespace pg8 {
constexpr int BM = 256, BK = 64, HALF = 128, HTB = HALF * BK * 2, STAGE_BYTES = 8 * HTB, NXCD = 8, WGM = 8;
__host__ __device__ __forceinline__ int lds_byte(int r, int c) { const int st = (r >> 4) * 2 + (c >> 5), rr = r & 15, cc = c & 31, ob = rr * 64 + cc * 2; return st * 1024 + (ob ^ (((ob >> 9) & 1) << 5)); }
__host__ __device__ __forceinline__ void stage_rc(int b, int& R, int& C) { const int st = b / 1024, sb = b % 1024, swz = sb ^ (((sb >> 9) & 1) << 5); R = (st >> 1) * 16 + swz / 64; C = (st & 1) * 32 + (swz % 64) / 2; }
__host__ __device__ __forceinline__ int perm32(int rho) { const int n = rho >> 4, i = rho & 15; return 8 * (i >> 2) + 4 * n + (i & 3); }
struct Unit { int pm, pn; };
struct Gemm { const bf16_t* A; const bf16_t* Bt; int lda, ldb, K; };
struct AddrAffine { size_t tA, tB;
    __device__ __forceinline__ const char* A(const char* b, const Unit& u) const { return b + (size_t)u.pm * tA; }
    __device__ __forceinline__ const char* B(const char* b, const Unit& u) const { return b + (size_t)u.pn * tB; }
    __device__ __forceinline__ size_t ka(int t) const { return (size_t)t * (BK * 2); } };
struct AddrCmp { int ntile;
    __device__ __forceinline__ const char* A(const char* b, const Unit& u) const { return b + (size_t)(u.pm >> 3) * (8 * MiB) + (size_t)((u.pm >> 1) & 3) * (2 * MiB) + (size_t)(u.pm & 1) * (256 * 4096) + ka(u.pn * ntile); }
    __device__ __forceinline__ const char* B(const char* b, const Unit& u) const { return b + (size_t)(u.pm >> 3) * (2 * MiB) + (size_t)u.pn * ntile * (BK * 2); }
    __device__ __forceinline__ size_t ka(int t) const { return (size_t)t * (BK * 2); } };
struct StaticOrder {
    int nM, nN, nwg, G, c;
    __host__ __device__ void init(int M, int N, int G_, int c_) { nM = M / BM; nN = N / BM; nwg = nM * nN; G = G_; c = c_; }
    __host__ __device__ bool next(int i, Unit& u) const {
        const long L = (long)i * G + c; if (L >= nwg) return false;
        int wgid = (int)L; { const int q = nwg / NXCD, r = nwg % NXCD, xcd = wgid % NXCD, off = wgid / NXCD; wgid = (xcd < r ? xcd * (q + 1) : r * (q + 1) + (xcd - r) * q) + off; }
        const int nig = WGM * nN, gid = wgid / nig, fm = gid * WGM, gsz = (nM - fm) < WGM ? (nM - fm) : WGM;
        u.pm = fm + ((wgid % nig) % gsz); u.pn = (wgid % nig) / gsz; return true;
    }
};
template <class Epi, bool ALIGN_EPI, class Addr>
__device__ __forceinline__ void gemm_phase(LAS unsigned char* lds, const Gemm g, const StaticOrder& S, const Epi& E, const Addr& AD) {
    const int tid = otid(), wid = __builtin_amdgcn_readfirstlane(tid >> 6), lane = tid & 63, wr = wid >> 2, wc = wid & 3, fr = lane & 15, fq = lane >> 4;
    const int K = g.K, nt = K / BK;
    unsigned voffA[2], voffB[2];
#pragma unroll
    for (int i = 0; i < 2; ++i) { int R, C; stage_rc(tid * 16 + i * 8192, R, C); const int Rb = (R & ~31) + perm32(R & 31);
        voffA[i] = (unsigned)(R * g.lda + C) * 2u; voffB[i] = (unsigned)(Rb * g.ldb + C) * 2u; }
    const size_t kstep = (size_t)(BK * 2);
    const size_t hA = (size_t)HALF * g.lda * 2, hB = (size_t)HALF * g.ldb * 2;
    const unsigned ldsw = (unsigned)wid * 1024u;
    const int aoff = lds_byte(wr * 64 + fr, fq * 8), boff = lds_byte(wc * 32 + fr, fq * 8);
#define PG8_SA(b, h) (((b) * 2 + (h)) * HTB)
#define PG8_SB(b, h) ((4 + (b) * 2 + (h)) * HTB)
#define PG8_STAGE(bufoff, gbase, voff) do { _Pragma("unroll") for (int _i = 0; _i < 2; ++_i) \
        __builtin_amdgcn_global_load_lds((const unsigned*)((const char*)(gbase) + (voff)[_i]), (LAS unsigned*)(lds + (bufoff) + ldsw + _i * 8192), 16, 0, 0); } while (0)
#define PG8_LDA(dst, b, h) do { _Pragma("unroll") for (int m = 0; m < 4; ++m) _Pragma("unroll") for (int k = 0; k < 2; ++k) dst[m][k] = *(const LAS bf16x8*)(lds + PG8_SA(b, h) + aoff + m * 2048 + k * 1024); } while (0)
#define PG8_LDB(dst, b, h) do { _Pragma("unroll") for (int n = 0; n < 2; ++n) _Pragma("unroll") for (int k = 0; k < 2; ++k) dst[n][k] = *(const LAS bf16x8*)(lds + PG8_SB(b, h) + boff + n * 2048 + k * 1024); } while (0)
#define PG8_MMA(ai, bj, At, Bt) do { __builtin_amdgcn_s_setprio(1); _Pragma("unroll") for (int m = 0; m < 4; ++m) _Pragma("unroll") for (int n = 0; n < 2; ++n) _Pragma("unroll") for (int k = 0; k < 2; ++k) \
        acc[ai][bj][m][n] = __builtin_amdgcn_mfma_f32_16x16x32_bf16(Bt[n][k], At[m][k], acc[ai][bj][m][n], 0, 0, 0); __builtin_amdgcn_s_setprio(0); } while (0)
#define PG8_WAIT_V(n) asm volatile("s_waitcnt vmcnt(" #n ")" ::: "memory")
#define PG8_WAIT_L(n) asm volatile("s_waitcnt lgkmcnt(" #n ")" ::: "memory")
#define PG8_BAR __builtin_amdgcn_s_barrier()
#define PG8_SCHED __builtin_amdgcn_sched_barrier(0)
    Unit cur, nxt; int ui = 0;
    if (!S.next(0, cur)) return;
    f32x4 acc[2][2][4][2];
#pragma unroll
    for (int a = 0; a < 2; ++a)
#pragma unroll
        for (int b = 0; b < 2; ++b)
#pragma unroll
            for (int m = 0; m < 4; ++m)
#pragma unroll
                for (int n = 0; n < 2; ++n) acc[a][b][m][n] = (f32x4){0.f, 0.f, 0.f, 0.f};
    bf16x8 At[4][2], B0[2][2], B1[2][2];
    const char* cA = AD.A((const char*)g.A, cur); const char* cB = AD.B((const char*)g.Bt, cur);
    PG8_STAGE(PG8_SB(0, 0), cB, voffB); PG8_STAGE(PG8_SB(0, 1), cB + hB, voffB); PG8_STAGE(PG8_SA(0, 0), cA, voffA); PG8_STAGE(PG8_SA(0, 1), cA + hA, voffA);
    if (wr == 1) PG8_BAR;
    PG8_WAIT_V(2); PG8_BAR;
    PG8_STAGE(PG8_SB(1, 0), cB + kstep, voffB); PG8_STAGE(PG8_SA(1, 0), cA + kstep, voffA); PG8_STAGE(PG8_SB(1, 1), cB + hB + kstep, voffB);
    PG8_WAIT_V(6); PG8_BAR;
    for (;;) {
        const bool has_next = S.next(ui + 1, nxt);
        const char* nA = has_next ? AD.A((const char*)g.A, nxt) : cA; const char* nB = has_next ? AD.B((const char*)g.Bt, nxt) : cB;
        for (int t = 0; t < nt; t += 2) {
            const bool last = (t == nt - 2);
            const char* a1 = cA + AD.ka(t) + kstep;
            const char* a2 = last ? nA : cA + AD.ka(t + 2); const char* b2 = last ? nB : cB + (size_t)(t + 2) * kstep;
            const char* a3 = a2 + kstep; const char* b3 = b2 + kstep;
            PG8_LDB(B0, 0, 0); PG8_LDB(B1, 0, 1); PG8_SCHED; PG8_LDA(At, 0, 0); PG8_STAGE(PG8_SA(1, 1), a1 + hA, voffA);
            PG8_WAIT_V(8); PG8_WAIT_L(0); PG8_BAR; PG8_MMA(0, 0, At, B0); PG8_MMA(0, 1, At, B1); PG8_BAR; PG8_SCHED;
            PG8_LDA(At, 0, 1); PG8_STAGE(PG8_SB(0, 0), b2, voffB); PG8_STAGE(PG8_SB(0, 1), b2 + hB, voffB); PG8_STAGE(PG8_SA(0, 0), a2, voffA);
            PG8_WAIT_V(8); PG8_WAIT_L(0); PG8_BAR; PG8_MMA(1, 0, At, B0); PG8_MMA(1, 1, At, B1); PG8_BAR; PG8_SCHED;
            PG8_LDB(B0, 1, 0); PG8_LDB(B1, 1, 1); PG8_SCHED; PG8_LDA(At, 1, 0); PG8_STAGE(PG8_SA(0, 1), a2 + hA, voffA);
            PG8_WAIT_V(8); PG8_WAIT_L(0); PG8_BAR; PG8_MMA(0, 0, At, B0); PG8_MMA(0, 1, At, B1); PG8_BAR; PG8_SCHED;
            PG8_LDA(At, 1, 1); PG8_STAGE(PG8_SB(1, 0), b3, voffB); PG8_STAGE(PG8_SB(1, 1), b3 + hB, voffB); PG8_STAGE(PG8_SA(1, 0), a3, voffA);
            PG8_WAIT_V(8); PG8_WAIT_L(0); PG8_BAR; PG8_MMA(1, 0, At, B0); PG8_MMA(1, 1, At, B1); PG8_BAR; PG8_SCHED;
        }
        if constexpr (ALIGN_EPI) { if (wr == 0) PG8_BAR; }
        E(acc, cur, wr, wc, fr, fq);
        if (!has_next) break;
#pragma unroll
        for (int a = 0; a < 2; ++a)
#pragma unroll
            for (int b = 0; b < 2; ++b)
#pragma unroll
                for (int m = 0; m < 4; ++m)
#pragma unroll
                    for (int n = 0; n < 2; ++n) acc[a][b][m][n] = (f32x4){0.f, 0.f, 0.f, 0.f};
        cur = nxt; cA = nA; cB = nB; ++ui;
        if constexpr (ALIGN_EPI) { if (wr == 1) PG8_BAR; }
    }
    PG8_WAIT_V(0);
    if constexpr (!ALIGN_EPI) { if (wr == 0) PG8_BAR; }
    PG8_BAR;
#undef PG8_SA
#undef PG8_SB
#undef PG8_STAGE
#undef PG8_LDA
#undef PG8_LDB
#undef PG8_MMA
#undef PG8_WAIT_V
#undef PG8_WAIT_L
#undef PG8_BAR
#undef PG8_SCHED
}
template <class Epi>
__device__ __forceinline__ void gemm_phase2(LAS unsigned char* lds, const Gemm g0, const Gemm g1, const StaticOrder& S, const Epi& E) {
    const int tid = otid(), wid = __builtin_amdgcn_readfirstlane(tid >> 6), lane = tid & 63, wr = wid >> 2, wc = wid & 3, fr = lane & 15, fq = lane >> 4;
#define PG8_MKOFF(vA, vB, G) do { _Pragma("unroll") for (int i_ = 0; i_ < 2; ++i_) { int R_, C_; stage_rc(tid * 16 + i_ * 8192, R_, C_); const int Rb_ = (R_ & ~31) + perm32(R_ & 31); \
        (vA)[i_] = (unsigned)(R_ * (G).lda + C_) * 2u; (vB)[i_] = (unsigned)(Rb_ * (G).ldb + C_) * 2u; } } while (0)
    const size_t kstep = (size_t)(BK * 2);
    const size_t hA0 = (size_t)HALF * g0.lda * 2, hB0 = (size_t)HALF * g0.ldb * 2, hA1 = (size_t)HALF * g1.lda * 2, hB1 = (size_t)HALF * g1.ldb * 2;
    const unsigned ldsw = (unsigned)wid * 1024u;
    const int aoff = lds_byte(wr * 64 + fr, fq * 8), boff = lds_byte(wc * 32 + fr, fq * 8);
#define PG8_SA(b, h) (((b) * 2 + (h)) * HTB)
#define PG8_SB(b, h) ((4 + (b) * 2 + (h)) * HTB)
#define PG8_STAGE(bufoff, gbase, voff) do { _Pragma("unroll") for (int _i = 0; _i < 2; ++_i) \
        __builtin_amdgcn_global_load_lds((const unsigned*)((const char*)(gbase) + (voff)[_i]), (LAS unsigned*)(lds + (bufoff) + ldsw + _i * 8192), 16, 0, 0); } while (0)
#define PG8_LDA(dst, b, h) do { _Pragma("unroll") for (int m = 0; m < 4; ++m) _Pragma("unroll") for (int k = 0; k < 2; ++k) dst[m][k] = *(const LAS bf16x8*)(lds + PG8_SA(b, h) + aoff + m * 2048 + k * 1024); } while (0)
#define PG8_LDB(dst, b, h) do { _Pragma("unroll") for (int n = 0; n < 2; ++n) _Pragma("unroll") for (int k = 0; k < 2; ++k) dst[n][k] = *(const LAS bf16x8*)(lds + PG8_SB(b, h) + boff + n * 2048 + k * 1024); } while (0)
#define PG8_MMA(ai, bj, At, Bt) do { __builtin_amdgcn_s_setprio(1); _Pragma("unroll") for (int m = 0; m < 4; ++m) _Pragma("unroll") for (int n = 0; n < 2; ++n) _Pragma("unroll") for (int k = 0; k < 2; ++k) \
        acc[ai][bj][m][n] = __builtin_amdgcn_mfma_f32_16x16x32_bf16(Bt[n][k], At[m][k], acc[ai][bj][m][n], 0, 0, 0); __builtin_amdgcn_s_setprio(0); } while (0)
#define PG8_WAIT_V(n) asm volatile("s_waitcnt vmcnt(" #n ")" ::: "memory")
#define PG8_WAIT_L(n) asm volatile("s_waitcnt lgkmcnt(" #n ")" ::: "memory")
#define PG8_BAR __builtin_amdgcn_s_barrier()
#define PG8_SCHED __builtin_amdgcn_sched_barrier(0)
    Unit cur; int kind = 0;
    if (!S.next(0, cur)) return;
    f32x4 acc[2][2][4][2];
#pragma unroll
    for (int a = 0; a < 2; ++a)
#pragma unroll
        for (int b = 0; b < 2; ++b)
#pragma unroll
            for (int m = 0; m < 4; ++m)
#pragma unroll
                for (int n = 0; n < 2; ++n) acc[a][b][m][n] = (f32x4){0.f, 0.f, 0.f, 0.f};
    bf16x8 At[4][2], B0[2][2], B1[2][2];
    const char* cA = (const char*)g0.A + (size_t)cur.pm * (2 * hA0); const char* cB = (const char*)g0.Bt + (size_t)cur.pn * (2 * hB0);
    unsigned voffA[2], voffB[2]; PG8_MKOFF(voffA, voffB, g0); size_t hA = hA0, hB = hB0;
    PG8_STAGE(PG8_SB(0, 0), cB, voffB); PG8_STAGE(PG8_SB(0, 1), cB + hB, voffB); PG8_STAGE(PG8_SA(0, 0), cA, voffA); PG8_STAGE(PG8_SA(0, 1), cA + hA, voffA);
    if (wr == 1) PG8_BAR;
    PG8_WAIT_V(2); PG8_BAR;
    PG8_STAGE(PG8_SB(1, 0), cB + kstep, voffB); PG8_STAGE(PG8_SA(1, 0), cA + kstep, voffA); PG8_STAGE(PG8_SB(1, 1), cB + hB + kstep, voffB);
    PG8_WAIT_V(6); PG8_BAR;
    for (;;) {
        const bool has_next = kind == 0;
        const int nt = (kind == 0 ? g0.K : g1.K) / BK;
        const char* nA = has_next ? (const char*)g1.A + (size_t)cur.pm * (2 * hA1) : cA; const char* nB = has_next ? (const char*)g1.Bt + (size_t)cur.pn * (2 * hB1) : cB;
        for (int t = 0; t < nt; t += 2) {
            const bool last = (t == nt - 2);
            const char* a1 = cA + (size_t)(t + 1) * kstep;
            const char* a2 = last ? nA : cA + (size_t)(t + 2) * kstep; const char* b2 = last ? nB : cB + (size_t)(t + 2) * kstep;
            const char* a3 = a2 + kstep; const char* b3 = b2 + kstep;
            const bool sw = last && has_next;
            unsigned voffAn[2] = {voffA[0], voffA[1]}, voffBn[2] = {voffB[0], voffB[1]}; if (sw) PG8_MKOFF(voffAn, voffBn, g1);
            const size_t hAn = sw ? hA1 : hA, hBn = sw ? hB1 : hB;
            PG8_LDB(B0, 0, 0); PG8_LDB(B1, 0, 1); PG8_SCHED; PG8_LDA(At, 0, 0); PG8_STAGE(PG8_SA(1, 1), a1 + hA, voffA);
            PG8_WAIT_V(8); PG8_WAIT_L(0); PG8_BAR; PG8_MMA(0, 0, At, B0); PG8_MMA(0, 1, At, B1); PG8_BAR; PG8_SCHED;
            PG8_LDA(At, 0, 1); PG8_STAGE(PG8_SB(0, 0), b2, voffBn); PG8_STAGE(PG8_SB(0, 1), b2 + hBn, voffBn); PG8_STAGE(PG8_SA(0, 0), a2, voffAn);
            PG8_WAIT_V(8); PG8_WAIT_L(0); PG8_BAR; PG8_MMA(1, 0, At, B0); PG8_MMA(1, 1, At, B1); PG8_BAR; PG8_SCHED;
            PG8_LDB(B0, 1, 0); PG8_LDB(B1, 1, 1); PG8_SCHED; PG8_LDA(At, 1, 0); PG8_STAGE(PG8_SA(0, 1), a2 + hAn, voffAn);
            PG8_WAIT_V(8); PG8_WAIT_L(0); PG8_BAR; PG8_MMA(0, 0, At, B0); PG8_MMA(0, 1, At, B1); PG8_BAR; PG8_SCHED;
            PG8_LDA(At, 1, 1); PG8_STAGE(PG8_SB(1, 0), b3, voffBn); PG8_STAGE(PG8_SB(1, 1), b3 + hBn, voffBn); PG8_STAGE(PG8_SA(1, 0), a3, voffAn);
            PG8_WAIT_V(8); PG8_WAIT_L(0); PG8_BAR; PG8_MMA(1, 0, At, B0); PG8_MMA(1, 1, At, B1); PG8_BAR; PG8_SCHED;
        }
        if (wr == 0) PG8_BAR;
        E(acc, cur, kind, wr, wc, fr, fq);
        if (!has_next) break;
#pragma unroll
        for (int a = 0; a < 2; ++a)
#pragma unroll
            for (int b = 0; b < 2; ++b)
#pragma unroll
                for (int m = 0; m < 4; ++m)
#pragma unroll
                    for (int n = 0; n < 2; ++n) acc[a][b][m][n] = (f32x4){0.f, 0.f, 0.f, 0.f};
        cA = nA; cB = nB; kind = 1; PG8_MKOFF(voffA, voffB, g1); hA = hA1; hB = hB1;
        if (wr == 1) PG8_BAR;
    }
    PG8_WAIT_V(0);
    PG8_BAR;
#undef PG8_SA
#undef PG8_SB
#undef PG8_STAGE
#undef PG8_LDA
#undef PG8_LDB
#undef PG8_MMA
#undef PG8_WAIT_V
#undef PG8_WAIT_L
#undef PG8_BAR
#undef PG8_SCHED
#undef PG8_MKOFF
}
}

typedef f32x4 Acc[2][2][4][2];
__device__ __forceinline__ u32x4 pack8(f32x4 a, f32x4 b) { u32x4 w; w.x = cvtpk(a[0], a[1]); w.y = cvtpk(a[2], a[3]); w.z = cvtpk(b[0], b[1]); w.w = cvtpk(b[2], b[3]); return w; }
__device__ __forceinline__ void unpack8(u32x4 w, f32x4& a, f32x4& b) { a = (f32x4){bflo(w.x), bfhi(w.x), bflo(w.y), bfhi(w.y)}; b = (f32x4){bflo(w.z), bfhi(w.z), bflo(w.w), bfhi(w.w)}; }

struct EpiInProj {
    unsigned char* ws; bf16_t* gm; const float* bmerge;
    __device__ __forceinline__ void operator()(const Acc& acc, const pg8::Unit& u, int wr, int wc, int fr, int fq) const {
        const int pn = u.pn;
        bf16_t* dst; int ldc, cb, mode; size_t bjs = 128; unsigned char* dst8 = nullptr;
        if (pn < 4)       { dst = (bf16_t*)(ws + WS_U);   ldc = 1024; cb = pn * 256;        mode = 0; }
        else if (pn < 8)  { dst = (bf16_t*)(ws + WS_GP);  ldc = 1024; cb = (pn - 4) * 256;  mode = 1; }
        else if (pn < 16) { dst = (bf16_t*)(ws + WS_Q);   ldc = 2048; cb = (pn - 8) * 256;  mode = 3; dst8 = ws + WS_Q8; }
        else if (pn < 28) { const int k = (pn - 16) >> 1; dst = (bf16_t*)(ws + WS_KCR + (size_t)k * (8 * MiB)); ldc = 512; cb = ((pn - 16) & 1) * 256; mode = (k == 2 || k == 4) ? 3 : 0;
                            if (k < 2) { ldc = 128; cb = 0; bjs = (size_t)S * 128; dst += (size_t)((pn - 16) & 1) * 2 * S * 128; }
                            else { dst8 = ws + (k == 2 ? WS_K8S : k == 3 ? WS_V8S : k == 4 ? WS_K8W : WS_V8W); dst = nullptr; } }
        else if (pn < 36) { dst = (bf16_t*)(ws + WS_GN);  ldc = 2048; cb = (pn - 28) * 256; mode = 1; }
        else if (pn < 52) { dst = gm;                     ldc = 4096; cb = (pn - 36) * 256; mode = 2; }
        else              { dst = (bf16_t*)(ws + WS_GBR); ldc = 256;  cb = 0;               mode = 4; }
        const int row0 = u.pm * 256 + wr * 64 + fr, cl = wc * 32 + 8 * fq, col0 = cb + cl;
        const float* rcos = (const float*)(ws + WS_ROPE); const float* rsin = rcos + (size_t)S * 64;
#pragma unroll
        for (int ai = 0; ai < 2; ++ai)
#pragma unroll
            for (int m = 0; m < 4; ++m) {
                const int row = row0 + ai * 128 + m * 16;
                bf16_t* rowp = dst + (size_t)row * ldc + col0;
                f32x4 cs0, cs1, sn0, sn1;
                if (mode == 3) { const int i0 = (cl & 127) >> 1; cs0 = *(const f32x4*)(rcos + (size_t)row * 64 + i0); sn0 = *(const f32x4*)(rsin + (size_t)row * 64 + i0); }
#pragma unroll
                for (int bj = 0; bj < 2; ++bj) {
                    f32x4 v0 = acc[ai][bj][m][0], v1 = acc[ai][bj][m][1];
                    if (mode == 1) { for (int e = 0; e < 4; ++e) { v0[e] = siluf_(v0[e]); v1[e] = siluf_(v1[e]); } }
                    else if (mode == 2 || mode == 4) { if (mode == 2) { v0 = v0 + *(const f32x4*)(bmerge + col0 + bj * 128); v1 = v1 + *(const f32x4*)(bmerge + col0 + bj * 128 + 4); } for (int e = 0; e < 4; ++e) { v0[e] = sigmoidf_(v0[e]); v1[e] = sigmoidf_(v1[e]); } }
                    else if (mode == 3) {
                        f32x4 o0, o1;
                        o0[0] = v0[0] * cs0[0] - v0[1] * sn0[0]; o0[1] = v0[1] * cs0[0] + v0[0] * sn0[0];
                        o0[2] = v0[2] * cs0[1] - v0[3] * sn0[1]; o0[3] = v0[3] * cs0[1] + v0[2] * sn0[1];
                        o1[0] = v1[0] * cs0[2] - v1[1] * sn0[2]; o1[1] = v1[1] * cs0[2] + v1[0] * sn0[2];
                        o1[2] = v1[2] * cs0[3] - v1[3] * sn0[3]; o1[3] = v1[3] * cs0[3] + v1[2] * sn0[3];
                        v0 = o0; v1 = o1;
                    }
                    if (dst) *(u32x4*)(rowp + bj * bjs) = pack8(v0, v1);
                    if (dst8) { u32x2 w8; w8.x = cvt4_fp8(v0[0], v0[1], v0[2], v0[3]); w8.y = cvt4_fp8(v1[0], v1[1], v1[2], v1[3]); *(u32x2*)(dst8 + (size_t)row * ldc + col0 + bj * 128) = w8; }
                }
            }
    }
};
struct EpiYa {
    bf16_t* yag; const bf16_t* gm;
    __device__ __forceinline__ void operator()(const Acc& acc, const pg8::Unit& u, int wr, int wc, int fr, int fq) const {
        const int row0 = u.pm * 256 + wr * 64 + fr, col0 = u.pn * 256 + wc * 32 + 8 * fq;
#pragma unroll
        for (int ai = 0; ai < 2; ++ai)
#pragma unroll
            for (int m = 0; m < 4; ++m) { int ro_ = ai * 128 + m * 16; asm volatile("" : "+v"(ro_)); const size_t r = (size_t)(row0 + ro_);
#pragma unroll
                for (int bj = 0; bj < 2; ++bj) { f32x4 g0, g1; unpack8(*(const u32x4*)(gm + r * 4096 + col0 + bj * 128), g0, g1);
                    *(u32x4*)(yag + r * 2048 + col0 + bj * 128) = pack8(acc[ai][bj][m][0] * g0, acc[ai][bj][m][1] * g1); } }
    }
};
struct EpiYb {
    bf16_t* merged; const bf16_t* yag; const bf16_t* gm;
    __device__ __forceinline__ void operator()(const Acc& acc, const pg8::Unit& u, int wr, int wc, int fr, int fq) const {
        const int row0 = u.pm * 256 + wr * 64 + fr, col0 = u.pn * 256 + wc * 32 + 8 * fq;
#pragma unroll
        for (int ai = 0; ai < 2; ++ai)
#pragma unroll
            for (int m = 0; m < 4; ++m) { int ro_ = ai * 128 + m * 16; asm volatile("" : "+v"(ro_)); const size_t r = (size_t)(row0 + ro_);
#pragma unroll
                for (int bj = 0; bj < 2; ++bj) { f32x4 g0, g1, y0, y1; unpack8(*(const u32x4*)(gm + r * 4096 + 2048 + col0 + bj * 128), g0, g1);
                    unpack8(*(const u32x4*)(yag + r * 2048 + col0 + bj * 128), y0, y1);
                    *(u32x4*)(merged + r * 2048 + col0 + bj * 128) = pack8(y0 + acc[ai][bj][m][0] * g0, y1 + acc[ai][bj][m][1] * g1); } }
    }
};
struct EpiYaYb {
    EpiYa ya; EpiYb yb;
    __device__ __forceinline__ void operator()(const Acc& acc, const pg8::Unit& u, int kind, int wr, int wc, int fr, int fq) const {
        if (kind == 0) { ya(acc, u, wr, wc, fr, fq); asm volatile("s_waitcnt vmcnt(0)" ::: "memory"); } else yb(acc, u, wr, wc, fr, fq);
    }
};
constexpr int NSPLIT = 8;
struct EpiSlab {
    float* slab;
    __device__ __forceinline__ void operator()(const Acc& acc, const pg8::Unit& u, int wr, int wc, int fr, int fq) const {
        float* base = slab + ((size_t)((u.pm >> 3) * NSPLIT + u.pn) * 2048 + (size_t)(u.pm & 7) * 256 + wr * 64 + fr) * 256 + wc * 32 + 8 * fq;
#pragma unroll
        for (int ai = 0; ai < 2; ++ai)
#pragma unroll
            for (int m = 0; m < 4; ++m)
#pragma unroll
                for (int bj = 0; bj < 2; ++bj) { float* p = base + (size_t)(ai * 128 + m * 16) * 256 + bj * 128; *(f32x4*)p = acc[ai][bj][m][0]; *(f32x4*)(p + 4) = acc[ai][bj][m][1]; }
    }
};
constexpr int CW_PANEL = 16384;
constexpr int EPI_LDS_OFF = RING_BYTES + 1024;
struct EpiOut {
    float* out; const float* x; float* ssq; const float* fw; unsigned* ctl; LAS unsigned char* lds;
    __device__ __forceinline__ void operator()(const Acc& acc_, const pg8::Unit& u, int wr, int wc, int fr, int fq) const {
        Acc& acc = const_cast<Acc&>(acc_);
        const int tid = otid();
        const int row0 = u.pm * 256 + wr * 64 + fr, col0 = u.pn * 256 + wc * 32 + 8 * fq;
        LAS float* rs = (LAS float*)(lds + EPI_LDS_OFF);
#pragma unroll
        for (int ai = 0; ai < 2; ++ai)
#pragma unroll
            for (int m = 0; m < 4; ++m) { const size_t r = (size_t)(row0 + ai * 128 + m * 16); float q = 0.f;
#pragma unroll
                for (int bj = 0; bj < 2; ++bj)
#pragma unroll
                    for (int n = 0; n < 2; ++n) { const size_t o = r * 2048 + col0 + bj * 128 + 4 * n; const f32x4 v = *(const f32x4*)(x + o) + acc[ai][bj][m][n];
                        acc[ai][bj][m][n] = v; q += (v[0] * v[0] + v[1] * v[1]) + (v[2] * v[2] + v[3] * v[3]); }
                q += __shfl_xor(q, 16); q += __shfl_xor(q, 32);
                if (fq == 0) __hip_atomic_store((unsigned*)(ssq + (size_t)(u.pn * 4 + wc) * S + r), __float_as_uint(q), __ATOMIC_RELAXED, __HIP_MEMORY_SCOPE_AGENT); }
        asm volatile("s_waitcnt vmcnt(0)" ::: "memory");
        __syncthreads();
        if (tid == 0) { unsigned* c = ctl + CW_PANEL + 64 * u.pm;
            __hip_atomic_fetch_add(c, 1u, __ATOMIC_RELAXED, __HIP_MEMORY_SCOPE_AGENT);
            unsigned sp = 0; while (__hip_atomic_load(c, __ATOMIC_RELAXED, __HIP_MEMORY_SCOPE_AGENT) < 8u) { __builtin_amdgcn_s_sleep(2); if (++sp > (1u << 22)) break; }
            __builtin_amdgcn_fence(__ATOMIC_ACQUIRE, "agent"); asm volatile("s_waitcnt vmcnt(0)" ::: "memory"); }
        __syncthreads();
        if (tid < 256) { const size_t r = (size_t)u.pm * 256 + tid; float s = 0.f;
#pragma unroll 8
            for (int p = 0; p < 32; ++p) s += __uint_as_float(__hip_atomic_load((unsigned*)(ssq + (size_t)p * S + r), __ATOMIC_RELAXED, __HIP_MEMORY_SCOPE_AGENT));
            rs[tid] = 1.0f / sqrtf(s * (1.f / DM) + EPS); }
        __syncthreads();
#pragma unroll
        for (int ai = 0; ai < 2; ++ai)
#pragma unroll
            for (int m = 0; m < 4; ++m) { const int rl = wr * 64 + fr + ai * 128 + m * 16; const float sc = rs[rl]; const size_t r = (size_t)u.pm * 256 + rl;
#pragma unroll
                for (int bj = 0; bj < 2; ++bj)
#pragma unroll
                    for (int n = 0; n < 2; ++n) { const size_t o = r * 2048 + col0 + bj * 128 + 4 * n; *(f32x4*)(out + o) = acc[ai][bj][m][n] * sc * *(const f32x4*)(fw + col0 + bj * 128 + 4 * n); } }
    }
};

struct Args { const float* in[17]; float* out; unsigned char* ws; int ph_lo, ph_hi; };
struct Frame { LAS unsigned char* lds; int tid, lane, wave, vcu, G; };

__device__ __forceinline__ int ropeperm(int d) { return d < 64 ? 2 * d : 2 * (d - 64) + 1; }
__device__ __forceinline__ void transpose_item(const float* W, int ldw, int Nvalid, bf16_t* WT, int ldt, int row_off, bool perm, LAS float* scr, int kb, int nb, int lane) {
    const int k0 = 64 * kb, n0 = 32 * nb, cq = lane & 7, rb = lane >> 3; const bool ok = n0 + cq * 4 < Nvalid;
    f32x4 v[8];
#pragma unroll
    for (int i = 0; i < 8; ++i) v[i] = ok ? *(const f32x4*)(W + (size_t)(k0 + i * 8 + rb) * ldw + n0 + cq * 4) : (f32x4){0.f, 0.f, 0.f, 0.f};
#pragma unroll
    for (int i = 0; i < 8; ++i) *(LAS f32x4*)(scr + (i * 8 + rb) * 32 + ((cq ^ i) << 2)) = v[i];
    LDS_WAIT(); asm volatile("" ::: "memory");
#pragma unroll
    for (int j = 0; j < 4; ++j) { const int idx = lane + 64 * j, n = idx >> 3, c = idx & 7; const LAS float* s = scr + (8 * c) * 32 + ((((n >> 2) ^ c) << 2) | (n & 3));
        u32x4 o; o.x = cvtpk(s[0 * 32], s[1 * 32]); o.y = cvtpk(s[2 * 32], s[3 * 32]); o.z = cvtpk(s[4 * 32], s[5 * 32]); o.w = cvtpk(s[6 * 32], s[7 * 32]);
        const int ng = n0 + n;
        if (ng < Nvalid) { const int dr = perm ? ((ng & ~127) | ropeperm(ng & 127)) : ng; *(GAS u32x4*)(WT + (size_t)(row_off + dr) * ldt + k0 + 8 * c) = o; } }
    LDS_WAIT(); asm volatile("" ::: "memory");
}

__device__ __forceinline__ void p0_prologue(const Frame& F, const Args& a) {
    unsigned char* ws = a.ws;
    LAS float* scr = (LAS float*)(F.lds + F.wave * 8192);
    const int gw = F.vcu * NWAVES + F.wave, NGW = F.G * NWAVES, lane = F.lane;
    constexpr int I_WIN = 32 * 258, I_WM = 32 * 128;
    for (int it = gw; it < I_WIN + I_WM; it += NGW) {
        int r = it;
        if (r < I_WIN) { const int kb = r / 258, nb = 32 + r % 258, n0 = nb * 32;
            const bool perm = (n0 >= 2048 && n0 < 4096) || (n0 >= 5120 && n0 < 5632) || (n0 >= 6144 && n0 < 6656);
            transpose_item(a.in[2], 9264, 9264, (bf16_t*)(ws + WS_WCAT), 2048, nb >= 288 ? 4096 : 0, perm, scr, kb, nb, lane); continue; } r -= I_WIN;
        transpose_item(a.in[13], 4096, 4096, (bf16_t*)(ws + WS_WCAT), 2048, 9216, false, scr, r / 128, r % 128, lane);
    }
    {
        const float* win = a.in[2]; const float* mix = a.in[3]; bf16_t* WC = (bf16_t*)(ws + WS_WCAT); const int r = lane & 31, hh = lane >> 5;
        for (int it = gw; it < 1024; it += NGW) {
            const int g = it >> 8, d0 = ((it >> 5) & 7) * 32, kin0 = (it & 31) * 64;
            f32x16 acc0 = f32x16{}, acc1 = f32x16{};
            const float* ap = mix + (size_t)g * 65536 + (size_t)(8 * hh) * 256 + d0 + r;
            const float* bp0 = win + (size_t)(kin0 + r) * 9264 + g * 256 + 8 * hh; const float* bp1 = bp0 + (size_t)32 * 9264;
#pragma unroll 4
            for (int k = 0; k < 16; ++k) {
                f32x4 a0, a1;
#pragma unroll
                for (int j = 0; j < 4; ++j) { a0[j] = ap[(size_t)(k * 16 + j) * 256]; a1[j] = ap[(size_t)(k * 16 + 4 + j) * 256]; }
                const u32x4 af = pack8(a0, a1), b0 = pack8(*(const f32x4*)(bp0 + k * 16), *(const f32x4*)(bp0 + k * 16 + 4)), b1 = pack8(*(const f32x4*)(bp1 + k * 16), *(const f32x4*)(bp1 + k * 16 + 4));
                acc0 = __builtin_amdgcn_mfma_f32_32x32x16_bf16(__builtin_bit_cast(bf16x8, af), __builtin_bit_cast(bf16x8, b0), acc0, 0, 0, 0);
                acc1 = __builtin_amdgcn_mfma_f32_32x32x16_bf16(__builtin_bit_cast(bf16x8, af), __builtin_bit_cast(bf16x8, b1), acc1, 0, 0, 0);
            }
#pragma unroll
            for (int e = 0; e < 16; ++e) { int ee = e; asm volatile("" : "+v"(ee)); bf16_t* rowp = WC + (size_t)(g * 256 + d0 + crow(ee, hh)) * 2048 + kin0 + r;
                const float v0 = acc0[e], v1 = acc1[e], n0_ = dpp_x1f(v0), n1_ = dpp_x1f(v1);
                if ((r & 1) == 0) { *(unsigned*)rowp = cvtpk(v0, n0_); *(unsigned*)(rowp + 32) = cvtpk(v1, n1_); } }
        }
    }
    for (int i = gw * 64 + lane; i < 53248; i += NGW * 64) *(GAS u32x4*)(ws + WS_WCAT + (size_t)13360 * 4096 + (size_t)i * 16) = (u32x4){0u, 0u, 0u, 0u};
    {
        const float* x = a.in[0]; const float* nw = a.in[1]; bf16_t* H = (bf16_t*)(ws + WS_H);
        f32x4 wv[8];
#pragma unroll
        for (int j = 0; j < 8; ++j) wv[j] = *((const f32x4*)nw + lane + 64 * j);
        for (int m = gw; m < S; m += NGW) {
            const f32x4* xr = (const f32x4*)(x + (size_t)m * DM) + lane; f32x4 v[8]; float s = 0.f;
#pragma unroll
            for (int j = 0; j < 8; ++j) { v[j] = xr[64 * j]; s += (v[j][0] * v[j][0] + v[j][1] * v[j][1]) + (v[j][2] * v[j][2] + v[j][3] * v[j][3]); }
            const float rstd = 1.0f / sqrtf(wave_sum(s) * (1.f / DM) + EPS);
            u32x2* o = (u32x2*)(H + (size_t)m * DM) + lane;
#pragma unroll
            for (int j = 0; j < 8; ++j) { const f32x4 y = v[j] * rstd * wv[j]; u32x2 w; w.x = cvtpk(y[0], y[1]); w.y = cvtpk(y[2], y[3]); o[64 * j] = w; }
        }
    }
    {
        float* rcos = (float*)(ws + WS_ROPE); float* rsin = rcos + (size_t)S * 64;
        for (int e = gw * 64 + lane; e < S * 64; e += NGW * 64) {
            const int pos = e >> 6, i = e & 63;
            double inv = 1.0, b = 0.86596432336006535;
            for (int k = i; k; k >>= 1) { if (k & 1) inv *= b; b *= b; }
            const double t = (double)pos * inv * 0.15915494309189535;
            const float fr = (float)(t - floor(t));
            rcos[e] = __builtin_amdgcn_cosf(fr); rsin[e] = __builtin_amdgcn_sinf(fr);
        }
    }
}
__device__ __forceinline__ void p1_late_weights(const Frame& F, const Args& a, int cw, int NCW) {
    unsigned char* ws = a.ws;
    LAS float* scr = (LAS float*)(F.lds + F.wave * 8192);
    const int lane = F.lane;
    constexpr int I_NO = 32 * 64, I_O = 32 * 64, I_PO = 16 * 64, I_W1 = 64 * 8, I_W2 = 4 * 4, I_B1 = 512;
    constexpr int NITEMS = I_NO + I_O + I_PO + 2 * I_W1 + 2 * I_W2 + I_B1;
    for (int it = cw; it < NITEMS; it += NCW) {
        int r = it;
        if (r < I_W1) { transpose_item(a.in[6], 256, 256, (bf16_t*)(ws + WS_W1KT), 4096, 0, false, scr, r / 8, r % 8, lane); continue; } r -= I_W1;
        if (r < I_W1) { transpose_item(a.in[9], 256, 256, (bf16_t*)(ws + WS_W1VT), 4096, 0, false, scr, r / 8, r % 8, lane); continue; } r -= I_W1;
        if (r < I_B1) {
            const int which = r >> 8, fb = (r >> 6) & 3, ch = r & 63, f = fb * 64 + lane;
            const float* pe = a.in[which ? 8 : 5]; const float* w1 = a.in[which ? 9 : 6]; float s = 0.f;
#pragma unroll 16
            for (int k = ch * 64; k < ch * 64 + 64; ++k) s += pe[k] * w1[(size_t)k * 256 + f];
            ((float*)(ws + WS_B1P))[(which * 64 + ch) * 256 + f] = s; continue; } r -= I_B1;
        if (r < I_W2) { transpose_item(a.in[7], 128, 128, (bf16_t*)(ws + WS_W2KT), 256, 0, true, scr, r / 4, r % 4, lane); continue; } r -= I_W2;
        if (r < I_W2) { transpose_item(a.in[10], 128, 128, (bf16_t*)(ws + WS_W2VT), 256, 0, false, scr, r / 4, r % 4, lane); continue; } r -= I_W2;
        if (r < I_PO) { transpose_item(a.in[11], 2048, 2048, (bf16_t*)(ws + WS_WPOT), 1024, 0, false, scr, r / 64, r % 64, lane); continue; } r -= I_PO;
        if (r < I_NO) { transpose_item(a.in[12], 2048, 2048, (bf16_t*)(ws + WS_WNOT), 2048, 0, false, scr, r / 64, r % 64, lane); continue; } r -= I_NO;
        transpose_item(a.in[15], 2048, 2048, (bf16_t*)(ws + WS_WOT), 2048, 0, false, scr, r / 64, r % 64, lane);
    }
}

template <int W>
__device__ __forceinline__ void ypool_item(const bf16_t* __restrict__ U, const bf16_t* __restrict__ GP, bf16_t* __restrict__ Y, const float* __restrict__ scale, int c, int t0) {
    u32x4 x[W + 7], gq[8];
#pragma unroll
    for (int k = 0; k < W + 7; ++k) { const int r = t0 - (W - 1) + k; x[k] = r >= 0 ? *(const u32x4*)(U + (size_t)r * 1024 + c) : (u32x4){0u, 0u, 0u, 0u}; }
#pragma unroll
    for (int k = 0; k < 8; ++k) gq[k] = *(const u32x4*)(GP + (size_t)(t0 + k) * 1024 + c);
    const f32x4 sc0 = *(const f32x4*)(scale + c), sc1 = *(const f32x4*)(scale + c + 4);
    f32x4 s0 = {0.f, 0.f, 0.f, 0.f}, s1 = s0, a0, a1;
#pragma unroll
    for (int k = 0; k < W - 1; ++k) { unpack8(x[k], a0, a1); s0 = s0 + a0; s1 = s1 + a1; }
#pragma unroll
    for (int k = 0; k < 8; ++k) { const int t = t0 + k;
        unpack8(x[W - 1 + k], a0, a1); s0 = s0 + a0; s1 = s1 + a1;
        const int cnt = (t + 1 < W) ? t + 1 : W; const float ic = 1.0f / (float)cnt;
        f32x4 g0, g1; unpack8(gq[k], g0, g1);
        *(u32x4*)(Y + (size_t)t * 1024 + c) = pack8((s0 * ic - a0) * sc0 * g0, (s1 * ic - a1) * sc1 * g1);
        f32x4 b0, b1; unpack8(x[k], b0, b1); s0 = s0 - b0; s1 = s1 - b1; }
}
__device__ __forceinline__ void p2_ypool(const Frame& F, unsigned char* ws, const float* __restrict__ scale, int cw, int NCW) {
    const bf16_t* __restrict__ U = (const bf16_t*)(ws + WS_U); const bf16_t* __restrict__ GP = (const bf16_t*)(ws + WS_GP); bf16_t* __restrict__ Y = (bf16_t*)(ws + WS_H + 16 * MiB);
    for (int wi = cw; wi < 4 * 512; wi += NCW) {
        const int g = wi & 3, t0 = ((wi >> 2) * 2 + (F.lane >> 5)) * 8, c = (g * 32 + (F.lane & 31)) * 8;
        if (g == 0) ypool_item<2>(U, GP, Y, scale, c, t0); else if (g == 1) ypool_item<4>(U, GP, Y, scale, c, t0);
        else if (g == 2) ypool_item<8>(U, GP, Y, scale, c, t0); else ypool_item<16>(U, GP, Y, scale, c, t0);
    }
}
__device__ __forceinline__ void p2_vt8(const Frame& F, unsigned char* ws, int cw, int NCW) {
    const int lane = F.lane;
    for (int it = cw; it < 1024; it += NCW) {
        const int which = it >> 9, h = (it >> 7) & 3, j = it & 127;
        const unsigned char* V8 = ws + (which ? WS_V8W : WS_V8S) + (size_t)(64 * j) * 512 + h * 128 + 2 * lane;
        unsigned char* T = ws + (which ? WS_V8TW : WS_V8TS) + (size_t)(h * 128 + j) * 8192 + (size_t)(2 * lane) * 64;
#pragma unroll
        for (int hb = 0; hb < 2; ++hb) {
            unsigned short e[32];
#pragma unroll
            for (int jj = 0; jj < 32; ++jj) { const int key = jj < 16 ? crow(jj, hb) : 32 + crow(jj - 16, hb); e[jj] = *(const unsigned short*)(V8 + (size_t)key * 512); }
            u32x4 a0, a1, b0, b1;
#pragma unroll
            for (int q = 0; q < 4; ++q) {
                a0[q] = (unsigned)(e[4*q] & 0xff) | ((unsigned)(e[4*q+1] & 0xff) << 8) | ((unsigned)(e[4*q+2] & 0xff) << 16) | ((unsigned)(e[4*q+3] & 0xff) << 24);
                a1[q] = (unsigned)(e[16+4*q] & 0xff) | ((unsigned)(e[16+4*q+1] & 0xff) << 8) | ((unsigned)(e[16+4*q+2] & 0xff) << 16) | ((unsigned)(e[16+4*q+3] & 0xff) << 24);
                b0[q] = (unsigned)(e[4*q] >> 8) | ((unsigned)(e[4*q+1] >> 8) << 8) | ((unsigned)(e[4*q+2] >> 8) << 16) | ((unsigned)(e[4*q+3] >> 8) << 24);
                b1[q] = (unsigned)(e[16+4*q] >> 8) | ((unsigned)(e[16+4*q+1] >> 8) << 8) | ((unsigned)(e[16+4*q+2] >> 8) << 16) | ((unsigned)(e[16+4*q+3] >> 8) << 24); }
            *(u32x4*)(T + hb * 32) = a0; *(u32x4*)(T + hb * 32 + 16) = a1; *(u32x4*)(T + 64 + hb * 32) = b0; *(u32x4*)(T + 64 + hb * 32 + 16) = b1;
        }
    }
}

__device__ __forceinline__ void p3_compress2(const Frame& F, unsigned char* ws, int cwg, int NCWG) {
    const int tid = F.tid, lane = F.lane, r = lane & 31, hh = lane >> 5, wave = F.wave;
    const float* rcos = (const float*)(ws + WS_ROPE); const float* rsin = rcos + (size_t)S * 64;
    LAS bf16_t* hl = (LAS bf16_t*)F.lds;
    for (int it = cwg; it < 128; it += NCWG) {
        const int which = it >> 6, rt = it & 63;
        { const int row = tid >> 4, f0 = (tid & 15) * 16;
          const float* sl = (const float*)(ws + WS_SLAB) + ((size_t)(which * NSPLIT) * 2048 + rt * 32 + row) * 256 + f0; const float* b1 = (const float*)(ws + WS_B1) + which * 256 + f0;
          f32x4 s[4];
#pragma unroll
          for (int q = 0; q < 4; ++q) s[q] = *(const f32x4*)(b1 + 4 * q);
#pragma unroll
          for (int ks = 0; ks < NSPLIT; ++ks)
#pragma unroll
              for (int q = 0; q < 4; ++q) s[q] = s[q] + *(const f32x4*)(sl + (size_t)ks * 2048 * 256 + 4 * q);
#pragma unroll
          for (int q = 0; q < 4; ++q)
#pragma unroll
              for (int e = 0; e < 4; ++e) s[q][e] = siluf_(s[q][e]);
          *(LAS u32x4*)(hl + row * 264 + f0) = pack8(s[0], s[1]); *(LAS u32x4*)(hl + row * 264 + f0 + 8) = pack8(s[2], s[3]); }
        __syncthreads();
        if (wave < 4) {
            const int ct = wave, row = rt * 32 + r;
            const bf16_t* W2 = (const bf16_t*)(ws + (which ? WS_W2VT : WS_W2KT)) + (size_t)(ct * 32 + r) * 256 + hh * 8;
            f32x16 acc = f32x16{};
#pragma unroll 4
            for (int k = 0; k < 16; ++k) acc = __builtin_amdgcn_mfma_f32_32x32x16_bf16(*(const bf16x8*)(W2 + k * 16), *(const LAS bf16x8*)(hl + r * 264 + k * 16 + hh * 8), acc, 0, 0, 0);
            const int n = row & 511; bf16_t* dst = (bf16_t*)(ws + (which ? WS_VC : WS_KC)) + (size_t)row * 128 + ct * 32 + 4 * hh;
            const int pos = (16 * n + 31) > S - 1 ? S - 1 : 16 * n + 31;
#pragma unroll
            for (int gq = 0; gq < 4; ++gq) {
                float v0 = acc[4 * gq], v1 = acc[4 * gq + 1], v2 = acc[4 * gq + 2], v3 = acc[4 * gq + 3];
                if (which == 0) { const int i = (ct * 32 + 8 * gq + 4 * hh) >> 1; const float c0 = rcos[(size_t)pos * 64 + i], s0 = rsin[(size_t)pos * 64 + i], c1 = rcos[(size_t)pos * 64 + i + 1], s1 = rsin[(size_t)pos * 64 + i + 1];
                    const float o0 = v0 * c0 - v1 * s0, o1 = v1 * c0 + v0 * s0, o2 = v2 * c1 - v3 * s1, o3 = v3 * c1 + v2 * s1; v0 = o0; v1 = o1; v2 = o2; v3 = o3; }
                u32x2 w; w.x = cvtpk(v0, v1); w.y = cvtpk(v2, v3); if (n == 511) { w.x = 0u; w.y = 0u; }
                *(u32x2*)(dst + 8 * gq) = w;
            }
        }
        __syncthreads();
    }
}

namespace nsa {
constexpr int SHM_V = 16384, SHM_K = 16384;
constexpr int L_V = 0, L_K = 3 * SHM_V, L_WS = L_K + 2 * SHM_K, L_IMP = L_WS + NWAVES * 64 * 4, IMP_LD = 129, L_SELM = L_IMP + 64 * IMP_LD * 4, L_END = L_SELM + 64 * 8 * 2;
static_assert(L_END <= RING_BYTES, "attention LDS");
constexpr float SCALE = 0.08838834764831845f, C2 = 1.4426950408889634f * SCALE, THR = 8.f;
#define KSWZ(row, colB) ((row) * 256 + ((colB) ^ (((row) & 7) << 4)))
#define SBAR() __builtin_amdgcn_sched_barrier(0)
#define LADD(p, v) (void)__hip_atomic_fetch_add((p), (v), __ATOMIC_RELAXED, __HIP_MEMORY_SCOPE_WORKGROUP)
__device__ __forceinline__ int v_st(int k, int c) { const int kk = (k & ~0xC) | ((k & 4) << 1) | ((k & 8) >> 1); return ((kk >> 3) * 4 + (c >> 5)) * 512 + ((kk & 7) * 32 + (c & 31)) * 2; }
__device__ __forceinline__ int v_rd_base(int lane) { return ((lane & 3) << 3) | (((lane >> 2) & 3) << 6) | (((lane >> 4) & 1) << 5) | (((lane >> 5) & 1) << 8); }
constexpr int v_rd_off(int d0, int ks, int half) { return d0 * 512 + ks * 4096 + half * 2048; }
__device__ __forceinline__ unsigned cvtpk_a(float lo, float hi) { unsigned r; asm volatile("v_cvt_pk_bf16_f32 %0, %1, %2" : "=v"(r) : "v"(lo), "v"(hi)); return r; }

__device__ __forceinline__ void mask_range(f32x16& p0, f32x16& p1, int dq, unsigned Wn) {
    const float NEG = -__builtin_inff();
#pragma unroll
    for (int r = 0; r < 16; ++r) { const int c = (r & 3) + 8 * (r >> 2);
        if ((unsigned)(dq + c) >= Wn) p0[r] = NEG;
        if ((unsigned)(dq + c + 32) >= Wn) p1[r] = NEG; }
}
__device__ __forceinline__ void mask_row(f32x16& p0, f32x16& p1, bool keep) {
    const float NEG = -__builtin_inff();
#pragma unroll
    for (int r = 0; r < 16; ++r) { p0[r] = keep ? p0[r] : NEG; p1[r] = keep ? p1[r] : NEG; }
}
__device__ __forceinline__ float rowmax32(const f32x16& p0, const f32x16& p1) {
    float pmax = p0[0];
#pragma unroll
    for (int r = 1; r < 16; ++r) pmax = fmaxf(pmax, p0[r]);
#pragma unroll
    for (int r = 0; r < 16; ++r) pmax = fmaxf(pmax, p1[r]);
    auto rr = __builtin_amdgcn_permlane32_swap(__float_as_uint(pmax), __float_as_uint(pmax), false, false);
    return fmaxf(__uint_as_float(rr[0]), __uint_as_float(rr[1]));
}
__device__ __forceinline__ float rowsum32(const f32x16& p0, const f32x16& p1) {
    float ps = 0.f;
#pragma unroll
    for (int r = 0; r < 16; ++r) ps += p0[r];
#pragma unroll
    for (int r = 0; r < 16; ++r) ps += p1[r];
    auto rr = __builtin_amdgcn_permlane32_swap(__float_as_uint(ps), __float_as_uint(ps), false, false);
    return __uint_as_float(rr[0]) + __uint_as_float(rr[1]);
}
__device__ __forceinline__ void pack_p(const f32x16& p0, const f32x16& p1, bf16x8& pa0, bf16x8& pa1, bf16x8& pa2, bf16x8& pa3) {
#define PK4(P, B_, OUT) do { unsigned a0 = cvtpk_a(P[B_+0], P[B_+1]), a1 = cvtpk_a(P[B_+2], P[B_+3]);                          \
        unsigned b0 = cvtpk_a(P[B_+4], P[B_+5]), b1 = cvtpk_a(P[B_+6], P[B_+7]);                                             \
        auto r0 = __builtin_amdgcn_permlane32_swap(a0, b0, false, false); auto r1 = __builtin_amdgcn_permlane32_swap(a1, b1, false, false); \
        u32x4 w = {r0[0], r1[0], r0[1], r1[1]}; OUT = __builtin_bit_cast(bf16x8, w); } while (0)
    PK4(p0, 0, pa0); PK4(p0, 8, pa1); PK4(p1, 0, pa2); PK4(p1, 8, pa3);
#undef PK4
}
__device__ __forceinline__ void qkt(f32x16& p0, f32x16& p1, const LAS unsigned char* K_buf, int r32, int hi, const bf16x8* qr) {
    p0 = f32x16{}; p1 = f32x16{};
    const LAS unsigned char* kb[4];
#pragma unroll
    for (int dd = 0; dd < 4; ++dd) kb[dd] = K_buf + KSWZ(r32, (dd * 16 + hi * 8) * 2);
#define KLD(F, d0) do { const LAS unsigned char* a_ = kb[(d0) & 3] + ((d0) >> 2) * 128; F##0 = *(const LAS bf16x8*)(a_); F##1 = *(const LAS bf16x8*)(a_ + 32 * 256); \
        const LAS unsigned char* c_ = kb[((d0) + 1) & 3] + (((d0) + 1) >> 2) * 128; F##2 = *(const LAS bf16x8*)(c_); F##3 = *(const LAS bf16x8*)(c_ + 32 * 256); } while (0)
#define KMM(F, d0) do { p0 = __builtin_amdgcn_mfma_f32_32x32x16_bf16(F##0, qr[d0], p0, 0, 0, 0); p1 = __builtin_amdgcn_mfma_f32_32x32x16_bf16(F##1, qr[d0], p1, 0, 0, 0); \
        p0 = __builtin_amdgcn_mfma_f32_32x32x16_bf16(F##2, qr[(d0) + 1], p0, 0, 0, 0); p1 = __builtin_amdgcn_mfma_f32_32x32x16_bf16(F##3, qr[(d0) + 1], p1, 0, 0, 0); } while (0)
    bf16x8 fa0, fa1, fa2, fa3, fb0, fb1, fb2, fb3;
    KLD(fa, 0); KLD(fb, 2); SBAR();
    KMM(fa, 0); KLD(fa, 4); SBAR();
    KMM(fb, 2); KLD(fb, 6); SBAR();
    KMM(fa, 4); SBAR();
    KMM(fb, 6);
#undef KLD
#undef KMM
}
struct VF8 { s16x4 l0, h0, l1, h1, l2, h2, l3, h3; };
#define TRRD(dst, off) asm volatile("ds_read_b64_tr_b16 %0, %1 offset:%2" : "=&v"(dst) : "v"(vb0), "i"(off) : "memory")
__device__ __forceinline__ void pv_read0(VF8& f, int vb0) {
    constexpr int b_ = v_rd_off(0, 0, 0);
    TRRD(f.l0, b_); TRRD(f.h0, b_ + 2048); TRRD(f.l1, b_ + 4096); TRRD(f.h1, b_ + 6144); TRRD(f.l2, b_ + 8192); TRRD(f.h2, b_ + 10240); TRRD(f.l3, b_ + 12288); TRRD(f.h3, b_ + 14336);
}
__device__ __forceinline__ void pv_tile(f32x16* o, int vb0, bf16x8 pa0, bf16x8 pa1, bf16x8 pa2, bf16x8 pa3, VF8& f) {
#define PV_MM(d0, l0, h0, l1, h1, l2, h2, l3, h3) do { \
        o[d0] = __builtin_amdgcn_mfma_f32_32x32x16_bf16(pa0, (bf16x8){l0[0], l0[1], l0[2], l0[3], h0[0], h0[1], h0[2], h0[3]}, o[d0], 0, 0, 0);   \
        o[d0] = __builtin_amdgcn_mfma_f32_32x32x16_bf16(pa1, (bf16x8){l1[0], l1[1], l1[2], l1[3], h1[0], h1[1], h1[2], h1[3]}, o[d0], 0, 0, 0);   \
        o[d0] = __builtin_amdgcn_mfma_f32_32x32x16_bf16(pa2, (bf16x8){l2[0], l2[1], l2[2], l2[3], h2[0], h2[1], h2[2], h2[3]}, o[d0], 0, 0, 0);   \
        o[d0] = __builtin_amdgcn_mfma_f32_32x32x16_bf16(pa3, (bf16x8){l3[0], l3[1], l3[2], l3[3], h3[0], h3[1], h3[2], h3[3]}, o[d0], 0, 0, 0); } while (0)
#define PV_D0(d0) do { s16x4 l0, l1, l2, l3, h0, h1, h2, h3; constexpr int b_ = v_rd_off(d0, 0, 0); \
        TRRD(l0, b_); TRRD(h0, b_ + 2048); TRRD(l1, b_ + 4096); TRRD(h1, b_ + 6144); TRRD(l2, b_ + 8192); TRRD(h2, b_ + 10240); TRRD(l3, b_ + 12288); TRRD(h3, b_ + 14336); \
        asm volatile("s_waitcnt lgkmcnt(0)" ::: "memory"); SBAR(); PV_MM(d0, l0, h0, l1, h1, l2, h2, l3, h3); } while (0)
    asm volatile("s_waitcnt lgkmcnt(0)" ::: "memory"); SBAR(); PV_MM(0, f.l0, f.h0, f.l1, f.h1, f.l2, f.h2, f.l3, f.h3);
    PV_D0(1); PV_D0(2); PV_D0(3);
#undef PV_D0
#undef PV_MM
}
#undef TRRD

enum { M_C1 = 0, M_C2 = 1, M_S = 2, M_W = 3 };
struct Stage { bf16x8 k0, k1, v0, v1; };
__device__ __forceinline__ void stage_load(Stage& sg, const bf16_t* Kp, const bf16_t* Vp, int ld, int j, bool hasv) {
    const int tid = otid(), sr = tid >> 4, sc = (tid & 15) * 8; const size_t k0_ = (size_t)j * 64;
    sg.k0 = *(const bf16x8*)(Kp + (k0_ + sr) * ld + sc); sg.k1 = *(const bf16x8*)(Kp + (k0_ + 32 + sr) * ld + sc);
    if (hasv) { sg.v0 = *(const bf16x8*)(Vp + (k0_ + sr) * ld + sc); sg.v1 = *(const bf16x8*)(Vp + (k0_ + 32 + sr) * ld + sc); }
}
struct RowState { float m, l; };
template <int MODE>
__device__ __forceinline__ void attn_pass(LAS unsigned char* lds, const bf16_t* Kp, const bf16_t* Vp, int ld, int j_lo, int j_hi, const bf16x8* qr, int t, int Tq, const u32x4 sel,
                                          RowState& st, float invl, f32x16* o, bool do_imp, Stage& sg) {
    constexpr bool HASV = MODE != M_C1;
    const int tid = otid(), wid = __builtin_amdgcn_readfirstlane(tid >> 6), lane = tid & 63, r32 = lane & 31, hi = lane >> 5;
    LAS unsigned char* V_lds = lds + L_V; LAS unsigned char* K_lds = lds + L_K;
    LAS float* wsf = (LAS float*)(lds + L_WS) + wid * 64; LAS float* al_l = wsf + 32;
    const int sr = tid >> 4, sc = (tid & 15) * 8, vst0 = v_st(sr, sc), vst1 = v_st(32 + sr, sc), kws = KSWZ(sr, sc * 2);
    const int vb0 = (int)(uintptr_t)V_lds + v_rd_base(lane);
    const int NT = j_hi - j_lo;
#define st_k0 sg.k0
#define st_k1 sg.k1
#define st_v0 sg.v0
#define st_v1 sg.v1
    float m_reg = st.m, l_reg = st.l;
#define SLOAD(j) do { const size_t k0_ = (size_t)(j) * 64; st_k0 = *(const bf16x8*)(Kp + (k0_ + sr) * ld + sc); st_k1 = *(const bf16x8*)(Kp + (k0_ + 32 + sr) * ld + sc); \
        if (HASV) { st_v0 = *(const bf16x8*)(Vp + (k0_ + sr) * ld + sc); st_v1 = *(const bf16x8*)(Vp + (k0_ + 32 + sr) * ld + sc); } } while (0)
#define SWRITE(kof, vof) do { *(LAS bf16x8*)(K_lds + (kof) + kws) = st_k0; *(LAS bf16x8*)(K_lds + (kof) + kws + 32 * 256) = st_k1; \
        if (HASV) { *(LAS bf16x8*)(V_lds + (vof) + vst0) = st_v0; *(LAS bf16x8*)(V_lds + (vof) + vst1) = st_v1; } } while (0)
    const bool late = HASV && wid >= 4;
    bf16x8 pa0, pa1, pa2, pa3;
    SWRITE(0, 0);
    __syncthreads();
    int kof = 0, vof = 0, vprev = 0;
    for (int idx = 0; idx < NT; ++idx) {
        const int j = j_lo + idx, kb = j * 64;
        if (idx + 1 < NT) SLOAD(j + 1);
        if (HASV && late && idx > 0) { SBAR(); VF8 vf; pv_read0(vf, vb0 + vprev); pv_tile(o, vb0 + vprev, pa0, pa1, pa2, pa3, vf); SBAR(); }
        f32x16 p0, p1; qkt(p0, p1, K_lds + kof, r32, hi, qr);
        VF8 vfe; if (HASV && !late) { SBAR(); pv_read0(vfe, vb0 + vof); SBAR(); }
#if EXP_QKT2
        asm volatile("" : "+v"(p0), "+v"(p1)); SBAR(); qkt(p0, p1, K_lds + kof, r32, hi, qr);
#endif
        if (MODE == M_C1 || MODE == M_C2) { const int nmax1 = ((t - 31) >> 4) + 1; mask_range(p0, p1, kb + 4 * hi, (unsigned)(nmax1 > 0 ? nmax1 : 0)); }
        else if (MODE == M_S) { if (j == Tq) mask_range(p0, p1, kb + 4 * hi, (unsigned)(t + 1));
                                else { const unsigned w_ = (j >> 5) == 0 ? sel.x : (j >> 5) == 1 ? sel.y : (j >> 5) == 2 ? sel.z : sel.w; mask_row(p0, p1, ((w_ >> (j & 31)) & 1u) != 0u); } }
        else { if (j == Tq || j + 8 <= Tq) mask_range(p0, p1, kb + 4 * hi - (t - 511), 512u); }
        if (MODE == M_C1) { const float pmax = rowmax32(p0, p1); const float mn = fmaxf(m_reg, pmax); const float alpha = __builtin_amdgcn_exp2f((m_reg - mn) * C2); m_reg = mn;
            const float mnL = -mn * C2;
#pragma unroll
            for (int r = 0; r < 16; ++r) { p0[r] = __builtin_amdgcn_exp2f(fmaf(p0[r], C2, mnL)); p1[r] = __builtin_amdgcn_exp2f(fmaf(p1[r], C2, mnL)); }
            l_reg = l_reg * alpha + rowsum32(p0, p1); }
        else if (MODE == M_C2) { const float mnL = -m_reg * C2;
#pragma unroll
            for (int r = 0; r < 16; ++r) { p0[r] = __builtin_amdgcn_exp2f(fmaf(p0[r], C2, mnL)) * invl; p1[r] = __builtin_amdgcn_exp2f(fmaf(p1[r], C2, mnL)) * invl; }
            if (do_imp) { LAS unsigned* imp = (LAS unsigned*)(lds + L_IMP) + ((wid & 1) * 32 + r32) * IMP_LD + 16 * j + hi;
#pragma unroll
                for (int k = 0; k < 4; ++k) {
                    { const float e_ = p0[4 * k + 3], a_ = 2.f * (p0[4 * k] + p0[4 * k + 1] + p0[4 * k + 2]) + e_;
                      LADD(imp + 2 * k, (unsigned)(a_ * 67108864.f + 0.5f)); LADD(imp + 2 * k + 1, (unsigned)(e_ * 67108864.f + 0.5f)); }
                    { const float e_ = p1[4 * k + 3], a_ = 2.f * (p1[4 * k] + p1[4 * k + 1] + p1[4 * k + 2]) + e_;
                      LADD(imp + 8 + 2 * k, (unsigned)(a_ * 67108864.f + 0.5f)); LADD(imp + 8 + 2 * k + 1, (unsigned)(e_ * 67108864.f + 0.5f)); } } }
            pack_p(p0, p1, pa0, pa1, pa2, pa3); }
        else { const float pmax = rowmax32(p0, p1); float mn, alpha;
            if (__builtin_expect(__all((pmax - m_reg) * SCALE <= THR), 1)) { mn = m_reg; alpha = 1.f; }
            else { mn = fmaxf(m_reg, pmax); alpha = __builtin_amdgcn_exp2f((m_reg - mn) * C2); m_reg = mn; }
            const float mnL = -mn * C2;
#pragma unroll
            for (int r = 0; r < 16; ++r) { p0[r] = __builtin_amdgcn_exp2f(fmaf(p0[r], C2, mnL)); p1[r] = __builtin_amdgcn_exp2f(fmaf(p1[r], C2, mnL)); }
            l_reg = l_reg * alpha + rowsum32(p0, p1);
            pack_p(p0, p1, pa0, pa1, pa2, pa3);
            if (__any(alpha < 1.f)) { if (hi == 0) al_l[r32] = alpha; asm volatile("s_waitcnt lgkmcnt(0)" ::: "memory");
#pragma unroll
                for (int d_ = 0; d_ < 4; ++d_)
#pragma unroll
                    for (int r = 0; r < 16; ++r) o[d_][r] *= al_l[crow(r, hi)]; } }
        if (HASV && !late) { SBAR(); pv_tile(o, vb0 + vof, pa0, pa1, pa2, pa3, vfe); }
        const int kn = kof ^ SHM_K, vn = (vof == 2 * SHM_V) ? 0 : vof + SHM_V;
        if (idx + 1 < NT) { SWRITE(kn, vn); }
        __syncthreads();
        vprev = vof; kof = kn; vof = vn;
    }
    if (HASV) { if (late) { SBAR(); VF8 vf; pv_read0(vf, vb0 + vprev); pv_tile(o, vb0 + vprev, pa0, pa1, pa2, pa3, vf); } __syncthreads(); }
    st.m = m_reg; st.l = l_reg;
#undef SLOAD
#undef SWRITE
#undef st_k0
#undef st_k1
#undef st_v0
#undef st_v1
}

typedef int v8i __attribute__((ext_vector_type(8)));
struct Stage8 { u32x4 k, v; };
constexpr int SHM8 = 8192;
constexpr float THR8 = 0.5f;
__device__ __forceinline__ f32x16 mfma8(v8i a, v8i b, f32x16 c) { return __builtin_amdgcn_mfma_scale_f32_32x32x64_f8f6f4(a, b, c, 0, 0, 0, 0x7F7F7F7F, 0, 0x7F7F7F7F); }
__device__ __forceinline__ int k8_off(int key, int c) { return key * 128 + ((c ^ ((key >> 1) & 7)) << 4); }
__device__ __forceinline__ int v8_off(int d, int c) { return d * 64 + ((c ^ ((d >> 2) & 3)) << 4); }
__device__ __forceinline__ void stage_load8(Stage8& sg, const unsigned char* K8h, const unsigned char* V8Th, int j) {
    const int tid = otid();
    sg.k = *(const u32x4*)(K8h + (size_t)(64 * j + (tid >> 3)) * 512 + (tid & 7) * 16); sg.v = *(const u32x4*)(V8Th + (size_t)j * 8192 + tid * 16);
}
__device__ __forceinline__ v8i ld_v8i(const LAS unsigned char* a, const LAS unsigned char* b) { const u32x4 x = *(const LAS u32x4*)a, y = *(const LAS u32x4*)b; return (v8i){(int)x.x, (int)x.y, (int)x.z, (int)x.w, (int)y.x, (int)y.y, (int)y.z, (int)y.w}; }
template <int MODE>
__device__ __forceinline__ void attn_pass8(LAS unsigned char* lds, const unsigned char* K8h, const unsigned char* V8Th, int j_lo, int j_hi, const v8i* qf, int t, int Tq, const u32x4 sel,
                                           RowState& st, f32x16* o, f32x16& ol, Stage8& sg0) {
    const int tid = otid(), wid = __builtin_amdgcn_readfirstlane(tid >> 6), lane = tid & 63, r32 = lane & 31, hi = lane >> 5;
    LAS unsigned char* V_lds = lds + L_V; LAS unsigned char* K_lds = lds + L_K;
    LAS float* wsf = (LAS float*)(lds + L_WS) + wid * 64; LAS float* al_l = wsf + 32;
    const int kws = k8_off(tid >> 3, tid & 7), vws = v8_off(tid >> 2, tid & 3);
    const int NT = j_hi - j_lo;
    float m_reg = st.m;
#define SWRITE8(SG, kof, vof) do { *(LAS u32x4*)(K_lds + (kof) + kws) = (SG).k; *(LAS u32x4*)(V_lds + (vof) + vws) = (SG).v; } while (0)
    const bool late = wid >= 4;
    v8i pa; Stage8 sg1;
    const v8i ones = {0x38383838, 0x38383838, 0x38383838, 0x38383838, 0x38383838, 0x38383838, 0x38383838, 0x38383838};
    SWRITE8(sg0, 0, 0);
    __syncthreads();
    if (NT > 1) stage_load8(sg1, K8h, V8Th, j_lo + 1);
    int kof = 0, vof = 0, vprev = 0;
#define PV8(vo) do { const LAS unsigned char* vb_ = V_lds + (vo);                                                                      \
        _Pragma("unroll") for (int d0 = 0; d0 < 4; ++d0) { const int d_ = d0 * 32 + r32;                                               \
            o[d0] = mfma8(pa, ld_v8i(vb_ + v8_off(d_, 2 * hi), vb_ + v8_off(d_, 2 * hi + 1)), o[d0]); }                                \
        ol = mfma8(pa, ones, ol); } while (0)
#define TILE8(idx, SGL, SGW) do { const int j = j_lo + (idx), kb = j * 64;                                                               \
        if ((idx) + 2 < NT) stage_load8(SGL, K8h, V8Th, j + 2);                                                                        \
        if (late && (idx) > 0) { SBAR(); PV8(vprev); SBAR(); }                                                                         \
        f32x16 p0 = f32x16{}, p1 = f32x16{};                                                                                           \
        { const LAS unsigned char* kb_ = K_lds + kof;                                                                                  \
          _Pragma("unroll") for (int ks = 0; ks < 2; ++ks) {                                                                           \
              p0 = mfma8(ld_v8i(kb_ + k8_off(r32, 4 * ks + 2 * hi), kb_ + k8_off(r32, 4 * ks + 2 * hi + 1)), qf[ks], p0);               \
              p1 = mfma8(ld_v8i(kb_ + k8_off(32 + r32, 4 * ks + 2 * hi), kb_ + k8_off(32 + r32, 4 * ks + 2 * hi + 1)), qf[ks], p1); } } \
        bool rowkeep = true;                                                                                                           \
        if (MODE == M_S) { if (j == Tq) mask_range(p0, p1, kb + 4 * hi, (unsigned)(t + 1));                                             \
                           else { const unsigned w_ = (j >> 5) == 0 ? sel.x : (j >> 5) == 1 ? sel.y : (j >> 5) == 2 ? sel.z : sel.w; rowkeep = ((w_ >> (j & 31)) & 1u) != 0u; } } \
        else { if (j == Tq || j + 8 <= Tq) mask_range(p0, p1, kb + 4 * hi - (t - 511), 512u); }                                          \
        { float pmax = rowmax32(p0, p1); if (MODE == M_S) pmax = rowkeep ? pmax : -__builtin_inff(); float mn, alpha;                  \
          if (__builtin_expect(__all((pmax - m_reg) * SCALE <= THR8), 1)) { mn = m_reg; alpha = 1.f; }                                 \
          else { mn = fmaxf(m_reg, pmax); alpha = __builtin_amdgcn_exp2f((m_reg - mn) * C2); m_reg = mn; }                             \
          float mnL = 8.0f - mn * C2;                                                                                                  \
          if (MODE == M_S) mnL = rowkeep ? mnL : -__builtin_inff();                                                                    \
          _Pragma("unroll") for (int r = 0; r < 16; ++r) { p0[r] = __builtin_amdgcn_exp2f(fmaf(p0[r], C2, mnL)); p1[r] = __builtin_amdgcn_exp2f(fmaf(p1[r], C2, mnL)); } \
          _Pragma("unroll") for (int q = 0; q < 4; ++q) { pa[q] = (int)cvt4_fp8(p0[4 * q], p0[4 * q + 1], p0[4 * q + 2], p0[4 * q + 3]); pa[4 + q] = (int)cvt4_fp8(p1[4 * q], p1[4 * q + 1], p1[4 * q + 2], p1[4 * q + 3]); } \
          if (__any(alpha < 1.f)) { if (hi == 0) al_l[r32] = alpha; asm volatile("s_waitcnt lgkmcnt(0)" ::: "memory");                 \
              _Pragma("unroll") for (int r = 0; r < 16; ++r) { const float a_ = al_l[crow(r, hi)]; o[0][r] *= a_; o[1][r] *= a_; o[2][r] *= a_; o[3][r] *= a_; ol[r] *= a_; } } } \
        if (!late) { SBAR(); PV8(vof); }                                                                                               \
        const int kn = kof ^ SHM8, vn = (vof == 2 * SHM8) ? 0 : vof + SHM8;                                                            \
        if ((idx) + 1 < NT) { SWRITE8(SGW, kn, vn); }                                                                                  \
        __syncthreads();                                                                                                               \
        vprev = vof; kof = kn; vof = vn; } while (0)
    int idx = 0;
    for (; idx + 1 < NT; idx += 2) { TILE8(idx, sg0, sg1); TILE8(idx + 1, sg1, sg0); }
    if (idx < NT) TILE8(idx, sg0, sg1);
    if (late) { SBAR(); PV8(vprev); }
    __syncthreads();
    st.m = m_reg;
#undef TILE8
#undef PV8
#undef SWRITE8
}

template <int MODE, bool USE_OL>
__device__ __forceinline__ void branch_out(LAS unsigned char* lds, const f32x16* o, float rowscale, bf16_t* onsa_w, const bf16_t* gn_w, const f32x16 ol) {
    const int tid = otid(), wid = __builtin_amdgcn_readfirstlane(tid >> 6), lane = tid & 63, r32 = lane & 31, hi = lane >> 5;
    LAS float* li_l = (LAS float*)(lds + L_WS) + wid * 64;
    if (hi == 0) li_l[r32] = rowscale; asm volatile("s_waitcnt lgkmcnt(0)" ::: "memory");
    LAS unsigned* stg = (LAS unsigned*)(lds + wid * 8192);
#pragma unroll
    for (int r = 0; r < 16; ++r) { const int orow = crow(r, hi); float sc = li_l[orow]; if (USE_OL) sc = ol[r] > 0.f ? sc * __builtin_amdgcn_rcpf(ol[r]) : 0.f;
#pragma unroll
        for (int d0 = 0; d0 < 4; ++d0) { const float v = o[d0][r] * sc; const float vn = dpp_x1f(v);
            if ((r32 & 1) == 0) stg[orow * 64 + d0 * 16 + (r32 >> 1)] = cvtpk(v, vn); } }
    asm volatile("s_waitcnt lgkmcnt(0)" ::: "memory");
    u32x4 val[8], prev[8], gq[8];
#pragma unroll
    for (int i = 0; i < 8; ++i) val[i] = *(const LAS u32x4*)(stg + (i * 4 + (lane >> 4)) * 64 + (lane & 15) * 4);
    int rb = lane >> 4; asm volatile("" : "+v"(rb));
    bf16_t* gp_ = onsa_w + (size_t)rb * 2048 + (lane & 15) * 8; const bf16_t* gg_ = gn_w + (size_t)rb * 2048 + (lane & 15) * 8;
    if (MODE >= 1) {
#pragma unroll
        for (int i = 0; i < 8; ++i) prev[i] = *(const u32x4*)(gp_ + (size_t)i * 4 * 2048); }
    if (MODE == 2) {
#pragma unroll
        for (int i = 0; i < 8; ++i) gq[i] = *(const u32x4*)(gg_ + (size_t)i * 4 * 2048); }
#pragma unroll
    for (int i = 0; i < 8; ++i) { u32x4 w = val[i];
        if (MODE >= 1) { f32x4 a0, a1, b0, b1; unpack8(val[i], a0, a1); unpack8(prev[i], b0, b1); a0 = a0 + b0; a1 = a1 + b1;
            if (MODE == 2) { f32x4 g0, g1; unpack8(gq[i], g0, g1); a0 = a0 * g0; a1 = a1 * g1; }
            w = pack8(a0, a1); }
        *(u32x4*)(gp_ + (size_t)i * 4 * 2048) = w; }
    __syncthreads();
}

__device__ __forceinline__ void attn_unit(LAS unsigned char* lds, unsigned char* ws, int h, int Tq) {
    const int tid = otid(), wid = __builtin_amdgcn_readfirstlane(tid >> 6), lane = tid & 63, r32 = lane & 31, hi = lane >> 5;
    const int g = wid >> 1, tl = (wid & 1) * 32 + r32, t = Tq * 64 + tl, hq = 4 * h + g;
    const bf16_t* Q = (const bf16_t*)(ws + WS_Q); const bf16_t* GBR = (const bf16_t*)(ws + WS_GBR);
    bf16_t* onsa_w = (bf16_t*)(ws + WS_ONSA) + (size_t)(Tq * 64 + (wid & 1) * 32) * 2048 + hq * 128; const bf16_t* gn_w = (const bf16_t*)(ws + WS_GN) + (size_t)(Tq * 64 + (wid & 1) * 32) * 2048 + hq * 128;
    bf16x8 qr[8];
#pragma unroll
    for (int d0 = 0; d0 < 8; ++d0) qr[d0] = *(const bf16x8*)(Q + (size_t)t * 2048 + hq * 128 + d0 * 16 + hi * 8);
    const float g_c = bf2f(GBR[(size_t)t * 256 + hq * 3 + 0]), g_s = bf2f(GBR[(size_t)t * 256 + hq * 3 + 1]), g_w = bf2f(GBR[(size_t)t * 256 + hq * 3 + 2]);
    const bool big = Tq >= 16;
    LAS unsigned* IMP = (LAS unsigned*)(lds + L_IMP);
    if (big) { for (int i = tid; i < 64 * IMP_LD; i += 512) IMP[i] = 0u; }
    const u32x4 nosel = {0u, 0u, 0u, 0u};
    f32x16 o[4]; Stage sg;
    {
        const bf16_t* Kc = (const bf16_t*)(ws + WS_KC) + (size_t)h * 512 * 128; const bf16_t* Vc = (const bf16_t*)(ws + WS_VC) + (size_t)h * 512 * 128;
        const int ntc = ((4 * Tq + 2) >> 6) + 1;
        RowState stc{-1e30f, 0.f};
        stage_load(sg, Kc, Vc, 128, 0, false);
        attn_pass<M_C1>(lds, Kc, Vc, 128, 0, ntc, qr, t, Tq, nosel, stc, 0.f, o, false, sg);
        stage_load(sg, Kc, Vc, 128, 0, true);
        const float invl = stc.l > 0.f ? 1.0f / stc.l : 0.f;
#pragma unroll
        for (int d = 0; d < 4; ++d) o[d] = f32x16{};
        attn_pass<M_C2>(lds, Kc, Vc, 128, 0, ntc, qr, t, Tq, nosel, stc, invl, o, big, sg);
        branch_out<0, false>(lds, o, g_c, onsa_w, gn_w, f32x16{});
    }
    {
        LAS unsigned short* SELM = (LAS unsigned short*)(lds + L_SELM);
        int tok = tid >> 3, sub = tid & 7; asm volatile("" : "+v"(tok), "+v"(sub));
        unsigned bits = 0u;
        if (big) {
            unsigned kv[16];
#pragma unroll
            for (int e = 0; e < 16; ++e) { const int j = sub * 16 + e; const unsigned v = IMP[tok * IMP_LD + j]; kv[e] = (j >= 1 && j <= Tq - 2) ? v + 1u : 0u; }
            for (int round = 0; round < 13; ++round) {
                unsigned bv = kv[0]; int bj = 0;
#pragma unroll
                for (int e = 1; e < 16; ++e) { const bool gt = kv[e] > bv; bv = gt ? kv[e] : bv; bj = gt ? e : bj; }
                bj += sub * 16;
#pragma unroll
                for (int st_ = 0; st_ < 3; ++st_) { const unsigned ov = st_ == 0 ? dpp_x1(bv) : st_ == 1 ? dpp_x2(bv) : dpp_m8(bv); const int oj = (int)(st_ == 0 ? dpp_x1((unsigned)bj) : st_ == 1 ? dpp_x2((unsigned)bj) : dpp_m8((unsigned)bj));
                    const bool take = (ov > bv) || (ov == bv && oj < bj); bv = take ? ov : bv; bj = take ? oj : bj; }
                const int we = (bv != 0u && (bj >> 4) == sub) ? (bj & 15) : -1;
#pragma unroll
                for (int e = 0; e < 16; ++e) { const bool hit = (we == e); bits |= hit ? (1u << e) : 0u; kv[e] = hit ? 0u : kv[e]; }
            }
#pragma unroll
            for (int e = 0; e < 16; ++e) { const int j = sub * 16 + e; if (j == 0 || j == Tq - 1 || j == Tq) bits |= 1u << e; }
        } else {
#pragma unroll
            for (int e = 0; e < 16; ++e) { const int j = sub * 16 + e; if (j <= Tq) bits |= 1u << e; }
        }
        SELM[tok * 8 + sub] = (unsigned short)bits;
        __syncthreads();
    }
    const u32x4 sel = *(const LAS u32x4*)(lds + L_SELM + tl * 16);
    v8i qf[2];
    { const unsigned char* q8 = ws + WS_Q8 + (size_t)t * 2048 + hq * 128 + 32 * hi;
#pragma unroll
      for (int ks = 0; ks < 2; ++ks) { const u32x4 x = *(const u32x4*)(q8 + 64 * ks), y = *(const u32x4*)(q8 + 64 * ks + 16); qf[ks] = (v8i){(int)x.x, (int)x.y, (int)x.z, (int)x.w, (int)y.x, (int)y.y, (int)y.z, (int)y.w}; } }
    const unsigned char* K8S = ws + WS_K8S + h * 128; const unsigned char* V8TS = ws + WS_V8TS + (size_t)h * 128 * 8192;
    const unsigned char* K8W = ws + WS_K8W + h * 128; const unsigned char* V8TW = ws + WS_V8TW + (size_t)h * 128 * 8192;
    Stage8 s8;
    {
        RowState sts{-1e30f, 0.f};
#pragma unroll
        for (int d = 0; d < 4; ++d) o[d] = f32x16{};
        f32x16 ol = f32x16{};
        stage_load8(s8, K8S, V8TS, 0);
        attn_pass8<M_S>(lds, K8S, V8TS, 0, Tq + 1, qf, t, Tq, sel, sts, o, ol, s8);
        stage_load8(s8, K8W, V8TW, Tq >= 8 ? Tq - 8 : 0);
        branch_out<1, true>(lds, o, g_s, onsa_w, gn_w, ol);
    }
    {
        RowState stw{-1e30f, 0.f};
#pragma unroll
        for (int d = 0; d < 4; ++d) o[d] = f32x16{};
        f32x16 ol = f32x16{};
        attn_pass8<M_W>(lds, K8W, V8TW, Tq >= 8 ? Tq - 8 : 0, Tq + 1, qf, t, Tq, sel, stw, o, ol, s8);
        branch_out<2, true>(lds, o, g_w, onsa_w, gn_w, ol);
    }
}
#undef KSWZ
#undef SBAR
}

constexpr int NPHASE = 8;
__global__ void __launch_bounds__(NWAVES * 64, 2) mega_fwd(Args args) {
    extern __shared__ __attribute__((aligned(16))) unsigned char lds[];
    Frame F;
    F.lds = (LAS unsigned char*)lds;
    F.tid = threadIdx.x; F.lane = F.tid & 63; F.wave = __builtin_amdgcn_readfirstlane(F.tid >> 6);
    F.G = gridDim.x; { const int bx = blockIdx.x; F.vcu = (F.G % 8 == 0) ? (bx % 8) * (F.G / 8) + bx / 8 : bx; }
    volatile LAS unsigned* MISC = (volatile LAS unsigned*)(F.lds + MISC_OFF);
    unsigned char* ws = args.ws;
    for (int u = F.tid; u < (LDS_BYTES - LDSCTL_OFF) / 4; u += NWAVES * 64) ((LAS unsigned*)(F.lds + LDSCTL_OFF))[u] = 0u;
    __syncthreads();
    XcdBarrier bar; bar.bar = (unsigned*)(ws + WS_CTL) + CW_BAR; bar.x = 0; bar.st = nullptr;
#if !N_LAUNCHES_PER_PHASE
    bar = xcd_barrier_post((unsigned*)(ws + WS_CTL) + CW_BAR, MISC + 8);
#endif
    const int lo = args.ph_lo, hi = args.ph_hi;
#define IN(k) (lo <= (k) && (k) < hi && (F.tid = otid(), F.lane = F.tid & 63, true))
#define SEAM(k) do { if (IN(k) && IN((k) + 1)) xcd_barrier(bar); } while (0)
    bf16_t* const GM = (bf16_t*)args.out;

    for (int rep_ = 0; rep_ < (DUP_PHASE == 0 ? 2 : 1); ++rep_) if (IN(0)) { if (rep_) xcd_barrier(bar); p0_prologue(F, args); } SEAM(0);
    for (int rep_ = 0; rep_ < (DUP_PHASE == 1 ? 2 : 1); ++rep_) if (IN(1)) { if (rep_) xcd_barrier(bar);
        pg8::Gemm g{(const bf16_t*)(ws + WS_H), (const bf16_t*)(ws + WS_WCAT), 2048, 2048, 2048};
        pg8::StaticOrder So; So.init(S, NCAT, F.G, (int)blockIdx.x);
        EpiInProj E{ws, GM, args.in[14]};
        pg8::AddrAffine AD{(size_t)256 * 2048 * 2, (size_t)256 * 2048 * 2};
        pg8::gemm_phase<EpiInProj, true>(F.lds, g, So, E, AD);
        { const int nun = (So.nwg + F.G - 1) / F.G, full = So.nwg - (nun - 1) * F.G;
          const int base = full < F.G ? full : 0; if ((int)blockIdx.x >= base) p1_late_weights(F, args, ((int)blockIdx.x - base) * NWAVES + F.wave, (F.G - base) * NWAVES); }
    } SEAM(1);
    for (int rep_ = 0; rep_ < (DUP_PHASE == 2 ? 2 : 1); ++rep_) if (IN(2)) { if (rep_) xcd_barrier(bar);
        pg8::Gemm g{(const bf16_t*)(ws + WS_KCR), (const bf16_t*)(ws + WS_W1KT), 2048, 4096, 4096 / NSPLIT};
        pg8::StaticOrder So; So.init(16 * 256, NSPLIT * 256, F.G, (int)blockIdx.x);
        EpiSlab E{(float*)(ws + WS_SLAB)};
        pg8::AddrCmp AD{(4096 / NSPLIT) / 64};
        pg8::gemm_phase<EpiSlab, false>(F.lds, g, So, E, AD);
        { const int base = F.G > So.nwg ? So.nwg : 0; if ((int)blockIdx.x >= base) { p2_ypool(F, ws, args.in[4], ((int)blockIdx.x - base) * NWAVES + F.wave, (F.G - base) * NWAVES); p2_vt8(F, ws, ((int)blockIdx.x - base) * NWAVES + F.wave, (F.G - base) * NWAVES); } }
        if (blockIdx.x == F.G - 1) { const float* b1p = (const float*)(ws + WS_B1P); float* b1 = (float*)(ws + WS_B1); const int t = F.tid; float s = 0.f;
            for (int c = 0; c < 64; ++c) s += b1p[((t >> 8) * 64 + c) * 256 + (t & 255)];
            b1[t] = s; }
    } SEAM(2);
    for (int rep_ = 0; rep_ < (DUP_PHASE == 3 ? 2 : 1); ++rep_) if (IN(3)) { if (rep_) xcd_barrier(bar);
        p3_compress2(F, ws, (int)blockIdx.x, F.G);
    } SEAM(3);
    for (int rep_ = 0; rep_ < (DUP_PHASE == 5 ? 2 : 1); ++rep_) if (IN(5)) { if (rep_) xcd_barrier(bar);
        for (int p = F.vcu; p < 256; p += F.G) {
#pragma unroll 1
            for (int i = 0; i < 2; ++i) { const int h = p >> 6, x = p & 63; nsa::attn_unit(F.lds, ws, h, i ? x : 127 - x); } }
    } SEAM(5);
    for (int rep_ = 0; rep_ < (DUP_PHASE == 6 ? 2 : 1); ++rep_) if (IN(6)) { if (rep_) xcd_barrier(bar);
        pg8::Gemm ga{(const bf16_t*)(ws + WS_H + 16 * MiB), (const bf16_t*)(ws + WS_WPOT), 1024, 1024, 1024};
        pg8::Gemm gb{(const bf16_t*)(ws + WS_ONSA), (const bf16_t*)(ws + WS_WNOT), 2048, 2048, 2048};
        pg8::StaticOrder So; So.init(S, 2048, F.G, (int)blockIdx.x);
        EpiYaYb E{EpiYa{(bf16_t*)(ws + WS_YAG), GM}, EpiYb{(bf16_t*)(ws + WS_H), (const bf16_t*)(ws + WS_YAG), GM}};
        pg8::gemm_phase2<EpiYaYb>(F.lds, ga, gb, So, E);
    } SEAM(6);
    for (int rep_ = 0; rep_ < (DUP_PHASE == 7 ? 2 : 1); ++rep_) if (IN(7)) { if (rep_) xcd_barrier(bar);
        pg8::Gemm g{(const bf16_t*)(ws + WS_H), (const bf16_t*)(ws + WS_WOT), 2048, 2048, 2048}; pg8::AddrAffine AD{(size_t)256 * 2048 * 2, (size_t)256 * 2048 * 2};
        pg8::StaticOrder So; So.init(S, 2048, F.G, (int)blockIdx.x);
        EpiOut E{args.out, args.in[0], (float*)(ws + WS_SSQ), args.in[16], (unsigned*)(ws + WS_CTL), F.lds};
        pg8::gemm_phase<EpiOut, true>(F.lds, g, So, E, AD);
    }
#undef IN
#undef SEAM
}

extern "C" void kernel_launch(void* const* d_in, const int* in_sizes, int n_in, void* d_out, int out_size, void* d_ws, size_t ws_size, hipStream_t stream) {
    static int grid = 0;
    if (grid == 0) {
        if (n_in != 17 || in_sizes[0] != S * DM || out_size != S * DM || ws_size < WS_END) { fprintf(stderr, "kernel_launch: unexpected shapes (n_in %d, in0 %d, out %d, ws %zu); nothing launched\n", n_in, n_in > 0 ? in_sizes[0] : -1, out_size, ws_size); grid = -1; return; }
        int dev = 0, cus = 0;
        if (hipGetDevice(&dev) != hipSuccess || hipDeviceGetAttribute(&cus, hipDeviceAttributeMultiprocessorCount, dev) != hipSuccess) { fprintf(stderr, "kernel_launch: device query failed\n"); grid = -1; return; }
        if (hipFuncSetAttribute((const void*)mega_fwd, hipFuncAttributeMaxDynamicSharedMemorySize, LDS_BYTES) != hipSuccess) { fprintf(stderr, "kernel_launch: hipFuncSetAttribute failed\n"); grid = -1; return; }
        (void)hipGetLastError();
        grid = cus;
    }
    if (grid < 0) return;
    (void)hipMemsetAsync((char*)d_ws + WS_CTL, 0, CTL_BYTES, stream);
    Args a{};
    for (int i = 0; i < 17; ++i) a.in[i] = (const float*)d_in[i];
    a.out = (float*)d_out; a.ws = (unsigned char*)d_ws;
#if N_LAUNCHES_PER_PHASE
    for (int p = 0; p < NPHASE; ++p) { a.ph_lo = p; a.ph_hi = p + 1; hipLaunchKernelGGL(mega_fwd, dim3(grid), dim3(NWAVES * 64), LDS_BYTES, stream, a); }
#else
    a.ph_lo = 0; a.ph_hi = NPHASE;
    hipLaunchKernelGGL(mega_fwd, dim3(grid), dim3(NWAVES * 64), LDS_BYTES, stream, a);
#endif
}
```

```cpp
#include <hip/hip_runtime.h>
#include <cstdio>
#include <cstdint>

#define LAS __attribute__((address_space(3)))
#define GAS __attribute__((address_space(1)))
typedef unsigned short bf16_t;
typedef short bf16x8 __attribute__((ext_vector_type(8)));
typedef short s16x4 __attribute__((ext_vector_type(4)));
typedef float f32x4 __attribute__((ext_vector_type(4)));
typedef float f32x16 __attribute__((ext_vector_type(16)));
typedef unsigned u32x4 __attribute__((ext_vector_type(4)));
typedef unsigned u32x2 __attribute__((ext_vector_type(2)));
typedef float f32x2_t __attribute__((ext_vector_type(2)));
typedef __bf16 bf16x2_t __attribute__((ext_vector_type(2)));

#ifndef EXP_QKT2
#define EXP_QKT2 0
#endif
#ifndef DUP_PHASE
#define DUP_PHASE -1
#endif
#ifndef N_LAUNCHES_PER_PHASE
#define N_LAUNCHES_PER_PHASE 0
#endif

constexpr int S = 8192, DM = 2048, NCAT = 13568;
constexpr int HD = 128, NKV = 4, NCMP = 511;
constexpr float EPS = 1e-6f;

constexpr size_t MiB = 1u << 20;
constexpr size_t WS_CTL = 0, CTL_BYTES = 1 * MiB;
constexpr size_t WS_WCAT = 1 * MiB;
constexpr size_t WS_SLAB = WS_WCAT;
constexpr size_t WS_ONSA = WS_WCAT;
constexpr size_t WS_MIXT = 54 * MiB;
constexpr size_t WS_WPOT = 55 * MiB;
constexpr size_t WS_WNOT = 59 * MiB;
constexpr size_t WS_WOT  = 67 * MiB;
constexpr size_t WS_W1KT = 75 * MiB, WS_W1VT = 77 * MiB;
constexpr size_t WS_W2KT = 79 * MiB, WS_W2VT = 79 * MiB + 65536;
constexpr size_t WS_B1P  = 80 * MiB + 262144;
constexpr size_t WS_B1   = 79 * MiB + 131072 + 32768;
constexpr size_t WS_KC   = 79 * MiB + 262144, WS_VC = 79 * MiB + 786432;
constexpr size_t WS_ROPE = 81 * MiB;
constexpr size_t WS_SSQ  = 85 * MiB;
constexpr size_t WS_H    = 86 * MiB;
constexpr size_t WS_U    = 118 * MiB, WS_GP = 134 * MiB;
constexpr size_t WS_YAG  = WS_U;
constexpr size_t WS_Q    = 150 * MiB;
constexpr size_t WS_KCR  = 182 * MiB, WS_VCR = 190 * MiB, WS_KS = 198 * MiB, WS_VS = 206 * MiB, WS_KW = 214 * MiB, WS_VW = 222 * MiB;
constexpr size_t WS_GN   = 230 * MiB;
constexpr size_t WS_GBR  = 262 * MiB;
constexpr size_t WS_K8S = 198 * MiB, WS_K8W = 202 * MiB;
constexpr size_t WS_V8S = 206 * MiB, WS_V8W = 210 * MiB;
constexpr size_t WS_V8TS = 214 * MiB, WS_V8TW = 218 * MiB;
constexpr size_t WS_ONSA8 = WS_WCAT + 32 * MiB;
constexpr float   ONSA_SCALE = 64.f, WNO_SCALE = 64.f;
constexpr size_t WS_Q8   = 266 * MiB;
constexpr size_t WS_END  = 282 * MiB;
constexpr int CW_BAR = 4096;

constexpr int RING_BYTES = 131072;
constexpr int LDSCTL_OFF = RING_BYTES, MISC_OFF = LDSCTL_OFF + 320;
constexpr int LDS_BYTES = 147456;
constexpr int NWAVES = 8;

#define LDS_WAIT() asm volatile("s_waitcnt lgkmcnt(0)" ::: "memory")
#define VM_WAIT() asm volatile("s_waitcnt vmcnt(0)" ::: "memory")

__device__ __forceinline__ unsigned cvtpk(float lo, float hi) { f32x2_t v = {lo, hi}; bf16x2_t b = __builtin_convertvector(v, bf16x2_t); return __builtin_bit_cast(unsigned, b); }
__device__ __forceinline__ float sat8(float x) { return __builtin_amdgcn_fmed3f(x, -448.f, 448.f); }
__device__ __forceinline__ unsigned cvt4_fp8(float a, float b, float c, float d) { int w = __builtin_amdgcn_cvt_pk_fp8_f32(a, b, 0, false); return (unsigned)__builtin_amdgcn_cvt_pk_fp8_f32(c, d, w, true); }
__device__ __forceinline__ float bf2f(unsigned short h) { return __builtin_bit_cast(float, (unsigned)h << 16); }
__device__ __forceinline__ float bflo(unsigned w) { return __builtin_bit_cast(float, w << 16); }
__device__ __forceinline__ float bfhi(unsigned w) { return __builtin_bit_cast(float, w & 0xffff0000u); }
__device__ __forceinline__ float sigmoidf_(float x) { return __builtin_amdgcn_rcpf(1.0f + __expf(-x)); }
__device__ __forceinline__ float siluf_(float x) { return x * __builtin_amdgcn_rcpf(1.0f + __expf(-x)); }
__device__ __forceinline__ int otid() { int t = threadIdx.x; asm volatile("" : "+v"(t)); return t; }
__device__ __forceinline__ unsigned dpp_x1(unsigned v) { return __builtin_amdgcn_update_dpp(0u, v, 0xB1, 0xF, 0xF, false); }
__device__ __forceinline__ unsigned dpp_x2(unsigned v) { return __builtin_amdgcn_update_dpp(0u, v, 0x4E, 0xF, 0xF, false); }
__device__ __forceinline__ unsigned dpp_m8(unsigned v) { return __builtin_amdgcn_update_dpp(0u, v, 0x141, 0xF, 0xF, false); }
__device__ __forceinline__ float dpp_x1f(float v) { return __uint_as_float(dpp_x1(__float_as_uint(v))); }
__device__ __forceinline__ int crow(int r, int hi) { return (r & 3) + 8 * (r >> 2) + 4 * hi; }
__device__ __forceinline__ float wave_sum(float v) {
#pragma unroll
    for (int o = 1; o < 64; o <<= 1) v += __shfl_xor(v, o);
    return v;
}

#define XB_TMO      128
#define XB_XCNT(j)  (256  + 64 * (j))
#define XB_XSUB(j)  (1280 + 64 * (j))
#define XB_XGEN(j)  (2304 + 64 * (j))
#define XB_TOP      3328
#define XB_TOPGEN   3392
#define XCD_BAR_WORDS 3456
#define XB_SPIN_CAP (1u << 18)
__device__ __forceinline__ unsigned xb_ld(unsigned* p)              { return __hip_atomic_load(p, __ATOMIC_RELAXED, __HIP_MEMORY_SCOPE_AGENT); }
__device__ __forceinline__ unsigned xb_add(unsigned* p, unsigned v) { return __hip_atomic_fetch_add(p, v, __ATOMIC_RELAXED, __HIP_MEMORY_SCOPE_AGENT); }
__device__ __forceinline__ unsigned xb_xcc_id() { return (unsigned)__builtin_amdgcn_s_getreg((3 << 11) | 20) & 0xFu; }
#define XB_SPIN(cond, bar) do { unsigned _sp = 0; while (cond) { __builtin_amdgcn_s_sleep(1); \
    if ((++_sp & 255u) == 0u) { if (xb_ld(&(bar)[XB_TMO])) break; if (_sp > XB_SPIN_CAP) { atomicAdd(&(bar)[XB_TMO], 1u); break; } } } } while (0)
struct XcdBarrier { unsigned* bar; unsigned x; volatile LAS unsigned* st; };
__device__ __forceinline__ XcdBarrier xcd_barrier_post(unsigned* bar, volatile LAS unsigned* st) {
    XcdBarrier b; b.bar = bar; b.x = xb_xcc_id(); b.st = st;
    if (threadIdx.x == 0) (void)xb_add(&bar[XB_XCNT(b.x)], 1u);
    return b;
}
__device__ __forceinline__ void xcd_barrier_complete(unsigned* bar, unsigned x, unsigned& nloc, unsigned& nx) {
    const unsigned G = gridDim.x * gridDim.y * gridDim.z;
    unsigned sum, cnt, mine, sp = 0u;
    for (;;) {
        sum = 0u; cnt = 0u; mine = 0u;
#pragma unroll
        for (unsigned j = 0; j < 16; ++j) { const unsigned c = xb_ld(&bar[XB_XCNT(j)]); sum += c; cnt += (c > 0u) ? 1u : 0u; mine = (j == x) ? c : mine; }
        if (sum == G) break;
        __builtin_amdgcn_s_sleep(1);
        if ((++sp & 255u) == 0u) { if (xb_ld(&bar[XB_TMO])) break; if (sp > XB_SPIN_CAP) { atomicAdd(&bar[XB_TMO], 1u); break; } }
    }
    nloc = mine > 0u ? mine : 1u; nx = cnt > 0u ? cnt : 1u;
}
__device__ __forceinline__ void xcd_barrier(const XcdBarrier& b) {
    asm volatile("s_waitcnt vmcnt(0)" ::: "memory");
    __syncthreads();
    if (threadIdx.x == 0) {
        unsigned* bar = b.bar;
        __builtin_amdgcn_s_waitcnt(0);
        unsigned nloc = b.st[0], nx = b.st[1];
        if (nloc == 0u) { xcd_barrier_complete(bar, b.x, nloc, nx); b.st[0] = nloc; b.st[1] = nx; }
        const unsigned old = xb_add(&bar[XB_XSUB(b.x)], 1u);
        const unsigned gen = old / nloc;
        if (old + 1u == (gen + 1u) * nloc) {
            __builtin_amdgcn_fence(__ATOMIC_RELEASE, "agent");
            asm volatile("s_waitcnt vmcnt(0)" ::: "memory");
            const unsigned og = xb_add(&bar[XB_TOP], 1u);
            const unsigned tg = og / nx;
            if (og + 1u == (tg + 1u) * nx) xb_add(&bar[XB_TOPGEN], 1u);
            else XB_SPIN(xb_ld(&bar[XB_TOPGEN]) == tg, bar);
            __builtin_amdgcn_fence(__ATOMIC_ACQUIRE, "agent");
            xb_add(&bar[XB_XGEN(b.x)], 1u);
            asm volatile("s_waitcnt vmcnt(0)" ::: "memory");
        } else {
            XB_SPIN(xb_ld(&bar[XB_XGEN(b.x)]) == gen, bar);
            __builtin_amdgcn_fence(__ATOMIC_ACQUIRE, "agent");
            asm volatile("s_waitcnt vmcnt(0)" ::: "memory");
        }
    }
    __syncthreads();
}

namespace pg8 {
constexpr int BM = 256, BK = 64, HALF = 128, HTB = HALF * BK * 2, STAGE_BYTES = 8 * HTB, NXCD = 8, WGM = 8;
__host__ __device__ __forceinline__ int lds_byte(int r, int c) { const int st = (r >> 4) * 2 + (c >> 5), rr = r & 15, cc = c & 31, ob = rr * 64 + cc * 2; return st * 1024 + (ob ^ (((ob >> 9) & 1) << 5)); }
__host__ __device__ __forceinline__ void stage_rc(int b, int& R, int& C) { const int st = b / 1024, sb = b % 1024, swz = sb ^ (((sb >> 9) & 1) << 5); R = (st >> 1) * 16 + swz / 64; C = (st & 1) * 32 + (swz % 64) / 2; }
__host__ __device__ __forceinline__ int perm32(int rho) { const int n = rho >> 4, i = rho & 15; return 8 * (i >> 2) + 4 * n + (i & 3); }
struct Unit { int pm, pn; };
struct Gemm { const bf16_t* A; const bf16_t* Bt; int lda, ldb, K; };
struct AddrAffine { size_t tA, tB;
    __device__ __forceinline__ const char* A(const char* b, const Unit& u) const { return b + (size_t)u.pm * tA; }
    __device__ __forceinline__ const char* B(const char* b, const Unit& u) const { return b + (size_t)u.pn * tB; }
    __device__ __forceinline__ size_t ka(int t) const { return (size_t)t * (BK * 2); } };
struct AddrCmp { int ntile;
    __device__ __forceinline__ const char* A(const char* b, const Unit& u) const { return b + (size_t)(u.pm >> 3) * (8 * MiB) + (size_t)((u.pm >> 1) & 3) * (2 * MiB) + (size_t)(u.pm & 1) * (256 * 4096) + ka(u.pn * ntile); }
    __device__ __forceinline__ const char* B(const char* b, const Unit& u) const { return b + (size_t)(u.pm >> 3) * (2 * MiB) + (size_t)u.pn * ntile * (BK * 2); }
    __device__ __forceinline__ size_t ka(int t) const { return (size_t)t * (BK * 2); } };
struct StaticOrder {
    int nM, nN, nwg, G, c;
    __host__ __device__ void init(int M, int N, int G_, int c_) { nM = M / BM; nN = N / BM; nwg = nM * nN; G = G_; c = c_; }
    __host__ __device__ bool next(int i, Unit& u) const {
        const long L = (long)i * G + c; if (L >= nwg) return false;
        int wgid = (int)L; { const int q = nwg / NXCD, r = nwg % NXCD, xcd = wgid % NXCD, off = wgid / NXCD; wgid = (xcd < r ? xcd * (q + 1) : r * (q + 1) + (xcd - r) * q) + off; }
        const int nig = WGM * nN, gid = wgid / nig, fm = gid * WGM, gsz = (nM - fm) < WGM ? (nM - fm) : WGM;
        u.pm = fm + ((wgid % nig) % gsz); u.pn = (wgid % nig) / gsz; return true;
    }
};
template <class Epi, bool ALIGN_EPI, class Addr>
__device__ __forceinline__ void gemm_phase(LAS unsigned char* lds, const Gemm g, const StaticOrder& S, const Epi& E, const Addr& AD) {
    const int tid = otid(), wid = __builtin_amdgcn_readfirstlane(tid >> 6), lane = tid & 63, wr = wid >> 2, wc = wid & 3, fr = lane & 15, fq = lane >> 4;
    const int K = g.K, nt = K / BK;
    unsigned voffA[2], voffB[2];
#pragma unroll
    for (int i = 0; i < 2; ++i) { int R, C; stage_rc(tid * 16 + i * 8192, R, C); const int Rb = (R & ~31) + perm32(R & 31);
        voffA[i] = (unsigned)(R * g.lda + C) * 2u; voffB[i] = (unsigned)(Rb * g.ldb + C) * 2u; }
    const size_t kstep = (size_t)(BK * 2);
    const size_t hA = (size_t)HALF * g.lda * 2, hB = (size_t)HALF * g.ldb * 2;
    const unsigned ldsw = (unsigned)wid * 1024u;
    const int aoff = lds_byte(wr * 64 + fr, fq * 8), boff = lds_byte(wc * 32 + fr, fq * 8);
#define PG8_SA(b, h) (((b) * 2 + (h)) * HTB)
#define PG8_SB(b, h) ((4 + (b) * 2 + (h)) * HTB)
#define PG8_STAGE(bufoff, gbase, voff) do { _Pragma("unroll") for (int _i = 0; _i < 2; ++_i) \
        __builtin_amdgcn_global_load_lds((const unsigned*)((const char*)(gbase) + (voff)[_i]), (LAS unsigned*)(lds + (bufoff) + ldsw + _i * 8192), 16, 0, 0); } while (0)
#define PG8_LDA(dst, b, h) do { _Pragma("unroll") for (int m = 0; m < 4; ++m) _Pragma("unroll") for (int k = 0; k < 2; ++k) dst[m][k] = *(const LAS bf16x8*)(lds + PG8_SA(b, h) + aoff + m * 2048 + k * 1024); } while (0)
#define PG8_LDB(dst, b, h) do { _Pragma("unroll") for (int n = 0; n < 2; ++n) _Pragma("unroll") for (int k = 0; k < 2; ++k) dst[n][k] = *(const LAS bf16x8*)(lds + PG8_SB(b, h) + boff + n * 2048 + k * 1024); } while (0)
#define PG8_MMA(ai, bj, At, Bt) do { __builtin_amdgcn_s_setprio(1); _Pragma("unroll") for (int m = 0; m < 4; ++m) _Pragma("unroll") for (int n = 0; n < 2; ++n) _Pragma("unroll") for (int k = 0; k < 2; ++k) \
        acc[ai][bj][m][n] = __builtin_amdgcn_mfma_f32_16x16x32_bf16(Bt[n][k], At[m][k], acc[ai][bj][m][n], 0, 0, 0); __builtin_amdgcn_s_setprio(0); } while (0)
#define PG8_WAIT_V(n) asm volatile("s_waitcnt vmcnt(" #n ")" ::: "memory")
#define PG8_WAIT_L(n) asm volatile("s_waitcnt lgkmcnt(" #n ")" ::: "memory")
#define PG8_BAR __builtin_amdgcn_s_barrier()
#define PG8_SCHED __builtin_amdgcn_sched_barrier(0)
    Unit cur, nxt; int ui = 0;
    if (!S.next(0, cur)) return;
    f32x4 acc[2][2][4][2];
#pragma unroll
    for (int a = 0; a < 2; ++a)
#pragma unroll
        for (int b = 0; b < 2; ++b)
#pragma unroll
            for (int m = 0; m < 4; ++m)
#pragma unroll
                for (int n = 0; n < 2; ++n) acc[a][b][m][n] = (f32x4){0.f, 0.f, 0.f, 0.f};
    bf16x8 At[4][2], B0[2][2], B1[2][2];
    const char* cA = AD.A((const char*)g.A, cur); const char* cB = AD.B((const char*)g.Bt, cur);
    PG8_STAGE(PG8_SB(0, 0), cB, voffB); PG8_STAGE(PG8_SB(0, 1), cB + hB, voffB); PG8_STAGE(PG8_SA(0, 0), cA, voffA); PG8_STAGE(PG8_SA(0, 1), cA + hA, voffA);
    if (wr == 1) PG8_BAR;
    PG8_WAIT_V(2); PG8_BAR;
    PG8_STAGE(PG8_SB(1, 0), cB + kstep, voffB); PG8_STAGE(PG8_SA(1, 0), cA + kstep, voffA); PG8_STAGE(PG8_SB(1, 1), cB + hB + kstep, voffB);
    PG8_WAIT_V(6); PG8_BAR;
    for (;;) {
        const bool has_next = S.next(ui + 1, nxt);
        const char* nA = has_next ? AD.A((const char*)g.A, nxt) : cA; const char* nB = has_next ? AD.B((const char*)g.Bt, nxt) : cB;
        for (int t = 0; t < nt; t += 2) {
            const bool last = (t == nt - 2);
            const char* a1 = cA + AD.ka(t) + kstep;
            const char* a2 = last ? nA : cA + AD.ka(t + 2); const char* b2 = last ? nB : cB + (size_t)(t + 2) * kstep;
            const char* a3 = a2 + kstep; const char* b3 = b2 + kstep;
            PG8_LDB(B0, 0, 0); PG8_LDB(B1, 0, 1); PG8_SCHED; PG8_LDA(At, 0, 0); PG8_STAGE(PG8_SA(1, 1), a1 + hA, voffA);
            PG8_WAIT_V(8); PG8_WAIT_L(0); PG8_BAR; PG8_MMA(0, 0, At, B0); PG8_MMA(0, 1, At, B1); PG8_BAR; PG8_SCHED;
            PG8_LDA(At, 0, 1); PG8_STAGE(PG8_SB(0, 0), b2, voffB); PG8_STAGE(PG8_SB(0, 1), b2 + hB, voffB); PG8_STAGE(PG8_SA(0, 0), a2, voffA);
            PG8_WAIT_V(8); PG8_WAIT_L(0); PG8_BAR; PG8_MMA(1, 0, At, B0); PG8_MMA(1, 1, At, B1); PG8_BAR; PG8_SCHED;
            PG8_LDB(B0, 1, 0); PG8_LDB(B1, 1, 1); PG8_SCHED; PG8_LDA(At, 1, 0); PG8_STAGE(PG8_SA(0, 1), a2 + hA, voffA);
            PG8_WAIT_V(8); PG8_WAIT_L(0); PG8_BAR; PG8_MMA(0, 0, At, B0); PG8_MMA(0, 1, At, B1); PG8_BAR; PG8_SCHED;
            PG8_LDA(At, 1, 1); PG8_STAGE(PG8_SB(1, 0), b3, voffB); PG8_STAGE(PG8_SB(1, 1), b3 + hB, voffB); PG8_STAGE(PG8_SA(1, 0), a3, voffA);
            PG8_WAIT_V(8); PG8_WAIT_L(0); PG8_BAR; PG8_MMA(1, 0, At, B0); PG8_MMA(1, 1, At, B1); PG8_BAR; PG8_SCHED;
        }
        if constexpr (ALIGN_EPI) { if (wr == 0) PG8_BAR; }
        E(acc, cur, wr, wc, fr, fq);
        if (!has_next) break;
#pragma unroll
        for (int a = 0; a < 2; ++a)
#pragma unroll
            for (int b = 0; b < 2; ++b)
#pragma unroll
                for (int m = 0; m < 4; ++m)
#pragma unroll
                    for (int n = 0; n < 2; ++n) acc[a][b][m][n] = (f32x4){0.f, 0.f, 0.f, 0.f};
        cur = nxt; cA = nA; cB = nB; ++ui;
        if constexpr (ALIGN_EPI) { if (wr == 1) PG8_BAR; }
    }
    PG8_WAIT_V(0);
    if constexpr (!ALIGN_EPI) { if (wr == 0) PG8_BAR; }
    PG8_BAR;
#undef PG8_SA
#undef PG8_SB
#undef PG8_STAGE
#undef PG8_LDA
#undef PG8_LDB
#undef PG8_MMA
#undef PG8_WAIT_V
#undef PG8_WAIT_L
#undef PG8_BAR
#undef PG8_SCHED
}
typedef int v8i_g __attribute__((ext_vector_type(8)));
typedef int v4i_g __attribute__((ext_vector_type(4)));
template <class Epi>
__device__ __forceinline__ void gemm_phase2(LAS unsigned char* lds, const Gemm g0, const Gemm g1, const StaticOrder& S, const Epi& E) {
    int tid = otid(); const int wid = __builtin_amdgcn_readfirstlane(tid >> 6), lane = tid & 63, wr = wid >> 2, wc = wid & 3, fr = lane & 15, fq = lane >> 4;
#define PG8_MKOFF(vA, vB, G) do { _Pragma("unroll") for (int i_ = 0; i_ < 2; ++i_) { int R_, C_; stage_rc(tid * 16 + i_ * 8192, R_, C_); const int Rb_ = (R_ & ~31) + perm32(R_ & 31); \
        (vA)[i_] = (unsigned)(R_ * (G).lda + C_) * 2u; (vB)[i_] = (unsigned)(Rb_ * (G).ldb + C_) * 2u; } } while (0)
    const size_t kstep = (size_t)(BK * 2);
    const size_t hA0 = (size_t)HALF * g0.lda * 2, hB0 = (size_t)HALF * g0.ldb * 2, hA1 = hA0, hB1 = hB0;
    unsigned ldsw = (unsigned)wid * 1024u;
    int aoff = lds_byte(wr * 64 + fr, fq * 8), boff = lds_byte(wc * 32 + fr, fq * 8);
#define PG8_SA(b, h) (((b) * 2 + (h)) * HTB)
#define PG8_SB(b, h) ((4 + (b) * 2 + (h)) * HTB)
#define PG8_STAGE(bufoff, gbase, voff) do { _Pragma("unroll") for (int _i = 0; _i < 2; ++_i) \
        __builtin_amdgcn_global_load_lds((const unsigned*)((const char*)(gbase) + (voff)[_i]), (LAS unsigned*)(lds + (bufoff) + ldsw + _i * 8192), 16, 0, 0); } while (0)
#define PG8_LDA(dst, b, h) do { _Pragma("unroll") for (int m = 0; m < 4; ++m) _Pragma("unroll") for (int k = 0; k < 2; ++k) dst[m][k] = *(const LAS bf16x8*)(lds + PG8_SA(b, h) + aoff + m * 2048 + k * 1024); } while (0)
#define PG8_LDB(dst, b, h) do { _Pragma("unroll") for (int n = 0; n < 2; ++n) _Pragma("unroll") for (int k = 0; k < 2; ++k) dst[n][k] = *(const LAS bf16x8*)(lds + PG8_SB(b, h) + boff + n * 2048 + k * 1024); } while (0)
#define PG8_LD8(p_) __builtin_shufflevector(*(const LAS v4i_g*)(p_), *(const LAS v4i_g*)((p_) + 1024), 0, 1, 2, 3, 4, 5, 6, 7)
#define PG8_LDA8(dst, b, h) do { _Pragma("unroll") for (int m = 0; m < 4; ++m) dst[m] = PG8_LD8(lds + PG8_SA(b, h) + aoff + m * 2048); } while (0)
#define PG8_LDB8(dst, b, h) do { _Pragma("unroll") for (int n = 0; n < 2; ++n) dst[n] = PG8_LD8(lds + PG8_SB(b, h) + boff + n * 2048); } while (0)
#define PG8_MMA16(ai, bj, At, Bt) do { __builtin_amdgcn_s_setprio(1); _Pragma("unroll") for (int m = 0; m < 4; ++m) _Pragma("unroll") for (int n = 0; n < 2; ++n) _Pragma("unroll") for (int k = 0; k < 2; ++k) \
        acc[ai][bj][m][n] = __builtin_amdgcn_mfma_f32_16x16x32_bf16(Bt[n][k], At[m][k], acc[ai][bj][m][n], 0, 0, 0); __builtin_amdgcn_s_setprio(0); } while (0)
#define PG8_MMA8(ai, bj, At, Bt) do { __builtin_amdgcn_s_setprio(1); _Pragma("unroll") for (int m = 0; m < 4; ++m) _Pragma("unroll") for (int n = 0; n < 2; ++n) \
        asm volatile("v_mfma_scale_f32_16x16x128_f8f6f4 %0, %1, %2, %0, %3, %3 op_sel_hi:[0,0,0]" : "+v"(acc[ai][bj][m][n]) : "v"(Bt[n]), "v"(At[m]), "v"(sc8_)); __builtin_amdgcn_s_setprio(0); } while (0)
#define PG8_WAIT_V(n) asm volatile("s_waitcnt vmcnt(" #n ")" ::: "memory")
#define PG8_WAIT_L(n) asm volatile("s_waitcnt lgkmcnt(" #n ")" ::: "memory")
#define PG8_BAR __builtin_amdgcn_s_barrier()
#define PG8_SCHED __builtin_amdgcn_sched_barrier(0)
    Unit cur;
    if (!S.next(0, cur)) return;
    f32x4 acc[2][2][4][2];
#define PG8_ZERO() do { _Pragma("unroll") for (int a = 0; a < 2; ++a) _Pragma("unroll") for (int b = 0; b < 2; ++b) _Pragma("unroll") for (int m = 0; m < 4; ++m) _Pragma("unroll") for (int n = 0; n < 2; ++n) acc[a][b][m][n] = (f32x4){0.f, 0.f, 0.f, 0.f}; } while (0)
    PG8_ZERO();
    bf16x8 At[4][2], B0[2][2], B1[2][2];
    const char* cA = (const char*)g0.A + (size_t)cur.pm * (2 * hA0); const char* cB = (const char*)g0.Bt + (size_t)cur.pn * (2 * hB0);
    unsigned voffA[2], voffB[2]; PG8_MKOFF(voffA, voffB, g0); const size_t hA = hA0, hB = hB0;
    PG8_STAGE(PG8_SB(0, 0), cB, voffB); PG8_STAGE(PG8_SB(0, 1), cB + hB, voffB); PG8_STAGE(PG8_SA(0, 0), cA, voffA); PG8_STAGE(PG8_SA(0, 1), cA + hA, voffA);
    if (wr == 1) PG8_BAR;
    PG8_WAIT_V(2); PG8_BAR;
    PG8_STAGE(PG8_SB(1, 0), cB + kstep, voffB); PG8_STAGE(PG8_SA(1, 0), cA + kstep, voffA); PG8_STAGE(PG8_SB(1, 1), cB + hB + kstep, voffB);
    PG8_WAIT_V(6); PG8_BAR;
#define PG8_KLOOP(MMA, LDA_, LDB_, At, B0, B1, NT, HASNEXT) do { const int nt = (NT);                                                                            \
        const char* nA = (HASNEXT) ? (const char*)g1.A + (size_t)cur.pm * (2 * hA1) : cA; const char* nB = (HASNEXT) ? (const char*)g1.Bt + (size_t)cur.pn * (2 * hB1) : cB; \
        for (int t = 0; t < nt; t += 2) {                                                                                              \
            const bool last = (t == nt - 2);                                                                                           \
            const char* a1 = cA + (size_t)(t + 1) * kstep;                                                                             \
            const char* a2 = last ? nA : cA + (size_t)(t + 2) * kstep; const char* b2 = last ? nB : cB + (size_t)(t + 2) * kstep;       \
            const char* a3 = a2 + kstep; const char* b3 = b2 + kstep;                                                                  \
            LDB_(B0, 0, 0); LDB_(B1, 0, 1); PG8_SCHED; LDA_(At, 0, 0); PG8_STAGE(PG8_SA(1, 1), a1 + hA, voffA);                \
            PG8_WAIT_V(8); PG8_WAIT_L(0); PG8_BAR; MMA(0, 0, At, B0); MMA(0, 1, At, B1); PG8_BAR; PG8_SCHED;                            \
            LDA_(At, 0, 1); PG8_STAGE(PG8_SB(0, 0), b2, voffB); PG8_STAGE(PG8_SB(0, 1), b2 + hB, voffB); PG8_STAGE(PG8_SA(0, 0), a2, voffA); \
            PG8_WAIT_V(8); PG8_WAIT_L(0); PG8_BAR; MMA(1, 0, At, B0); MMA(1, 1, At, B1); PG8_BAR; PG8_SCHED;                            \
            LDB_(B0, 1, 0); LDB_(B1, 1, 1); PG8_SCHED; LDA_(At, 1, 0); PG8_STAGE(PG8_SA(0, 1), a2 + hA, voffA);              \
            PG8_WAIT_V(8); PG8_WAIT_L(0); PG8_BAR; MMA(0, 0, At, B0); MMA(0, 1, At, B1); PG8_BAR; PG8_SCHED;                            \
            LDA_(At, 1, 1); PG8_STAGE(PG8_SB(1, 0), b3, voffB); PG8_STAGE(PG8_SB(1, 1), b3 + hB, voffB); PG8_STAGE(PG8_SA(1, 0), a3, voffA); \
            PG8_WAIT_V(8); PG8_WAIT_L(0); PG8_BAR; MMA(1, 0, At, B0); MMA(1, 1, At, B1); PG8_BAR; PG8_SCHED;                            \
        }                                                                                                                              \
        if (HASNEXT) { cA = nA; cB = nB; } } while (0)
    PG8_KLOOP(PG8_MMA16, PG8_LDA, PG8_LDB, At, B0, B1, g0.K / BK, true);
    if (wr == 0) PG8_BAR;
    E(acc, cur, 0, wr, wc, fr, fq);
    PG8_ZERO();
    { tid = otid(); const int l2 = tid & 63, w2 = __builtin_amdgcn_readfirstlane(tid >> 6);
      ldsw = (unsigned)w2 * 1024u; aoff = lds_byte((w2 >> 2) * 64 + (l2 & 15), (l2 >> 4) * 8); boff = lds_byte((w2 & 3) * 32 + (l2 & 15), (l2 >> 4) * 8); PG8_MKOFF(voffA, voffB, g1); }
    if (wr == 1) PG8_BAR;
    { v8i_g At8[4], B08[2], B18[2]; const int sc8_ = 0x7F7F7F7F;
      PG8_KLOOP(PG8_MMA8, PG8_LDA8, PG8_LDB8, At8, B08, B18, g1.K / BK, false); }
    asm volatile("s_nop 15\n\ts_nop 7" ::: "memory");
    if (wr == 0) PG8_BAR;
    E(acc, cur, 1, wr, wc, fr, fq);
    PG8_WAIT_V(0);
    PG8_BAR;
#undef PG8_KLOOP
#undef PG8_ZERO
#undef PG8_MMA16
#undef PG8_MMA8
#undef PG8_SA
#undef PG8_SB
#undef PG8_STAGE
#undef PG8_LDA
#undef PG8_LDB
#undef PG8_WAIT_V
#undef PG8_WAIT_L
#undef PG8_BAR
#undef PG8_SCHED
#undef PG8_MKOFF
#undef PG8_LD8
#undef PG8_LDA8
#undef PG8_LDB8
}
}

typedef f32x4 Acc[2][2][4][2];
__device__ __forceinline__ u32x4 pack8(f32x4 a, f32x4 b) { u32x4 w; w.x = cvtpk(a[0], a[1]); w.y = cvtpk(a[2], a[3]); w.z = cvtpk(b[0], b[1]); w.w = cvtpk(b[2], b[3]); return w; }
__device__ __forceinline__ void unpack8(u32x4 w, f32x4& a, f32x4& b) { a = (f32x4){bflo(w.x), bfhi(w.x), bflo(w.y), bfhi(w.y)}; b = (f32x4){bflo(w.z), bfhi(w.z), bflo(w.w), bfhi(w.w)}; }

struct EpiInProj {
    unsigned char* ws; bf16_t* gm; const float* bmerge;
    __device__ __forceinline__ void operator()(const Acc& acc, const pg8::Unit& u, int wr, int wc, int fr, int fq) const {
        const int pn = u.pn;
        bf16_t* dst; int ldc, cb, mode; size_t bjs = 128; unsigned char* dst8 = nullptr;
        if (pn < 4)       { dst = (bf16_t*)(ws + WS_U);   ldc = 1024; cb = pn * 256;        mode = 0; }
        else if (pn < 8)  { dst = (bf16_t*)(ws + WS_GP);  ldc = 1024; cb = (pn - 4) * 256;  mode = 1; }
        else if (pn < 16) { dst = (bf16_t*)(ws + WS_Q);   ldc = 2048; cb = (pn - 8) * 256;  mode = 3; dst8 = ws + WS_Q8; }
        else if (pn < 28) { const int k = (pn - 16) >> 1; dst = (bf16_t*)(ws + WS_KCR + (size_t)k * (8 * MiB)); ldc = 512; cb = ((pn - 16) & 1) * 256; mode = (k == 2 || k == 4) ? 3 : 0;
                            if (k < 2) { ldc = 128; cb = 0; bjs = (size_t)S * 128; dst += (size_t)((pn - 16) & 1) * 2 * S * 128; }
                            else { dst8 = ws + (k == 2 ? WS_K8S : k == 3 ? WS_V8S : k == 4 ? WS_K8W : WS_V8W); dst = nullptr; } }
        else if (pn < 36) { dst = (bf16_t*)(ws + WS_GN);  ldc = 2048; cb = (pn - 28) * 256; mode = 1; }
        else if (pn < 52) { dst = gm;                     ldc = 4096; cb = (pn - 36) * 256; mode = 2; }
        else              { dst = (bf16_t*)(ws + WS_GBR); ldc = 256;  cb = 0;               mode = 4; }
        const int row0 = u.pm * 256 + wr * 64 + fr, cl = wc * 32 + 8 * fq, col0 = cb + cl;
        const float* rcos = (const float*)(ws + WS_ROPE); const float* rsin = rcos + (size_t)S * 64;
#pragma unroll
        for (int ai = 0; ai < 2; ++ai)
#pragma unroll
            for (int m = 0; m < 4; ++m) {
                const int row = row0 + ai * 128 + m * 16;
                bf16_t* rowp = dst + (size_t)row * ldc + col0;
                f32x4 cs0, cs1, sn0, sn1;
                if (mode == 3) { const int i0 = (cl & 127) >> 1; cs0 = *(const f32x4*)(rcos + (size_t)row * 64 + i0); sn0 = *(const f32x4*)(rsin + (size_t)row * 64 + i0); }
#pragma unroll
                for (int bj = 0; bj < 2; ++bj) {
                    f32x4 v0 = acc[ai][bj][m][0], v1 = acc[ai][bj][m][1];
                    if (mode == 1) { for (int e = 0; e < 4; ++e) { v0[e] = siluf_(v0[e]); v1[e] = siluf_(v1[e]); } }
                    else if (mode == 2 || mode == 4) { if (mode == 2) { v0 = v0 + *(const f32x4*)(bmerge + col0 + bj * 128); v1 = v1 + *(const f32x4*)(bmerge + col0 + bj * 128 + 4); } for (int e = 0; e < 4; ++e) { v0[e] = sigmoidf_(v0[e]); v1[e] = sigmoidf_(v1[e]); } }
                    else if (mode == 3) {
                        f32x4 o0, o1;
                        o0[0] = v0[0] * cs0[0] - v0[1] * sn0[0]; o0[1] = v0[1] * cs0[0] + v0[0] * sn0[0];
                        o0[2] = v0[2] * cs0[1] - v0[3] * sn0[1]; o0[3] = v0[3] * cs0[1] + v0[2] * sn0[1];
                        o1[0] = v1[0] * cs0[2] - v1[1] * sn0[2]; o1[1] = v1[1] * cs0[2] + v1[0] * sn0[2];
                        o1[2] = v1[2] * cs0[3] - v1[3] * sn0[3]; o1[3] = v1[3] * cs0[3] + v1[2] * sn0[3];
                        v0 = o0; v1 = o1;
                    }
                    if (dst) *(u32x4*)(rowp + bj * bjs) = pack8(v0, v1);
                    if (dst8) { u32x2 w8; w8.x = cvt4_fp8(sat8(v0[0]), sat8(v0[1]), sat8(v0[2]), sat8(v0[3])); w8.y = cvt4_fp8(sat8(v1[0]), sat8(v1[1]), sat8(v1[2]), sat8(v1[3])); *(u32x2*)(dst8 + (size_t)row * ldc + col0 + bj * 128) = w8; }
                }
            }
    }
};
struct EpiYa {
    bf16_t* yag; const bf16_t* gm;
    __device__ __forceinline__ void operator()(const Acc& acc, const pg8::Unit& u, int wr, int wc, int fr, int fq) const {
        const int row0 = u.pm * 256 + wr * 64 + fr, col0 = u.pn * 256 + wc * 32 + 8 * fq;
#pragma unroll
        for (int ai = 0; ai < 2; ++ai)
#pragma unroll
            for (int m = 0; m < 4; ++m) { int ro_ = ai * 128 + m * 16; asm volatile("" : "+v"(ro_)); const size_t r = (size_t)(row0 + ro_);
#pragma unroll
                for (int bj = 0; bj < 2; ++bj) { f32x4 g0, g1; unpack8(*(const u32x4*)(gm + r * 4096 + col0 + bj * 128), g0, g1);
                    *(u32x4*)(yag + r * 2048 + col0 + bj * 128) = pack8(acc[ai][bj][m][0] * g0, acc[ai][bj][m][1] * g1); }
                if (m & 1) asm volatile("" ::: "memory"); }
    }
};
struct EpiYb {
    bf16_t* merged; const bf16_t* yag; const bf16_t* gm; float ascale;
    __device__ __forceinline__ void operator()(const Acc& acc, const pg8::Unit& u, int wr, int wc, int fr, int fq) const {
        const int row0 = u.pm * 256 + wr * 64 + fr, col0 = u.pn * 256 + wc * 32 + 8 * fq;
#pragma unroll
        for (int ai = 0; ai < 2; ++ai)
#pragma unroll
            for (int m = 0; m < 4; ++m) { int ro_ = ai * 128 + m * 16; asm volatile("" : "+v"(ro_)); const size_t r = (size_t)(row0 + ro_);
#pragma unroll
                for (int bj = 0; bj < 2; ++bj) { f32x4 g0, g1, y0, y1; unpack8(*(const u32x4*)(gm + r * 4096 + 2048 + col0 + bj * 128), g0, g1);
                    unpack8(*(const u32x4*)(yag + r * 2048 + col0 + bj * 128), y0, y1);
                    *(u32x4*)(merged + r * 2048 + col0 + bj * 128) = pack8(y0 + acc[ai][bj][m][0] * ascale * g0, y1 + acc[ai][bj][m][1] * ascale * g1); }
                if (m & 1) asm volatile("" ::: "memory"); }
    }
};
struct EpiYaYb {
    EpiYa ya; EpiYb yb;
    __device__ __forceinline__ void operator()(const Acc& acc, const pg8::Unit& u, int kind, int wr, int wc, int fr, int fq) const {
        if (kind == 0) { ya(acc, u, wr, wc, fr, fq); asm volatile("s_waitcnt vmcnt(0)" ::: "memory"); } else yb(acc, u, wr, wc, fr, fq);
    }
};
constexpr int NSPLIT = 8;
struct EpiSlab {
    float* slab;
    __device__ __forceinline__ void operator()(const Acc& acc, const pg8::Unit& u, int wr, int wc, int fr, int fq) const {
        float* base = slab + ((size_t)((u.pm >> 3) * NSPLIT + u.pn) * 2048 + (size_t)(u.pm & 7) * 256 + wr * 64 + fr) * 256 + wc * 32 + 8 * fq;
#pragma unroll
        for (int ai = 0; ai < 2; ++ai)
#pragma unroll
            for (int m = 0; m < 4; ++m)
#pragma unroll
                for (int bj = 0; bj < 2; ++bj) { float* p = base + (size_t)(ai * 128 + m * 16) * 256 + bj * 128; *(f32x4*)p = acc[ai][bj][m][0]; *(f32x4*)(p + 4) = acc[ai][bj][m][1]; }
    }
};
constexpr int CW_PANEL = 16384;
constexpr int EPI_LDS_OFF = RING_BYTES + 1024;
struct EpiOut {
    float* out; const float* x; float* ssq; const float* fw; unsigned* ctl; LAS unsigned char* lds;
    __device__ __forceinline__ void operator()(const Acc& acc_, const pg8::Unit& u, int wr, int wc, int fr, int fq) const {
        Acc& acc = const_cast<Acc&>(acc_);
        const int tid = otid();
        const int row0 = u.pm * 256 + wr * 64 + fr, col0 = u.pn * 256 + wc * 32 + 8 * fq;
        LAS float* rs = (LAS float*)(lds + EPI_LDS_OFF);
#pragma unroll
        for (int ai = 0; ai < 2; ++ai)
#pragma unroll
            for (int m = 0; m < 4; ++m) { const size_t r = (size_t)(row0 + ai * 128 + m * 16); float q = 0.f;
#pragma unroll
                for (int bj = 0; bj < 2; ++bj)
#pragma unroll
                    for (int n = 0; n < 2; ++n) { const size_t o = r * 2048 + col0 + bj * 128 + 4 * n; const f32x4 v = *(const f32x4*)(x + o) + acc[ai][bj][m][n];
                        acc[ai][bj][m][n] = v; q += (v[0] * v[0] + v[1] * v[1]) + (v[2] * v[2] + v[3] * v[3]); }
                q += __shfl_xor(q, 16); q += __shfl_xor(q, 32);
                if (fq == 0) __hip_atomic_store((unsigned*)(ssq + (size_t)(u.pn * 4 + wc) * S + r), __float_as_uint(q), __ATOMIC_RELAXED, __HIP_MEMORY_SCOPE_AGENT); }
        asm volatile("s_waitcnt vmcnt(0)" ::: "memory");
        __syncthreads();
        if (tid == 0) { unsigned* c = ctl + CW_PANEL + 64 * u.pm;
            __hip_atomic_fetch_add(c, 1u, __ATOMIC_RELAXED, __HIP_MEMORY_SCOPE_AGENT);
            unsigned sp = 0; while (__hip_atomic_load(c, __ATOMIC_RELAXED, __HIP_MEMORY_SCOPE_AGENT) < 8u) { __builtin_amdgcn_s_sleep(2); if (++sp > (1u << 22)) break; }
            __builtin_amdgcn_fence(__ATOMIC_ACQUIRE, "agent"); asm volatile("s_waitcnt vmcnt(0)" ::: "memory"); }
        __syncthreads();
        if (tid < 256) { const size_t r = (size_t)u.pm * 256 + tid; float s = 0.f;
#pragma unroll 8
            for (int p = 0; p < 32; ++p) s += __uint_as_float(__hip_atomic_load((unsigned*)(ssq + (size_t)p * S + r), __ATOMIC_RELAXED, __HIP_MEMORY_SCOPE_AGENT));
            rs[tid] = 1.0f / sqrtf(s * (1.f / DM) + EPS); }
        __syncthreads();
#pragma unroll
        for (int ai = 0; ai < 2; ++ai)
#pragma unroll
            for (int m = 0; m < 4; ++m) { const int rl = wr * 64 + fr + ai * 128 + m * 16; const float sc = rs[rl]; const size_t r = (size_t)u.pm * 256 + rl;
#pragma unroll
                for (int bj = 0; bj < 2; ++bj)
#pragma unroll
                    for (int n = 0; n < 2; ++n) { const size_t o = r * 2048 + col0 + bj * 128 + 4 * n; *(f32x4*)(out + o) = acc[ai][bj][m][n] * sc * *(const f32x4*)(fw + col0 + bj * 128 + 4 * n); } }
    }
};

struct Args { const float* in[17]; float* out; unsigned char* ws; int ph_lo, ph_hi; };
struct Frame { LAS unsigned char* lds; int tid, lane, wave, vcu, G; };

__device__ __forceinline__ int ropeperm(int d) { return d < 64 ? 2 * d : 2 * (d - 64) + 1; }
__device__ __forceinline__ void transpose_item(const float* W, int ldw, int Nvalid, bf16_t* WT, int ldt, int row_off, bool perm, LAS float* scr, int kb, int nb, int lane, float f8scale = 0.f) {
    const int k0 = 64 * kb, n0 = 32 * nb, cq = lane & 7, rb = lane >> 3; const bool ok = n0 + cq * 4 < Nvalid;
    f32x4 v[8];
#pragma unroll
    for (int i = 0; i < 8; ++i) v[i] = ok ? *(const f32x4*)(W + (size_t)(k0 + i * 8 + rb) * ldw + n0 + cq * 4) : (f32x4){0.f, 0.f, 0.f, 0.f};
#pragma unroll
    for (int i = 0; i < 8; ++i) *(LAS f32x4*)(scr + (i * 8 + rb) * 32 + ((cq ^ i) << 2)) = v[i];
    LDS_WAIT(); asm volatile("" ::: "memory");
#pragma unroll
    for (int j = 0; j < 4; ++j) { const int idx = lane + 64 * j, n = idx >> 3, c = idx & 7; const LAS float* s = scr + (8 * c) * 32 + ((((n >> 2) ^ c) << 2) | (n & 3));
        u32x4 o; o.x = cvtpk(s[0 * 32], s[1 * 32]); o.y = cvtpk(s[2 * 32], s[3 * 32]); o.z = cvtpk(s[4 * 32], s[5 * 32]); o.w = cvtpk(s[6 * 32], s[7 * 32]);
        const int ng = n0 + n;
        if (ng < Nvalid) { const int dr = perm ? ((ng & ~127) | ropeperm(ng & 127)) : ng;
            if (f8scale > 0.f) { u32x2 o8; o8.x = cvt4_fp8(sat8(s[0 * 32] * f8scale), sat8(s[1 * 32] * f8scale), sat8(s[2 * 32] * f8scale), sat8(s[3 * 32] * f8scale)); o8.y = cvt4_fp8(sat8(s[4 * 32] * f8scale), sat8(s[5 * 32] * f8scale), sat8(s[6 * 32] * f8scale), sat8(s[7 * 32] * f8scale));
                *(GAS u32x2*)((unsigned char*)WT + (size_t)(row_off + dr) * ldt + k0 + 8 * c) = o8; }
            else *(GAS u32x4*)(WT + (size_t)(row_off + dr) * ldt + k0 + 8 * c) = o; } }
    LDS_WAIT(); asm volatile("" ::: "memory");
}

__device__ __forceinline__ void p0_prologue(const Frame& F, const Args& a) {
    unsigned char* ws = a.ws;
    LAS float* scr = (LAS float*)(F.lds + F.wave * 8192);
    const int gw = F.vcu * NWAVES + F.wave, NGW = F.G * NWAVES, lane = F.lane;
    constexpr int I_WIN = 32 * 258, I_WM = 32 * 128;
    for (int it = gw; it < I_WIN + I_WM; it += NGW) {
        int r = it;
        if (r < I_WIN) { const int kb = r / 258, nb = 32 + r % 258, n0 = nb * 32;
            const bool perm = (n0 >= 2048 && n0 < 4096) || (n0 >= 5120 && n0 < 5632) || (n0 >= 6144 && n0 < 6656);
            transpose_item(a.in[2], 9264, 9264, (bf16_t*)(ws + WS_WCAT), 2048, nb >= 288 ? 4096 : 0, perm, scr, kb, nb, lane); continue; } r -= I_WIN;
        transpose_item(a.in[13], 4096, 4096, (bf16_t*)(ws + WS_WCAT), 2048, 9216, false, scr, r / 128, r % 128, lane);
    }
    {
        const float* win = a.in[2]; const float* mix = a.in[3]; bf16_t* WC = (bf16_t*)(ws + WS_WCAT); const int r = lane & 31, hh = lane >> 5;
        for (int it = gw; it < 1024; it += NGW) {
            const int g = it >> 8, d0 = ((it >> 5) & 7) * 32, kin0 = (it & 31) * 64;
            f32x16 acc0 = f32x16{}, acc1 = f32x16{};
            const float* ap = mix + (size_t)g * 65536 + (size_t)(8 * hh) * 256 + d0 + r;
            const float* bp0 = win + (size_t)(kin0 + r) * 9264 + g * 256 + 8 * hh; const float* bp1 = bp0 + (size_t)32 * 9264;
#pragma unroll 4
            for (int k = 0; k < 16; ++k) {
                f32x4 a0, a1;
#pragma unroll
                for (int j = 0; j < 4; ++j) { a0[j] = ap[(size_t)(k * 16 + j) * 256]; a1[j] = ap[(size_t)(k * 16 + 4 + j) * 256]; }
                const u32x4 af = pack8(a0, a1), b0 = pack8(*(const f32x4*)(bp0 + k * 16), *(const f32x4*)(bp0 + k * 16 + 4)), b1 = pack8(*(const f32x4*)(bp1 + k * 16), *(const f32x4*)(bp1 + k * 16 + 4));
                acc0 = __builtin_amdgcn_mfma_f32_32x32x16_bf16(__builtin_bit_cast(bf16x8, af), __builtin_bit_cast(bf16x8, b0), acc0, 0, 0, 0);
                acc1 = __builtin_amdgcn_mfma_f32_32x32x16_bf16(__builtin_bit_cast(bf16x8, af), __builtin_bit_cast(bf16x8, b1), acc1, 0, 0, 0);
            }
#pragma unroll
            for (int e = 0; e < 16; ++e) { int ee = e; asm volatile("" : "+v"(ee)); bf16_t* rowp = WC + (size_t)(g * 256 + d0 + crow(ee, hh)) * 2048 + kin0 + r;
                const float v0 = acc0[e], v1 = acc1[e], n0_ = dpp_x1f(v0), n1_ = dpp_x1f(v1);
                if ((r & 1) == 0) { *(unsigned*)rowp = cvtpk(v0, n0_); *(unsigned*)(rowp + 32) = cvtpk(v1, n1_); } }
        }
    }
    for (int i = gw * 64 + lane; i < 53248; i += NGW * 64) *(GAS u32x4*)(ws + WS_WCAT + (size_t)13360 * 4096 + (size_t)i * 16) = (u32x4){0u, 0u, 0u, 0u};
    {
        const float* x = a.in[0]; const float* nw = a.in[1]; bf16_t* H = (bf16_t*)(ws + WS_H);
        f32x4 wv[8];
#pragma unroll
        for (int j = 0; j < 8; ++j) wv[j] = *((const f32x4*)nw + lane + 64 * j);
        for (int m = gw; m < S; m += NGW) {
            const f32x4* xr = (const f32x4*)(x + (size_t)m * DM) + lane; f32x4 v[8]; float s = 0.f;
#pragma unroll
            for (int j = 0; j < 8; ++j) { v[j] = xr[64 * j]; s += (v[j][0] * v[j][0] + v[j][1] * v[j][1]) + (v[j][2] * v[j][2] + v[j][3] * v[j][3]); }
            const float rstd = 1.0f / sqrtf(wave_sum(s) * (1.f / DM) + EPS);
            u32x2* o = (u32x2*)(H + (size_t)m * DM) + lane;
#pragma unroll
            for (int j = 0; j < 8; ++j) { const f32x4 y = v[j] * rstd * wv[j]; u32x2 w; w.x = cvtpk(y[0], y[1]); w.y = cvtpk(y[2], y[3]); o[64 * j] = w; }
        }
    }
    {
        float* rcos = (float*)(ws + WS_ROPE); float* rsin = rcos + (size_t)S * 64;
        for (int e = gw * 64 + lane; e < S * 64; e += NGW * 64) {
            const int pos = e >> 6, i = e & 63;
            double inv = 1.0, b = 0.86596432336006535;
            for (int k = i; k; k >>= 1) { if (k & 1) inv *= b; b *= b; }
            const double t = (double)pos * inv * 0.15915494309189535;
            const float fr = (float)(t - floor(t));
            rcos[e] = __builtin_amdgcn_cosf(fr); rsin[e] = __builtin_amdgcn_sinf(fr);
        }
    }
}
__device__ __forceinline__ void p1_late_weights(const Frame& F, const Args& a, int cw, int NCW) {
    unsigned char* ws = a.ws;
    LAS float* scr = (LAS float*)(F.lds + F.wave * 8192);
    const int lane = F.lane;
    constexpr int I_NO = 32 * 64, I_O = 32 * 64, I_PO = 16 * 64, I_W1 = 64 * 8, I_W2 = 4 * 4, I_B1 = 512;
    constexpr int NITEMS = I_NO + I_O + I_PO + 2 * I_W1 + 2 * I_W2 + I_B1;
    for (int it = cw; it < NITEMS; it += NCW) {
        int r = it;
        if (r < I_W1) { transpose_item(a.in[6], 256, 256, (bf16_t*)(ws + WS_W1KT), 4096, 0, false, scr, r / 8, r % 8, lane); continue; } r -= I_W1;
        if (r < I_W1) { transpose_item(a.in[9], 256, 256, (bf16_t*)(ws + WS_W1VT), 4096, 0, false, scr, r / 8, r % 8, lane); continue; } r -= I_W1;
        if (r < I_B1) {
            const int which = r >> 8, fb = (r >> 6) & 3, ch = r & 63, f = fb * 64 + lane;
            const float* pe = a.in[which ? 8 : 5]; const float* w1 = a.in[which ? 9 : 6]; float s = 0.f;
#pragma unroll 16
            for (int k = ch * 64; k < ch * 64 + 64; ++k) s += pe[k] * w1[(size_t)k * 256 + f];
            ((float*)(ws + WS_B1P))[(which * 64 + ch) * 256 + f] = s; continue; } r -= I_B1;
        if (r < I_W2) { transpose_item(a.in[7], 128, 128, (bf16_t*)(ws + WS_W2KT), 256, 0, true, scr, r / 4, r % 4, lane); continue; } r -= I_W2;
        if (r < I_W2) { transpose_item(a.in[10], 128, 128, (bf16_t*)(ws + WS_W2VT), 256, 0, false, scr, r / 4, r % 4, lane); continue; } r -= I_W2;
        if (r < I_PO) { transpose_item(a.in[11], 2048, 2048, (bf16_t*)(ws + WS_WPOT), 1024, 0, false, scr, r / 64, r % 64, lane); continue; } r -= I_PO;
        if (r < I_NO) { transpose_item(a.in[12], 2048, 2048, (bf16_t*)(ws + WS_WNOT), 2048, 0, false, scr, r / 64, r % 64, lane, WNO_SCALE); continue; } r -= I_NO;
        transpose_item(a.in[15], 2048, 2048, (bf16_t*)(ws + WS_WOT), 2048, 0, false, scr, r / 64, r % 64, lane);
    }
}

template <int W>
__device__ __forceinline__ void ypool_item(const bf16_t* __restrict__ U, const bf16_t* __restrict__ GP, bf16_t* __restrict__ Y, const float* __restrict__ scale, int c, int t0) {
    u32x4 x[W + 7], gq[8];
#pragma unroll
    for (int k = 0; k < W + 7; ++k) { const int r = t0 - (W - 1) + k; x[k] = r >= 0 ? *(const u32x4*)(U + (size_t)r * 1024 + c) : (u32x4){0u, 0u, 0u, 0u}; }
#pragma unroll
    for (int k = 0; k < 8; ++k) gq[k] = *(const u32x4*)(GP + (size_t)(t0 + k) * 1024 + c);
    const f32x4 sc0 = *(const f32x4*)(scale + c), sc1 = *(const f32x4*)(scale + c + 4);
    f32x4 s0 = {0.f, 0.f, 0.f, 0.f}, s1 = s0, a0, a1;
#pragma unroll
    for (int k = 0; k < W - 1; ++k) { unpack8(x[k], a0, a1); s0 = s0 + a0; s1 = s1 + a1; }
#pragma unroll
    for (int k = 0; k < 8; ++k) { const int t = t0 + k;
        unpack8(x[W - 1 + k], a0, a1); s0 = s0 + a0; s1 = s1 + a1;
        const int cnt = (t + 1 < W) ? t + 1 : W; const float ic = 1.0f / (float)cnt;
        f32x4 g0, g1; unpack8(gq[k], g0, g1);
        *(u32x4*)(Y + (size_t)t * 1024 + c) = pack8((s0 * ic - a0) * sc0 * g0, (s1 * ic - a1) * sc1 * g1);
        f32x4 b0, b1; unpack8(x[k], b0, b1); s0 = s0 - b0; s1 = s1 - b1; }
}
__device__ __forceinline__ void p2_ypool(const Frame& F, unsigned char* ws, const float* __restrict__ scale, int cw, int NCW) {
    const bf16_t* __restrict__ U = (const bf16_t*)(ws + WS_U); const bf16_t* __restrict__ GP = (const bf16_t*)(ws + WS_GP); bf16_t* __restrict__ Y = (bf16_t*)(ws + WS_H + 16 * MiB);
    for (int wi = cw; wi < 4 * 512; wi += NCW) {
        const int g = wi & 3, t0 = ((wi >> 2) * 2 + (F.lane >> 5)) * 8, c = (g * 32 + (F.lane & 31)) * 8;
        if (g == 0) ypool_item<2>(U, GP, Y, scale, c, t0); else if (g == 1) ypool_item<4>(U, GP, Y, scale, c, t0);
        else if (g == 2) ypool_item<8>(U, GP, Y, scale, c, t0); else ypool_item<16>(U, GP, Y, scale, c, t0);
    }
}
__device__ __forceinline__ void p2_vt8(const Frame& F, unsigned char* ws, int cw, int NCW) {
    const int lane = F.lane;
    for (int it = cw; it < 1024; it += NCW) {
        const int which = it >> 9, h = (it >> 7) & 3, j = it & 127;
        const unsigned char* V8 = ws + (which ? WS_V8W : WS_V8S) + (size_t)(64 * j) * 512 + h * 128 + 2 * lane;
        unsigned char* T = ws + (which ? WS_V8TW : WS_V8TS) + (size_t)(h * 128 + j) * 8192 + (size_t)(2 * lane) * 64;
#pragma unroll
        for (int hb = 0; hb < 2; ++hb) {
            unsigned short e[32];
#pragma unroll
            for (int jj = 0; jj < 32; ++jj) { const int key = jj < 16 ? crow(jj, hb) : 32 + crow(jj - 16, hb); e[jj] = *(const unsigned short*)(V8 + (size_t)key * 512); }
            u32x4 a0, a1, b0, b1;
#pragma unroll
            for (int q = 0; q < 4; ++q) {
                a0[q] = (unsigned)(e[4*q] & 0xff) | ((unsigned)(e[4*q+1] & 0xff) << 8) | ((unsigned)(e[4*q+2] & 0xff) << 16) | ((unsigned)(e[4*q+3] & 0xff) << 24);
                a1[q] = (unsigned)(e[16+4*q] & 0xff) | ((unsigned)(e[16+4*q+1] & 0xff) << 8) | ((unsigned)(e[16+4*q+2] & 0xff) << 16) | ((unsigned)(e[16+4*q+3] & 0xff) << 24);
                b0[q] = (unsigned)(e[4*q] >> 8) | ((unsigned)(e[4*q+1] >> 8) << 8) | ((unsigned)(e[4*q+2] >> 8) << 16) | ((unsigned)(e[4*q+3] >> 8) << 24);
                b1[q] = (unsigned)(e[16+4*q] >> 8) | ((unsigned)(e[16+4*q+1] >> 8) << 8) | ((unsigned)(e[16+4*q+2] >> 8) << 16) | ((unsigned)(e[16+4*q+3] >> 8) << 24); }
            *(u32x4*)(T + hb * 32) = a0; *(u32x4*)(T + hb * 32 + 16) = a1; *(u32x4*)(T + 64 + hb * 32) = b0; *(u32x4*)(T + 64 + hb * 32 + 16) = b1;
        }
    }
}

__device__ __forceinline__ void p3_compress2(const Frame& F, unsigned char* ws, int cwg, int NCWG) {
    const int tid = F.tid, lane = F.lane, r = lane & 31, hh = lane >> 5, wave = F.wave;
    const float* rcos = (const float*)(ws + WS_ROPE); const float* rsin = rcos + (size_t)S * 64;
    LAS bf16_t* hl = (LAS bf16_t*)F.lds;
    for (int it = cwg; it < 128; it += NCWG) {
        const int which = it >> 6, rt = it & 63;
        { const int row = tid >> 4, f0 = (tid & 15) * 16;
          const float* sl = (const float*)(ws + WS_SLAB) + ((size_t)(which * NSPLIT) * 2048 + rt * 32 + row) * 256 + f0; const float* b1 = (const float*)(ws + WS_B1) + which * 256 + f0;
          f32x4 s[4];
#pragma unroll
          for (int q = 0; q < 4; ++q) s[q] = *(const f32x4*)(b1 + 4 * q);
#pragma unroll
          for (int ks = 0; ks < NSPLIT; ++ks)
#pragma unroll
              for (int q = 0; q < 4; ++q) s[q] = s[q] + *(const f32x4*)(sl + (size_t)ks * 2048 * 256 + 4 * q);
#pragma unroll
          for (int q = 0; q < 4; ++q)
#pragma unroll
              for (int e = 0; e < 4; ++e) s[q][e] = siluf_(s[q][e]);
          *(LAS u32x4*)(hl + row * 264 + f0) = pack8(s[0], s[1]); *(LAS u32x4*)(hl + row * 264 + f0 + 8) = pack8(s[2], s[3]); }
        __syncthreads();
        if (wave < 4) {
            const int ct = wave, row = rt * 32 + r;
            const bf16_t* W2 = (const bf16_t*)(ws + (which ? WS_W2VT : WS_W2KT)) + (size_t)(ct * 32 + r) * 256 + hh * 8;
            f32x16 acc = f32x16{};
#pragma unroll 4
            for (int k = 0; k < 16; ++k) acc = __builtin_amdgcn_mfma_f32_32x32x16_bf16(*(const bf16x8*)(W2 + k * 16), *(const LAS bf16x8*)(hl + r * 264 + k * 16 + hh * 8), acc, 0, 0, 0);
            const int n = row & 511; bf16_t* dst = (bf16_t*)(ws + (which ? WS_VC : WS_KC)) + (size_t)row * 128 + ct * 32 + 4 * hh;
            const int pos = (16 * n + 31) > S - 1 ? S - 1 : 16 * n + 31;
#pragma unroll
            for (int gq = 0; gq < 4; ++gq) {
                float v0 = acc[4 * gq], v1 = acc[4 * gq + 1], v2 = acc[4 * gq + 2], v3 = acc[4 * gq + 3];
                if (which == 0) { const int i = (ct * 32 + 8 * gq + 4 * hh) >> 1; const float c0 = rcos[(size_t)pos * 64 + i], s0 = rsin[(size_t)pos * 64 + i], c1 = rcos[(size_t)pos * 64 + i + 1], s1 = rsin[(size_t)pos * 64 + i + 1];
                    const float o0 = v0 * c0 - v1 * s0, o1 = v1 * c0 + v0 * s0, o2 = v2 * c1 - v3 * s1, o3 = v3 * c1 + v2 * s1; v0 = o0; v1 = o1; v2 = o2; v3 = o3; }
                u32x2 w; w.x = cvtpk(v0, v1); w.y = cvtpk(v2, v3); if (n == 511) { w.x = 0u; w.y = 0u; }
                *(u32x2*)(dst + 8 * gq) = w;
            }
        }
        __syncthreads();
    }
}

namespace nsa {
constexpr int SHM_V = 16384, SHM_K = 16384;
constexpr int L_V = 0, L_K = 3 * SHM_V, L_WS = L_K + 2 * SHM_K, L_IMP = L_WS + NWAVES * 64 * 4, IMP_LD = 129, L_SELM = L_IMP + 64 * IMP_LD * 4, L_END = L_SELM + 64 * 8 * 2;
static_assert(L_END <= RING_BYTES, "attention LDS");
constexpr float SCALE = 0.08838834764831845f, C2 = 1.4426950408889634f * SCALE, THR = 8.f;
#define KSWZ(row, colB) ((row) * 256 + ((colB) ^ (((row) & 7) << 4)))
#define SBAR() __builtin_amdgcn_sched_barrier(0)
#define LADD(p, v) (void)__hip_atomic_fetch_add((p), (v), __ATOMIC_RELAXED, __HIP_MEMORY_SCOPE_WORKGROUP)
__device__ __forceinline__ int v_st(int k, int c) { const int kk = (k & ~0xC) | ((k & 4) << 1) | ((k & 8) >> 1); return ((kk >> 3) * 4 + (c >> 5)) * 512 + ((kk & 7) * 32 + (c & 31)) * 2; }
__device__ __forceinline__ int v_rd_base(int lane) { return ((lane & 3) << 3) | (((lane >> 2) & 3) << 6) | (((lane >> 4) & 1) << 5) | (((lane >> 5) & 1) << 8); }
constexpr int v_rd_off(int d0, int ks, int half) { return d0 * 512 + ks * 4096 + half * 2048; }
__device__ __forceinline__ unsigned cvtpk_a(float lo, float hi) { unsigned r; asm volatile("v_cvt_pk_bf16_f32 %0, %1, %2" : "=v"(r) : "v"(lo), "v"(hi)); return r; }

__device__ __forceinline__ void mask_range(f32x16& p0, f32x16& p1, int dq, unsigned Wn) {
    const float NEG = -__builtin_inff();
#pragma unroll
    for (int r = 0; r < 16; ++r) { const int c = (r & 3) + 8 * (r >> 2);
        if ((unsigned)(dq + c) >= Wn) p0[r] = NEG;
        if ((unsigned)(dq + c + 32) >= Wn) p1[r] = NEG; }
}
__device__ __forceinline__ void mask_row(f32x16& p0, f32x16& p1, bool keep) {
    const float NEG = -__builtin_inff();
#pragma unroll
    for (int r = 0; r < 16; ++r) { p0[r] = keep ? p0[r] : NEG; p1[r] = keep ? p1[r] : NEG; }
}
__device__ __forceinline__ float rowmax32(const f32x16& p0, const f32x16& p1) {
    float pmax = p0[0];
#pragma unroll
    for (int r = 1; r < 16; ++r) pmax = fmaxf(pmax, p0[r]);
#pragma unroll
    for (int r = 0; r < 16; ++r) pmax = fmaxf(pmax, p1[r]);
    auto rr = __builtin_amdgcn_permlane32_swap(__float_as_uint(pmax), __float_as_uint(pmax), false, false);
    return fmaxf(__uint_as_float(rr[0]), __uint_as_float(rr[1]));
}
__device__ __forceinline__ float rowsum32(const f32x16& p0, const f32x16& p1) {
    float ps = 0.f;
#pragma unroll
    for (int r = 0; r < 16; ++r) ps += p0[r];
#pragma unroll
    for (int r = 0; r < 16; ++r) ps += p1[r];
    auto rr = __builtin_amdgcn_permlane32_swap(__float_as_uint(ps), __float_as_uint(ps), false, false);
    return __uint_as_float(rr[0]) + __uint_as_float(rr[1]);
}
__device__ __forceinline__ void pack_p(const f32x16& p0, const f32x16& p1, bf16x8& pa0, bf16x8& pa1, bf16x8& pa2, bf16x8& pa3) {
#define PK4(P, B_, OUT) do { unsigned a0 = cvtpk_a(P[B_+0], P[B_+1]), a1 = cvtpk_a(P[B_+2], P[B_+3]);                          \
        unsigned b0 = cvtpk_a(P[B_+4], P[B_+5]), b1 = cvtpk_a(P[B_+6], P[B_+7]);                                             \
        auto r0 = __builtin_amdgcn_permlane32_swap(a0, b0, false, false); auto r1 = __builtin_amdgcn_permlane32_swap(a1, b1, false, false); \
        u32x4 w = {r0[0], r1[0], r0[1], r1[1]}; OUT = __builtin_bit_cast(bf16x8, w); } while (0)
    PK4(p0, 0, pa0); PK4(p0, 8, pa1); PK4(p1, 0, pa2); PK4(p1, 8, pa3);
#undef PK4
}
__device__ __forceinline__ void qkt(f32x16& p0, f32x16& p1, const LAS unsigned char* K_buf, int r32, int hi, const bf16x8* qr) {
    p0 = f32x16{}; p1 = f32x16{};
    const LAS unsigned char* kb[4];
#pragma unroll
    for (int dd = 0; dd < 4; ++dd) kb[dd] = K_buf + KSWZ(r32, (dd * 16 + hi * 8) * 2);
#define KLD(F, d0) do { const LAS unsigned char* a_ = kb[(d0) & 3] + ((d0) >> 2) * 128; F##0 = *(const LAS bf16x8*)(a_); F##1 = *(const LAS bf16x8*)(a_ + 32 * 256); \
        const LAS unsigned char* c_ = kb[((d0) + 1) & 3] + (((d0) + 1) >> 2) * 128; F##2 = *(const LAS bf16x8*)(c_); F##3 = *(const LAS bf16x8*)(c_ + 32 * 256); } while (0)
#define KMM(F, d0) do { p0 = __builtin_amdgcn_mfma_f32_32x32x16_bf16(F##0, qr[d0], p0, 0, 0, 0); p1 = __builtin_amdgcn_mfma_f32_32x32x16_bf16(F##1, qr[d0], p1, 0, 0, 0); \
        p0 = __builtin_amdgcn_mfma_f32_32x32x16_bf16(F##2, qr[(d0) + 1], p0, 0, 0, 0); p1 = __builtin_amdgcn_mfma_f32_32x32x16_bf16(F##3, qr[(d0) + 1], p1, 0, 0, 0); } while (0)
    bf16x8 fa0, fa1, fa2, fa3, fb0, fb1, fb2, fb3;
    KLD(fa, 0); KLD(fb, 2); SBAR();
    KMM(fa, 0); KLD(fa, 4); SBAR();
    KMM(fb, 2); KLD(fb, 6); SBAR();
    KMM(fa, 4); SBAR();
    KMM(fb, 6);
#undef KLD
#undef KMM
}
struct VF8 { s16x4 l0, h0, l1, h1, l2, h2, l3, h3; };
#define TRRD(dst, off) asm volatile("ds_read_b64_tr_b16 %0, %1 offset:%2" : "=&v"(dst) : "v"(vb0), "i"(off) : "memory")
__device__ __forceinline__ void pv_read0(VF8& f, int vb0) {
    constexpr int b_ = v_rd_off(0, 0, 0);
    TRRD(f.l0, b_); TRRD(f.h0, b_ + 2048); TRRD(f.l1, b_ + 4096); TRRD(f.h1, b_ + 6144); TRRD(f.l2, b_ + 8192); TRRD(f.h2, b_ + 10240); TRRD(f.l3, b_ + 12288); TRRD(f.h3, b_ + 14336);
}
__device__ __forceinline__ void pv_tile(f32x16* o, int vb0, bf16x8 pa0, bf16x8 pa1, bf16x8 pa2, bf16x8 pa3, VF8& f) {
#define PV_MM(d0, l0, h0, l1, h1, l2, h2, l3, h3) do { \
        o[d0] = __builtin_amdgcn_mfma_f32_32x32x16_bf16(pa0, (bf16x8){l0[0], l0[1], l0[2], l0[3], h0[0], h0[1], h0[2], h0[3]}, o[d0], 0, 0, 0);   \
        o[d0] = __builtin_amdgcn_mfma_f32_32x32x16_bf16(pa1, (bf16x8){l1[0], l1[1], l1[2], l1[3], h1[0], h1[1], h1[2], h1[3]}, o[d0], 0, 0, 0);   \
        o[d0] = __builtin_amdgcn_mfma_f32_32x32x16_bf16(pa2, (bf16x8){l2[0], l2[1], l2[2], l2[3], h2[0], h2[1], h2[2], h2[3]}, o[d0], 0, 0, 0);   \
        o[d0] = __builtin_amdgcn_mfma_f32_32x32x16_bf16(pa3, (bf16x8){l3[0], l3[1], l3[2], l3[3], h3[0], h3[1], h3[2], h3[3]}, o[d0], 0, 0, 0); } while (0)
#define PV_D0(d0) do { s16x4 l0, l1, l2, l3, h0, h1, h2, h3; constexpr int b_ = v_rd_off(d0, 0, 0); \
        TRRD(l0, b_); TRRD(h0, b_ + 2048); TRRD(l1, b_ + 4096); TRRD(h1, b_ + 6144); TRRD(l2, b_ + 8192); TRRD(h2, b_ + 10240); TRRD(l3, b_ + 12288); TRRD(h3, b_ + 14336); \
        asm volatile("s_waitcnt lgkmcnt(0)" ::: "memory"); SBAR(); PV_MM(d0, l0, h0, l1, h1, l2, h2, l3, h3); } while (0)
    asm volatile("s_waitcnt lgkmcnt(0)" ::: "memory"); SBAR(); PV_MM(0, f.l0, f.h0, f.l1, f.h1, f.l2, f.h2, f.l3, f.h3);
    PV_D0(1); PV_D0(2); PV_D0(3);
#undef PV_D0
#undef PV_MM
}
#undef TRRD

enum { M_C1 = 0, M_C2 = 1, M_S = 2, M_W = 3 };
struct Stage { bf16x8 k0, k1, v0, v1; };
__device__ __forceinline__ void stage_load(Stage& sg, const bf16_t* Kp, const bf16_t* Vp, int ld, int j, bool hasv) {
    const int tid = otid(), sr = tid >> 4, sc = (tid & 15) * 8; const size_t k0_ = (size_t)j * 64;
    sg.k0 = *(const bf16x8*)(Kp + (k0_ + sr) * ld + sc); sg.k1 = *(const bf16x8*)(Kp + (k0_ + 32 + sr) * ld + sc);
    if (hasv) { sg.v0 = *(const bf16x8*)(Vp + (k0_ + sr) * ld + sc); sg.v1 = *(const bf16x8*)(Vp + (k0_ + 32 + sr) * ld + sc); }
}
struct RowState { float m, l; };
template <int MODE>
__device__ __forceinline__ void attn_pass(LAS unsigned char* lds, const bf16_t* Kp, const bf16_t* Vp, int ld, int j_lo, int j_hi, const bf16x8* qr, int t, int Tq, const u32x4 sel,
                                          RowState& st, float invl, f32x16* o, bool do_imp, Stage& sg) {
    constexpr bool HASV = MODE != M_C1;
    const int tid = otid(), wid = __builtin_amdgcn_readfirstlane(tid >> 6), lane = tid & 63, r32 = lane & 31, hi = lane >> 5;
    LAS unsigned char* V_lds = lds + L_V; LAS unsigned char* K_lds = lds + L_K;
    LAS float* wsf = (LAS float*)(lds + L_WS) + wid * 64; LAS float* al_l = wsf + 32;
    const int sr = tid >> 4, sc = (tid & 15) * 8, vst0 = v_st(sr, sc), vst1 = v_st(32 + sr, sc), kws = KSWZ(sr, sc * 2);
    const int vb0 = (int)(uintptr_t)V_lds + v_rd_base(lane);
    const int NT = j_hi - j_lo;
#define st_k0 sg.k0
#define st_k1 sg.k1
#define st_v0 sg.v0
#define st_v1 sg.v1
    float m_reg = st.m, l_reg = st.l;
#define SLOAD(j) do { const size_t k0_ = (size_t)(j) * 64; st_k0 = *(const bf16x8*)(Kp + (k0_ + sr) * ld + sc); st_k1 = *(const bf16x8*)(Kp + (k0_ + 32 + sr) * ld + sc); \
        if (HASV) { st_v0 = *(const bf16x8*)(Vp + (k0_ + sr) * ld + sc); st_v1 = *(const bf16x8*)(Vp + (k0_ + 32 + sr) * ld + sc); } } while (0)
#define SWRITE(kof, vof) do { *(LAS bf16x8*)(K_lds + (kof) + kws) = st_k0; *(LAS bf16x8*)(K_lds + (kof) + kws + 32 * 256) = st_k1; \
        if (HASV) { *(LAS bf16x8*)(V_lds + (vof) + vst0) = st_v0; *(LAS bf16x8*)(V_lds + (vof) + vst1) = st_v1; } } while (0)
    const bool late = HASV && wid >= 4;
    bf16x8 pa0, pa1, pa2, pa3;
    SWRITE(0, 0);
    __syncthreads();
    int kof = 0, vof = 0, vprev = 0;
    for (int idx = 0; idx < NT; ++idx) {
        const int j = j_lo + idx, kb = j * 64;
        if (idx + 1 < NT) SLOAD(j + 1);
        if (HASV && late && idx > 0) { SBAR(); VF8 vf; pv_read0(vf, vb0 + vprev); pv_tile(o, vb0 + vprev, pa0, pa1, pa2, pa3, vf); SBAR(); }
        f32x16 p0, p1; qkt(p0, p1, K_lds + kof, r32, hi, qr);
        VF8 vfe; if (HASV && !late) { SBAR(); pv_read0(vfe, vb0 + vof); SBAR(); }
#if EXP_QKT2
        asm volatile("" : "+v"(p0), "+v"(p1)); SBAR(); qkt(p0, p1, K_lds + kof, r32, hi, qr);
#endif
        if (MODE == M_C1 || MODE == M_C2) { const int nmax1 = ((t - 31) >> 4) + 1; mask_range(p0, p1, kb + 4 * hi, (unsigned)(nmax1 > 0 ? nmax1 : 0)); }
        else if (MODE == M_S) { if (j == Tq) mask_range(p0, p1, kb + 4 * hi, (unsigned)(t + 1));
                                else { const unsigned w_ = (j >> 5) == 0 ? sel.x : (j >> 5) == 1 ? sel.y : (j >> 5) == 2 ? sel.z : sel.w; mask_row(p0, p1, ((w_ >> (j & 31)) & 1u) != 0u); } }
        else { if (j == Tq || j + 8 <= Tq) mask_range(p0, p1, kb + 4 * hi - (t - 511), 512u); }
        if (MODE == M_C1) { const float pmax = rowmax32(p0, p1); const float mn = fmaxf(m_reg, pmax); const float alpha = __builtin_amdgcn_exp2f((m_reg - mn) * C2); m_reg = mn;
            const float mnL = -mn * C2;
#pragma unroll
            for (int r = 0; r < 16; ++r) { p0[r] = __builtin_amdgcn_exp2f(fmaf(p0[r], C2, mnL)); p1[r] = __builtin_amdgcn_exp2f(fmaf(p1[r], C2, mnL)); }
            l_reg = l_reg * alpha + rowsum32(p0, p1); }
        else if (MODE == M_C2) { const float mnL = -m_reg * C2;
#pragma unroll
            for (int r = 0; r < 16; ++r) { p0[r] = __builtin_amdgcn_exp2f(fmaf(p0[r], C2, mnL)) * invl; p1[r] = __builtin_amdgcn_exp2f(fmaf(p1[r], C2, mnL)) * invl; }
            if (do_imp) { LAS unsigned* imp = (LAS unsigned*)(lds + L_IMP) + ((wid & 1) * 32 + r32) * IMP_LD + 16 * j + hi;
#pragma unroll
                for (int k = 0; k < 4; ++k) {
                    { const float e_ = p0[4 * k + 3], a_ = 2.f * (p0[4 * k] + p0[4 * k + 1] + p0[4 * k + 2]) + e_;
                      LADD(imp + 2 * k, (unsigned)(a_ * 67108864.f + 0.5f)); LADD(imp + 2 * k + 1, (unsigned)(e_ * 67108864.f + 0.5f)); }
                    { const float e_ = p1[4 * k + 3], a_ = 2.f * (p1[4 * k] + p1[4 * k + 1] + p1[4 * k + 2]) + e_;
                      LADD(imp + 8 + 2 * k, (unsigned)(a_ * 67108864.f + 0.5f)); LADD(imp + 8 + 2 * k + 1, (unsigned)(e_ * 67108864.f + 0.5f)); } } }
            pack_p(p0, p1, pa0, pa1, pa2, pa3); }
        else { const float pmax = rowmax32(p0, p1); float mn, alpha;
            if (__builtin_expect(__all((pmax - m_reg) * SCALE <= THR), 1)) { mn = m_reg; alpha = 1.f; }
            else { mn = fmaxf(m_reg, pmax); alpha = __builtin_amdgcn_exp2f((m_reg - mn) * C2); m_reg = mn; }
            const float mnL = -mn * C2;
#pragma unroll
            for (int r = 0; r < 16; ++r) { p0[r] = __builtin_amdgcn_exp2f(fmaf(p0[r], C2, mnL)); p1[r] = __builtin_amdgcn_exp2f(fmaf(p1[r], C2, mnL)); }
            l_reg = l_reg * alpha + rowsum32(p0, p1);
            pack_p(p0, p1, pa0, pa1, pa2, pa3);
            if (__any(alpha < 1.f)) { if (hi == 0) al_l[r32] = alpha; asm volatile("s_waitcnt lgkmcnt(0)" ::: "memory");
#pragma unroll
                for (int d_ = 0; d_ < 4; ++d_)
#pragma unroll
                    for (int r = 0; r < 16; ++r) o[d_][r] *= al_l[crow(r, hi)]; } }
        if (HASV && !late) { SBAR(); pv_tile(o, vb0 + vof, pa0, pa1, pa2, pa3, vfe); }
        const int kn = kof ^ SHM_K, vn = (vof == 2 * SHM_V) ? 0 : vof + SHM_V;
        if (idx + 1 < NT) { SWRITE(kn, vn); }
        __syncthreads();
        vprev = vof; kof = kn; vof = vn;
    }
    if (HASV) { if (late) { SBAR(); VF8 vf; pv_read0(vf, vb0 + vprev); pv_tile(o, vb0 + vprev, pa0, pa1, pa2, pa3, vf); } __syncthreads(); }
    st.m = m_reg; st.l = l_reg;
#undef SLOAD
#undef SWRITE
#undef st_k0
#undef st_k1
#undef st_v0
#undef st_v1
}

typedef int v8i __attribute__((ext_vector_type(8)));
struct Stage8 { u32x4 k, v; };
constexpr int SHM8 = 8192;
constexpr float THR8 = 0.5f;
__device__ __forceinline__ f32x16 mfma8(v8i a, v8i b, f32x16 c) { return __builtin_amdgcn_mfma_scale_f32_32x32x64_f8f6f4(a, b, c, 0, 0, 0, 0x7F7F7F7F, 0, 0x7F7F7F7F); }
__device__ __forceinline__ int k8_off(int key, int c) { return key * 128 + ((c ^ ((key >> 1) & 7)) << 4); }
__device__ __forceinline__ int v8_off(int d, int c) { return d * 64 + ((c ^ ((d >> 2) & 3)) << 4); }
__device__ __forceinline__ void stage_load8(Stage8& sg, const unsigned char* K8h, const unsigned char* V8Th, int j) {
    const int tid = otid();
    sg.k = *(const u32x4*)(K8h + (size_t)(64 * j + (tid >> 3)) * 512 + (tid & 7) * 16); sg.v = *(const u32x4*)(V8Th + (size_t)j * 8192 + tid * 16);
}
__device__ __forceinline__ v8i ld_v8i(const LAS unsigned char* a, const LAS unsigned char* b) { const u32x4 x = *(const LAS u32x4*)a, y = *(const LAS u32x4*)b; return (v8i){(int)x.x, (int)x.y, (int)x.z, (int)x.w, (int)y.x, (int)y.y, (int)y.z, (int)y.w}; }
template <int MODE>
__device__ __forceinline__ void attn_pass8(LAS unsigned char* lds, const unsigned char* K8h, const unsigned char* V8Th, int j_lo, int j_hi, const v8i* qf, int t, int Tq, const u32x4 sel,
                                           RowState& st, f32x16* o, f32x16& ol, Stage8& sg0) {
    const int tid = otid(), wid = __builtin_amdgcn_readfirstlane(tid >> 6), lane = tid & 63, r32 = lane & 31, hi = lane >> 5;
    LAS unsigned char* V_lds = lds + L_V; LAS unsigned char* K_lds = lds + L_K;
    LAS float* wsf = (LAS float*)(lds + L_WS) + wid * 64; LAS float* al_l = wsf + 32;
    const int kws = k8_off(tid >> 3, tid & 7), vws = v8_off(tid >> 2, tid & 3);
    const int NT = j_hi - j_lo;
    float m_reg = st.m;
#define SWRITE8(SG, kof, vof) do { *(LAS u32x4*)(K_lds + (kof) + kws) = (SG).k; *(LAS u32x4*)(V_lds + (vof) + vws) = (SG).v; } while (0)
    const bool late = wid >= 4;
    v8i pa; Stage8 sg1;
    const v8i ones = {0x38383838, 0x38383838, 0x38383838, 0x38383838, 0x38383838, 0x38383838, 0x38383838, 0x38383838};
    SWRITE8(sg0, 0, 0);
    __syncthreads();
    if (NT > 1) stage_load8(sg1, K8h, V8Th, j_lo + 1);
    int kof = 0, vof = 0, vprev = 0;
#define PV8(vo) do { const LAS unsigned char* vb_ = V_lds + (vo);                                                                      \
        _Pragma("unroll") for (int d0 = 0; d0 < 4; ++d0) { const int d_ = d0 * 32 + r32;                                               \
            o[d0] = mfma8(pa, ld_v8i(vb_ + v8_off(d_, 2 * hi), vb_ + v8_off(d_, 2 * hi + 1)), o[d0]); }                                \
        ol = mfma8(pa, ones, ol); } while (0)
#define TILE8(idx, SGL, SGW) do { const int j = j_lo + (idx), kb = j * 64;                                                               \
        if ((idx) + 2 < NT) stage_load8(SGL, K8h, V8Th, j + 2);                                                                        \
        if (late && (idx) > 0) { SBAR(); PV8(vprev); SBAR(); }                                                                         \
        f32x16 p0 = f32x16{}, p1 = f32x16{};                                                                                           \
        { const LAS unsigned char* kb_ = K_lds + kof;                                                                                  \
          _Pragma("unroll") for (int ks = 0; ks < 2; ++ks) {                                                                           \
              p0 = mfma8(ld_v8i(kb_ + k8_off(r32, 4 * ks + 2 * hi), kb_ + k8_off(r32, 4 * ks + 2 * hi + 1)), qf[ks], p0);               \
              p1 = mfma8(ld_v8i(kb_ + k8_off(32 + r32, 4 * ks + 2 * hi), kb_ + k8_off(32 + r32, 4 * ks + 2 * hi + 1)), qf[ks], p1); } } \
        bool rowkeep = true;                                                                                                           \
        if (MODE == M_S) { if (j == Tq) mask_range(p0, p1, kb + 4 * hi, (unsigned)(t + 1));                                             \
                           else { const unsigned w_ = (j >> 5) == 0 ? sel.x : (j >> 5) == 1 ? sel.y : (j >> 5) == 2 ? sel.z : sel.w; rowkeep = ((w_ >> (j & 31)) & 1u) != 0u; } } \
        else { if (j == Tq || j + 8 <= Tq) mask_range(p0, p1, kb + 4 * hi - (t - 511), 512u); }                                          \
        { float pmax = rowmax32(p0, p1); if (MODE == M_S) pmax = rowkeep ? pmax : -__builtin_inff(); float mn, alpha;                  \
          if (__builtin_expect(__all((pmax - m_reg) * SCALE <= THR8), 1)) { mn = m_reg; alpha = 1.f; }                                 \
          else { mn = fmaxf(m_reg, pmax); alpha = __builtin_amdgcn_exp2f((m_reg - mn) * C2); m_reg = mn; }                             \
          float mnL = 8.0f - mn * C2;                                                                                                  \
          if (MODE == M_S) mnL = rowkeep ? mnL : -__builtin_inff();                                                                    \
          _Pragma("unroll") for (int r = 0; r < 16; ++r) { p0[r] = __builtin_amdgcn_exp2f(fmaf(p0[r], C2, mnL)); p1[r] = __builtin_amdgcn_exp2f(fmaf(p1[r], C2, mnL)); } \
          _Pragma("unroll") for (int q = 0; q < 4; ++q) { pa[q] = (int)cvt4_fp8(p0[4 * q], p0[4 * q + 1], p0[4 * q + 2], p0[4 * q + 3]); pa[4 + q] = (int)cvt4_fp8(p1[4 * q], p1[4 * q + 1], p1[4 * q + 2], p1[4 * q + 3]); } \
          if (__any(alpha < 1.f)) { if (hi == 0) al_l[r32] = alpha; asm volatile("s_waitcnt lgkmcnt(0)" ::: "memory");                 \
              _Pragma("unroll") for (int r = 0; r < 16; ++r) { const float a_ = al_l[crow(r, hi)]; o[0][r] *= a_; o[1][r] *= a_; o[2][r] *= a_; o[3][r] *= a_; ol[r] *= a_; } } } \
        if (!late) { SBAR(); PV8(vof); }                                                                                               \
        const int kn = kof ^ SHM8, vn = (vof == 2 * SHM8) ? 0 : vof + SHM8;                                                            \
        if ((idx) + 1 < NT) { SWRITE8(SGW, kn, vn); }                                                                                  \
        __syncthreads();                                                                                                               \
        vprev = vof; kof = kn; vof = vn; } while (0)
    int idx = 0;
    for (; idx + 1 < NT; idx += 2) { TILE8(idx, sg0, sg1); TILE8(idx + 1, sg1, sg0); }
    if (idx < NT) TILE8(idx, sg0, sg1);
    if (late) { SBAR(); PV8(vprev); }
    __syncthreads();
    st.m = m_reg;
#undef TILE8
#undef PV8
#undef SWRITE8
}

template <int MODE, bool USE_OL>
__device__ __forceinline__ void branch_out(LAS unsigned char* lds, const f32x16* o, float rowscale, bf16_t* onsa_w, const bf16_t* gn_w, const f32x16 ol, unsigned char* onsa8_w = nullptr) {
    const int tid = otid(), wid = __builtin_amdgcn_readfirstlane(tid >> 6), lane = tid & 63, r32 = lane & 31, hi = lane >> 5;
    LAS float* li_l = (LAS float*)(lds + L_WS) + wid * 64;
    if (hi == 0) li_l[r32] = rowscale; asm volatile("s_waitcnt lgkmcnt(0)" ::: "memory");
    LAS unsigned* stg = (LAS unsigned*)(lds + wid * 8192);
#pragma unroll
    for (int r = 0; r < 16; ++r) { const int orow = crow(r, hi); float sc = li_l[orow]; if (USE_OL) sc = ol[r] > 0.f ? sc * __builtin_amdgcn_rcpf(ol[r]) : 0.f;
#pragma unroll
        for (int d0 = 0; d0 < 4; ++d0) { const float v = o[d0][r] * sc; const float vn = dpp_x1f(v);
            if ((r32 & 1) == 0) stg[orow * 64 + d0 * 16 + (r32 >> 1)] = cvtpk(v, vn); } }
    asm volatile("s_waitcnt lgkmcnt(0)" ::: "memory");
    u32x4 val[8], prev[8], gq[8];
#pragma unroll
    for (int i = 0; i < 8; ++i) val[i] = *(const LAS u32x4*)(stg + (i * 4 + (lane >> 4)) * 64 + (lane & 15) * 4);
    int rb = lane >> 4; asm volatile("" : "+v"(rb));
    bf16_t* gp_ = onsa_w + (size_t)rb * 2048 + (lane & 15) * 8; const bf16_t* gg_ = gn_w + (size_t)rb * 2048 + (lane & 15) * 8;
    unsigned char* o8_ = onsa8_w + (size_t)rb * 2048 + (lane & 15) * 8;
    if (MODE >= 1) {
#pragma unroll
        for (int i = 0; i < 8; ++i) prev[i] = *(const u32x4*)(gp_ + (size_t)i * 4 * 2048); }
    if (MODE == 2) {
#pragma unroll
        for (int i = 0; i < 8; ++i) gq[i] = *(const u32x4*)(gg_ + (size_t)i * 4 * 2048); }
#pragma unroll
    for (int i = 0; i < 8; ++i) { u32x4 w = val[i];
        if (MODE >= 1) { f32x4 a0, a1, b0, b1; unpack8(val[i], a0, a1); unpack8(prev[i], b0, b1); a0 = a0 + b0; a1 = a1 + b1;
            if (MODE == 2) { f32x4 g0, g1; unpack8(gq[i], g0, g1); a0 = a0 * g0; a1 = a1 * g1; }
            w = pack8(a0, a1); }
        if (MODE == 2) { f32x4 a0, a1; unpack8(w, a0, a1); u32x2 w8; w8.x = cvt4_fp8(sat8(a0[0] * ONSA_SCALE), sat8(a0[1] * ONSA_SCALE), sat8(a0[2] * ONSA_SCALE), sat8(a0[3] * ONSA_SCALE));
            w8.y = cvt4_fp8(sat8(a1[0] * ONSA_SCALE), sat8(a1[1] * ONSA_SCALE), sat8(a1[2] * ONSA_SCALE), sat8(a1[3] * ONSA_SCALE)); *(u32x2*)(o8_ + (size_t)i * 4 * 2048) = w8; }
        else *(u32x4*)(gp_ + (size_t)i * 4 * 2048) = w; }
    __syncthreads();
}

__device__ __forceinline__ void attn_unit(LAS unsigned char* lds, unsigned char* ws, int h, int Tq) {
    const int tid = otid(), wid = __builtin_amdgcn_readfirstlane(tid >> 6), lane = tid & 63, r32 = lane & 31, hi = lane >> 5;
    const int g = wid >> 1, tl = (wid & 1) * 32 + r32, t = Tq * 64 + tl, hq = 4 * h + g;
    const bf16_t* Q = (const bf16_t*)(ws + WS_Q); const bf16_t* GBR = (const bf16_t*)(ws + WS_GBR);
    bf16_t* onsa_w = (bf16_t*)(ws + WS_ONSA) + (size_t)(Tq * 64 + (wid & 1) * 32) * 2048 + hq * 128; const bf16_t* gn_w = (const bf16_t*)(ws + WS_GN) + (size_t)(Tq * 64 + (wid & 1) * 32) * 2048 + hq * 128;
    bf16x8 qr[8];
#pragma unroll
    for (int d0 = 0; d0 < 8; ++d0) qr[d0] = *(const bf16x8*)(Q + (size_t)t * 2048 + hq * 128 + d0 * 16 + hi * 8);
    const float g_c = bf2f(GBR[(size_t)t * 256 + hq * 3 + 0]), g_s = bf2f(GBR[(size_t)t * 256 + hq * 3 + 1]), g_w = bf2f(GBR[(size_t)t * 256 + hq * 3 + 2]);
    const bool big = Tq >= 16;
    LAS unsigned* IMP = (LAS unsigned*)(lds + L_IMP);
    if (big) { for (int i = tid; i < 64 * IMP_LD; i += 512) IMP[i] = 0u; }
    const u32x4 nosel = {0u, 0u, 0u, 0u};
    f32x16 o[4]; Stage sg;
    {
        const bf16_t* Kc = (const bf16_t*)(ws + WS_KC) + (size_t)h * 512 * 128; const bf16_t* Vc = (const bf16_t*)(ws + WS_VC) + (size_t)h * 512 * 128;
        const int ntc = ((4 * Tq + 2) >> 6) + 1;
        RowState stc{-1e30f, 0.f};
        stage_load(sg, Kc, Vc, 128, 0, false);
        attn_pass<M_C1>(lds, Kc, Vc, 128, 0, ntc, qr, t, Tq, nosel, stc, 0.f, o, false, sg);
        stage_load(sg, Kc, Vc, 128, 0, true);
        const float invl = stc.l > 0.f ? 1.0f / stc.l : 0.f;
#pragma unroll
        for (int d = 0; d < 4; ++d) o[d] = f32x16{};
        attn_pass<M_C2>(lds, Kc, Vc, 128, 0, ntc, qr, t, Tq, nosel, stc, invl, o, big, sg);
        branch_out<0, false>(lds, o, g_c, onsa_w, gn_w, f32x16{});
    }
    {
        LAS unsigned short* SELM = (LAS unsigned short*)(lds + L_SELM);
        int tok = tid >> 3, sub = tid & 7; asm volatile("" : "+v"(tok), "+v"(sub));
        unsigned bits = 0u;
        if (big) {
            unsigned kv[16];
#pragma unroll
            for (int e = 0; e < 16; ++e) { const int j = sub * 16 + e; const unsigned v = IMP[tok * IMP_LD + j]; kv[e] = (j >= 1 && j <= Tq - 2) ? v + 1u : 0u; }
            for (int round = 0; round < 13; ++round) {
                unsigned bv = kv[0]; int bj = 0;
#pragma unroll
                for (int e = 1; e < 16; ++e) { const bool gt = kv[e] > bv; bv = gt ? kv[e] : bv; bj = gt ? e : bj; }
                bj += sub * 16;
#pragma unroll
                for (int st_ = 0; st_ < 3; ++st_) { const unsigned ov = st_ == 0 ? dpp_x1(bv) : st_ == 1 ? dpp_x2(bv) : dpp_m8(bv); const int oj = (int)(st_ == 0 ? dpp_x1((unsigned)bj) : st_ == 1 ? dpp_x2((unsigned)bj) : dpp_m8((unsigned)bj));
                    const bool take = (ov > bv) || (ov == bv && oj < bj); bv = take ? ov : bv; bj = take ? oj : bj; }
                const int we = (bv != 0u && (bj >> 4) == sub) ? (bj & 15) : -1;
#pragma unroll
                for (int e = 0; e < 16; ++e) { const bool hit = (we == e); bits |= hit ? (1u << e) : 0u; kv[e] = hit ? 0u : kv[e]; }
            }
#pragma unroll
            for (int e = 0; e < 16; ++e) { const int j = sub * 16 + e; if (j == 0 || j == Tq - 1 || j == Tq) bits |= 1u << e; }
        } else {
#pragma unroll
            for (int e = 0; e < 16; ++e) { const int j = sub * 16 + e; if (j <= Tq) bits |= 1u << e; }
        }
        SELM[tok * 8 + sub] = (unsigned short)bits;
        __syncthreads();
    }
    const u32x4 sel = *(const LAS u32x4*)(lds + L_SELM + tl * 16);
    v8i qf[2];
    { const unsigned char* q8 = ws + WS_Q8 + (size_t)t * 2048 + hq * 128 + 32 * hi;
#pragma unroll
      for (int ks = 0; ks < 2; ++ks) { const u32x4 x = *(const u32x4*)(q8 + 64 * ks), y = *(const u32x4*)(q8 + 64 * ks + 16); qf[ks] = (v8i){(int)x.x, (int)x.y, (int)x.z, (int)x.w, (int)y.x, (int)y.y, (int)y.z, (int)y.w}; } }
    const unsigned char* K8S = ws + WS_K8S + h * 128; const unsigned char* V8TS = ws + WS_V8TS + (size_t)h * 128 * 8192;
    const unsigned char* K8W = ws + WS_K8W + h * 128; const unsigned char* V8TW = ws + WS_V8TW + (size_t)h * 128 * 8192;
    Stage8 s8;
    {
        RowState sts{-1e30f, 0.f};
#pragma unroll
        for (int d = 0; d < 4; ++d) o[d] = f32x16{};
        f32x16 ol = f32x16{};
        stage_load8(s8, K8S, V8TS, 0);
        attn_pass8<M_S>(lds, K8S, V8TS, 0, Tq + 1, qf, t, Tq, sel, sts, o, ol, s8);
        stage_load8(s8, K8W, V8TW, Tq >= 8 ? Tq - 8 : 0);
        branch_out<1, true>(lds, o, g_s, onsa_w, gn_w, ol);
    }
    {
        RowState stw{-1e30f, 0.f};
#pragma unroll
        for (int d = 0; d < 4; ++d) o[d] = f32x16{};
        f32x16 ol = f32x16{};
        attn_pass8<M_W>(lds, K8W, V8TW, Tq >= 8 ? Tq - 8 : 0, Tq + 1, qf, t, Tq, sel, stw, o, ol, s8);
        branch_out<2, true>(lds, o, g_w, onsa_w, gn_w, ol, ws + WS_ONSA8 + (size_t)(Tq * 64 + (wid & 1) * 32) * 2048 + hq * 128);
    }
}
#undef KSWZ
#undef SBAR
}

constexpr int NPHASE = 8;
__global__ void __launch_bounds__(NWAVES * 64, 2) mega_fwd(Args args) {
    extern __shared__ __attribute__((aligned(16))) unsigned char lds[];
    Frame F;
    F.lds = (LAS unsigned char*)lds;
    F.tid = threadIdx.x; F.lane = F.tid & 63; F.wave = __builtin_amdgcn_readfirstlane(F.tid >> 6);
    F.G = gridDim.x; { const int bx = blockIdx.x; F.vcu = (F.G % 8 == 0) ? (bx % 8) * (F.G / 8) + bx / 8 : bx; }
    volatile LAS unsigned* MISC = (volatile LAS unsigned*)(F.lds + MISC_OFF);
    unsigned char* ws = args.ws;
    for (int u = F.tid; u < (LDS_BYTES - LDSCTL_OFF) / 4; u += NWAVES * 64) ((LAS unsigned*)(F.lds + LDSCTL_OFF))[u] = 0u;
    __syncthreads();
    XcdBarrier bar; bar.bar = (unsigned*)(ws + WS_CTL) + CW_BAR; bar.x = 0; bar.st = nullptr;
#if !N_LAUNCHES_PER_PHASE
    bar = xcd_barrier_post((unsigned*)(ws + WS_CTL) + CW_BAR, MISC + 8);
#endif
    const int lo = args.ph_lo, hi = args.ph_hi;
#define IN(k) (lo <= (k) && (k) < hi && (F.tid = otid(), F.lane = F.tid & 63, true))
#define SEAM(k) do { if (IN(k) && IN((k) + 1)) xcd_barrier(bar); } while (0)
    bf16_t* const GM = (bf16_t*)args.out;

    for (int rep_ = 0; rep_ < (DUP_PHASE == 0 ? 2 : 1); ++rep_) if (IN(0)) { if (rep_) xcd_barrier(bar); p0_prologue(F, args); } SEAM(0);
    for (int rep_ = 0; rep_ < (DUP_PHASE == 1 ? 2 : 1); ++rep_) if (IN(1)) { if (rep_) xcd_barrier(bar);
        pg8::Gemm g{(const bf16_t*)(ws + WS_H), (const bf16_t*)(ws + WS_WCAT), 2048, 2048, 2048};
        pg8::StaticOrder So; So.init(S, NCAT, F.G, (int)blockIdx.x);
        EpiInProj E{ws, GM, args.in[14]};
        pg8::AddrAffine AD{(size_t)256 * 2048 * 2, (size_t)256 * 2048 * 2};
        pg8::gemm_phase<EpiInProj, true>(F.lds, g, So, E, AD);
        { const int nun = (So.nwg + F.G - 1) / F.G, full = So.nwg - (nun - 1) * F.G;
          const int base = full < F.G ? full : 0; if ((int)blockIdx.x >= base) p1_late_weights(F, args, ((int)blockIdx.x - base) * NWAVES + F.wave, (F.G - base) * NWAVES); }
    } SEAM(1);
    for (int rep_ = 0; rep_ < (DUP_PHASE == 2 ? 2 : 1); ++rep_) if (IN(2)) { if (rep_) xcd_barrier(bar);
        pg8::Gemm g{(const bf16_t*)(ws + WS_KCR), (const bf16_t*)(ws + WS_W1KT), 2048, 4096, 4096 / NSPLIT};
        pg8::StaticOrder So; So.init(16 * 256, NSPLIT * 256, F.G, (int)blockIdx.x);
        EpiSlab E{(float*)(ws + WS_SLAB)};
        pg8::AddrCmp AD{(4096 / NSPLIT) / 64};
        pg8::gemm_phase<EpiSlab, false>(F.lds, g, So, E, AD);
        { const int base = F.G > So.nwg ? So.nwg : 0; if ((int)blockIdx.x >= base) { p2_ypool(F, ws, args.in[4], ((int)blockIdx.x - base) * NWAVES + F.wave, (F.G - base) * NWAVES); p2_vt8(F, ws, ((int)blockIdx.x - base) * NWAVES + F.wave, (F.G - base) * NWAVES); } }
        if (blockIdx.x == F.G - 1) { const float* b1p = (const float*)(ws + WS_B1P); float* b1 = (float*)(ws + WS_B1); const int t = F.tid; float s = 0.f;
            for (int c = 0; c < 64; ++c) s += b1p[((t >> 8) * 64 + c) * 256 + (t & 255)];
            b1[t] = s; }
    } SEAM(2);
    for (int rep_ = 0; rep_ < (DUP_PHASE == 3 ? 2 : 1); ++rep_) if (IN(3)) { if (rep_) xcd_barrier(bar);
        p3_compress2(F, ws, (int)blockIdx.x, F.G);
    } SEAM(3);
    for (int rep_ = 0; rep_ < (DUP_PHASE == 5 ? 2 : 1); ++rep_) if (IN(5)) { if (rep_) xcd_barrier(bar);
        for (int p = F.vcu; p < 256; p += F.G) {
#pragma unroll 1
            for (int i = 0; i < 2; ++i) { const int h = p >> 6, x = p & 63; nsa::attn_unit(F.lds, ws, h, i ? x : 127 - x); } }
    } SEAM(5);
    for (int rep_ = 0; rep_ < (DUP_PHASE == 6 ? 2 : 1); ++rep_) if (IN(6)) { if (rep_) xcd_barrier(bar);
        pg8::Gemm ga{(const bf16_t*)(ws + WS_H + 16 * MiB), (const bf16_t*)(ws + WS_WPOT), 1024, 1024, 1024};
        pg8::Gemm gb{(const bf16_t*)(ws + WS_ONSA8), (const bf16_t*)(ws + WS_WNOT), 1024, 1024, 1024};
        pg8::StaticOrder So; So.init(S, 2048, F.G, (int)blockIdx.x);
        EpiYaYb E{EpiYa{(bf16_t*)(ws + WS_YAG), GM}, EpiYb{(bf16_t*)(ws + WS_H), (const bf16_t*)(ws + WS_YAG), GM, 1.0f / (ONSA_SCALE * WNO_SCALE)}};
        pg8::gemm_phase2<EpiYaYb>(F.lds, ga, gb, So, E);
    } SEAM(6);
    for (int rep_ = 0; rep_ < (DUP_PHASE == 7 ? 2 : 1); ++rep_) if (IN(7)) { if (rep_) xcd_barrier(bar);
        pg8::Gemm g{(const bf16_t*)(ws + WS_H), (const bf16_t*)(ws + WS_WOT), 2048, 2048, 2048}; pg8::AddrAffine AD{(size_t)256 * 2048 * 2, (size_t)256 * 2048 * 2};
        pg8::StaticOrder So; So.init(S, 2048, F.G, (int)blockIdx.x);
        EpiOut E{args.out, args.in[0], (float*)(ws + WS_SSQ), args.in[16], (unsigned*)(ws + WS_CTL), F.lds};
        pg8::gemm_phase<EpiOut, true>(F.lds, g, So, E, AD);
    }
#undef IN
#undef SEAM
}

extern "C" void kernel_launch(void* const* d_in, const int* in_sizes, int n_in, void* d_out, int out_size, void* d_ws, size_t ws_size, hipStream_t stream) {
    static int grid = 0;
    if (grid == 0) {
        if (n_in != 17 || in_sizes[0] != S * DM || out_size != S * DM || ws_size < WS_END) { fprintf(stderr, "kernel_launch: unexpected shapes (n_in %d, in0 %d, out %d, ws %zu); nothing launched\n", n_in, n_in > 0 ? in_sizes[0] : -1, out_size, ws_size); grid = -1; return; }
        int dev = 0, cus = 0;
        if (hipGetDevice(&dev) != hipSuccess || hipDeviceGetAttribute(&cus, hipDeviceAttributeMultiprocessorCount, dev) != hipSuccess) { fprintf(stderr, "kernel_launch: device query failed\n"); grid = -1; return; }
        if (hipFuncSetAttribute((const void*)mega_fwd, hipFuncAttributeMaxDynamicSharedMemorySize, LDS_BYTES) != hipSuccess) { fprintf(stderr, "kernel_launch: hipFuncSetAttribute failed\n"); grid = -1; return; }
        (void)hipGetLastError();
        grid = cus;
    }
    if (grid < 0) return;
    (void)hipMemsetAsync((char*)d_ws + WS_CTL, 0, CTL_BYTES, stream);
    Args a{};
    for (int i = 0; i < 17; ++i) a.in[i] = (const float*)d_in[i];
    a.out = (float*)d_out; a.ws = (unsigned char*)d_ws;
#if N_LAUNCHES_PER_PHASE
    for (int p = 0; p < NPHASE; ++p) { a.ph_lo = p; a.ph_hi = p + 1; hipLaunchKernelGGL(mega_fwd, dim3(grid), dim3(NWAVES * 64), LDS_BYTES, stream, a); }
#else
    a.ph_lo = 0; a.ph_hi = NPHASE;
    hipLaunchKernelGGL(mega_fwd, dim3(grid), dim3(NWAVES * 64), LDS_BYTES, stream, a);
#endif
}
```

```cpp
#include <hip/hip_runtime.h>
#include <cstdio>
#include <cstdint>

#define LAS __attribute__((address_space(3)))
#define GAS __attribute__((address_space(1)))
typedef unsigned short bf16_t;
typedef short bf16x8 __attribute__((ext_vector_type(8)));
typedef short s16x4 __attribute__((ext_vector_type(4)));
typedef float f32x4 __attribute__((ext_vector_type(4)));
typedef float f32x16 __attribute__((ext_vector_type(16)));
typedef unsigned u32x4 __attribute__((ext_vector_type(4)));
typedef unsigned u32x2 __attribute__((ext_vector_type(2)));
typedef float f32x2_t __attribute__((ext_vector_type(2)));
typedef __bf16 bf16x2_t __attribute__((ext_vector_type(2)));

#ifndef EXP_QKT2
#define EXP_QKT2 0
#endif
#ifndef DUP_PHASE
#define DUP_PHASE -1
#endif
#ifndef N_LAUNCHES_PER_PHASE
#define N_LAUNCHES_PER_PHASE 0
#endif

constexpr int S = 8192, DM = 2048, NCAT = 9472;
constexpr int HD = 128, NKV = 4, NCMP = 511;
constexpr float EPS = 1e-6f;

constexpr size_t MiB = 1u << 20;
constexpr size_t WS_CTL = 0, CTL_BYTES = 1 * MiB;
constexpr size_t WS_WCAT = 1 * MiB;
constexpr size_t WS_SLAB = WS_WCAT;
constexpr size_t WS_ONSA = WS_WCAT;
constexpr size_t WS_MIXT = 54 * MiB;
constexpr size_t WS_WPOT = 55 * MiB;
constexpr size_t WS_WNOT = 59 * MiB;
constexpr size_t WS_WOT  = 67 * MiB;
constexpr size_t WS_W1KT = 75 * MiB, WS_W1VT = 77 * MiB;
constexpr size_t WS_W2KT = 79 * MiB, WS_W2VT = 79 * MiB + 65536;
constexpr size_t WS_B1P  = 80 * MiB + 262144;
constexpr size_t WS_B1   = 79 * MiB + 131072 + 32768;
constexpr size_t WS_KC   = 79 * MiB + 262144, WS_VC = 79 * MiB + 786432;
constexpr size_t WS_ROPE = 81 * MiB;
constexpr size_t WS_SSQ  = 85 * MiB;
constexpr size_t WS_H    = 86 * MiB;
constexpr size_t WS_U    = 118 * MiB, WS_GP = 134 * MiB;
constexpr size_t WS_YAG  = WS_U;
constexpr size_t WS_Q    = 150 * MiB;
constexpr size_t WS_KCR  = 182 * MiB, WS_VCR = 190 * MiB, WS_KS = 198 * MiB, WS_VS = 206 * MiB, WS_KW = 214 * MiB, WS_VW = 222 * MiB;
constexpr size_t WS_GN   = 230 * MiB;
constexpr size_t WS_GBR  = 262 * MiB;
constexpr size_t WS_K8S = 198 * MiB, WS_K8W = 202 * MiB;
constexpr size_t WS_V8S = 206 * MiB, WS_V8W = 210 * MiB;
constexpr size_t WS_V8TS = 214 * MiB, WS_V8TW = 218 * MiB;
constexpr size_t WS_ONSA8 = WS_WCAT + 32 * MiB;
constexpr float   ONSA_SCALE = 64.f, WNO_SCALE = 64.f;
constexpr size_t WS_H8   = 214 * MiB;
constexpr size_t WS_W8   = 38 * MiB;
constexpr float   W8_SCALE = 64.f;
constexpr size_t WS_Q8   = 266 * MiB;
constexpr size_t WS_END  = 282 * MiB;
constexpr int CW_BAR = 4096;

constexpr int RING_BYTES = 131072;
constexpr int LDSCTL_OFF = RING_BYTES, MISC_OFF = LDSCTL_OFF + 320;
constexpr int LDS_BYTES = 147456;
constexpr int NWAVES = 8;

#define LDS_WAIT() asm volatile("s_waitcnt lgkmcnt(0)" ::: "memory")
#define VM_WAIT() asm volatile("s_waitcnt vmcnt(0)" ::: "memory")

__device__ __forceinline__ unsigned cvtpk(float lo, float hi) { f32x2_t v = {lo, hi}; bf16x2_t b = __builtin_convertvector(v, bf16x2_t); return __builtin_bit_cast(unsigned, b); }
__device__ __forceinline__ float sat8(float x) { return __builtin_amdgcn_fmed3f(x, -448.f, 448.f); }
__device__ __forceinline__ unsigned cvt4_fp8(float a, float b, float c, float d) { int w = __builtin_amdgcn_cvt_pk_fp8_f32(a, b, 0, false); return (unsigned)__builtin_amdgcn_cvt_pk_fp8_f32(c, d, w, true); }
__device__ __forceinline__ float bf2f(unsigned short h) { return __builtin_bit_cast(float, (unsigned)h << 16); }
__device__ __forceinline__ float bflo(unsigned w) { return __builtin_bit_cast(float, w << 16); }
__device__ __forceinline__ float bfhi(unsigned w) { return __builtin_bit_cast(float, w & 0xffff0000u); }
__device__ __forceinline__ float sigmoidf_(float x) { return __builtin_amdgcn_rcpf(1.0f + __expf(-x)); }
__device__ __forceinline__ float siluf_(float x) { return x * __builtin_amdgcn_rcpf(1.0f + __expf(-x)); }
__device__ __forceinline__ int otid() { int t = threadIdx.x; asm volatile("" : "+v"(t)); return t; }
__device__ __forceinline__ unsigned dpp_x1(unsigned v) { return __builtin_amdgcn_update_dpp(0u, v, 0xB1, 0xF, 0xF, false); }
__device__ __forceinline__ unsigned dpp_x2(unsigned v) { return __builtin_amdgcn_update_dpp(0u, v, 0x4E, 0xF, 0xF, false); }
__device__ __forceinline__ unsigned dpp_m8(unsigned v) { return __builtin_amdgcn_update_dpp(0u, v, 0x141, 0xF, 0xF, false); }
__device__ __forceinline__ float dpp_x1f(float v) { return __uint_as_float(dpp_x1(__float_as_uint(v))); }
__device__ __forceinline__ int crow(int r, int hi) { return (r & 3) + 8 * (r >> 2) + 4 * hi; }
__device__ __forceinline__ float wave_sum(float v) {
#pragma unroll
    for (int o = 1; o < 64; o <<= 1) v += __shfl_xor(v, o);
    return v;
}

#define XB_TMO      128
#define XB_XCNT(j)  (256  + 64 * (j))
#define XB_XSUB(j)  (1280 + 64 * (j))
#define XB_XGEN(j)  (2304 + 64 * (j))
#define XB_TOP      3328
#define XB_TOPGEN   3392
#define XCD_BAR_WORDS 3456
#define XB_SPIN_CAP (1u << 18)
__device__ __forceinline__ unsigned xb_ld(unsigned* p)              { return __hip_atomic_load(p, __ATOMIC_RELAXED, __HIP_MEMORY_SCOPE_AGENT); }
__device__ __forceinline__ unsigned xb_add(unsigned* p, unsigned v) { return __hip_atomic_fetch_add(p, v, __ATOMIC_RELAXED, __HIP_MEMORY_SCOPE_AGENT); }
__device__ __forceinline__ unsigned xb_xcc_id() { return (unsigned)__builtin_amdgcn_s_getreg((3 << 11) | 20) & 0xFu; }
#define XB_SPIN(cond, bar) do { unsigned _sp = 0; while (cond) { __builtin_amdgcn_s_sleep(1); \
    if ((++_sp & 255u) == 0u) { if (xb_ld(&(bar)[XB_TMO])) break; if (_sp > XB_SPIN_CAP) { atomicAdd(&(bar)[XB_TMO], 1u); break; } } } } while (0)
struct XcdBarrier { unsigned* bar; unsigned x; volatile LAS unsigned* st; };
__device__ __forceinline__ XcdBarrier xcd_barrier_post(unsigned* bar, volatile LAS unsigned* st) {
    XcdBarrier b; b.bar = bar; b.x = xb_xcc_id(); b.st = st;
    if (threadIdx.x == 0) (void)xb_add(&bar[XB_XCNT(b.x)], 1u);
    return b;
}
__device__ __forceinline__ void xcd_barrier_complete(unsigned* bar, unsigned x, unsigned& nloc, unsigned& nx) {
    const unsigned G = gridDim.x * gridDim.y * gridDim.z;
    unsigned sum, cnt, mine, sp = 0u;
    for (;;) {
        sum = 0u; cnt = 0u; mine = 0u;
#pragma unroll
        for (unsigned j = 0; j < 16; ++j) { const unsigned c = xb_ld(&bar[XB_XCNT(j)]); sum += c; cnt += (c > 0u) ? 1u : 0u; mine = (j == x) ? c : mine; }
        if (sum == G) break;
        __builtin_amdgcn_s_sleep(1);
        if ((++sp & 255u) == 0u) { if (xb_ld(&bar[XB_TMO])) break; if (sp > XB_SPIN_CAP) { atomicAdd(&bar[XB_TMO], 1u); break; } }
    }
    nloc = mine > 0u ? mine : 1u; nx = cnt > 0u ? cnt : 1u;
}
__device__ __forceinline__ void xcd_barrier(const XcdBarrier& b) {
    asm volatile("s_waitcnt vmcnt(0)" ::: "memory");
    __syncthreads();
    if (threadIdx.x == 0) {
        unsigned* bar = b.bar;
        __builtin_amdgcn_s_waitcnt(0);
        unsigned nloc = b.st[0], nx = b.st[1];
        if (nloc == 0u) { xcd_barrier_complete(bar, b.x, nloc, nx); b.st[0] = nloc; b.st[1] = nx; }
        const unsigned old = xb_add(&bar[XB_XSUB(b.x)], 1u);
        const unsigned gen = old / nloc;
        if (old + 1u == (gen + 1u) * nloc) {
            __builtin_amdgcn_fence(__ATOMIC_RELEASE, "agent");
            asm volatile("s_waitcnt vmcnt(0)" ::: "memory");
            const unsigned og = xb_add(&bar[XB_TOP], 1u);
            const unsigned tg = og / nx;
            if (og + 1u == (tg + 1u) * nx) xb_add(&bar[XB_TOPGEN], 1u);
            else XB_SPIN(xb_ld(&bar[XB_TOPGEN]) == tg, bar);
            __builtin_amdgcn_fence(__ATOMIC_ACQUIRE, "agent");
            xb_add(&bar[XB_XGEN(b.x)], 1u);
            asm volatile("s_waitcnt vmcnt(0)" ::: "memory");
        } else {
            XB_SPIN(xb_ld(&bar[XB_XGEN(b.x)]) == gen, bar);
            __builtin_amdgcn_fence(__ATOMIC_ACQUIRE, "agent");
            asm volatile("s_waitcnt vmcnt(0)" ::: "memory");
        }
    }
    __syncthreads();
}

namespace pg8 {
constexpr int BM = 256, BK = 64, HALF = 128, HTB = HALF * BK * 2, STAGE_BYTES = 8 * HTB, NXCD = 8, WGM = 8;
__host__ __device__ __forceinline__ int lds_byte(int r, int c) { const int st = (r >> 4) * 2 + (c >> 5), rr = r & 15, cc = c & 31, ob = rr * 64 + cc * 2; return st * 1024 + (ob ^ (((ob >> 9) & 1) << 5)); }
__host__ __device__ __forceinline__ void stage_rc(int b, int& R, int& C) { const int st = b / 1024, sb = b % 1024, swz = sb ^ (((sb >> 9) & 1) << 5); R = (st >> 1) * 16 + swz / 64; C = (st & 1) * 32 + (swz % 64) / 2; }
__host__ __device__ __forceinline__ int perm32(int rho) { const int n = rho >> 4, i = rho & 15; return 8 * (i >> 2) + 4 * n + (i & 3); }
struct Unit { int pm, pn; };
struct Gemm { const bf16_t* A; const bf16_t* Bt; int lda, ldb, K; };
struct AddrAffine { size_t tA, tB;
    __device__ __forceinline__ const char* A(const char* b, const Unit& u) const { return b + (size_t)u.pm * tA; }
    __device__ __forceinline__ const char* B(const char* b, const Unit& u) const { return b + (size_t)u.pn * tB; }
    __device__ __forceinline__ size_t ka(int t) const { return (size_t)t * (BK * 2); } };
struct AddrCmp { int ntile;
    __device__ __forceinline__ const char* A(const char* b, const Unit& u) const { return b + (size_t)(u.pm >> 3) * (8 * MiB) + (size_t)((u.pm >> 1) & 3) * (2 * MiB) + (size_t)(u.pm & 1) * (256 * 4096) + ka(u.pn * ntile); }
    __device__ __forceinline__ const char* B(const char* b, const Unit& u) const { return b + (size_t)(u.pm >> 3) * (2 * MiB) + (size_t)u.pn * ntile * (BK * 2); }
    __device__ __forceinline__ size_t ka(int t) const { return (size_t)t * (BK * 2); } };
struct StaticOrder {
    int nM, nN, nwg, G, c;
    __host__ __device__ void init(int M, int N, int G_, int c_) { nM = M / BM; nN = N / BM; nwg = nM * nN; G = G_; c = c_; }
    __host__ __device__ bool next(int i, Unit& u) const {
        const long L = (long)i * G + c; if (L >= nwg) return false;
        int wgid = (int)L; { const int q = nwg / NXCD, r = nwg % NXCD, xcd = wgid % NXCD, off = wgid / NXCD; wgid = (xcd < r ? xcd * (q + 1) : r * (q + 1) + (xcd - r) * q) + off; }
        const int nig = WGM * nN, gid = wgid / nig, fm = gid * WGM, gsz = (nM - fm) < WGM ? (nM - fm) : WGM;
        u.pm = fm + ((wgid % nig) % gsz); u.pn = (wgid % nig) / gsz; return true;
    }
};
typedef int v8i_g __attribute__((ext_vector_type(8)));
typedef int v4i_g __attribute__((ext_vector_type(4)));
template <class Epi, bool ALIGN_EPI, class Addr, bool FP8 = false>
__device__ __forceinline__ void gemm_phase(LAS unsigned char* lds, const Gemm g, const StaticOrder& S, const Epi& E, const Addr& AD) {
    const int tid = otid(), wid = __builtin_amdgcn_readfirstlane(tid >> 6), lane = tid & 63, wr = wid >> 2, wc = wid & 3, fr = lane & 15, fq = lane >> 4;
    const int K = g.K, nt = K / BK;
    unsigned voffA[2], voffB[2];
#pragma unroll
    for (int i = 0; i < 2; ++i) { int R, C; stage_rc(tid * 16 + i * 8192, R, C); const int Rb = (R & ~31) + perm32(R & 31);
        voffA[i] = (unsigned)(R * g.lda + C) * 2u; voffB[i] = (unsigned)(Rb * g.ldb + C) * 2u; }
    const size_t kstep = (size_t)(BK * 2);
    const size_t hA = (size_t)HALF * g.lda * 2, hB = (size_t)HALF * g.ldb * 2;
    const unsigned ldsw = (unsigned)wid * 1024u;
    const int aoff = lds_byte(wr * 64 + fr, fq * 8), boff = lds_byte(wc * 32 + fr, fq * 8);
#define PG8_SA(b, h) (((b) * 2 + (h)) * HTB)
#define PG8_SB(b, h) ((4 + (b) * 2 + (h)) * HTB)
#define PG8_STAGE(bufoff, gbase, voff) do { _Pragma("unroll") for (int _i = 0; _i < 2; ++_i) \
        __builtin_amdgcn_global_load_lds((const unsigned*)((const char*)(gbase) + (voff)[_i]), (LAS unsigned*)(lds + (bufoff) + ldsw + _i * 8192), 16, 0, 0); } while (0)
#define PG8_LDA(dst, b, h) do { _Pragma("unroll") for (int m = 0; m < 4; ++m) _Pragma("unroll") for (int k = 0; k < 2; ++k) dst[m][k] = *(const LAS bf16x8*)(lds + PG8_SA(b, h) + aoff + m * 2048 + k * 1024); } while (0)
#define PG8_LDB(dst, b, h) do { _Pragma("unroll") for (int n = 0; n < 2; ++n) _Pragma("unroll") for (int k = 0; k < 2; ++k) dst[n][k] = *(const LAS bf16x8*)(lds + PG8_SB(b, h) + boff + n * 2048 + k * 1024); } while (0)
#define PG8_LD8(p_) __builtin_shufflevector(*(const LAS v4i_g*)(p_), *(const LAS v4i_g*)((p_) + 1024), 0, 1, 2, 3, 4, 5, 6, 7)
#define PG8_LDA8(dst, b, h) do { _Pragma("unroll") for (int m = 0; m < 4; ++m) dst[m] = PG8_LD8(lds + PG8_SA(b, h) + aoff + m * 2048); } while (0)
#define PG8_LDB8(dst, b, h) do { _Pragma("unroll") for (int n = 0; n < 2; ++n) dst[n] = PG8_LD8(lds + PG8_SB(b, h) + boff + n * 2048); } while (0)
#define PG8_MMA16(ai, bj, At, Bt) do { __builtin_amdgcn_s_setprio(1); _Pragma("unroll") for (int m = 0; m < 4; ++m) _Pragma("unroll") for (int n = 0; n < 2; ++n) _Pragma("unroll") for (int k = 0; k < 2; ++k) \
        acc[ai][bj][m][n] = __builtin_amdgcn_mfma_f32_16x16x32_bf16(Bt[n][k], At[m][k], acc[ai][bj][m][n], 0, 0, 0); __builtin_amdgcn_s_setprio(0); } while (0)
#define PG8_MMA8(ai, bj, At, Bt) do { __builtin_amdgcn_s_setprio(1); _Pragma("unroll") for (int m = 0; m < 4; ++m) _Pragma("unroll") for (int n = 0; n < 2; ++n) \
        asm volatile("v_mfma_scale_f32_16x16x128_f8f6f4 %0, %1, %2, %0, %3, %3 op_sel_hi:[0,0,0]" : "+v"(acc[ai][bj][m][n]) : "v"(Bt[n]), "v"(At[m]), "v"(sc8_)); __builtin_amdgcn_s_setprio(0); } while (0)
#define PG8_WAIT_V(n) asm volatile("s_waitcnt vmcnt(" #n ")" ::: "memory")
#define PG8_WAIT_L(n) asm volatile("s_waitcnt lgkmcnt(" #n ")" ::: "memory")
#define PG8_BAR __builtin_amdgcn_s_barrier()
#define PG8_SCHED __builtin_amdgcn_sched_barrier(0)
#define PG8_KBODY(LDA_, LDB_, MMA_, At, B0, B1) do { \
            LDB_(B0, 0, 0); LDB_(B1, 0, 1); PG8_SCHED; LDA_(At, 0, 0); PG8_STAGE(PG8_SA(1, 1), a1 + hA, voffA); \
            PG8_WAIT_V(8); PG8_WAIT_L(0); PG8_BAR; MMA_(0, 0, At, B0); MMA_(0, 1, At, B1); PG8_BAR; PG8_SCHED; \
            LDA_(At, 0, 1); PG8_STAGE(PG8_SB(0, 0), b2, voffB); PG8_STAGE(PG8_SB(0, 1), b2 + hB, voffB); PG8_STAGE(PG8_SA(0, 0), a2, voffA); \
            PG8_WAIT_V(8); PG8_WAIT_L(0); PG8_BAR; MMA_(1, 0, At, B0); MMA_(1, 1, At, B1); PG8_BAR; PG8_SCHED; \
            LDB_(B0, 1, 0); LDB_(B1, 1, 1); PG8_SCHED; LDA_(At, 1, 0); PG8_STAGE(PG8_SA(0, 1), a2 + hA, voffA); \
            PG8_WAIT_V(8); PG8_WAIT_L(0); PG8_BAR; MMA_(0, 0, At, B0); MMA_(0, 1, At, B1); PG8_BAR; PG8_SCHED; \
            LDA_(At, 1, 1); PG8_STAGE(PG8_SB(1, 0), b3, voffB); PG8_STAGE(PG8_SB(1, 1), b3 + hB, voffB); PG8_STAGE(PG8_SA(1, 0), a3, voffA); \
            PG8_WAIT_V(8); PG8_WAIT_L(0); PG8_BAR; MMA_(1, 0, At, B0); MMA_(1, 1, At, B1); PG8_BAR; PG8_SCHED; } while (0)
    Unit cur, nxt; int ui = 0;
    if (!S.next(0, cur)) return;
    f32x4 acc[2][2][4][2];
#pragma unroll
    for (int a = 0; a < 2; ++a)
#pragma unroll
        for (int b = 0; b < 2; ++b)
#pragma unroll
            for (int m = 0; m < 4; ++m)
#pragma unroll
                for (int n = 0; n < 2; ++n) acc[a][b][m][n] = (f32x4){0.f, 0.f, 0.f, 0.f};
    bf16x8 At16[4][2], B016[2][2], B116[2][2]; v8i_g At8[4], B08[2], B18[2]; const int sc8_ = 0x7F7F7F7F;
    const char* cA = AD.A((const char*)g.A, cur); const char* cB = AD.B((const char*)g.Bt, cur);
    PG8_STAGE(PG8_SB(0, 0), cB, voffB); PG8_STAGE(PG8_SB(0, 1), cB + hB, voffB); PG8_STAGE(PG8_SA(0, 0), cA, voffA); PG8_STAGE(PG8_SA(0, 1), cA + hA, voffA);
    if (wr == 1) PG8_BAR;
    PG8_WAIT_V(2); PG8_BAR;
    PG8_STAGE(PG8_SB(1, 0), cB + kstep, voffB); PG8_STAGE(PG8_SA(1, 0), cA + kstep, voffA); PG8_STAGE(PG8_SB(1, 1), cB + hB + kstep, voffB);
    PG8_WAIT_V(6); PG8_BAR;
    for (;;) {
        const bool has_next = S.next(ui + 1, nxt);
        const char* nA = has_next ? AD.A((const char*)g.A, nxt) : cA; const char* nB = has_next ? AD.B((const char*)g.Bt, nxt) : cB;
        for (int t = 0; t < nt; t += 2) {
            const bool last = (t == nt - 2);
            const char* a1 = cA + AD.ka(t) + kstep;
            const char* a2 = last ? nA : cA + AD.ka(t + 2); const char* b2 = last ? nB : cB + (size_t)(t + 2) * kstep;
            const char* a3 = a2 + kstep; const char* b3 = b2 + kstep;
            if constexpr (FP8) PG8_KBODY(PG8_LDA8, PG8_LDB8, PG8_MMA8, At8, B08, B18); else PG8_KBODY(PG8_LDA, PG8_LDB, PG8_MMA16, At16, B016, B116);
        }
        if constexpr (ALIGN_EPI) { if (wr == 0) PG8_BAR; }
        if constexpr (FP8) asm volatile("s_nop 15\n\ts_nop 7" ::: "memory");
        E(acc, cur, wr, wc, fr, fq);
        if (!has_next) break;
#pragma unroll
        for (int a = 0; a < 2; ++a)
#pragma unroll
            for (int b = 0; b < 2; ++b)
#pragma unroll
                for (int m = 0; m < 4; ++m)
#pragma unroll
                    for (int n = 0; n < 2; ++n) acc[a][b][m][n] = (f32x4){0.f, 0.f, 0.f, 0.f};
        cur = nxt; cA = nA; cB = nB; ++ui;
        if constexpr (ALIGN_EPI) { if (wr == 1) PG8_BAR; }
    }
    PG8_WAIT_V(0);
    if constexpr (!ALIGN_EPI) { if (wr == 0) PG8_BAR; }
    PG8_BAR;
#undef PG8_SA
#undef PG8_SB
#undef PG8_STAGE
#undef PG8_LDA
#undef PG8_LDB
#undef PG8_MMA16
#undef PG8_MMA8
#undef PG8_KBODY
#undef PG8_LD8
#undef PG8_LDA8
#undef PG8_LDB8
#undef PG8_WAIT_V
#undef PG8_WAIT_L
#undef PG8_BAR
#undef PG8_SCHED
}
template <class Epi>
__device__ __forceinline__ void gemm_phase2(LAS unsigned char* lds, const Gemm g0, const Gemm g1, const StaticOrder& S, const Epi& E) {
    int tid = otid(); const int wid = __builtin_amdgcn_readfirstlane(tid >> 6), lane = tid & 63, wr = wid >> 2, wc = wid & 3, fr = lane & 15, fq = lane >> 4;
#define PG8_MKOFF(vA, vB, G) do { _Pragma("unroll") for (int i_ = 0; i_ < 2; ++i_) { int R_, C_; stage_rc(tid * 16 + i_ * 8192, R_, C_); const int Rb_ = (R_ & ~31) + perm32(R_ & 31); \
        (vA)[i_] = (unsigned)(R_ * (G).lda + C_) * 2u; (vB)[i_] = (unsigned)(Rb_ * (G).ldb + C_) * 2u; } } while (0)
    const size_t kstep = (size_t)(BK * 2);
    const size_t hA0 = (size_t)HALF * g0.lda * 2, hB0 = (size_t)HALF * g0.ldb * 2, hA1 = hA0, hB1 = hB0;
    unsigned ldsw = (unsigned)wid * 1024u;
    int aoff = lds_byte(wr * 64 + fr, fq * 8), boff = lds_byte(wc * 32 + fr, fq * 8);
#define PG8_SA(b, h) (((b) * 2 + (h)) * HTB)
#define PG8_SB(b, h) ((4 + (b) * 2 + (h)) * HTB)
#define PG8_STAGE(bufoff, gbase, voff) do { _Pragma("unroll") for (int _i = 0; _i < 2; ++_i) \
        __builtin_amdgcn_global_load_lds((const unsigned*)((const char*)(gbase) + (voff)[_i]), (LAS unsigned*)(lds + (bufoff) + ldsw + _i * 8192), 16, 0, 0); } while (0)
#define PG8_LDA(dst, b, h) do { _Pragma("unroll") for (int m = 0; m < 4; ++m) _Pragma("unroll") for (int k = 0; k < 2; ++k) dst[m][k] = *(const LAS bf16x8*)(lds + PG8_SA(b, h) + aoff + m * 2048 + k * 1024); } while (0)
#define PG8_LDB(dst, b, h) do { _Pragma("unroll") for (int n = 0; n < 2; ++n) _Pragma("unroll") for (int k = 0; k < 2; ++k) dst[n][k] = *(const LAS bf16x8*)(lds + PG8_SB(b, h) + boff + n * 2048 + k * 1024); } while (0)
#define PG8_LD8(p_) __builtin_shufflevector(*(const LAS v4i_g*)(p_), *(const LAS v4i_g*)((p_) + 1024), 0, 1, 2, 3, 4, 5, 6, 7)
#define PG8_LDA8(dst, b, h) do { _Pragma("unroll") for (int m = 0; m < 4; ++m) dst[m] = PG8_LD8(lds + PG8_SA(b, h) + aoff + m * 2048); } while (0)
#define PG8_LDB8(dst, b, h) do { _Pragma("unroll") for (int n = 0; n < 2; ++n) dst[n] = PG8_LD8(lds + PG8_SB(b, h) + boff + n * 2048); } while (0)
#define PG8_MMA16(ai, bj, At, Bt) do { __builtin_amdgcn_s_setprio(1); _Pragma("unroll") for (int m = 0; m < 4; ++m) _Pragma("unroll") for (int n = 0; n < 2; ++n) _Pragma("unroll") for (int k = 0; k < 2; ++k) \
        acc[ai][bj][m][n] = __builtin_amdgcn_mfma_f32_16x16x32_bf16(Bt[n][k], At[m][k], acc[ai][bj][m][n], 0, 0, 0); __builtin_amdgcn_s_setprio(0); } while (0)
#define PG8_MMA8(ai, bj, At, Bt) do { __builtin_amdgcn_s_setprio(1); _Pragma("unroll") for (int m = 0; m < 4; ++m) _Pragma("unroll") for (int n = 0; n < 2; ++n) \
        asm volatile("v_mfma_scale_f32_16x16x128_f8f6f4 %0, %1, %2, %0, %3, %3 op_sel_hi:[0,0,0]" : "+v"(acc[ai][bj][m][n]) : "v"(Bt[n]), "v"(At[m]), "v"(sc8_)); __builtin_amdgcn_s_setprio(0); } while (0)
#define PG8_WAIT_V(n) asm volatile("s_waitcnt vmcnt(" #n ")" ::: "memory")
#define PG8_WAIT_L(n) asm volatile("s_waitcnt lgkmcnt(" #n ")" ::: "memory")
#define PG8_BAR __builtin_amdgcn_s_barrier()
#define PG8_SCHED __builtin_amdgcn_sched_barrier(0)
    Unit cur;
    if (!S.next(0, cur)) return;
    f32x4 acc[2][2][4][2];
#define PG8_ZERO() do { _Pragma("unroll") for (int a = 0; a < 2; ++a) _Pragma("unroll") for (int b = 0; b < 2; ++b) _Pragma("unroll") for (int m = 0; m < 4; ++m) _Pragma("unroll") for (int n = 0; n < 2; ++n) acc[a][b][m][n] = (f32x4){0.f, 0.f, 0.f, 0.f}; } while (0)
    PG8_ZERO();
    bf16x8 At[4][2], B0[2][2], B1[2][2];
    const char* cA = (const char*)g0.A + (size_t)cur.pm * (2 * hA0); const char* cB = (const char*)g0.Bt + (size_t)cur.pn * (2 * hB0);
    unsigned voffA[2], voffB[2]; PG8_MKOFF(voffA, voffB, g0); const size_t hA = hA0, hB = hB0;
    PG8_STAGE(PG8_SB(0, 0), cB, voffB); PG8_STAGE(PG8_SB(0, 1), cB + hB, voffB); PG8_STAGE(PG8_SA(0, 0), cA, voffA); PG8_STAGE(PG8_SA(0, 1), cA + hA, voffA);
    if (wr == 1) PG8_BAR;
    PG8_WAIT_V(2); PG8_BAR;
    PG8_STAGE(PG8_SB(1, 0), cB + kstep, voffB); PG8_STAGE(PG8_SA(1, 0), cA + kstep, voffA); PG8_STAGE(PG8_SB(1, 1), cB + hB + kstep, voffB);
    PG8_WAIT_V(6); PG8_BAR;
#define PG8_KLOOP(MMA, LDA_, LDB_, At, B0, B1, NT, HASNEXT) do { const int nt = (NT);                                                                            \
        const char* nA = (HASNEXT) ? (const char*)g1.A + (size_t)cur.pm * (2 * hA1) : cA; const char* nB = (HASNEXT) ? (const char*)g1.Bt + (size_t)cur.pn * (2 * hB1) : cB; \
        for (int t = 0; t < nt; t += 2) {                                                                                              \
            const bool last = (t == nt - 2);                                                                                           \
            const char* a1 = cA + (size_t)(t + 1) * kstep;                                                                             \
            const char* a2 = last ? nA : cA + (size_t)(t + 2) * kstep; const char* b2 = last ? nB : cB + (size_t)(t + 2) * kstep;       \
            const char* a3 = a2 + kstep; const char* b3 = b2 + kstep;                                                                  \
            LDB_(B0, 0, 0); LDB_(B1, 0, 1); PG8_SCHED; LDA_(At, 0, 0); PG8_STAGE(PG8_SA(1, 1), a1 + hA, voffA);                \
            PG8_WAIT_V(8); PG8_WAIT_L(0); PG8_BAR; MMA(0, 0, At, B0); MMA(0, 1, At, B1); PG8_BAR; PG8_SCHED;                            \
            LDA_(At, 0, 1); PG8_STAGE(PG8_SB(0, 0), b2, voffB); PG8_STAGE(PG8_SB(0, 1), b2 + hB, voffB); PG8_STAGE(PG8_SA(0, 0), a2, voffA); \
            PG8_WAIT_V(8); PG8_WAIT_L(0); PG8_BAR; MMA(1, 0, At, B0); MMA(1, 1, At, B1); PG8_BAR; PG8_SCHED;                            \
            LDB_(B0, 1, 0); LDB_(B1, 1, 1); PG8_SCHED; LDA_(At, 1, 0); PG8_STAGE(PG8_SA(0, 1), a2 + hA, voffA);              \
            PG8_WAIT_V(8); PG8_WAIT_L(0); PG8_BAR; MMA(0, 0, At, B0); MMA(0, 1, At, B1); PG8_BAR; PG8_SCHED;                            \
            LDA_(At, 1, 1); PG8_STAGE(PG8_SB(1, 0), b3, voffB); PG8_STAGE(PG8_SB(1, 1), b3 + hB, voffB); PG8_STAGE(PG8_SA(1, 0), a3, voffA); \
            PG8_WAIT_V(8); PG8_WAIT_L(0); PG8_BAR; MMA(1, 0, At, B0); MMA(1, 1, At, B1); PG8_BAR; PG8_SCHED;                            \
        }                                                                                                                              \
        if (HASNEXT) { cA = nA; cB = nB; } } while (0)
    PG8_KLOOP(PG8_MMA16, PG8_LDA, PG8_LDB, At, B0, B1, g0.K / BK, true);
    if (wr == 0) PG8_BAR;
    E(acc, cur, 0, wr, wc, fr, fq);
    PG8_ZERO();
    { tid = otid(); const int l2 = tid & 63, w2 = __builtin_amdgcn_readfirstlane(tid >> 6);
      ldsw = (unsigned)w2 * 1024u; aoff = lds_byte((w2 >> 2) * 64 + (l2 & 15), (l2 >> 4) * 8); boff = lds_byte((w2 & 3) * 32 + (l2 & 15), (l2 >> 4) * 8); PG8_MKOFF(voffA, voffB, g1); }
    if (wr == 1) PG8_BAR;
    { v8i_g At8[4], B08[2], B18[2]; const int sc8_ = 0x7F7F7F7F;
      PG8_KLOOP(PG8_MMA8, PG8_LDA8, PG8_LDB8, At8, B08, B18, g1.K / BK, false); }
    asm volatile("s_nop 15\n\ts_nop 7" ::: "memory");
    if (wr == 0) PG8_BAR;
    E(acc, cur, 1, wr, wc, fr, fq);
    PG8_WAIT_V(0);
    PG8_BAR;
#undef PG8_KLOOP
#undef PG8_ZERO
#undef PG8_MMA16
#undef PG8_MMA8
#undef PG8_SA
#undef PG8_SB
#undef PG8_STAGE
#undef PG8_LDA
#undef PG8_LDB
#undef PG8_WAIT_V
#undef PG8_WAIT_L
#undef PG8_BAR
#undef PG8_SCHED
#undef PG8_MKOFF
#undef PG8_LD8
#undef PG8_LDA8
#undef PG8_LDB8
}
}

typedef f32x4 Acc[2][2][4][2];
__device__ __forceinline__ u32x4 pack8(f32x4 a, f32x4 b) { u32x4 w; w.x = cvtpk(a[0], a[1]); w.y = cvtpk(a[2], a[3]); w.z = cvtpk(b[0], b[1]); w.w = cvtpk(b[2], b[3]); return w; }
__device__ __forceinline__ void unpack8(u32x4 w, f32x4& a, f32x4& b) { a = (f32x4){bflo(w.x), bfhi(w.x), bflo(w.y), bfhi(w.y)}; b = (f32x4){bflo(w.z), bfhi(w.z), bflo(w.w), bfhi(w.w)}; }

struct EpiInProj {
    unsigned char* ws; bf16_t* gm; const float* bmerge; int pn_off;
    __device__ __forceinline__ void operator()(const Acc& acc, const pg8::Unit& u, int wr, int wc, int fr, int fq) const {
        const int pn = u.pn + pn_off;
        bf16_t* dst; int ldc, cb, mode; size_t bjs = 128; unsigned char* dst8 = nullptr; float ascale = 1.0f;
        if (pn < 4)       { dst = (bf16_t*)(ws + WS_U);   ldc = 1024; cb = pn * 256;        mode = 0; }
        else if (pn < 8)  { dst = (bf16_t*)(ws + WS_GP);  ldc = 1024; cb = (pn - 4) * 256;  mode = 1; }
        else if (pn < 12) { const int k = (pn - 8) >> 1; dst = (bf16_t*)(ws + WS_KCR + (size_t)k * (8 * MiB)); mode = 0;
                            ldc = 128; cb = 0; bjs = (size_t)S * 128; dst += (size_t)((pn - 8) & 1) * 2 * S * 128; }
        else if (pn < 20) { dst = (bf16_t*)(ws + WS_GN);  ldc = 2048; cb = (pn - 12) * 256; mode = 1; }
        else if (pn < 36) { dst = gm;                     ldc = 4096; cb = (pn - 20) * 256; mode = 2; }
        else if (pn < 37) { dst = (bf16_t*)(ws + WS_GBR); ldc = 256;  cb = 0;               mode = 4; }
        else if (pn < 45) { dst = (bf16_t*)(ws + WS_Q);   ldc = 2048; cb = (pn - 37) * 256; mode = 3; dst8 = ws + WS_Q8; ascale = 1.0f / W8_SCALE; }
        else              { const int k = (pn - 45) >> 1;
                            dst = nullptr; dst8 = ws + (k == 0 ? WS_K8S : k == 1 ? WS_V8S : k == 2 ? WS_K8W : WS_V8W); ldc = 512; cb = ((pn - 45) & 1) * 256; mode = (k == 0 || k == 2) ? 3 : 0; ascale = 1.0f / W8_SCALE; }
        const int row0 = u.pm * 256 + wr * 64 + fr, cl = wc * 32 + 8 * fq, col0 = cb + cl;
        const float* rcos = (const float*)(ws + WS_ROPE); const float* rsin = rcos + (size_t)S * 64;
#pragma unroll
        for (int ai = 0; ai < 2; ++ai)
#pragma unroll
            for (int m = 0; m < 4; ++m) {
                const int row = row0 + ai * 128 + m * 16;
                bf16_t* rowp = dst + (size_t)row * ldc + col0;
                f32x4 cs0, cs1, sn0, sn1;
                if (mode == 3) { const int i0 = (cl & 127) >> 1; cs0 = *(const f32x4*)(rcos + (size_t)row * 64 + i0); sn0 = *(const f32x4*)(rsin + (size_t)row * 64 + i0); }
#pragma unroll
                for (int bj = 0; bj < 2; ++bj) {
                    f32x4 v0 = acc[ai][bj][m][0] * ascale, v1 = acc[ai][bj][m][1] * ascale;
                    if (mode == 1) { for (int e = 0; e < 4; ++e) { v0[e] = siluf_(v0[e]); v1[e] = siluf_(v1[e]); } }
                    else if (mode == 2 || mode == 4) { if (mode == 2) { v0 = v0 + *(const f32x4*)(bmerge + col0 + bj * 128); v1 = v1 + *(const f32x4*)(bmerge + col0 + bj * 128 + 4); } for (int e = 0; e < 4; ++e) { v0[e] = sigmoidf_(v0[e]); v1[e] = sigmoidf_(v1[e]); } }
                    else if (mode == 3) {
                        f32x4 o0, o1;
                        o0[0] = v0[0] * cs0[0] - v0[1] * sn0[0]; o0[1] = v0[1] * cs0[0] + v0[0] * sn0[0];
                        o0[2] = v0[2] * cs0[1] - v0[3] * sn0[1]; o0[3] = v0[3] * cs0[1] + v0[2] * sn0[1];
                        o1[0] = v1[0] * cs0[2] - v1[1] * sn0[2]; o1[1] = v1[1] * cs0[2] + v1[0] * sn0[2];
                        o1[2] = v1[2] * cs0[3] - v1[3] * sn0[3]; o1[3] = v1[3] * cs0[3] + v1[2] * sn0[3];
                        v0 = o0; v1 = o1;
                    }
                    if (dst) *(u32x4*)(rowp + bj * bjs) = pack8(v0, v1);
                    if (dst8) { u32x2 w8; w8.x = cvt4_fp8(sat8(v0[0]), sat8(v0[1]), sat8(v0[2]), sat8(v0[3])); w8.y = cvt4_fp8(sat8(v1[0]), sat8(v1[1]), sat8(v1[2]), sat8(v1[3])); *(u32x2*)(dst8 + (size_t)row * ldc + col0 + bj * 128) = w8; }
                }
            }
    }
};
struct EpiYa {
    bf16_t* yag; const bf16_t* gm;
    __device__ __forceinline__ void operator()(const Acc& acc, const pg8::Unit& u, int wr, int wc, int fr, int fq) const {
        const int row0 = u.pm * 256 + wr * 64 + fr, col0 = u.pn * 256 + wc * 32 + 8 * fq;
#pragma unroll
        for (int ai = 0; ai < 2; ++ai)
#pragma unroll
            for (int m = 0; m < 4; ++m) { int ro_ = ai * 128 + m * 16; asm volatile("" : "+v"(ro_)); const size_t r = (size_t)(row0 + ro_);
#pragma unroll
                for (int bj = 0; bj < 2; ++bj) { f32x4 g0, g1; unpack8(*(const u32x4*)(gm + r * 4096 + col0 + bj * 128), g0, g1);
                    *(u32x4*)(yag + r * 2048 + col0 + bj * 128) = pack8(acc[ai][bj][m][0] * g0, acc[ai][bj][m][1] * g1); }
                if (m & 1) asm volatile("" ::: "memory"); }
    }
};
struct EpiYb {
    bf16_t* merged; const bf16_t* yag; const bf16_t* gm; float ascale;
    __device__ __forceinline__ void operator()(const Acc& acc, const pg8::Unit& u, int wr, int wc, int fr, int fq) const {
        const int row0 = u.pm * 256 + wr * 64 + fr, col0 = u.pn * 256 + wc * 32 + 8 * fq;
#pragma unroll
        for (int ai = 0; ai < 2; ++ai)
#pragma unroll
            for (int m = 0; m < 4; ++m) { int ro_ = ai * 128 + m * 16; asm volatile("" : "+v"(ro_)); const size_t r = (size_t)(row0 + ro_);
#pragma unroll
                for (int bj = 0; bj < 2; ++bj) { f32x4 g0, g1, y0, y1; unpack8(*(const u32x4*)(gm + r * 4096 + 2048 + col0 + bj * 128), g0, g1);
                    unpack8(*(const u32x4*)(yag + r * 2048 + col0 + bj * 128), y0, y1);
                    *(u32x4*)(merged + r * 2048 + col0 + bj * 128) = pack8(y0 + acc[ai][bj][m][0] * ascale * g0, y1 + acc[ai][bj][m][1] * ascale * g1); }
                if (m & 1) asm volatile("" ::: "memory"); }
    }
};
struct EpiYaYb {
    EpiYa ya; EpiYb yb;
    __device__ __forceinline__ void operator()(const Acc& acc, const pg8::Unit& u, int kind, int wr, int wc, int fr, int fq) const {
        if (kind == 0) { ya(acc, u, wr, wc, fr, fq); asm volatile("s_waitcnt vmcnt(0)" ::: "memory"); } else yb(acc, u, wr, wc, fr, fq);
    }
};
constexpr int NSPLIT = 8;
struct EpiSlab {
    float* slab;
    __device__ __forceinline__ void operator()(const Acc& acc, const pg8::Unit& u, int wr, int wc, int fr, int fq) const {
        float* base = slab + ((size_t)((u.pm >> 3) * NSPLIT + u.pn) * 2048 + (size_t)(u.pm & 7) * 256 + wr * 64 + fr) * 256 + wc * 32 + 8 * fq;
#pragma unroll
        for (int ai = 0; ai < 2; ++ai)
#pragma unroll
            for (int m = 0; m < 4; ++m)
#pragma unroll
                for (int bj = 0; bj < 2; ++bj) { float* p = base + (size_t)(ai * 128 + m * 16) * 256 + bj * 128; *(f32x4*)p = acc[ai][bj][m][0]; *(f32x4*)(p + 4) = acc[ai][bj][m][1]; }
    }
};
constexpr int CW_PANEL = 16384;
constexpr int EPI_LDS_OFF = RING_BYTES + 1024;
struct EpiOut {
    float* out; const float* x; float* ssq; const float* fw; unsigned* ctl; LAS unsigned char* lds;
    __device__ __forceinline__ void operator()(const Acc& acc_, const pg8::Unit& u, int wr, int wc, int fr, int fq) const {
        Acc& acc = const_cast<Acc&>(acc_);
        const int tid = otid();
        const int row0 = u.pm * 256 + wr * 64 + fr, col0 = u.pn * 256 + wc * 32 + 8 * fq;
        LAS float* rs = (LAS float*)(lds + EPI_LDS_OFF);
#pragma unroll
        for (int ai = 0; ai < 2; ++ai)
#pragma unroll
            for (int m = 0; m < 4; ++m) { const size_t r = (size_t)(row0 + ai * 128 + m * 16); float q = 0.f;
#pragma unroll
                for (int bj = 0; bj < 2; ++bj)
#pragma unroll
                    for (int n = 0; n < 2; ++n) { const size_t o = r * 2048 + col0 + bj * 128 + 4 * n; const f32x4 v = *(const f32x4*)(x + o) + acc[ai][bj][m][n];
                        acc[ai][bj][m][n] = v; q += (v[0] * v[0] + v[1] * v[1]) + (v[2] * v[2] + v[3] * v[3]); }
                q += __shfl_xor(q, 16); q += __shfl_xor(q, 32);
                if (fq == 0) __hip_atomic_store((unsigned*)(ssq + (size_t)(u.pn * 4 + wc) * S + r), __float_as_uint(q), __ATOMIC_RELAXED, __HIP_MEMORY_SCOPE_AGENT); }
        asm volatile("s_waitcnt vmcnt(0)" ::: "memory");
        __syncthreads();
        if (tid == 0) { unsigned* c = ctl + CW_PANEL + 64 * u.pm;
            __hip_atomic_fetch_add(c, 1u, __ATOMIC_RELAXED, __HIP_MEMORY_SCOPE_AGENT);
            unsigned sp = 0; while (__hip_atomic_load(c, __ATOMIC_RELAXED, __HIP_MEMORY_SCOPE_AGENT) < 8u) { __builtin_amdgcn_s_sleep(2); if (++sp > (1u << 22)) break; }
            __builtin_amdgcn_fence(__ATOMIC_ACQUIRE, "agent"); asm volatile("s_waitcnt vmcnt(0)" ::: "memory"); }
        __syncthreads();
        if (tid < 256) { const size_t r = (size_t)u.pm * 256 + tid; float s = 0.f;
#pragma unroll 8
            for (int p = 0; p < 32; ++p) s += __uint_as_float(__hip_atomic_load((unsigned*)(ssq + (size_t)p * S + r), __ATOMIC_RELAXED, __HIP_MEMORY_SCOPE_AGENT));
            rs[tid] = 1.0f / sqrtf(s * (1.f / DM) + EPS); }
        __syncthreads();
#pragma unroll
        for (int ai = 0; ai < 2; ++ai)
#pragma unroll
            for (int m = 0; m < 4; ++m) { const int rl = wr * 64 + fr + ai * 128 + m * 16; const float sc = rs[rl]; const size_t r = (size_t)u.pm * 256 + rl;
#pragma unroll
                for (int bj = 0; bj < 2; ++bj)
#pragma unroll
                    for (int n = 0; n < 2; ++n) { const size_t o = r * 2048 + col0 + bj * 128 + 4 * n; *(f32x4*)(out + o) = acc[ai][bj][m][n] * sc * *(const f32x4*)(fw + col0 + bj * 128 + 4 * n); } }
    }
};

struct Args { const float* in[17]; float* out; unsigned char* ws; int ph_lo, ph_hi; };
struct Frame { LAS unsigned char* lds; int tid, lane, wave, vcu, G; };

__device__ __forceinline__ int ropeperm(int d) { return d < 64 ? 2 * d : 2 * (d - 64) + 1; }
__device__ __forceinline__ void transpose_item(const float* W, int ldw, int Nvalid, bf16_t* WT, int ldt, int row_off, bool perm, LAS float* scr, int kb, int nb, int lane, float f8scale = 0.f) {
    const int k0 = 64 * kb, n0 = 32 * nb, cq = lane & 7, rb = lane >> 3; const bool ok = n0 + cq * 4 < Nvalid;
    f32x4 v[8];
#pragma unroll
    for (int i = 0; i < 8; ++i) v[i] = ok ? *(const f32x4*)(W + (size_t)(k0 + i * 8 + rb) * ldw + n0 + cq * 4) : (f32x4){0.f, 0.f, 0.f, 0.f};
#pragma unroll
    for (int i = 0; i < 8; ++i) *(LAS f32x4*)(scr + (i * 8 + rb) * 32 + ((cq ^ i) << 2)) = v[i];
    LDS_WAIT(); asm volatile("" ::: "memory");
#pragma unroll
    for (int j = 0; j < 4; ++j) { const int idx = lane + 64 * j, n = idx >> 3, c = idx & 7; const LAS float* s = scr + (8 * c) * 32 + ((((n >> 2) ^ c) << 2) | (n & 3));
        u32x4 o; o.x = cvtpk(s[0 * 32], s[1 * 32]); o.y = cvtpk(s[2 * 32], s[3 * 32]); o.z = cvtpk(s[4 * 32], s[5 * 32]); o.w = cvtpk(s[6 * 32], s[7 * 32]);
        const int ng = n0 + n;
        if (ng < Nvalid) { const int dr = perm ? ((ng & ~127) | ropeperm(ng & 127)) : ng;
            if (f8scale > 0.f) { u32x2 o8; o8.x = cvt4_fp8(sat8(s[0 * 32] * f8scale), sat8(s[1 * 32] * f8scale), sat8(s[2 * 32] * f8scale), sat8(s[3 * 32] * f8scale)); o8.y = cvt4_fp8(sat8(s[4 * 32] * f8scale), sat8(s[5 * 32] * f8scale), sat8(s[6 * 32] * f8scale), sat8(s[7 * 32] * f8scale));
                *(GAS u32x2*)((unsigned char*)WT + (size_t)(row_off + dr) * ldt + k0 + 8 * c) = o8; }
            else *(GAS u32x4*)(WT + (size_t)(row_off + dr) * ldt + k0 + 8 * c) = o; } }
    LDS_WAIT(); asm volatile("" ::: "memory");
}

__device__ __forceinline__ void p0_prologue(const Frame& F, const Args& a) {
    unsigned char* ws = a.ws;
    LAS float* scr = (LAS float*)(F.lds + F.wave * 8192);
    const int gw = F.vcu * NWAVES + F.wave, NGW = F.G * NWAVES, lane = F.lane;
    constexpr int I_WIN = 32 * 258, I_WM = 32 * 128;
    for (int it = gw; it < I_WIN + I_WM; it += NGW) {
        int r = it;
        if (r < I_WIN) { const int kb = r / 258, nb = 32 + r % 258, n0 = nb * 32;
            const bool perm = (n0 >= 2048 && n0 < 4096) || (n0 >= 5120 && n0 < 5632) || (n0 >= 6144 && n0 < 6656);
            if (n0 >= 2048 && n0 < 4096) transpose_item(a.in[2], 9264, 9264, (bf16_t*)(ws + WS_W8), 2048, -2048, perm, scr, kb, nb, lane, W8_SCALE);
            else if (n0 >= 5120 && n0 < 7168) transpose_item(a.in[2], 9264, 9264, (bf16_t*)(ws + WS_W8), 2048, -3072, perm, scr, kb, nb, lane, W8_SCALE);
            else transpose_item(a.in[2], 9264, 9264, (bf16_t*)(ws + WS_WCAT), 2048, n0 < 2048 ? 0 : n0 < 5120 ? -2048 : (nb >= 288 ? 0 : -4096), perm, scr, kb, nb, lane);
            continue; } r -= I_WIN;
        transpose_item(a.in[13], 4096, 4096, (bf16_t*)(ws + WS_WCAT), 2048, 5120, false, scr, r / 128, r % 128, lane);
    }
    {
        const float* win = a.in[2]; const float* mix = a.in[3]; bf16_t* WC = (bf16_t*)(ws + WS_WCAT); const int r = lane & 31, hh = lane >> 5;
        for (int it = gw; it < 1024; it += NGW) {
            const int g = it >> 8, d0 = ((it >> 5) & 7) * 32, kin0 = (it & 31) * 64;
            f32x16 acc0 = f32x16{}, acc1 = f32x16{};
            const float* ap = mix + (size_t)g * 65536 + (size_t)(8 * hh) * 256 + d0 + r;
            const float* bp0 = win + (size_t)(kin0 + r) * 9264 + g * 256 + 8 * hh; const float* bp1 = bp0 + (size_t)32 * 9264;
#pragma unroll 4
            for (int k = 0; k < 16; ++k) {
                f32x4 a0, a1;
#pragma unroll
                for (int j = 0; j < 4; ++j) { a0[j] = ap[(size_t)(k * 16 + j) * 256]; a1[j] = ap[(size_t)(k * 16 + 4 + j) * 256]; }
                const u32x4 af = pack8(a0, a1), b0 = pack8(*(const f32x4*)(bp0 + k * 16), *(const f32x4*)(bp0 + k * 16 + 4)), b1 = pack8(*(const f32x4*)(bp1 + k * 16), *(const f32x4*)(bp1 + k * 16 + 4));
                acc0 = __builtin_amdgcn_mfma_f32_32x32x16_bf16(__builtin_bit_cast(bf16x8, af), __builtin_bit_cast(bf16x8, b0), acc0, 0, 0, 0);
                acc1 = __builtin_amdgcn_mfma_f32_32x32x16_bf16(__builtin_bit_cast(bf16x8, af), __builtin_bit_cast(bf16x8, b1), acc1, 0, 0, 0);
            }
#pragma unroll
            for (int e = 0; e < 16; ++e) { int ee = e; asm volatile("" : "+v"(ee)); bf16_t* rowp = WC + (size_t)(g * 256 + d0 + crow(ee, hh)) * 2048 + kin0 + r;
                const float v0 = acc0[e], v1 = acc1[e], n0_ = dpp_x1f(v0), n1_ = dpp_x1f(v1);
                if ((r & 1) == 0) { *(unsigned*)rowp = cvtpk(v0, n0_); *(unsigned*)(rowp + 32) = cvtpk(v1, n1_); } }
        }
    }
    for (int i = gw * 64 + lane; i < 53248; i += NGW * 64) *(GAS u32x4*)(ws + WS_WCAT + (size_t)9264 * 4096 + (size_t)i * 16) = (u32x4){0u, 0u, 0u, 0u};
    {
        const float* x = a.in[0]; const float* nw = a.in[1]; bf16_t* H = (bf16_t*)(ws + WS_H); unsigned char* H8 = ws + WS_H8;
        f32x4 wv[8];
#pragma unroll
        for (int j = 0; j < 8; ++j) wv[j] = *((const f32x4*)nw + lane + 64 * j);
        for (int m = gw; m < S; m += NGW) {
            const f32x4* xr = (const f32x4*)(x + (size_t)m * DM) + lane; f32x4 v[8]; float s = 0.f;
#pragma unroll
            for (int j = 0; j < 8; ++j) { v[j] = xr[64 * j]; s += (v[j][0] * v[j][0] + v[j][1] * v[j][1]) + (v[j][2] * v[j][2] + v[j][3] * v[j][3]); }
            const float rstd = 1.0f / sqrtf(wave_sum(s) * (1.f / DM) + EPS);
            u32x2* o = (u32x2*)(H + (size_t)m * DM) + lane;
#pragma unroll
            for (int j = 0; j < 8; ++j) { const f32x4 y = v[j] * rstd * wv[j]; u32x2 w; w.x = cvtpk(y[0], y[1]); w.y = cvtpk(y[2], y[3]); o[64 * j] = w;
                *(unsigned*)(H8 + (size_t)m * DM + (lane + 64 * j) * 4) = cvt4_fp8(sat8(y[0]), sat8(y[1]), sat8(y[2]), sat8(y[3])); }
        }
    }
    {
        float* rcos = (float*)(ws + WS_ROPE); float* rsin = rcos + (size_t)S * 64;
        for (int e = gw * 64 + lane; e < S * 64; e += NGW * 64) {
            const int pos = e >> 6, i = e & 63;
            double inv = 1.0, b = 0.86596432336006535;
            for (int k = i; k; k >>= 1) { if (k & 1) inv *= b; b *= b; }
            const double t = (double)pos * inv * 0.15915494309189535;
            const float fr = (float)(t - floor(t));
            rcos[e] = __builtin_amdgcn_cosf(fr); rsin[e] = __builtin_amdgcn_sinf(fr);
        }
    }
}
__device__ __forceinline__ void p1_late_weights(const Frame& F, const Args& a, int cw, int NCW) {
    unsigned char* ws = a.ws;
    LAS float* scr = (LAS float*)(F.lds + F.wave * 8192);
    const int lane = F.lane;
    constexpr int I_NO = 32 * 64, I_O = 32 * 64, I_PO = 16 * 64, I_W1 = 64 * 8, I_W2 = 4 * 4, I_B1 = 512;
    constexpr int NITEMS = I_NO + I_O + I_PO + 2 * I_W1 + 2 * I_W2 + I_B1;
    for (int it = cw; it < NITEMS; it += NCW) {
        int r = it;
        if (r < I_W1) { transpose_item(a.in[6], 256, 256, (bf16_t*)(ws + WS_W1KT), 4096, 0, false, scr, r / 8, r % 8, lane); continue; } r -= I_W1;
        if (r < I_W1) { transpose_item(a.in[9], 256, 256, (bf16_t*)(ws + WS_W1VT), 4096, 0, false, scr, r / 8, r % 8, lane); continue; } r -= I_W1;
        if (r < I_B1) {
            const int which = r >> 8, fb = (r >> 6) & 3, ch = r & 63, f = fb * 64 + lane;
            const float* pe = a.in[which ? 8 : 5]; const float* w1 = a.in[which ? 9 : 6]; float s = 0.f;
#pragma unroll 16
            for (int k = ch * 64; k < ch * 64 + 64; ++k) s += pe[k] * w1[(size_t)k * 256 + f];
            ((float*)(ws + WS_B1P))[(which * 64 + ch) * 256 + f] = s; continue; } r -= I_B1;
        if (r < I_W2) { transpose_item(a.in[7], 128, 128, (bf16_t*)(ws + WS_W2KT), 256, 0, true, scr, r / 4, r % 4, lane); continue; } r -= I_W2;
        if (r < I_W2) { transpose_item(a.in[10], 128, 128, (bf16_t*)(ws + WS_W2VT), 256, 0, false, scr, r / 4, r % 4, lane); continue; } r -= I_W2;
        if (r < I_PO) { transpose_item(a.in[11], 2048, 2048, (bf16_t*)(ws + WS_WPOT), 1024, 0, false, scr, r / 64, r % 64, lane); continue; } r -= I_PO;
        if (r < I_NO) { transpose_item(a.in[12], 2048, 2048, (bf16_t*)(ws + WS_WNOT), 2048, 0, false, scr, r / 64, r % 64, lane, WNO_SCALE); continue; } r -= I_NO;
        transpose_item(a.in[15], 2048, 2048, (bf16_t*)(ws + WS_WOT), 2048, 0, false, scr, r / 64, r % 64, lane);
    }
}

template <int W>
__device__ __forceinline__ void ypool_item(const bf16_t* __restrict__ U, const bf16_t* __restrict__ GP, bf16_t* __restrict__ Y, const float* __restrict__ scale, int c, int t0) {
    u32x4 x[W + 7], gq[8];
#pragma unroll
    for (int k = 0; k < W + 7; ++k) { const int r = t0 - (W - 1) + k; x[k] = r >= 0 ? *(const u32x4*)(U + (size_t)r * 1024 + c) : (u32x4){0u, 0u, 0u, 0u}; }
#pragma unroll
    for (int k = 0; k < 8; ++k) gq[k] = *(const u32x4*)(GP + (size_t)(t0 + k) * 1024 + c);
    const f32x4 sc0 = *(const f32x4*)(scale + c), sc1 = *(const f32x4*)(scale + c + 4);
    f32x4 s0 = {0.f, 0.f, 0.f, 0.f}, s1 = s0, a0, a1;
#pragma unroll
    for (int k = 0; k < W - 1; ++k) { unpack8(x[k], a0, a1); s0 = s0 + a0; s1 = s1 + a1; }
#pragma unroll
    for (int k = 0; k < 8; ++k) { const int t = t0 + k;
        unpack8(x[W - 1 + k], a0, a1); s0 = s0 + a0; s1 = s1 + a1;
        const int cnt = (t + 1 < W) ? t + 1 : W; const float ic = 1.0f / (float)cnt;
        f32x4 g0, g1; unpack8(gq[k], g0, g1);
        *(u32x4*)(Y + (size_t)t * 1024 + c) = pack8((s0 * ic - a0) * sc0 * g0, (s1 * ic - a1) * sc1 * g1);
        f32x4 b0, b1; unpack8(x[k], b0, b1); s0 = s0 - b0; s1 = s1 - b1; }
}
__device__ __forceinline__ void p2_ypool(const Frame& F, unsigned char* ws, const float* __restrict__ scale, int cw, int NCW) {
    const bf16_t* __restrict__ U = (const bf16_t*)(ws + WS_U); const bf16_t* __restrict__ GP = (const bf16_t*)(ws + WS_GP); bf16_t* __restrict__ Y = (bf16_t*)(ws + WS_H + 16 * MiB);
    for (int wi = cw; wi < 4 * 512; wi += NCW) {
        const int g = wi & 3, t0 = ((wi >> 2) * 2 + (F.lane >> 5)) * 8, c = (g * 32 + (F.lane & 31)) * 8;
        if (g == 0) ypool_item<2>(U, GP, Y, scale, c, t0); else if (g == 1) ypool_item<4>(U, GP, Y, scale, c, t0);
        else if (g == 2) ypool_item<8>(U, GP, Y, scale, c, t0); else ypool_item<16>(U, GP, Y, scale, c, t0);
    }
}
__device__ __forceinline__ void p2_vt8(const Frame& F, unsigned char* ws, int cw, int NCW) {
    const int lane = F.lane;
    for (int it = cw; it < 1024; it += NCW) {
        const int which = it >> 9, h = (it >> 7) & 3, j = it & 127;
        const unsigned char* V8 = ws + (which ? WS_V8W : WS_V8S) + (size_t)(64 * j) * 512 + h * 128 + 2 * lane;
        unsigned char* T = ws + (which ? WS_V8TW : WS_V8TS) + (size_t)(h * 128 + j) * 8192 + (size_t)(2 * lane) * 64;
#pragma unroll
        for (int hb = 0; hb < 2; ++hb) {
            unsigned short e[32];
#pragma unroll
            for (int jj = 0; jj < 32; ++jj) { const int key = jj < 16 ? crow(jj, hb) : 32 + crow(jj - 16, hb); e[jj] = *(const unsigned short*)(V8 + (size_t)key * 512); }
            u32x4 a0, a1, b0, b1;
#pragma unroll
            for (int q = 0; q < 4; ++q) {
                a0[q] = (unsigned)(e[4*q] & 0xff) | ((unsigned)(e[4*q+1] & 0xff) << 8) | ((unsigned)(e[4*q+2] & 0xff) << 16) | ((unsigned)(e[4*q+3] & 0xff) << 24);
                a1[q] = (unsigned)(e[16+4*q] & 0xff) | ((unsigned)(e[16+4*q+1] & 0xff) << 8) | ((unsigned)(e[16+4*q+2] & 0xff) << 16) | ((unsigned)(e[16+4*q+3] & 0xff) << 24);
                b0[q] = (unsigned)(e[4*q] >> 8) | ((unsigned)(e[4*q+1] >> 8) << 8) | ((unsigned)(e[4*q+2] >> 8) << 16) | ((unsigned)(e[4*q+3] >> 8) << 24);
                b1[q] = (unsigned)(e[16+4*q] >> 8) | ((unsigned)(e[16+4*q+1] >> 8) << 8) | ((unsigned)(e[16+4*q+2] >> 8) << 16) | ((unsigned)(e[16+4*q+3] >> 8) << 24); }
            *(u32x4*)(T + hb * 32) = a0; *(u32x4*)(T + hb * 32 + 16) = a1; *(u32x4*)(T + 64 + hb * 32) = b0; *(u32x4*)(T + 64 + hb * 32 + 16) = b1;
        }
    }
}

__device__ __forceinline__ void p3_compress2(const Frame& F, unsigned char* ws, int cwg, int NCWG) {
    const int tid = F.tid, lane = F.lane, r = lane & 31, hh = lane >> 5, wave = F.wave;
    const float* rcos = (const float*)(ws + WS_ROPE); const float* rsin = rcos + (size_t)S * 64;
    LAS bf16_t* hl = (LAS bf16_t*)F.lds;
    for (int it = cwg; it < 128; it += NCWG) {
        const int which = it >> 6, rt = it & 63;
        { const int row = tid >> 4, f0 = (tid & 15) * 16;
          const float* sl = (const float*)(ws + WS_SLAB) + ((size_t)(which * NSPLIT) * 2048 + rt * 32 + row) * 256 + f0; const float* b1 = (const float*)(ws + WS_B1) + which * 256 + f0;
          f32x4 s[4];
#pragma unroll
          for (int q = 0; q < 4; ++q) s[q] = *(const f32x4*)(b1 + 4 * q);
#pragma unroll
          for (int ks = 0; ks < NSPLIT; ++ks)
#pragma unroll
              for (int q = 0; q < 4; ++q) s[q] = s[q] + *(const f32x4*)(sl + (size_t)ks * 2048 * 256 + 4 * q);
#pragma unroll
          for (int q = 0; q < 4; ++q)
#pragma unroll
              for (int e = 0; e < 4; ++e) s[q][e] = siluf_(s[q][e]);
          *(LAS u32x4*)(hl + row * 264 + f0) = pack8(s[0], s[1]); *(LAS u32x4*)(hl + row * 264 + f0 + 8) = pack8(s[2], s[3]); }
        __syncthreads();
        if (wave < 4) {
            const int ct = wave, row = rt * 32 + r;
            const bf16_t* W2 = (const bf16_t*)(ws + (which ? WS_W2VT : WS_W2KT)) + (size_t)(ct * 32 + r) * 256 + hh * 8;
            f32x16 acc = f32x16{};
#pragma unroll 4
            for (int k = 0; k < 16; ++k) acc = __builtin_amdgcn_mfma_f32_32x32x16_bf16(*(const bf16x8*)(W2 + k * 16), *(const LAS bf16x8*)(hl + r * 264 + k * 16 + hh * 8), acc, 0, 0, 0);
            const int n = row & 511; bf16_t* dst = (bf16_t*)(ws + (which ? WS_VC : WS_KC)) + (size_t)row * 128 + ct * 32 + 4 * hh;
            const int pos = (16 * n + 31) > S - 1 ? S - 1 : 16 * n + 31;
#pragma unroll
            for (int gq = 0; gq < 4; ++gq) {
                float v0 = acc[4 * gq], v1 = acc[4 * gq + 1], v2 = acc[4 * gq + 2], v3 = acc[4 * gq + 3];
                if (which == 0) { const int i = (ct * 32 + 8 * gq + 4 * hh) >> 1; const float c0 = rcos[(size_t)pos * 64 + i], s0 = rsin[(size_t)pos * 64 + i], c1 = rcos[(size_t)pos * 64 + i + 1], s1 = rsin[(size_t)pos * 64 + i + 1];
                    const float o0 = v0 * c0 - v1 * s0, o1 = v1 * c0 + v0 * s0, o2 = v2 * c1 - v3 * s1, o3 = v3 * c1 + v2 * s1; v0 = o0; v1 = o1; v2 = o2; v3 = o3; }
                u32x2 w; w.x = cvtpk(v0, v1); w.y = cvtpk(v2, v3); if (n == 511) { w.x = 0u; w.y = 0u; }
                *(u32x2*)(dst + 8 * gq) = w;
            }
        }
        __syncthreads();
    }
}

namespace nsa {
constexpr int SHM_V = 16384, SHM_K = 16384;
constexpr int L_V = 0, L_K = 3 * SHM_V, L_WS = L_K + 2 * SHM_K, L_IMP = L_WS + NWAVES * 64 * 4, IMP_LD = 129, L_SELM = L_IMP + 64 * IMP_LD * 4, L_END = L_SELM + 64 * 8 * 2;
static_assert(L_END <= RING_BYTES, "attention LDS");
constexpr float SCALE = 0.08838834764831845f, C2 = 1.4426950408889634f * SCALE, THR = 8.f;
#define KSWZ(row, colB) ((row) * 256 + ((colB) ^ (((row) & 7) << 4)))
#define SBAR() __builtin_amdgcn_sched_barrier(0)
#define LADD(p, v) (void)__hip_atomic_fetch_add((p), (v), __ATOMIC_RELAXED, __HIP_MEMORY_SCOPE_WORKGROUP)
__device__ __forceinline__ int v_st(int k, int c) { const int kk = (k & ~0xC) | ((k & 4) << 1) | ((k & 8) >> 1); return ((kk >> 3) * 4 + (c >> 5)) * 512 + ((kk & 7) * 32 + (c & 31)) * 2; }
__device__ __forceinline__ int v_rd_base(int lane) { return ((lane & 3) << 3) | (((lane >> 2) & 3) << 6) | (((lane >> 4) & 1) << 5) | (((lane >> 5) & 1) << 8); }
constexpr int v_rd_off(int d0, int ks, int half) { return d0 * 512 + ks * 4096 + half * 2048; }
__device__ __forceinline__ unsigned cvtpk_a(float lo, float hi) { unsigned r; asm volatile("v_cvt_pk_bf16_f32 %0, %1, %2" : "=v"(r) : "v"(lo), "v"(hi)); return r; }

__device__ __forceinline__ void mask_range(f32x16& p0, f32x16& p1, int dq, unsigned Wn) {
    const float NEG = -__builtin_inff();
#pragma unroll
    for (int r = 0; r < 16; ++r) { const int c = (r & 3) + 8 * (r >> 2);
        if ((unsigned)(dq + c) >= Wn) p0[r] = NEG;
        if ((unsigned)(dq + c + 32) >= Wn) p1[r] = NEG; }
}
__device__ __forceinline__ void mask_row(f32x16& p0, f32x16& p1, bool keep) {
    const float NEG = -__builtin_inff();
#pragma unroll
    for (int r = 0; r < 16; ++r) { p0[r] = keep ? p0[r] : NEG; p1[r] = keep ? p1[r] : NEG; }
}
__device__ __forceinline__ float rowmax32(const f32x16& p0, const f32x16& p1) {
    float pmax = p0[0];
#pragma unroll
    for (int r = 1; r < 16; ++r) pmax = fmaxf(pmax, p0[r]);
#pragma unroll
    for (int r = 0; r < 16; ++r) pmax = fmaxf(pmax, p1[r]);
    auto rr = __builtin_amdgcn_permlane32_swap(__float_as_uint(pmax), __float_as_uint(pmax), false, false);
    return fmaxf(__uint_as_float(rr[0]), __uint_as_float(rr[1]));
}
__device__ __forceinline__ float rowsum32(const f32x16& p0, const f32x16& p1) {
    float ps = 0.f;
#pragma unroll
    for (int r = 0; r < 16; ++r) ps += p0[r];
#pragma unroll
    for (int r = 0; r < 16; ++r) ps += p1[r];
    auto rr = __builtin_amdgcn_permlane32_swap(__float_as_uint(ps), __float_as_uint(ps), false, false);
    return __uint_as_float(rr[0]) + __uint_as_float(rr[1]);
}
__device__ __forceinline__ void pack_p(const f32x16& p0, const f32x16& p1, bf16x8& pa0, bf16x8& pa1, bf16x8& pa2, bf16x8& pa3) {
#define PK4(P, B_, OUT) do { unsigned a0 = cvtpk_a(P[B_+0], P[B_+1]), a1 = cvtpk_a(P[B_+2], P[B_+3]);                          \
        unsigned b0 = cvtpk_a(P[B_+4], P[B_+5]), b1 = cvtpk_a(P[B_+6], P[B_+7]);                                             \
        auto r0 = __builtin_amdgcn_permlane32_swap(a0, b0, false, false); auto r1 = __builtin_amdgcn_permlane32_swap(a1, b1, false, false); \
        u32x4 w = {r0[0], r1[0], r0[1], r1[1]}; OUT = __builtin_bit_cast(bf16x8, w); } while (0)
    PK4(p0, 0, pa0); PK4(p0, 8, pa1); PK4(p1, 0, pa2); PK4(p1, 8, pa3);
#undef PK4
}
__device__ __forceinline__ void qkt(f32x16& p0, f32x16& p1, const LAS unsigned char* K_buf, int r32, int hi, const bf16x8* qr) {
    p0 = f32x16{}; p1 = f32x16{};
    const LAS unsigned char* kb[4];
#pragma unroll
    for (int dd = 0; dd < 4; ++dd) kb[dd] = K_buf + KSWZ(r32, (dd * 16 + hi * 8) * 2);
#define KLD(F, d0) do { const LAS unsigned char* a_ = kb[(d0) & 3] + ((d0) >> 2) * 128; F##0 = *(const LAS bf16x8*)(a_); F##1 = *(const LAS bf16x8*)(a_ + 32 * 256); \
        const LAS unsigned char* c_ = kb[((d0) + 1) & 3] + (((d0) + 1) >> 2) * 128; F##2 = *(const LAS bf16x8*)(c_); F##3 = *(const LAS bf16x8*)(c_ + 32 * 256); } while (0)
#define KMM(F, d0) do { p0 = __builtin_amdgcn_mfma_f32_32x32x16_bf16(F##0, qr[d0], p0, 0, 0, 0); p1 = __builtin_amdgcn_mfma_f32_32x32x16_bf16(F##1, qr[d0], p1, 0, 0, 0); \
        p0 = __builtin_amdgcn_mfma_f32_32x32x16_bf16(F##2, qr[(d0) + 1], p0, 0, 0, 0); p1 = __builtin_amdgcn_mfma_f32_32x32x16_bf16(F##3, qr[(d0) + 1], p1, 0, 0, 0); } while (0)
    bf16x8 fa0, fa1, fa2, fa3, fb0, fb1, fb2, fb3;
    KLD(fa, 0); KLD(fb, 2); SBAR();
    KMM(fa, 0); KLD(fa, 4); SBAR();
    KMM(fb, 2); KLD(fb, 6); SBAR();
    KMM(fa, 4); SBAR();
    KMM(fb, 6);
#undef KLD
#undef KMM
}
struct VF8 { s16x4 l0, h0, l1, h1, l2, h2, l3, h3; };
#define TRRD(dst, off) asm volatile("ds_read_b64_tr_b16 %0, %1 offset:%2" : "=&v"(dst) : "v"(vb0), "i"(off) : "memory")
__device__ __forceinline__ void pv_read0(VF8& f, int vb0) {
    constexpr int b_ = v_rd_off(0, 0, 0);
    TRRD(f.l0, b_); TRRD(f.h0, b_ + 2048); TRRD(f.l1, b_ + 4096); TRRD(f.h1, b_ + 6144); TRRD(f.l2, b_ + 8192); TRRD(f.h2, b_ + 10240); TRRD(f.l3, b_ + 12288); TRRD(f.h3, b_ + 14336);
}
__device__ __forceinline__ void pv_tile(f32x16* o, int vb0, bf16x8 pa0, bf16x8 pa1, bf16x8 pa2, bf16x8 pa3, VF8& f) {
#define PV_MM(d0, l0, h0, l1, h1, l2, h2, l3, h3) do { \
        o[d0] = __builtin_amdgcn_mfma_f32_32x32x16_bf16(pa0, (bf16x8){l0[0], l0[1], l0[2], l0[3], h0[0], h0[1], h0[2], h0[3]}, o[d0], 0, 0, 0);   \
        o[d0] = __builtin_amdgcn_mfma_f32_32x32x16_bf16(pa1, (bf16x8){l1[0], l1[1], l1[2], l1[3], h1[0], h1[1], h1[2], h1[3]}, o[d0], 0, 0, 0);   \
        o[d0] = __builtin_amdgcn_mfma_f32_32x32x16_bf16(pa2, (bf16x8){l2[0], l2[1], l2[2], l2[3], h2[0], h2[1], h2[2], h2[3]}, o[d0], 0, 0, 0);   \
        o[d0] = __builtin_amdgcn_mfma_f32_32x32x16_bf16(pa3, (bf16x8){l3[0], l3[1], l3[2], l3[3], h3[0], h3[1], h3[2], h3[3]}, o[d0], 0, 0, 0); } while (0)
#define PV_D0(d0) do { s16x4 l0, l1, l2, l3, h0, h1, h2, h3; constexpr int b_ = v_rd_off(d0, 0, 0); \
        TRRD(l0, b_); TRRD(h0, b_ + 2048); TRRD(l1, b_ + 4096); TRRD(h1, b_ + 6144); TRRD(l2, b_ + 8192); TRRD(h2, b_ + 10240); TRRD(l3, b_ + 12288); TRRD(h3, b_ + 14336); \
        asm volatile("s_waitcnt lgkmcnt(0)" ::: "memory"); SBAR(); PV_MM(d0, l0, h0, l1, h1, l2, h2, l3, h3); } while (0)
    asm volatile("s_waitcnt lgkmcnt(0)" ::: "memory"); SBAR(); PV_MM(0, f.l0, f.h0, f.l1, f.h1, f.l2, f.h2, f.l3, f.h3);
    PV_D0(1); PV_D0(2); PV_D0(3);
#undef PV_D0
#undef PV_MM
}
#undef TRRD

enum { M_C1 = 0, M_C2 = 1, M_S = 2, M_W = 3 };
struct Stage { bf16x8 k0, k1, v0, v1; };
__device__ __forceinline__ void stage_load(Stage& sg, const bf16_t* Kp, const bf16_t* Vp, int ld, int j, bool hasv) {
    const int tid = otid(), sr = tid >> 4, sc = (tid & 15) * 8; const size_t k0_ = (size_t)j * 64;
    sg.k0 = *(const bf16x8*)(Kp + (k0_ + sr) * ld + sc); sg.k1 = *(const bf16x8*)(Kp + (k0_ + 32 + sr) * ld + sc);
    if (hasv) { sg.v0 = *(const bf16x8*)(Vp + (k0_ + sr) * ld + sc); sg.v1 = *(const bf16x8*)(Vp + (k0_ + 32 + sr) * ld + sc); }
}
struct RowState { float m, l; };
template <int MODE>
__device__ __forceinline__ void attn_pass(LAS unsigned char* lds, const bf16_t* Kp, const bf16_t* Vp, int ld, int j_lo, int j_hi, const bf16x8* qr, int t, int Tq, const u32x4 sel,
                                          RowState& st, float invl, f32x16* o, bool do_imp, Stage& sg) {
    constexpr bool HASV = MODE != M_C1;
    const int tid = otid(), wid = __builtin_amdgcn_readfirstlane(tid >> 6), lane = tid & 63, r32 = lane & 31, hi = lane >> 5;
    LAS unsigned char* V_lds = lds + L_V; LAS unsigned char* K_lds = lds + L_K;
    LAS float* wsf = (LAS float*)(lds + L_WS) + wid * 64; LAS float* al_l = wsf + 32;
    const int sr = tid >> 4, sc = (tid & 15) * 8, vst0 = v_st(sr, sc), vst1 = v_st(32 + sr, sc), kws = KSWZ(sr, sc * 2);
    const int vb0 = (int)(uintptr_t)V_lds + v_rd_base(lane);
    const int NT = j_hi - j_lo;
#define st_k0 sg.k0
#define st_k1 sg.k1
#define st_v0 sg.v0
#define st_v1 sg.v1
    float m_reg = st.m, l_reg = st.l;
#define SLOAD(j) do { const size_t k0_ = (size_t)(j) * 64; st_k0 = *(const bf16x8*)(Kp + (k0_ + sr) * ld + sc); st_k1 = *(const bf16x8*)(Kp + (k0_ + 32 + sr) * ld + sc); \
        if (HASV) { st_v0 = *(const bf16x8*)(Vp + (k0_ + sr) * ld + sc); st_v1 = *(const bf16x8*)(Vp + (k0_ + 32 + sr) * ld + sc); } } while (0)
#define SWRITE(kof, vof) do { *(LAS bf16x8*)(K_lds + (kof) + kws) = st_k0; *(LAS bf16x8*)(K_lds + (kof) + kws + 32 * 256) = st_k1; \
        if (HASV) { *(LAS bf16x8*)(V_lds + (vof) + vst0) = st_v0; *(LAS bf16x8*)(V_lds + (vof) + vst1) = st_v1; } } while (0)
    const bool late = HASV && wid >= 4;
    bf16x8 pa0, pa1, pa2, pa3;
    SWRITE(0, 0);
    __syncthreads();
    int kof = 0, vof = 0, vprev = 0;
    for (int idx = 0; idx < NT; ++idx) {
        const int j = j_lo + idx, kb = j * 64;
        if (idx + 1 < NT) SLOAD(j + 1);
        if (HASV && late && idx > 0) { SBAR(); VF8 vf; pv_read0(vf, vb0 + vprev); pv_tile(o, vb0 + vprev, pa0, pa1, pa2, pa3, vf); SBAR(); }
        f32x16 p0, p1; qkt(p0, p1, K_lds + kof, r32, hi, qr);
        VF8 vfe; if (HASV && !late) { SBAR(); pv_read0(vfe, vb0 + vof); SBAR(); }
#if EXP_QKT2
        asm volatile("" : "+v"(p0), "+v"(p1)); SBAR(); qkt(p0, p1, K_lds + kof, r32, hi, qr);
#endif
        if (MODE == M_C1 || MODE == M_C2) { const int nmax1 = ((t - 31) >> 4) + 1; mask_range(p0, p1, kb + 4 * hi, (unsigned)(nmax1 > 0 ? nmax1 : 0)); }
        else if (MODE == M_S) { if (j == Tq) mask_range(p0, p1, kb + 4 * hi, (unsigned)(t + 1));
                                else { const unsigned w_ = (j >> 5) == 0 ? sel.x : (j >> 5) == 1 ? sel.y : (j >> 5) == 2 ? sel.z : sel.w; mask_row(p0, p1, ((w_ >> (j & 31)) & 1u) != 0u); } }
        else { if (j == Tq || j + 8 <= Tq) mask_range(p0, p1, kb + 4 * hi - (t - 511), 512u); }
        if (MODE == M_C1) { const float pmax = rowmax32(p0, p1); const float mn = fmaxf(m_reg, pmax); const float alpha = __builtin_amdgcn_exp2f((m_reg - mn) * C2); m_reg = mn;
            const float mnL = -mn * C2;
#pragma unroll
            for (int r = 0; r < 16; ++r) { p0[r] = __builtin_amdgcn_exp2f(fmaf(p0[r], C2, mnL)); p1[r] = __builtin_amdgcn_exp2f(fmaf(p1[r], C2, mnL)); }
            l_reg = l_reg * alpha + rowsum32(p0, p1); }
        else if (MODE == M_C2) { const float mnL = -m_reg * C2;
#pragma unroll
            for (int r = 0; r < 16; ++r) { p0[r] = __builtin_amdgcn_exp2f(fmaf(p0[r], C2, mnL)) * invl; p1[r] = __builtin_amdgcn_exp2f(fmaf(p1[r], C2, mnL)) * invl; }
            if (do_imp) { LAS unsigned* imp = (LAS unsigned*)(lds + L_IMP) + ((wid & 1) * 32 + r32) * IMP_LD + 16 * j + hi;
#pragma unroll
                for (int k = 0; k < 4; ++k) {
                    { const float e_ = p0[4 * k + 3], a_ = 2.f * (p0[4 * k] + p0[4 * k + 1] + p0[4 * k + 2]) + e_;
                      LADD(imp + 2 * k, (unsigned)(a_ * 67108864.f + 0.5f)); LADD(imp + 2 * k + 1, (unsigned)(e_ * 67108864.f + 0.5f)); }
                    { const float e_ = p1[4 * k + 3], a_ = 2.f * (p1[4 * k] + p1[4 * k + 1] + p1[4 * k + 2]) + e_;
                      LADD(imp + 8 + 2 * k, (unsigned)(a_ * 67108864.f + 0.5f)); LADD(imp + 8 + 2 * k + 1, (unsigned)(e_ * 67108864.f + 0.5f)); } } }
            pack_p(p0, p1, pa0, pa1, pa2, pa3); }
        else { const float pmax = rowmax32(p0, p1); float mn, alpha;
            if (__builtin_expect(__all((pmax - m_reg) * SCALE <= THR), 1)) { mn = m_reg; alpha = 1.f; }
            else { mn = fmaxf(m_reg, pmax); alpha = __builtin_amdgcn_exp2f((m_reg - mn) * C2); m_reg = mn; }
            const float mnL = -mn * C2;
#pragma unroll
            for (int r = 0; r < 16; ++r) { p0[r] = __builtin_amdgcn_exp2f(fmaf(p0[r], C2, mnL)); p1[r] = __builtin_amdgcn_exp2f(fmaf(p1[r], C2, mnL)); }
            l_reg = l_reg * alpha + rowsum32(p0, p1);
            pack_p(p0, p1, pa0, pa1, pa2, pa3);
            if (__any(alpha < 1.f)) { if (hi == 0) al_l[r32] = alpha; asm volatile("s_waitcnt lgkmcnt(0)" ::: "memory");
#pragma unroll
                for (int d_ = 0; d_ < 4; ++d_)
#pragma unroll
                    for (int r = 0; r < 16; ++r) o[d_][r] *= al_l[crow(r, hi)]; } }
        if (HASV && !late) { SBAR(); pv_tile(o, vb0 + vof, pa0, pa1, pa2, pa3, vfe); }
        const int kn = kof ^ SHM_K, vn = (vof == 2 * SHM_V) ? 0 : vof + SHM_V;
        if (idx + 1 < NT) { SWRITE(kn, vn); }
        __syncthreads();
        vprev = vof; kof = kn; vof = vn;
    }
    if (HASV) { if (late) { SBAR(); VF8 vf; pv_read0(vf, vb0 + vprev); pv_tile(o, vb0 + vprev, pa0, pa1, pa2, pa3, vf); } __syncthreads(); }
    st.m = m_reg; st.l = l_reg;
#undef SLOAD
#undef SWRITE
#undef st_k0
#undef st_k1
#undef st_v0
#undef st_v1
}

typedef int v8i __attribute__((ext_vector_type(8)));
struct Stage8 { u32x4 k, v; };
constexpr int SHM8 = 8192;
constexpr float THR8 = 0.5f;
__device__ __forceinline__ f32x16 mfma8(v8i a, v8i b, f32x16 c) { return __builtin_amdgcn_mfma_scale_f32_32x32x64_f8f6f4(a, b, c, 0, 0, 0, 0x7F7F7F7F, 0, 0x7F7F7F7F); }
__device__ __forceinline__ int k8_off(int key, int c) { return key * 128 + ((c ^ ((key >> 1) & 7)) << 4); }
__device__ __forceinline__ int v8_off(int d, int c) { return d * 64 + ((c ^ ((d >> 2) & 3)) << 4); }
__device__ __forceinline__ void stage_load8(Stage8& sg, const unsigned char* K8h, const unsigned char* V8Th, int j) {
    const int tid = otid();
    sg.k = *(const u32x4*)(K8h + (size_t)(64 * j + (tid >> 3)) * 512 + (tid & 7) * 16); sg.v = *(const u32x4*)(V8Th + (size_t)j * 8192 + tid * 16);
}
__device__ __forceinline__ v8i ld_v8i(const LAS unsigned char* a, const LAS unsigned char* b) { const u32x4 x = *(const LAS u32x4*)a, y = *(const LAS u32x4*)b; return (v8i){(int)x.x, (int)x.y, (int)x.z, (int)x.w, (int)y.x, (int)y.y, (int)y.z, (int)y.w}; }
template <int MODE>
__device__ __forceinline__ void attn_pass8(LAS unsigned char* lds, const unsigned char* K8h, const unsigned char* V8Th, int j_lo, int j_hi, const v8i* qf, int t, int Tq, const u32x4 sel,
                                           RowState& st, f32x16* o, f32x16& ol, Stage8& sg0) {
    const int tid = otid(), wid = __builtin_amdgcn_readfirstlane(tid >> 6), lane = tid & 63, r32 = lane & 31, hi = lane >> 5;
    LAS unsigned char* V_lds = lds + L_V; LAS unsigned char* K_lds = lds + L_K;
    LAS float* wsf = (LAS float*)(lds + L_WS) + wid * 64; LAS float* al_l = wsf + 32;
    const int kws = k8_off(tid >> 3, tid & 7), vws = v8_off(tid >> 2, tid & 3);
    const int NT = j_hi - j_lo;
    float m_reg = st.m;
#define SWRITE8(SG, kof, vof) do { *(LAS u32x4*)(K_lds + (kof) + kws) = (SG).k; *(LAS u32x4*)(V_lds + (vof) + vws) = (SG).v; } while (0)
    const bool late = wid >= 4;
    v8i pa; Stage8 sg1;
    const v8i ones = {0x38383838, 0x38383838, 0x38383838, 0x38383838, 0x38383838, 0x38383838, 0x38383838, 0x38383838};
    SWRITE8(sg0, 0, 0);
    __syncthreads();
    if (NT > 1) stage_load8(sg1, K8h, V8Th, j_lo + 1);
    int kof = 0, vof = 0, vprev = 0;
#define PV8(vo) do { const LAS unsigned char* vb_ = V_lds + (vo);                                                                      \
        _Pragma("unroll") for (int d0 = 0; d0 < 4; ++d0) { const int d_ = d0 * 32 + r32;                                               \
            o[d0] = mfma8(pa, ld_v8i(vb_ + v8_off(d_, 2 * hi), vb_ + v8_off(d_, 2 * hi + 1)), o[d0]); }                                \
        ol = mfma8(pa, ones, ol); } while (0)
#define TILE8(idx, SGL, SGW) do { const int j = j_lo + (idx), kb = j * 64;                                                               \
        if ((idx) + 2 < NT) stage_load8(SGL, K8h, V8Th, j + 2);                                                                        \
        if (late && (idx) > 0) { SBAR(); PV8(vprev); SBAR(); }                                                                         \
        f32x16 p0 = f32x16{}, p1 = f32x16{};                                                                                           \
        { const LAS unsigned char* kb_ = K_lds + kof;                                                                                  \
          _Pragma("unroll") for (int ks = 0; ks < 2; ++ks) {                                                                           \
              p0 = mfma8(ld_v8i(kb_ + k8_off(r32, 4 * ks + 2 * hi), kb_ + k8_off(r32, 4 * ks + 2 * hi + 1)), qf[ks], p0);               \
              p1 = mfma8(ld_v8i(kb_ + k8_off(32 + r32, 4 * ks + 2 * hi), kb_ + k8_off(32 + r32, 4 * ks + 2 * hi + 1)), qf[ks], p1); } } \
        bool rowkeep = true;                                                                                                           \
        if (MODE == M_S) { if (j == Tq) mask_range(p0, p1, kb + 4 * hi, (unsigned)(t + 1));                                             \
                           else { const unsigned w_ = (j >> 5) == 0 ? sel.x : (j >> 5) == 1 ? sel.y : (j >> 5) == 2 ? sel.z : sel.w; rowkeep = ((w_ >> (j & 31)) & 1u) != 0u; } } \
        else { if (j == Tq || j + 8 <= Tq) mask_range(p0, p1, kb + 4 * hi - (t - 511), 512u); }                                          \
        { float pmax = rowmax32(p0, p1); if (MODE == M_S) pmax = rowkeep ? pmax : -__builtin_inff(); float mn, alpha;                  \
          if (__builtin_expect(__all((pmax - m_reg) * SCALE <= THR8), 1)) { mn = m_reg; alpha = 1.f; }                                 \
          else { mn = fmaxf(m_reg, pmax); alpha = __builtin_amdgcn_exp2f((m_reg - mn) * C2); m_reg = mn; }                             \
          float mnL = 8.0f - mn * C2;                                                                                                  \
          if (MODE == M_S) mnL = rowkeep ? mnL : -__builtin_inff();                                                                    \
          _Pragma("unroll") for (int r = 0; r < 16; ++r) { p0[r] = __builtin_amdgcn_exp2f(fmaf(p0[r], C2, mnL)); p1[r] = __builtin_amdgcn_exp2f(fmaf(p1[r], C2, mnL)); } \
          _Pragma("unroll") for (int q = 0; q < 4; ++q) { pa[q] = (int)cvt4_fp8(p0[4 * q], p0[4 * q + 1], p0[4 * q + 2], p0[4 * q + 3]); pa[4 + q] = (int)cvt4_fp8(p1[4 * q], p1[4 * q + 1], p1[4 * q + 2], p1[4 * q + 3]); } \
          if (__any(alpha < 1.f)) { if (hi == 0) al_l[r32] = alpha; asm volatile("s_waitcnt lgkmcnt(0)" ::: "memory");                 \
              _Pragma("unroll") for (int r = 0; r < 16; ++r) { const float a_ = al_l[crow(r, hi)]; o[0][r] *= a_; o[1][r] *= a_; o[2][r] *= a_; o[3][r] *= a_; ol[r] *= a_; } } } \
        if (!late) { SBAR(); PV8(vof); }                                                                                               \
        const int kn = kof ^ SHM8, vn = (vof == 2 * SHM8) ? 0 : vof + SHM8;                                                            \
        if ((idx) + 1 < NT) { SWRITE8(SGW, kn, vn); }                                                                                  \
        __syncthreads();                                                                                                               \
        vprev = vof; kof = kn; vof = vn; } while (0)
    int idx = 0;
    for (; idx + 1 < NT; idx += 2) { TILE8(idx, sg0, sg1); TILE8(idx + 1, sg1, sg0); }
    if (idx < NT) TILE8(idx, sg0, sg1);
    if (late) { SBAR(); PV8(vprev); }
    __syncthreads();
    st.m = m_reg;
#undef TILE8
#undef PV8
#undef SWRITE8
}

template <int MODE, bool USE_OL>
__device__ __forceinline__ void branch_out(LAS unsigned char* lds, const f32x16* o, float rowscale, bf16_t* onsa_w, const bf16_t* gn_w, const f32x16 ol, unsigned char* onsa8_w = nullptr) {
    const int tid = otid(), wid = __builtin_amdgcn_readfirstlane(tid >> 6), lane = tid & 63, r32 = lane & 31, hi = lane >> 5;
    LAS float* li_l = (LAS float*)(lds + L_WS) + wid * 64;
    if (hi == 0) li_l[r32] = rowscale; asm volatile("s_waitcnt lgkmcnt(0)" ::: "memory");
    LAS unsigned* stg = (LAS unsigned*)(lds + wid * 8192);
#pragma unroll
    for (int r = 0; r < 16; ++r) { const int orow = crow(r, hi); float sc = li_l[orow]; if (USE_OL) sc = ol[r] > 0.f ? sc * __builtin_amdgcn_rcpf(ol[r]) : 0.f;
#pragma unroll
        for (int d0 = 0; d0 < 4; ++d0) { const float v = o[d0][r] * sc; const float vn = dpp_x1f(v);
            if ((r32 & 1) == 0) stg[orow * 64 + d0 * 16 + (r32 >> 1)] = cvtpk(v, vn); } }
    asm volatile("s_waitcnt lgkmcnt(0)" ::: "memory");
    u32x4 val[8], prev[8], gq[8];
#pragma unroll
    for (int i = 0; i < 8; ++i) val[i] = *(const LAS u32x4*)(stg + (i * 4 + (lane >> 4)) * 64 + (lane & 15) * 4);
    int rb = lane >> 4; asm volatile("" : "+v"(rb));
    bf16_t* gp_ = onsa_w + (size_t)rb * 2048 + (lane & 15) * 8; const bf16_t* gg_ = gn_w + (size_t)rb * 2048 + (lane & 15) * 8;
    unsigned char* o8_ = onsa8_w + (size_t)rb * 2048 + (lane & 15) * 8;
    if (MODE >= 1) {
#pragma unroll
        for (int i = 0; i < 8; ++i) prev[i] = *(const u32x4*)(gp_ + (size_t)i * 4 * 2048); }
    if (MODE == 2) {
#pragma unroll
        for (int i = 0; i < 8; ++i) gq[i] = *(const u32x4*)(gg_ + (size_t)i * 4 * 2048); }
#pragma unroll
    for (int i = 0; i < 8; ++i) { u32x4 w = val[i];
        if (MODE >= 1) { f32x4 a0, a1, b0, b1; unpack8(val[i], a0, a1); unpack8(prev[i], b0, b1); a0 = a0 + b0; a1 = a1 + b1;
            if (MODE == 2) { f32x4 g0, g1; unpack8(gq[i], g0, g1); a0 = a0 * g0; a1 = a1 * g1; }
            w = pack8(a0, a1); }
        if (MODE == 2) { f32x4 a0, a1; unpack8(w, a0, a1); u32x2 w8; w8.x = cvt4_fp8(sat8(a0[0] * ONSA_SCALE), sat8(a0[1] * ONSA_SCALE), sat8(a0[2] * ONSA_SCALE), sat8(a0[3] * ONSA_SCALE));
            w8.y = cvt4_fp8(sat8(a1[0] * ONSA_SCALE), sat8(a1[1] * ONSA_SCALE), sat8(a1[2] * ONSA_SCALE), sat8(a1[3] * ONSA_SCALE)); *(u32x2*)(o8_ + (size_t)i * 4 * 2048) = w8; }
        else *(u32x4*)(gp_ + (size_t)i * 4 * 2048) = w; }
    __syncthreads();
}

__device__ __forceinline__ void attn_unit(LAS unsigned char* lds, unsigned char* ws, int h, int Tq) {
    const int tid = otid(), wid = __builtin_amdgcn_readfirstlane(tid >> 6), lane = tid & 63, r32 = lane & 31, hi = lane >> 5;
    const int g = wid >> 1, tl = (wid & 1) * 32 + r32, t = Tq * 64 + tl, hq = 4 * h + g;
    const bf16_t* Q = (const bf16_t*)(ws + WS_Q); const bf16_t* GBR = (const bf16_t*)(ws + WS_GBR);
    bf16_t* onsa_w = (bf16_t*)(ws + WS_ONSA) + (size_t)(Tq * 64 + (wid & 1) * 32) * 2048 + hq * 128; const bf16_t* gn_w = (const bf16_t*)(ws + WS_GN) + (size_t)(Tq * 64 + (wid & 1) * 32) * 2048 + hq * 128;
    bf16x8 qr[8];
#pragma unroll
    for (int d0 = 0; d0 < 8; ++d0) qr[d0] = *(const bf16x8*)(Q + (size_t)t * 2048 + hq * 128 + d0 * 16 + hi * 8);
    const float g_c = bf2f(GBR[(size_t)t * 256 + hq * 3 + 0]), g_s = bf2f(GBR[(size_t)t * 256 + hq * 3 + 1]), g_w = bf2f(GBR[(size_t)t * 256 + hq * 3 + 2]);
    const bool big = Tq >= 16;
    LAS unsigned* IMP = (LAS unsigned*)(lds + L_IMP);
    if (big) { for (int i = tid; i < 64 * IMP_LD; i += 512) IMP[i] = 0u; }
    const u32x4 nosel = {0u, 0u, 0u, 0u};
    f32x16 o[4]; Stage sg;
    {
        const bf16_t* Kc = (const bf16_t*)(ws + WS_KC) + (size_t)h * 512 * 128; const bf16_t* Vc = (const bf16_t*)(ws + WS_VC) + (size_t)h * 512 * 128;
        const int ntc = ((4 * Tq + 2) >> 6) + 1;
        RowState stc{-1e30f, 0.f};
        stage_load(sg, Kc, Vc, 128, 0, false);
        attn_pass<M_C1>(lds, Kc, Vc, 128, 0, ntc, qr, t, Tq, nosel, stc, 0.f, o, false, sg);
        stage_load(sg, Kc, Vc, 128, 0, true);
        const float invl = stc.l > 0.f ? 1.0f / stc.l : 0.f;
#pragma unroll
        for (int d = 0; d < 4; ++d) o[d] = f32x16{};
        attn_pass<M_C2>(lds, Kc, Vc, 128, 0, ntc, qr, t, Tq, nosel, stc, invl, o, big, sg);
        branch_out<0, false>(lds, o, g_c, onsa_w, gn_w, f32x16{});
    }
    {
        LAS unsigned short* SELM = (LAS unsigned short*)(lds + L_SELM);
        int tok = tid >> 3, sub = tid & 7; asm volatile("" : "+v"(tok), "+v"(sub));
        unsigned bits = 0u;
        if (big) {
            unsigned kv[16];
#pragma unroll
            for (int e = 0; e < 16; ++e) { const int j = sub * 16 + e; const unsigned v = IMP[tok * IMP_LD + j]; kv[e] = (j >= 1 && j <= Tq - 2) ? v + 1u : 0u; }
            for (int round = 0; round < 13; ++round) {
                unsigned bv = kv[0]; int bj = 0;
#pragma unroll
                for (int e = 1; e < 16; ++e) { const bool gt = kv[e] > bv; bv = gt ? kv[e] : bv; bj = gt ? e : bj; }
                bj += sub * 16;
#pragma unroll
                for (int st_ = 0; st_ < 3; ++st_) { const unsigned ov = st_ == 0 ? dpp_x1(bv) : st_ == 1 ? dpp_x2(bv) : dpp_m8(bv); const int oj = (int)(st_ == 0 ? dpp_x1((unsigned)bj) : st_ == 1 ? dpp_x2((unsigned)bj) : dpp_m8((unsigned)bj));
                    const bool take = (ov > bv) || (ov == bv && oj < bj); bv = take ? ov : bv; bj = take ? oj : bj; }
                const int we = (bv != 0u && (bj >> 4) == sub) ? (bj & 15) : -1;
#pragma unroll
                for (int e = 0; e < 16; ++e) { const bool hit = (we == e); bits |= hit ? (1u << e) : 0u; kv[e] = hit ? 0u : kv[e]; }
            }
#pragma unroll
            for (int e = 0; e < 16; ++e) { const int j = sub * 16 + e; if (j == 0 || j == Tq - 1 || j == Tq) bits |= 1u << e; }
        } else {
#pragma unroll
            for (int e = 0; e < 16; ++e) { const int j = sub * 16 + e; if (j <= Tq) bits |= 1u << e; }
        }
        SELM[tok * 8 + sub] = (unsigned short)bits;
        __syncthreads();
    }
    const u32x4 sel = *(const LAS u32x4*)(lds + L_SELM + tl * 16);
    v8i qf[2];
    { const unsigned char* q8 = ws + WS_Q8 + (size_t)t * 2048 + hq * 128 + 32 * hi;
#pragma unroll
      for (int ks = 0; ks < 2; ++ks) { const u32x4 x = *(const u32x4*)(q8 + 64 * ks), y = *(const u32x4*)(q8 + 64 * ks + 16); qf[ks] = (v8i){(int)x.x, (int)x.y, (int)x.z, (int)x.w, (int)y.x, (int)y.y, (int)y.z, (int)y.w}; } }
    const unsigned char* K8S = ws + WS_K8S + h * 128; const unsigned char* V8TS = ws + WS_V8TS + (size_t)h * 128 * 8192;
    const unsigned char* K8W = ws + WS_K8W + h * 128; const unsigned char* V8TW = ws + WS_V8TW + (size_t)h * 128 * 8192;
    Stage8 s8;
    {
        RowState sts{-1e30f, 0.f};
#pragma unroll
        for (int d = 0; d < 4; ++d) o[d] = f32x16{};
        f32x16 ol = f32x16{};
        stage_load8(s8, K8S, V8TS, 0);
        attn_pass8<M_S>(lds, K8S, V8TS, 0, Tq + 1, qf, t, Tq, sel, sts, o, ol, s8);
        stage_load8(s8, K8W, V8TW, Tq >= 8 ? Tq - 8 : 0);
        branch_out<1, true>(lds, o, g_s, onsa_w, gn_w, ol);
    }
    {
        RowState stw{-1e30f, 0.f};
#pragma unroll
        for (int d = 0; d < 4; ++d) o[d] = f32x16{};
        f32x16 ol = f32x16{};
        attn_pass8<M_W>(lds, K8W, V8TW, Tq >= 8 ? Tq - 8 : 0, Tq + 1, qf, t, Tq, sel, stw, o, ol, s8);
        branch_out<2, true>(lds, o, g_w, onsa_w, gn_w, ol, ws + WS_ONSA8 + (size_t)(Tq * 64 + (wid & 1) * 32) * 2048 + hq * 128);
    }
}
#undef KSWZ
#undef SBAR
}

constexpr int NPHASE = 8;
__global__ void __launch_bounds__(NWAVES * 64, 2) mega_fwd(Args args) {
    extern __shared__ __attribute__((aligned(16))) unsigned char lds[];
    Frame F;
    F.lds = (LAS unsigned char*)lds;
    F.tid = threadIdx.x; F.lane = F.tid & 63; F.wave = __builtin_amdgcn_readfirstlane(F.tid >> 6);
    F.G = gridDim.x; { const int bx = blockIdx.x; F.vcu = (F.G % 8 == 0) ? (bx % 8) * (F.G / 8) + bx / 8 : bx; }
    volatile LAS unsigned* MISC = (volatile LAS unsigned*)(F.lds + MISC_OFF);
    unsigned char* ws = args.ws;
    for (int u = F.tid; u < (LDS_BYTES - LDSCTL_OFF) / 4; u += NWAVES * 64) ((LAS unsigned*)(F.lds + LDSCTL_OFF))[u] = 0u;
    __syncthreads();
    XcdBarrier bar; bar.bar = (unsigned*)(ws + WS_CTL) + CW_BAR; bar.x = 0; bar.st = nullptr;
#if !N_LAUNCHES_PER_PHASE
    bar = xcd_barrier_post((unsigned*)(ws + WS_CTL) + CW_BAR, MISC + 8);
#endif
    const int lo = args.ph_lo, hi = args.ph_hi;
#define IN(k) (lo <= (k) && (k) < hi && (F.tid = otid(), F.lane = F.tid & 63, true))
#define SEAM(k) do { if (IN(k) && IN((k) + 1)) xcd_barrier(bar); } while (0)
    bf16_t* const GM = (bf16_t*)args.out;

    for (int rep_ = 0; rep_ < (DUP_PHASE == 0 ? 2 : 1); ++rep_) if (IN(0)) { if (rep_) xcd_barrier(bar); p0_prologue(F, args); } SEAM(0);
    for (int rep_ = 0; rep_ < (DUP_PHASE == 1 ? 2 : 1); ++rep_) if (IN(1)) { if (rep_) xcd_barrier(bar);
        pg8::Gemm g{(const bf16_t*)(ws + WS_H), (const bf16_t*)(ws + WS_WCAT), 2048, 2048, 2048};
        pg8::StaticOrder So; So.init(S, NCAT, F.G, (int)blockIdx.x);
        EpiInProj E{ws, GM, args.in[14], 0};
        pg8::AddrAffine AD{(size_t)256 * 2048 * 2, (size_t)256 * 2048 * 2};
        pg8::gemm_phase<EpiInProj, true>(F.lds, g, So, E, AD);
        {
            pg8::Gemm g8{(const bf16_t*)(ws + WS_H8), (const bf16_t*)(ws + WS_W8), 1024, 1024, 1024};
            pg8::StaticOrder S8; S8.init(S, 4096, F.G, (int)blockIdx.x);
            EpiInProj E8{ws, GM, args.in[14], 37};
            pg8::AddrAffine AD8{(size_t)256 * 1024 * 2, (size_t)256 * 1024 * 2};
            pg8::gemm_phase<EpiInProj, true, pg8::AddrAffine, true>(F.lds, g8, S8, E8, AD8);
        }
        { const int nun = (So.nwg + F.G - 1) / F.G, full = So.nwg - (nun - 1) * F.G;
          const int base = full < F.G ? full : 0; if ((int)blockIdx.x >= base) p1_late_weights(F, args, ((int)blockIdx.x - base) * NWAVES + F.wave, (F.G - base) * NWAVES); }
    } SEAM(1);
    for (int rep_ = 0; rep_ < (DUP_PHASE == 2 ? 2 : 1); ++rep_) if (IN(2)) { if (rep_) xcd_barrier(bar);
        pg8::Gemm g{(const bf16_t*)(ws + WS_KCR), (const bf16_t*)(ws + WS_W1KT), 2048, 4096, 4096 / NSPLIT};
        pg8::StaticOrder So; So.init(16 * 256, NSPLIT * 256, F.G, (int)blockIdx.x);
        EpiSlab E{(float*)(ws + WS_SLAB)};
        pg8::AddrCmp AD{(4096 / NSPLIT) / 64};
        pg8::gemm_phase<EpiSlab, false>(F.lds, g, So, E, AD);
        { const int base = F.G > So.nwg ? So.nwg : 0; if ((int)blockIdx.x >= base) { p2_ypool(F, ws, args.in[4], ((int)blockIdx.x - base) * NWAVES + F.wave, (F.G - base) * NWAVES); p2_vt8(F, ws, ((int)blockIdx.x - base) * NWAVES + F.wave, (F.G - base) * NWAVES); } }
        if (blockIdx.x == F.G - 1) { const float* b1p = (const float*)(ws + WS_B1P); float* b1 = (float*)(ws + WS_B1); const int t = F.tid; float s = 0.f;
            for (int c = 0; c < 64; ++c) s += b1p[((t >> 8) * 64 + c) * 256 + (t & 255)];
            b1[t] = s; }
    } SEAM(2);
    for (int rep_ = 0; rep_ < (DUP_PHASE == 3 ? 2 : 1); ++rep_) if (IN(3)) { if (rep_) xcd_barrier(bar);
        p3_compress2(F, ws, (int)blockIdx.x, F.G);
    } SEAM(3);
    for (int rep_ = 0; rep_ < (DUP_PHASE == 5 ? 2 : 1); ++rep_) if (IN(5)) { if (rep_) xcd_barrier(bar);
        for (int p = F.vcu; p < 256; p += F.G) {
#pragma unroll 1
            for (int i = 0; i < 2; ++i) { const int h = p >> 6, x = p & 63; nsa::attn_unit(F.lds, ws, h, i ? x : 127 - x); } }
    } SEAM(5);
    for (int rep_ = 0; rep_ < (DUP_PHASE == 6 ? 2 : 1); ++rep_) if (IN(6)) { if (rep_) xcd_barrier(bar);
        pg8::Gemm ga{(const bf16_t*)(ws + WS_H + 16 * MiB), (const bf16_t*)(ws + WS_WPOT), 1024, 1024, 1024};
        pg8::Gemm gb{(const bf16_t*)(ws + WS_ONSA8), (const bf16_t*)(ws + WS_WNOT), 1024, 1024, 1024};
        pg8::StaticOrder So; So.init(S, 2048, F.G, (int)blockIdx.x);
        EpiYaYb E{EpiYa{(bf16_t*)(ws + WS_YAG), GM}, EpiYb{(bf16_t*)(ws + WS_H), (const bf16_t*)(ws + WS_YAG), GM, 1.0f / (ONSA_SCALE * WNO_SCALE)}};
        pg8::gemm_phase2<EpiYaYb>(F.lds, ga, gb, So, E);
    } SEAM(6);
    for (int rep_ = 0; rep_ < (DUP_PHASE == 7 ? 2 : 1); ++rep_) if (IN(7)) { if (rep_) xcd_barrier(bar);
        pg8::Gemm g{(const bf16_t*)(ws + WS_H), (const bf16_t*)(ws + WS_WOT), 2048, 2048, 2048}; pg8::AddrAffine AD{(size_t)256 * 2048 * 2, (size_t)256 * 2048 * 2};
        pg8::StaticOrder So; So.init(S, 2048, F.G, (int)blockIdx.x);
        EpiOut E{args.out, args.in[0], (float*)(ws + WS_SSQ), args.in[16], (unsigned*)(ws + WS_CTL), F.lds};
        pg8::gemm_phase<EpiOut, true>(F.lds, g, So, E, AD);
    }
#undef IN
#undef SEAM
}

extern "C" void kernel_launch(void* const* d_in, const int* in_sizes, int n_in, void* d_out, int out_size, void* d_ws, size_t ws_size, hipStream_t stream) {
    static int grid = 0;
    if (grid == 0) {
        if (n_in != 17 || in_sizes[0] != S * DM || out_size != S * DM || ws_size < WS_END) { fprintf(stderr, "kernel_launch: unexpected shapes (n_in %d, in0 %d, out %d, ws %zu); nothing launched\n", n_in, n_in > 0 ? in_sizes[0] : -1, out_size, ws_size); grid = -1; return; }
        int dev = 0, cus = 0;
        if (hipGetDevice(&dev) != hipSuccess || hipDeviceGetAttribute(&cus, hipDeviceAttributeMultiprocessorCount, dev) != hipSuccess) { fprintf(stderr, "kernel_launch: device query failed\n"); grid = -1; return; }
        if (hipFuncSetAttribute((const void*)mega_fwd, hipFuncAttributeMaxDynamicSharedMemorySize, LDS_BYTES) != hipSuccess) { fprintf(stderr, "kernel_launch: hipFuncSetAttribute failed\n"); grid = -1; return; }
        (void)hipGetLastError();
        grid = cus;
    }
    if (grid < 0) return;
    (void)hipMemsetAsync((char*)d_ws + WS_CTL, 0, CTL_BYTES, stream);
    Args a{};
    for (int i = 0; i < 17; ++i) a.in[i] = (const float*)d_in[i];
    a.out = (float*)d_out; a.ws = (unsigned char*)d_ws;
#if N_LAUNCHES_PER_PHASE
    for (int p = 0; p < NPHASE; ++p) { a.ph_lo = p; a.ph_hi = p + 1; hipLaunchKernelGGL(mega_fwd, dim3(grid), dim3(NWAVES * 64), LDS_BYTES, stream, a); }
#else
    a.ph_lo = 0; a.ph_hi = NPHASE;
    hipLaunchKernelGGL(mega_fwd, dim3(grid), dim3(NWAVES * 64), LDS_BYTES, stream, a);
#endif
}
```

```cpp
#include <hip/hip_runtime.h>
#include <cstdio>
#include <cstdint>

#define LAS __attribute__((address_space(3)))
#define GAS __attribute__((address_space(1)))
typedef unsigned short bf16_t;
typedef short bf16x8 __attribute__((ext_vector_type(8)));
typedef short s16x4 __attribute__((ext_vector_type(4)));
typedef float f32x4 __attribute__((ext_vector_type(4)));
typedef float f32x16 __attribute__((ext_vector_type(16)));
typedef unsigned u32x4 __attribute__((ext_vector_type(4)));
typedef unsigned u32x2 __attribute__((ext_vector_type(2)));
typedef float f32x2_t __attribute__((ext_vector_type(2)));
typedef __bf16 bf16x2_t __attribute__((ext_vector_type(2)));

#ifndef EXP_QKT2
#define EXP_QKT2 0
#endif
#ifndef DUP_PHASE
#define DUP_PHASE -1
#endif
#ifndef N_LAUNCHES_PER_PHASE
#define N_LAUNCHES_PER_PHASE 0
#endif

constexpr int S = 8192, DM = 2048, NCAT = 9472;
constexpr int HD = 128, NKV = 4, NCMP = 511;
constexpr float EPS = 1e-6f;

constexpr size_t MiB = 1u << 20;
constexpr size_t WS_CTL = 0, CTL_BYTES = 1 * MiB;
constexpr size_t WS_WCAT = 1 * MiB;
constexpr size_t WS_SLAB = WS_WCAT;
constexpr size_t WS_ONSA = WS_WCAT;
constexpr size_t WS_MIXT = 54 * MiB;
constexpr size_t WS_WPOT = 55 * MiB;
constexpr size_t WS_WNOT = 59 * MiB;
constexpr size_t WS_WOT  = 67 * MiB;
constexpr size_t WS_W1KT = 75 * MiB, WS_W1VT = 77 * MiB;
constexpr size_t WS_W2KT = 79 * MiB, WS_W2VT = 79 * MiB + 65536;
constexpr size_t WS_B1P  = 80 * MiB + 262144;
constexpr size_t WS_B1   = 79 * MiB + 131072 + 32768;
constexpr size_t WS_KC   = 79 * MiB + 262144, WS_VC = 79 * MiB + 786432;
constexpr size_t WS_ROPE = 81 * MiB;
constexpr size_t WS_SSQ  = 85 * MiB;
constexpr size_t WS_H    = 86 * MiB;
constexpr size_t WS_U    = 118 * MiB, WS_GP = 134 * MiB;
constexpr size_t WS_YAG  = WS_U;
constexpr size_t WS_Q    = 150 * MiB;
constexpr size_t WS_KCR  = 182 * MiB, WS_VCR = 190 * MiB, WS_KS = 198 * MiB, WS_VS = 206 * MiB, WS_KW = 214 * MiB, WS_VW = 222 * MiB;
constexpr size_t WS_GN   = 230 * MiB;
constexpr size_t WS_GBR  = 262 * MiB;
constexpr size_t WS_K8S = 198 * MiB, WS_K8W = 202 * MiB;
constexpr size_t WS_V8S = 206 * MiB, WS_V8W = 210 * MiB;
constexpr size_t WS_V8TS = 214 * MiB, WS_V8TW = 218 * MiB;
constexpr size_t WS_ONSA8 = WS_WCAT + 32 * MiB;
constexpr float   ONSA_SCALE = 64.f, WNO_SCALE = 64.f;
constexpr size_t WS_H8   = 214 * MiB;
constexpr size_t WS_W8   = 38 * MiB;
constexpr float   W8_SCALE = 64.f;
constexpr size_t WS_Q8   = 266 * MiB;
constexpr size_t WS_END  = 282 * MiB;
constexpr int CW_BAR = 4096;

constexpr int RING_BYTES = 131072;
constexpr int LDSCTL_OFF = RING_BYTES, MISC_OFF = LDSCTL_OFF + 320;
constexpr int LDS_BYTES = 147456;
constexpr int NWAVES = 8;

#define LDS_WAIT() asm volatile("s_waitcnt lgkmcnt(0)" ::: "memory")
#define VM_WAIT() asm volatile("s_waitcnt vmcnt(0)" ::: "memory")

__device__ __forceinline__ unsigned cvtpk(float lo, float hi) { f32x2_t v = {lo, hi}; bf16x2_t b = __builtin_convertvector(v, bf16x2_t); return __builtin_bit_cast(unsigned, b); }
__device__ __forceinline__ float sat8(float x) { return __builtin_amdgcn_fmed3f(x, -448.f, 448.f); }
__device__ __forceinline__ unsigned cvt4_fp8(float a, float b, float c, float d) { int w = __builtin_amdgcn_cvt_pk_fp8_f32(a, b, 0, false); return (unsigned)__builtin_amdgcn_cvt_pk_fp8_f32(c, d, w, true); }
__device__ __forceinline__ float bf2f(unsigned short h) { return __builtin_bit_cast(float, (unsigned)h << 16); }
__device__ __forceinline__ float bflo(unsigned w) { return __builtin_bit_cast(float, w << 16); }
__device__ __forceinline__ float bfhi(unsigned w) { return __builtin_bit_cast(float, w & 0xffff0000u); }
__device__ __forceinline__ float sigmoidf_(float x) { return __builtin_amdgcn_rcpf(1.0f + __expf(-x)); }
__device__ __forceinline__ float siluf_(float x) { return x * __builtin_amdgcn_rcpf(1.0f + __expf(-x)); }
__device__ __forceinline__ int otid() { int t = threadIdx.x; asm volatile("" : "+v"(t)); return t; }
__device__ __forceinline__ unsigned dpp_x1(unsigned v) { return __builtin_amdgcn_update_dpp(0u, v, 0xB1, 0xF, 0xF, false); }
__device__ __forceinline__ unsigned dpp_x2(unsigned v) { return __builtin_amdgcn_update_dpp(0u, v, 0x4E, 0xF, 0xF, false); }
__device__ __forceinline__ unsigned dpp_m8(unsigned v) { return __builtin_amdgcn_update_dpp(0u, v, 0x141, 0xF, 0xF, false); }
__device__ __forceinline__ float dpp_x1f(float v) { return __uint_as_float(dpp_x1(__float_as_uint(v))); }
__device__ __forceinline__ int crow(int r, int hi) { return (r & 3) + 8 * (r >> 2) + 4 * hi; }
__device__ __forceinline__ float wave_sum(float v) {
#pragma unroll
    for (int o = 1; o < 64; o <<= 1) v += __shfl_xor(v, o);
    return v;
}

#define XB_TMO      128
#define XB_XCNT(j)  (256  + 64 * (j))
#define XB_XSUB(j)  (1280 + 64 * (j))
#define XB_XGEN(j)  (2304 + 64 * (j))
#define XB_TOP      3328
#define XB_TOPGEN   3392
#define XCD_BAR_WORDS 3456
#define XB_SPIN_CAP (1u << 18)
__device__ __forceinline__ unsigned xb_ld(unsigned* p)              { return __hip_atomic_load(p, __ATOMIC_RELAXED, __HIP_MEMORY_SCOPE_AGENT); }
__device__ __forceinline__ unsigned xb_add(unsigned* p, unsigned v) { return __hip_atomic_fetch_add(p, v, __ATOMIC_RELAXED, __HIP_MEMORY_SCOPE_AGENT); }
__device__ __forceinline__ unsigned xb_xcc_id() { return (unsigned)__builtin_amdgcn_s_getreg((3 << 11) | 20) & 0xFu; }
#define XB_SPIN(cond, bar) do { unsigned _sp = 0; while (cond) { __builtin_amdgcn_s_sleep(1); \
    if ((++_sp & 255u) == 0u) { if (xb_ld(&(bar)[XB_TMO])) break; if (_sp > XB_SPIN_CAP) { atomicAdd(&(bar)[XB_TMO], 1u); break; } } } } while (0)
struct XcdBarrier { unsigned* bar; unsigned x; volatile LAS unsigned* st; };
__device__ __forceinline__ XcdBarrier xcd_barrier_post(unsigned* bar, volatile LAS unsigned* st) {
    XcdBarrier b; b.bar = bar; b.x = xb_xcc_id(); b.st = st;
    if (threadIdx.x == 0) (void)xb_add(&bar[XB_XCNT(b.x)], 1u);
    return b;
}
__device__ __forceinline__ void xcd_barrier_complete(unsigned* bar, unsigned x, unsigned& nloc, unsigned& nx) {
    const unsigned G = gridDim.x * gridDim.y * gridDim.z;
    unsigned sum, cnt, mine, sp = 0u;
    for (;;) {
        sum = 0u; cnt = 0u; mine = 0u;
#pragma unroll
        for (unsigned j = 0; j < 16; ++j) { const unsigned c = xb_ld(&bar[XB_XCNT(j)]); sum += c; cnt += (c > 0u) ? 1u : 0u; mine = (j == x) ? c : mine; }
        if (sum == G) break;
        __builtin_amdgcn_s_sleep(1);
        if ((++sp & 255u) == 0u) { if (xb_ld(&bar[XB_TMO])) break; if (sp > XB_SPIN_CAP) { atomicAdd(&bar[XB_TMO], 1u); break; } }
    }
    nloc = mine > 0u ? mine : 1u; nx = cnt > 0u ? cnt : 1u;
}
__device__ __forceinline__ void xcd_barrier(const XcdBarrier& b) {
    asm volatile("s_waitcnt vmcnt(0)" ::: "memory");
    __syncthreads();
    if (threadIdx.x == 0) {
        unsigned* bar = b.bar;
        __builtin_amdgcn_s_waitcnt(0);
        unsigned nloc = b.st[0], nx = b.st[1];
        if (nloc == 0u) { xcd_barrier_complete(bar, b.x, nloc, nx); b.st[0] = nloc; b.st[1] = nx; }
        const unsigned old = xb_add(&bar[XB_XSUB(b.x)], 1u);
        const unsigned gen = old / nloc;
        if (old + 1u == (gen + 1u) * nloc) {
            __builtin_amdgcn_fence(__ATOMIC_RELEASE, "agent");
            asm volatile("s_waitcnt vmcnt(0)" ::: "memory");
            const unsigned og = xb_add(&bar[XB_TOP], 1u);
            const unsigned tg = og / nx;
            if (og + 1u == (tg + 1u) * nx) xb_add(&bar[XB_TOPGEN], 1u);
            else XB_SPIN(xb_ld(&bar[XB_TOPGEN]) == tg, bar);
            __builtin_amdgcn_fence(__ATOMIC_ACQUIRE, "agent");
            xb_add(&bar[XB_XGEN(b.x)], 1u);
            asm volatile("s_waitcnt vmcnt(0)" ::: "memory");
        } else {
            XB_SPIN(xb_ld(&bar[XB_XGEN(b.x)]) == gen, bar);
            __builtin_amdgcn_fence(__ATOMIC_ACQUIRE, "agent");
            asm volatile("s_waitcnt vmcnt(0)" ::: "memory");
        }
    }
    __syncthreads();
}

namespace pg8 {
constexpr int BM = 256, BK = 64, HALF = 128, HTB = HALF * BK * 2, STAGE_BYTES = 8 * HTB, NXCD = 8, WGM = 8;
__host__ __device__ __forceinline__ int lds_byte(int r, int c) { const int st = (r >> 4) * 2 + (c >> 5), rr = r & 15, cc = c & 31, ob = rr * 64 + cc * 2; return st * 1024 + (ob ^ (((ob >> 9) & 1) << 5)); }
__host__ __device__ __forceinline__ void stage_rc(int b, int& R, int& C) { const int st = b / 1024, sb = b % 1024, swz = sb ^ (((sb >> 9) & 1) << 5); R = (st >> 1) * 16 + swz / 64; C = (st & 1) * 32 + (swz % 64) / 2; }
__host__ __device__ __forceinline__ int perm32(int rho) { const int n = rho >> 4, i = rho & 15; return 8 * (i >> 2) + 4 * n + (i & 3); }
struct Unit { int pm, pn; };
struct Gemm { const bf16_t* A; const bf16_t* Bt; int lda, ldb, K; };
struct AddrAffine { size_t tA, tB;
    __device__ __forceinline__ const char* A(const char* b, const Unit& u) const { return b + (size_t)u.pm * tA; }
    __device__ __forceinline__ const char* B(const char* b, const Unit& u) const { return b + (size_t)u.pn * tB; }
    __device__ __forceinline__ size_t ka(int t) const { return (size_t)t * (BK * 2); } };
struct AddrCmp { int ntile;
    __device__ __forceinline__ const char* A(const char* b, const Unit& u) const { return b + (size_t)(u.pm >> 3) * (8 * MiB) + (size_t)((u.pm >> 1) & 3) * (2 * MiB) + (size_t)(u.pm & 1) * (256 * 4096) + ka(u.pn * ntile); }
    __device__ __forceinline__ const char* B(const char* b, const Unit& u) const { return b + (size_t)(u.pm >> 3) * (2 * MiB) + (size_t)u.pn * ntile * (BK * 2); }
    __device__ __forceinline__ size_t ka(int t) const { return (size_t)t * (BK * 2); } };
struct StaticOrder {
    int nM, nN, nwg, G, c;
    __host__ __device__ void init(int M, int N, int G_, int c_) { nM = M / BM; nN = N / BM; nwg = nM * nN; G = G_; c = c_; }
    __host__ __device__ bool next(int i, Unit& u) const {
        const long L = (long)i * G + c; if (L >= nwg) return false;
        int wgid = (int)L; { const int q = nwg / NXCD, r = nwg % NXCD, xcd = wgid % NXCD, off = wgid / NXCD; wgid = (xcd < r ? xcd * (q + 1) : r * (q + 1) + (xcd - r) * q) + off; }
        const int nig = WGM * nN, gid = wgid / nig, fm = gid * WGM, gsz = (nM - fm) < WGM ? (nM - fm) : WGM;
        u.pm = fm + ((wgid % nig) % gsz); u.pn = (wgid % nig) / gsz; return true;
    }
};
typedef int v8i_g __attribute__((ext_vector_type(8)));
typedef int v4i_g __attribute__((ext_vector_type(4)));
template <class Epi, bool ALIGN_EPI, class Addr, bool FP8 = false>
__device__ __forceinline__ void gemm_phase(LAS unsigned char* lds, const Gemm g, const StaticOrder& S, const Epi& E, const Addr& AD) {
    const int tid = otid(), wid = __builtin_amdgcn_readfirstlane(tid >> 6), lane = tid & 63, wr = wid >> 2, wc = wid & 3, fr = lane & 15, fq = lane >> 4;
    const int K = g.K, nt = K / BK;
    unsigned voffA[2], voffB[2];
#pragma unroll
    for (int i = 0; i < 2; ++i) { int R, C; stage_rc(tid * 16 + i * 8192, R, C); const int Rb = (R & ~31) + perm32(R & 31);
        voffA[i] = (unsigned)(R * g.lda + C) * 2u; voffB[i] = (unsigned)(Rb * g.ldb + C) * 2u; }
    const size_t kstep = (size_t)(BK * 2);
    const size_t hA = (size_t)HALF * g.lda * 2, hB = (size_t)HALF * g.ldb * 2;
    const unsigned ldsw = (unsigned)wid * 1024u;
    const int aoff = lds_byte(wr * 64 + fr, fq * 8), boff = lds_byte(wc * 32 + fr, fq * 8);
#define PG8_SA(b, h) (((b) * 2 + (h)) * HTB)
#define PG8_SB(b, h) ((4 + (b) * 2 + (h)) * HTB)
#define PG8_STAGE(bufoff, gbase, voff) do { _Pragma("unroll") for (int _i = 0; _i < 2; ++_i) \
        __builtin_amdgcn_global_load_lds((const unsigned*)((const char*)(gbase) + (voff)[_i]), (LAS unsigned*)(lds + (bufoff) + ldsw + _i * 8192), 16, 0, 0); } while (0)
#define PG8_LDA(dst, b, h) do { _Pragma("unroll") for (int m = 0; m < 4; ++m) _Pragma("unroll") for (int k = 0; k < 2; ++k) dst[m][k] = *(const LAS bf16x8*)(lds + PG8_SA(b, h) + aoff + m * 2048 + k * 1024); } while (0)
#define PG8_LDB(dst, b, h) do { _Pragma("unroll") for (int n = 0; n < 2; ++n) _Pragma("unroll") for (int k = 0; k < 2; ++k) dst[n][k] = *(const LAS bf16x8*)(lds + PG8_SB(b, h) + boff + n * 2048 + k * 1024); } while (0)
#define PG8_LD8(p_) __builtin_shufflevector(*(const LAS v4i_g*)(p_), *(const LAS v4i_g*)((p_) + 1024), 0, 1, 2, 3, 4, 5, 6, 7)
#define PG8_LDA8(dst, b, h) do { _Pragma("unroll") for (int m = 0; m < 4; ++m) dst[m] = PG8_LD8(lds + PG8_SA(b, h) + aoff + m * 2048); } while (0)
#define PG8_LDB8(dst, b, h) do { _Pragma("unroll") for (int n = 0; n < 2; ++n) dst[n] = PG8_LD8(lds + PG8_SB(b, h) + boff + n * 2048); } while (0)
#define PG8_MMA16(ai, bj, At, Bt) do { __builtin_amdgcn_s_setprio(1); _Pragma("unroll") for (int m = 0; m < 4; ++m) _Pragma("unroll") for (int n = 0; n < 2; ++n) _Pragma("unroll") for (int k = 0; k < 2; ++k) \
        acc[ai][bj][m][n] = __builtin_amdgcn_mfma_f32_16x16x32_bf16(Bt[n][k], At[m][k], acc[ai][bj][m][n], 0, 0, 0); __builtin_amdgcn_s_setprio(0); } while (0)
#define PG8_MMA8(ai, bj, At, Bt) do { __builtin_amdgcn_s_setprio(1); _Pragma("unroll") for (int m = 0; m < 4; ++m) _Pragma("unroll") for (int n = 0; n < 2; ++n) \
        asm volatile("v_mfma_scale_f32_16x16x128_f8f6f4 %0, %1, %2, %0, %3, %3 op_sel_hi:[0,0,0]" : "+v"(acc[ai][bj][m][n]) : "v"(Bt[n]), "v"(At[m]), "v"(sc8_)); __builtin_amdgcn_s_setprio(0); } while (0)
#define PG8_WAIT_V(n) asm volatile("s_waitcnt vmcnt(" #n ")" ::: "memory")
#define PG8_WAIT_L(n) asm volatile("s_waitcnt lgkmcnt(" #n ")" ::: "memory")
#define PG8_BAR __builtin_amdgcn_s_barrier()
#define PG8_SCHED __builtin_amdgcn_sched_barrier(0)
#define PG8_KBODY(LDA_, LDB_, MMA_, At, B0, B1) do { \
            LDB_(B0, 0, 0); LDB_(B1, 0, 1); PG8_SCHED; LDA_(At, 0, 0); PG8_STAGE(PG8_SA(1, 1), a1 + hA, voffA); \
            PG8_WAIT_V(8); PG8_WAIT_L(0); PG8_BAR; MMA_(0, 0, At, B0); MMA_(0, 1, At, B1); PG8_BAR; PG8_SCHED; \
            LDA_(At, 0, 1); PG8_STAGE(PG8_SB(0, 0), b2, voffB); PG8_STAGE(PG8_SB(0, 1), b2 + hB, voffB); PG8_STAGE(PG8_SA(0, 0), a2, voffA); \
            PG8_WAIT_V(8); PG8_WAIT_L(0); PG8_BAR; MMA_(1, 0, At, B0); MMA_(1, 1, At, B1); PG8_BAR; PG8_SCHED; \
            LDB_(B0, 1, 0); LDB_(B1, 1, 1); PG8_SCHED; LDA_(At, 1, 0); PG8_STAGE(PG8_SA(0, 1), a2 + hA, voffA); \
            PG8_WAIT_V(8); PG8_WAIT_L(0); PG8_BAR; MMA_(0, 0, At, B0); MMA_(0, 1, At, B1); PG8_BAR; PG8_SCHED; \
            LDA_(At, 1, 1); PG8_STAGE(PG8_SB(1, 0), b3, voffB); PG8_STAGE(PG8_SB(1, 1), b3 + hB, voffB); PG8_STAGE(PG8_SA(1, 0), a3, voffA); \
            PG8_WAIT_V(8); PG8_WAIT_L(0); PG8_BAR; MMA_(1, 0, At, B0); MMA_(1, 1, At, B1); PG8_BAR; PG8_SCHED; } while (0)
    Unit cur, nxt; int ui = 0;
    if (!S.next(0, cur)) return;
    f32x4 acc[2][2][4][2];
#pragma unroll
    for (int a = 0; a < 2; ++a)
#pragma unroll
        for (int b = 0; b < 2; ++b)
#pragma unroll
            for (int m = 0; m < 4; ++m)
#pragma unroll
                for (int n = 0; n < 2; ++n) acc[a][b][m][n] = (f32x4){0.f, 0.f, 0.f, 0.f};
    bf16x8 At16[4][2], B016[2][2], B116[2][2]; v8i_g At8[4], B08[2], B18[2]; const int sc8_ = 0x7F7F7F7F;
    const char* cA = AD.A((const char*)g.A, cur); const char* cB = AD.B((const char*)g.Bt, cur);
    PG8_STAGE(PG8_SB(0, 0), cB, voffB); PG8_STAGE(PG8_SB(0, 1), cB + hB, voffB); PG8_STAGE(PG8_SA(0, 0), cA, voffA); PG8_STAGE(PG8_SA(0, 1), cA + hA, voffA);
    if (wr == 1) PG8_BAR;
    PG8_WAIT_V(2); PG8_BAR;
    PG8_STAGE(PG8_SB(1, 0), cB + kstep, voffB); PG8_STAGE(PG8_SA(1, 0), cA + kstep, voffA); PG8_STAGE(PG8_SB(1, 1), cB + hB + kstep, voffB);
    PG8_WAIT_V(6); PG8_BAR;
    for (;;) {
        const bool has_next = S.next(ui + 1, nxt);
        const char* nA = has_next ? AD.A((const char*)g.A, nxt) : cA; const char* nB = has_next ? AD.B((const char*)g.Bt, nxt) : cB;
        for (int t = 0; t < nt; t += 2) {
            const bool last = (t == nt - 2);
            const char* a1 = cA + AD.ka(t) + kstep;
            const char* a2 = last ? nA : cA + AD.ka(t + 2); const char* b2 = last ? nB : cB + (size_t)(t + 2) * kstep;
            const char* a3 = a2 + kstep; const char* b3 = b2 + kstep;
            if constexpr (FP8) PG8_KBODY(PG8_LDA8, PG8_LDB8, PG8_MMA8, At8, B08, B18); else PG8_KBODY(PG8_LDA, PG8_LDB, PG8_MMA16, At16, B016, B116);
        }
        if constexpr (ALIGN_EPI) { if (wr == 0) PG8_BAR; }
        if constexpr (FP8) asm volatile("s_nop 15\n\ts_nop 7" ::: "memory");
        E(acc, cur, wr, wc, fr, fq);
        if (!has_next) break;
#pragma unroll
        for (int a = 0; a < 2; ++a)
#pragma unroll
            for (int b = 0; b < 2; ++b)
#pragma unroll
                for (int m = 0; m < 4; ++m)
#pragma unroll
                    for (int n = 0; n < 2; ++n) acc[a][b][m][n] = (f32x4){0.f, 0.f, 0.f, 0.f};
        cur = nxt; cA = nA; cB = nB; ++ui;
        if constexpr (ALIGN_EPI) { if (wr == 1) PG8_BAR; }
    }
    PG8_WAIT_V(0);
    if constexpr (!ALIGN_EPI) { if (wr == 0) PG8_BAR; }
    PG8_BAR;
#undef PG8_SA
#undef PG8_SB
#undef PG8_STAGE
#undef PG8_LDA
#undef PG8_LDB
#undef PG8_MMA16
#undef PG8_MMA8
#undef PG8_KBODY
#undef PG8_LD8
#undef PG8_LDA8
#undef PG8_LDB8
#undef PG8_WAIT_V
#undef PG8_WAIT_L
#undef PG8_BAR
#undef PG8_SCHED
}
template <class Epi>
__device__ __forceinline__ void gemm_phase2(LAS unsigned char* lds, const Gemm g0, const Gemm g1, const StaticOrder& S, const Epi& E) {
    int tid = otid(); const int wid = __builtin_amdgcn_readfirstlane(tid >> 6), lane = tid & 63, wr = wid >> 2, wc = wid & 3, fr = lane & 15, fq = lane >> 4;
#define PG8_MKOFF(vA, vB, G) do { _Pragma("unroll") for (int i_ = 0; i_ < 2; ++i_) { int R_, C_; stage_rc(tid * 16 + i_ * 8192, R_, C_); const int Rb_ = (R_ & ~31) + perm32(R_ & 31); \
        (vA)[i_] = (unsigned)(R_ * (G).lda + C_) * 2u; (vB)[i_] = (unsigned)(Rb_ * (G).ldb + C_) * 2u; } } while (0)
    const size_t kstep = (size_t)(BK * 2);
    const size_t hA0 = (size_t)HALF * g0.lda * 2, hB0 = (size_t)HALF * g0.ldb * 2, hA1 = hA0, hB1 = hB0;
    unsigned ldsw = (unsigned)wid * 1024u;
    int aoff = lds_byte(wr * 64 + fr, fq * 8), boff = lds_byte(wc * 32 + fr, fq * 8);
#define PG8_SA(b, h) (((b) * 2 + (h)) * HTB)
#define PG8_SB(b, h) ((4 + (b) * 2 + (h)) * HTB)
#define PG8_STAGE(bufoff, gbase, voff) do { _Pragma("unroll") for (int _i = 0; _i < 2; ++_i) \
        __builtin_amdgcn_global_load_lds((const unsigned*)((const char*)(gbase) + (voff)[_i]), (LAS unsigned*)(lds + (bufoff) + ldsw + _i * 8192), 16, 0, 0); } while (0)
#define PG8_LDA(dst, b, h) do { _Pragma("unroll") for (int m = 0; m < 4; ++m) _Pragma("unroll") for (int k = 0; k < 2; ++k) dst[m][k] = *(const LAS bf16x8*)(lds + PG8_SA(b, h) + aoff + m * 2048 + k * 1024); } while (0)
#define PG8_LDB(dst, b, h) do { _Pragma("unroll") for (int n = 0; n < 2; ++n) _Pragma("unroll") for (int k = 0; k < 2; ++k) dst[n][k] = *(const LAS bf16x8*)(lds + PG8_SB(b, h) + boff + n * 2048 + k * 1024); } while (0)
#define PG8_LD8(p_) __builtin_shufflevector(*(const LAS v4i_g*)(p_), *(const LAS v4i_g*)((p_) + 1024), 0, 1, 2, 3, 4, 5, 6, 7)
#define PG8_LDA8(dst, b, h) do { _Pragma("unroll") for (int m = 0; m < 4; ++m) dst[m] = PG8_LD8(lds + PG8_SA(b, h) + aoff + m * 2048); } while (0)
#define PG8_LDB8(dst, b, h) do { _Pragma("unroll") for (int n = 0; n < 2; ++n) dst[n] = PG8_LD8(lds + PG8_SB(b, h) + boff + n * 2048); } while (0)
#define PG8_MMA16(ai, bj, At, Bt) do { __builtin_amdgcn_s_setprio(1); _Pragma("unroll") for (int m = 0; m < 4; ++m) _Pragma("unroll") for (int n = 0; n < 2; ++n) _Pragma("unroll") for (int k = 0; k < 2; ++k) \
        acc[ai][bj][m][n] = __builtin_amdgcn_mfma_f32_16x16x32_bf16(Bt[n][k], At[m][k], acc[ai][bj][m][n], 0, 0, 0); __builtin_amdgcn_s_setprio(0); } while (0)
#define PG8_MMA8(ai, bj, At, Bt) do { __builtin_amdgcn_s_setprio(1); _Pragma("unroll") for (int m = 0; m < 4; ++m) _Pragma("unroll") for (int n = 0; n < 2; ++n) \
        asm volatile("v_mfma_scale_f32_16x16x128_f8f6f4 %0, %1, %2, %0, %3, %3 op_sel_hi:[0,0,0]" : "+v"(acc[ai][bj][m][n]) : "v"(Bt[n]), "v"(At[m]), "v"(sc8_)); __builtin_amdgcn_s_setprio(0); } while (0)
#define PG8_WAIT_V(n) asm volatile("s_waitcnt vmcnt(" #n ")" ::: "memory")
#define PG8_WAIT_L(n) asm volatile("s_waitcnt lgkmcnt(" #n ")" ::: "memory")
#define PG8_BAR __builtin_amdgcn_s_barrier()
#define PG8_SCHED __builtin_amdgcn_sched_barrier(0)
    Unit cur;
    if (!S.next(0, cur)) return;
    f32x4 acc[2][2][4][2];
#define PG8_ZERO() do { _Pragma("unroll") for (int a = 0; a < 2; ++a) _Pragma("unroll") for (int b = 0; b < 2; ++b) _Pragma("unroll") for (int m = 0; m < 4; ++m) _Pragma("unroll") for (int n = 0; n < 2; ++n) acc[a][b][m][n] = (f32x4){0.f, 0.f, 0.f, 0.f}; } while (0)
    PG8_ZERO();
    bf16x8 At[4][2], B0[2][2], B1[2][2];
    const char* cA = (const char*)g0.A + (size_t)cur.pm * (2 * hA0); const char* cB = (const char*)g0.Bt + (size_t)cur.pn * (2 * hB0);
    unsigned voffA[2], voffB[2]; PG8_MKOFF(voffA, voffB, g0); const size_t hA = hA0, hB = hB0;
    PG8_STAGE(PG8_SB(0, 0), cB, voffB); PG8_STAGE(PG8_SB(0, 1), cB + hB, voffB); PG8_STAGE(PG8_SA(0, 0), cA, voffA); PG8_STAGE(PG8_SA(0, 1), cA + hA, voffA);
    if (wr == 1) PG8_BAR;
    PG8_WAIT_V(2); PG8_BAR;
    PG8_STAGE(PG8_SB(1, 0), cB + kstep, voffB); PG8_STAGE(PG8_SA(1, 0), cA + kstep, voffA); PG8_STAGE(PG8_SB(1, 1), cB + hB + kstep, voffB);
    PG8_WAIT_V(6); PG8_BAR;
#define PG8_KLOOP(MMA, LDA_, LDB_, At, B0, B1, NT, HASNEXT) do { const int nt = (NT);                                                                            \
        const char* nA = (HASNEXT) ? (const char*)g1.A + (size_t)cur.pm * (2 * hA1) : cA; const char* nB = (HASNEXT) ? (const char*)g1.Bt + (size_t)cur.pn * (2 * hB1) : cB; \
        for (int t = 0; t < nt; t += 2) {                                                                                              \
            const bool last = (t == nt - 2);                                                                                           \
            const char* a1 = cA + (size_t)(t + 1) * kstep;                                                                             \
            const char* a2 = last ? nA : cA + (size_t)(t + 2) * kstep; const char* b2 = last ? nB : cB + (size_t)(t + 2) * kstep;       \
            const char* a3 = a2 + kstep; const char* b3 = b2 + kstep;                                                                  \
            LDB_(B0, 0, 0); LDB_(B1, 0, 1); PG8_SCHED; LDA_(At, 0, 0); PG8_STAGE(PG8_SA(1, 1), a1 + hA, voffA);                \
            PG8_WAIT_V(8); PG8_WAIT_L(0); PG8_BAR; MMA(0, 0, At, B0); MMA(0, 1, At, B1); PG8_BAR; PG8_SCHED;                            \
            LDA_(At, 0, 1); PG8_STAGE(PG8_SB(0, 0), b2, voffB); PG8_STAGE(PG8_SB(0, 1), b2 + hB, voffB); PG8_STAGE(PG8_SA(0, 0), a2, voffA); \
            PG8_WAIT_V(8); PG8_WAIT_L(0); PG8_BAR; MMA(1, 0, At, B0); MMA(1, 1, At, B1); PG8_BAR; PG8_SCHED;                            \
            LDB_(B0, 1, 0); LDB_(B1, 1, 1); PG8_SCHED; LDA_(At, 1, 0); PG8_STAGE(PG8_SA(0, 1), a2 + hA, voffA);              \
            PG8_WAIT_V(8); PG8_WAIT_L(0); PG8_BAR; MMA(0, 0, At, B0); MMA(0, 1, At, B1); PG8_BAR; PG8_SCHED;                            \
            LDA_(At, 1, 1); PG8_STAGE(PG8_SB(1, 0), b3, voffB); PG8_STAGE(PG8_SB(1, 1), b3 + hB, voffB); PG8_STAGE(PG8_SA(1, 0), a3, voffA); \
            PG8_WAIT_V(8); PG8_WAIT_L(0); PG8_BAR; MMA(1, 0, At, B0); MMA(1, 1, At, B1); PG8_BAR; PG8_SCHED;                            \
        }                                                                                                                              \
        if (HASNEXT) { cA = nA; cB = nB; } } while (0)
    PG8_KLOOP(PG8_MMA16, PG8_LDA, PG8_LDB, At, B0, B1, g0.K / BK, true);
    if (wr == 0) PG8_BAR;
    E(acc, cur, 0, wr, wc, fr, fq);
    PG8_ZERO();
    { tid = otid(); const int l2 = tid & 63, w2 = __builtin_amdgcn_readfirstlane(tid >> 6);
      ldsw = (unsigned)w2 * 1024u; aoff = lds_byte((w2 >> 2) * 64 + (l2 & 15), (l2 >> 4) * 8); boff = lds_byte((w2 & 3) * 32 + (l2 & 15), (l2 >> 4) * 8); PG8_MKOFF(voffA, voffB, g1); }
    if (wr == 1) PG8_BAR;
    { v8i_g At8[4], B08[2], B18[2]; const int sc8_ = 0x7F7F7F7F;
      PG8_KLOOP(PG8_MMA8, PG8_LDA8, PG8_LDB8, At8, B08, B18, g1.K / BK, false); }
    asm volatile("s_nop 15\n\ts_nop 7" ::: "memory");
    if (wr == 0) PG8_BAR;
    E(acc, cur, 1, wr, wc, fr, fq);
    PG8_WAIT_V(0);
    PG8_BAR;
#undef PG8_KLOOP
#undef PG8_ZERO
#undef PG8_MMA16
#undef PG8_MMA8
#undef PG8_SA
#undef PG8_SB
#undef PG8_STAGE
#undef PG8_LDA
#undef PG8_LDB
#undef PG8_WAIT_V
#undef PG8_WAIT_L
#undef PG8_BAR
#undef PG8_SCHED
#undef PG8_MKOFF
#undef PG8_LD8
#undef PG8_LDA8
#undef PG8_LDB8
}
}

typedef f32x4 Acc[2][2][4][2];
__device__ __forceinline__ u32x4 pack8(f32x4 a, f32x4 b) { u32x4 w; w.x = cvtpk(a[0], a[1]); w.y = cvtpk(a[2], a[3]); w.z = cvtpk(b[0], b[1]); w.w = cvtpk(b[2], b[3]); return w; }
__device__ __forceinline__ void unpack8(u32x4 w, f32x4& a, f32x4& b) { a = (f32x4){bflo(w.x), bfhi(w.x), bflo(w.y), bfhi(w.y)}; b = (f32x4){bflo(w.z), bfhi(w.z), bflo(w.w), bfhi(w.w)}; }

struct EpiInProj {
    unsigned char* ws; bf16_t* gm; const float* bmerge; int pn_off;
    __device__ __forceinline__ void operator()(const Acc& acc, const pg8::Unit& u, int wr, int wc, int fr, int fq) const {
        const int pn = u.pn + pn_off;
        bf16_t* dst; int ldc, cb, mode; size_t bjs = 128; unsigned char* dst8 = nullptr; float ascale = 1.0f;
        if (pn < 4)       { dst = (bf16_t*)(ws + WS_U);   ldc = 1024; cb = pn * 256;        mode = 0; }
        else if (pn < 8)  { dst = (bf16_t*)(ws + WS_GP);  ldc = 1024; cb = (pn - 4) * 256;  mode = 1; }
        else if (pn < 12) { const int k = (pn - 8) >> 1; dst = (bf16_t*)(ws + WS_KCR + (size_t)k * (8 * MiB)); mode = 0;
                            ldc = 128; cb = 0; bjs = (size_t)S * 128; dst += (size_t)((pn - 8) & 1) * 2 * S * 128; }
        else if (pn < 20) { dst = (bf16_t*)(ws + WS_GN);  ldc = 2048; cb = (pn - 12) * 256; mode = 1; }
        else if (pn < 36) { dst = gm;                     ldc = 4096; cb = (pn - 20) * 256; mode = 2; }
        else if (pn < 37) { dst = (bf16_t*)(ws + WS_GBR); ldc = 256;  cb = 0;               mode = 4; }
        else if (pn < 45) { dst = (bf16_t*)(ws + WS_Q);   ldc = 2048; cb = (pn - 37) * 256; mode = 3; dst8 = ws + WS_Q8; ascale = 1.0f / W8_SCALE; }
        else              { const int k = (pn - 45) >> 1;
                            dst = nullptr; dst8 = ws + (k == 0 ? WS_K8S : k == 1 ? WS_V8S : k == 2 ? WS_K8W : WS_V8W); ldc = 512; cb = ((pn - 45) & 1) * 256; mode = (k == 0 || k == 2) ? 3 : 0; ascale = 1.0f / W8_SCALE; }
        const int row0 = u.pm * 256 + wr * 64 + fr, cl = wc * 32 + 8 * fq, col0 = cb + cl;
        const float* rcos = (const float*)(ws + WS_ROPE); const float* rsin = rcos + (size_t)S * 64;
#pragma unroll
        for (int ai = 0; ai < 2; ++ai)
#pragma unroll
            for (int m = 0; m < 4; ++m) {
                const int row = row0 + ai * 128 + m * 16;
                bf16_t* rowp = dst + (size_t)row * ldc + col0;
                f32x4 cs0, cs1, sn0, sn1;
                if (mode == 3) { const int i0 = (cl & 127) >> 1; cs0 = *(const f32x4*)(rcos + (size_t)row * 64 + i0); sn0 = *(const f32x4*)(rsin + (size_t)row * 64 + i0); }
#pragma unroll
                for (int bj = 0; bj < 2; ++bj) {
                    f32x4 v0 = acc[ai][bj][m][0] * ascale, v1 = acc[ai][bj][m][1] * ascale;
                    if (mode == 1) { for (int e = 0; e < 4; ++e) { v0[e] = siluf_(v0[e]); v1[e] = siluf_(v1[e]); } }
                    else if (mode == 2 || mode == 4) { if (mode == 2) { v0 = v0 + *(const f32x4*)(bmerge + col0 + bj * 128); v1 = v1 + *(const f32x4*)(bmerge + col0 + bj * 128 + 4); } for (int e = 0; e < 4; ++e) { v0[e] = sigmoidf_(v0[e]); v1[e] = sigmoidf_(v1[e]); } }
                    else if (mode == 3) {
                        f32x4 o0, o1;
                        o0[0] = v0[0] * cs0[0] - v0[1] * sn0[0]; o0[1] = v0[1] * cs0[0] + v0[0] * sn0[0];
                        o0[2] = v0[2] * cs0[1] - v0[3] * sn0[1]; o0[3] = v0[3] * cs0[1] + v0[2] * sn0[1];
                        o1[0] = v1[0] * cs0[2] - v1[1] * sn0[2]; o1[1] = v1[1] * cs0[2] + v1[0] * sn0[2];
                        o1[2] = v1[2] * cs0[3] - v1[3] * sn0[3]; o1[3] = v1[3] * cs0[3] + v1[2] * sn0[3];
                        v0 = o0; v1 = o1;
                    }
                    if (dst) *(u32x4*)(rowp + bj * bjs) = pack8(v0, v1);
                    if (dst8) { u32x2 w8; w8.x = cvt4_fp8(sat8(v0[0]), sat8(v0[1]), sat8(v0[2]), sat8(v0[3])); w8.y = cvt4_fp8(sat8(v1[0]), sat8(v1[1]), sat8(v1[2]), sat8(v1[3])); *(u32x2*)(dst8 + (size_t)row * ldc + col0 + bj * 128) = w8; }
                }
            }
    }
};
struct EpiYa {
    bf16_t* yag; const bf16_t* gm;
    __device__ __forceinline__ void operator()(const Acc& acc, const pg8::Unit& u, int wr, int wc, int fr, int fq) const {
        const int row0 = u.pm * 256 + wr * 64 + fr, col0 = u.pn * 256 + wc * 32 + 8 * fq;
#pragma unroll
        for (int ai = 0; ai < 2; ++ai)
#pragma unroll
            for (int m = 0; m < 4; ++m) { int ro_ = ai * 128 + m * 16; asm volatile("" : "+v"(ro_)); const size_t r = (size_t)(row0 + ro_);
#pragma unroll
                for (int bj = 0; bj < 2; ++bj) { f32x4 g0, g1; unpack8(*(const u32x4*)(gm + r * 4096 + col0 + bj * 128), g0, g1);
                    *(u32x4*)(yag + r * 2048 + col0 + bj * 128) = pack8(acc[ai][bj][m][0] * g0, acc[ai][bj][m][1] * g1); }
                if (m & 1) asm volatile("" ::: "memory"); }
    }
};
struct EpiYb {
    bf16_t* merged; const bf16_t* yag; const bf16_t* gm; float ascale;
    __device__ __forceinline__ void operator()(const Acc& acc, const pg8::Unit& u, int wr, int wc, int fr, int fq) const {
        const int row0 = u.pm * 256 + wr * 64 + fr, col0 = u.pn * 256 + wc * 32 + 8 * fq;
#pragma unroll
        for (int ai = 0; ai < 2; ++ai)
#pragma unroll
            for (int m = 0; m < 4; ++m) { int ro_ = ai * 128 + m * 16; asm volatile("" : "+v"(ro_)); const size_t r = (size_t)(row0 + ro_);
#pragma unroll
                for (int bj = 0; bj < 2; ++bj) { f32x4 g0, g1, y0, y1; unpack8(*(const u32x4*)(gm + r * 4096 + 2048 + col0 + bj * 128), g0, g1);
                    unpack8(*(const u32x4*)(yag + r * 2048 + col0 + bj * 128), y0, y1);
                    *(u32x4*)(merged + r * 2048 + col0 + bj * 128) = pack8(y0 + acc[ai][bj][m][0] * ascale * g0, y1 + acc[ai][bj][m][1] * ascale * g1); }
                if (m & 1) asm volatile("" ::: "memory"); }
    }
};
struct EpiYaYb {
    EpiYa ya; EpiYb yb;
    __device__ __forceinline__ void operator()(const Acc& acc, const pg8::Unit& u, int kind, int wr, int wc, int fr, int fq) const {
        if (kind == 0) { ya(acc, u, wr, wc, fr, fq); asm volatile("s_waitcnt vmcnt(0)" ::: "memory"); } else yb(acc, u, wr, wc, fr, fq);
    }
};
constexpr int NSPLIT = 8;
struct EpiSlab {
    float* slab;
    __device__ __forceinline__ void operator()(const Acc& acc, const pg8::Unit& u, int wr, int wc, int fr, int fq) const {
        float* base = slab + ((size_t)((u.pm >> 3) * NSPLIT + u.pn) * 2048 + (size_t)(u.pm & 7) * 256 + wr * 64 + fr) * 256 + wc * 32 + 8 * fq;
#pragma unroll
        for (int ai = 0; ai < 2; ++ai)
#pragma unroll
            for (int m = 0; m < 4; ++m)
#pragma unroll
                for (int bj = 0; bj < 2; ++bj) { float* p = base + (size_t)(ai * 128 + m * 16) * 256 + bj * 128; *(f32x4*)p = acc[ai][bj][m][0]; *(f32x4*)(p + 4) = acc[ai][bj][m][1]; }
    }
};
constexpr int CW_PANEL = 16384;
constexpr int EPI_LDS_OFF = RING_BYTES + 1024;
struct EpiOut {
    float* out; const float* x; float* ssq; const float* fw; unsigned* ctl; LAS unsigned char* lds;
    __device__ __forceinline__ void operator()(const Acc& acc_, const pg8::Unit& u, int wr, int wc, int fr, int fq) const {
        Acc& acc = const_cast<Acc&>(acc_);
        const int tid = otid();
        const int row0 = u.pm * 256 + wr * 64 + fr, col0 = u.pn * 256 + wc * 32 + 8 * fq;
        LAS float* rs = (LAS float*)(lds + EPI_LDS_OFF);
#pragma unroll
        for (int ai = 0; ai < 2; ++ai)
#pragma unroll
            for (int m = 0; m < 4; ++m) { const size_t r = (size_t)(row0 + ai * 128 + m * 16); float q = 0.f;
#pragma unroll
                for (int bj = 0; bj < 2; ++bj)
#pragma unroll
                    for (int n = 0; n < 2; ++n) { const size_t o = r * 2048 + col0 + bj * 128 + 4 * n; const f32x4 v = *(const f32x4*)(x + o) + acc[ai][bj][m][n];
                        acc[ai][bj][m][n] = v; q += (v[0] * v[0] + v[1] * v[1]) + (v[2] * v[2] + v[3] * v[3]); }
                q += __shfl_xor(q, 16); q += __shfl_xor(q, 32);
                if (fq == 0) __hip_atomic_store((unsigned*)(ssq + (size_t)(u.pn * 4 + wc) * S + r), __float_as_uint(q), __ATOMIC_RELAXED, __HIP_MEMORY_SCOPE_AGENT); }
        asm volatile("s_waitcnt vmcnt(0)" ::: "memory");
        __syncthreads();
        if (tid == 0) { unsigned* c = ctl + CW_PANEL + 64 * u.pm;
            __hip_atomic_fetch_add(c, 1u, __ATOMIC_RELAXED, __HIP_MEMORY_SCOPE_AGENT);
            unsigned sp = 0; while (__hip_atomic_load(c, __ATOMIC_RELAXED, __HIP_MEMORY_SCOPE_AGENT) < 8u) { __builtin_amdgcn_s_sleep(2); if (++sp > (1u << 22)) break; }
            __builtin_amdgcn_fence(__ATOMIC_ACQUIRE, "agent"); asm volatile("s_waitcnt vmcnt(0)" ::: "memory"); }
        __syncthreads();
        if (tid < 256) { const size_t r = (size_t)u.pm * 256 + tid; float s = 0.f;
#pragma unroll 8
            for (int p = 0; p < 32; ++p) s += __uint_as_float(__hip_atomic_load((unsigned*)(ssq + (size_t)p * S + r), __ATOMIC_RELAXED, __HIP_MEMORY_SCOPE_AGENT));
            rs[tid] = 1.0f / sqrtf(s * (1.f / DM) + EPS); }
        __syncthreads();
#pragma unroll
        for (int ai = 0; ai < 2; ++ai)
#pragma unroll
            for (int m = 0; m < 4; ++m) { const int rl = wr * 64 + fr + ai * 128 + m * 16; const float sc = rs[rl]; const size_t r = (size_t)u.pm * 256 + rl;
#pragma unroll
                for (int bj = 0; bj < 2; ++bj)
#pragma unroll
                    for (int n = 0; n < 2; ++n) { const size_t o = r * 2048 + col0 + bj * 128 + 4 * n; *(f32x4*)(out + o) = acc[ai][bj][m][n] * sc * *(const f32x4*)(fw + col0 + bj * 128 + 4 * n); } }
    }
};

struct Args { const float* in[17]; float* out; unsigned char* ws; int ph_lo, ph_hi; };
struct Frame { LAS unsigned char* lds; int tid, lane, wave, vcu, G; };

__device__ __forceinline__ int ropeperm(int d) { return d < 64 ? 2 * d : 2 * (d - 64) + 1; }
__device__ __forceinline__ void transpose_item(const float* W, int ldw, int Nvalid, bf16_t* WT, int ldt, int row_off, bool perm, LAS float* scr, int kb, int nb, int lane, float f8scale = 0.f) {
    const int k0 = 64 * kb, n0 = 32 * nb, cq = lane & 7, rb = lane >> 3; const bool ok = n0 + cq * 4 < Nvalid;
    f32x4 v[8];
#pragma unroll
    for (int i = 0; i < 8; ++i) v[i] = ok ? *(const f32x4*)(W + (size_t)(k0 + i * 8 + rb) * ldw + n0 + cq * 4) : (f32x4){0.f, 0.f, 0.f, 0.f};
#pragma unroll
    for (int i = 0; i < 8; ++i) *(LAS f32x4*)(scr + (i * 8 + rb) * 32 + ((cq ^ i) << 2)) = v[i];
    LDS_WAIT(); asm volatile("" ::: "memory");
#pragma unroll
    for (int j = 0; j < 4; ++j) { const int idx = lane + 64 * j, n = idx >> 3, c = idx & 7; const LAS float* s = scr + (8 * c) * 32 + ((((n >> 2) ^ c) << 2) | (n & 3));
        u32x4 o; o.x = cvtpk(s[0 * 32], s[1 * 32]); o.y = cvtpk(s[2 * 32], s[3 * 32]); o.z = cvtpk(s[4 * 32], s[5 * 32]); o.w = cvtpk(s[6 * 32], s[7 * 32]);
        const int ng = n0 + n;
        if (ng < Nvalid) { const int dr = perm ? ((ng & ~127) | ropeperm(ng & 127)) : ng;
            if (f8scale > 0.f) { u32x2 o8; o8.x = cvt4_fp8(sat8(s[0 * 32] * f8scale), sat8(s[1 * 32] * f8scale), sat8(s[2 * 32] * f8scale), sat8(s[3 * 32] * f8scale)); o8.y = cvt4_fp8(sat8(s[4 * 32] * f8scale), sat8(s[5 * 32] * f8scale), sat8(s[6 * 32] * f8scale), sat8(s[7 * 32] * f8scale));
                *(GAS u32x2*)((unsigned char*)WT + (size_t)(row_off + dr) * ldt + k0 + 8 * c) = o8; }
            else *(GAS u32x4*)(WT + (size_t)(row_off + dr) * ldt + k0 + 8 * c) = o; } }
    LDS_WAIT(); asm volatile("" ::: "memory");
}

__device__ __forceinline__ void p0_prologue(const Frame& F, const Args& a) {
    unsigned char* ws = a.ws;
    LAS float* scr = (LAS float*)(F.lds + F.wave * 8192);
    const int gw = F.vcu * NWAVES + F.wave, NGW = F.G * NWAVES, lane = F.lane;
    constexpr int I_WIN = 32 * 258, I_WM = 32 * 128;
    for (int it = gw; it < I_WIN + I_WM; it += NGW) {
        int r = it;
        if (r < I_WIN) { const int kb = r / 258, nb = 32 + r % 258, n0 = nb * 32;
            const bool perm = (n0 >= 2048 && n0 < 4096) || (n0 >= 5120 && n0 < 5632) || (n0 >= 6144 && n0 < 6656);
            if (n0 >= 2048 && n0 < 4096) transpose_item(a.in[2], 9264, 9264, (bf16_t*)(ws + WS_W8), 2048, -2048, perm, scr, kb, nb, lane, W8_SCALE);
            else if (n0 >= 5120 && n0 < 7168) transpose_item(a.in[2], 9264, 9264, (bf16_t*)(ws + WS_W8), 2048, -3072, perm, scr, kb, nb, lane, W8_SCALE);
            else transpose_item(a.in[2], 9264, 9264, (bf16_t*)(ws + WS_WCAT), 2048, n0 < 2048 ? 0 : n0 < 5120 ? -2048 : (nb >= 288 ? 0 : -4096), perm, scr, kb, nb, lane);
            continue; } r -= I_WIN;
        transpose_item(a.in[13], 4096, 4096, (bf16_t*)(ws + WS_WCAT), 2048, 5120, false, scr, r / 128, r % 128, lane);
    }
    {
        const float* win = a.in[2]; const float* mix = a.in[3]; bf16_t* WC = (bf16_t*)(ws + WS_WCAT); const int r = lane & 31, hh = lane >> 5;
        for (int it = gw; it < 1024; it += NGW) {
            const int g = it >> 8, d0 = ((it >> 5) & 7) * 32, kin0 = (it & 31) * 64;
            f32x16 acc0 = f32x16{}, acc1 = f32x16{};
            const float* ap = mix + (size_t)g * 65536 + (size_t)(8 * hh) * 256 + d0 + r;
            const float* bp0 = win + (size_t)(kin0 + r) * 9264 + g * 256 + 8 * hh; const float* bp1 = bp0 + (size_t)32 * 9264;
#pragma unroll 4
            for (int k = 0; k < 16; ++k) {
                f32x4 a0, a1;
#pragma unroll
                for (int j = 0; j < 4; ++j) { a0[j] = ap[(size_t)(k * 16 + j) * 256]; a1[j] = ap[(size_t)(k * 16 + 4 + j) * 256]; }
                const u32x4 af = pack8(a0, a1), b0 = pack8(*(const f32x4*)(bp0 + k * 16), *(const f32x4*)(bp0 + k * 16 + 4)), b1 = pack8(*(const f32x4*)(bp1 + k * 16), *(const f32x4*)(bp1 + k * 16 + 4));
                acc0 = __builtin_amdgcn_mfma_f32_32x32x16_bf16(__builtin_bit_cast(bf16x8, af), __builtin_bit_cast(bf16x8, b0), acc0, 0, 0, 0);
                acc1 = __builtin_amdgcn_mfma_f32_32x32x16_bf16(__builtin_bit_cast(bf16x8, af), __builtin_bit_cast(bf16x8, b1), acc1, 0, 0, 0);
            }
#pragma unroll
            for (int e = 0; e < 16; ++e) { int ee = e; asm volatile("" : "+v"(ee)); bf16_t* rowp = WC + (size_t)(g * 256 + d0 + crow(ee, hh)) * 2048 + kin0 + r;
                const float v0 = acc0[e], v1 = acc1[e], n0_ = dpp_x1f(v0), n1_ = dpp_x1f(v1);
                if ((r & 1) == 0) { *(unsigned*)rowp = cvtpk(v0, n0_); *(unsigned*)(rowp + 32) = cvtpk(v1, n1_); } }
        }
    }
    for (int i = gw * 64 + lane; i < 53248; i += NGW * 64) *(GAS u32x4*)(ws + WS_WCAT + (size_t)9264 * 4096 + (size_t)i * 16) = (u32x4){0u, 0u, 0u, 0u};
    {
        const float* x = a.in[0]; const float* nw = a.in[1]; bf16_t* H = (bf16_t*)(ws + WS_H); unsigned char* H8 = ws + WS_H8;
        f32x4 wv[8];
#pragma unroll
        for (int j = 0; j < 8; ++j) wv[j] = *((const f32x4*)nw + lane + 64 * j);
        for (int m = gw; m < S; m += NGW) {
            const f32x4* xr = (const f32x4*)(x + (size_t)m * DM) + lane; f32x4 v[8]; float s = 0.f;
#pragma unroll
            for (int j = 0; j < 8; ++j) { v[j] = xr[64 * j]; s += (v[j][0] * v[j][0] + v[j][1] * v[j][1]) + (v[j][2] * v[j][2] + v[j][3] * v[j][3]); }
            const float rstd = 1.0f / sqrtf(wave_sum(s) * (1.f / DM) + EPS);
            u32x2* o = (u32x2*)(H + (size_t)m * DM) + lane;
#pragma unroll
            for (int j = 0; j < 8; ++j) { const f32x4 y = v[j] * rstd * wv[j]; u32x2 w; w.x = cvtpk(y[0], y[1]); w.y = cvtpk(y[2], y[3]); o[64 * j] = w;
                *(unsigned*)(H8 + (size_t)m * DM + (lane + 64 * j) * 4) = cvt4_fp8(sat8(y[0]), sat8(y[1]), sat8(y[2]), sat8(y[3])); }
        }
    }
    {
        float* rcos = (float*)(ws + WS_ROPE); float* rsin = rcos + (size_t)S * 64;
        for (int e = gw * 64 + lane; e < S * 64; e += NGW * 64) {
            const int pos = e >> 6, i = e & 63;
            double inv = 1.0, b = 0.86596432336006535;
            for (int k = i; k; k >>= 1) { if (k & 1) inv *= b; b *= b; }
            const double t = (double)pos * inv * 0.15915494309189535;
            const float fr = (float)(t - floor(t));
            rcos[e] = __builtin_amdgcn_cosf(fr); rsin[e] = __builtin_amdgcn_sinf(fr);
        }
    }
}
__device__ __forceinline__ void p1_late_weights(const Frame& F, const Args& a, int cw, int NCW) {
    unsigned char* ws = a.ws;
    LAS float* scr = (LAS float*)(F.lds + F.wave * 8192);
    const int lane = F.lane;
    constexpr int I_NO = 32 * 64, I_O = 32 * 64, I_PO = 16 * 64, I_W1 = 64 * 8, I_W2 = 4 * 4, I_B1 = 512;
    constexpr int NITEMS = I_NO + I_O + I_PO + 2 * I_W1 + 2 * I_W2 + I_B1;
    for (int it = cw; it < NITEMS; it += NCW) {
        int r = it;
        if (r < I_W1) { transpose_item(a.in[6], 256, 256, (bf16_t*)(ws + WS_W1KT), 4096, 0, false, scr, r / 8, r % 8, lane); continue; } r -= I_W1;
        if (r < I_W1) { transpose_item(a.in[9], 256, 256, (bf16_t*)(ws + WS_W1VT), 4096, 0, false, scr, r / 8, r % 8, lane); continue; } r -= I_W1;
        if (r < I_B1) {
            const int which = r >> 8, fb = (r >> 6) & 3, ch = r & 63, f = fb * 64 + lane;
            const float* pe = a.in[which ? 8 : 5]; const float* w1 = a.in[which ? 9 : 6]; float s = 0.f;
#pragma unroll 16
            for (int k = ch * 64; k < ch * 64 + 64; ++k) s += pe[k] * w1[(size_t)k * 256 + f];
            ((float*)(ws + WS_B1P))[(which * 64 + ch) * 256 + f] = s; continue; } r -= I_B1;
        if (r < I_W2) { transpose_item(a.in[7], 128, 128, (bf16_t*)(ws + WS_W2KT), 256, 0, true, scr, r / 4, r % 4, lane); continue; } r -= I_W2;
        if (r < I_W2) { transpose_item(a.in[10], 128, 128, (bf16_t*)(ws + WS_W2VT), 256, 0, false, scr, r / 4, r % 4, lane); continue; } r -= I_W2;
        if (r < I_PO) { transpose_item(a.in[11], 2048, 2048, (bf16_t*)(ws + WS_WPOT), 1024, 0, false, scr, r / 64, r % 64, lane); continue; } r -= I_PO;
        if (r < I_NO) { transpose_item(a.in[12], 2048, 2048, (bf16_t*)(ws + WS_WNOT), 2048, 0, false, scr, r / 64, r % 64, lane, WNO_SCALE); continue; } r -= I_NO;
        transpose_item(a.in[15], 2048, 2048, (bf16_t*)(ws + WS_WOT), 2048, 0, false, scr, r / 64, r % 64, lane);
    }
}

template <int W>
__device__ __forceinline__ void ypool_item(const bf16_t* __restrict__ U, const bf16_t* __restrict__ GP, bf16_t* __restrict__ Y, const float* __restrict__ scale, int c, int t0) {
    u32x4 x[W + 7], gq[8];
#pragma unroll
    for (int k = 0; k < W + 7; ++k) { const int r = t0 - (W - 1) + k; x[k] = r >= 0 ? *(const u32x4*)(U + (size_t)r * 1024 + c) : (u32x4){0u, 0u, 0u, 0u}; }
#pragma unroll
    for (int k = 0; k < 8; ++k) gq[k] = *(const u32x4*)(GP + (size_t)(t0 + k) * 1024 + c);
    const f32x4 sc0 = *(const f32x4*)(scale + c), sc1 = *(const f32x4*)(scale + c + 4);
    f32x4 s0 = {0.f, 0.f, 0.f, 0.f}, s1 = s0, a0, a1;
#pragma unroll
    for (int k = 0; k < W - 1; ++k) { unpack8(x[k], a0, a1); s0 = s0 + a0; s1 = s1 + a1; }
#pragma unroll
    for (int k = 0; k < 8; ++k) { const int t = t0 + k;
        unpack8(x[W - 1 + k], a0, a1); s0 = s0 + a0; s1 = s1 + a1;
        const int cnt = (t + 1 < W) ? t + 1 : W; const float ic = 1.0f / (float)cnt;
        f32x4 g0, g1; unpack8(gq[k], g0, g1);
        *(u32x4*)(Y + (size_t)t * 1024 + c) = pack8((s0 * ic - a0) * sc0 * g0, (s1 * ic - a1) * sc1 * g1);
        f32x4 b0, b1; unpack8(x[k], b0, b1); s0 = s0 - b0; s1 = s1 - b1; }
}
__device__ __forceinline__ void p2_ypool(const Frame& F, unsigned char* ws, const float* __restrict__ scale, int cw, int NCW) {
    const bf16_t* __restrict__ U = (const bf16_t*)(ws + WS_U); const bf16_t* __restrict__ GP = (const bf16_t*)(ws + WS_GP); bf16_t* __restrict__ Y = (bf16_t*)(ws + WS_H + 16 * MiB);
    for (int wi = cw; wi < 4 * 512; wi += NCW) {
        const int g = wi & 3, t0 = ((wi >> 2) * 2 + (F.lane >> 5)) * 8, c = (g * 32 + (F.lane & 31)) * 8;
        if (g == 0) ypool_item<2>(U, GP, Y, scale, c, t0); else if (g == 1) ypool_item<4>(U, GP, Y, scale, c, t0);
        else if (g == 2) ypool_item<8>(U, GP, Y, scale, c, t0); else ypool_item<16>(U, GP, Y, scale, c, t0);
    }
}
__device__ __forceinline__ void p2_vt8(const Frame& F, unsigned char* ws, int cw, int NCW) {
    const int lane = F.lane;
    for (int it = cw; it < 1024; it += NCW) {
        const int which = it >> 9, h = (it >> 7) & 3, j = it & 127;
        const unsigned char* V8 = ws + (which ? WS_V8W : WS_V8S) + (size_t)(64 * j) * 512 + h * 128 + 2 * lane;
        unsigned char* T = ws + (which ? WS_V8TW : WS_V8TS) + (size_t)(h * 128 + j) * 8192 + (size_t)(2 * lane) * 64;
#pragma unroll
        for (int hb = 0; hb < 2; ++hb) {
            unsigned short e[32];
#pragma unroll
            for (int jj = 0; jj < 32; ++jj) { const int key = jj < 16 ? crow(jj, hb) : 32 + crow(jj - 16, hb); e[jj] = *(const unsigned short*)(V8 + (size_t)key * 512); }
            u32x4 a0, a1, b0, b1;
#pragma unroll
            for (int q = 0; q < 4; ++q) {
                a0[q] = (unsigned)(e[4*q] & 0xff) | ((unsigned)(e[4*q+1] & 0xff) << 8) | ((unsigned)(e[4*q+2] & 0xff) << 16) | ((unsigned)(e[4*q+3] & 0xff) << 24);
                a1[q] = (unsigned)(e[16+4*q] & 0xff) | ((unsigned)(e[16+4*q+1] & 0xff) << 8) | ((unsigned)(e[16+4*q+2] & 0xff) << 16) | ((unsigned)(e[16+4*q+3] & 0xff) << 24);
                b0[q] = (unsigned)(e[4*q] >> 8) | ((unsigned)(e[4*q+1] >> 8) << 8) | ((unsigned)(e[4*q+2] >> 8) << 16) | ((unsigned)(e[4*q+3] >> 8) << 24);
                b1[q] = (unsigned)(e[16+4*q] >> 8) | ((unsigned)(e[16+4*q+1] >> 8) << 8) | ((unsigned)(e[16+4*q+2] >> 8) << 16) | ((unsigned)(e[16+4*q+3] >> 8) << 24); }
            *(u32x4*)(T + hb * 32) = a0; *(u32x4*)(T + hb * 32 + 16) = a1; *(u32x4*)(T + 64 + hb * 32) = b0; *(u32x4*)(T + 64 + hb * 32 + 16) = b1;
        }
    }
}

__device__ __forceinline__ void p3_compress2(const Frame& F, unsigned char* ws, int cwg, int NCWG) {
    const int tid = F.tid, lane = F.lane, r = lane & 31, hh = lane >> 5, wave = F.wave;
    const float* rcos = (const float*)(ws + WS_ROPE); const float* rsin = rcos + (size_t)S * 64;
    LAS bf16_t* hl = (LAS bf16_t*)F.lds;
    for (int it = cwg; it < 128; it += NCWG) {
        const int which = it >> 6, rt = it & 63;
        { const int row = tid >> 4, f0 = (tid & 15) * 16;
          const float* sl = (const float*)(ws + WS_SLAB) + ((size_t)(which * NSPLIT) * 2048 + rt * 32 + row) * 256 + f0; const float* b1 = (const float*)(ws + WS_B1) + which * 256 + f0;
          f32x4 s[4];
#pragma unroll
          for (int q = 0; q < 4; ++q) s[q] = *(const f32x4*)(b1 + 4 * q);
#pragma unroll
          for (int ks = 0; ks < NSPLIT; ++ks)
#pragma unroll
              for (int q = 0; q < 4; ++q) s[q] = s[q] + *(const f32x4*)(sl + (size_t)ks * 2048 * 256 + 4 * q);
#pragma unroll
          for (int q = 0; q < 4; ++q)
#pragma unroll
              for (int e = 0; e < 4; ++e) s[q][e] = siluf_(s[q][e]);
          *(LAS u32x4*)(hl + row * 264 + f0) = pack8(s[0], s[1]); *(LAS u32x4*)(hl + row * 264 + f0 + 8) = pack8(s[2], s[3]); }
        __syncthreads();
        if (wave < 4) {
            const int ct = wave, row = rt * 32 + r;
            const bf16_t* W2 = (const bf16_t*)(ws + (which ? WS_W2VT : WS_W2KT)) + (size_t)(ct * 32 + r) * 256 + hh * 8;
            f32x16 acc = f32x16{};
#pragma unroll 4
            for (int k = 0; k < 16; ++k) acc = __builtin_amdgcn_mfma_f32_32x32x16_bf16(*(const bf16x8*)(W2 + k * 16), *(const LAS bf16x8*)(hl + r * 264 + k * 16 + hh * 8), acc, 0, 0, 0);
            const int n = row & 511; bf16_t* dst = (bf16_t*)(ws + (which ? WS_VC : WS_KC)) + (size_t)row * 128 + ct * 32 + 4 * hh;
            const int pos = (16 * n + 31) > S - 1 ? S - 1 : 16 * n + 31;
#pragma unroll
            for (int gq = 0; gq < 4; ++gq) {
                float v0 = acc[4 * gq], v1 = acc[4 * gq + 1], v2 = acc[4 * gq + 2], v3 = acc[4 * gq + 3];
                if (which == 0) { const int i = (ct * 32 + 8 * gq + 4 * hh) >> 1; const float c0 = rcos[(size_t)pos * 64 + i], s0 = rsin[(size_t)pos * 64 + i], c1 = rcos[(size_t)pos * 64 + i + 1], s1 = rsin[(size_t)pos * 64 + i + 1];
                    const float o0 = v0 * c0 - v1 * s0, o1 = v1 * c0 + v0 * s0, o2 = v2 * c1 - v3 * s1, o3 = v3 * c1 + v2 * s1; v0 = o0; v1 = o1; v2 = o2; v3 = o3; }
                u32x2 w; w.x = cvtpk(v0, v1); w.y = cvtpk(v2, v3); if (n == 511) { w.x = 0u; w.y = 0u; }
                *(u32x2*)(dst + 8 * gq) = w;
            }
        }
        __syncthreads();
    }
}

namespace nsa {
constexpr int SHM_V = 16384, SHM_K = 16384;
constexpr int L_V = 0, L_K = 3 * SHM_V, L_WS = L_K + 2 * SHM_K, L_IMP = L_WS + NWAVES * 64 * 4, IMP_LD = 129, L_SELM = L_IMP + 64 * IMP_LD * 4, L_END = L_SELM + 64 * 8 * 2;
static_assert(L_END <= RING_BYTES, "attention LDS");
constexpr float SCALE = 0.08838834764831845f, C2 = 1.4426950408889634f * SCALE, THR = 8.f;
#define KSWZ(row, colB) ((row) * 256 + ((colB) ^ (((row) & 7) << 4)))
#define SBAR() __builtin_amdgcn_sched_barrier(0)
#define LADD(p, v) (void)__hip_atomic_fetch_add((p), (v), __ATOMIC_RELAXED, __HIP_MEMORY_SCOPE_WORKGROUP)
__device__ __forceinline__ int v_st(int k, int c) { const int kk = (k & ~0xC) | ((k & 4) << 1) | ((k & 8) >> 1); return ((kk >> 3) * 4 + (c >> 5)) * 512 + ((kk & 7) * 32 + (c & 31)) * 2; }
__device__ __forceinline__ int v_rd_base(int lane) { return ((lane & 3) << 3) | (((lane >> 2) & 3) << 6) | (((lane >> 4) & 1) << 5) | (((lane >> 5) & 1) << 8); }
constexpr int v_rd_off(int d0, int ks, int half) { return d0 * 512 + ks * 4096 + half * 2048; }
__device__ __forceinline__ unsigned cvtpk_a(float lo, float hi) { unsigned r; asm volatile("v_cvt_pk_bf16_f32 %0, %1, %2" : "=v"(r) : "v"(lo), "v"(hi)); return r; }

__device__ __forceinline__ void mask_range(f32x16& p0, f32x16& p1, int dq, unsigned Wn) {
    const float NEG = -__builtin_inff();
#pragma unroll
    for (int r = 0; r < 16; ++r) { const int c = (r & 3) + 8 * (r >> 2);
        if ((unsigned)(dq + c) >= Wn) p0[r] = NEG;
        if ((unsigned)(dq + c + 32) >= Wn) p1[r] = NEG; }
}
__device__ __forceinline__ void mask_row(f32x16& p0, f32x16& p1, bool keep) {
    const float NEG = -__builtin_inff();
#pragma unroll
    for (int r = 0; r < 16; ++r) { p0[r] = keep ? p0[r] : NEG; p1[r] = keep ? p1[r] : NEG; }
}
__device__ __forceinline__ float rowmax32(const f32x16& p0, const f32x16& p1) {
    float pmax = p0[0];
#pragma unroll
    for (int r = 1; r < 16; ++r) pmax = fmaxf(pmax, p0[r]);
#pragma unroll
    for (int r = 0; r < 16; ++r) pmax = fmaxf(pmax, p1[r]);
    auto rr = __builtin_amdgcn_permlane32_swap(__float_as_uint(pmax), __float_as_uint(pmax), false, false);
    return fmaxf(__uint_as_float(rr[0]), __uint_as_float(rr[1]));
}
__device__ __forceinline__ float rowsum32(const f32x16& p0, const f32x16& p1) {
    float ps = 0.f;
#pragma unroll
    for (int r = 0; r < 16; ++r) ps += p0[r];
#pragma unroll
    for (int r = 0; r < 16; ++r) ps += p1[r];
    auto rr = __builtin_amdgcn_permlane32_swap(__float_as_uint(ps), __float_as_uint(ps), false, false);
    return __uint_as_float(rr[0]) + __uint_as_float(rr[1]);
}
__device__ __forceinline__ void pack_p(const f32x16& p0, const f32x16& p1, bf16x8& pa0, bf16x8& pa1, bf16x8& pa2, bf16x8& pa3) {
#define PK4(P, B_, OUT) do { unsigned a0 = cvtpk_a(P[B_+0], P[B_+1]), a1 = cvtpk_a(P[B_+2], P[B_+3]);                          \
        unsigned b0 = cvtpk_a(P[B_+4], P[B_+5]), b1 = cvtpk_a(P[B_+6], P[B_+7]);                                             \
        auto r0 = __builtin_amdgcn_permlane32_swap(a0, b0, false, false); auto r1 = __builtin_amdgcn_permlane32_swap(a1, b1, false, false); \
        u32x4 w = {r0[0], r1[0], r0[1], r1[1]}; OUT = __builtin_bit_cast(bf16x8, w); } while (0)
    PK4(p0, 0, pa0); PK4(p0, 8, pa1); PK4(p1, 0, pa2); PK4(p1, 8, pa3);
#undef PK4
}
__device__ __forceinline__ void qkt(f32x16& p0, f32x16& p1, const LAS unsigned char* K_buf, int r32, int hi, const bf16x8* qr) {
    p0 = f32x16{}; p1 = f32x16{};
    const LAS unsigned char* kb[4];
#pragma unroll
    for (int dd = 0; dd < 4; ++dd) kb[dd] = K_buf + KSWZ(r32, (dd * 16 + hi * 8) * 2);
#define KLD(F, d0) do { const LAS unsigned char* a_ = kb[(d0) & 3] + ((d0) >> 2) * 128; F##0 = *(const LAS bf16x8*)(a_); F##1 = *(const LAS bf16x8*)(a_ + 32 * 256); \
        const LAS unsigned char* c_ = kb[((d0) + 1) & 3] + (((d0) + 1) >> 2) * 128; F##2 = *(const LAS bf16x8*)(c_); F##3 = *(const LAS bf16x8*)(c_ + 32 * 256); } while (0)
#define KMM(F, d0) do { p0 = __builtin_amdgcn_mfma_f32_32x32x16_bf16(F##0, qr[d0], p0, 0, 0, 0); p1 = __builtin_amdgcn_mfma_f32_32x32x16_bf16(F##1, qr[d0], p1, 0, 0, 0); \
        p0 = __builtin_amdgcn_mfma_f32_32x32x16_bf16(F##2, qr[(d0) + 1], p0, 0, 0, 0); p1 = __builtin_amdgcn_mfma_f32_32x32x16_bf16(F##3, qr[(d0) + 1], p1, 0, 0, 0); } while (0)
    bf16x8 fa0, fa1, fa2, fa3, fb0, fb1, fb2, fb3;
    KLD(fa, 0); KLD(fb, 2); SBAR();
    KMM(fa, 0); KLD(fa, 4); SBAR();
    KMM(fb, 2); KLD(fb, 6); SBAR();
    KMM(fa, 4); SBAR();
    KMM(fb, 6);
#undef KLD
#undef KMM
}
struct VF8 { s16x4 l0, h0, l1, h1, l2, h2, l3, h3; };
#define TRRD(dst, off) asm volatile("ds_read_b64_tr_b16 %0, %1 offset:%2" : "=&v"(dst) : "v"(vb0), "i"(off) : "memory")
__device__ __forceinline__ void pv_read0(VF8& f, int vb0) {
    constexpr int b_ = v_rd_off(0, 0, 0);
    TRRD(f.l0, b_); TRRD(f.h0, b_ + 2048); TRRD(f.l1, b_ + 4096); TRRD(f.h1, b_ + 6144); TRRD(f.l2, b_ + 8192); TRRD(f.h2, b_ + 10240); TRRD(f.l3, b_ + 12288); TRRD(f.h3, b_ + 14336);
}
__device__ __forceinline__ void pv_tile(f32x16* o, int vb0, bf16x8 pa0, bf16x8 pa1, bf16x8 pa2, bf16x8 pa3, VF8& f) {
#define PV_MM(d0, l0, h0, l1, h1, l2, h2, l3, h3) do { \
        o[d0] = __builtin_amdgcn_mfma_f32_32x32x16_bf16(pa0, (bf16x8){l0[0], l0[1], l0[2], l0[3], h0[0], h0[1], h0[2], h0[3]}, o[d0], 0, 0, 0);   \
        o[d0] = __builtin_amdgcn_mfma_f32_32x32x16_bf16(pa1, (bf16x8){l1[0], l1[1], l1[2], l1[3], h1[0], h1[1], h1[2], h1[3]}, o[d0], 0, 0, 0);   \
        o[d0] = __builtin_amdgcn_mfma_f32_32x32x16_bf16(pa2, (bf16x8){l2[0], l2[1], l2[2], l2[3], h2[0], h2[1], h2[2], h2[3]}, o[d0], 0, 0, 0);   \
        o[d0] = __builtin_amdgcn_mfma_f32_32x32x16_bf16(pa3, (bf16x8){l3[0], l3[1], l3[2], l3[3], h3[0], h3[1], h3[2], h3[3]}, o[d0], 0, 0, 0); } while (0)
#define PV_D0(d0) do { s16x4 l0, l1, l2, l3, h0, h1, h2, h3; constexpr int b_ = v_rd_off(d0, 0, 0); \
        TRRD(l0, b_); TRRD(h0, b_ + 2048); TRRD(l1, b_ + 4096); TRRD(h1, b_ + 6144); TRRD(l2, b_ + 8192); TRRD(h2, b_ + 10240); TRRD(l3, b_ + 12288); TRRD(h3, b_ + 14336); \
        asm volatile("s_waitcnt lgkmcnt(0)" ::: "memory"); SBAR(); PV_MM(d0, l0, h0, l1, h1, l2, h2, l3, h3); } while (0)
    asm volatile("s_waitcnt lgkmcnt(0)" ::: "memory"); SBAR(); PV_MM(0, f.l0, f.h0, f.l1, f.h1, f.l2, f.h2, f.l3, f.h3);
    PV_D0(1); PV_D0(2); PV_D0(3);
#undef PV_D0
#undef PV_MM
}
#undef TRRD

enum { M_C1 = 0, M_C2 = 1, M_S = 2, M_W = 3 };
struct Stage { bf16x8 k0, k1, v0, v1; };
__device__ __forceinline__ void stage_load(Stage& sg, const bf16_t* Kp, const bf16_t* Vp, int ld, int j, bool hasv) {
    const int tid = otid(), sr = tid >> 4, sc = (tid & 15) * 8; const size_t k0_ = (size_t)j * 64;
    sg.k0 = *(const bf16x8*)(Kp + (k0_ + sr) * ld + sc); sg.k1 = *(const bf16x8*)(Kp + (k0_ + 32 + sr) * ld + sc);
    if (hasv) { sg.v0 = *(const bf16x8*)(Vp + (k0_ + sr) * ld + sc); sg.v1 = *(const bf16x8*)(Vp + (k0_ + 32 + sr) * ld + sc); }
}
struct RowState { float m, l; };
template <int MODE>
__device__ __forceinline__ void attn_pass(LAS unsigned char* lds, const bf16_t* Kp, const bf16_t* Vp, int ld, int j_lo, int j_hi, const bf16x8* qr, int t, int Tq, const u32x4 sel,
                                          RowState& st, float invl, f32x16* o, bool do_imp, Stage& sg) {
    constexpr bool HASV = MODE != M_C1;
    const int tid = otid(), wid = __builtin_amdgcn_readfirstlane(tid >> 6), lane = tid & 63, r32 = lane & 31, hi = lane >> 5;
    LAS unsigned char* V_lds = lds + L_V; LAS unsigned char* K_lds = lds + L_K;
    LAS float* wsf = (LAS float*)(lds + L_WS) + wid * 64; LAS float* al_l = wsf + 32;
    const int sr = tid >> 4, sc = (tid & 15) * 8, vst0 = v_st(sr, sc), vst1 = v_st(32 + sr, sc), kws = KSWZ(sr, sc * 2);
    const int vb0 = (int)(uintptr_t)V_lds + v_rd_base(lane);
    const int NT = j_hi - j_lo;
#define st_k0 sg.k0
#define st_k1 sg.k1
#define st_v0 sg.v0
#define st_v1 sg.v1
    float m_reg = st.m, l_reg = st.l;
#define SLOAD(j) do { const size_t k0_ = (size_t)(j) * 64; st_k0 = *(const bf16x8*)(Kp + (k0_ + sr) * ld + sc); st_k1 = *(const bf16x8*)(Kp + (k0_ + 32 + sr) * ld + sc); \
        if (HASV) { st_v0 = *(const bf16x8*)(Vp + (k0_ + sr) * ld + sc); st_v1 = *(const bf16x8*)(Vp + (k0_ + 32 + sr) * ld + sc); } } while (0)
#define SWRITE(kof, vof) do { *(LAS bf16x8*)(K_lds + (kof) + kws) = st_k0; *(LAS bf16x8*)(K_lds + (kof) + kws + 32 * 256) = st_k1; \
        if (HASV) { *(LAS bf16x8*)(V_lds + (vof) + vst0) = st_v0; *(LAS bf16x8*)(V_lds + (vof) + vst1) = st_v1; } } while (0)
    const bool late = HASV && wid >= 4;
    bf16x8 pa0, pa1, pa2, pa3;
    SWRITE(0, 0);
    __syncthreads();
    int kof = 0, vof = 0, vprev = 0;
    for (int idx = 0; idx < NT; ++idx) {
        const int j = j_lo + idx, kb = j * 64;
        if (idx + 1 < NT) SLOAD(j + 1);
        if (HASV && late && idx > 0) { SBAR(); VF8 vf; pv_read0(vf, vb0 + vprev); pv_tile(o, vb0 + vprev, pa0, pa1, pa2, pa3, vf); SBAR(); }
        f32x16 p0, p1; qkt(p0, p1, K_lds + kof, r32, hi, qr);
        VF8 vfe; if (HASV && !late) { SBAR(); pv_read0(vfe, vb0 + vof); SBAR(); }
#if EXP_QKT2
        asm volatile("" : "+v"(p0), "+v"(p1)); SBAR(); qkt(p0, p1, K_lds + kof, r32, hi, qr);
#endif
        if (MODE == M_C1 || MODE == M_C2) { const int nmax1 = ((t - 31) >> 4) + 1; mask_range(p0, p1, kb + 4 * hi, (unsigned)(nmax1 > 0 ? nmax1 : 0)); }
        else if (MODE == M_S) { if (j == Tq) mask_range(p0, p1, kb + 4 * hi, (unsigned)(t + 1));
                                else { const unsigned w_ = (j >> 5) == 0 ? sel.x : (j >> 5) == 1 ? sel.y : (j >> 5) == 2 ? sel.z : sel.w; mask_row(p0, p1, ((w_ >> (j & 31)) & 1u) != 0u); } }
        else { if (j == Tq || j + 8 <= Tq) mask_range(p0, p1, kb + 4 * hi - (t - 511), 512u); }
        if (MODE == M_C1) { const float pmax = rowmax32(p0, p1); const float mn = fmaxf(m_reg, pmax); const float alpha = __builtin_amdgcn_exp2f((m_reg - mn) * C2); m_reg = mn;
            const float mnL = -mn * C2;
#pragma unroll
            for (int r = 0; r < 16; ++r) { p0[r] = __builtin_amdgcn_exp2f(fmaf(p0[r], C2, mnL)); p1[r] = __builtin_amdgcn_exp2f(fmaf(p1[r], C2, mnL)); }
            l_reg = l_reg * alpha + rowsum32(p0, p1); }
        else if (MODE == M_C2) { const float mnL = -m_reg * C2;
#pragma unroll
            for (int r = 0; r < 16; ++r) { p0[r] = __builtin_amdgcn_exp2f(fmaf(p0[r], C2, mnL)) * invl; p1[r] = __builtin_amdgcn_exp2f(fmaf(p1[r], C2, mnL)) * invl; }
            if (do_imp) { LAS unsigned* imp = (LAS unsigned*)(lds + L_IMP) + ((wid & 1) * 32 + r32) * IMP_LD + 16 * j + hi;
#pragma unroll
                for (int k = 0; k < 4; ++k) {
                    { const float e_ = p0[4 * k + 3], a_ = 2.f * (p0[4 * k] + p0[4 * k + 1] + p0[4 * k + 2]) + e_;
                      LADD(imp + 2 * k, (unsigned)(a_ * 67108864.f + 0.5f)); LADD(imp + 2 * k + 1, (unsigned)(e_ * 67108864.f + 0.5f)); }
                    { const float e_ = p1[4 * k + 3], a_ = 2.f * (p1[4 * k] + p1[4 * k + 1] + p1[4 * k + 2]) + e_;
                      LADD(imp + 8 + 2 * k, (unsigned)(a_ * 67108864.f + 0.5f)); LADD(imp + 8 + 2 * k + 1, (unsigned)(e_ * 67108864.f + 0.5f)); } } }
            pack_p(p0, p1, pa0, pa1, pa2, pa3); }
        else { const float pmax = rowmax32(p0, p1); float mn, alpha;
            if (__builtin_expect(__all((pmax - m_reg) * SCALE <= THR), 1)) { mn = m_reg; alpha = 1.f; }
            else { mn = fmaxf(m_reg, pmax); alpha = __builtin_amdgcn_exp2f((m_reg - mn) * C2); m_reg = mn; }
            const float mnL = -mn * C2;
#pragma unroll
            for (int r = 0; r < 16; ++r) { p0[r] = __builtin_amdgcn_exp2f(fmaf(p0[r], C2, mnL)); p1[r] = __builtin_amdgcn_exp2f(fmaf(p1[r], C2, mnL)); }
            l_reg = l_reg * alpha + rowsum32(p0, p1);
            pack_p(p0, p1, pa0, pa1, pa2, pa3);
            if (__any(alpha < 1.f)) { if (hi == 0) al_l[r32] = alpha; asm volatile("s_waitcnt lgkmcnt(0)" ::: "memory");
#pragma unroll
                for (int d_ = 0; d_ < 4; ++d_)
#pragma unroll
                    for (int r = 0; r < 16; ++r) o[d_][r] *= al_l[crow(r, hi)]; } }
        if (HASV && !late) { SBAR(); pv_tile(o, vb0 + vof, pa0, pa1, pa2, pa3, vfe); }
        const int kn = kof ^ SHM_K, vn = (vof == 2 * SHM_V) ? 0 : vof + SHM_V;
        if (idx + 1 < NT) { SWRITE(kn, vn); }
        __syncthreads();
        vprev = vof; kof = kn; vof = vn;
    }
    if (HASV) { if (late) { SBAR(); VF8 vf; pv_read0(vf, vb0 + vprev); pv_tile(o, vb0 + vprev, pa0, pa1, pa2, pa3, vf); } __syncthreads(); }
    st.m = m_reg; st.l = l_reg;
#undef SLOAD
#undef SWRITE
#undef st_k0
#undef st_k1
#undef st_v0
#undef st_v1
}

typedef int v8i __attribute__((ext_vector_type(8)));
struct Stage8 { u32x4 k, v; };
constexpr int SHM8 = 8192;
constexpr float THR8 = 0.5f;
__device__ __forceinline__ f32x16 mfma8(v8i a, v8i b, f32x16 c) { return __builtin_amdgcn_mfma_scale_f32_32x32x64_f8f6f4(a, b, c, 0, 0, 0, 0x7F7F7F7F, 0, 0x7F7F7F7F); }
__device__ __forceinline__ int k8_off(int key, int c) { return key * 128 + ((c ^ ((key >> 1) & 7)) << 4); }
__device__ __forceinline__ int v8_off(int d, int c) { return d * 64 + ((c ^ ((d >> 2) & 3)) << 4); }
__device__ __forceinline__ void stage_load8(Stage8& sg, const unsigned char* K8h, const unsigned char* V8Th, int j) {
    const int tid = otid();
    sg.k = *(const u32x4*)(K8h + (size_t)(64 * j + (tid >> 3)) * 512 + (tid & 7) * 16); sg.v = *(const u32x4*)(V8Th + (size_t)j * 8192 + tid * 16);
}
__device__ __forceinline__ v8i ld_v8i(const LAS unsigned char* a, const LAS unsigned char* b) { const u32x4 x = *(const LAS u32x4*)a, y = *(const LAS u32x4*)b; return (v8i){(int)x.x, (int)x.y, (int)x.z, (int)x.w, (int)y.x, (int)y.y, (int)y.z, (int)y.w}; }
struct Stage8x2 { u32x4 ka, va, kb, vb; };
__device__ __forceinline__ void stage_load8x2(Stage8x2& sg, const unsigned char* K8h, const unsigned char* V8Th, int ja, bool hasb) {
    const int tid = otid();
    sg.ka = *(const u32x4*)(K8h + (size_t)(64 * ja + (tid >> 3)) * 512 + (tid & 7) * 16); sg.va = *(const u32x4*)(V8Th + (size_t)ja * 8192 + tid * 16);
    if (hasb) { sg.kb = *(const u32x4*)(K8h + (size_t)(64 * (ja + 1) + (tid >> 3)) * 512 + (tid & 7) * 16); sg.vb = *(const u32x4*)(V8Th + (size_t)(ja + 1) * 8192 + tid * 16); }
}
template <int MODE>
__device__ __forceinline__ void attn_pass8(LAS unsigned char* lds, const unsigned char* K8h, const unsigned char* V8Th, int j_lo, int j_hi, const v8i* qf, int t, int Tq, const u32x4 sel,
                                           RowState& st, f32x16* o, Stage8x2& sg0) {
    const int tid = otid(), wid = __builtin_amdgcn_readfirstlane(tid >> 6), lane = tid & 63, r32 = lane & 31, hi = lane >> 5;
    LAS unsigned char* V_lds = lds + L_V; LAS unsigned char* K_lds = lds + L_K;
    LAS float* wsf = (LAS float*)(lds + L_WS) + wid * 64; LAS float* al_l = wsf + 32;
    const int kws = k8_off(tid >> 3, tid & 7), vws = v8_off(tid >> 2, tid & 3);
    const int NT = j_hi - j_lo, NS = (NT + 1) >> 1;
    float m_reg = st.m, l_reg = st.l;
#define SWRITE8(SG, kof, vof, hasb) do { *(LAS u32x4*)(K_lds + (kof) + kws) = (SG).ka; *(LAS u32x4*)(V_lds + (vof) + vws) = (SG).va; \
        if (hasb) { *(LAS u32x4*)(K_lds + (kof) + SHM8 + kws) = (SG).kb; *(LAS u32x4*)(V_lds + (vof) + SHM8 + vws) = (SG).vb; } } while (0)
    const bool late = wid >= 4;
    v8i paa, pab;
    SWRITE8(sg0, 0, 0, NT > 1);
    __syncthreads();
    int kof = 0, vof = 0, vprev = 0; bool bprev = false;
#define PV8(vo, pa) do { const LAS unsigned char* vb_ = V_lds + (vo);                                                                  \
        _Pragma("unroll") for (int d0 = 0; d0 < 4; ++d0) { const int d_ = d0 * 32 + r32;                                               \
            o[d0] = mfma8(pa, ld_v8i(vb_ + v8_off(d_, 2 * hi), vb_ + v8_off(d_, 2 * hi + 1)), o[d0]); } } while (0)
#define QK8(P0, P1, ko) do { const LAS unsigned char* kb_ = K_lds + (ko); P0 = f32x16{}; P1 = f32x16{};                                  \
        _Pragma("unroll") for (int ks = 0; ks < 2; ++ks) {                                                                             \
            P0 = mfma8(ld_v8i(kb_ + k8_off(r32, 4 * ks + 2 * hi), kb_ + k8_off(r32, 4 * ks + 2 * hi + 1)), qf[ks], P0);                 \
            P1 = mfma8(ld_v8i(kb_ + k8_off(32 + r32, 4 * ks + 2 * hi), kb_ + k8_off(32 + r32, 4 * ks + 2 * hi + 1)), qf[ks], P1); } } while (0)
#define SOFT8(P0, P1, jt, PA) do { const int j_ = (jt), kb = j_ * 64; bool rowkeep = true;                                               \
        if (MODE == M_S) { if (j_ == Tq) mask_range(P0, P1, kb + 4 * hi, (unsigned)(t + 1));                                            \
                           else { const unsigned w_ = (j_ >> 5) == 0 ? sel.x : (j_ >> 5) == 1 ? sel.y : (j_ >> 5) == 2 ? sel.z : sel.w; rowkeep = ((w_ >> (j_ & 31)) & 1u) != 0u; } } \
        else { if (j_ == Tq || j_ + 8 <= Tq) mask_range(P0, P1, kb + 4 * hi - (t - 511), 512u); }                                        \
        float pmax = rowmax32(P0, P1); if (MODE == M_S) pmax = rowkeep ? pmax : -__builtin_inff(); float mn, alpha;                    \
        if (__builtin_expect(__all((pmax - m_reg) * SCALE <= THR8), 1)) { mn = m_reg; alpha = 1.f; }                                   \
        else { mn = fmaxf(m_reg, pmax); alpha = __builtin_amdgcn_exp2f((m_reg - mn) * C2); m_reg = mn; }                               \
        float mnL = 8.0f - mn * C2;                                                                                                    \
        if (MODE == M_S) mnL = rowkeep ? mnL : -__builtin_inff();                                                                      \
        _Pragma("unroll") for (int r = 0; r < 16; ++r) { P0[r] = __builtin_amdgcn_exp2f(fmaf(P0[r], C2, mnL)); P1[r] = __builtin_amdgcn_exp2f(fmaf(P1[r], C2, mnL)); } \
        l_reg = l_reg * alpha + rowsum32(P0, P1);                                                                                      \
        _Pragma("unroll") for (int q = 0; q < 4; ++q) { PA[q] = (int)cvt4_fp8(P0[4 * q], P0[4 * q + 1], P0[4 * q + 2], P0[4 * q + 3]); PA[4 + q] = (int)cvt4_fp8(P1[4 * q], P1[4 * q + 1], P1[4 * q + 2], P1[4 * q + 3]); } \
        if (__any(alpha < 1.f)) { if (hi == 0) al_l[r32] = alpha; asm volatile("s_waitcnt lgkmcnt(0)" ::: "memory");                   \
            _Pragma("unroll") for (int r = 0; r < 16; ++r) { const float a_ = al_l[crow(r, hi)]; o[0][r] *= a_; o[1][r] *= a_; o[2][r] *= a_; o[3][r] *= a_; } } } while (0)
#define SUPER8(sidx, SGL, SGW) do { const int ja = j_lo + 2 * (sidx); const bool hasb = ja + 1 < j_hi;                                    \
        if ((sidx) + 1 < NS) stage_load8x2(SGL, K8h, V8Th, ja + 2, ja + 3 < j_hi);                                                     \
        if (late && (sidx) > 0) { SBAR(); PV8(vprev, paa); if (bprev) PV8(vprev + SHM8, pab); SBAR(); }                                 \
        f32x16 p0a, p1a, p0b, p1b;                                                                                                     \
        QK8(p0a, p1a, kof); SBAR(); if (hasb) QK8(p0b, p1b, kof + SHM8);                                                               \
        SBAR();                                                                                                                        \
        if (!hasb) { SOFT8(p0a, p1a, ja, paa); }                                                                                        \
        else {                       \
            SOFT8_2(); }                                                                                                               \
        if (!late) { SBAR(); PV8(vof, paa); if (hasb) PV8(vof + SHM8, pab); }                                                          \
        const int kn = kof ^ (2 * SHM8), vn = (vof == 4 * SHM8) ? 0 : vof + 2 * SHM8;                                                  \
        if ((sidx) + 1 < NS) { SWRITE8(SGW, kn, vn, ja + 3 < j_hi); }                                                                  \
        __syncthreads();                                                                                                               \
        vprev = vof; bprev = hasb; kof = kn; vof = vn; } while (0)
#define SOFT8_2() do { const int kba = ja * 64, kbb = kba + 64; bool keepa = true, keepb = true;                                         \
        if (MODE == M_S) { const unsigned wa_ = (ja >> 5) == 0 ? sel.x : (ja >> 5) == 1 ? sel.y : (ja >> 5) == 2 ? sel.z : sel.w; const int jb = ja + 1;                         \
                           const unsigned wb_ = (jb >> 5) == 0 ? sel.x : (jb >> 5) == 1 ? sel.y : (jb >> 5) == 2 ? sel.z : sel.w;                                                \
                           if (ja == Tq) mask_range(p0a, p1a, kba + 4 * hi, (unsigned)(t + 1)); else keepa = ((wa_ >> (ja & 31)) & 1u) != 0u;                                      \
                           if (jb == Tq) mask_range(p0b, p1b, kbb + 4 * hi, (unsigned)(t + 1)); else keepb = ((wb_ >> (jb & 31)) & 1u) != 0u; }                                    \
        else { if (ja == Tq || ja + 8 <= Tq) mask_range(p0a, p1a, kba + 4 * hi - (t - 511), 512u);                                        \
               if (ja + 1 == Tq || ja + 9 <= Tq) mask_range(p0b, p1b, kbb + 4 * hi - (t - 511), 512u); }                                  \
        float pma = rowmax32(p0a, p1a), pmb = rowmax32(p0b, p1b);                                                                      \
        if (MODE == M_S) { pma = keepa ? pma : -__builtin_inff(); pmb = keepb ? pmb : -__builtin_inff(); }                             \
        const float pmax = fmaxf(pma, pmb); float mn, alpha;                                                                           \
        if (__builtin_expect(__all((pmax - m_reg) * SCALE <= THR8), 1)) { mn = m_reg; alpha = 1.f; }                                   \
        else { mn = fmaxf(m_reg, pmax); alpha = __builtin_amdgcn_exp2f((m_reg - mn) * C2); m_reg = mn; }                               \
        const float mnL0 = 8.0f - mn * C2; float mnLa = mnL0, mnLb = mnL0;                                                             \
        if (MODE == M_S) { mnLa = keepa ? mnL0 : -__builtin_inff(); mnLb = keepb ? mnL0 : -__builtin_inff(); }                         \
        _Pragma("unroll") for (int r = 0; r < 16; ++r) { p0a[r] = __builtin_amdgcn_exp2f(fmaf(p0a[r], C2, mnLa)); p1a[r] = __builtin_amdgcn_exp2f(fmaf(p1a[r], C2, mnLa)); } \
        l_reg = l_reg * alpha + rowsum32(p0a, p1a);                                                                                    \
        _Pragma("unroll") for (int q = 0; q < 4; ++q) { paa[q] = (int)cvt4_fp8(p0a[4 * q], p0a[4 * q + 1], p0a[4 * q + 2], p0a[4 * q + 3]); paa[4 + q] = (int)cvt4_fp8(p1a[4 * q], p1a[4 * q + 1], p1a[4 * q + 2], p1a[4 * q + 3]); } \
        _Pragma("unroll") for (int r = 0; r < 16; ++r) { p0b[r] = __builtin_amdgcn_exp2f(fmaf(p0b[r], C2, mnLb)); p1b[r] = __builtin_amdgcn_exp2f(fmaf(p1b[r], C2, mnLb)); } \
        l_reg += rowsum32(p0b, p1b);                                                                                                   \
        _Pragma("unroll") for (int q = 0; q < 4; ++q) { pab[q] = (int)cvt4_fp8(p0b[4 * q], p0b[4 * q + 1], p0b[4 * q + 2], p0b[4 * q + 3]); pab[4 + q] = (int)cvt4_fp8(p1b[4 * q], p1b[4 * q + 1], p1b[4 * q + 2], p1b[4 * q + 3]); } \
        if (__any(alpha < 1.f)) { if (hi == 0) al_l[r32] = alpha; asm volatile("s_waitcnt lgkmcnt(0)" ::: "memory");                   \
            _Pragma("unroll") for (int r = 0; r < 16; ++r) { const float a_ = al_l[crow(r, hi)]; o[0][r] *= a_; o[1][r] *= a_; o[2][r] *= a_; o[3][r] *= a_; } } } while (0)
    for (int sidx = 0; sidx < NS; ++sidx) SUPER8(sidx, sg0, sg0);
    if (late) { SBAR(); PV8(vprev, paa); if (bprev) PV8(vprev + SHM8, pab); }
    __syncthreads();
    st.m = m_reg; st.l = l_reg;
#undef SUPER8
#undef SOFT8_2
#undef SOFT8
#undef QK8
#undef PV8
#undef SWRITE8
}

template <int MODE, bool USE_OL>
__device__ __forceinline__ void branch_out(LAS unsigned char* lds, const f32x16* o, float rowscale, bf16_t* onsa_w, const bf16_t* gn_w, const f32x16 ol, unsigned char* onsa8_w = nullptr) {
    const int tid = otid(), wid = __builtin_amdgcn_readfirstlane(tid >> 6), lane = tid & 63, r32 = lane & 31, hi = lane >> 5;
    LAS float* li_l = (LAS float*)(lds + L_WS) + wid * 64;
    if (hi == 0) li_l[r32] = rowscale; asm volatile("s_waitcnt lgkmcnt(0)" ::: "memory");
    LAS unsigned* stg = (LAS unsigned*)(lds + wid * 8192);
#pragma unroll
    for (int r = 0; r < 16; ++r) { const int orow = crow(r, hi); float sc = li_l[orow]; if (USE_OL) sc = ol[r] > 0.f ? sc * __builtin_amdgcn_rcpf(ol[r]) : 0.f;
#pragma unroll
        for (int d0 = 0; d0 < 4; ++d0) { const float v = o[d0][r] * sc; const float vn = dpp_x1f(v);
            if ((r32 & 1) == 0) stg[orow * 64 + d0 * 16 + (r32 >> 1)] = cvtpk(v, vn); } }
    asm volatile("s_waitcnt lgkmcnt(0)" ::: "memory");
    u32x4 val[8], prev[8], gq[8];
#pragma unroll
    for (int i = 0; i < 8; ++i) val[i] = *(const LAS u32x4*)(stg + (i * 4 + (lane >> 4)) * 64 + (lane & 15) * 4);
    int rb = lane >> 4; asm volatile("" : "+v"(rb));
    bf16_t* gp_ = onsa_w + (size_t)rb * 2048 + (lane & 15) * 8; const bf16_t* gg_ = gn_w + (size_t)rb * 2048 + (lane & 15) * 8;
    unsigned char* o8_ = onsa8_w + (size_t)rb * 2048 + (lane & 15) * 8;
    if (MODE >= 1) {
#pragma unroll
        for (int i = 0; i < 8; ++i) prev[i] = *(const u32x4*)(gp_ + (size_t)i * 4 * 2048); }
    if (MODE == 2) {
#pragma unroll
        for (int i = 0; i < 8; ++i) gq[i] = *(const u32x4*)(gg_ + (size_t)i * 4 * 2048); }
#pragma unroll
    for (int i = 0; i < 8; ++i) { u32x4 w = val[i];
        if (MODE >= 1) { f32x4 a0, a1, b0, b1; unpack8(val[i], a0, a1); unpack8(prev[i], b0, b1); a0 = a0 + b0; a1 = a1 + b1;
            if (MODE == 2) { f32x4 g0, g1; unpack8(gq[i], g0, g1); a0 = a0 * g0; a1 = a1 * g1; }
            w = pack8(a0, a1); }
        if (MODE == 2) { f32x4 a0, a1; unpack8(w, a0, a1); u32x2 w8; w8.x = cvt4_fp8(sat8(a0[0] * ONSA_SCALE), sat8(a0[1] * ONSA_SCALE), sat8(a0[2] * ONSA_SCALE), sat8(a0[3] * ONSA_SCALE));
            w8.y = cvt4_fp8(sat8(a1[0] * ONSA_SCALE), sat8(a1[1] * ONSA_SCALE), sat8(a1[2] * ONSA_SCALE), sat8(a1[3] * ONSA_SCALE)); *(u32x2*)(o8_ + (size_t)i * 4 * 2048) = w8; }
        else *(u32x4*)(gp_ + (size_t)i * 4 * 2048) = w; }
    __syncthreads();
}

__device__ __forceinline__ void attn_unit(LAS unsigned char* lds, unsigned char* ws, int h, int Tq) {
    const int tid = otid(), wid = __builtin_amdgcn_readfirstlane(tid >> 6), lane = tid & 63, r32 = lane & 31, hi = lane >> 5;
    const int g = wid >> 1, tl = (wid & 1) * 32 + r32, t = Tq * 64 + tl, hq = 4 * h + g;
    const bf16_t* Q = (const bf16_t*)(ws + WS_Q); const bf16_t* GBR = (const bf16_t*)(ws + WS_GBR);
    bf16_t* onsa_w = (bf16_t*)(ws + WS_ONSA) + (size_t)(Tq * 64 + (wid & 1) * 32) * 2048 + hq * 128; const bf16_t* gn_w = (const bf16_t*)(ws + WS_GN) + (size_t)(Tq * 64 + (wid & 1) * 32) * 2048 + hq * 128;
    bf16x8 qr[8];
#pragma unroll
    for (int d0 = 0; d0 < 8; ++d0) qr[d0] = *(const bf16x8*)(Q + (size_t)t * 2048 + hq * 128 + d0 * 16 + hi * 8);
    const float g_c = bf2f(GBR[(size_t)t * 256 + hq * 3 + 0]);
    const bool big = Tq >= 16;
    LAS unsigned* IMP = (LAS unsigned*)(lds + L_IMP);
    if (big) { for (int i = tid; i < 64 * IMP_LD; i += 512) IMP[i] = 0u; }
    const u32x4 nosel = {0u, 0u, 0u, 0u};
    f32x16 o[4]; Stage sg;
    {
        const bf16_t* Kc = (const bf16_t*)(ws + WS_KC) + (size_t)h * 512 * 128; const bf16_t* Vc = (const bf16_t*)(ws + WS_VC) + (size_t)h * 512 * 128;
        const int ntc = ((4 * Tq + 2) >> 6) + 1;
        RowState stc{-1e30f, 0.f};
        stage_load(sg, Kc, Vc, 128, 0, false);
        attn_pass<M_C1>(lds, Kc, Vc, 128, 0, ntc, qr, t, Tq, nosel, stc, 0.f, o, false, sg);
        stage_load(sg, Kc, Vc, 128, 0, true);
        const float invl = stc.l > 0.f ? 1.0f / stc.l : 0.f;
#pragma unroll
        for (int d = 0; d < 4; ++d) o[d] = f32x16{};
        attn_pass<M_C2>(lds, Kc, Vc, 128, 0, ntc, qr, t, Tq, nosel, stc, invl, o, big, sg);
        branch_out<0, false>(lds, o, g_c, onsa_w, gn_w, f32x16{});
    }
    {
        LAS unsigned short* SELM = (LAS unsigned short*)(lds + L_SELM);
        int tok = tid >> 3, sub = tid & 7; asm volatile("" : "+v"(tok), "+v"(sub));
        unsigned bits = 0u;
        if (big) {
            unsigned kv[16];
#pragma unroll
            for (int e = 0; e < 16; ++e) { const int j = sub * 16 + e; const unsigned v = IMP[tok * IMP_LD + j]; kv[e] = (j >= 1 && j <= Tq - 2) ? v + 1u : 0u; }
            for (int round = 0; round < 13; ++round) {
                unsigned bv = kv[0]; int bj = 0;
#pragma unroll
                for (int e = 1; e < 16; ++e) { const bool gt = kv[e] > bv; bv = gt ? kv[e] : bv; bj = gt ? e : bj; }
                bj += sub * 16;
#pragma unroll
                for (int st_ = 0; st_ < 3; ++st_) { const unsigned ov = st_ == 0 ? dpp_x1(bv) : st_ == 1 ? dpp_x2(bv) : dpp_m8(bv); const int oj = (int)(st_ == 0 ? dpp_x1((unsigned)bj) : st_ == 1 ? dpp_x2((unsigned)bj) : dpp_m8((unsigned)bj));
                    const bool take = (ov > bv) || (ov == bv && oj < bj); bv = take ? ov : bv; bj = take ? oj : bj; }
                const int we = (bv != 0u && (bj >> 4) == sub) ? (bj & 15) : -1;
#pragma unroll
                for (int e = 0; e < 16; ++e) { const bool hit = (we == e); bits |= hit ? (1u << e) : 0u; kv[e] = hit ? 0u : kv[e]; }
            }
#pragma unroll
            for (int e = 0; e < 16; ++e) { const int j = sub * 16 + e; if (j == 0 || j == Tq - 1 || j == Tq) bits |= 1u << e; }
        } else {
#pragma unroll
            for (int e = 0; e < 16; ++e) { const int j = sub * 16 + e; if (j <= Tq) bits |= 1u << e; }
        }
        SELM[tok * 8 + sub] = (unsigned short)bits;
        __syncthreads();
    }
    const u32x4 sel = *(const LAS u32x4*)(lds + L_SELM + tl * 16);
    v8i qf[2];
    { const unsigned char* q8 = ws + WS_Q8 + (size_t)t * 2048 + hq * 128 + 32 * hi;
#pragma unroll
      for (int ks = 0; ks < 2; ++ks) { const u32x4 x = *(const u32x4*)(q8 + 64 * ks), y = *(const u32x4*)(q8 + 64 * ks + 16); qf[ks] = (v8i){(int)x.x, (int)x.y, (int)x.z, (int)x.w, (int)y.x, (int)y.y, (int)y.z, (int)y.w}; } }
    const unsigned char* K8S = ws + WS_K8S + h * 128; const unsigned char* V8TS = ws + WS_V8TS + (size_t)h * 128 * 8192;
    const unsigned char* K8W = ws + WS_K8W + h * 128; const unsigned char* V8TW = ws + WS_V8TW + (size_t)h * 128 * 8192;
    Stage8x2 s8;
    {
        RowState sts{-1e30f, 0.f};
#pragma unroll
        for (int d = 0; d < 4; ++d) o[d] = f32x16{};
        stage_load8x2(s8, K8S, V8TS, 0, Tq + 1 > 1);
        attn_pass8<M_S>(lds, K8S, V8TS, 0, Tq + 1, qf, t, Tq, sel, sts, o, s8);
        stage_load8x2(s8, K8W, V8TW, Tq >= 8 ? Tq - 8 : 0, Tq >= 1);
        const float g_s = bf2f(GBR[(size_t)t * 256 + hq * 3 + 1]);
        branch_out<1, false>(lds, o, sts.l > 0.f ? g_s / sts.l : 0.f, onsa_w, gn_w, f32x16{});
    }
    {
        RowState stw{-1e30f, 0.f};
#pragma unroll
        for (int d = 0; d < 4; ++d) o[d] = f32x16{};
        attn_pass8<M_W>(lds, K8W, V8TW, Tq >= 8 ? Tq - 8 : 0, Tq + 1, qf, t, Tq, sel, stw, o, s8);
        const float g_w = bf2f(GBR[(size_t)t * 256 + hq * 3 + 2]);
        branch_out<2, false>(lds, o, stw.l > 0.f ? g_w / stw.l : 0.f, onsa_w, gn_w, f32x16{}, ws + WS_ONSA8 + (size_t)(Tq * 64 + (wid & 1) * 32) * 2048 + hq * 128);
    }
}
#undef KSWZ
#undef SBAR
}

constexpr int NPHASE = 8;
__global__ void __launch_bounds__(NWAVES * 64, 2) mega_fwd(Args args) {
    extern __shared__ __attribute__((aligned(16))) unsigned char lds[];
    Frame F;
    F.lds = (LAS unsigned char*)lds;
    F.tid = threadIdx.x; F.lane = F.tid & 63; F.wave = __builtin_amdgcn_readfirstlane(F.tid >> 6);
    F.G = gridDim.x; { const int bx = blockIdx.x; F.vcu = (F.G % 8 == 0) ? (bx % 8) * (F.G / 8) + bx / 8 : bx; }
    volatile LAS unsigned* MISC = (volatile LAS unsigned*)(F.lds + MISC_OFF);
    unsigned char* ws = args.ws;
    for (int u = F.tid; u < (LDS_BYTES - LDSCTL_OFF) / 4; u += NWAVES * 64) ((LAS unsigned*)(F.lds + LDSCTL_OFF))[u] = 0u;
    __syncthreads();
    XcdBarrier bar; bar.bar = (unsigned*)(ws + WS_CTL) + CW_BAR; bar.x = 0; bar.st = nullptr;
#if !N_LAUNCHES_PER_PHASE
    bar = xcd_barrier_post((unsigned*)(ws + WS_CTL) + CW_BAR, MISC + 8);
#endif
    const int lo = args.ph_lo, hi = args.ph_hi;
#define IN(k) (lo <= (k) && (k) < hi && (F.tid = otid(), F.lane = F.tid & 63, true))
#define SEAM(k) do { if (IN(k) && IN((k) + 1)) xcd_barrier(bar); } while (0)
    bf16_t* const GM = (bf16_t*)args.out;

    for (int rep_ = 0; rep_ < (DUP_PHASE == 0 ? 2 : 1); ++rep_) if (IN(0)) { if (rep_) xcd_barrier(bar); p0_prologue(F, args); } SEAM(0);
    for (int rep_ = 0; rep_ < (DUP_PHASE == 1 ? 2 : 1); ++rep_) if (IN(1)) { if (rep_) xcd_barrier(bar);
        pg8::Gemm g{(const bf16_t*)(ws + WS_H), (const bf16_t*)(ws + WS_WCAT), 2048, 2048, 2048};
        pg8::StaticOrder So; So.init(S, NCAT, F.G, (int)blockIdx.x);
        EpiInProj E{ws, GM, args.in[14], 0};
        pg8::AddrAffine AD{(size_t)256 * 2048 * 2, (size_t)256 * 2048 * 2};
        pg8::gemm_phase<EpiInProj, true>(F.lds, g, So, E, AD);
        {
            pg8::Gemm g8{(const bf16_t*)(ws + WS_H8), (const bf16_t*)(ws + WS_W8), 1024, 1024, 1024};
            pg8::StaticOrder S8; S8.init(S, 4096, F.G, (int)blockIdx.x);
            EpiInProj E8{ws, GM, args.in[14], 37};
            pg8::AddrAffine AD8{(size_t)256 * 1024 * 2, (size_t)256 * 1024 * 2};
            pg8::gemm_phase<EpiInProj, true, pg8::AddrAffine, true>(F.lds, g8, S8, E8, AD8);
        }
        { const int nun = (So.nwg + F.G - 1) / F.G, full = So.nwg - (nun - 1) * F.G;
          const int base = full < F.G ? full : 0; if ((int)blockIdx.x >= base) p1_late_weights(F, args, ((int)blockIdx.x - base) * NWAVES + F.wave, (F.G - base) * NWAVES); }
    } SEAM(1);
    for (int rep_ = 0; rep_ < (DUP_PHASE == 2 ? 2 : 1); ++rep_) if (IN(2)) { if (rep_) xcd_barrier(bar);
        pg8::Gemm g{(const bf16_t*)(ws + WS_KCR), (const bf16_t*)(ws + WS_W1KT), 2048, 4096, 4096 / NSPLIT};
        pg8::StaticOrder So; So.init(16 * 256, NSPLIT * 256, F.G, (int)blockIdx.x);
        EpiSlab E{(float*)(ws + WS_SLAB)};
        pg8::AddrCmp AD{(4096 / NSPLIT) / 64};
        pg8::gemm_phase<EpiSlab, false>(F.lds, g, So, E, AD);
        { const int base = F.G > So.nwg ? So.nwg : 0; if ((int)blockIdx.x >= base) { p2_ypool(F, ws, args.in[4], ((int)blockIdx.x - base) * NWAVES + F.wave, (F.G - base) * NWAVES); p2_vt8(F, ws, ((int)blockIdx.x - base) * NWAVES + F.wave, (F.G - base) * NWAVES); } }
        if (blockIdx.x == F.G - 1) { const float* b1p = (const float*)(ws + WS_B1P); float* b1 = (float*)(ws + WS_B1); const int t = F.tid; float s = 0.f;
            for (int c = 0; c < 64; ++c) s += b1p[((t >> 8) * 64 + c) * 256 + (t & 255)];
            b1[t] = s; }
    } SEAM(2);
    for (int rep_ = 0; rep_ < (DUP_PHASE == 3 ? 2 : 1); ++rep_) if (IN(3)) { if (rep_) xcd_barrier(bar);
        p3_compress2(F, ws, (int)blockIdx.x, F.G);
    } SEAM(3);
    for (int rep_ = 0; rep_ < (DUP_PHASE == 5 ? 2 : 1); ++rep_) if (IN(5)) { if (rep_) xcd_barrier(bar);
        for (int p = F.vcu; p < 256; p += F.G) {
#pragma unroll 1
            for (int i = 0; i < 2; ++i) { const int h = p >> 6, x = p & 63; nsa::attn_unit(F.lds, ws, h, i ? x : 127 - x); } }
    } SEAM(5);
    for (int rep_ = 0; rep_ < (DUP_PHASE == 6 ? 2 : 1); ++rep_) if (IN(6)) { if (rep_) xcd_barrier(bar);
        pg8::Gemm ga{(const bf16_t*)(ws + WS_H + 16 * MiB), (const bf16_t*)(ws + WS_WPOT), 1024, 1024, 1024};
        pg8::Gemm gb{(const bf16_t*)(ws + WS_ONSA8), (const bf16_t*)(ws + WS_WNOT), 1024, 1024, 1024};
        pg8::StaticOrder So; So.init(S, 2048, F.G, (int)blockIdx.x);
        EpiYaYb E{EpiYa{(bf16_t*)(ws + WS_YAG), GM}, EpiYb{(bf16_t*)(ws + WS_H), (const bf16_t*)(ws + WS_YAG), GM, 1.0f / (ONSA_SCALE * WNO_SCALE)}};
        pg8::gemm_phase2<EpiYaYb>(F.lds, ga, gb, So, E);
    } SEAM(6);
    for (int rep_ = 0; rep_ < (DUP_PHASE == 7 ? 2 : 1); ++rep_) if (IN(7)) { if (rep_) xcd_barrier(bar);
        pg8::Gemm g{(const bf16_t*)(ws + WS_H), (const bf16_t*)(ws + WS_WOT), 2048, 2048, 2048}; pg8::AddrAffine AD{(size_t)256 * 2048 * 2, (size_t)256 * 2048 * 2};
        pg8::StaticOrder So; So.init(S, 2048, F.G, (int)blockIdx.x);
        EpiOut E{args.out, args.in[0], (float*)(ws + WS_SSQ), args.in[16], (unsigned*)(ws + WS_CTL), F.lds};
        pg8::gemm_phase<EpiOut, true>(F.lds, g, So, E, AD);
    }
#undef IN
#undef SEAM
}

extern "C" void kernel_launch(void* const* d_in, const int* in_sizes, int n_in, void* d_out, int out_size, void* d_ws, size_t ws_size, hipStream_t stream) {
    static int grid = 0;
    if (grid == 0) {
        if (n_in != 17 || in_sizes[0] != S * DM || out_size != S * DM || ws_size < WS_END) { fprintf(stderr, "kernel_launch: unexpected shapes (n_in %d, in0 %d, out %d, ws %zu); nothing launched\n", n_in, n_in > 0 ? in_sizes[0] : -1, out_size, ws_size); grid = -1; return; }
        int dev = 0, cus = 0;
        if (hipGetDevice(&dev) != hipSuccess || hipDeviceGetAttribute(&cus, hipDeviceAttributeMultiprocessorCount, dev) != hipSuccess) { fprintf(stderr, "kernel_launch: device query failed\n"); grid = -1; return; }
        if (hipFuncSetAttribute((const void*)mega_fwd, hipFuncAttributeMaxDynamicSharedMemorySize, LDS_BYTES) != hipSuccess) { fprintf(stderr, "kernel_launch: hipFuncSetAttribute failed\n"); grid = -1; return; }
        (void)hipGetLastError();
        grid = cus;
    }
    if (grid < 0) return;
    (void)hipMemsetAsync((char*)d_ws + WS_CTL, 0, CTL_BYTES, stream);
    Args a{};
    for (int i = 0; i < 17; ++i) a.in[i] = (const float*)d_in[i];
    a.out = (float*)d_out; a.ws = (unsigned char*)d_ws;
#if N_LAUNCHES_PER_PHASE
    for (int p = 0; p < NPHASE; ++p) { a.ph_lo = p; a.ph_hi = p + 1; hipLaunchKernelGGL(mega_fwd, dim3(grid), dim3(NWAVES * 64), LDS_BYTES, stream, a); }
#else
    a.ph_lo = 0; a.ph_hi = NPHASE;
    hipLaunchKernelGGL(mega_fwd, dim3(grid), dim3(NWAVES * 64), LDS_BYTES, stream, a);
#endif
}
```

```cpp
#include <hip/hip_runtime.h>
#include <cstdio>
#include <cstdint>

#define LAS __attribute__((address_space(3)))
#define GAS __attribute__((address_space(1)))
typedef unsigned short bf16_t;
typedef short bf16x8 __attribute__((ext_vector_type(8)));
typedef short s16x4 __attribute__((ext_vector_type(4)));
typedef float f32x4 __attribute__((ext_vector_type(4)));
typedef float f32x16 __attribute__((ext_vector_type(16)));
typedef unsigned u32x4 __attribute__((ext_vector_type(4)));
typedef unsigned u32x2 __attribute__((ext_vector_type(2)));
typedef float f32x2_t __attribute__((ext_vector_type(2)));
typedef __bf16 bf16x2_t __attribute__((ext_vector_type(2)));

#ifndef EXP_QKT2
#define EXP_QKT2 0
#endif
#ifndef DUP_PHASE
#define DUP_PHASE -1
#endif
#ifndef N_LAUNCHES_PER_PHASE
#define N_LAUNCHES_PER_PHASE 0
#endif

constexpr int S = 8192, DM = 2048, NCAT = 9472;
constexpr int HD = 128, NKV = 4, NCMP = 511;
constexpr float EPS = 1e-6f;

constexpr size_t MiB = 1u << 20;
constexpr size_t WS_CTL = 0, CTL_BYTES = 1 * MiB;
constexpr size_t WS_WCAT = 1 * MiB;
constexpr size_t WS_SLAB = WS_WCAT;
constexpr size_t WS_ONSA = WS_WCAT;
constexpr size_t WS_MIXT = 54 * MiB;
constexpr size_t WS_WPOT = 55 * MiB;
constexpr size_t WS_WNOT = 59 * MiB;
constexpr size_t WS_WOT  = 67 * MiB;
constexpr size_t WS_W1KT = 75 * MiB, WS_W1VT = 77 * MiB;
constexpr size_t WS_W2KT = 79 * MiB, WS_W2VT = 79 * MiB + 65536;
constexpr size_t WS_B1P  = 80 * MiB + 262144;
constexpr size_t WS_B1   = 79 * MiB + 131072 + 32768;
constexpr size_t WS_KC   = 79 * MiB + 262144, WS_VC = 79 * MiB + 786432;
constexpr size_t WS_ROPE = 81 * MiB;
constexpr size_t WS_SSQ  = 85 * MiB;
constexpr size_t WS_H    = 86 * MiB;
constexpr size_t WS_U    = 118 * MiB, WS_GP = 134 * MiB;
constexpr size_t WS_YAG  = WS_U;
constexpr size_t WS_Q    = 150 * MiB;
constexpr size_t WS_KCR  = 182 * MiB, WS_VCR = 190 * MiB, WS_KS = 198 * MiB, WS_VS = 206 * MiB, WS_KW = 214 * MiB, WS_VW = 222 * MiB;
constexpr size_t WS_GN   = 230 * MiB;
constexpr size_t WS_GBR  = 262 * MiB;
constexpr size_t WS_K8S = 198 * MiB, WS_K8W = 202 * MiB;
constexpr size_t WS_V8S = 206 * MiB, WS_V8W = 210 * MiB;
constexpr size_t WS_V8TS = 214 * MiB, WS_V8TW = 218 * MiB;
constexpr size_t WS_ONSA8 = WS_WCAT + 32 * MiB;
constexpr float   ONSA_SCALE = 64.f, WNO_SCALE = 64.f;
constexpr size_t WS_H8   = 214 * MiB;
constexpr size_t WS_W8   = 38 * MiB;
constexpr float   W8_SCALE = 64.f;
constexpr size_t WS_Q8   = 266 * MiB;
constexpr size_t WS_END  = 282 * MiB;
constexpr int CW_BAR = 4096;

constexpr int RING_BYTES = 131072;
constexpr int LDSCTL_OFF = RING_BYTES, MISC_OFF = LDSCTL_OFF + 320;
constexpr int LDS_BYTES = 147456;
constexpr int NWAVES = 8;

#define LDS_WAIT() asm volatile("s_waitcnt lgkmcnt(0)" ::: "memory")
#define VM_WAIT() asm volatile("s_waitcnt vmcnt(0)" ::: "memory")

__device__ __forceinline__ unsigned cvtpk(float lo, float hi) { f32x2_t v = {lo, hi}; bf16x2_t b = __builtin_convertvector(v, bf16x2_t); return __builtin_bit_cast(unsigned, b); }
__device__ __forceinline__ float sat8(float x) { return __builtin_amdgcn_fmed3f(x, -448.f, 448.f); }
__device__ __forceinline__ unsigned cvt4_fp8(float a, float b, float c, float d) { int w = __builtin_amdgcn_cvt_pk_fp8_f32(a, b, 0, false); return (unsigned)__builtin_amdgcn_cvt_pk_fp8_f32(c, d, w, true); }
__device__ __forceinline__ float bf2f(unsigned short h) { return __builtin_bit_cast(float, (unsigned)h << 16); }
__device__ __forceinline__ float bflo(unsigned w) { return __builtin_bit_cast(float, w << 16); }
__device__ __forceinline__ float bfhi(unsigned w) { return __builtin_bit_cast(float, w & 0xffff0000u); }
__device__ __forceinline__ float sigmoidf_(float x) { return __builtin_amdgcn_rcpf(1.0f + __expf(-x)); }
__device__ __forceinline__ float siluf_(float x) { return x * __builtin_amdgcn_rcpf(1.0f + __expf(-x)); }
__device__ __forceinline__ int otid() { int t = threadIdx.x; asm volatile("" : "+v"(t)); return t; }
__device__ __forceinline__ unsigned dpp_x1(unsigned v) { return __builtin_amdgcn_update_dpp(0u, v, 0xB1, 0xF, 0xF, false); }
__device__ __forceinline__ unsigned dpp_x2(unsigned v) { return __builtin_amdgcn_update_dpp(0u, v, 0x4E, 0xF, 0xF, false); }
__device__ __forceinline__ unsigned dpp_m8(unsigned v) { return __builtin_amdgcn_update_dpp(0u, v, 0x141, 0xF, 0xF, false); }
__device__ __forceinline__ float dpp_x1f(float v) { return __uint_as_float(dpp_x1(__float_as_uint(v))); }
__device__ __forceinline__ int crow(int r, int hi) { return (r & 3) + 8 * (r >> 2) + 4 * hi; }
__device__ __forceinline__ float wave_sum(float v) {
#pragma unroll
    for (int o = 1; o < 64; o <<= 1) v += __shfl_xor(v, o);
    return v;
}

#define XB_TMO      128
#define XB_XCNT(j)  (256  + 64 * (j))
#define XB_XSUB(j)  (1280 + 64 * (j))
#define XB_XGEN(j)  (2304 + 64 * (j))
#define XB_TOP      3328
#define XB_TOPGEN   3392
#define XCD_BAR_WORDS 3456
#define XB_SPIN_CAP (1u << 18)
__device__ __forceinline__ unsigned xb_ld(unsigned* p)              { return __hip_atomic_load(p, __ATOMIC_RELAXED, __HIP_MEMORY_SCOPE_AGENT); }
__device__ __forceinline__ unsigned xb_add(unsigned* p, unsigned v) { return __hip_atomic_fetch_add(p, v, __ATOMIC_RELAXED, __HIP_MEMORY_SCOPE_AGENT); }
__device__ __forceinline__ unsigned xb_xcc_id() { return (unsigned)__builtin_amdgcn_s_getreg((3 << 11) | 20) & 0xFu; }
#define XB_SPIN(cond, bar) do { unsigned _sp = 0; while (cond) { __builtin_amdgcn_s_sleep(1); \
    if ((++_sp & 255u) == 0u) { if (xb_ld(&(bar)[XB_TMO])) break; if (_sp > XB_SPIN_CAP) { atomicAdd(&(bar)[XB_TMO], 1u); break; } } } } while (0)
struct XcdBarrier { unsigned* bar; unsigned x; volatile LAS unsigned* st; };
__device__ __forceinline__ XcdBarrier xcd_barrier_post(unsigned* bar, volatile LAS unsigned* st) {
    XcdBarrier b; b.bar = bar; b.x = xb_xcc_id(); b.st = st;
    if (threadIdx.x == 0) (void)xb_add(&bar[XB_XCNT(b.x)], 1u);
    return b;
}
__device__ __forceinline__ void xcd_barrier_complete(unsigned* bar, unsigned x, unsigned& nloc, unsigned& nx) {
    const unsigned G = gridDim.x * gridDim.y * gridDim.z;
    unsigned sum, cnt, mine, sp = 0u;
    for (;;) {
        sum = 0u; cnt = 0u; mine = 0u;
#pragma unroll
        for (unsigned j = 0; j < 16; ++j) { const unsigned c = xb_ld(&bar[XB_XCNT(j)]); sum += c; cnt += (c > 0u) ? 1u : 0u; mine = (j == x) ? c : mine; }
        if (sum == G) break;
        __builtin_amdgcn_s_sleep(1);
        if ((++sp & 255u) == 0u) { if (xb_ld(&bar[XB_TMO])) break; if (sp > XB_SPIN_CAP) { atomicAdd(&bar[XB_TMO], 1u); break; } }
    }
    nloc = mine > 0u ? mine : 1u; nx = cnt > 0u ? cnt : 1u;
}
__device__ __forceinline__ void xcd_barrier(const XcdBarrier& b) {
    asm volatile("s_waitcnt vmcnt(0)" ::: "memory");
    __syncthreads();
    if (threadIdx.x == 0) {
        unsigned* bar = b.bar;
        __builtin_amdgcn_s_waitcnt(0);
        unsigned nloc = b.st[0], nx = b.st[1];
        if (nloc == 0u) { xcd_barrier_complete(bar, b.x, nloc, nx); b.st[0] = nloc; b.st[1] = nx; }
        const unsigned old = xb_add(&bar[XB_XSUB(b.x)], 1u);
        const unsigned gen = old / nloc;
        if (old + 1u == (gen + 1u) * nloc) {
            __builtin_amdgcn_fence(__ATOMIC_RELEASE, "agent");
            asm volatile("s_waitcnt vmcnt(0)" ::: "memory");
            const unsigned og = xb_add(&bar[XB_TOP], 1u);
            const unsigned tg = og / nx;
            if (og + 1u == (tg + 1u) * nx) xb_add(&bar[XB_TOPGEN], 1u);
            else XB_SPIN(xb_ld(&bar[XB_TOPGEN]) == tg, bar);
            __builtin_amdgcn_fence(__ATOMIC_ACQUIRE, "agent");
            xb_add(&bar[XB_XGEN(b.x)], 1u);
            asm volatile("s_waitcnt vmcnt(0)" ::: "memory");
        } else {
            XB_SPIN(xb_ld(&bar[XB_XGEN(b.x)]) == gen, bar);
            __builtin_amdgcn_fence(__ATOMIC_ACQUIRE, "agent");
            asm volatile("s_waitcnt vmcnt(0)" ::: "memory");
        }
    }
    __syncthreads();
}

namespace pg8 {
constexpr int BM = 256, BK = 64, HALF = 128, HTB = HALF * BK * 2, STAGE_BYTES = 8 * HTB, NXCD = 8, WGM = 8;
__host__ __device__ __forceinline__ int lds_byte(int r, int c) { const int st = (r >> 4) * 2 + (c >> 5), rr = r & 15, cc = c & 31, ob = rr * 64 + cc * 2; return st * 1024 + (ob ^ (((ob >> 9) & 1) << 5)); }
__host__ __device__ __forceinline__ void stage_rc(int b, int& R, int& C) { const int st = b / 1024, sb = b % 1024, swz = sb ^ (((sb >> 9) & 1) << 5); R = (st >> 1) * 16 + swz / 64; C = (st & 1) * 32 + (swz % 64) / 2; }
__host__ __device__ __forceinline__ int perm32(int rho) { const int n = rho >> 4, i = rho & 15; return 8 * (i >> 2) + 4 * n + (i & 3); }
struct Unit { int pm, pn; };
struct Gemm { const bf16_t* A; const bf16_t* Bt; int lda, ldb, K; };
struct AddrAffine { size_t tA, tB;
    __device__ __forceinline__ const char* A(const char* b, const Unit& u) const { return b + (size_t)u.pm * tA; }
    __device__ __forceinline__ const char* B(const char* b, const Unit& u) const { return b + (size_t)u.pn * tB; }
    __device__ __forceinline__ size_t ka(int t) const { return (size_t)t * (BK * 2); } };
struct AddrCmp { int ntile;
    __device__ __forceinline__ const char* A(const char* b, const Unit& u) const { return b + (size_t)(u.pm >> 3) * (8 * MiB) + (size_t)((u.pm >> 1) & 3) * (2 * MiB) + (size_t)(u.pm & 1) * (256 * 4096) + ka(u.pn * ntile); }
    __device__ __forceinline__ const char* B(const char* b, const Unit& u) const { return b + (size_t)(u.pm >> 3) * (2 * MiB) + (size_t)u.pn * ntile * (BK * 2); }
    __device__ __forceinline__ size_t ka(int t) const { return (size_t)t * (BK * 2); } };
struct StaticOrder {
    int nM, nN, nwg, G, c;
    __host__ __device__ void init(int M, int N, int G_, int c_) { nM = M / BM; nN = N / BM; nwg = nM * nN; G = G_; c = c_; }
    __host__ __device__ bool next(int i, Unit& u) const {
        const long L = (long)i * G + c; if (L >= nwg) return false;
        int wgid = (int)L; { const int q = nwg / NXCD, r = nwg % NXCD, xcd = wgid % NXCD, off = wgid / NXCD; wgid = (xcd < r ? xcd * (q + 1) : r * (q + 1) + (xcd - r) * q) + off; }
        const int nig = WGM * nN, gid = wgid / nig, fm = gid * WGM, gsz = (nM - fm) < WGM ? (nM - fm) : WGM;
        u.pm = fm + ((wgid % nig) % gsz); u.pn = (wgid % nig) / gsz; return true;
    }
};
typedef int v8i_g __attribute__((ext_vector_type(8)));
typedef int v4i_g __attribute__((ext_vector_type(4)));
template <class Epi, bool ALIGN_EPI, class Addr, bool FP8 = false>
__device__ __forceinline__ void gemm_phase(LAS unsigned char* lds, const Gemm g, const StaticOrder& S, const Epi& E, const Addr& AD) {
    const int tid = otid(), wid = __builtin_amdgcn_readfirstlane(tid >> 6), lane = tid & 63, wr = wid >> 2, wc = wid & 3, fr = lane & 15, fq = lane >> 4;
    const int K = g.K, nt = K / BK;
    unsigned voffA[2], voffB[2];
#pragma unroll
    for (int i = 0; i < 2; ++i) { int R, C; stage_rc(tid * 16 + i * 8192, R, C); const int Rb = (R & ~31) + perm32(R & 31);
        voffA[i] = (unsigned)(R * g.lda + C) * 2u; voffB[i] = (unsigned)(Rb * g.ldb + C) * 2u; }
    const size_t kstep = (size_t)(BK * 2);
    const size_t hA = (size_t)HALF * g.lda * 2, hB = (size_t)HALF * g.ldb * 2;
    const unsigned ldsw = (unsigned)wid * 1024u;
    const int aoff = lds_byte(wr * 64 + fr, fq * 8), boff = lds_byte(wc * 32 + fr, fq * 8);
#define PG8_SA(b, h) (((b) * 2 + (h)) * HTB)
#define PG8_SB(b, h) ((4 + (b) * 2 + (h)) * HTB)
#define PG8_STAGE(bufoff, gbase, voff) do { _Pragma("unroll") for (int _i = 0; _i < 2; ++_i) \
        __builtin_amdgcn_global_load_lds((const unsigned*)((const char*)(gbase) + (voff)[_i]), (LAS unsigned*)(lds + (bufoff) + ldsw + _i * 8192), 16, 0, 0); } while (0)
#define PG8_LDA(dst, b, h) do { _Pragma("unroll") for (int m = 0; m < 4; ++m) _Pragma("unroll") for (int k = 0; k < 2; ++k) dst[m][k] = *(const LAS bf16x8*)(lds + PG8_SA(b, h) + aoff + m * 2048 + k * 1024); } while (0)
#define PG8_LDB(dst, b, h) do { _Pragma("unroll") for (int n = 0; n < 2; ++n) _Pragma("unroll") for (int k = 0; k < 2; ++k) dst[n][k] = *(const LAS bf16x8*)(lds + PG8_SB(b, h) + boff + n * 2048 + k * 1024); } while (0)
#define PG8_LD8(p_) __builtin_shufflevector(*(const LAS v4i_g*)(p_), *(const LAS v4i_g*)((p_) + 1024), 0, 1, 2, 3, 4, 5, 6, 7)
#define PG8_LDA8(dst, b, h) do { _Pragma("unroll") for (int m = 0; m < 4; ++m) dst[m] = PG8_LD8(lds + PG8_SA(b, h) + aoff + m * 2048); } while (0)
#define PG8_LDB8(dst, b, h) do { _Pragma("unroll") for (int n = 0; n < 2; ++n) dst[n] = PG8_LD8(lds + PG8_SB(b, h) + boff + n * 2048); } while (0)
#define PG8_MMA16(ai, bj, At, Bt) do { __builtin_amdgcn_s_setprio(1); _Pragma("unroll") for (int m = 0; m < 4; ++m) _Pragma("unroll") for (int n = 0; n < 2; ++n) _Pragma("unroll") for (int k = 0; k < 2; ++k) \
        acc[ai][bj][m][n] = __builtin_amdgcn_mfma_f32_16x16x32_bf16(Bt[n][k], At[m][k], acc[ai][bj][m][n], 0, 0, 0); __builtin_amdgcn_s_setprio(0); } while (0)
#define PG8_MMA8(ai, bj, At, Bt) do { __builtin_amdgcn_s_setprio(1); _Pragma("unroll") for (int m = 0; m < 4; ++m) _Pragma("unroll") for (int n = 0; n < 2; ++n) \
        asm volatile("v_mfma_scale_f32_16x16x128_f8f6f4 %0, %1, %2, %0, %3, %3 op_sel_hi:[0,0,0]" : "+v"(acc[ai][bj][m][n]) : "v"(Bt[n]), "v"(At[m]), "v"(sc8_)); __builtin_amdgcn_s_setprio(0); } while (0)
#define PG8_WAIT_V(n) asm volatile("s_waitcnt vmcnt(" #n ")" ::: "memory")
#define PG8_WAIT_L(n) asm volatile("s_waitcnt lgkmcnt(" #n ")" ::: "memory")
#define PG8_BAR __builtin_amdgcn_s_barrier()
#define PG8_SCHED __builtin_amdgcn_sched_barrier(0)
#define PG8_KBODY(LDA_, LDB_, MMA_, At, B0, B1) do { \
            LDB_(B0, 0, 0); LDB_(B1, 0, 1); PG8_SCHED; LDA_(At, 0, 0); PG8_STAGE(PG8_SA(1, 1), a1 + hA, voffA); \
            PG8_WAIT_V(8); PG8_WAIT_L(0); PG8_BAR; MMA_(0, 0, At, B0); MMA_(0, 1, At, B1); PG8_BAR; PG8_SCHED; \
            LDA_(At, 0, 1); PG8_STAGE(PG8_SB(0, 0), b2, voffB); PG8_STAGE(PG8_SB(0, 1), b2 + hB, voffB); PG8_STAGE(PG8_SA(0, 0), a2, voffA); \
            PG8_WAIT_V(8); PG8_WAIT_L(0); PG8_BAR; MMA_(1, 0, At, B0); MMA_(1, 1, At, B1); PG8_BAR; PG8_SCHED; \
            LDB_(B0, 1, 0); LDB_(B1, 1, 1); PG8_SCHED; LDA_(At, 1, 0); PG8_STAGE(PG8_SA(0, 1), a2 + hA, voffA); \
            PG8_WAIT_V(8); PG8_WAIT_L(0); PG8_BAR; MMA_(0, 0, At, B0); MMA_(0, 1, At, B1); PG8_BAR; PG8_SCHED; \
            LDA_(At, 1, 1); PG8_STAGE(PG8_SB(1, 0), b3, voffB); PG8_STAGE(PG8_SB(1, 1), b3 + hB, voffB); PG8_STAGE(PG8_SA(1, 0), a3, voffA); \
            PG8_WAIT_V(8); PG8_WAIT_L(0); PG8_BAR; MMA_(1, 0, At, B0); MMA_(1, 1, At, B1); PG8_BAR; PG8_SCHED; } while (0)
    Unit cur, nxt; int ui = 0;
    if (!S.next(0, cur)) return;
    f32x4 acc[2][2][4][2];
#pragma unroll
    for (int a = 0; a < 2; ++a)
#pragma unroll
        for (int b = 0; b < 2; ++b)
#pragma unroll
            for (int m = 0; m < 4; ++m)
#pragma unroll
                for (int n = 0; n < 2; ++n) acc[a][b][m][n] = (f32x4){0.f, 0.f, 0.f, 0.f};
    bf16x8 At16[4][2], B016[2][2], B116[2][2]; v8i_g At8[4], B08[2], B18[2]; const int sc8_ = 0x7F7F7F7F;
    const char* cA = AD.A((const char*)g.A, cur); const char* cB = AD.B((const char*)g.Bt, cur);
    PG8_STAGE(PG8_SB(0, 0), cB, voffB); PG8_STAGE(PG8_SB(0, 1), cB + hB, voffB); PG8_STAGE(PG8_SA(0, 0), cA, voffA); PG8_STAGE(PG8_SA(0, 1), cA + hA, voffA);
    if (wr == 1) PG8_BAR;
    PG8_WAIT_V(2); PG8_BAR;
    PG8_STAGE(PG8_SB(1, 0), cB + kstep, voffB); PG8_STAGE(PG8_SA(1, 0), cA + kstep, voffA); PG8_STAGE(PG8_SB(1, 1), cB + hB + kstep, voffB);
    PG8_WAIT_V(6); PG8_BAR;
    for (;;) {
        const bool has_next = S.next(ui + 1, nxt);
        const char* nA = has_next ? AD.A((const char*)g.A, nxt) : cA; const char* nB = has_next ? AD.B((const char*)g.Bt, nxt) : cB;
        for (int t = 0; t < nt; t += 2) {
            const bool last = (t == nt - 2);
            const char* a1 = cA + AD.ka(t) + kstep;
            const char* a2 = last ? nA : cA + AD.ka(t + 2); const char* b2 = last ? nB : cB + (size_t)(t + 2) * kstep;
            const char* a3 = a2 + kstep; const char* b3 = b2 + kstep;
            if constexpr (FP8) PG8_KBODY(PG8_LDA8, PG8_LDB8, PG8_MMA8, At8, B08, B18); else PG8_KBODY(PG8_LDA, PG8_LDB, PG8_MMA16, At16, B016, B116);
        }
        if constexpr (ALIGN_EPI) { if (wr == 0) PG8_BAR; }
        if constexpr (FP8) asm volatile("s_nop 15\n\ts_nop 7" ::: "memory");
        E(acc, cur, wr, wc, fr, fq);
        if (!has_next) break;
#pragma unroll
        for (int a = 0; a < 2; ++a)
#pragma unroll
            for (int b = 0; b < 2; ++b)
#pragma unroll
                for (int m = 0; m < 4; ++m)
#pragma unroll
                    for (int n = 0; n < 2; ++n) acc[a][b][m][n] = (f32x4){0.f, 0.f, 0.f, 0.f};
        cur = nxt; cA = nA; cB = nB; ++ui;
        if constexpr (ALIGN_EPI) { if (wr == 1) PG8_BAR; }
    }
    PG8_WAIT_V(0);
    if constexpr (!ALIGN_EPI) { if (wr == 0) PG8_BAR; }
    PG8_BAR;
#undef PG8_SA
#undef PG8_SB
#undef PG8_STAGE
#undef PG8_LDA
#undef PG8_LDB
#undef PG8_MMA16
#undef PG8_MMA8
#undef PG8_KBODY
#undef PG8_LD8
#undef PG8_LDA8
#undef PG8_LDB8
#undef PG8_WAIT_V
#undef PG8_WAIT_L
#undef PG8_BAR
#undef PG8_SCHED
}
template <class Epi>
__device__ __forceinline__ void gemm_phase2(LAS unsigned char* lds, const Gemm g0, const Gemm g1, const StaticOrder& S, const Epi& E) {
    int tid = otid(); const int wid = __builtin_amdgcn_readfirstlane(tid >> 6), lane = tid & 63, wr = wid >> 2, wc = wid & 3, fr = lane & 15, fq = lane >> 4;
#define PG8_MKOFF(vA, vB, G) do { _Pragma("unroll") for (int i_ = 0; i_ < 2; ++i_) { int R_, C_; stage_rc(tid * 16 + i_ * 8192, R_, C_); const int Rb_ = (R_ & ~31) + perm32(R_ & 31); \
        (vA)[i_] = (unsigned)(R_ * (G).lda + C_) * 2u; (vB)[i_] = (unsigned)(Rb_ * (G).ldb + C_) * 2u; } } while (0)
    const size_t kstep = (size_t)(BK * 2);
    const size_t hA0 = (size_t)HALF * g0.lda * 2, hB0 = (size_t)HALF * g0.ldb * 2, hA1 = hA0, hB1 = hB0;
    unsigned ldsw = (unsigned)wid * 1024u;
    int aoff = lds_byte(wr * 64 + fr, fq * 8), boff = lds_byte(wc * 32 + fr, fq * 8);
#define PG8_SA(b, h) (((b) * 2 + (h)) * HTB)
#define PG8_SB(b, h) ((4 + (b) * 2 + (h)) * HTB)
#define PG8_STAGE(bufoff, gbase, voff) do { _Pragma("unroll") for (int _i = 0; _i < 2; ++_i) \
        __builtin_amdgcn_global_load_lds((const unsigned*)((const char*)(gbase) + (voff)[_i]), (LAS unsigned*)(lds + (bufoff) + ldsw + _i * 8192), 16, 0, 0); } while (0)
#define PG8_LDA(dst, b, h) do { _Pragma("unroll") for (int m = 0; m < 4; ++m) _Pragma("unroll") for (int k = 0; k < 2; ++k) dst[m][k] = *(const LAS bf16x8*)(lds + PG8_SA(b, h) + aoff + m * 2048 + k * 1024); } while (0)
#define PG8_LDB(dst, b, h) do { _Pragma("unroll") for (int n = 0; n < 2; ++n) _Pragma("unroll") for (int k = 0; k < 2; ++k) dst[n][k] = *(const LAS bf16x8*)(lds + PG8_SB(b, h) + boff + n * 2048 + k * 1024); } while (0)
#define PG8_LD8(p_) __builtin_shufflevector(*(const LAS v4i_g*)(p_), *(const LAS v4i_g*)((p_) + 1024), 0, 1, 2, 3, 4, 5, 6, 7)
#define PG8_LDA8(dst, b, h) do { _Pragma("unroll") for (int m = 0; m < 4; ++m) dst[m] = PG8_LD8(lds + PG8_SA(b, h) + aoff + m * 2048); } while (0)
#define PG8_LDB8(dst, b, h) do { _Pragma("unroll") for (int n = 0; n < 2; ++n) dst[n] = PG8_LD8(lds + PG8_SB(b, h) + boff + n * 2048); } while (0)
#define PG8_MMA16(ai, bj, At, Bt) do { __builtin_amdgcn_s_setprio(1); _Pragma("unroll") for (int m = 0; m < 4; ++m) _Pragma("unroll") for (int n = 0; n < 2; ++n) _Pragma("unroll") for (int k = 0; k < 2; ++k) \
        acc[ai][bj][m][n] = __builtin_amdgcn_mfma_f32_16x16x32_bf16(Bt[n][k], At[m][k], acc[ai][bj][m][n], 0, 0, 0); __builtin_amdgcn_s_setprio(0); } while (0)
#define PG8_MMA8(ai, bj, At, Bt) do { __builtin_amdgcn_s_setprio(1); _Pragma("unroll") for (int m = 0; m < 4; ++m) _Pragma("unroll") for (int n = 0; n < 2; ++n) \
        asm volatile("v_mfma_scale_f32_16x16x128_f8f6f4 %0, %1, %2, %0, %3, %3 op_sel_hi:[0,0,0]" : "+v"(acc[ai][bj][m][n]) : "v"(Bt[n]), "v"(At[m]), "v"(sc8_)); __builtin_amdgcn_s_setprio(0); } while (0)
#define PG8_WAIT_V(n) asm volatile("s_waitcnt vmcnt(" #n ")" ::: "memory")
#define PG8_WAIT_L(n) asm volatile("s_waitcnt lgkmcnt(" #n ")" ::: "memory")
#define PG8_BAR __builtin_amdgcn_s_barrier()
#define PG8_SCHED __builtin_amdgcn_sched_barrier(0)
    Unit cur;
    if (!S.next(0, cur)) return;
    f32x4 acc[2][2][4][2];
#define PG8_ZERO() do { _Pragma("unroll") for (int a = 0; a < 2; ++a) _Pragma("unroll") for (int b = 0; b < 2; ++b) _Pragma("unroll") for (int m = 0; m < 4; ++m) _Pragma("unroll") for (int n = 0; n < 2; ++n) acc[a][b][m][n] = (f32x4){0.f, 0.f, 0.f, 0.f}; } while (0)
    PG8_ZERO();
    bf16x8 At[4][2], B0[2][2], B1[2][2];
    const char* cA = (const char*)g0.A + (size_t)cur.pm * (2 * hA0); const char* cB = (const char*)g0.Bt + (size_t)cur.pn * (2 * hB0);
    unsigned voffA[2], voffB[2]; PG8_MKOFF(voffA, voffB, g0); const size_t hA = hA0, hB = hB0;
    PG8_STAGE(PG8_SB(0, 0), cB, voffB); PG8_STAGE(PG8_SB(0, 1), cB + hB, voffB); PG8_STAGE(PG8_SA(0, 0), cA, voffA); PG8_STAGE(PG8_SA(0, 1), cA + hA, voffA);
    if (wr == 1) PG8_BAR;
    PG8_WAIT_V(2); PG8_BAR;
    PG8_STAGE(PG8_SB(1, 0), cB + kstep, voffB); PG8_STAGE(PG8_SA(1, 0), cA + kstep, voffA); PG8_STAGE(PG8_SB(1, 1), cB + hB + kstep, voffB);
    PG8_WAIT_V(6); PG8_BAR;
#define PG8_KLOOP(MMA, LDA_, LDB_, At, B0, B1, NT, HASNEXT) do { const int nt = (NT);                                                                            \
        const char* nA = (HASNEXT) ? (const char*)g1.A + (size_t)cur.pm * (2 * hA1) : cA; const char* nB = (HASNEXT) ? (const char*)g1.Bt + (size_t)cur.pn * (2 * hB1) : cB; \
        for (int t = 0; t < nt; t += 2) {                                                                                              \
            const bool last = (t == nt - 2);                                                                                           \
            const char* a1 = cA + (size_t)(t + 1) * kstep;                                                                             \
            const char* a2 = last ? nA : cA + (size_t)(t + 2) * kstep; const char* b2 = last ? nB : cB + (size_t)(t + 2) * kstep;       \
            const char* a3 = a2 + kstep; const char* b3 = b2 + kstep;                                                                  \
            LDB_(B0, 0, 0); LDB_(B1, 0, 1); PG8_SCHED; LDA_(At, 0, 0); PG8_STAGE(PG8_SA(1, 1), a1 + hA, voffA);                \
            PG8_WAIT_V(8); PG8_WAIT_L(0); PG8_BAR; MMA(0, 0, At, B0); MMA(0, 1, At, B1); PG8_BAR; PG8_SCHED;                            \
            LDA_(At, 0, 1); PG8_STAGE(PG8_SB(0, 0), b2, voffB); PG8_STAGE(PG8_SB(0, 1), b2 + hB, voffB); PG8_STAGE(PG8_SA(0, 0), a2, voffA); \
            PG8_WAIT_V(8); PG8_WAIT_L(0); PG8_BAR; MMA(1, 0, At, B0); MMA(1, 1, At, B1); PG8_BAR; PG8_SCHED;                            \
            LDB_(B0, 1, 0); LDB_(B1, 1, 1); PG8_SCHED; LDA_(At, 1, 0); PG8_STAGE(PG8_SA(0, 1), a2 + hA, voffA);              \
            PG8_WAIT_V(8); PG8_WAIT_L(0); PG8_BAR; MMA(0, 0, At, B0); MMA(0, 1, At, B1); PG8_BAR; PG8_SCHED;                            \
            LDA_(At, 1, 1); PG8_STAGE(PG8_SB(1, 0), b3, voffB); PG8_STAGE(PG8_SB(1, 1), b3 + hB, voffB); PG8_STAGE(PG8_SA(1, 0), a3, voffA); \
            PG8_WAIT_V(8); PG8_WAIT_L(0); PG8_BAR; MMA(1, 0, At, B0); MMA(1, 1, At, B1); PG8_BAR; PG8_SCHED;                            \
        }                                                                                                                              \
        if (HASNEXT) { cA = nA; cB = nB; } } while (0)
    PG8_KLOOP(PG8_MMA16, PG8_LDA, PG8_LDB, At, B0, B1, g0.K / BK, true);
    if (wr == 0) PG8_BAR;
    E(acc, cur, 0, wr, wc, fr, fq);
    PG8_ZERO();
    { tid = otid(); const int l2 = tid & 63, w2 = __builtin_amdgcn_readfirstlane(tid >> 6);
      ldsw = (unsigned)w2 * 1024u; aoff = lds_byte((w2 >> 2) * 64 + (l2 & 15), (l2 >> 4) * 8); boff = lds_byte((w2 & 3) * 32 + (l2 & 15), (l2 >> 4) * 8); PG8_MKOFF(voffA, voffB, g1); }
    if (wr == 1) PG8_BAR;
    { v8i_g At8[4], B08[2], B18[2]; const int sc8_ = 0x7F7F7F7F;
      PG8_KLOOP(PG8_MMA8, PG8_LDA8, PG8_LDB8, At8, B08, B18, g1.K / BK, false); }
    asm volatile("s_nop 15\n\ts_nop 7" ::: "memory");
    if (wr == 0) PG8_BAR;
    E(acc, cur, 1, wr, wc, fr, fq);
    PG8_WAIT_V(0);
    PG8_BAR;
#undef PG8_KLOOP
#undef PG8_ZERO
#undef PG8_MMA16
#undef PG8_MMA8
#undef PG8_SA
#undef PG8_SB
#undef PG8_STAGE
#undef PG8_LDA
#undef PG8_LDB
#undef PG8_WAIT_V
#undef PG8_WAIT_L
#undef PG8_BAR
#undef PG8_SCHED
#undef PG8_MKOFF
#undef PG8_LD8
#undef PG8_LDA8
#undef PG8_LDB8
}
}

typedef f32x4 Acc[2][2][4][2];
__device__ __forceinline__ u32x4 pack8(f32x4 a, f32x4 b) { u32x4 w; w.x = cvtpk(a[0], a[1]); w.y = cvtpk(a[2], a[3]); w.z = cvtpk(b[0], b[1]); w.w = cvtpk(b[2], b[3]); return w; }
__device__ __forceinline__ void unpack8(u32x4 w, f32x4& a, f32x4& b) { a = (f32x4){bflo(w.x), bfhi(w.x), bflo(w.y), bfhi(w.y)}; b = (f32x4){bflo(w.z), bfhi(w.z), bflo(w.w), bfhi(w.w)}; }

struct EpiInProj {
    unsigned char* ws; bf16_t* gm; const float* bmerge; int pn_off;
    __device__ __forceinline__ void operator()(const Acc& acc, const pg8::Unit& u, int wr, int wc, int fr, int fq) const {
        const int pn = u.pn + pn_off;
        bf16_t* dst; int ldc, cb, mode; size_t bjs = 128; unsigned char* dst8 = nullptr; float ascale = 1.0f;
        if (pn < 4)       { dst = (bf16_t*)(ws + WS_U);   ldc = 1024; cb = pn * 256;        mode = 0; }
        else if (pn < 8)  { dst = (bf16_t*)(ws + WS_GP);  ldc = 1024; cb = (pn - 4) * 256;  mode = 1; }
        else if (pn < 12) { const int k = (pn - 8) >> 1; dst = (bf16_t*)(ws + WS_KCR + (size_t)k * (8 * MiB)); mode = 0;
                            ldc = 128; cb = 0; bjs = (size_t)S * 128; dst += (size_t)((pn - 8) & 1) * 2 * S * 128; }
        else if (pn < 20) { dst = (bf16_t*)(ws + WS_GN);  ldc = 2048; cb = (pn - 12) * 256; mode = 1; }
        else if (pn < 36) { dst = gm;                     ldc = 4096; cb = (pn - 20) * 256; mode = 2; }
        else if (pn < 37) { dst = (bf16_t*)(ws + WS_GBR); ldc = 256;  cb = 0;               mode = 4; }
        else if (pn < 45) { dst = (bf16_t*)(ws + WS_Q);   ldc = 2048; cb = (pn - 37) * 256; mode = 3; dst8 = ws + WS_Q8; ascale = 1.0f / W8_SCALE; }
        else              { const int k = (pn - 45) >> 1;
                            dst = nullptr; dst8 = ws + (k == 0 ? WS_K8S : k == 1 ? WS_V8S : k == 2 ? WS_K8W : WS_V8W); ldc = 512; cb = ((pn - 45) & 1) * 256; mode = (k == 0 || k == 2) ? 3 : 0; ascale = 1.0f / W8_SCALE; }
        const int row0 = u.pm * 256 + wr * 64 + fr, cl = wc * 32 + 8 * fq, col0 = cb + cl;
        const float* rcos = (const float*)(ws + WS_ROPE); const float* rsin = rcos + (size_t)S * 64;
#pragma unroll
        for (int ai = 0; ai < 2; ++ai)
#pragma unroll
            for (int m = 0; m < 4; ++m) {
                const int row = row0 + ai * 128 + m * 16;
                bf16_t* rowp = dst + (size_t)row * ldc + col0;
                f32x4 cs0, cs1, sn0, sn1;
                if (mode == 3) { const int i0 = (cl & 127) >> 1; cs0 = *(const f32x4*)(rcos + (size_t)row * 64 + i0); sn0 = *(const f32x4*)(rsin + (size_t)row * 64 + i0); }
#pragma unroll
                for (int bj = 0; bj < 2; ++bj) {
                    f32x4 v0 = acc[ai][bj][m][0] * ascale, v1 = acc[ai][bj][m][1] * ascale;
                    if (mode == 1) { for (int e = 0; e < 4; ++e) { v0[e] = siluf_(v0[e]); v1[e] = siluf_(v1[e]); } }
                    else if (mode == 2 || mode == 4) { if (mode == 2) { v0 = v0 + *(const f32x4*)(bmerge + col0 + bj * 128); v1 = v1 + *(const f32x4*)(bmerge + col0 + bj * 128 + 4); } for (int e = 0; e < 4; ++e) { v0[e] = sigmoidf_(v0[e]); v1[e] = sigmoidf_(v1[e]); } }
                    else if (mode == 3) {
                        f32x4 o0, o1;
                        o0[0] = v0[0] * cs0[0] - v0[1] * sn0[0]; o0[1] = v0[1] * cs0[0] + v0[0] * sn0[0];
                        o0[2] = v0[2] * cs0[1] - v0[3] * sn0[1]; o0[3] = v0[3] * cs0[1] + v0[2] * sn0[1];
                        o1[0] = v1[0] * cs0[2] - v1[1] * sn0[2]; o1[1] = v1[1] * cs0[2] + v1[0] * sn0[2];
                        o1[2] = v1[2] * cs0[3] - v1[3] * sn0[3]; o1[3] = v1[3] * cs0[3] + v1[2] * sn0[3];
                        v0 = o0; v1 = o1;
                    }
                    if (dst) *(u32x4*)(rowp + bj * bjs) = pack8(v0, v1);
                    if (dst8) { u32x2 w8; w8.x = cvt4_fp8(sat8(v0[0]), sat8(v0[1]), sat8(v0[2]), sat8(v0[3])); w8.y = cvt4_fp8(sat8(v1[0]), sat8(v1[1]), sat8(v1[2]), sat8(v1[3])); *(u32x2*)(dst8 + (size_t)row * ldc + col0 + bj * 128) = w8; }
                }
            }
    }
};
struct EpiYa {
    bf16_t* yag; const bf16_t* gm;
    __device__ __forceinline__ void operator()(const Acc& acc, const pg8::Unit& u, int wr, int wc, int fr, int fq) const {
        const int row0 = u.pm * 256 + wr * 64 + fr, col0 = u.pn * 256 + wc * 32 + 8 * fq;
#pragma unroll
        for (int ai = 0; ai < 2; ++ai)
#pragma unroll
            for (int m = 0; m < 4; ++m) { int ro_ = ai * 128 + m * 16; asm volatile("" : "+v"(ro_)); const size_t r = (size_t)(row0 + ro_);
#pragma unroll
                for (int bj = 0; bj < 2; ++bj) { f32x4 g0, g1; unpack8(*(const u32x4*)(gm + r * 4096 + col0 + bj * 128), g0, g1);
                    *(u32x4*)(yag + r * 2048 + col0 + bj * 128) = pack8(acc[ai][bj][m][0] * g0, acc[ai][bj][m][1] * g1); }
                if (m & 1) asm volatile("" ::: "memory"); }
    }
};
struct EpiYb {
    bf16_t* merged; const bf16_t* yag; const bf16_t* gm; float ascale;
    __device__ __forceinline__ void operator()(const Acc& acc, const pg8::Unit& u, int wr, int wc, int fr, int fq) const {
        const int row0 = u.pm * 256 + wr * 64 + fr, col0 = u.pn * 256 + wc * 32 + 8 * fq;
#pragma unroll
        for (int ai = 0; ai < 2; ++ai)
#pragma unroll
            for (int m = 0; m < 4; ++m) { int ro_ = ai * 128 + m * 16; asm volatile("" : "+v"(ro_)); const size_t r = (size_t)(row0 + ro_);
#pragma unroll
                for (int bj = 0; bj < 2; ++bj) { f32x4 g0, g1, y0, y1; unpack8(*(const u32x4*)(gm + r * 4096 + 2048 + col0 + bj * 128), g0, g1);
                    unpack8(*(const u32x4*)(yag + r * 2048 + col0 + bj * 128), y0, y1);
                    *(u32x4*)(merged + r * 2048 + col0 + bj * 128) = pack8(y0 + acc[ai][bj][m][0] * ascale * g0, y1 + acc[ai][bj][m][1] * ascale * g1); }
                if (m & 1) asm volatile("" ::: "memory"); }
    }
};
struct EpiYaYb {
    EpiYa ya; EpiYb yb;
    __device__ __forceinline__ void operator()(const Acc& acc, const pg8::Unit& u, int kind, int wr, int wc, int fr, int fq) const {
        if (kind == 0) { ya(acc, u, wr, wc, fr, fq); asm volatile("s_waitcnt vmcnt(0)" ::: "memory"); } else yb(acc, u, wr, wc, fr, fq);
    }
};
constexpr int NSPLIT = 8;
struct EpiSlab {
    float* slab;
    __device__ __forceinline__ void operator()(const Acc& acc, const pg8::Unit& u, int wr, int wc, int fr, int fq) const {
        float* base = slab + ((size_t)((u.pm >> 3) * NSPLIT + u.pn) * 2048 + (size_t)(u.pm & 7) * 256 + wr * 64 + fr) * 256 + wc * 32 + 8 * fq;
#pragma unroll
        for (int ai = 0; ai < 2; ++ai)
#pragma unroll
            for (int m = 0; m < 4; ++m)
#pragma unroll
                for (int bj = 0; bj < 2; ++bj) { float* p = base + (size_t)(ai * 128 + m * 16) * 256 + bj * 128; *(f32x4*)p = acc[ai][bj][m][0]; *(f32x4*)(p + 4) = acc[ai][bj][m][1]; }
    }
};
constexpr int CW_PANEL = 16384;
constexpr int EPI_LDS_OFF = RING_BYTES + 1024;
struct EpiOut {
    float* out; const float* x; float* ssq; const float* fw; unsigned* ctl; LAS unsigned char* lds;
    __device__ __forceinline__ void operator()(const Acc& acc_, const pg8::Unit& u, int wr, int wc, int fr, int fq) const {
        Acc& acc = const_cast<Acc&>(acc_);
        const int tid = otid();
        const int row0 = u.pm * 256 + wr * 64 + fr, col0 = u.pn * 256 + wc * 32 + 8 * fq;
        LAS float* rs = (LAS float*)(lds + EPI_LDS_OFF);
#pragma unroll
        for (int ai = 0; ai < 2; ++ai)
#pragma unroll
            for (int m = 0; m < 4; ++m) { const size_t r = (size_t)(row0 + ai * 128 + m * 16); float q = 0.f;
#pragma unroll
                for (int bj = 0; bj < 2; ++bj)
#pragma unroll
                    for (int n = 0; n < 2; ++n) { const size_t o = r * 2048 + col0 + bj * 128 + 4 * n; const f32x4 v = *(const f32x4*)(x + o) + acc[ai][bj][m][n];
                        acc[ai][bj][m][n] = v; q += (v[0] * v[0] + v[1] * v[1]) + (v[2] * v[2] + v[3] * v[3]); }
                q += __shfl_xor(q, 16); q += __shfl_xor(q, 32);
                if (fq == 0) __hip_atomic_store((unsigned*)(ssq + (size_t)(u.pn * 4 + wc) * S + r), __float_as_uint(q), __ATOMIC_RELAXED, __HIP_MEMORY_SCOPE_AGENT); }
        asm volatile("s_waitcnt vmcnt(0)" ::: "memory");
        __syncthreads();
        if (tid == 0) { unsigned* c = ctl + CW_PANEL + 64 * u.pm;
            __hip_atomic_fetch_add(c, 1u, __ATOMIC_RELAXED, __HIP_MEMORY_SCOPE_AGENT);
            unsigned sp = 0; while (__hip_atomic_load(c, __ATOMIC_RELAXED, __HIP_MEMORY_SCOPE_AGENT) < 8u) { __builtin_amdgcn_s_sleep(2); if (++sp > (1u << 22)) break; }
            __builtin_amdgcn_fence(__ATOMIC_ACQUIRE, "agent"); asm volatile("s_waitcnt vmcnt(0)" ::: "memory"); }
        __syncthreads();
        if (tid < 256) { const size_t r = (size_t)u.pm * 256 + tid; float s = 0.f;
#pragma unroll 8
            for (int p = 0; p < 32; ++p) s += __uint_as_float(__hip_atomic_load((unsigned*)(ssq + (size_t)p * S + r), __ATOMIC_RELAXED, __HIP_MEMORY_SCOPE_AGENT));
            rs[tid] = 1.0f / sqrtf(s * (1.f / DM) + EPS); }
        __syncthreads();
#pragma unroll
        for (int ai = 0; ai < 2; ++ai)
#pragma unroll
            for (int m = 0; m < 4; ++m) { const int rl = wr * 64 + fr + ai * 128 + m * 16; const float sc = rs[rl]; const size_t r = (size_t)u.pm * 256 + rl;
#pragma unroll
                for (int bj = 0; bj < 2; ++bj)
#pragma unroll
                    for (int n = 0; n < 2; ++n) { const size_t o = r * 2048 + col0 + bj * 128 + 4 * n; *(f32x4*)(out + o) = acc[ai][bj][m][n] * sc * *(const f32x4*)(fw + col0 + bj * 128 + 4 * n); } }
    }
};

struct Args { const float* in[17]; float* out; unsigned char* ws; int ph_lo, ph_hi; };
struct Frame { LAS unsigned char* lds; int tid, lane, wave, vcu, G; };

__device__ __forceinline__ int ropeperm(int d) { return d < 64 ? 2 * d : 2 * (d - 64) + 1; }
__device__ __forceinline__ void transpose_item(const float* W, int ldw, int Nvalid, bf16_t* WT, int ldt, int row_off, bool perm, LAS float* scr, int kb, int nb, int lane, float f8scale = 0.f) {
    const int k0 = 64 * kb, n0 = 32 * nb, cq = lane & 7, rb = lane >> 3; const bool ok = n0 + cq * 4 < Nvalid;
    f32x4 v[8];
#pragma unroll
    for (int i = 0; i < 8; ++i) v[i] = ok ? *(const f32x4*)(W + (size_t)(k0 + i * 8 + rb) * ldw + n0 + cq * 4) : (f32x4){0.f, 0.f, 0.f, 0.f};
#pragma unroll
    for (int i = 0; i < 8; ++i) *(LAS f32x4*)(scr + (i * 8 + rb) * 32 + ((cq ^ i) << 2)) = v[i];
    LDS_WAIT(); asm volatile("" ::: "memory");
#pragma unroll
    for (int j = 0; j < 4; ++j) { const int idx = lane + 64 * j, n = idx >> 3, c = idx & 7; const LAS float* s = scr + (8 * c) * 32 + ((((n >> 2) ^ c) << 2) | (n & 3));
        u32x4 o; o.x = cvtpk(s[0 * 32], s[1 * 32]); o.y = cvtpk(s[2 * 32], s[3 * 32]); o.z = cvtpk(s[4 * 32], s[5 * 32]); o.w = cvtpk(s[6 * 32], s[7 * 32]);
        const int ng = n0 + n;
        if (ng < Nvalid) { const int dr = perm ? ((ng & ~127) | ropeperm(ng & 127)) : ng;
            if (f8scale > 0.f) { u32x2 o8; o8.x = cvt4_fp8(sat8(s[0 * 32] * f8scale), sat8(s[1 * 32] * f8scale), sat8(s[2 * 32] * f8scale), sat8(s[3 * 32] * f8scale)); o8.y = cvt4_fp8(sat8(s[4 * 32] * f8scale), sat8(s[5 * 32] * f8scale), sat8(s[6 * 32] * f8scale), sat8(s[7 * 32] * f8scale));
                *(GAS u32x2*)((unsigned char*)WT + (size_t)(row_off + dr) * ldt + k0 + 8 * c) = o8; }
            else *(GAS u32x4*)(WT + (size_t)(row_off + dr) * ldt + k0 + 8 * c) = o; } }
    LDS_WAIT(); asm volatile("" ::: "memory");
}

__device__ __forceinline__ void p0_prologue(const Frame& F, const Args& a) {
    unsigned char* ws = a.ws;
    LAS float* scr = (LAS float*)(F.lds + F.wave * 8192);
    const int gw = F.vcu * NWAVES + F.wave, NGW = F.G * NWAVES, lane = F.lane;
    constexpr int I_WIN = 32 * 258, I_WM = 32 * 128;
    for (int it = gw; it < I_WIN + I_WM; it += NGW) {
        int r = it;
        if (r < I_WIN) { const int kb = r / 258, nb = 32 + r % 258, n0 = nb * 32;
            const bool perm = (n0 >= 2048 && n0 < 4096) || (n0 >= 5120 && n0 < 5632) || (n0 >= 6144 && n0 < 6656);
            if (n0 >= 2048 && n0 < 4096) transpose_item(a.in[2], 9264, 9264, (bf16_t*)(ws + WS_W8), 2048, -2048, perm, scr, kb, nb, lane, W8_SCALE);
            else if (n0 >= 5120 && n0 < 7168) transpose_item(a.in[2], 9264, 9264, (bf16_t*)(ws + WS_W8), 2048, -3072, perm, scr, kb, nb, lane, W8_SCALE);
            else transpose_item(a.in[2], 9264, 9264, (bf16_t*)(ws + WS_WCAT), 2048, n0 < 2048 ? 0 : n0 < 5120 ? -2048 : (nb >= 288 ? 0 : -4096), perm, scr, kb, nb, lane);
            continue; } r -= I_WIN;
        transpose_item(a.in[13], 4096, 4096, (bf16_t*)(ws + WS_WCAT), 2048, 5120, false, scr, r / 128, r % 128, lane);
    }
    {
        const float* win = a.in[2]; const float* mix = a.in[3]; bf16_t* WC = (bf16_t*)(ws + WS_WCAT); const int r = lane & 31, hh = lane >> 5;
        for (int it = gw; it < 1024; it += NGW) {
            const int g = it >> 8, d0 = ((it >> 5) & 7) * 32, kin0 = (it & 31) * 64;
            f32x16 acc0 = f32x16{}, acc1 = f32x16{};
            const float* ap = mix + (size_t)g * 65536 + (size_t)(8 * hh) * 256 + d0 + r;
            const float* bp0 = win + (size_t)(kin0 + r) * 9264 + g * 256 + 8 * hh; const float* bp1 = bp0 + (size_t)32 * 9264;
#pragma unroll 4
            for (int k = 0; k < 16; ++k) {
                f32x4 a0, a1;
#pragma unroll
                for (int j = 0; j < 4; ++j) { a0[j] = ap[(size_t)(k * 16 + j) * 256]; a1[j] = ap[(size_t)(k * 16 + 4 + j) * 256]; }
                const u32x4 af = pack8(a0, a1), b0 = pack8(*(const f32x4*)(bp0 + k * 16), *(const f32x4*)(bp0 + k * 16 + 4)), b1 = pack8(*(const f32x4*)(bp1 + k * 16), *(const f32x4*)(bp1 + k * 16 + 4));
                acc0 = __builtin_amdgcn_mfma_f32_32x32x16_bf16(__builtin_bit_cast(bf16x8, af), __builtin_bit_cast(bf16x8, b0), acc0, 0, 0, 0);
                acc1 = __builtin_amdgcn_mfma_f32_32x32x16_bf16(__builtin_bit_cast(bf16x8, af), __builtin_bit_cast(bf16x8, b1), acc1, 0, 0, 0);
            }
#pragma unroll
            for (int e = 0; e < 16; ++e) { int ee = e; asm volatile("" : "+v"(ee)); bf16_t* rowp = WC + (size_t)(g * 256 + d0 + crow(ee, hh)) * 2048 + kin0 + r;
                const float v0 = acc0[e], v1 = acc1[e], n0_ = dpp_x1f(v0), n1_ = dpp_x1f(v1);
                if ((r & 1) == 0) { *(unsigned*)rowp = cvtpk(v0, n0_); *(unsigned*)(rowp + 32) = cvtpk(v1, n1_); } }
        }
    }
    for (int i = gw * 64 + lane; i < 53248; i += NGW * 64) *(GAS u32x4*)(ws + WS_WCAT + (size_t)9264 * 4096 + (size_t)i * 16) = (u32x4){0u, 0u, 0u, 0u};
    {
        const float* x = a.in[0]; const float* nw = a.in[1]; bf16_t* H = (bf16_t*)(ws + WS_H); unsigned char* H8 = ws + WS_H8;
        f32x4 wv[8];
#pragma unroll
        for (int j = 0; j < 8; ++j) wv[j] = *((const f32x4*)nw + lane + 64 * j);
        for (int m = gw; m < S; m += NGW) {
            const f32x4* xr = (const f32x4*)(x + (size_t)m * DM) + lane; f32x4 v[8]; float s = 0.f;
#pragma unroll
            for (int j = 0; j < 8; ++j) { v[j] = xr[64 * j]; s += (v[j][0] * v[j][0] + v[j][1] * v[j][1]) + (v[j][2] * v[j][2] + v[j][3] * v[j][3]); }
            const float rstd = 1.0f / sqrtf(wave_sum(s) * (1.f / DM) + EPS);
            u32x2* o = (u32x2*)(H + (size_t)m * DM) + lane;
#pragma unroll
            for (int j = 0; j < 8; ++j) { const f32x4 y = v[j] * rstd * wv[j]; u32x2 w; w.x = cvtpk(y[0], y[1]); w.y = cvtpk(y[2], y[3]); o[64 * j] = w;
                *(unsigned*)(H8 + (size_t)m * DM + (lane + 64 * j) * 4) = cvt4_fp8(sat8(y[0]), sat8(y[1]), sat8(y[2]), sat8(y[3])); }
        }
    }
    {
        float* rcos = (float*)(ws + WS_ROPE); float* rsin = rcos + (size_t)S * 64;
        for (int e = gw * 64 + lane; e < S * 64; e += NGW * 64) {
            const int pos = e >> 6, i = e & 63;
            double inv = 1.0, b = 0.86596432336006535;
            for (int k = i; k; k >>= 1) { if (k & 1) inv *= b; b *= b; }
            const double t = (double)pos * inv * 0.15915494309189535;
            const float fr = (float)(t - floor(t));
            rcos[e] = __builtin_amdgcn_cosf(fr); rsin[e] = __builtin_amdgcn_sinf(fr);
        }
    }
}
__device__ __forceinline__ void p1_late_weights(const Frame& F, const Args& a, int cw, int NCW) {
    unsigned char* ws = a.ws;
    LAS float* scr = (LAS float*)(F.lds + F.wave * 8192);
    const int lane = F.lane;
    constexpr int I_NO = 32 * 64, I_O = 32 * 64, I_PO = 16 * 64, I_W1 = 64 * 8, I_W2 = 4 * 4, I_B1 = 512;
    constexpr int NITEMS = I_NO + I_O + I_PO + 2 * I_W1 + 2 * I_W2 + I_B1;
    for (int it = cw; it < NITEMS; it += NCW) {
        int r = it;
        if (r < I_W1) { transpose_item(a.in[6], 256, 256, (bf16_t*)(ws + WS_W1KT), 4096, 0, false, scr, r / 8, r % 8, lane); continue; } r -= I_W1;
        if (r < I_W1) { transpose_item(a.in[9], 256, 256, (bf16_t*)(ws + WS_W1VT), 4096, 0, false, scr, r / 8, r % 8, lane); continue; } r -= I_W1;
        if (r < I_B1) {
            const int which = r >> 8, fb = (r >> 6) & 3, ch = r & 63, f = fb * 64 + lane;
            const float* pe = a.in[which ? 8 : 5]; const float* w1 = a.in[which ? 9 : 6]; float s = 0.f;
#pragma unroll 16
            for (int k = ch * 64; k < ch * 64 + 64; ++k) s += pe[k] * w1[(size_t)k * 256 + f];
            ((float*)(ws + WS_B1P))[(which * 64 + ch) * 256 + f] = s; continue; } r -= I_B1;
        if (r < I_W2) { transpose_item(a.in[7], 128, 128, (bf16_t*)(ws + WS_W2KT), 256, 0, true, scr, r / 4, r % 4, lane); continue; } r -= I_W2;
        if (r < I_W2) { transpose_item(a.in[10], 128, 128, (bf16_t*)(ws + WS_W2VT), 256, 0, false, scr, r / 4, r % 4, lane); continue; } r -= I_W2;
        if (r < I_PO) { transpose_item(a.in[11], 2048, 2048, (bf16_t*)(ws + WS_WPOT), 1024, 0, false, scr, r / 64, r % 64, lane); continue; } r -= I_PO;
        if (r < I_NO) { transpose_item(a.in[12], 2048, 2048, (bf16_t*)(ws + WS_WNOT), 2048, 0, false, scr, r / 64, r % 64, lane, WNO_SCALE); continue; } r -= I_NO;
        transpose_item(a.in[15], 2048, 2048, (bf16_t*)(ws + WS_WOT), 2048, 0, false, scr, r / 64, r % 64, lane);
    }
}

template <int W>
__device__ __forceinline__ void ypool_item(const bf16_t* __restrict__ U, const bf16_t* __restrict__ GP, bf16_t* __restrict__ Y, const float* __restrict__ scale, int c, int t0) {
    u32x4 x[W + 7], gq[8];
#pragma unroll
    for (int k = 0; k < W + 7; ++k) { const int r = t0 - (W - 1) + k; x[k] = r >= 0 ? *(const u32x4*)(U + (size_t)r * 1024 + c) : (u32x4){0u, 0u, 0u, 0u}; }
#pragma unroll
    for (int k = 0; k < 8; ++k) gq[k] = *(const u32x4*)(GP + (size_t)(t0 + k) * 1024 + c);
    const f32x4 sc0 = *(const f32x4*)(scale + c), sc1 = *(const f32x4*)(scale + c + 4);
    f32x4 s0 = {0.f, 0.f, 0.f, 0.f}, s1 = s0, a0, a1;
#pragma unroll
    for (int k = 0; k < W - 1; ++k) { unpack8(x[k], a0, a1); s0 = s0 + a0; s1 = s1 + a1; }
#pragma unroll
    for (int k = 0; k < 8; ++k) { const int t = t0 + k;
        unpack8(x[W - 1 + k], a0, a1); s0 = s0 + a0; s1 = s1 + a1;
        const int cnt = (t + 1 < W) ? t + 1 : W; const float ic = 1.0f / (float)cnt;
        f32x4 g0, g1; unpack8(gq[k], g0, g1);
        *(u32x4*)(Y + (size_t)t * 1024 + c) = pack8((s0 * ic - a0) * sc0 * g0, (s1 * ic - a1) * sc1 * g1);
        f32x4 b0, b1; unpack8(x[k], b0, b1); s0 = s0 - b0; s1 = s1 - b1; }
}
__device__ __forceinline__ void p2_ypool(const Frame& F, unsigned char* ws, const float* __restrict__ scale, int cw, int NCW) {
    const bf16_t* __restrict__ U = (const bf16_t*)(ws + WS_U); const bf16_t* __restrict__ GP = (const bf16_t*)(ws + WS_GP); bf16_t* __restrict__ Y = (bf16_t*)(ws + WS_H + 16 * MiB);
    for (int wi = cw; wi < 4 * 512; wi += NCW) {
        const int g = wi & 3, t0 = ((wi >> 2) * 2 + (F.lane >> 5)) * 8, c = (g * 32 + (F.lane & 31)) * 8;
        if (g == 0) ypool_item<2>(U, GP, Y, scale, c, t0); else if (g == 1) ypool_item<4>(U, GP, Y, scale, c, t0);
        else if (g == 2) ypool_item<8>(U, GP, Y, scale, c, t0); else ypool_item<16>(U, GP, Y, scale, c, t0);
    }
}
__device__ __forceinline__ void p2_vt8(const Frame& F, unsigned char* ws, int cw, int NCW) {
    const int lane = F.lane;
    for (int it = cw; it < 1024; it += NCW) {
        const int which = it >> 9, h = (it >> 7) & 3, j = it & 127;
        const unsigned char* V8 = ws + (which ? WS_V8W : WS_V8S) + (size_t)(64 * j) * 512 + h * 128 + 2 * lane;
        unsigned char* T = ws + (which ? WS_V8TW : WS_V8TS) + (size_t)(h * 128 + j) * 8192 + (size_t)(2 * lane) * 64;
#pragma unroll
        for (int hb = 0; hb < 2; ++hb) {
            unsigned short e[32];
#pragma unroll
            for (int jj = 0; jj < 32; ++jj) { const int key = jj < 16 ? crow(jj, hb) : 32 + crow(jj - 16, hb); e[jj] = *(const unsigned short*)(V8 + (size_t)key * 512); }
            u32x4 a0, a1, b0, b1;
#pragma unroll
            for (int q = 0; q < 4; ++q) {
                a0[q] = (unsigned)(e[4*q] & 0xff) | ((unsigned)(e[4*q+1] & 0xff) << 8) | ((unsigned)(e[4*q+2] & 0xff) << 16) | ((unsigned)(e[4*q+3] & 0xff) << 24);
                a1[q] = (unsigned)(e[16+4*q] & 0xff) | ((unsigned)(e[16+4*q+1] & 0xff) << 8) | ((unsigned)(e[16+4*q+2] & 0xff) << 16) | ((unsigned)(e[16+4*q+3] & 0xff) << 24);
                b0[q] = (unsigned)(e[4*q] >> 8) | ((unsigned)(e[4*q+1] >> 8) << 8) | ((unsigned)(e[4*q+2] >> 8) << 16) | ((unsigned)(e[4*q+3] >> 8) << 24);
                b1[q] = (unsigned)(e[16+4*q] >> 8) | ((unsigned)(e[16+4*q+1] >> 8) << 8) | ((unsigned)(e[16+4*q+2] >> 8) << 16) | ((unsigned)(e[16+4*q+3] >> 8) << 24); }
            *(u32x4*)(T + hb * 32) = a0; *(u32x4*)(T + hb * 32 + 16) = a1; *(u32x4*)(T + 64 + hb * 32) = b0; *(u32x4*)(T + 64 + hb * 32 + 16) = b1;
        }
    }
}

__device__ __forceinline__ void p3_compress2(const Frame& F, unsigned char* ws, int cwg, int NCWG) {
    const int tid = F.tid, lane = F.lane, r = lane & 31, hh = lane >> 5, wave = F.wave;
    const float* rcos = (const float*)(ws + WS_ROPE); const float* rsin = rcos + (size_t)S * 64;
    LAS bf16_t* hl = (LAS bf16_t*)F.lds;
    for (int it = cwg; it < 128; it += NCWG) {
        const int which = it >> 6, rt = it & 63;
        { const int row = tid >> 4, f0 = (tid & 15) * 16;
          const float* sl = (const float*)(ws + WS_SLAB) + ((size_t)(which * NSPLIT) * 2048 + rt * 32 + row) * 256 + f0; const float* b1 = (const float*)(ws + WS_B1) + which * 256 + f0;
          f32x4 s[4];
#pragma unroll
          for (int q = 0; q < 4; ++q) s[q] = *(const f32x4*)(b1 + 4 * q);
#pragma unroll
          for (int ks = 0; ks < NSPLIT; ++ks)
#pragma unroll
              for (int q = 0; q < 4; ++q) s[q] = s[q] + *(const f32x4*)(sl + (size_t)ks * 2048 * 256 + 4 * q);
#pragma unroll
          for (int q = 0; q < 4; ++q)
#pragma unroll
              for (int e = 0; e < 4; ++e) s[q][e] = siluf_(s[q][e]);
          *(LAS u32x4*)(hl + row * 264 + f0) = pack8(s[0], s[1]); *(LAS u32x4*)(hl + row * 264 + f0 + 8) = pack8(s[2], s[3]); }
        __syncthreads();
        if (wave < 4) {
            const int ct = wave, row = rt * 32 + r;
            const bf16_t* W2 = (const bf16_t*)(ws + (which ? WS_W2VT : WS_W2KT)) + (size_t)(ct * 32 + r) * 256 + hh * 8;
            f32x16 acc = f32x16{};
#pragma unroll 4
            for (int k = 0; k < 16; ++k) acc = __builtin_amdgcn_mfma_f32_32x32x16_bf16(*(const bf16x8*)(W2 + k * 16), *(const LAS bf16x8*)(hl + r * 264 + k * 16 + hh * 8), acc, 0, 0, 0);
            const int n = row & 511; bf16_t* dst = (bf16_t*)(ws + (which ? WS_VC : WS_KC)) + (size_t)row * 128 + ct * 32 + 4 * hh;
            const int pos = (16 * n + 31) > S - 1 ? S - 1 : 16 * n + 31;
#pragma unroll
            for (int gq = 0; gq < 4; ++gq) {
                float v0 = acc[4 * gq], v1 = acc[4 * gq + 1], v2 = acc[4 * gq + 2], v3 = acc[4 * gq + 3];
                if (which == 0) { const int i = (ct * 32 + 8 * gq + 4 * hh) >> 1; const float c0 = rcos[(size_t)pos * 64 + i], s0 = rsin[(size_t)pos * 64 + i], c1 = rcos[(size_t)pos * 64 + i + 1], s1 = rsin[(size_t)pos * 64 + i + 1];
                    const float o0 = v0 * c0 - v1 * s0, o1 = v1 * c0 + v0 * s0, o2 = v2 * c1 - v3 * s1, o3 = v3 * c1 + v2 * s1; v0 = o0; v1 = o1; v2 = o2; v3 = o3; }
                u32x2 w; w.x = cvtpk(v0, v1); w.y = cvtpk(v2, v3); if (n == 511) { w.x = 0u; w.y = 0u; }
                *(u32x2*)(dst + 8 * gq) = w;
            }
        }
        __syncthreads();
    }
}

namespace nsa {
constexpr int SHM_V = 16384, SHM_K = 16384;
constexpr int L_V = 0, L_K = 3 * SHM_V, L_WS = L_K + 2 * SHM_K, L_IMP = L_WS + NWAVES * 64 * 4, IMP_LD = 129, L_SELM = L_IMP + 64 * IMP_LD * 4, L_END = L_SELM + 64 * 8 * 2;
static_assert(L_END <= RING_BYTES, "attention LDS");
constexpr float SCALE = 0.08838834764831845f, C2 = 1.4426950408889634f * SCALE, THR = 8.f;
#define KSWZ(row, colB) ((row) * 256 + ((colB) ^ (((row) & 7) << 4)))
#define SBAR() __builtin_amdgcn_sched_barrier(0)
#define LADD(p, v) (void)__hip_atomic_fetch_add((p), (v), __ATOMIC_RELAXED, __HIP_MEMORY_SCOPE_WORKGROUP)
__device__ __forceinline__ int v_st(int k, int c) { const int kk = (k & ~0xC) | ((k & 4) << 1) | ((k & 8) >> 1); return ((kk >> 3) * 4 + (c >> 5)) * 512 + ((kk & 7) * 32 + (c & 31)) * 2; }
__device__ __forceinline__ int v_rd_base(int lane) { return ((lane & 3) << 3) | (((lane >> 2) & 3) << 6) | (((lane >> 4) & 1) << 5) | (((lane >> 5) & 1) << 8); }
constexpr int v_rd_off(int d0, int ks, int half) { return d0 * 512 + ks * 4096 + half * 2048; }
__device__ __forceinline__ unsigned cvtpk_a(float lo, float hi) { unsigned r; asm volatile("v_cvt_pk_bf16_f32 %0, %1, %2" : "=v"(r) : "v"(lo), "v"(hi)); return r; }

__device__ __forceinline__ void mask_range(f32x16& p0, f32x16& p1, int dq, unsigned Wn) {
    const float NEG = -__builtin_inff();
#pragma unroll
    for (int r = 0; r < 16; ++r) { const int c = (r & 3) + 8 * (r >> 2);
        if ((unsigned)(dq + c) >= Wn) p0[r] = NEG;
        if ((unsigned)(dq + c + 32) >= Wn) p1[r] = NEG; }
}
__device__ __forceinline__ void mask_row(f32x16& p0, f32x16& p1, bool keep) {
    const float NEG = -__builtin_inff();
#pragma unroll
    for (int r = 0; r < 16; ++r) { p0[r] = keep ? p0[r] : NEG; p1[r] = keep ? p1[r] : NEG; }
}
__device__ __forceinline__ float rowmax32(const f32x16& p0, const f32x16& p1) {
    float pmax = p0[0];
#pragma unroll
    for (int r = 1; r < 16; ++r) pmax = fmaxf(pmax, p0[r]);
#pragma unroll
    for (int r = 0; r < 16; ++r) pmax = fmaxf(pmax, p1[r]);
    auto rr = __builtin_amdgcn_permlane32_swap(__float_as_uint(pmax), __float_as_uint(pmax), false, false);
    return fmaxf(__uint_as_float(rr[0]), __uint_as_float(rr[1]));
}
__device__ __forceinline__ float rowsum32(const f32x16& p0, const f32x16& p1) {
    float ps = 0.f;
#pragma unroll
    for (int r = 0; r < 16; ++r) ps += p0[r];
#pragma unroll
    for (int r = 0; r < 16; ++r) ps += p1[r];
    auto rr = __builtin_amdgcn_permlane32_swap(__float_as_uint(ps), __float_as_uint(ps), false, false);
    return __uint_as_float(rr[0]) + __uint_as_float(rr[1]);
}
__device__ __forceinline__ void pack_p(const f32x16& p0, const f32x16& p1, bf16x8& pa0, bf16x8& pa1, bf16x8& pa2, bf16x8& pa3) {
#define PK4(P, B_, OUT) do { unsigned a0 = cvtpk_a(P[B_+0], P[B_+1]), a1 = cvtpk_a(P[B_+2], P[B_+3]);                          \
        unsigned b0 = cvtpk_a(P[B_+4], P[B_+5]), b1 = cvtpk_a(P[B_+6], P[B_+7]);                                             \
        auto r0 = __builtin_amdgcn_permlane32_swap(a0, b0, false, false); auto r1 = __builtin_amdgcn_permlane32_swap(a1, b1, false, false); \
        u32x4 w = {r0[0], r1[0], r0[1], r1[1]}; OUT = __builtin_bit_cast(bf16x8, w); } while (0)
    PK4(p0, 0, pa0); PK4(p0, 8, pa1); PK4(p1, 0, pa2); PK4(p1, 8, pa3);
#undef PK4
}
__device__ __forceinline__ void qkt(f32x16& p0, f32x16& p1, const LAS unsigned char* K_buf, int r32, int hi, const bf16x8* qr) {
    p0 = f32x16{}; p1 = f32x16{};
    const LAS unsigned char* kb[4];
#pragma unroll
    for (int dd = 0; dd < 4; ++dd) kb[dd] = K_buf + KSWZ(r32, (dd * 16 + hi * 8) * 2);
#define KLD(F, d0) do { const LAS unsigned char* a_ = kb[(d0) & 3] + ((d0) >> 2) * 128; F##0 = *(const LAS bf16x8*)(a_); F##1 = *(const LAS bf16x8*)(a_ + 32 * 256); \
        const LAS unsigned char* c_ = kb[((d0) + 1) & 3] + (((d0) + 1) >> 2) * 128; F##2 = *(const LAS bf16x8*)(c_); F##3 = *(const LAS bf16x8*)(c_ + 32 * 256); } while (0)
#define KMM(F, d0) do { p0 = __builtin_amdgcn_mfma_f32_32x32x16_bf16(F##0, qr[d0], p0, 0, 0, 0); p1 = __builtin_amdgcn_mfma_f32_32x32x16_bf16(F##1, qr[d0], p1, 0, 0, 0); \
        p0 = __builtin_amdgcn_mfma_f32_32x32x16_bf16(F##2, qr[(d0) + 1], p0, 0, 0, 0); p1 = __builtin_amdgcn_mfma_f32_32x32x16_bf16(F##3, qr[(d0) + 1], p1, 0, 0, 0); } while (0)
    bf16x8 fa0, fa1, fa2, fa3, fb0, fb1, fb2, fb3;
    KLD(fa, 0); KLD(fb, 2); SBAR();
    KMM(fa, 0); KLD(fa, 4); SBAR();
    KMM(fb, 2); KLD(fb, 6); SBAR();
    KMM(fa, 4); SBAR();
    KMM(fb, 6);
#undef KLD
#undef KMM
}
struct VF8 { s16x4 l0, h0, l1, h1, l2, h2, l3, h3; };
#define TRRD(dst, off) asm volatile("ds_read_b64_tr_b16 %0, %1 offset:%2" : "=&v"(dst) : "v"(vb0), "i"(off) : "memory")
__device__ __forceinline__ void pv_read0(VF8& f, int vb0) {
    constexpr int b_ = v_rd_off(0, 0, 0);
    TRRD(f.l0, b_); TRRD(f.h0, b_ + 2048); TRRD(f.l1, b_ + 4096); TRRD(f.h1, b_ + 6144); TRRD(f.l2, b_ + 8192); TRRD(f.h2, b_ + 10240); TRRD(f.l3, b_ + 12288); TRRD(f.h3, b_ + 14336);
}
__device__ __forceinline__ void pv_tile(f32x16* o, int vb0, bf16x8 pa0, bf16x8 pa1, bf16x8 pa2, bf16x8 pa3, VF8& f) {
#define PV_MM(d0, l0, h0, l1, h1, l2, h2, l3, h3) do { \
        o[d0] = __builtin_amdgcn_mfma_f32_32x32x16_bf16(pa0, (bf16x8){l0[0], l0[1], l0[2], l0[3], h0[0], h0[1], h0[2], h0[3]}, o[d0], 0, 0, 0);   \
        o[d0] = __builtin_amdgcn_mfma_f32_32x32x16_bf16(pa1, (bf16x8){l1[0], l1[1], l1[2], l1[3], h1[0], h1[1], h1[2], h1[3]}, o[d0], 0, 0, 0);   \
        o[d0] = __builtin_amdgcn_mfma_f32_32x32x16_bf16(pa2, (bf16x8){l2[0], l2[1], l2[2], l2[3], h2[0], h2[1], h2[2], h2[3]}, o[d0], 0, 0, 0);   \
        o[d0] = __builtin_amdgcn_mfma_f32_32x32x16_bf16(pa3, (bf16x8){l3[0], l3[1], l3[2], l3[3], h3[0], h3[1], h3[2], h3[3]}, o[d0], 0, 0, 0); } while (0)
#define PV_D0(d0) do { s16x4 l0, l1, l2, l3, h0, h1, h2, h3; constexpr int b_ = v_rd_off(d0, 0, 0); \
        TRRD(l0, b_); TRRD(h0, b_ + 2048); TRRD(l1, b_ + 4096); TRRD(h1, b_ + 6144); TRRD(l2, b_ + 8192); TRRD(h2, b_ + 10240); TRRD(l3, b_ + 12288); TRRD(h3, b_ + 14336); \
        asm volatile("s_waitcnt lgkmcnt(0)" ::: "memory"); SBAR(); PV_MM(d0, l0, h0, l1, h1, l2, h2, l3, h3); } while (0)
    asm volatile("s_waitcnt lgkmcnt(0)" ::: "memory"); SBAR(); PV_MM(0, f.l0, f.h0, f.l1, f.h1, f.l2, f.h2, f.l3, f.h3);
    PV_D0(1); PV_D0(2); PV_D0(3);
#undef PV_D0
#undef PV_MM
}
#undef TRRD

enum { M_C1 = 0, M_C2 = 1, M_S = 2, M_W = 3 };
struct Stage { bf16x8 k0, k1, v0, v1; };
__device__ __forceinline__ void stage_load(Stage& sg, const bf16_t* Kp, const bf16_t* Vp, int ld, int j, bool hasv) {
    const int tid = otid(), sr = tid >> 4, sc = (tid & 15) * 8; const size_t k0_ = (size_t)j * 64;
    sg.k0 = *(const bf16x8*)(Kp + (k0_ + sr) * ld + sc); sg.k1 = *(const bf16x8*)(Kp + (k0_ + 32 + sr) * ld + sc);
    if (hasv) { sg.v0 = *(const bf16x8*)(Vp + (k0_ + sr) * ld + sc); sg.v1 = *(const bf16x8*)(Vp + (k0_ + 32 + sr) * ld + sc); }
}
struct RowState { float m, l; };
template <int MODE>
__device__ __forceinline__ void attn_pass(LAS unsigned char* lds, const bf16_t* Kp, const bf16_t* Vp, int ld, int j_lo, int j_hi, const bf16x8* qr, int t, int Tq, const u32x4 sel,
                                          RowState& st, float invl, f32x16* o, bool do_imp, Stage& sg) {
    constexpr bool HASV = MODE != M_C1;
    const int tid = otid(), wid = __builtin_amdgcn_readfirstlane(tid >> 6), lane = tid & 63, r32 = lane & 31, hi = lane >> 5;
    LAS unsigned char* V_lds = lds + L_V; LAS unsigned char* K_lds = lds + L_K;
    LAS float* wsf = (LAS float*)(lds + L_WS) + wid * 64; LAS float* al_l = wsf + 32;
    const int sr = tid >> 4, sc = (tid & 15) * 8, vst0 = v_st(sr, sc), vst1 = v_st(32 + sr, sc), kws = KSWZ(sr, sc * 2);
    const int vb0 = (int)(uintptr_t)V_lds + v_rd_base(lane);
    const int NT = j_hi - j_lo;
#define st_k0 sg.k0
#define st_k1 sg.k1
#define st_v0 sg.v0
#define st_v1 sg.v1
    float m_reg = st.m, l_reg = st.l;
#define SLOAD(j) do { const size_t k0_ = (size_t)(j) * 64; st_k0 = *(const bf16x8*)(Kp + (k0_ + sr) * ld + sc); st_k1 = *(const bf16x8*)(Kp + (k0_ + 32 + sr) * ld + sc); \
        if (HASV) { st_v0 = *(const bf16x8*)(Vp + (k0_ + sr) * ld + sc); st_v1 = *(const bf16x8*)(Vp + (k0_ + 32 + sr) * ld + sc); } } while (0)
#define SWRITE(kof, vof) do { *(LAS bf16x8*)(K_lds + (kof) + kws) = st_k0; *(LAS bf16x8*)(K_lds + (kof) + kws + 32 * 256) = st_k1; \
        if (HASV) { *(LAS bf16x8*)(V_lds + (vof) + vst0) = st_v0; *(LAS bf16x8*)(V_lds + (vof) + vst1) = st_v1; } } while (0)
    const bool late = HASV && wid >= 4;
    bf16x8 pa0, pa1, pa2, pa3;
    SWRITE(0, 0);
    __syncthreads();
    int kof = 0, vof = 0, vprev = 0;
    for (int idx = 0; idx < NT; ++idx) {
        const int j = j_lo + idx, kb = j * 64;
        if (idx + 1 < NT) SLOAD(j + 1);
        if (HASV && late && idx > 0) { SBAR(); VF8 vf; pv_read0(vf, vb0 + vprev); pv_tile(o, vb0 + vprev, pa0, pa1, pa2, pa3, vf); SBAR(); }
        f32x16 p0, p1; qkt(p0, p1, K_lds + kof, r32, hi, qr);
        VF8 vfe; if (HASV && !late) { SBAR(); pv_read0(vfe, vb0 + vof); SBAR(); }
#if EXP_QKT2
        asm volatile("" : "+v"(p0), "+v"(p1)); SBAR(); qkt(p0, p1, K_lds + kof, r32, hi, qr);
#endif
        if (MODE == M_C1 || MODE == M_C2) { const int nmax1 = ((t - 31) >> 4) + 1; mask_range(p0, p1, kb + 4 * hi, (unsigned)(nmax1 > 0 ? nmax1 : 0)); }
        else if (MODE == M_S) { if (j == Tq) mask_range(p0, p1, kb + 4 * hi, (unsigned)(t + 1));
                                else { const unsigned w_ = (j >> 5) == 0 ? sel.x : (j >> 5) == 1 ? sel.y : (j >> 5) == 2 ? sel.z : sel.w; mask_row(p0, p1, ((w_ >> (j & 31)) & 1u) != 0u); } }
        else { if (j == Tq || j + 8 <= Tq) mask_range(p0, p1, kb + 4 * hi - (t - 511), 512u); }
        if (MODE == M_C1) { const float pmax = rowmax32(p0, p1); const float mn = fmaxf(m_reg, pmax); const float alpha = __builtin_amdgcn_exp2f((m_reg - mn) * C2); m_reg = mn;
            const float mnL = -mn * C2;
#pragma unroll
            for (int r = 0; r < 16; ++r) { p0[r] = __builtin_amdgcn_exp2f(fmaf(p0[r], C2, mnL)); p1[r] = __builtin_amdgcn_exp2f(fmaf(p1[r], C2, mnL)); }
            l_reg = l_reg * alpha + rowsum32(p0, p1); }
        else if (MODE == M_C2) { const float mnL = -m_reg * C2;
#pragma unroll
            for (int r = 0; r < 16; ++r) { p0[r] = __builtin_amdgcn_exp2f(fmaf(p0[r], C2, mnL)) * invl; p1[r] = __builtin_amdgcn_exp2f(fmaf(p1[r], C2, mnL)) * invl; }
            if (do_imp) { LAS unsigned* imp = (LAS unsigned*)(lds + L_IMP) + ((wid & 1) * 32 + r32) * IMP_LD + 16 * j + hi;
#pragma unroll
                for (int k = 0; k < 4; ++k) {
                    { const float e_ = p0[4 * k + 3], a_ = 2.f * (p0[4 * k] + p0[4 * k + 1] + p0[4 * k + 2]) + e_;
                      LADD(imp + 2 * k, (unsigned)(a_ * 67108864.f + 0.5f)); LADD(imp + 2 * k + 1, (unsigned)(e_ * 67108864.f + 0.5f)); }
                    { const float e_ = p1[4 * k + 3], a_ = 2.f * (p1[4 * k] + p1[4 * k + 1] + p1[4 * k + 2]) + e_;
                      LADD(imp + 8 + 2 * k, (unsigned)(a_ * 67108864.f + 0.5f)); LADD(imp + 8 + 2 * k + 1, (unsigned)(e_ * 67108864.f + 0.5f)); } } }
            pack_p(p0, p1, pa0, pa1, pa2, pa3); }
        else { const float pmax = rowmax32(p0, p1); float mn, alpha;
            if (__builtin_expect(__all((pmax - m_reg) * SCALE <= THR), 1)) { mn = m_reg; alpha = 1.f; }
            else { mn = fmaxf(m_reg, pmax); alpha = __builtin_amdgcn_exp2f((m_reg - mn) * C2); m_reg = mn; }
            const float mnL = -mn * C2;
#pragma unroll
            for (int r = 0; r < 16; ++r) { p0[r] = __builtin_amdgcn_exp2f(fmaf(p0[r], C2, mnL)); p1[r] = __builtin_amdgcn_exp2f(fmaf(p1[r], C2, mnL)); }
            l_reg = l_reg * alpha + rowsum32(p0, p1);
            pack_p(p0, p1, pa0, pa1, pa2, pa3);
            if (__any(alpha < 1.f)) { if (hi == 0) al_l[r32] = alpha; asm volatile("s_waitcnt lgkmcnt(0)" ::: "memory");
#pragma unroll
                for (int d_ = 0; d_ < 4; ++d_)
#pragma unroll
                    for (int r = 0; r < 16; ++r) o[d_][r] *= al_l[crow(r, hi)]; } }
        if (HASV && !late) { SBAR(); pv_tile(o, vb0 + vof, pa0, pa1, pa2, pa3, vfe); }
        const int kn = kof ^ SHM_K, vn = (vof == 2 * SHM_V) ? 0 : vof + SHM_V;
        if (idx + 1 < NT) { SWRITE(kn, vn); }
        __syncthreads();
        vprev = vof; kof = kn; vof = vn;
    }
    if (HASV) { if (late) { SBAR(); VF8 vf; pv_read0(vf, vb0 + vprev); pv_tile(o, vb0 + vprev, pa0, pa1, pa2, pa3, vf); } __syncthreads(); }
    st.m = m_reg; st.l = l_reg;
#undef SLOAD
#undef SWRITE
#undef st_k0
#undef st_k1
#undef st_v0
#undef st_v1
}

typedef int v8i __attribute__((ext_vector_type(8)));
struct Stage8 { u32x4 k, v; };
constexpr int SHM8 = 8192;
constexpr float THR8 = 2.5f, P8_EXP = 5.0f;
__device__ __forceinline__ f32x16 mfma8(v8i a, v8i b, f32x16 c) { return __builtin_amdgcn_mfma_scale_f32_32x32x64_f8f6f4(a, b, c, 0, 0, 0, 0x7F7F7F7F, 0, 0x7F7F7F7F); }
__device__ __forceinline__ int k8_off(int key, int c) { return key * 128 + ((c ^ ((key >> 1) & 7)) << 4); }
__device__ __forceinline__ int v8_off(int d, int c) { return d * 64 + ((c ^ ((d >> 2) & 3)) << 4); }
__device__ __forceinline__ void stage_load8(Stage8& sg, const unsigned char* K8h, const unsigned char* V8Th, int j) {
    const int tid = otid();
    sg.k = *(const u32x4*)(K8h + (size_t)(64 * j + (tid >> 3)) * 512 + (tid & 7) * 16); sg.v = *(const u32x4*)(V8Th + (size_t)j * 8192 + tid * 16);
}
__device__ __forceinline__ v8i ld_v8i(const LAS unsigned char* a, const LAS unsigned char* b) { const u32x4 x = *(const LAS u32x4*)a, y = *(const LAS u32x4*)b; return (v8i){(int)x.x, (int)x.y, (int)x.z, (int)x.w, (int)y.x, (int)y.y, (int)y.z, (int)y.w}; }
struct Stage8x2 { u32x4 ka, va, kb, vb; };
__device__ __forceinline__ void stage_load8x2(Stage8x2& sg, const unsigned char* K8h, const unsigned char* V8Th, int ja, bool hasb) {
    const int tid = otid();
    sg.ka = *(const u32x4*)(K8h + (size_t)(64 * ja + (tid >> 3)) * 512 + (tid & 7) * 16); sg.va = *(const u32x4*)(V8Th + (size_t)ja * 8192 + tid * 16);
    if (hasb) { sg.kb = *(const u32x4*)(K8h + (size_t)(64 * (ja + 1) + (tid >> 3)) * 512 + (tid & 7) * 16); sg.vb = *(const u32x4*)(V8Th + (size_t)(ja + 1) * 8192 + tid * 16); }
}
template <int MODE>
__device__ __forceinline__ void attn_pass8(LAS unsigned char* lds, const unsigned char* K8h, const unsigned char* V8Th, int j_lo, int j_hi, const v8i* qf, int t, int Tq, const u32x4 sel,
                                           RowState& st, f32x16* o, Stage8x2& sg0) {
    const int tid = otid(), wid = __builtin_amdgcn_readfirstlane(tid >> 6), lane = tid & 63, r32 = lane & 31, hi = lane >> 5;
    LAS unsigned char* V_lds = lds + L_V; LAS unsigned char* K_lds = lds + L_K;
    LAS float* wsf = (LAS float*)(lds + L_WS) + wid * 64; LAS float* al_l = wsf + 32;
    const int kws = k8_off(tid >> 3, tid & 7), vws = v8_off(tid >> 2, tid & 3);
    const int NT = j_hi - j_lo, NS = (NT + 1) >> 1;
    float m_reg = st.m, l_reg = st.l;
#define SWRITE8(SG, kof, vof, hasb) do { *(LAS u32x4*)(K_lds + (kof) + kws) = (SG).ka; *(LAS u32x4*)(V_lds + (vof) + vws) = (SG).va; \
        if (hasb) { *(LAS u32x4*)(K_lds + (kof) + SHM8 + kws) = (SG).kb; *(LAS u32x4*)(V_lds + (vof) + SHM8 + vws) = (SG).vb; } } while (0)
    const bool late = wid >= 4;
    v8i paa, pab;
    SWRITE8(sg0, 0, 0, NT > 1);
    __syncthreads();
    int kof = 0, vof = 0, vprev = 0; bool bprev = false;
#define PV8(vo, pa) do { const LAS unsigned char* vb_ = V_lds + (vo);                                                                  \
        _Pragma("unroll") for (int d0 = 0; d0 < 4; ++d0) { const int d_ = d0 * 32 + r32;                                               \
            o[d0] = mfma8(pa, ld_v8i(vb_ + v8_off(d_, 2 * hi), vb_ + v8_off(d_, 2 * hi + 1)), o[d0]); } } while (0)
#define QK8(P0, P1, ko) do { const LAS unsigned char* kb_ = K_lds + (ko); P0 = f32x16{}; P1 = f32x16{};                                  \
        _Pragma("unroll") for (int ks = 0; ks < 2; ++ks) {                                                                             \
            P0 = mfma8(ld_v8i(kb_ + k8_off(r32, 4 * ks + 2 * hi), kb_ + k8_off(r32, 4 * ks + 2 * hi + 1)), qf[ks], P0);                 \
            P1 = mfma8(ld_v8i(kb_ + k8_off(32 + r32, 4 * ks + 2 * hi), kb_ + k8_off(32 + r32, 4 * ks + 2 * hi + 1)), qf[ks], P1); } } while (0)
#define SOFT8(P0, P1, jt, PA) do { const int j_ = (jt), kb = j_ * 64; bool rowkeep = true;                                               \
        if (MODE == M_S) { if (j_ == Tq) mask_range(P0, P1, kb + 4 * hi, (unsigned)(t + 1));                                            \
                           else { const unsigned w_ = (j_ >> 5) == 0 ? sel.x : (j_ >> 5) == 1 ? sel.y : (j_ >> 5) == 2 ? sel.z : sel.w; rowkeep = ((w_ >> (j_ & 31)) & 1u) != 0u; } } \
        else { if (j_ == Tq || j_ + 8 <= Tq) mask_range(P0, P1, kb + 4 * hi - (t - 511), 512u); }                                        \
        float pmax = rowmax32(P0, P1); if (MODE == M_S) pmax = rowkeep ? pmax : -__builtin_inff(); float mn, alpha;                    \
        if (__builtin_expect(__all((pmax - m_reg) * SCALE <= THR8), 1)) { mn = m_reg; alpha = 1.f; }                                   \
        else { mn = fmaxf(m_reg, pmax); alpha = __builtin_amdgcn_exp2f((m_reg - mn) * C2); m_reg = mn; }                               \
        float mnL = P8_EXP - mn * C2;                                                                                                    \
        if (MODE == M_S) mnL = rowkeep ? mnL : -__builtin_inff();                                                                      \
        _Pragma("unroll") for (int r = 0; r < 16; ++r) { P0[r] = __builtin_amdgcn_exp2f(fmaf(P0[r], C2, mnL)); P1[r] = __builtin_amdgcn_exp2f(fmaf(P1[r], C2, mnL)); } \
        l_reg = l_reg * alpha + rowsum32(P0, P1);                                                                                      \
        _Pragma("unroll") for (int q = 0; q < 4; ++q) { PA[q] = (int)cvt4_fp8(P0[4 * q], P0[4 * q + 1], P0[4 * q + 2], P0[4 * q + 3]); PA[4 + q] = (int)cvt4_fp8(P1[4 * q], P1[4 * q + 1], P1[4 * q + 2], P1[4 * q + 3]); } \
        if (__any(alpha < 1.f)) { if (hi == 0) al_l[r32] = alpha; asm volatile("s_waitcnt lgkmcnt(0)" ::: "memory");                   \
            _Pragma("unroll") for (int r = 0; r < 16; ++r) { const float a_ = al_l[crow(r, hi)]; o[0][r] *= a_; o[1][r] *= a_; o[2][r] *= a_; o[3][r] *= a_; } } } while (0)
#define SUPER8(sidx, SGL, SGW) do { const int ja = j_lo + 2 * (sidx); const bool hasb = ja + 1 < j_hi;                                    \
        if ((sidx) + 1 < NS) stage_load8x2(SGL, K8h, V8Th, ja + 2, ja + 3 < j_hi);                                                     \
        if (late && (sidx) > 0) { SBAR(); PV8(vprev, paa); if (bprev) PV8(vprev + SHM8, pab); SBAR(); }                                 \
        f32x16 p0a, p1a, p0b, p1b;                                                                                                     \
        QK8(p0a, p1a, kof); SBAR(); if (hasb) QK8(p0b, p1b, kof + SHM8);                                                               \
        SBAR();                                                                                                                        \
        if (!hasb) { SOFT8(p0a, p1a, ja, paa); }                                                                                        \
        else {                       \
            SOFT8_2(); }                                                                                                               \
        if (!late) { SBAR(); PV8(vof, paa); if (hasb) PV8(vof + SHM8, pab); }                                                          \
        const int kn = kof ^ (2 * SHM8), vn = (vof == 4 * SHM8) ? 0 : vof + 2 * SHM8;                                                  \
        if ((sidx) + 1 < NS) { SWRITE8(SGW, kn, vn, ja + 3 < j_hi); }                                                                  \
        __syncthreads();                                                                                                               \
        vprev = vof; bprev = hasb; kof = kn; vof = vn; } while (0)
#define SOFT8_2() do { const int kba = ja * 64, kbb = kba + 64; bool keepa = true, keepb = true;                                         \
        if (MODE == M_S) { const unsigned wa_ = (ja >> 5) == 0 ? sel.x : (ja >> 5) == 1 ? sel.y : (ja >> 5) == 2 ? sel.z : sel.w; const int jb = ja + 1;                         \
                           const unsigned wb_ = (jb >> 5) == 0 ? sel.x : (jb >> 5) == 1 ? sel.y : (jb >> 5) == 2 ? sel.z : sel.w;                                                \
                           if (ja == Tq) mask_range(p0a, p1a, kba + 4 * hi, (unsigned)(t + 1)); else keepa = ((wa_ >> (ja & 31)) & 1u) != 0u;                                      \
                           if (jb == Tq) mask_range(p0b, p1b, kbb + 4 * hi, (unsigned)(t + 1)); else keepb = ((wb_ >> (jb & 31)) & 1u) != 0u; }                                    \
        else { if (ja == Tq || ja + 8 <= Tq) mask_range(p0a, p1a, kba + 4 * hi - (t - 511), 512u);                                        \
               if (ja + 1 == Tq || ja + 9 <= Tq) mask_range(p0b, p1b, kbb + 4 * hi - (t - 511), 512u); }                                  \
        float pma = rowmax32(p0a, p1a), pmb = rowmax32(p0b, p1b);                                                                      \
        if (MODE == M_S) { pma = keepa ? pma : -__builtin_inff(); pmb = keepb ? pmb : -__builtin_inff(); }                             \
        const float pmax = fmaxf(pma, pmb); float mn, alpha;                                                                           \
        if (__builtin_expect(__all((pmax - m_reg) * SCALE <= THR8), 1)) { mn = m_reg; alpha = 1.f; }                                   \
        else { mn = fmaxf(m_reg, pmax); alpha = __builtin_amdgcn_exp2f((m_reg - mn) * C2); m_reg = mn; }                               \
        const float mnL0 = P8_EXP - mn * C2; float mnLa = mnL0, mnLb = mnL0;                                                             \
        if (MODE == M_S) { mnLa = keepa ? mnL0 : -__builtin_inff(); mnLb = keepb ? mnL0 : -__builtin_inff(); }                         \
        _Pragma("unroll") for (int r = 0; r < 16; ++r) { p0a[r] = __builtin_amdgcn_exp2f(fmaf(p0a[r], C2, mnLa)); p1a[r] = __builtin_amdgcn_exp2f(fmaf(p1a[r], C2, mnLa)); } \
        l_reg = l_reg * alpha + rowsum32(p0a, p1a);                                                                                    \
        _Pragma("unroll") for (int q = 0; q < 4; ++q) { paa[q] = (int)cvt4_fp8(p0a[4 * q], p0a[4 * q + 1], p0a[4 * q + 2], p0a[4 * q + 3]); paa[4 + q] = (int)cvt4_fp8(p1a[4 * q], p1a[4 * q + 1], p1a[4 * q + 2], p1a[4 * q + 3]); } \
        _Pragma("unroll") for (int r = 0; r < 16; ++r) { p0b[r] = __builtin_amdgcn_exp2f(fmaf(p0b[r], C2, mnLb)); p1b[r] = __builtin_amdgcn_exp2f(fmaf(p1b[r], C2, mnLb)); } \
        l_reg += rowsum32(p0b, p1b);                                                                                                   \
        _Pragma("unroll") for (int q = 0; q < 4; ++q) { pab[q] = (int)cvt4_fp8(p0b[4 * q], p0b[4 * q + 1], p0b[4 * q + 2], p0b[4 * q + 3]); pab[4 + q] = (int)cvt4_fp8(p1b[4 * q], p1b[4 * q + 1], p1b[4 * q + 2], p1b[4 * q + 3]); } \
        if (__any(alpha < 1.f)) { if (hi == 0) al_l[r32] = alpha; asm volatile("s_waitcnt lgkmcnt(0)" ::: "memory");                   \
            _Pragma("unroll") for (int r = 0; r < 16; ++r) { const float a_ = al_l[crow(r, hi)]; o[0][r] *= a_; o[1][r] *= a_; o[2][r] *= a_; o[3][r] *= a_; } } } while (0)
    for (int sidx = 0; sidx < NS; ++sidx) SUPER8(sidx, sg0, sg0);
    if (late) { SBAR(); PV8(vprev, paa); if (bprev) PV8(vprev + SHM8, pab); }
    __syncthreads();
    st.m = m_reg; st.l = l_reg;
#undef SUPER8
#undef SOFT8_2
#undef SOFT8
#undef QK8
#undef PV8
#undef SWRITE8
}

template <int MODE, bool USE_OL>
__device__ __forceinline__ void branch_out(LAS unsigned char* lds, const f32x16* o, float rowscale, bf16_t* onsa_w, const bf16_t* gn_w, const f32x16 ol, unsigned char* onsa8_w = nullptr) {
    const int tid = otid(), wid = __builtin_amdgcn_readfirstlane(tid >> 6), lane = tid & 63, r32 = lane & 31, hi = lane >> 5;
    LAS float* li_l = (LAS float*)(lds + L_WS) + wid * 64;
    if (hi == 0) li_l[r32] = rowscale; asm volatile("s_waitcnt lgkmcnt(0)" ::: "memory");
    LAS unsigned* stg = (LAS unsigned*)(lds + wid * 8192);
#pragma unroll
    for (int r = 0; r < 16; ++r) { const int orow = crow(r, hi); float sc = li_l[orow]; if (USE_OL) sc = ol[r] > 0.f ? sc * __builtin_amdgcn_rcpf(ol[r]) : 0.f;
#pragma unroll
        for (int d0 = 0; d0 < 4; ++d0) { const float v = o[d0][r] * sc; const float vn = dpp_x1f(v);
            if ((r32 & 1) == 0) stg[orow * 64 + d0 * 16 + (r32 >> 1)] = cvtpk(v, vn); } }
    asm volatile("s_waitcnt lgkmcnt(0)" ::: "memory");
    u32x4 val[8], prev[8], gq[8];
#pragma unroll
    for (int i = 0; i < 8; ++i) val[i] = *(const LAS u32x4*)(stg + (i * 4 + (lane >> 4)) * 64 + (lane & 15) * 4);
    int rb = lane >> 4; asm volatile("" : "+v"(rb));
    bf16_t* gp_ = onsa_w + (size_t)rb * 2048 + (lane & 15) * 8; const bf16_t* gg_ = gn_w + (size_t)rb * 2048 + (lane & 15) * 8;
    unsigned char* o8_ = onsa8_w + (size_t)rb * 2048 + (lane & 15) * 8;
    if (MODE >= 1) {
#pragma unroll
        for (int i = 0; i < 8; ++i) prev[i] = *(const u32x4*)(gp_ + (size_t)i * 4 * 2048); }
    if (MODE == 2) {
#pragma unroll
        for (int i = 0; i < 8; ++i) gq[i] = *(const u32x4*)(gg_ + (size_t)i * 4 * 2048); }
#pragma unroll
    for (int i = 0; i < 8; ++i) { u32x4 w = val[i];
        if (MODE >= 1) { f32x4 a0, a1, b0, b1; unpack8(val[i], a0, a1); unpack8(prev[i], b0, b1); a0 = a0 + b0; a1 = a1 + b1;
            if (MODE == 2) { f32x4 g0, g1; unpack8(gq[i], g0, g1); a0 = a0 * g0; a1 = a1 * g1; }
            w = pack8(a0, a1); }
        if (MODE == 2) { f32x4 a0, a1; unpack8(w, a0, a1); u32x2 w8; w8.x = cvt4_fp8(sat8(a0[0] * ONSA_SCALE), sat8(a0[1] * ONSA_SCALE), sat8(a0[2] * ONSA_SCALE), sat8(a0[3] * ONSA_SCALE));
            w8.y = cvt4_fp8(sat8(a1[0] * ONSA_SCALE), sat8(a1[1] * ONSA_SCALE), sat8(a1[2] * ONSA_SCALE), sat8(a1[3] * ONSA_SCALE)); *(u32x2*)(o8_ + (size_t)i * 4 * 2048) = w8; }
        else *(u32x4*)(gp_ + (size_t)i * 4 * 2048) = w; }
    __syncthreads();
}

__device__ __forceinline__ void attn_unit(LAS unsigned char* lds, unsigned char* ws, int h, int Tq) {
    const int tid = otid(), wid = __builtin_amdgcn_readfirstlane(tid >> 6), lane = tid & 63, r32 = lane & 31, hi = lane >> 5;
    const int g = wid >> 1, tl = (wid & 1) * 32 + r32, t = Tq * 64 + tl, hq = 4 * h + g;
    const bf16_t* Q = (const bf16_t*)(ws + WS_Q); const bf16_t* GBR = (const bf16_t*)(ws + WS_GBR);
    bf16_t* onsa_w = (bf16_t*)(ws + WS_ONSA) + (size_t)(Tq * 64 + (wid & 1) * 32) * 2048 + hq * 128; const bf16_t* gn_w = (const bf16_t*)(ws + WS_GN) + (size_t)(Tq * 64 + (wid & 1) * 32) * 2048 + hq * 128;
    bf16x8 qr[8];
#pragma unroll
    for (int d0 = 0; d0 < 8; ++d0) qr[d0] = *(const bf16x8*)(Q + (size_t)t * 2048 + hq * 128 + d0 * 16 + hi * 8);
    const float g_c = bf2f(GBR[(size_t)t * 256 + hq * 3 + 0]);
    const bool big = Tq >= 16;
    LAS unsigned* IMP = (LAS unsigned*)(lds + L_IMP);
    if (big) { for (int i = tid; i < 64 * IMP_LD; i += 512) IMP[i] = 0u; }
    const u32x4 nosel = {0u, 0u, 0u, 0u};
    f32x16 o[4]; Stage sg;
    {
        const bf16_t* Kc = (const bf16_t*)(ws + WS_KC) + (size_t)h * 512 * 128; const bf16_t* Vc = (const bf16_t*)(ws + WS_VC) + (size_t)h * 512 * 128;
        const int ntc = ((4 * Tq + 2) >> 6) + 1;
        RowState stc{-1e30f, 0.f};
        stage_load(sg, Kc, Vc, 128, 0, false);
        attn_pass<M_C1>(lds, Kc, Vc, 128, 0, ntc, qr, t, Tq, nosel, stc, 0.f, o, false, sg);
        stage_load(sg, Kc, Vc, 128, 0, true);
        const float invl = stc.l > 0.f ? 1.0f / stc.l : 0.f;
#pragma unroll
        for (int d = 0; d < 4; ++d) o[d] = f32x16{};
        attn_pass<M_C2>(lds, Kc, Vc, 128, 0, ntc, qr, t, Tq, nosel, stc, invl, o, big, sg);
        branch_out<0, false>(lds, o, g_c, onsa_w, gn_w, f32x16{});
    }
    {
        LAS unsigned short* SELM = (LAS unsigned short*)(lds + L_SELM);
        int tok = tid >> 3, sub = tid & 7; asm volatile("" : "+v"(tok), "+v"(sub));
        unsigned bits = 0u;
        if (big) {
            unsigned kv[16];
#pragma unroll
            for (int e = 0; e < 16; ++e) { const int j = sub * 16 + e; const unsigned v = IMP[tok * IMP_LD + j]; kv[e] = (j >= 1 && j <= Tq - 2) ? v + 1u : 0u; }
            for (int round = 0; round < 13; ++round) {
                unsigned bv = kv[0]; int bj = 0;
#pragma unroll
                for (int e = 1; e < 16; ++e) { const bool gt = kv[e] > bv; bv = gt ? kv[e] : bv; bj = gt ? e : bj; }
                bj += sub * 16;
#pragma unroll
                for (int st_ = 0; st_ < 3; ++st_) { const unsigned ov = st_ == 0 ? dpp_x1(bv) : st_ == 1 ? dpp_x2(bv) : dpp_m8(bv); const int oj = (int)(st_ == 0 ? dpp_x1((unsigned)bj) : st_ == 1 ? dpp_x2((unsigned)bj) : dpp_m8((unsigned)bj));
                    const bool take = (ov > bv) || (ov == bv && oj < bj); bv = take ? ov : bv; bj = take ? oj : bj; }
                const int we = (bv != 0u && (bj >> 4) == sub) ? (bj & 15) : -1;
#pragma unroll
                for (int e = 0; e < 16; ++e) { const bool hit = (we == e); bits |= hit ? (1u << e) : 0u; kv[e] = hit ? 0u : kv[e]; }
            }
#pragma unroll
            for (int e = 0; e < 16; ++e) { const int j = sub * 16 + e; if (j == 0 || j == Tq - 1 || j == Tq) bits |= 1u << e; }
        } else {
#pragma unroll
            for (int e = 0; e < 16; ++e) { const int j = sub * 16 + e; if (j <= Tq) bits |= 1u << e; }
        }
        SELM[tok * 8 + sub] = (unsigned short)bits;
        __syncthreads();
    }
    const u32x4 sel = *(const LAS u32x4*)(lds + L_SELM + tl * 16);
    v8i qf[2];
    { const unsigned char* q8 = ws + WS_Q8 + (size_t)t * 2048 + hq * 128 + 32 * hi;
#pragma unroll
      for (int ks = 0; ks < 2; ++ks) { const u32x4 x = *(const u32x4*)(q8 + 64 * ks), y = *(const u32x4*)(q8 + 64 * ks + 16); qf[ks] = (v8i){(int)x.x, (int)x.y, (int)x.z, (int)x.w, (int)y.x, (int)y.y, (int)y.z, (int)y.w}; } }
    const unsigned char* K8S = ws + WS_K8S + h * 128; const unsigned char* V8TS = ws + WS_V8TS + (size_t)h * 128 * 8192;
    const unsigned char* K8W = ws + WS_K8W + h * 128; const unsigned char* V8TW = ws + WS_V8TW + (size_t)h * 128 * 8192;
    Stage8x2 s8;
    {
        RowState sts{-1e30f, 0.f};
#pragma unroll
        for (int d = 0; d < 4; ++d) o[d] = f32x16{};
        stage_load8x2(s8, K8S, V8TS, 0, Tq + 1 > 1);
        attn_pass8<M_S>(lds, K8S, V8TS, 0, Tq + 1, qf, t, Tq, sel, sts, o, s8);
        stage_load8x2(s8, K8W, V8TW, Tq >= 8 ? Tq - 8 : 0, Tq >= 1);
        const float g_s = bf2f(GBR[(size_t)t * 256 + hq * 3 + 1]);
        branch_out<1, false>(lds, o, sts.l > 0.f ? g_s / sts.l : 0.f, onsa_w, gn_w, f32x16{});
    }
    {
        RowState stw{-1e30f, 0.f};
#pragma unroll
        for (int d = 0; d < 4; ++d) o[d] = f32x16{};
        attn_pass8<M_W>(lds, K8W, V8TW, Tq >= 8 ? Tq - 8 : 0, Tq + 1, qf, t, Tq, sel, stw, o, s8);
        const float g_w = bf2f(GBR[(size_t)t * 256 + hq * 3 + 2]);
        branch_out<2, false>(lds, o, stw.l > 0.f ? g_w / stw.l : 0.f, onsa_w, gn_w, f32x16{}, ws + WS_ONSA8 + (size_t)(Tq * 64 + (wid & 1) * 32) * 2048 + hq * 128);
    }
}
#undef KSWZ
#undef SBAR
}

constexpr int NPHASE = 8;
__global__ void __launch_bounds__(NWAVES * 64, 2) mega_fwd(Args args) {
    extern __shared__ __attribute__((aligned(16))) unsigned char lds[];
    Frame F;
    F.lds = (LAS unsigned char*)lds;
    F.tid = threadIdx.x; F.lane = F.tid & 63; F.wave = __builtin_amdgcn_readfirstlane(F.tid >> 6);
    F.G = gridDim.x; { const int bx = blockIdx.x; F.vcu = (F.G % 8 == 0) ? (bx % 8) * (F.G / 8) + bx / 8 : bx; }
    volatile LAS unsigned* MISC = (volatile LAS unsigned*)(F.lds + MISC_OFF);
    unsigned char* ws = args.ws;
    for (int u = F.tid; u < (LDS_BYTES - LDSCTL_OFF) / 4; u += NWAVES * 64) ((LAS unsigned*)(F.lds + LDSCTL_OFF))[u] = 0u;
    __syncthreads();
    XcdBarrier bar; bar.bar = (unsigned*)(ws + WS_CTL) + CW_BAR; bar.x = 0; bar.st = nullptr;
#if !N_LAUNCHES_PER_PHASE
    bar = xcd_barrier_post((unsigned*)(ws + WS_CTL) + CW_BAR, MISC + 8);
#endif
    const int lo = args.ph_lo, hi = args.ph_hi;
#define IN(k) (lo <= (k) && (k) < hi && (F.tid = otid(), F.lane = F.tid & 63, true))
#define SEAM(k) do { if (IN(k) && IN((k) + 1)) xcd_barrier(bar); } while (0)
    bf16_t* const GM = (bf16_t*)args.out;

    for (int rep_ = 0; rep_ < (DUP_PHASE == 0 ? 2 : 1); ++rep_) if (IN(0)) { if (rep_) xcd_barrier(bar); p0_prologue(F, args); } SEAM(0);
    for (int rep_ = 0; rep_ < (DUP_PHASE == 1 ? 2 : 1); ++rep_) if (IN(1)) { if (rep_) xcd_barrier(bar);
        pg8::Gemm g{(const bf16_t*)(ws + WS_H), (const bf16_t*)(ws + WS_WCAT), 2048, 2048, 2048};
        pg8::StaticOrder So; So.init(S, NCAT, F.G, (int)blockIdx.x);
        EpiInProj E{ws, GM, args.in[14], 0};
        pg8::AddrAffine AD{(size_t)256 * 2048 * 2, (size_t)256 * 2048 * 2};
        pg8::gemm_phase<EpiInProj, true>(F.lds, g, So, E, AD);
        {
            pg8::Gemm g8{(const bf16_t*)(ws + WS_H8), (const bf16_t*)(ws + WS_W8), 1024, 1024, 1024};
            pg8::StaticOrder S8; S8.init(S, 4096, F.G, (int)blockIdx.x);
            EpiInProj E8{ws, GM, args.in[14], 37};
            pg8::AddrAffine AD8{(size_t)256 * 1024 * 2, (size_t)256 * 1024 * 2};
            pg8::gemm_phase<EpiInProj, true, pg8::AddrAffine, true>(F.lds, g8, S8, E8, AD8);
        }
        { const int nun = (So.nwg + F.G - 1) / F.G, full = So.nwg - (nun - 1) * F.G;
          const int base = full < F.G ? full : 0; if ((int)blockIdx.x >= base) p1_late_weights(F, args, ((int)blockIdx.x - base) * NWAVES + F.wave, (F.G - base) * NWAVES); }
    } SEAM(1);
    for (int rep_ = 0; rep_ < (DUP_PHASE == 2 ? 2 : 1); ++rep_) if (IN(2)) { if (rep_) xcd_barrier(bar);
        pg8::Gemm g{(const bf16_t*)(ws + WS_KCR), (const bf16_t*)(ws + WS_W1KT), 2048, 4096, 4096 / NSPLIT};
        pg8::StaticOrder So; So.init(16 * 256, NSPLIT * 256, F.G, (int)blockIdx.x);
        EpiSlab E{(float*)(ws + WS_SLAB)};
        pg8::AddrCmp AD{(4096 / NSPLIT) / 64};
        pg8::gemm_phase<EpiSlab, false>(F.lds, g, So, E, AD);
        { const int base = F.G > So.nwg ? So.nwg : 0; if ((int)blockIdx.x >= base) { p2_ypool(F, ws, args.in[4], ((int)blockIdx.x - base) * NWAVES + F.wave, (F.G - base) * NWAVES); p2_vt8(F, ws, ((int)blockIdx.x - base) * NWAVES + F.wave, (F.G - base) * NWAVES); } }
        if (blockIdx.x == F.G - 1) { const float* b1p = (const float*)(ws + WS_B1P); float* b1 = (float*)(ws + WS_B1); const int t = F.tid; float s = 0.f;
            for (int c = 0; c < 64; ++c) s += b1p[((t >> 8) * 64 + c) * 256 + (t & 255)];
            b1[t] = s; }
    } SEAM(2);
    for (int rep_ = 0; rep_ < (DUP_PHASE == 3 ? 2 : 1); ++rep_) if (IN(3)) { if (rep_) xcd_barrier(bar);
        p3_compress2(F, ws, (int)blockIdx.x, F.G);
    } SEAM(3);
    for (int rep_ = 0; rep_ < (DUP_PHASE == 5 ? 2 : 1); ++rep_) if (IN(5)) { if (rep_) xcd_barrier(bar);
        for (int p = F.vcu; p < 256; p += F.G) {
#pragma unroll 1
            for (int i = 0; i < 2; ++i) { const int h = p >> 6, x = p & 63; nsa::attn_unit(F.lds, ws, h, i ? x : 127 - x); } }
    } SEAM(5);
    for (int rep_ = 0; rep_ < (DUP_PHASE == 6 ? 2 : 1); ++rep_) if (IN(6)) { if (rep_) xcd_barrier(bar);
        pg8::Gemm ga{(const bf16_t*)(ws + WS_H + 16 * MiB), (const bf16_t*)(ws + WS_WPOT), 1024, 1024, 1024};
        pg8::Gemm gb{(const bf16_t*)(ws + WS_ONSA8), (const bf16_t*)(ws + WS_WNOT), 1024, 1024, 1024};
        pg8::StaticOrder So; So.init(S, 2048, F.G, (int)blockIdx.x);
        EpiYaYb E{EpiYa{(bf16_t*)(ws + WS_YAG), GM}, EpiYb{(bf16_t*)(ws + WS_H), (const bf16_t*)(ws + WS_YAG), GM, 1.0f / (ONSA_SCALE * WNO_SCALE)}};
        pg8::gemm_phase2<EpiYaYb>(F.lds, ga, gb, So, E);
    } SEAM(6);
    for (int rep_ = 0; rep_ < (DUP_PHASE == 7 ? 2 : 1); ++rep_) if (IN(7)) { if (rep_) xcd_barrier(bar);
        pg8::Gemm g{(const bf16_t*)(ws + WS_H), (const bf16_t*)(ws + WS_WOT), 2048, 2048, 2048}; pg8::AddrAffine AD{(size_t)256 * 2048 * 2, (size_t)256 * 2048 * 2};
        pg8::StaticOrder So; So.init(S, 2048, F.G, (int)blockIdx.x);
        EpiOut E{args.out, args.in[0], (float*)(ws + WS_SSQ), args.in[16], (unsigned*)(ws + WS_CTL), F.lds};
        pg8::gemm_phase<EpiOut, true>(F.lds, g, So, E, AD);
    }
#undef IN
#undef SEAM
}

extern "C" void kernel_launch(void* const* d_in, const int* in_sizes, int n_in, void* d_out, int out_size, void* d_ws, size_t ws_size, hipStream_t stream) {
    static int grid = 0;
    if (grid == 0) {
        if (n_in != 17 || in_sizes[0] != S * DM || out_size != S * DM || ws_size < WS_END) { fprintf(stderr, "kernel_launch: unexpected shapes (n_in %d, in0 %d, out %d, ws %zu); nothing launched\n", n_in, n_in > 0 ? in_sizes[0] : -1, out_size, ws_size); grid = -1; return; }
        int dev = 0, cus = 0;
        if (hipGetDevice(&dev) != hipSuccess || hipDeviceGetAttribute(&cus, hipDeviceAttributeMultiprocessorCount, dev) != hipSuccess) { fprintf(stderr, "kernel_launch: device query failed\n"); grid = -1; return; }
        if (hipFuncSetAttribute((const void*)mega_fwd, hipFuncAttributeMaxDynamicSharedMemorySize, LDS_BYTES) != hipSuccess) { fprintf(stderr, "kernel_launch: hipFuncSetAttribute failed\n"); grid = -1; return; }
        (void)hipGetLastError();
        grid = cus;
    }
    if (grid < 0) return;
    (void)hipMemsetAsync((char*)d_ws + WS_CTL, 0, CTL_BYTES, stream);
    Args a{};
    for (int i = 0; i < 17; ++i) a.in[i] = (const float*)d_in[i];
    a.out = (float*)d_out; a.ws = (unsigned char*)d_ws;
#if N_LAUNCHES_PER_PHASE
    for (int p = 0; p < NPHASE; ++p) { a.ph_lo = p; a.ph_hi = p + 1; hipLaunchKernelGGL(mega_fwd, dim3(grid), dim3(NWAVES * 64), LDS_BYTES, stream, a); }
#else
    a.ph_lo = 0; a.ph_hi = NPHASE;
    hipLaunchKernelGGL(mega_fwd, dim3(grid), dim3(NWAVES * 64), LDS_BYTES, stream, a);
#endif
}
```
